# Optimizing an MI355X kernel written in HIP

```python
import jax, jax.numpy as jnp
from jax import lax
import numpy as np

D_MODEL = 1024
BATCH = 4
SEQ = 4096
DEPTH = 2

N_A_LAYERS = DEPTH // 2
N_B_LAYERS = DEPTH - N_A_LAYERS
CONV_WIDTH = 3
N_HEADS = 16
HEAD_DIM = D_MODEL // N_HEADS
N_KV_HEADS = 4
GQA_GROUP = N_HEADS // N_KV_HEADS
CMP_BLOCK = 32
CMP_STRIDE = 16
CMP_HIDDEN = 4 * HEAD_DIM
SEL_BLOCK = 64
SEL_TOP = 16
WINDOW = 512
Q_BLOCK = 128
N_EXPERTS = 16
N_GROUPS = 4
EXPERTS_PER_GROUP = N_EXPERTS // N_GROUPS
TOP_K = 2
D_FF_EXPERT = D_MODEL // 2
ALPHA = (2 * DEPTH) ** 0.25
BETA = (8 * DEPTH) ** -0.25
LN_EPS = 1e-5
NEG = -1e30
FORCE = 1e9

kernel_name = "hybrid_shortconv_nsa_yoco_moe"


def layer_norm(x, g, b):
    xf = x.astype(jnp.float32)
    mu = jnp.mean(xf, -1, keepdims=True)
    var = jnp.mean(jnp.square(xf - mu), -1, keepdims=True)
    y = (xf - mu) * lax.rsqrt(var + LN_EPS)
    return (y * g.astype(jnp.float32) + b.astype(jnp.float32)).astype(x.dtype)


def masked_softmax(s, mask, axis):
    s = jnp.where(mask, s, NEG)
    m = jnp.max(s, axis=axis, keepdims=True)
    e = jnp.where(mask, jnp.exp(s - m), 0.0)
    return e / jnp.maximum(jnp.sum(e, axis=axis, keepdims=True), 1e-30)


def short_conv_mixer(u, w_in, conv_w, conv_b, w_out):
    bch = u @ w_in
    b_gate, c_gate, h = jnp.split(bch, 3, axis=-1)
    z = c_gate * h
    z = lax.conv_general_dilated(
        z, conv_w[:, None, :], window_strides=(1,),
        padding=[(CONV_WIDTH - 1, 0)],
        dimension_numbers=("NWC", "WIO", "NWC"),
        feature_group_count=D_MODEL) + conv_b
    return (b_gate * z) @ w_out


def nsa_shared_kv(s, w_kv, cmp_pe, cmp_w1, cmp_b1, cmp_w2, cmp_b2):
    B, S, _ = s.shape
    kv = (s @ w_kv).reshape(B, S, 6, N_KV_HEADS, HEAD_DIM)
    kv = jnp.transpose(kv, (2, 0, 3, 1, 4))
    k_c, v_c, k_s, v_s, k_w, v_w = kv[0], kv[1], kv[2], kv[3], kv[4], kv[5]
    n_cmp = (S - CMP_BLOCK) // CMP_STRIDE + 1
    idx = jnp.arange(n_cmp)[:, None] * CMP_STRIDE + jnp.arange(CMP_BLOCK)[None, :]

    def compress(t, i):
        blocks = t[:, :, idx] + cmp_pe[i]
        flat = blocks.reshape(B, N_KV_HEADS, n_cmp, CMP_BLOCK * HEAD_DIM)
        hdn = jax.nn.gelu(flat @ cmp_w1[i] + cmp_b1[i])
        return hdn @ cmp_w2[i] + cmp_b2[i]

    kc = compress(k_c, 0)
    vc = compress(v_c, 1)
    n_sel = S // SEL_BLOCK
    ks = k_s.reshape(B, N_KV_HEADS, n_sel, SEL_BLOCK, HEAD_DIM)
    vs = v_s.reshape(B, N_KV_HEADS, n_sel, SEL_BLOCK, HEAD_DIM)
    pad = ((0, 0), (0, 0), (WINDOW, 0), (0, 0))
    kw = jnp.pad(k_w, pad)
    vw = jnp.pad(v_w, pad)
    return kc, vc, ks, vs, kw, vw


def nsa_mixer(u, w_qg, b_g, w_o, kc, vc, ks, vs, kw, vw):
    B, S, _ = u.shape
    f32 = jnp.float32
    qg = u @ w_qg
    q = qg[..., :N_HEADS * HEAD_DIM].reshape(B, S, N_KV_HEADS, GQA_GROUP, HEAD_DIM)
    q = jnp.transpose(q, (0, 2, 3, 1, 4)) * (HEAD_DIM ** -0.5)
    g = jax.nn.sigmoid((qg[..., N_HEADS * HEAD_DIM:] + b_g).astype(f32))
    g = jnp.transpose(g.reshape(B, S, N_KV_HEADS, GQA_GROUP, 3), (0, 2, 3, 1, 4))

    n_cmp = kc.shape[2]
    n_sel = ks.shape[2]
    cmp_start = jnp.arange(n_cmp) * CMP_STRIDE
    cmp_end = cmp_start + CMP_BLOCK - 1
    sel_start = jnp.arange(n_sel) * SEL_BLOCK
    overlap = jnp.clip(
        jnp.minimum(cmp_start[:, None] + CMP_BLOCK, sel_start[None, :] + SEL_BLOCK)
        - jnp.maximum(cmp_start[:, None], sel_start[None, :]), 0, None).astype(f32) / CMP_BLOCK
    n_top = min(SEL_TOP, n_sel)
    bi = jnp.arange(B)[:, None, None, None]
    hi = jnp.arange(N_KV_HEADS)[None, :, None, None]
    jsel = jnp.arange(n_sel)

    def block(i):
        s0 = i * Q_BLOCK
        qb = lax.dynamic_slice_in_dim(q, s0, Q_BLOCK, axis=3)
        gb = lax.dynamic_slice_in_dim(g, s0, Q_BLOCK, axis=3)
        t = s0 + jnp.arange(Q_BLOCK)
        sc = jnp.einsum("bhgqd,bhnd->bhgqn", qb, kc).astype(f32)
        pc = masked_softmax(sc, cmp_end[None, :] <= t[:, None], -1)
        o_c = jnp.einsum("bhgqn,bhnd->bhgqd", pc.astype(vc.dtype), vc)
        imp = jnp.einsum("bhgqn,nj->bhqj", pc, overlap)
        cur = t // SEL_BLOCK
        allowed = jsel[None, :] <= cur[:, None]
        forced = (jsel[None, :] == 0) | (jsel[None, :] == cur[:, None]) | (jsel[None, :] == cur[:, None] - 1)
        score = jnp.where(forced & allowed, FORCE, jnp.where(allowed, imp, NEG))
        top_val, top_idx = lax.top_k(score, n_top)
        sel_ok = top_val > 0.5 * NEG
        kg = ks[bi, hi, top_idx]
        vg = vs[bi, hi, top_idx]
        kpos = top_idx[..., None] * SEL_BLOCK + jnp.arange(SEL_BLOCK)
        ms = sel_ok[..., None] & (kpos <= t[None, None, :, None, None])
        ssel = jnp.einsum("bhgqd,bhqnkd->bhgqnk", qb, kg).astype(f32)
        ps = masked_softmax(ssel, ms[:, :, None], (-2, -1))
        o_s = jnp.einsum("bhgqnk,bhqnkd->bhgqd", ps.astype(vg.dtype), vg)
        kwb = lax.dynamic_slice_in_dim(kw, s0, WINDOW + Q_BLOCK, axis=2)
        vwb = lax.dynamic_slice_in_dim(vw, s0, WINDOW + Q_BLOCK, axis=2)
        wpos = s0 - WINDOW + jnp.arange(WINDOW + Q_BLOCK)
        mw = (wpos[None, :] <= t[:, None]) & (wpos[None, :] > t[:, None] - WINDOW) & (wpos[None, :] >= 0)
        sw = jnp.einsum("bhgqd,bhkd->bhgqk", qb, kwb).astype(f32)
        pw = masked_softmax(sw, mw, -1)
        o_w = jnp.einsum("bhgqk,bhkd->bhgqd", pw.astype(vwb.dtype), vwb)
        o = gb[..., 0:1] * o_c + gb[..., 1:2] * o_s + gb[..., 2:3] * o_w
        return o.astype(u.dtype)

    o = lax.map(block, jnp.arange(S // Q_BLOCK))
    o = jnp.transpose(o, (1, 0, 4, 2, 3, 5)).reshape(B, S, N_HEADS * HEAD_DIM)
    return o @ w_o


def grouped_moe(u, router_w, router_bias, w_gu, w_down):
    B, S, D = u.shape
    f32 = jnp.float32
    tok = u.reshape(-1, D)
    aff = jax.nn.softmax((tok @ router_w).astype(f32), axis=-1)
    biased = aff + router_bias.astype(f32)
    grp_score = lax.top_k(biased.reshape(-1, N_GROUPS, EXPERTS_PER_GROUP), TOP_K)[0].sum(-1)
    best = jnp.argmax(grp_score, axis=-1)
    in_grp = (jnp.arange(N_EXPERTS) // EXPERTS_PER_GROUP)[None, :] == best[:, None]
    _, idx = lax.top_k(jnp.where(in_grp, biased, NEG), TOP_K)
    w = jnp.take_along_axis(aff, idx, axis=-1)
    w = w / jnp.sum(w, -1, keepdims=True)
    comb = jnp.sum(jax.nn.one_hot(idx, N_EXPERTS, dtype=f32) * w[..., None], axis=-2)
    out = jnp.zeros_like(tok)
    for e in range(N_EXPERTS):
        gate, up = jnp.split(tok @ w_gu[e], 2, axis=-1)
        out = out + comb[:, e:e + 1].astype(tok.dtype) * ((jax.nn.silu(gate) * up) @ w_down[e])
    return out.reshape(B, S, D)


def setup_inputs(seed: int = 0) -> dict:
    key = jax.random.key(seed)
    ks = jax.random.split(key, 24)
    f32 = jnp.float32
    D = D_MODEL
    nrm = lambda k, shape, s: jax.random.normal(k, shape, f32) * s
    gate_pattern = jnp.repeat(jnp.array([0.0, 0.0, 1.0, 0.0, 0.0, 1.0], f32), D)
    return {
        "x": nrm(ks[0], (BATCH, SEQ, D), 1.0),
        "c": nrm(ks[1], (BATCH, D), 1.0),
        "ada_w": nrm(ks[2], (DEPTH, D, 6 * D), 0.1 * D ** -0.5),
        "ada_b": gate_pattern[None, :] + nrm(ks[3], (DEPTH, 6 * D), 0.02),
        "ln_g": 1.0 + nrm(ks[4], (DEPTH, 2, D), 0.02),
        "ln_b": nrm(ks[5], (DEPTH, 2, D), 0.02),
        "conv_w_in": nrm(ks[6], (N_A_LAYERS, D, 3 * D), D ** -0.5),
        "conv_w": nrm(ks[7], (N_A_LAYERS, CONV_WIDTH, D), CONV_WIDTH ** -0.5),
        "conv_b": nrm(ks[8], (N_A_LAYERS, D), 0.02),
        "conv_w_out": nrm(ks[9], (N_A_LAYERS, D, D), BETA * D ** -0.5),
        "w_kv": nrm(ks[10], (D, 6 * N_KV_HEADS * HEAD_DIM), D ** -0.5),
        "cmp_pe": nrm(ks[11], (2, CMP_BLOCK, HEAD_DIM), 0.02),
        "cmp_w1": nrm(ks[12], (2, CMP_BLOCK * HEAD_DIM, CMP_HIDDEN), (CMP_BLOCK * HEAD_DIM) ** -0.5),
        "cmp_b1": nrm(ks[13], (2, CMP_HIDDEN), 0.02),
        "cmp_w2": nrm(ks[14], (2, CMP_HIDDEN, HEAD_DIM), CMP_HIDDEN ** -0.5),
        "cmp_b2": nrm(ks[15], (2, HEAD_DIM), 0.02),
        "w_qg": nrm(ks[16], (N_B_LAYERS, D, N_HEADS * HEAD_DIM + 3 * N_HEADS), D ** -0.5),
        "b_g": nrm(ks[17], (N_B_LAYERS, 3 * N_HEADS), 0.02),
        "w_o": nrm(ks[18], (N_B_LAYERS, N_HEADS * HEAD_DIM, D), BETA * (N_HEADS * HEAD_DIM) ** -0.5),
        "router_w": nrm(ks[19], (D, N_EXPERTS), D ** -0.5),
        "router_bias": nrm(ks[20], (N_EXPERTS,), 0.01),
        "w_gu": nrm(ks[21], (DEPTH, N_EXPERTS, D, 2 * D_FF_EXPERT), D ** -0.5),
        "w_down": nrm(ks[22], (DEPTH, N_EXPERTS, D_FF_EXPERT, D), BETA * D_FF_EXPERT ** -0.5),
    }


def reference(x, c, ada_w, ada_b, ln_g, ln_b, conv_w_in, conv_w, conv_b, conv_w_out,
              w_kv, cmp_pe, cmp_w1, cmp_b1, cmp_w2, cmp_b2, w_qg, b_g, w_o,
              router_w, router_bias, w_gu, w_down):
    mod = jnp.einsum("bd,lde->lbe", jax.nn.silu(c), ada_w) + ada_b[:, None, :]
    shared = None
    for l in range(DEPTH):
        sh1, sc1, g1, sh2, sc2, g2 = jnp.split(mod[l][:, None, :], 6, axis=-1)
        u = x * (1.0 + sc1) + sh1
        if l < N_A_LAYERS:
            y = short_conv_mixer(u, conv_w_in[l], conv_w[l], conv_b[l], conv_w_out[l])
        else:
            if l == N_A_LAYERS:
                shared = nsa_shared_kv(x, w_kv, cmp_pe, cmp_w1, cmp_b1, cmp_w2, cmp_b2)
            lb = l - N_A_LAYERS
            y = nsa_mixer(u, w_qg[lb], b_g[lb], w_o[lb], *shared)
        x = layer_norm(ALPHA * x + g1 * y, ln_g[l, 0], ln_b[l, 0])
        u = x * (1.0 + sc2) + sh2
        y = grouped_moe(u, router_w, router_bias, w_gu[l], w_down[l])
        x = layer_norm(ALPHA * x + g2 * y, ln_g[l, 1], ln_b[l, 1])
    return x
```

```cpp
#include <hip/hip_runtime.h>
#include <cstdio>
#include <cstdint>

#ifndef MK_N_LAUNCHES
#define MK_N_LAUNCHES 18
#endif

#define GAS __attribute__((address_space(1)))
#define LAS __attribute__((address_space(3)))
typedef unsigned short bf16;
typedef short bf16x8 __attribute__((ext_vector_type(8)));
typedef float f32x4 __attribute__((ext_vector_type(4)));
typedef unsigned u32x4 __attribute__((ext_vector_type(4)));
typedef unsigned u32x2 __attribute__((ext_vector_type(2)));
typedef GAS unsigned gu32;
#define RLX_AGENT __ATOMIC_RELAXED, __HIP_MEMORY_SCOPE_AGENT

constexpr int NB = 4, SEQ = 4096, DM = 1024, T = NB * SEQ, NH = 16, HKV = 4, HD = 64, NE = 16, FF = 512;
constexpr int NPH = 18;
constexpr float ALPHA = 1.4142135623730951f;
constexpr float LN_EPS = 1e-5f;
constexpr float C2 = 0.125f * 1.4426950408889634f;
constexpr int KVROWS = SEQ + 128;
constexpr int HROWS = 2 * T + NE * 256;

constexpr size_t MiB = 1u << 20;
constexpr size_t WS_CTL = 0, CTL_ZERO_BYTES = 1 * MiB;
constexpr size_t WS_MODP = 1 * MiB;
constexpr size_t WS_MOD = 3 * MiB;
constexpr size_t WS_PETP = 3 * MiB + 512 * 1024;
constexpr size_t WS_LIST = 4 * MiB;
constexpr size_t WS_LW = 6 * MiB;
constexpr size_t WS_WIN = 8 * MiB, WS_WOUT = 14 * MiB, WS_WKV = 16 * MiB, WS_WQG = 19 * MiB, WS_WO = 22 * MiB, WS_W1C = 24 * MiB;
constexpr size_t WS_WGU = 26 * MiB, WS_WDN = 90 * MiB;
constexpr size_t WS_U = 122 * MiB, WS_XB = 154 * MiB, WS_H = 186 * MiB, WS_Y0 = 226 * MiB, WS_Y1 = 258 * MiB;
constexpr size_t WS_R1 = 290 * MiB;
constexpr size_t WS_BG = WS_R1, WS_Z = WS_R1 + 32 * MiB, WS_A2 = WS_R1 + 64 * MiB;
constexpr size_t WS_Q = WS_R1, WS_O = WS_R1 + 32 * MiB, WS_KV = WS_R1 + 64 * MiB;
constexpr size_t KVBUF_ELEMS = (size_t)16 * KVROWS * 64;
constexpr size_t WS_TB = WS_R1 + 114 * MiB, WS_KC = WS_R1 + 130 * MiB, WS_VC = WS_KC + 512 * 1024, WS_GATE = WS_R1 + 131 * MiB;
constexpr size_t WS_END = WS_R1 + 135 * MiB;
static_assert(WS_Y1 == WS_Y0 + (size_t)T * DM * 2, "Y1 follows Y0");
static_assert(WS_KV + 6 * KVBUF_ELEMS * 2 <= WS_TB, "kv buffers");
static_assert((size_t)HROWS * FF * 2 <= 40 * MiB, "H buffer");
constexpr int CW_CNT = 1024;
constexpr int CW_BAR = 4096;

constexpr int RING_BYTES = 131072;
constexpr int LDSCTL_OFF = RING_BYTES, MISC_OFF = LDSCTL_OFF + 320;
constexpr int LDS_BYTES = 147456;

#define LDS_WAIT() asm volatile("s_waitcnt lgkmcnt(0)" ::: "memory")
__device__ __forceinline__ unsigned f2bf(float f) { unsigned u = __builtin_bit_cast(unsigned, f); return (u + 0x7fffu + ((u >> 16) & 1u)) >> 16; }
__device__ __forceinline__ unsigned pk2(float lo, float hi) { return f2bf(lo) | (f2bf(hi) << 16); }
__device__ __forceinline__ float bf2f(unsigned short h) { return __builtin_bit_cast(float, (unsigned)h << 16); }
__device__ __forceinline__ float bflo(unsigned w) { return __builtin_bit_cast(float, w << 16); }
__device__ __forceinline__ float bfhi(unsigned w) { return __builtin_bit_cast(float, w & 0xffff0000u); }
__device__ __forceinline__ float wave_sum(float v) {
#pragma unroll
    for (int o = 1; o < 64; o <<= 1) v += __shfl_xor(v, o);
    return v;
}
__device__ __forceinline__ float wave_max(float v) {
#pragma unroll
    for (int o = 1; o < 64; o <<= 1) v = fmaxf(v, __shfl_xor(v, o));
    return v;
}
__device__ __forceinline__ void st_bf4(bf16* p, f32x4 v) { u32x2 w; w.x = pk2(v[0], v[1]); w.y = pk2(v[2], v[3]); *(u32x2*)p = w; }

#define XB_TMO      128
#define XB_XCNT(j)  (256  + 64 * (j))
#define XB_XSUB(j)  (1280 + 64 * (j))
#define XB_XGEN(j)  (2304 + 64 * (j))
#define XB_TOP      3328
#define XB_TOPGEN   3392
#define XCD_BAR_WORDS 3456
#define XB_SPIN_CAP (1u << 22)
__device__ __forceinline__ unsigned xb_ld(unsigned* p)              { return __hip_atomic_load(p, __ATOMIC_RELAXED, __HIP_MEMORY_SCOPE_AGENT); }
__device__ __forceinline__ unsigned xb_add(unsigned* p, unsigned v) { return __hip_atomic_fetch_add(p, v, __ATOMIC_RELAXED, __HIP_MEMORY_SCOPE_AGENT); }
__device__ __forceinline__ unsigned xb_xcc_id() { return (unsigned)__builtin_amdgcn_s_getreg((3 << 11) | 20) & 0xFu; }
#define XB_SPIN(cond, bar) do { unsigned _sp = 0; while (cond) { __builtin_amdgcn_s_sleep(1); \
    if ((++_sp & 255u) == 0u) { if (xb_ld(&(bar)[XB_TMO])) break; if (_sp > XB_SPIN_CAP) { atomicAdd(&(bar)[XB_TMO], 1u); break; } } } } while (0)
struct XcdBarrier { unsigned* bar; unsigned x; volatile LAS unsigned* st; };
__device__ __forceinline__ XcdBarrier xcd_barrier_post(unsigned* bar, volatile LAS unsigned* st) {
    XcdBarrier b; b.bar = bar; b.x = xb_xcc_id(); b.st = st;
    if (threadIdx.x == 0) (void)xb_add(&bar[XB_XCNT(b.x)], 1u);
    return b;
}
__device__ __forceinline__ void xcd_barrier_complete(unsigned* bar, unsigned x, unsigned& nloc, unsigned& nx) {
    const unsigned G = gridDim.x * gridDim.y * gridDim.z;
    unsigned sum, cnt, mine, sp = 0u;
    for (;;) {
        sum = 0u; cnt = 0u; mine = 0u;
#pragma unroll
        for (unsigned j = 0; j < 16; ++j) { const unsigned c = xb_ld(&bar[XB_XCNT(j)]); sum += c; cnt += (c > 0u) ? 1u : 0u; mine = (j == x) ? c : mine; }
        if (sum == G) break;
        __builtin_amdgcn_s_sleep(1);
        if ((++sp & 255u) == 0u) { if (xb_ld(&bar[XB_TMO])) break; if (sp > XB_SPIN_CAP) { atomicAdd(&bar[XB_TMO], 1u); break; } }
    }
    nloc = mine > 0u ? mine : 1u; nx = cnt > 0u ? cnt : 1u;
}
__device__ __forceinline__ void xcd_barrier(const XcdBarrier& b) {
    asm volatile("s_waitcnt vmcnt(0)" ::: "memory");
    __syncthreads();
    if (threadIdx.x == 0) {
        unsigned* bar = b.bar;
        __builtin_amdgcn_s_waitcnt(0);
        unsigned nloc = b.st[0], nx = b.st[1];
        if (nloc == 0u) { xcd_barrier_complete(bar, b.x, nloc, nx); b.st[0] = nloc; b.st[1] = nx; }
        const unsigned old = xb_add(&bar[XB_XSUB(b.x)], 1u);
        const unsigned gen = old / nloc;
        if (old + 1u == (gen + 1u) * nloc) {
            __builtin_amdgcn_fence(__ATOMIC_RELEASE, "agent");
            asm volatile("s_waitcnt vmcnt(0)" ::: "memory");
            const unsigned og = xb_add(&bar[XB_TOP], 1u);
            const unsigned tg = og / nx;
            if (og + 1u == (tg + 1u) * nx) xb_add(&bar[XB_TOPGEN], 1u);
            else XB_SPIN(xb_ld(&bar[XB_TOPGEN]) == tg, bar);
            __builtin_amdgcn_fence(__ATOMIC_ACQUIRE, "agent");
            xb_add(&bar[XB_XGEN(b.x)], 1u);
            asm volatile("s_waitcnt vmcnt(0)" ::: "memory");
        } else {
            XB_SPIN(xb_ld(&bar[XB_XGEN(b.x)]) == gen, bar);
            __builtin_amdgcn_fence(__ATOMIC_ACQUIRE, "agent");
            asm volatile("s_waitcnt vmcnt(0)" ::: "memory");
        }
    }
    __syncthreads();
}

struct Frame {
    LAS unsigned char* lds;
    volatile LAS unsigned* MISC;
    gu32* ctl;
    int tid, lane, wave, gw, NGW;
    const float* in[23];
    float* out;
    unsigned char* ws;
};
enum { I_X = 0, I_C, I_ADAW, I_ADAB, I_LNG, I_LNB, I_CWIN, I_CONVW, I_CONVB, I_CWOUT, I_WKV, I_PE, I_CW1, I_CB1, I_CW2, I_CB2, I_WQG, I_BG, I_WO, I_RW, I_RB, I_WGU, I_WDN };

__device__ __forceinline__ void transpose_item(const float* W, int ld, int nvalid, int K, bf16* WT, int dstrow0, int k0, int n0, LAS float* scr, int lane) {
    const int n = n0 + (lane & 31);
#pragma unroll 8
    for (int i = 0; i < 32; ++i) { const int kk = 2 * i + (lane >> 5); scr[kk * 33 + (lane & 31)] = (n < nvalid) ? W[(size_t)(k0 + kk) * ld + n] : 0.f; }
    LDS_WAIT(); asm volatile("" ::: "memory");
    const int c = lane & 7;
#pragma unroll
    for (int j = 0; j < 4; ++j) { const int nl = (lane >> 3) + 8 * j; const LAS float* s = scr + (8 * c) * 33 + nl;
        u32x4 o; o.x = pk2(s[0 * 33], s[1 * 33]); o.y = pk2(s[2 * 33], s[3 * 33]); o.z = pk2(s[4 * 33], s[5 * 33]); o.w = pk2(s[6 * 33], s[7 * 33]);
        *(u32x4*)(WT + (size_t)(dstrow0 + nl) * K + k0 + 8 * c) = o; }
    LDS_WAIT(); asm volatile("" ::: "memory");
}
__device__ __forceinline__ int pairmap(int n0, int half) {
    return n0 < half ? ((n0 >> 7) * 256 + (n0 & 127)) : ((((n0 - half) >> 7) * 256) + 128 + ((n0 - half) & 127));
}
__device__ __forceinline__ void p0_prologue(Frame& F) {
    LAS float* scr = (LAS float*)(F.lds + F.wave * 16384);
    const int lane = F.lane;
    constexpr int I1 = 16 * 96, I2 = 512, I3 = 16 * 48, I4 = 16 * 40, I5 = 512, I6 = 512, I7 = 32 * 512, I8 = 32 * 256, I9 = 1536, I10 = 128;
    constexpr int NITEMS = I1 + I2 + I3 + I4 + I5 + I6 + I7 + I8 + I9 + I10;
    for (int it = F.gw; it < NITEMS; it += F.NGW) {
        int r = it;
        if (r < I1) { const int kb = r / 96, nb = r % 96, n0 = nb * 32;
            const int dr = n0 < 1024 ? n0 : 1024 + pairmap(n0 - 1024, 1024);
            transpose_item(F.in[I_CWIN], 3072, 3072, 1024, (bf16*)(F.ws + WS_WIN), dr, kb * 64, n0, scr, lane); continue; } r -= I1;
        if (r < I2) { transpose_item(F.in[I_CWOUT], 1024, 1024, 1024, (bf16*)(F.ws + WS_WOUT), (r % 32) * 32, (r / 32) * 64, (r % 32) * 32, scr, lane); continue; } r -= I2;
        if (r < I3) { transpose_item(F.in[I_WKV], 1536, 1536, 1024, (bf16*)(F.ws + WS_WKV), (r % 48) * 32, (r / 48) * 64, (r % 48) * 32, scr, lane); continue; } r -= I3;
        if (r < I4) { transpose_item(F.in[I_WQG], 1072, 1072, 1024, (bf16*)(F.ws + WS_WQG), (r % 40) * 32, (r / 40) * 64, (r % 40) * 32, scr, lane); continue; } r -= I4;
        if (r < I5) { transpose_item(F.in[I_WO], 1024, 1024, 1024, (bf16*)(F.ws + WS_WO), (r % 32) * 32, (r / 32) * 64, (r % 32) * 32, scr, lane); continue; } r -= I5;
        if (r < I6) { const int sub = r / 128, q = r % 128, i = sub >> 1, hh = sub & 1;
            transpose_item(F.in[I_CW1] + (size_t)i * 2048 * 256 + (size_t)hh * 1024 * 256, 256, 256, 1024, (bf16*)(F.ws + WS_W1C) + (size_t)i * 512 * 1024, hh * 256 + (q % 8) * 32, (q / 8) * 64, (q % 8) * 32, scr, lane); continue; } r -= I6;
        if (r < I7) { const int mi = r / 512, q = r % 512, n0 = (q % 32) * 32;
            transpose_item(F.in[I_WGU] + (size_t)mi * 1024 * 1024, 1024, 1024, 1024, (bf16*)(F.ws + WS_WGU) + (size_t)mi * 1024 * 1024, pairmap(n0, 512), (q / 32) * 64, n0, scr, lane); continue; } r -= I7;
        if (r < I8) { const int mi = r / 256, q = r % 256, n0 = (q % 32) * 32;
            transpose_item(F.in[I_WDN] + (size_t)mi * 512 * 1024, 1024, 1024, 512, (bf16*)(F.ws + WS_WDN) + (size_t)mi * 1024 * 512, n0, (q / 32) * 64, n0, scr, lane); continue; } r -= I8;
        if (r < I9) {
            const int l = r / 768, rem = r % 768, dch = rem / 96, e = (rem % 96) * 64 + lane;
            const float* aw = F.in[I_ADAW] + (size_t)l * 1024 * 6144 + e; const float* c = F.in[I_C];
            float a0 = 0.f, a1 = 0.f, a2 = 0.f, a3 = 0.f;
#pragma unroll 8
            for (int d = dch * 128; d < dch * 128 + 128; ++d) {
                const float w = aw[(size_t)d * 6144];
                const float c0 = c[d], c1 = c[1024 + d], c2 = c[2048 + d], c3 = c[3072 + d];
                a0 += (c0 / (1.f + __expf(-c0))) * w; a1 += (c1 / (1.f + __expf(-c1))) * w; a2 += (c2 / (1.f + __expf(-c2))) * w; a3 += (c3 / (1.f + __expf(-c3))) * w;
            }
            float* mp = (float*)(F.ws + WS_MODP) + (size_t)dch * 49152 + (size_t)(l * 4) * 6144 + e;
            mp[0] = a0; mp[6144] = a1; mp[2 * 6144] = a2; mp[3 * 6144] = a3; continue; } r -= I9;
        {
            const int i = r / 64, rem = r % 64, cch = rem / 16, kch = rem % 16, c = cch * 64 + lane;
            const float* pe = F.in[I_PE] + i * 2048; const float* w1 = F.in[I_CW1] + (size_t)i * 2048 * 256 + c;
            float a = 0.f;
#pragma unroll 8
            for (int kk = kch * 128; kk < kch * 128 + 128; ++kk) a += pe[kk] * w1[(size_t)kk * 256];
            ((float*)(F.ws + WS_PETP))[(kch * 2 + i) * 256 + c] = a;
        }
    }
}
__device__ __forceinline__ f32x4 mod4_partials(const Frame& F, int l, int b, int e) {
    f32x4 s = *(const f32x4*)(F.in[I_ADAB] + l * 6144 + e);
    const float* mp = (const float*)(F.ws + WS_MODP) + (size_t)(l * 4 + b) * 6144 + e;
#pragma unroll
    for (int d = 0; d < 8; ++d) s += *(const f32x4*)(mp + (size_t)d * 49152);
    return s;
}
__device__ __forceinline__ void p1_mod_u0(Frame& F) {
    float* MOD = (float*)(F.ws + WS_MOD);
    for (int ch = F.gw; ch < 768; ch += F.NGW) {
        const int idx = ch * 64 + F.lane, lb = idx / 6144, e = idx % 6144;
        float s = F.in[I_ADAB][(lb >> 2) * 6144 + e];
        const float* mp = (const float*)(F.ws + WS_MODP) + idx;
#pragma unroll
        for (int d = 0; d < 8; ++d) s += mp[(size_t)d * 49152];
        MOD[idx] = s;
    }
    bf16* U = (bf16*)(F.ws + WS_U);
    for (int m0 = F.gw * 8; m0 < T; m0 += F.NGW * 8) {
        const int b = m0 >> 12;
        f32x4 sh[4], sc[4];
#pragma unroll
        for (int j = 0; j < 4; ++j) { const int col = 4 * F.lane + 256 * j; sh[j] = mod4_partials(F, 0, b, col); sc[j] = mod4_partials(F, 0, b, 1024 + col) + 1.0f; }
        for (int m = m0; m < m0 + 8; ++m) {
#pragma unroll
            for (int j = 0; j < 4; ++j) { const int col = 4 * F.lane + 256 * j; const f32x4 v = *(const f32x4*)(F.in[I_X] + (size_t)m * DM + col);
                st_bf4(U + (size_t)m * DM + col, v * sc[j] + sh[j]); }
        }
    }
}

template <bool PAIR, class AR, class EP>
__device__ __forceinline__ void gemm_wave_tile(const AR& arow, const bf16* Btile, int K, int m0, int nbase, const EP& ep, int lane) {
    const int fr = lane & 15, fq = lane >> 4;
    f32x4 acc[4][4];
#pragma unroll
    for (int i = 0; i < 4; ++i)
#pragma unroll
        for (int j = 0; j < 4; ++j) acc[i][j] = (f32x4){0.f, 0.f, 0.f, 0.f};
    const bf16* ap[4]; const bf16* bp[4];
#pragma unroll
    for (int i = 0; i < 4; ++i) ap[i] = arow(m0 + 16 * i + fr) + 8 * fq;
#pragma unroll
    for (int j = 0; j < 4; ++j) { const int nr = PAIR ? ((j & 1) * 16 + (j >> 1) * 128) : 16 * j; bp[j] = Btile + (size_t)(nr + fr) * K + 8 * fq; }
    for (int k0 = 0; k0 < K; k0 += 32) {
        bf16x8 a[4], b[4];
#pragma unroll
        for (int i = 0; i < 4; ++i) a[i] = *(const bf16x8*)(ap[i] + k0);
#pragma unroll
        for (int j = 0; j < 4; ++j) b[j] = *(const bf16x8*)(bp[j] + k0);
#pragma unroll
        for (int i = 0; i < 4; ++i)
#pragma unroll
            for (int j = 0; j < 4; ++j) acc[i][j] = __builtin_amdgcn_mfma_f32_16x16x32_bf16(b[j], a[i], acc[i][j], 0, 0, 0);
    }
#pragma unroll
    for (int i = 0; i < 4; ++i) {
        const int m = m0 + 16 * i + fr;
        if constexpr (PAIR) {
#pragma unroll
            for (int j = 0; j < 2; ++j) ep.pair(m, nbase + 16 * j + 4 * fq, acc[i][j], acc[i][j + 2]);
        } else {
#pragma unroll
            for (int j = 0; j < 4; ++j) ep(m, nbase + 16 * j + 4 * fq, acc[i][j]);
        }
    }
}
struct ARowPlain { const bf16* A; int K; __device__ __forceinline__ const bf16* operator()(int m) const { return A + (size_t)m * K; } };

struct EpBf16 { bf16* O; int ld; __device__ __forceinline__ void operator()(int m, int n, f32x4 v) const { st_bf4(O + (size_t)m * ld + n, v); } };
struct EpMulPair { bf16* O; int ld; __device__ __forceinline__ void pair(int m, int ch, f32x4 a, f32x4 b) const { st_bf4(O + (size_t)m * ld + ch, a * b); } };
struct EpSiluPair { bf16* O; int ld; __device__ __forceinline__ void pair(int m, int ch, f32x4 a, f32x4 b) const {
    f32x4 s; for (int r = 0; r < 4; ++r) s[r] = a[r] / (1.f + __expf(-a[r])) * b[r]; st_bf4(O + (size_t)m * ld + ch, s); } };
struct EpRes { const float* base; float* out; const float* gmod;
    __device__ __forceinline__ void operator()(int m, int n, f32x4 v) const { const int b = m >> 12; const f32x4 g = *(const f32x4*)(gmod + b * 6144 + n);
        const f32x4 x = *(const f32x4*)(base + (size_t)m * DM + n); *(f32x4*)(out + (size_t)m * DM + n) = x * ALPHA + g * v; } };
struct EpKV { bf16* KV; __device__ __forceinline__ void operator()(int m, int n, f32x4 v) const {
    const int j = n >> 8, hk = (n >> 6) & 3, d = n & 63, b = m >> 12, t = m & 4095;
    st_bf4(KV + (size_t)j * KVBUF_ELEMS + ((size_t)(b * 4 + hk) * KVROWS + t) * 64 + d, v); } };
struct EpQG { bf16* Q; float* GATE; const float* bg; __device__ __forceinline__ void operator()(int m, int n, f32x4 v) const {
    if (n < 1024) st_bf4(Q + (size_t)m * DM + n, v * C2);
    else { for (int r = 0; r < 4; ++r) { const int i = n - 1024 + r; if (i < 48) GATE[(size_t)m * 48 + i] = 1.f / (1.f + __expf(-(v[r] + bg[i]))); } } } };
struct EpF32 { float* O; int ld; __device__ __forceinline__ void operator()(int m, int n, f32x4 v) const { *(f32x4*)(O + (size_t)m * ld + n) = v; } };

template <bool PAIR, class AR, class EP>
__device__ __forceinline__ void gemm_dense(Frame& F, const AR& arow, const bf16* Bt, int K, int nM64, int nN64, int chbase, const EP& ep) {
    const int total = nM64 * nN64;
    for (int it = F.gw; it < total; it += F.NGW) {
        const int ni = it % nN64, mt = it / nN64;
        if constexpr (PAIR) { const int pn = ni >> 2, q = ni & 3;
            gemm_wave_tile<true>(arow, Bt + (size_t)(pn * 256 + q * 32) * K, K, mt * 64, chbase + pn * 128 + q * 32, ep, F.lane);
        } else gemm_wave_tile<false>(arow, Bt + (size_t)(ni * 64) * K, K, mt * 64, chbase + ni * 64, ep, F.lane);
    }
}

__device__ __forceinline__ void p3_conv(Frame& F) {
    const bf16* BG = (const bf16*)(F.ws + WS_BG); const bf16* Z = (const bf16*)(F.ws + WS_Z); bf16* A2 = (bf16*)(F.ws + WS_A2);
    const float* cw = F.in[I_CONVW]; const float* cb = F.in[I_CONVB];
    const int gt = F.gw * 64 + F.lane, NT_ = F.NGW * 64;
    for (int it = gt; it < T * 128; it += NT_) {
        const int m = it >> 7, ch = (it & 127) * 8, t = m & 4095;
        const u32x4 bg = *(const u32x4*)(BG + (size_t)m * DM + ch);
        const u32x4 z0 = *(const u32x4*)(Z + (size_t)m * DM + ch);
        u32x4 z1 = (u32x4){0, 0, 0, 0}, z2 = (u32x4){0, 0, 0, 0};
        if (t >= 1) z1 = *(const u32x4*)(Z + (size_t)(m - 1) * DM + ch);
        if (t >= 2) z2 = *(const u32x4*)(Z + (size_t)(m - 2) * DM + ch);
        u32x4 o;
#pragma unroll
        for (int w = 0; w < 4; ++w) {
            const int c = ch + 2 * w;
            const float r0 = bflo(bg[w]) * (cw[c] * bflo(z2[w]) + cw[1024 + c] * bflo(z1[w]) + cw[2048 + c] * bflo(z0[w]) + cb[c]);
            const float r1 = bfhi(bg[w]) * (cw[c + 1] * bfhi(z2[w]) + cw[1024 + c + 1] * bfhi(z1[w]) + cw[2048 + c + 1] * bfhi(z0[w]) + cb[c + 1]);
            o[w] = pk2(r0, r1);
        }
        *(u32x4*)(A2 + (size_t)m * DM + ch) = o;
    }
}

__device__ __forceinline__ void ln_row(f32x4 (&v)[4], const float* g, const float* bb, int lane) {
    float s = 0.f;
#pragma unroll
    for (int j = 0; j < 4; ++j) s += (v[j][0] + v[j][1]) + (v[j][2] + v[j][3]);
    const float mean = wave_sum(s) * (1.f / DM); float s2 = 0.f;
#pragma unroll
    for (int j = 0; j < 4; ++j) { v[j] = v[j] - mean; s2 += (v[j][0] * v[j][0] + v[j][1] * v[j][1]) + (v[j][2] * v[j][2] + v[j][3] * v[j][3]); }
    const float rstd = 1.f / sqrtf(wave_sum(s2) * (1.f / DM) + LN_EPS);
#pragma unroll
    for (int j = 0; j < 4; ++j) { const int col = 4 * lane + 256 * j; v[j] = v[j] * rstd * *(const f32x4*)(g + col) + *(const f32x4*)(bb + col); }
}
template <int L>
__device__ __forceinline__ void p_ln_router(Frame& F) {
    float* RES = F.out; bf16* U = (bf16*)(F.ws + WS_U);
    const float* MOD = (const float*)(F.ws + WS_MOD) + (size_t)L * 4 * 6144;
    const float* rw = F.in[I_RW]; const float* rb = F.in[I_RB];
    gu32* cnt = F.ctl + CW_CNT + L * 64;
    unsigned* LIST = (unsigned*)(F.ws + WS_LIST) + (size_t)L * NE * T; float* LW = (float*)(F.ws + WS_LW) + (size_t)L * NE * T;
    const int lane = F.lane;
    for (int m = F.gw; m < T; m += F.NGW) {
        const int b = m >> 12;
        f32x4 v[4];
#pragma unroll
        for (int j = 0; j < 4; ++j) v[j] = *(const f32x4*)(RES + (size_t)m * DM + 4 * lane + 256 * j);
        ln_row(v, F.in[I_LNG] + (L * 2 + 0) * DM, F.in[I_LNB] + (L * 2 + 0) * DM, lane);
        float lg[16];
#pragma unroll
        for (int e = 0; e < 16; ++e) lg[e] = 0.f;
#pragma unroll
        for (int j = 0; j < 4; ++j) { const int col = 4 * lane + 256 * j;
            *(f32x4*)(RES + (size_t)m * DM + col) = v[j];
            const f32x4 u = v[j] * (*(const f32x4*)(MOD + b * 6144 + 4 * 1024 + col) + 1.0f) + *(const f32x4*)(MOD + b * 6144 + 3 * 1024 + col);
            st_bf4(U + (size_t)m * DM + col, u);
#pragma unroll
            for (int c = 0; c < 4; ++c) {
#pragma unroll
                for (int q = 0; q < 4; ++q) { const f32x4 w = *(const f32x4*)(rw + (size_t)(col + c) * 16 + 4 * q);
                    lg[4 * q + 0] += u[c] * w[0]; lg[4 * q + 1] += u[c] * w[1]; lg[4 * q + 2] += u[c] * w[2]; lg[4 * q + 3] += u[c] * w[3]; }
            }
        }
#pragma unroll
        for (int e = 0; e < 16; ++e) lg[e] = wave_sum(lg[e]);
        float mx = lg[0];
#pragma unroll
        for (int e = 1; e < 16; ++e) mx = fmaxf(mx, lg[e]);
        float aff[16], bi[16]; float sum = 0.f;
#pragma unroll
        for (int e = 0; e < 16; ++e) { aff[e] = __expf(lg[e] - mx); sum += aff[e]; }
        const float inv = 1.f / sum;
#pragma unroll
        for (int e = 0; e < 16; ++e) { aff[e] *= inv; bi[e] = aff[e] + rb[e]; }
        float gs[4];
#pragma unroll
        for (int g = 0; g < 4; ++g) { const float a0 = bi[4 * g], a1 = bi[4 * g + 1], a2 = bi[4 * g + 2], a3 = bi[4 * g + 3];
            const float t1 = fmaxf(a0, a1), t2 = fminf(a0, a1), u1 = fmaxf(a2, a3), u2 = fminf(a2, a3);
            gs[g] = fmaxf(t1, u1) + fmaxf(fminf(t1, u1), fmaxf(t2, u2)); }
        int best = 0; float bv = gs[0];
#pragma unroll
        for (int g = 1; g < 4; ++g) if (gs[g] > bv) { bv = gs[g]; best = g; }
        float cb_[4], ca_[4];
#pragma unroll
        for (int i = 0; i < 4; ++i) { cb_[i] = best == 0 ? bi[i] : best == 1 ? bi[4 + i] : best == 2 ? bi[8 + i] : bi[12 + i];
                                      ca_[i] = best == 0 ? aff[i] : best == 1 ? aff[4 + i] : best == 2 ? aff[8 + i] : aff[12 + i]; }
        int i0 = 0; float b0 = cb_[0];
#pragma unroll
        for (int i = 1; i < 4; ++i) if (cb_[i] > b0) { b0 = cb_[i]; i0 = i; }
        int i1 = -1; float b1 = -3.0e38f;
#pragma unroll
        for (int i = 0; i < 4; ++i) if (i != i0 && cb_[i] > b1) { b1 = cb_[i]; i1 = i; }
        const float w0 = i0 == 0 ? ca_[0] : i0 == 1 ? ca_[1] : i0 == 2 ? ca_[2] : ca_[3];
        const float w1 = i1 == 0 ? ca_[0] : i1 == 1 ? ca_[1] : i1 == 2 ? ca_[2] : ca_[3];
        const float ws_ = 1.f / (w0 + w1);
        if (lane == 0) {
            const int e0 = best * 4 + i0, e1 = best * 4 + i1;
            const unsigned p0 = __hip_atomic_fetch_add(cnt + e0, 1u, RLX_AGENT);
            const unsigned p1 = __hip_atomic_fetch_add(cnt + e1, 1u, RLX_AGENT);
            LIST[(size_t)e0 * T + p0] = (unsigned)m * 2u; LW[(size_t)e0 * T + p0] = w0 * ws_;
            LIST[(size_t)e1 * T + p1] = (unsigned)m * 2u + 1u; LW[(size_t)e1 * T + p1] = w1 * ws_;
        }
    }
}
template <int L>
__device__ __forceinline__ void p_ln2(Frame& F) {
    float* RES = F.out; bf16* U = (bf16*)(F.ws + WS_U); bf16* XB = (bf16*)(F.ws + WS_XB);
    const bf16* Y0 = (const bf16*)(F.ws + WS_Y0); const bf16* Y1 = (const bf16*)(F.ws + WS_Y1);
    const float* MOD = (const float*)(F.ws + WS_MOD) + (size_t)L * 4 * 6144;
    const float* MODN = (const float*)(F.ws + WS_MOD) + (size_t)1 * 4 * 6144;
    const int lane = F.lane;
    for (int m = F.gw; m < T; m += F.NGW) {
        const int b = m >> 12;
        f32x4 v[4];
#pragma unroll
        for (int j = 0; j < 4; ++j) { const int col = 4 * lane + 256 * j;
            const f32x4 x = *(const f32x4*)(RES + (size_t)m * DM + col);
            const u32x2 a = *(const u32x2*)(Y0 + (size_t)m * DM + col), c = *(const u32x2*)(Y1 + (size_t)m * DM + col);
            const f32x4 y = (f32x4){bflo(a.x) + bflo(c.x), bfhi(a.x) + bfhi(c.x), bflo(a.y) + bflo(c.y), bfhi(a.y) + bfhi(c.y)};
            v[j] = x * ALPHA + *(const f32x4*)(MOD + b * 6144 + 5 * 1024 + col) * y; }
        ln_row(v, F.in[I_LNG] + (L * 2 + 1) * DM, F.in[I_LNB] + (L * 2 + 1) * DM, lane);
#pragma unroll
        for (int j = 0; j < 4; ++j) { const int col = 4 * lane + 256 * j;
            *(f32x4*)(RES + (size_t)m * DM + col) = v[j];
            if (L == 0) { st_bf4(XB + (size_t)m * DM + col, v[j]);
                st_bf4(U + (size_t)m * DM + col, v[j] * (*(const f32x4*)(MODN + b * 6144 + 1024 + col) + 1.0f) + *(const f32x4*)(MODN + b * 6144 + col)); } }
    }
}

__device__ __forceinline__ void moe_tables(Frame& F, int L) {
    LAS int* tb = (LAS int*)(F.lds + MISC_OFF + 128); LAS int* cn = tb + 20;
    __syncthreads();
    if (F.tid == 0) { int acc = 0; for (int e = 0; e < NE; ++e) { const int c = (int)__hip_atomic_load(F.ctl + CW_CNT + L * 64 + e, RLX_AGENT); cn[e] = c; tb[e] = acc; acc += (c + 255) >> 8; } tb[NE] = acc; }
    __syncthreads();
}
struct ARowMoe { const bf16* U; const unsigned* list; int rbase, cnt;
    __device__ __forceinline__ const bf16* operator()(int r) const { const int pos = r - rbase; const unsigned tok = pos < cnt ? (list[pos] >> 1) : 0u; return U + (size_t)tok * DM; } };
struct EpY { bf16* Y; const unsigned* list; const float* lw; int rbase, cnt;
    __device__ __forceinline__ void operator()(int r, int n, f32x4 v) const { const int pos = r - rbase; if (pos < cnt) { const unsigned ts = list[pos]; const float w = lw[pos];
        st_bf4(Y + (size_t)(ts & 1u) * ((size_t)T * DM) + (size_t)(ts >> 1) * DM + n, v * w); } } };
template <int L>
__device__ __forceinline__ void p_moe_gu(Frame& F) {
    moe_tables(F, L);
    LAS int* tb = (LAS int*)(F.lds + MISC_OFF + 128); LAS int* cn = tb + 20;
    const unsigned* LIST = (const unsigned*)(F.ws + WS_LIST) + (size_t)L * NE * T;
    const int total = tb[NE] * 4 * 16;
    for (int it = F.gw; it < total; it += F.NGW) {
        const int ni = it & 15, mt = it >> 4; int e = 0; while (tb[e + 1] * 4 <= mt) ++e;
        const ARowMoe ar{(const bf16*)(F.ws + WS_U), LIST + (size_t)e * T, tb[e] * 256, cn[e]};
        const EpSiluPair ep{(bf16*)(F.ws + WS_H), FF};
        const int pn = ni >> 2, q = ni & 3;
        gemm_wave_tile<true>(ar, (const bf16*)(F.ws + WS_WGU) + (size_t)(L * NE + e) * 1024 * 1024 + (size_t)(pn * 256 + q * 32) * 1024, 1024, mt * 64, pn * 128 + q * 32, ep, F.lane);
    }
}
template <int L>
__device__ __forceinline__ void p_moe_down(Frame& F) {
    moe_tables(F, L);
    LAS int* tb = (LAS int*)(F.lds + MISC_OFF + 128); LAS int* cn = tb + 20;
    const unsigned* LIST = (const unsigned*)(F.ws + WS_LIST) + (size_t)L * NE * T; const float* LW = (const float*)(F.ws + WS_LW) + (size_t)L * NE * T;
    const int total = tb[NE] * 4 * 16;
    for (int it = F.gw; it < total; it += F.NGW) {
        const int ni = it & 15, mt = it >> 4; int e = 0; while (tb[e + 1] * 4 <= mt) ++e;
        const ARowPlain ar{(const bf16*)(F.ws + WS_H), FF};
        const EpY ep{(bf16*)(F.ws + WS_Y0), LIST + (size_t)e * T, LW + (size_t)e * T, tb[e] * 256, cn[e]};
        gemm_wave_tile<false>(ar, (const bf16*)(F.ws + WS_WDN) + (size_t)(L * NE + e) * 1024 * 512 + (size_t)(ni * 64) * 512, 512, mt * 64, ni * 64, ep, F.lane);
    }
}

struct ARowCmp { const bf16* KVi; __device__ __forceinline__ const bf16* operator()(int R) const { return KVi + ((size_t)(R >> 8) * KVROWS + (size_t)(R & 255) * 16) * 64; } };
__device__ __forceinline__ float gelu_tanh(float x) { const float u = 0.7978845608028654f * (x + 0.044715f * x * x * x); const float e = __expf(2.f * u); const float th = 1.f - 2.f / (e + 1.f); return 0.5f * x * (1.f + th); }
__device__ __forceinline__ void p_cmp_finish(Frame& F) {
    LAS float* hd = (LAS float*)(F.lds + F.wave * 16384);
    const float* TB = (const float*)(F.ws + WS_TB); const float* PETP = (const float*)(F.ws + WS_PETP);
    const int lane = F.lane;
    for (int it = F.gw; it < 2 * 16 * 256; it += F.NGW) {
        const int i = it >> 12, bh = (it >> 8) & 15, n = it & 255;
        bf16* dst = (bf16*)(F.ws + (i ? WS_VC : WS_KC)) + ((size_t)bh * 256 + n) * 64 + lane;
        if (n == 255) { *dst = 0; continue; }
        const float* r0 = TB + ((size_t)i * 4096 + bh * 256 + n) * 512; const float* r1 = r0 + 512 + 256;
        const int c = 4 * lane;
        f32x4 h = *(const f32x4*)(r0 + c) + *(const f32x4*)(r1 + c) + *(const f32x4*)(F.in[I_CB1] + i * 256 + c);
#pragma unroll
        for (int k = 0; k < 16; ++k) h += *(const f32x4*)(PETP + (k * 2 + i) * 256 + c);
        LDS_WAIT(); asm volatile("" ::: "memory");
        *(LAS f32x4*)(hd + c) = (f32x4){gelu_tanh(h[0]), gelu_tanh(h[1]), gelu_tanh(h[2]), gelu_tanh(h[3])};
        LDS_WAIT(); asm volatile("" ::: "memory");
        const float* w2 = F.in[I_CW2] + (size_t)i * 256 * 64 + lane;
        float a = F.in[I_CB2][i * 64 + lane];
#pragma unroll 8
        for (int cc = 0; cc < 256; ++cc) a += hd[cc] * w2[cc * 64];
        *dst = (bf16)f2bf(a);
        LDS_WAIT(); asm volatile("" ::: "memory");
    }
}

__device__ __forceinline__ void score_tile(const bf16* krow, const LAS float* qs, float (&s)[4]) {
    s[0] = s[1] = s[2] = s[3] = 0.f;
#pragma unroll
    for (int c = 0; c < 8; ++c) { const u32x4 kv = *(const u32x4*)(krow + 8 * c);
#pragma unroll
        for (int w = 0; w < 4; ++w) { const f32x4 qa = *(const LAS f32x4*)(qs + (8 * c + 2 * w) * 4), qb = *(const LAS f32x4*)(qs + (8 * c + 2 * w + 1) * 4);
            const float ka = bflo(kv[w]), kb = bfhi(kv[w]);
            s[0] += ka * qa[0] + kb * qb[0]; s[1] += ka * qa[1] + kb * qb[1]; s[2] += ka * qa[2] + kb * qb[2]; s[3] += ka * qa[3] + kb * qb[3]; } }
}
__device__ __forceinline__ void attend_tile(const bf16* Kt, const bf16* Vt, bool valid, const LAS float* qs, LAS float* pbuf, float (&mr)[4], float (&l)[4], float (&o)[4], int lane) {
    float s[4]; score_tile(Kt + (size_t)lane * 64, qs, s);
    f32x4 p4;
#pragma unroll
    for (int g = 0; g < 4; ++g) {
        const float sg = valid ? s[g] : -INFINITY; const float tm = wave_max(sg); const float mn = fmaxf(mr[g], tm);
        const float mref = (mn == -INFINITY) ? 0.f : mn;
        const float alpha = __builtin_amdgcn_exp2f(mr[g] - mref); const float p = valid ? __builtin_amdgcn_exp2f(sg - mref) : 0.f;
        l[g] = l[g] * alpha + wave_sum(p); o[g] *= alpha; mr[g] = mn; p4[g] = p;
    }
    LDS_WAIT(); asm volatile("" ::: "memory");
    *(LAS f32x4*)(pbuf + lane * 4) = p4;
    LDS_WAIT(); asm volatile("" ::: "memory");
#pragma unroll 8
    for (int k = 0; k < 64; ++k) { const f32x4 pk = *(const LAS f32x4*)(pbuf + k * 4); const float vv = bf2f(Vt[(size_t)k * 64 + lane]);
        o[0] += pk[0] * vv; o[1] += pk[1] * vv; o[2] += pk[2] * vv; o[3] += pk[3] * vv; }
    LDS_WAIT(); asm volatile("" ::: "memory");
}
__device__ __forceinline__ void p_attn_simple(Frame& F) {
    LAS float* qs = (LAS float*)(F.lds + F.wave * 16384);
    LAS float* pbuf = qs + 256;
    LAS float* psum = pbuf + 1024;
    const bf16* Q = (const bf16*)(F.ws + WS_Q); const float* GATE = (const float*)(F.ws + WS_GATE); bf16* O = (bf16*)(F.ws + WS_O);
    const bf16* KVb = (const bf16*)(F.ws + WS_KV);
    const int lane = F.lane;
    for (int it = F.gw; it < 16 * SEQ; it += F.NGW) {
        const int bh = it & 15, t = it >> 4, b = bh >> 2, hk = bh & 3, m = b * SEQ + t;
        LDS_WAIT(); asm volatile("" ::: "memory");
        { f32x4 q4; for (int g = 0; g < 4; ++g) q4[g] = bf2f(Q[(size_t)m * DM + (hk * 4 + g) * 64 + lane]); *(LAS f32x4*)(qs + lane * 4) = q4; }
        LDS_WAIT(); asm volatile("" ::: "memory");
        const bf16* KC = (const bf16*)(F.ws + WS_KC) + (size_t)bh * 256 * 64; const bf16* VC = (const bf16*)(F.ws + WS_VC) + (size_t)bh * 256 * 64;
        const int nv = t >= 31 ? ((t - 31) >> 4) + 1 : 0;
        float sc[4][4];
#pragma unroll
        for (int i = 0; i < 4; ++i) { float s[4] = {0.f, 0.f, 0.f, 0.f}; if (64 * i < nv) score_tile(KC + (size_t)(64 * i + lane) * 64, qs, s);
            const bool v = (64 * i + lane) < nv;
#pragma unroll
            for (int g = 0; g < 4; ++g) sc[i][g] = v ? s[g] : -INFINITY; }
        float oc[4];
#pragma unroll
        for (int g = 0; g < 4; ++g) {
            const float mx = wave_max(fmaxf(fmaxf(sc[0][g], sc[1][g]), fmaxf(sc[2][g], sc[3][g]))); const float mref = (mx == -INFINITY) ? 0.f : mx;
            float e[4]; float ls = 0.f;
#pragma unroll
            for (int i = 0; i < 4; ++i) { e[i] = __builtin_amdgcn_exp2f(sc[i][g] - mref); ls += e[i]; }
            const float inv = 1.f / fmaxf(wave_sum(ls), 1e-30f);
#pragma unroll
            for (int i = 0; i < 4; ++i) sc[i][g] = e[i] * inv;
        }
#pragma unroll
        for (int i = 0; i < 4; ++i) { *(LAS f32x4*)(pbuf + (64 * i + lane) * 4) = (f32x4){sc[i][0], sc[i][1], sc[i][2], sc[i][3]};
            psum[64 * i + lane + 1] = (sc[i][0] + sc[i][1]) + (sc[i][2] + sc[i][3]); }
        if (lane == 0) psum[0] = 0.f;
        LDS_WAIT(); asm volatile("" ::: "memory");
        oc[0] = oc[1] = oc[2] = oc[3] = 0.f;
        for (int n = 0; n < nv; ++n) { const f32x4 pk = *(const LAS f32x4*)(pbuf + n * 4); const float vv = bf2f(VC[(size_t)n * 64 + lane]);
            oc[0] += pk[0] * vv; oc[1] += pk[1] * vv; oc[2] += pk[2] * vv; oc[3] += pk[3] * vv; }
        const float imp = 0.5f * psum[4 * lane] + psum[4 * lane + 1] + psum[4 * lane + 2] + psum[4 * lane + 3] + 0.5f * psum[4 * lane + 4];
        const int cur = t >> 6;
        const bool allowed = lane <= cur, forced = allowed && (lane == 0 || lane == cur || lane == cur - 1);
        const float score = forced ? 1e9f : (allowed ? imp : -1e30f);
        int rank = 0;
#pragma unroll
        for (int j = 0; j < 64; ++j) { const float sj = __shfl(score, j); rank += (sj > score || (sj == score && j < lane)) ? 1 : 0; }
        const unsigned long long mask = __ballot(rank < 16 && score > -0.5e30f);
        LDS_WAIT(); asm volatile("" ::: "memory");
        const bf16* KS = KVb + 2 * KVBUF_ELEMS + (size_t)bh * KVROWS * 64; const bf16* VS = KVb + 3 * KVBUF_ELEMS + (size_t)bh * KVROWS * 64;
        float ms[4] = {-INFINITY, -INFINITY, -INFINITY, -INFINITY}, ls[4] = {0.f, 0.f, 0.f, 0.f}, os[4] = {0.f, 0.f, 0.f, 0.f};
        for (unsigned long long mk = mask; mk; mk &= mk - 1) { const int j = __builtin_ctzll(mk);
            attend_tile(KS + (size_t)j * 64 * 64, VS + (size_t)j * 64 * 64, (64 * j + lane) <= t, qs, pbuf, ms, ls, os, lane); }
        const bf16* KW = KVb + 4 * KVBUF_ELEMS + (size_t)bh * KVROWS * 64; const bf16* VW = KVb + 5 * KVBUF_ELEMS + (size_t)bh * KVROWS * 64;
        float mw[4] = {-INFINITY, -INFINITY, -INFINITY, -INFINITY}, lw[4] = {0.f, 0.f, 0.f, 0.f}, ow[4] = {0.f, 0.f, 0.f, 0.f};
        const int lo = t - 511 > 0 ? t - 511 : 0;
        for (int j = lo >> 6; j <= (t >> 6); ++j) { const int pos = 64 * j + lane;
            attend_tile(KW + (size_t)j * 64 * 64, VW + (size_t)j * 64 * 64, pos >= lo && pos <= t, qs, pbuf, mw, lw, ow, lane); }
#pragma unroll
        for (int g = 0; g < 4; ++g) { const float* gp = GATE + (size_t)m * 48 + (hk * 4 + g) * 3;
            const float o = gp[0] * oc[g] + gp[1] * os[g] / fmaxf(ls[g], 1e-30f) + gp[2] * ow[g] / fmaxf(lw[g], 1e-30f);
            O[(size_t)m * DM + (hk * 4 + g) * 64 + lane] = (bf16)f2bf(o); }
    }
}

struct Args { const float* in[23]; float* out; unsigned char* ws; int ph_lo, ph_hi; };
__global__ void __launch_bounds__(512, 2) mk_fwd(Args args) {
    extern __shared__ __attribute__((aligned(16))) unsigned char lds[];
    Frame F;
    F.lds = (LAS unsigned char*)lds; F.MISC = (volatile LAS unsigned*)(F.lds + MISC_OFF);
    F.tid = threadIdx.x; F.lane = F.tid & 63; F.wave = __builtin_amdgcn_readfirstlane(F.tid >> 6);
    F.gw = blockIdx.x * 8 + F.wave; F.NGW = gridDim.x * 8;
#pragma unroll
    for (int i = 0; i < 23; ++i) F.in[i] = args.in[i];
    F.out = args.out; F.ws = args.ws; F.ctl = (gu32*)(args.ws + WS_CTL);
    for (int u = F.tid; u < (LDS_BYTES - LDSCTL_OFF) / 4; u += 512) ((LAS unsigned*)(F.lds + LDSCTL_OFF))[u] = 0u;
    __syncthreads();
    XcdBarrier bar; bar.bar = (unsigned*)(F.ctl + CW_BAR); bar.x = 0; bar.st = nullptr;
    const int lo = args.ph_lo, hi = args.ph_hi;
    if (hi - lo > 1) bar = xcd_barrier_post((unsigned*)(F.ctl + CW_BAR), F.MISC + 8);
#define IN(k) (lo <= (k) && (k) < hi)
#define SEAM(k) do { if (IN(k) && IN((k) + 1)) xcd_barrier(bar); } while (0)
    if (IN(0)) { p0_prologue(F); } SEAM(0);
    if (IN(1)) { p1_mod_u0(F); } SEAM(1);
    if (IN(2)) {
        const ARowPlain ar{(const bf16*)(F.ws + WS_U), DM};
        gemm_dense<false>(F, ar, (const bf16*)(F.ws + WS_WIN), DM, T / 64, 16, 0, EpBf16{(bf16*)(F.ws + WS_BG), DM});
        gemm_dense<true>(F, ar, (const bf16*)(F.ws + WS_WIN) + (size_t)1024 * DM, DM, T / 64, 32, 0, EpMulPair{(bf16*)(F.ws + WS_Z), DM});
    } SEAM(2);
    if (IN(3)) { p3_conv(F); } SEAM(3);
    if (IN(4)) {
        gemm_dense<false>(F, ARowPlain{(const bf16*)(F.ws + WS_A2), DM}, (const bf16*)(F.ws + WS_WOUT), DM, T / 64, 16, 0,
                          EpRes{F.in[I_X], F.out, (const float*)(F.ws + WS_MOD) + 2 * 1024});
    } SEAM(4);
    if (IN(5)) { p_ln_router<0>(F); } SEAM(5);
    if (IN(6)) { p_moe_gu<0>(F); } SEAM(6);
    if (IN(7)) { p_moe_down<0>(F); } SEAM(7);
    if (IN(8)) { p_ln2<0>(F); } SEAM(8);
    if (IN(9)) {
        gemm_dense<false>(F, ARowPlain{(const bf16*)(F.ws + WS_XB), DM}, (const bf16*)(F.ws + WS_WKV), DM, T / 64, 24, 0, EpKV{(bf16*)(F.ws + WS_KV)});
        gemm_dense<false>(F, ARowPlain{(const bf16*)(F.ws + WS_U), DM}, (const bf16*)(F.ws + WS_WQG), DM, T / 64, 17, 0,
                          EpQG{(bf16*)(F.ws + WS_Q), (float*)(F.ws + WS_GATE), F.in[I_BG]});
    } SEAM(9);
    if (IN(10)) {
        for (int i = 0; i < 2; ++i)
            gemm_dense<false>(F, ARowCmp{(const bf16*)(F.ws + WS_KV) + (size_t)i * KVBUF_ELEMS}, (const bf16*)(F.ws + WS_W1C) + (size_t)i * 512 * 1024, 1024, 4096 / 64, 8, 0,
                              EpF32{(float*)(F.ws + WS_TB) + (size_t)i * 4096 * 512, 512});
    } SEAM(10);
    if (IN(11)) { p_cmp_finish(F); } SEAM(11);
    if (IN(12)) { p_attn_simple(F); } SEAM(12);
    if (IN(13)) {
        gemm_dense<false>(F, ARowPlain{(const bf16*)(F.ws + WS_O), DM}, (const bf16*)(F.ws + WS_WO), DM, T / 64, 16, 0,
                          EpRes{F.out, F.out, (const float*)(F.ws + WS_MOD) + (size_t)4 * 6144 + 2 * 1024});
    } SEAM(13);
    if (IN(14)) { p_ln_router<1>(F); } SEAM(14);
    if (IN(15)) { p_moe_gu<1>(F); } SEAM(15);
    if (IN(16)) { p_moe_down<1>(F); } SEAM(16);
    if (IN(17)) { p_ln2<1>(F); }
#undef IN
#undef SEAM
}

extern "C" void kernel_launch(void* const* d_in, const int* in_sizes, int n_in, void* d_out, int out_size, void* d_ws, size_t ws_size, hipStream_t stream) {
    static int grid = 0;
    if (grid == 0) {
        if (n_in != 23 || out_size != T * DM || ws_size < WS_END) { fprintf(stderr, "kernel_launch: unexpected shapes (n_in %d out %d ws %zu, need ws >= %zu)\n", n_in, out_size, ws_size, (size_t)WS_END); grid = -1; return; }
        int dev = 0, cus = 0, per_cu = 0;
        if (hipGetDevice(&dev) != hipSuccess || hipDeviceGetAttribute(&cus, hipDeviceAttributeMultiprocessorCount, dev) != hipSuccess) { grid = -1; return; }
        if (hipFuncSetAttribute((const void*)mk_fwd, hipFuncAttributeMaxDynamicSharedMemorySize, LDS_BYTES) != hipSuccess) { fprintf(stderr, "kernel_launch: hipFuncSetAttribute failed\n"); grid = -1; return; }
        if (hipOccupancyMaxActiveBlocksPerMultiprocessor(&per_cu, (const void*)mk_fwd, 512, LDS_BYTES) != hipSuccess || per_cu < 1) { fprintf(stderr, "kernel_launch: occupancy query says %d\n", per_cu); per_cu = 1; }
        (void)hipGetLastError();
        grid = cus;
    }
    if (grid < 0) return;
    (void)hipMemsetAsync((char*)d_ws + WS_CTL, 0, CTL_ZERO_BYTES, stream);
    Args a{};
    for (int i = 0; i < 23; ++i) a.in[i] = (const float*)d_in[i];
    a.out = (float*)d_out; a.ws = (unsigned char*)d_ws;
    if (MK_N_LAUNCHES == 1) { a.ph_lo = 0; a.ph_hi = NPH; hipLaunchKernelGGL(mk_fwd, dim3(grid), dim3(512), LDS_BYTES, stream, a); }
    else for (int p = 0; p < NPH; ++p) { a.ph_lo = p; a.ph_hi = p + 1; hipLaunchKernelGGL(mk_fwd, dim3(grid), dim3(512), LDS_BYTES, stream, a); }
}
```

```cpp
#include <hip/hip_runtime.h>
#include <cstdio>
#include <cstdint>

#ifndef REP0
#define REP0 1
#endif
#ifndef REP1
#define REP1 1
#endif
#ifndef REP11
#define REP11 1
#endif
#ifndef XBAR
#define XBAR 1
#endif
#ifndef DRY5
#define DRY5 0
#endif
#ifndef DRY8
#define DRY8 0
#endif
#ifndef REP4
#define REP4 1
#endif
#ifndef REP2
#define REP2 1
#endif
#ifndef REP3
#define REP3 1
#endif
#ifndef REP6
#define REP6 1
#endif
#ifndef REP7
#define REP7 1
#endif
#ifndef REP9
#define REP9 1
#endif
#ifndef REP10
#define REP10 1
#endif
#ifndef REP12
#define REP12 1
#endif
#ifndef REP1213
#define REP1213 1
#endif
#ifndef ATV
#define ATV 0
#endif
#ifndef DRY2
#define DRY2 0
#endif
#ifndef DRY12
#define DRY12 0
#endif
#ifndef ATTN_FUSED
#define ATTN_FUSED 1
#endif
#ifndef MK_N_LAUNCHES
#define MK_N_LAUNCHES 1
#endif

#define GAS __attribute__((address_space(1)))
#define LAS __attribute__((address_space(3)))
typedef unsigned short bf16;
typedef short bf16x8 __attribute__((ext_vector_type(8)));
typedef float f32x4 __attribute__((ext_vector_type(4)));
typedef unsigned u32x4 __attribute__((ext_vector_type(4)));
typedef unsigned u32x2 __attribute__((ext_vector_type(2)));
typedef GAS unsigned gu32;
#define RLX_AGENT __ATOMIC_RELAXED, __HIP_MEMORY_SCOPE_AGENT

constexpr int NB = 4, SEQ = 4096, DM = 1024, T = NB * SEQ, NH = 16, HKV = 4, HD = 64, NE = 16, FF = 512;
constexpr int NPH = 19;
constexpr float ALPHA = 1.4142135623730951f;
constexpr float LN_EPS = 1e-5f;
constexpr float C2 = 0.125f * 1.4426950408889634f;
constexpr int KVROWS = SEQ + 128;
constexpr int HROWS = 2 * T + NE * 256;

constexpr size_t MiB = 1u << 20;
constexpr size_t WS_CTL = 0, CTL_ZERO_BYTES = 1 * MiB;
constexpr size_t WS_MODP = 290 * MiB;
constexpr size_t WS_MOD = 3 * MiB;
constexpr size_t WS_PETP = 3 * MiB + 512 * 1024;
constexpr size_t WS_LIST = 4 * MiB;
constexpr size_t WS_LW = 6 * MiB;
constexpr size_t WS_WIN = 8 * MiB, WS_WOUT = 14 * MiB, WS_WKV = 16 * MiB, WS_WQG = 19 * MiB, WS_WO = 22 * MiB, WS_W1C = 24 * MiB;
constexpr size_t WS_WGU = 26 * MiB, WS_WDN = 90 * MiB;
constexpr size_t WS_U = 122 * MiB, WS_XB = 154 * MiB, WS_H = 186 * MiB, WS_Y0 = 226 * MiB, WS_Y1 = 258 * MiB;
constexpr size_t WS_R1 = 290 * MiB;
constexpr size_t WS_BG = WS_R1, WS_Z = WS_R1 + 32 * MiB, WS_A2 = WS_R1 + 64 * MiB;
constexpr size_t WS_Q = WS_R1, WS_O = WS_R1 + 32 * MiB, WS_KV = WS_R1 + 64 * MiB;
constexpr size_t KVBUF_ELEMS = (size_t)16 * KVROWS * 64;
constexpr size_t WS_TB = WS_R1 + 114 * MiB, WS_KC = WS_R1 + 130 * MiB, WS_VC = WS_KC + 512 * 1024, WS_GATE = WS_R1 + 131 * MiB;
constexpr size_t WS_END = WS_R1 + 135 * MiB;
static_assert(WS_Y1 == WS_Y0 + (size_t)T * DM * 2, "Y1 follows Y0");
static_assert(WS_KV + 6 * KVBUF_ELEMS * 2 <= WS_TB, "kv buffers");
static_assert((size_t)HROWS * FF * 2 <= 40 * MiB, "H buffer");
constexpr int CW_CNT = 1024;
constexpr int CW_BAR = 4096;

constexpr int RING_BYTES = 131072;
constexpr int LDSCTL_OFF = 143360, MISC_OFF = LDSCTL_OFF + 320;
constexpr int LDS_BYTES = 147456;

#define LDS_WAIT() asm volatile("s_waitcnt lgkmcnt(0)" ::: "memory")
__device__ __forceinline__ unsigned f2bf(float f) { unsigned u = __builtin_bit_cast(unsigned, f); return (u + 0x7fffu + ((u >> 16) & 1u)) >> 16; }
typedef float f32x2v __attribute__((ext_vector_type(2)));
typedef __bf16 bf16x2_t __attribute__((ext_vector_type(2)));
__device__ __forceinline__ unsigned pk2(float lo, float hi) { f32x2v v = {lo, hi}; bf16x2_t b = __builtin_convertvector(v, bf16x2_t); return __builtin_bit_cast(unsigned, b); }
__device__ __forceinline__ float bf2f(unsigned short h) { return __builtin_bit_cast(float, (unsigned)h << 16); }
__device__ __forceinline__ float bflo(unsigned w) { return __builtin_bit_cast(float, w << 16); }
__device__ __forceinline__ float bfhi(unsigned w) { return __builtin_bit_cast(float, w & 0xffff0000u); }
__device__ __forceinline__ float wave_sum(float v) {
#pragma unroll
    for (int o = 1; o < 64; o <<= 1) v += __shfl_xor(v, o);
    return v;
}
__device__ __forceinline__ float wave_max(float v) {
#pragma unroll
    for (int o = 1; o < 64; o <<= 1) v = fmaxf(v, __shfl_xor(v, o));
    return v;
}
__device__ __forceinline__ float silu_f(float a) { return a * __builtin_amdgcn_rcpf(1.f + __builtin_amdgcn_exp2f(-1.4426950408889634f * a)); }
__device__ __forceinline__ void st_bf4(bf16* p, f32x4 v) { u32x2 w; w.x = pk2(v[0], v[1]); w.y = pk2(v[2], v[3]); *(u32x2*)p = w; }
__device__ __forceinline__ void st_bf8(bf16* p, f32x4 a, f32x4 b) { u32x4 w; w.x = pk2(a[0], a[1]); w.y = pk2(a[2], a[3]); w.z = pk2(b[0], b[1]); w.w = pk2(b[2], b[3]); *(u32x4*)p = w; }

#define XB_TMO      128
#define XB_XCNT(j)  (256  + 64 * (j))
#define XB_XSUB(j)  (1280 + 64 * (j))
#define XB_XGEN(j)  (2304 + 64 * (j))
#define XB_TOP      3328
#define XB_TOPGEN   3392
#define XCD_BAR_WORDS 3456
#define XB_SPIN_CAP (1u << 22)
__device__ __forceinline__ unsigned xb_ld(unsigned* p)              { return __hip_atomic_load(p, __ATOMIC_RELAXED, __HIP_MEMORY_SCOPE_AGENT); }
__device__ __forceinline__ unsigned xb_add(unsigned* p, unsigned v) { return __hip_atomic_fetch_add(p, v, __ATOMIC_RELAXED, __HIP_MEMORY_SCOPE_AGENT); }
__device__ __forceinline__ unsigned xb_xcc_id() { return (unsigned)__builtin_amdgcn_s_getreg((3 << 11) | 20) & 0xFu; }
#define XB_SPIN(cond, bar) do { unsigned _sp = 0; while (cond) { __builtin_amdgcn_s_sleep(1); \
    if ((++_sp & 255u) == 0u) { if (xb_ld(&(bar)[XB_TMO])) break; if (_sp > XB_SPIN_CAP) { atomicAdd(&(bar)[XB_TMO], 1u); break; } } } } while (0)
struct XcdBarrier { unsigned* bar; unsigned x; volatile LAS unsigned* st; };
__device__ __forceinline__ XcdBarrier xcd_barrier_post(unsigned* bar, volatile LAS unsigned* st) {
    XcdBarrier b; b.bar = bar; b.x = xb_xcc_id(); b.st = st;
    if (threadIdx.x == 0) (void)xb_add(&bar[XB_XCNT(b.x)], 1u);
    return b;
}
__device__ __forceinline__ void xcd_barrier_complete(unsigned* bar, unsigned x, unsigned& nloc, unsigned& nx) {
    const unsigned G = gridDim.x * gridDim.y * gridDim.z;
    unsigned sum, cnt, mine, sp = 0u;
    for (;;) {
        sum = 0u; cnt = 0u; mine = 0u;
#pragma unroll
        for (unsigned j = 0; j < 16; ++j) { const unsigned c = xb_ld(&bar[XB_XCNT(j)]); sum += c; cnt += (c > 0u) ? 1u : 0u; mine = (j == x) ? c : mine; }
        if (sum == G) break;
        __builtin_amdgcn_s_sleep(1);
        if ((++sp & 255u) == 0u) { if (xb_ld(&bar[XB_TMO])) break; if (sp > XB_SPIN_CAP) { atomicAdd(&bar[XB_TMO], 1u); break; } }
    }
    nloc = mine > 0u ? mine : 1u; nx = cnt > 0u ? cnt : 1u;
}
__device__ __forceinline__ void xcd_barrier(const XcdBarrier& b) {
    asm volatile("s_waitcnt vmcnt(0)" ::: "memory");
    __syncthreads();
    if (threadIdx.x == 0) {
        unsigned* bar = b.bar;
        __builtin_amdgcn_s_waitcnt(0);
        unsigned nloc = b.st[0], nx = b.st[1];
        if (nloc == 0u) { xcd_barrier_complete(bar, b.x, nloc, nx); b.st[0] = nloc; b.st[1] = nx; }
        const unsigned old = xb_add(&bar[XB_XSUB(b.x)], 1u);
        const unsigned gen = old / nloc;
        if (old + 1u == (gen + 1u) * nloc) {
            __builtin_amdgcn_fence(__ATOMIC_RELEASE, "agent");
            asm volatile("s_waitcnt vmcnt(0)" ::: "memory");
            const unsigned og = xb_add(&bar[XB_TOP], 1u);
            const unsigned tg = og / nx;
            if (og + 1u == (tg + 1u) * nx) xb_add(&bar[XB_TOPGEN], 1u);
            else XB_SPIN(xb_ld(&bar[XB_TOPGEN]) == tg, bar);
            __builtin_amdgcn_fence(__ATOMIC_ACQUIRE, "agent");
            xb_add(&bar[XB_XGEN(b.x)], 1u);
            asm volatile("s_waitcnt vmcnt(0)" ::: "memory");
        } else {
            XB_SPIN(xb_ld(&bar[XB_XGEN(b.x)]) == gen, bar);
            __builtin_amdgcn_fence(__ATOMIC_ACQUIRE, "agent");
            asm volatile("s_waitcnt vmcnt(0)" ::: "memory");
        }
    }
    __syncthreads();
}

constexpr int PTR_OFF = MISC_OFF + 512;
struct Frame {
    LAS unsigned char* lds;
    volatile LAS unsigned* MISC;
    int tid, lane, wave, gw, NGW;
    __device__ __forceinline__ unsigned long long ptr(int i) const { const LAS unsigned* p = (const LAS unsigned*)(lds + PTR_OFF) + 2 * i;
        const unsigned lo = __builtin_amdgcn_readfirstlane(p[0]), hi = __builtin_amdgcn_readfirstlane(p[1]); return ((unsigned long long)hi << 32) | lo; }
    __device__ __forceinline__ const float* inp(int i) const { return (const float*)(const GAS float*)ptr(i); }
    __device__ __forceinline__ float* outp() const { return (float*)(GAS float*)ptr(23); }
    __device__ __forceinline__ unsigned char* wsp() const { return (unsigned char*)(GAS unsigned char*)ptr(24); }
    __device__ __forceinline__ gu32* ctlp() const { return (gu32*)(wsp() + WS_CTL); }
};
enum { I_X = 0, I_C, I_ADAW, I_ADAB, I_LNG, I_LNB, I_CWIN, I_CONVW, I_CONVB, I_CWOUT, I_WKV, I_PE, I_CW1, I_CB1, I_CW2, I_CB2, I_WQG, I_BG, I_WO, I_RW, I_RB, I_WGU, I_WDN };

__device__ __forceinline__ void transpose_item(const float* W, int ld, int nvalid, int K, bf16* WT, int dstrow0, int k0, int n0, LAS float* scr, int lane) {
    const int n = n0 + (lane & 31);
#pragma unroll 8
    for (int i = 0; i < 32; ++i) { const int kk = 2 * i + (lane >> 5); scr[kk * 33 + (lane & 31)] = (n < nvalid) ? W[(size_t)(k0 + kk) * ld + n] : 0.f; }
    LDS_WAIT(); asm volatile("" ::: "memory");
    const int c = lane & 7;
#pragma unroll
    for (int j = 0; j < 4; ++j) { const int nl = (lane >> 3) + 8 * j; const LAS float* s = scr + (8 * c) * 33 + nl;
        u32x4 o; o.x = pk2(s[0 * 33], s[1 * 33]); o.y = pk2(s[2 * 33], s[3 * 33]); o.z = pk2(s[4 * 33], s[5 * 33]); o.w = pk2(s[6 * 33], s[7 * 33]);
        *(u32x4*)(WT + (size_t)(dstrow0 + nl) * K + k0 + 8 * c) = o; }
    LDS_WAIT(); asm volatile("" ::: "memory");
}
__device__ __forceinline__ int pairmap(int n0, int half) {
    return n0 < half ? ((n0 >> 7) * 256 + (n0 & 127)) : ((((n0 - half) >> 7) * 256) + 128 + ((n0 - half) & 127));
}
__device__ __forceinline__ void p0_prologue(Frame& F) {
    LAS float* scr = (LAS float*)(F.lds + F.wave * 16384);
    const int lane = F.lane;
    for (int r = F.gw; r < 768 + 256; r += F.NGW) {
        if (r < 768) {
            const int l = r / 384, rem = r % 384, dch = rem / 24, e = (rem % 24) * 256 + 4 * lane;
            const float* aw = F.inp(I_ADAW) + (size_t)l * 1024 * 6144 + e; const float* c = F.inp(I_C);
            f32x4 a0 = (f32x4){0.f, 0.f, 0.f, 0.f}, a1 = a0, a2 = a0, a3 = a0;
            { const int d = dch * 64 + lane; LAS f32x4* sc4 = (LAS f32x4*)scr;
              sc4[lane] = (f32x4){silu_f(c[d]), silu_f(c[1024 + d]), silu_f(c[2048 + d]), silu_f(c[3072 + d])};
              LDS_WAIT(); asm volatile("" ::: "memory"); }
#pragma unroll 16
            for (int dd = 0; dd < 64; ++dd) {
                const f32x4 w = *(const f32x4*)(aw + (size_t)(dch * 64 + dd) * 6144);
                const f32x4 sv = ((const LAS f32x4*)scr)[dd];
                a0 += w * sv[0]; a1 += w * sv[1]; a2 += w * sv[2]; a3 += w * sv[3];
            }
            LDS_WAIT(); asm volatile("" ::: "memory");
            float* mp = (float*)(F.wsp() + WS_MODP) + (size_t)dch * 49152 + (size_t)(l * 4) * 6144 + e;
            *(f32x4*)mp = a0; *(f32x4*)(mp + 6144) = a1; *(f32x4*)(mp + 2 * 6144) = a2; *(f32x4*)(mp + 3 * 6144) = a3;
        } else {
            const int q = r - 768, i = q / 128, rem = q % 128, cch = rem / 32, kch = rem % 32, c = cch * 64 + lane;
            const float* pe = F.inp(I_PE) + i * 2048; const float* w1 = F.inp(I_CW1) + (size_t)i * 2048 * 256 + c;
            float a = 0.f;
#pragma unroll 16
            for (int kk = kch * 64; kk < kch * 64 + 64; ++kk) a += pe[kk] * w1[(size_t)kk * 256];
            ((float*)(F.wsp() + WS_PETP))[(kch * 2 + i) * 256 + c] = a;
        }
    }
    constexpr int I1 = 16 * 96, I2 = 512, I3 = 16 * 48, I4 = 16 * 40, I5 = 512, I6 = 512, I7 = 32 * 512, I8 = 32 * 256;
    constexpr int NITEMS = I1 + I2 + I3 + I4 + I5 + I6 + I7 + I8;
    for (int it = F.gw; it < NITEMS; it += F.NGW) {
        int r = it;
        if (r < I1) { const int kb = r / 96, nb = r % 96, n0 = nb * 32;
            const int dr = n0 < 1024 ? n0 : 1024 + pairmap(n0 - 1024, 1024);
            transpose_item(F.inp(I_CWIN), 3072, 3072, 1024, (bf16*)(F.wsp() + WS_WIN), dr, kb * 64, n0, scr, lane); continue; } r -= I1;
        if (r < I2) { transpose_item(F.inp(I_CWOUT), 1024, 1024, 1024, (bf16*)(F.wsp() + WS_WOUT), (r % 32) * 32, (r / 32) * 64, (r % 32) * 32, scr, lane); continue; } r -= I2;
        if (r < I3) { transpose_item(F.inp(I_WKV), 1536, 1536, 1024, (bf16*)(F.wsp() + WS_WKV), (r % 48) * 32, (r / 48) * 64, (r % 48) * 32, scr, lane); continue; } r -= I3;
        if (r < I4) { transpose_item(F.inp(I_WQG), 1072, 1072, 1024, (bf16*)(F.wsp() + WS_WQG), (r % 40) * 32, (r / 40) * 64, (r % 40) * 32, scr, lane); continue; } r -= I4;
        if (r < I5) { transpose_item(F.inp(I_WO), 1024, 1024, 1024, (bf16*)(F.wsp() + WS_WO), (r % 32) * 32, (r / 32) * 64, (r % 32) * 32, scr, lane); continue; } r -= I5;
        if (r < I6) { const int sub = r / 128, q = r % 128, i = sub >> 1, hh = sub & 1;
            transpose_item(F.inp(I_CW1) + (size_t)i * 2048 * 256 + (size_t)hh * 1024 * 256, 256, 256, 1024, (bf16*)(F.wsp() + WS_W1C) + (size_t)i * 512 * 1024, hh * 256 + (q % 8) * 32, (q / 8) * 64, (q % 8) * 32, scr, lane); continue; } r -= I6;
        if (r < I7) { const int mi = r / 512, q = r % 512, n0 = (q % 32) * 32;
            transpose_item(F.inp(I_WGU) + (size_t)mi * 1024 * 1024, 1024, 1024, 1024, (bf16*)(F.wsp() + WS_WGU) + (size_t)mi * 1024 * 1024, pairmap(n0, 512), (q / 32) * 64, n0, scr, lane); continue; } r -= I7;
        { const int mi = r / 256, q = r % 256, n0 = (q % 32) * 32;
            transpose_item(F.inp(I_WDN) + (size_t)mi * 512 * 1024, 1024, 1024, 512, (bf16*)(F.wsp() + WS_WDN) + (size_t)mi * 1024 * 512, n0, (q / 32) * 64, n0, scr, lane); }
    }
}
__device__ __forceinline__ f32x4 mod4_partials(const Frame& F, int l, int b, int e) {
    f32x4 s = *(const f32x4*)(F.inp(I_ADAB) + l * 6144 + e);
    const float* mp = (const float*)(F.wsp() + WS_MODP) + (size_t)(l * 4 + b) * 6144 + e;
#pragma unroll
    for (int d = 0; d < 16; ++d) s += *(const f32x4*)(mp + (size_t)d * 49152);
    return s;
}
__device__ __forceinline__ void p1_mod_u0(Frame& F) {
    float* MOD = (float*)(F.wsp() + WS_MOD);
    for (int ch = F.gw; ch < 768; ch += F.NGW) {
        const int idx = ch * 64 + F.lane, lb = idx / 6144, e = idx % 6144;
        float s = F.inp(I_ADAB)[(lb >> 2) * 6144 + e];
        const float* mp = (const float*)(F.wsp() + WS_MODP) + idx;
#pragma unroll
        for (int d = 0; d < 16; ++d) s += mp[(size_t)d * 49152];
        MOD[idx] = s;
    }
    bf16* U = (bf16*)(F.wsp() + WS_U);
    for (int m0 = F.gw * 8; m0 < T; m0 += F.NGW * 8) {
        const int b = m0 >> 12;
        f32x4 sh[4], sc[4];
#pragma unroll
        for (int j = 0; j < 4; ++j) { const int col = 4 * F.lane + 256 * j; sh[j] = mod4_partials(F, 0, b, col); sc[j] = mod4_partials(F, 0, b, 1024 + col) + 1.0f; }
        for (int m = m0; m < m0 + 8; ++m) {
#pragma unroll
            for (int j = 0; j < 4; ++j) { const int col = 4 * F.lane + 256 * j; const f32x4 v = *(const f32x4*)(F.inp(I_X) + (size_t)m * DM + col);
                st_bf4(U + (size_t)m * DM + col, v * sc[j] + sh[j]); }
        }
    }
}

template <bool PAIR, class AR, class EP>
__device__ __forceinline__ void gemm_wave_tile(const AR& arow, const bf16* Btile, int K, int m0, int nbase, const EP& ep, int lane) {
    const int fr = lane & 15, fq = lane >> 4;
    f32x4 acc[4][4];
#pragma unroll
    for (int i = 0; i < 4; ++i)
#pragma unroll
        for (int j = 0; j < 4; ++j) acc[i][j] = (f32x4){0.f, 0.f, 0.f, 0.f};
    const bf16* ap[4]; const bf16* bp[4];
#pragma unroll
    for (int i = 0; i < 4; ++i) ap[i] = arow(m0 + 16 * i + fr) + 8 * fq;
#pragma unroll
    for (int j = 0; j < 4; ++j) { const int nr = PAIR ? ((j & 1) * 16 + (j >> 1) * 128) : 16 * j; bp[j] = Btile + (size_t)(nr + fr) * K + 8 * fq; }
    for (int k0 = 0; k0 < K; k0 += 32) {
        bf16x8 a[4], b[4];
#pragma unroll
        for (int i = 0; i < 4; ++i) a[i] = *(const bf16x8*)(ap[i] + k0);
#pragma unroll
        for (int j = 0; j < 4; ++j) b[j] = *(const bf16x8*)(bp[j] + k0);
#pragma unroll
        for (int i = 0; i < 4; ++i)
#pragma unroll
            for (int j = 0; j < 4; ++j) acc[i][j] = __builtin_amdgcn_mfma_f32_16x16x32_bf16(b[j], a[i], acc[i][j], 0, 0, 0);
    }
#pragma unroll
    for (int i = 0; i < 4; ++i) {
        const int m = m0 + 16 * i + fr;
        if constexpr (PAIR) {
#pragma unroll
            for (int j = 0; j < 2; ++j) ep.pair(m, nbase + 16 * j + 4 * fq, acc[i][j], acc[i][j + 2]);
        } else {
#pragma unroll
            for (int j = 0; j < 4; ++j) ep(m, nbase + 16 * j + 4 * fq, acc[i][j]);
        }
    }
}
struct ARowPlain { const bf16* A; int K; __device__ __forceinline__ const bf16* operator()(int m) const { return A + (size_t)m * K; } };

struct EpBf16 { bf16* O; int ld; __device__ __forceinline__ void operator()(int m, int n, f32x4 v) const { st_bf4(O + (size_t)m * ld + n, v); }
    __device__ __forceinline__ void op8(int m, int n, f32x4 a, f32x4 b) const { st_bf8(O + (size_t)m * ld + n, a, b); } };
struct EpMulPair { bf16* O; int ld; __device__ __forceinline__ void pair(int m, int ch, f32x4 a, f32x4 b) const { st_bf4(O + (size_t)m * ld + ch, a * b); }
    __device__ __forceinline__ void pair8(int m, int ch, f32x4 a0, f32x4 a1, f32x4 b0, f32x4 b1) const { st_bf8(O + (size_t)m * ld + ch, a0 * b0, a1 * b1); } };
struct EpSiluPair { bf16* O; int ld; __device__ __forceinline__ void pair(int m, int ch, f32x4 a, f32x4 b) const {
    f32x4 s; for (int r = 0; r < 4; ++r) s[r] = silu_f(a[r]) * b[r]; st_bf4(O + (size_t)m * ld + ch, s); } };
__device__ __forceinline__ f32x4 ld_bf4(const bf16* p) { const u32x2 w = *(const u32x2*)p; return (f32x4){bflo(w.x), bfhi(w.x), bflo(w.y), bfhi(w.y)}; }
struct EpRes { const float* base; bf16* out; const float* gmod;
    __device__ __forceinline__ void operator()(int m, int n, f32x4 v) const { const int b = m >> 12; const f32x4 g = *(const f32x4*)(gmod + b * 6144 + n);
        const f32x4 x = *(const f32x4*)(base + (size_t)m * DM + n); st_bf4(out + (size_t)m * DM + n, x * ALPHA + g * v); } };
struct EpResB { bf16* res; const float* gmod;
    __device__ __forceinline__ void operator()(int m, int n, f32x4 v) const { const int b = m >> 12; const f32x4 g = *(const f32x4*)(gmod + b * 6144 + n);
        bf16* p = res + (size_t)m * DM + n; st_bf4(p, ld_bf4(p) * ALPHA + g * v); } };
__device__ __forceinline__ int kfrag_off(int kk, int d) { return ((((kk >> 5) * 4 + (d >> 4)) * 2 + ((d >> 3) & 1)) * 32 + (kk & 31)) * 8 + (d & 7); }
__device__ __forceinline__ int vfrag_off(int kk, int d) { return ((((d >> 5) * 4 + (kk >> 4)) * 2 + ((kk >> 2) & 1)) * 32 + (d & 31)) * 8 + ((((kk >> 3) & 1) << 2) | (kk & 3)); }
struct EpKV { bf16* KV; __device__ __forceinline__ void operator()(int m, int n, f32x4 v) const {
    const int j = n >> 8, hk = (n >> 6) & 3, d = n & 63, b = m >> 12, t = m & 4095;
    bf16* base = KV + (size_t)j * KVBUF_ELEMS + (size_t)(b * 4 + hk) * KVROWS * 64;
    if (j < 2) st_bf4(base + (size_t)t * 64 + d, v);
    else if ((j & 1) == 0) st_bf4(base + (size_t)(t >> 6) * 4096 + kfrag_off(t & 63, d), v);
    else { bf16* tp = base + (size_t)(t >> 6) * 4096;
        for (int r = 0; r < 4; ++r) tp[vfrag_off(t & 63, d + r)] = (bf16)f2bf(v[r]); } }
    __device__ __forceinline__ void op8(int m, int n, f32x4 a, f32x4 c) const {
    const int j = n >> 8, hk = (n >> 6) & 3, d = n & 63, b = m >> 12, t = m & 4095;
    bf16* base = KV + (size_t)j * KVBUF_ELEMS + (size_t)(b * 4 + hk) * KVROWS * 64;
    if (j < 2) st_bf8(base + (size_t)t * 64 + d, a, c);
    else if ((j & 1) == 0) st_bf8(base + (size_t)(t >> 6) * 4096 + kfrag_off(t & 63, d), a, c);
    else { bf16* tp = base + (size_t)(t >> 6) * 4096;
        for (int r = 0; r < 4; ++r) { tp[vfrag_off(t & 63, d + r)] = (bf16)f2bf(a[r]); tp[vfrag_off(t & 63, d + 4 + r)] = (bf16)f2bf(c[r]); } } } };
struct EpQG { bf16* Q; float* GATE; const float* bg; __device__ __forceinline__ void operator()(int m, int n, f32x4 v) const {
    if (n < 1024) st_bf4(Q + (size_t)m * DM + n, v * C2);
    else { for (int r = 0; r < 4; ++r) { const int i = n - 1024 + r; if (i < 48) GATE[(size_t)m * 48 + i] = 1.f / (1.f + __expf(-(v[r] + bg[i]))); } } }
    __device__ __forceinline__ void op8(int m, int n, f32x4 a, f32x4 c) const {
    if (n < 1024) st_bf8(Q + (size_t)m * DM + n, a * C2, c * C2);
    else { (*this)(m, n, a); (*this)(m, n + 4, c); } } };
struct EpF32 { float* O; int ld; __device__ __forceinline__ void operator()(int m, int n, f32x4 v) const { *(f32x4*)(O + (size_t)m * ld + n) = v; } };

template <bool PAIR, class AR, class EP>
__device__ __forceinline__ void gemm_dense(Frame& F, const AR& arow, const bf16* Bt, int K, int nM64, int nN64, int chbase, const EP& ep) {
    const int total = nM64 * nN64;
    for (int it = F.gw; it < total; it += F.NGW) {
        const int ni = it % nN64, mt = it / nN64;
        if constexpr (PAIR) { const int pn = ni >> 2, q = ni & 3;
            gemm_wave_tile<true>(arow, Bt + (size_t)(pn * 256 + q * 32) * K, K, mt * 64, chbase + pn * 128 + q * 32, ep, F.lane);
        } else gemm_wave_tile<false>(arow, Bt + (size_t)(ni * 64) * K, K, mt * 64, chbase + ni * 64, ep, F.lane);
    }
}

namespace pg8 {
#define PG8_LAS __attribute__((address_space(3)))
constexpr int BM = 256, BK = 64, HALF = 128, HTB = HALF * BK * 2, STAGE_BYTES = 8 * HTB, NXCD = 8, WGM = 8;
__device__ __forceinline__ int lds_byte(int r, int c) { const int st = (r >> 4) * 2 + (c >> 5), rr = r & 15, cc = c & 31, ob = rr * 64 + cc * 2; return st * 1024 + (ob ^ (((ob >> 9) & 1) << 5)); }
__device__ __forceinline__ void stage_rc(int b, int& R, int& C) { const int st = b / 1024, sb = b % 1024, swz = sb ^ (((sb >> 9) & 1) << 5); R = (st >> 1) * 16 + swz / 64; C = (st & 1) * 32 + (swz % 64) / 2; }
struct Unit { const char* A; const char* B; int row0, col0, e, pos0, cnt; };
__device__ __forceinline__ bool static_order(int i, int G, int c, int nM, int nN, int& pm, int& pn) {
    const int nwg = nM * nN; const long L = (long)i * G + c; if (L >= nwg) return false;
    int wgid = (int)L; { const int q = nwg / NXCD, r = nwg % NXCD, xcd = wgid % NXCD, off = wgid / NXCD; wgid = (xcd < r ? xcd * (q + 1) : r * (q + 1) + (xcd - r) * q) + off; }
    const int nig = WGM * nN, gid = wgid / nig, fm = gid * WGM, gsz = (nM - fm) < WGM ? (nM - fm) : WGM;
    pm = fm + ((wgid % nig) % gsz); pn = (wgid % nig) / gsz; return true;
}
__device__ __forceinline__ void voff_plain(const int (&R)[2], const int (&C)[2], int K, unsigned (&v)[2][2]) {
#pragma unroll
    for (int h = 0; h < 2; ++h)
#pragma unroll
        for (int i = 0; i < 2; ++i) v[h][i] = (unsigned)((h * HALF + R[i]) * K + C[i]) * 2u;
}
__device__ __forceinline__ int perm32(int rho) { const int n = rho >> 4, i = rho & 15; return 8 * (i >> 2) + 4 * n + (i & 3); }
template <class EP, bool PAIR, bool PERM_ = false> struct EpiWrap {
    static constexpr bool PERM = PERM_;
    EP ep;
    __device__ __forceinline__ void operator()(const f32x4 (&acc)[2][2][4][2], const Unit& u, int wr, int wc, int fr, int fq) const {
#pragma unroll
        for (int ai = 0; ai < 2; ++ai)
#pragma unroll
            for (int m = 0; m < 4; ++m) { const int row = u.row0 + ai * HALF + wr * 64 + m * 16 + fr;
                if constexpr (PERM_) {
                    if constexpr (PAIR) ep.pair8(u, row, u.col0 + wc * 32 + 8 * fq, acc[ai][0][m][0], acc[ai][0][m][1], acc[ai][1][m][0], acc[ai][1][m][1]);
                    else {
#pragma unroll
                        for (int bj = 0; bj < 2; ++bj) ep.op8(u, row, u.col0 + bj * HALF + wc * 32 + 8 * fq, acc[ai][bj][m][0], acc[ai][bj][m][1]); }
                } else if constexpr (PAIR) {
#pragma unroll
                    for (int n = 0; n < 2; ++n) ep.pair(u, row, u.col0 + wc * 32 + 16 * n + 4 * fq, acc[ai][0][m][n], acc[ai][1][m][n]);
                } else {
#pragma unroll
                    for (int bj = 0; bj < 2; ++bj)
#pragma unroll
                        for (int n = 0; n < 2; ++n) ep(u, row, u.col0 + bj * HALF + wc * 32 + 16 * n + 4 * fq, acc[ai][bj][m][n]);
                } }
    }
};
template <class Epi, class Sched, bool ALIGN_EPI, bool GATHER>
__device__ __forceinline__ void gemm_phase(PG8_LAS unsigned char* lds, const int K, const Sched& S, const Epi& E) {
    const int tid = threadIdx.x, wid = __builtin_amdgcn_readfirstlane(tid >> 6), lane = tid & 63, wr = wid >> 2, wc = wid & 3, fr = lane & 15, fq = lane >> 4;
    const int nt = K / BK;
    int R[2], C[2]; unsigned voffB[2]; unsigned vC[2][2], vN[2][2];
#pragma unroll
    for (int i = 0; i < 2; ++i) { stage_rc(tid * 16 + i * 8192, R[i], C[i]); const int Rb = Epi::PERM ? ((R[i] & ~31) | perm32(R[i] & 31)) : R[i]; voffB[i] = (unsigned)(Rb * K + C[i]) * 2u; }
    const size_t kstep = (size_t)(BK * 2);
    const size_t hstep = (size_t)HALF * K * 2;
    const unsigned ldsw = (unsigned)wid * 1024u;
    const int aoff = lds_byte(wr * 64 + fr, fq * 8), boff = lds_byte(wc * 32 + fr, fq * 8);
#define PG8_SA(b, h) (((b) * 2 + (h)) * HTB)
#define PG8_SB(b, h) ((4 + (b) * 2 + (h)) * HTB)
#define PG8_STAGE(bufoff, gbase, voff) do { _Pragma("unroll") for (int _i = 0; _i < 2; ++_i) \
        __builtin_amdgcn_global_load_lds((const unsigned*)((const char*)(gbase) + (voff)[_i]), (PG8_LAS unsigned*)(lds + (bufoff) + ldsw + _i * 8192), 16, 0, 0); } while (0)
#define PG8_LDA(dst, b, h) do { _Pragma("unroll") for (int m = 0; m < 4; ++m) _Pragma("unroll") for (int k = 0; k < 2; ++k) dst[m][k] = *(const PG8_LAS bf16x8*)(lds + PG8_SA(b, h) + aoff + m * 2048 + k * 1024); } while (0)
#define PG8_LDB(dst, b, h) do { _Pragma("unroll") for (int n = 0; n < 2; ++n) _Pragma("unroll") for (int k = 0; k < 2; ++k) dst[n][k] = *(const PG8_LAS bf16x8*)(lds + PG8_SB(b, h) + boff + n * 2048 + k * 1024); } while (0)
#define PG8_MMA(ai, bj, At, Bt) do { __builtin_amdgcn_s_setprio(1); _Pragma("unroll") for (int m = 0; m < 4; ++m) _Pragma("unroll") for (int n = 0; n < 2; ++n) _Pragma("unroll") for (int k = 0; k < 2; ++k) \
        acc[ai][bj][m][n] = __builtin_amdgcn_mfma_f32_16x16x32_bf16(Bt[n][k], At[m][k], acc[ai][bj][m][n], 0, 0, 0); __builtin_amdgcn_s_setprio(0); } while (0)
#define PG8_WAIT_V(n) asm volatile("s_waitcnt vmcnt(" #n ")" ::: "memory")
#define PG8_WAIT_L(n) asm volatile("s_waitcnt lgkmcnt(" #n ")" ::: "memory")
#define PG8_BAR __builtin_amdgcn_s_barrier()
#define PG8_SCHED __builtin_amdgcn_sched_barrier(0)
    Unit cur, nxt; int ui = 0;
    if (!S.next(0, cur)) return;
    S.voff(cur, R, C, K, vC);
    f32x4 acc[2][2][4][2];
#pragma unroll
    for (int a = 0; a < 2; ++a)
#pragma unroll
        for (int b = 0; b < 2; ++b)
#pragma unroll
            for (int m = 0; m < 4; ++m)
#pragma unroll
                for (int n = 0; n < 2; ++n) acc[a][b][m][n] = (f32x4){0.f, 0.f, 0.f, 0.f};
    bf16x8 At[4][2], B0[2][2], B1[2][2];
    const char* cA = cur.A; const char* cB = cur.B;
    PG8_STAGE(PG8_SB(0, 0), cB, voffB); PG8_STAGE(PG8_SB(0, 1), cB + hstep, voffB); PG8_STAGE(PG8_SA(0, 0), cA, vC[0]); PG8_STAGE(PG8_SA(0, 1), cA, vC[1]);
    if (wr == 1) PG8_BAR;
    PG8_WAIT_V(2); PG8_BAR;
    PG8_STAGE(PG8_SB(1, 0), cB + kstep, voffB); PG8_STAGE(PG8_SA(1, 0), cA + kstep, vC[0]); PG8_STAGE(PG8_SB(1, 1), cB + hstep + kstep, voffB);
    PG8_WAIT_V(6); PG8_BAR;
    for (;;) {
        const bool has_next = S.next(ui + 1, nxt);
        const char* nA = has_next ? nxt.A : cA; const char* nB = has_next ? nxt.B : cB;
        if constexpr (GATHER) { if (has_next) S.voff(nxt, R, C, K, vN); else { vN[0][0] = vC[0][0]; vN[0][1] = vC[0][1]; vN[1][0] = vC[1][0]; vN[1][1] = vC[1][1]; } }
        for (int t = 0; t < nt; t += 2) {
            const bool last = (t == nt - 2);
            const char* a1 = cA + (size_t)(t + 1) * kstep;
            const char* a2 = last ? nA : cA + (size_t)(t + 2) * kstep; const char* b2 = last ? nB : cB + (size_t)(t + 2) * kstep;
            const char* a3 = a2 + kstep; const char* b3 = b2 + kstep;
            unsigned v2[2][2];
#pragma unroll
            for (int h = 0; h < 2; ++h)
#pragma unroll
                for (int i = 0; i < 2; ++i) v2[h][i] = (GATHER && last) ? vN[h][i] : vC[h][i];
            PG8_LDB(B0, 0, 0); PG8_LDB(B1, 0, 1); PG8_SCHED; PG8_LDA(At, 0, 0); PG8_STAGE(PG8_SA(1, 1), a1, vC[1]);
            PG8_WAIT_V(8); PG8_WAIT_L(0); PG8_BAR; PG8_MMA(0, 0, At, B0); PG8_MMA(0, 1, At, B1); PG8_BAR; PG8_SCHED;
            PG8_LDA(At, 0, 1); PG8_STAGE(PG8_SB(0, 0), b2, voffB); PG8_STAGE(PG8_SB(0, 1), b2 + hstep, voffB); PG8_STAGE(PG8_SA(0, 0), a2, v2[0]);
            PG8_WAIT_V(8); PG8_WAIT_L(0); PG8_BAR; PG8_MMA(1, 0, At, B0); PG8_MMA(1, 1, At, B1); PG8_BAR; PG8_SCHED;
            PG8_LDB(B0, 1, 0); PG8_LDB(B1, 1, 1); PG8_SCHED; PG8_LDA(At, 1, 0); PG8_STAGE(PG8_SA(0, 1), a2, v2[1]);
            PG8_WAIT_V(8); PG8_WAIT_L(0); PG8_BAR; PG8_MMA(0, 0, At, B0); PG8_MMA(0, 1, At, B1); PG8_BAR; PG8_SCHED;
            PG8_LDA(At, 1, 1); PG8_STAGE(PG8_SB(1, 0), b3, voffB); PG8_STAGE(PG8_SB(1, 1), b3 + hstep, voffB); PG8_STAGE(PG8_SA(1, 0), a3, v2[0]);
            PG8_WAIT_V(8); PG8_WAIT_L(0); PG8_BAR; PG8_MMA(1, 0, At, B0); PG8_MMA(1, 1, At, B1); PG8_BAR; PG8_SCHED;
        }
        if constexpr (ALIGN_EPI) { if (wr == 0) PG8_BAR; }
        E(acc, cur, wr, wc, fr, fq);
        if (!has_next) break;
#pragma unroll
        for (int a = 0; a < 2; ++a)
#pragma unroll
            for (int b = 0; b < 2; ++b)
#pragma unroll
                for (int m = 0; m < 4; ++m)
#pragma unroll
                    for (int n = 0; n < 2; ++n) acc[a][b][m][n] = (f32x4){0.f, 0.f, 0.f, 0.f};
        cur = nxt; cA = nA; cB = nB; ++ui;
        if constexpr (GATHER) { vC[0][0] = vN[0][0]; vC[0][1] = vN[0][1]; vC[1][0] = vN[1][0]; vC[1][1] = vN[1][1]; }
        if constexpr (ALIGN_EPI) { if (wr == 1) PG8_BAR; }
    }
    PG8_WAIT_V(0);
    if constexpr (!ALIGN_EPI) { if (wr == 0) PG8_BAR; }
    PG8_BAR;
#undef PG8_SA
#undef PG8_SB
#undef PG8_STAGE
#undef PG8_LDA
#undef PG8_LDB
#undef PG8_MMA
#undef PG8_WAIT_V
#undef PG8_WAIT_L
#undef PG8_BAR
#undef PG8_SCHED
}
struct SchedDense {
    const char* A0; const char* B0; const char* A1; const char* B1; int nM, nN0, nN1, K, G, c, colmul;
    __device__ __forceinline__ bool next(int i, Unit& u) const {
        int pm, pn; if (!static_order(i, G, c, nM, nN0 + nN1, pm, pn)) return false;
        const int sec = pn >= nN0 ? 1 : 0, pl = pn - (sec ? nN0 : 0);
        u.A = (sec ? A1 : A0) + (size_t)pm * 256 * K * 2; u.B = (sec ? B1 : B0) + (size_t)pl * 256 * K * 2;
        u.row0 = pm * 256; u.col0 = pl * colmul; u.e = sec; u.pos0 = 0; u.cnt = 0; return true;
    }
    __device__ __forceinline__ void voff(const Unit&, const int (&R)[2], const int (&C)[2], int K_, unsigned (&v)[2][2]) const { voff_plain(R, C, K_, v); }
};
}
template <class EP> struct EpU { EP ep; __device__ __forceinline__ void operator()(const pg8::Unit&, int m, int n, f32x4 v) const { ep(m, n, v); }
    __device__ __forceinline__ void op8(const pg8::Unit&, int m, int n, f32x4 a, f32x4 b) const { ep.op8(m, n, a, b); } };
template <class EP> struct EpUP { EP ep; __device__ __forceinline__ void pair(const pg8::Unit&, int m, int ch, f32x4 a, f32x4 b) const { ep.pair(m, ch, a, b); }
    __device__ __forceinline__ void pair8(const pg8::Unit&, int m, int ch, f32x4 a0, f32x4 a1, f32x4 b0, f32x4 b1) const { ep.pair8(m, ch, a0, a1, b0, b1); } };
struct EpG1 { static constexpr bool PERM = true; bf16* BG; bf16* Z;
    __device__ __forceinline__ void operator()(const f32x4 (&acc)[2][2][4][2], const pg8::Unit& u, int wr, int wc, int fr, int fq) const {
        if (u.e == 0) { pg8::EpiWrap<EpU<EpBf16>, false, true> w{{{BG, DM}}}; w(acc, u, wr, wc, fr, fq); }
        else { pg8::Unit u2 = u; u2.col0 = u.col0 >> 1; pg8::EpiWrap<EpUP<EpMulPair>, true, true> w{{{Z, DM}}}; w(acc, u2, wr, wc, fr, fq); }
    } };
struct EpNull { static constexpr bool PERM = false; __device__ __forceinline__ void operator()(const f32x4 (&acc)[2][2][4][2], const pg8::Unit&, int, int, int, int) const {
#pragma unroll
    for (int a = 0; a < 2; ++a)
#pragma unroll
        for (int b = 0; b < 2; ++b)
#pragma unroll
            for (int m = 0; m < 4; ++m)
#pragma unroll
                for (int n = 0; n < 2; ++n) asm volatile("" :: "v"(acc[a][b][m][n])); } };
struct EpKVQG { bf16* KV; bf16* Q; float* GATE; const float* bg;
    __device__ __forceinline__ void operator()(const pg8::Unit& u, int m, int n, f32x4 v) const { if (u.e == 0) { EpKV e{KV}; e(m, n, v); } else { EpQG e{Q, GATE, bg}; e(m, n, v); } }
    __device__ __forceinline__ void op8(const pg8::Unit& u, int m, int n, f32x4 a, f32x4 b) const { if (u.e == 0) { EpKV e{KV}; e.op8(m, n, a, b); } else { EpQG e{Q, GATE, bg}; e.op8(m, n, a, b); } } };

__device__ __forceinline__ void p3_conv(Frame& F) {
    const bf16* BG = (const bf16*)(F.wsp() + WS_BG); const bf16* Z = (const bf16*)(F.wsp() + WS_Z); bf16* A2 = (bf16*)(F.wsp() + WS_A2);
    const float* cw = F.inp(I_CONVW); const float* cb = F.inp(I_CONVB);
    const int gt = F.gw * 64 + F.lane, NT_ = F.NGW * 64;
    for (int it = gt; it < T * 128; it += NT_) {
        const int m = it >> 7, ch = (it & 127) * 8, t = m & 4095;
        const u32x4 bg = *(const u32x4*)(BG + (size_t)m * DM + ch);
        const u32x4 z0 = *(const u32x4*)(Z + (size_t)m * DM + ch);
        u32x4 z1 = (u32x4){0, 0, 0, 0}, z2 = (u32x4){0, 0, 0, 0};
        if (t >= 1) z1 = *(const u32x4*)(Z + (size_t)(m - 1) * DM + ch);
        if (t >= 2) z2 = *(const u32x4*)(Z + (size_t)(m - 2) * DM + ch);
        u32x4 o;
#pragma unroll
        for (int w = 0; w < 4; ++w) {
            const int c = ch + 2 * w;
            const float r0 = bflo(bg[w]) * (cw[c] * bflo(z2[w]) + cw[1024 + c] * bflo(z1[w]) + cw[2048 + c] * bflo(z0[w]) + cb[c]);
            const float r1 = bfhi(bg[w]) * (cw[c + 1] * bfhi(z2[w]) + cw[1024 + c + 1] * bfhi(z1[w]) + cw[2048 + c + 1] * bfhi(z0[w]) + cb[c + 1]);
            o[w] = pk2(r0, r1);
        }
        *(u32x4*)(A2 + (size_t)m * DM + ch) = o;
    }
}

__device__ __forceinline__ void ln_row(f32x4 (&v)[4], const float* g, const float* bb, int lane) {
    float s = 0.f;
#pragma unroll
    for (int j = 0; j < 4; ++j) s += (v[j][0] + v[j][1]) + (v[j][2] + v[j][3]);
    const float mean = wave_sum(s) * (1.f / DM); float s2 = 0.f;
#pragma unroll
    for (int j = 0; j < 4; ++j) { v[j] = v[j] - mean; s2 += (v[j][0] * v[j][0] + v[j][1] * v[j][1]) + (v[j][2] * v[j][2] + v[j][3] * v[j][3]); }
    const float rstd = 1.f / sqrtf(wave_sum(s2) * (1.f / DM) + LN_EPS);
#pragma unroll
    for (int j = 0; j < 4; ++j) { const int col = 4 * lane + 256 * j; v[j] = v[j] * rstd * *(const f32x4*)(g + col) + *(const f32x4*)(bb + col); }
}
template <int L, bool DRY = false>
__device__ __forceinline__ void p_ln_router(Frame& F) {
    bf16* RES = (bf16*)(F.wsp() + WS_XB); bf16* U = (bf16*)(F.wsp() + WS_U);
    bf16* RESO = DRY ? (bf16*)(F.wsp() + WS_Y0) : RES; if (DRY) U = (bf16*)(F.wsp() + WS_H);
    const float* MOD = (const float*)(F.wsp() + WS_MOD) + (size_t)L * 4 * 6144;
    const float* rw = F.inp(I_RW); const float* rb = F.inp(I_RB);
    gu32* cnt = F.ctlp() + CW_CNT + L * 1024;
    unsigned* LIST = (unsigned*)(F.wsp() + WS_LIST) + (size_t)L * NE * T; float* LW = (float*)(F.wsp() + WS_LW) + (size_t)L * NE * T;
    const int lane = F.lane;
    LAS int* ae = (LAS int*)F.lds; LAS float* aw = (LAS float*)(F.lds + 512); LAS int* base = (LAS int*)(F.lds + 1024);
    constexpr int RS = 2064, AST_OFF = 2048, ALO_OFF = AST_OFF + 16 * RS, PST_OFF = ALO_OFF + 16 * RS;
    static_assert(PST_OFF + 8192 <= LDSCTL_OFF, "router LDS map");
    const int r16 = lane & 15, kg = lane >> 4;
    bf16x8 Bh[4], Bl[4];
#pragma unroll
    for (int s_ = 0; s_ < 4; ++s_) { u32x4 hh, ll;
#pragma unroll
        for (int i = 0; i < 4; ++i) { const int k = 128 * F.wave + 32 * s_ + 8 * kg + 2 * i; const float a = rw[(size_t)k * 16 + r16], b_ = rw[(size_t)(k + 1) * 16 + r16];
            const unsigned h = pk2(a, b_); hh[i] = h; ll[i] = pk2(a - bflo(h), b_ - bfhi(h)); }
        Bh[s_] = __builtin_bit_cast(bf16x8, hh); Bl[s_] = __builtin_bit_cast(bf16x8, ll); }
    const int nchunk = T / 64;
    for (int ch = blockIdx.x; ch < nchunk; ch += gridDim.x) {
      const bf16* YB = (const bf16*)(F.wsp() + WS_Y0); const float* XF = F.inp(I_X);
      u32x2 yn[4]; f32x4 xn[4];
#pragma unroll
      for (int j = 0; j < 4; ++j) { const size_t o = (size_t)(ch * 64 + F.wave * 2) * DM + 4 * lane + 256 * j; yn[j] = *(const u32x2*)(YB + o);
          if (L == 0) xn[j] = *(const f32x4*)(XF + o); else xn[j] = ld_bf4(RES + o); }
#pragma unroll 2
      for (int rr = 0; rr < 8; ++rr) {
        const int pass = rr >> 1, sub = rr & 1, lrow = pass * 16 + F.wave * 2 + sub, m = ch * 64 + lrow;
        const int b = m >> 12;
        f32x4 v[4];
#pragma unroll
        for (int j = 0; j < 4; ++j) { const f32x4 g1 = *(const f32x4*)(MOD + b * 6144 + 2 * 1024 + 4 * lane + 256 * j);
            v[j] = xn[j] * ALPHA + g1 * (f32x4){bflo(yn[j].x), bfhi(yn[j].x), bflo(yn[j].y), bfhi(yn[j].y)}; }
        if (rr < 7) {
#pragma unroll
            for (int j = 0; j < 4; ++j) { const size_t o = (size_t)(m + (sub ? 15 : 1)) * DM + 4 * lane + 256 * j; yn[j] = *(const u32x2*)(YB + o);
                if (L == 0) xn[j] = *(const f32x4*)(XF + o); else xn[j] = ld_bf4(RES + o); } }
        ln_row(v, F.inp(I_LNG) + (L * 2 + 0) * DM, F.inp(I_LNB) + (L * 2 + 0) * DM, lane);
        {
            LAS unsigned char* arow = F.lds + AST_OFF + (F.wave * 2 + sub) * RS + lane * 8;
#pragma unroll
            for (int j = 0; j < 4; ++j) { const int col = 4 * lane + 256 * j;
                st_bf4(RESO + (size_t)m * DM + col, v[j]);
                const f32x4 u = v[j] * (*(const f32x4*)(MOD + b * 6144 + 4 * 1024 + col) + 1.0f) + *(const f32x4*)(MOD + b * 6144 + 3 * 1024 + col);
                u32x2 hh, ll; hh.x = pk2(u[0], u[1]); hh.y = pk2(u[2], u[3]);
                ll.x = pk2(u[0] - bflo(hh.x), u[1] - bfhi(hh.x)); ll.y = pk2(u[2] - bflo(hh.y), u[3] - bfhi(hh.y));
                *(u32x2*)(U + (size_t)m * DM + col) = hh;
                *(LAS u32x2*)(arow + j * 512) = hh; *(LAS u32x2*)(arow + 16 * RS + j * 512) = ll; }
        }
        if (sub == 0) continue;
        __syncthreads();
        float lgv;
        {
            f32x4 acc = (f32x4){0.f, 0.f, 0.f, 0.f};
            const LAS unsigned char* ap = F.lds + AST_OFF + r16 * RS + (128 * F.wave + 8 * kg) * 2;
#pragma unroll
            for (int s_ = 0; s_ < 4; ++s_) { const bf16x8 ah = *(const LAS bf16x8*)(ap + s_ * 64), al = *(const LAS bf16x8*)(ap + 16 * RS + s_ * 64);
                acc = __builtin_amdgcn_mfma_f32_16x16x32_bf16(ah, Bh[s_], acc, 0, 0, 0);
                acc = __builtin_amdgcn_mfma_f32_16x16x32_bf16(al, Bh[s_], acc, 0, 0, 0);
                acc = __builtin_amdgcn_mfma_f32_16x16x32_bf16(ah, Bl[s_], acc, 0, 0, 0); }
            *(LAS f32x4*)(F.lds + PST_OFF + ((F.wave * 4 + kg) * 16 + r16) * 16) = acc;
            __syncthreads();
            const int rho = 2 * F.wave + (kg & 1); float sm = 0.f;
#pragma unroll
            for (int x = 0; x < 4; ++x) sm += *(const LAS float*)(F.lds + PST_OFF + ((((kg >> 1) * 4 + x) * 4 + (rho >> 2)) * 16 + r16) * 16 + (rho & 3) * 4);
            lgv = sm + __shfl_xor(sm, 32);
        }
#pragma unroll 1
        for (int sb = 0; sb < 2; ++sb) {
        const int lrow2 = pass * 16 + F.wave * 2 + sb;
        float lg[16];
#pragma unroll
        for (int e = 0; e < 16; ++e) lg[e] = __builtin_bit_cast(float, __builtin_amdgcn_readlane(__builtin_bit_cast(int, lgv), 16 * sb + e));
        float mx = lg[0];
#pragma unroll
        for (int e = 1; e < 16; ++e) mx = fmaxf(mx, lg[e]);
        float aff[16], bi[16]; float sum = 0.f;
#pragma unroll
        for (int e = 0; e < 16; ++e) { aff[e] = __expf(lg[e] - mx); sum += aff[e]; }
        const float inv = 1.f / sum;
#pragma unroll
        for (int e = 0; e < 16; ++e) { aff[e] *= inv; bi[e] = aff[e] + rb[e]; }
        float gs[4];
#pragma unroll
        for (int g = 0; g < 4; ++g) { const float a0 = bi[4 * g], a1 = bi[4 * g + 1], a2 = bi[4 * g + 2], a3 = bi[4 * g + 3];
            const float t1 = fmaxf(a0, a1), t2 = fminf(a0, a1), u1 = fmaxf(a2, a3), u2 = fminf(a2, a3);
            gs[g] = fmaxf(t1, u1) + fmaxf(fminf(t1, u1), fmaxf(t2, u2)); }
        int best = 0; float bv = gs[0];
#pragma unroll
        for (int g = 1; g < 4; ++g) if (gs[g] > bv) { bv = gs[g]; best = g; }
        float cb_[4], ca_[4];
#pragma unroll
        for (int i = 0; i < 4; ++i) { cb_[i] = best == 0 ? bi[i] : best == 1 ? bi[4 + i] : best == 2 ? bi[8 + i] : bi[12 + i];
                                      ca_[i] = best == 0 ? aff[i] : best == 1 ? aff[4 + i] : best == 2 ? aff[8 + i] : aff[12 + i]; }
        int i0 = 0; float b0 = cb_[0];
#pragma unroll
        for (int i = 1; i < 4; ++i) if (cb_[i] > b0) { b0 = cb_[i]; i0 = i; }
        int i1 = -1; float b1 = -3.0e38f;
#pragma unroll
        for (int i = 0; i < 4; ++i) if (i != i0 && cb_[i] > b1) { b1 = cb_[i]; i1 = i; }
        const float w0 = i0 == 0 ? ca_[0] : i0 == 1 ? ca_[1] : i0 == 2 ? ca_[2] : ca_[3];
        const float w1 = i1 == 0 ? ca_[0] : i1 == 1 ? ca_[1] : i1 == 2 ? ca_[2] : ca_[3];
        const float ws_ = 1.f / (w0 + w1);
        if (lane == 0) { ae[2 * lrow2] = best * 4 + i0; ae[2 * lrow2 + 1] = best * 4 + i1; aw[2 * lrow2] = w0 * ws_; aw[2 * lrow2 + 1] = w1 * ws_; }
        }
      }
      __syncthreads();
      if (DRY) continue;
      if (F.tid < NE) { int c = 0; for (int i = 0; i < 128; ++i) c += (ae[i] == F.tid) ? 1 : 0;
          base[F.tid] = c ? (int)__hip_atomic_fetch_add(cnt + F.tid * 64, (unsigned)c, RLX_AGENT) : 0; }
      __syncthreads();
      if (F.tid < 128) { const int e = ae[F.tid]; int rk = 0; for (int i = 0; i < F.tid; ++i) rk += (ae[i] == e) ? 1 : 0;
          const int pos = base[e] + rk; const unsigned m = (unsigned)(ch * 64 + (F.tid >> 1));
          LIST[(size_t)e * T + pos] = m * 2u + (unsigned)(F.tid & 1); LW[(size_t)e * T + pos] = aw[F.tid]; }
      __syncthreads();
    }
}
template <int L, bool DRY = false>
__device__ __forceinline__ void p_ln2(Frame& F) {
    bf16* RES = (bf16*)(F.wsp() + WS_XB); bf16* U = (bf16*)(F.wsp() + WS_U); float* OUT = F.outp();
    bf16* RESO = DRY ? (bf16*)(F.wsp() + WS_R1) : RES; if (DRY) { U = (bf16*)(F.wsp() + WS_H); }
    const bf16* Y0 = (const bf16*)(F.wsp() + WS_Y0); const bf16* Y1 = (const bf16*)(F.wsp() + WS_Y1);
    const float* MOD = (const float*)(F.wsp() + WS_MOD) + (size_t)L * 4 * 6144;
    const float* MODN = (const float*)(F.wsp() + WS_MOD) + (size_t)1 * 4 * 6144;
    const int lane = F.lane;
    for (int m = F.gw; m < T; m += F.NGW) {
        const int b = m >> 12;
        f32x4 v[4];
#pragma unroll
        for (int j = 0; j < 4; ++j) { const int col = 4 * lane + 256 * j;
            const f32x4 x = ld_bf4(RES + (size_t)m * DM + col);
            const u32x2 a = *(const u32x2*)(Y0 + (size_t)m * DM + col), c = *(const u32x2*)(Y1 + (size_t)m * DM + col);
            const f32x4 y = (f32x4){bflo(a.x) + bflo(c.x), bfhi(a.x) + bfhi(c.x), bflo(a.y) + bflo(c.y), bfhi(a.y) + bfhi(c.y)};
            v[j] = x * ALPHA + *(const f32x4*)(MOD + b * 6144 + 5 * 1024 + col) * y; }
        ln_row(v, F.inp(I_LNG) + (L * 2 + 1) * DM, F.inp(I_LNB) + (L * 2 + 1) * DM, lane);
#pragma unroll
        for (int j = 0; j < 4; ++j) { const int col = 4 * lane + 256 * j;
            if (L == 1) *(f32x4*)(OUT + (size_t)m * DM + col) = v[j];
            if (L == 0) { st_bf4(RESO + (size_t)m * DM + col, v[j]);
                st_bf4(U + (size_t)m * DM + col, v[j] * (*(const f32x4*)(MODN + b * 6144 + 1024 + col) + 1.0f) + *(const f32x4*)(MODN + b * 6144 + col)); } }
    }
}

__device__ __forceinline__ void moe_tables(Frame& F, int L) {
    LAS int* tb = (LAS int*)(F.lds + MISC_OFF + 128); LAS int* cn = tb + 20;
    __syncthreads();
    if (F.tid == 0) { int acc = 0; for (int e = 0; e < NE; ++e) { const int c = (int)__hip_atomic_load(F.ctlp() + CW_CNT + L * 1024 + e * 64, RLX_AGENT); cn[e] = c; tb[e] = acc; acc += (c + 255) >> 8; } tb[NE] = acc; }
    __syncthreads();
}
struct ARowMoe { const bf16* U; const unsigned* list; int rbase, cnt;
    __device__ __forceinline__ const bf16* operator()(int r) const { const int pos = r - rbase; const unsigned tok = pos < cnt ? (list[pos] >> 1) : 0u; return U + (size_t)tok * DM; } };
struct EpY { bf16* Y; const unsigned* list; const float* lw; int rbase, cnt;
    __device__ __forceinline__ void operator()(int r, int n, f32x4 v) const { const int pos = r - rbase; if (pos < cnt) { const unsigned ts = list[pos]; const float w = lw[pos];
        st_bf4(Y + (size_t)(ts & 1u) * ((size_t)T * DM) + (size_t)(ts >> 1) * DM + n, v * w); } } };
template <int L>
__device__ __forceinline__ void p_moe_gu(Frame& F) {
    moe_tables(F, L);
    LAS int* tb = (LAS int*)(F.lds + MISC_OFF + 128); LAS int* cn = tb + 20;
    const unsigned* LIST = (const unsigned*)(F.wsp() + WS_LIST) + (size_t)L * NE * T;
    const int total = tb[NE] * 4 * 16;
    for (int it = F.gw; it < total; it += F.NGW) {
        const int ni = it & 15, mt = it >> 4; int e = 0; while (tb[e + 1] * 4 <= mt) ++e;
        const ARowMoe ar{(const bf16*)(F.wsp() + WS_U), LIST + (size_t)e * T, tb[e] * 256, cn[e]};
        const EpSiluPair ep{(bf16*)(F.wsp() + WS_H), FF};
        const int pn = ni >> 2, q = ni & 3;
        gemm_wave_tile<true>(ar, (const bf16*)(F.wsp() + WS_WGU) + (size_t)(L * NE + e) * 1024 * 1024 + (size_t)(pn * 256 + q * 32) * 1024, 1024, mt * 64, pn * 128 + q * 32, ep, F.lane);
    }
}
template <int L>
__device__ __forceinline__ void p_moe_down(Frame& F) {
    moe_tables(F, L);
    LAS int* tb = (LAS int*)(F.lds + MISC_OFF + 128); LAS int* cn = tb + 20;
    const unsigned* LIST = (const unsigned*)(F.wsp() + WS_LIST) + (size_t)L * NE * T; const float* LW = (const float*)(F.wsp() + WS_LW) + (size_t)L * NE * T;
    const int total = tb[NE] * 4 * 16;
    for (int it = F.gw; it < total; it += F.NGW) {
        const int ni = it & 15, mt = it >> 4; int e = 0; while (tb[e + 1] * 4 <= mt) ++e;
        const ARowPlain ar{(const bf16*)(F.wsp() + WS_H), FF};
        const EpY ep{(bf16*)(F.wsp() + WS_Y0), LIST + (size_t)e * T, LW + (size_t)e * T, tb[e] * 256, cn[e]};
        gemm_wave_tile<false>(ar, (const bf16*)(F.wsp() + WS_WDN) + (size_t)(L * NE + e) * 1024 * 512 + (size_t)(ni * 64) * 512, 512, mt * 64, ni * 64, ep, F.lane);
    }
}

struct ARowCmp { const bf16* KVi; __device__ __forceinline__ const bf16* operator()(int R) const { return KVi + ((size_t)(R >> 8) * KVROWS + (size_t)(R & 255) * 16) * 64; } };
__device__ __forceinline__ float gelu_tanh(float x) { const float u = 0.7978845608028654f * (x + 0.044715f * x * x * x); const float e = __expf(2.f * u); const float th = 1.f - 2.f / (e + 1.f); return 0.5f * x * (1.f + th); }
__device__ __forceinline__ void p_cmp_finish(Frame& F) {
    LAS float* w2s = (LAS float*)F.lds;
    LAS float* hd = (LAS float*)(F.lds + 65536 + F.wave * 4096);
    const float* TB = (const float*)(F.wsp() + WS_TB); const float* PETP = (const float*)(F.wsp() + WS_PETP);
    const int lane = F.lane;
    for (int base = blockIdx.x * 32; base < 2 * 16 * 256; base += gridDim.x * 32) {
        const int i = base >> 12;
        __syncthreads();
        for (int u = F.tid; u < 4096; u += 512) *(LAS f32x4*)(w2s + 4 * u) = *(const f32x4*)(F.inp(I_CW2) + (size_t)i * 256 * 64 + 4 * u);
        const int it0 = base + F.wave * 4, bh = (it0 >> 8) & 15, n0 = it0 & 255, c = 4 * lane;
        f32x4 pe = *(const f32x4*)(F.inp(I_CB1) + i * 256 + c);
#pragma unroll
        for (int k = 0; k < 32; ++k) pe += *(const f32x4*)(PETP + (k * 2 + i) * 256 + c);
#pragma unroll
        for (int r = 0; r < 4; ++r) { const int n = n0 + r;
            f32x4 h = (f32x4){0.f, 0.f, 0.f, 0.f};
            if (n < 255) { const float* r0 = TB + ((size_t)i * 4096 + bh * 256 + n) * 512; h = *(const f32x4*)(r0 + c) + *(const f32x4*)(r0 + 512 + 256 + c) + pe; }
#pragma unroll
            for (int q = 0; q < 4; ++q) hd[(c + q) * 4 + r] = gelu_tanh(h[q]); }
        __syncthreads();
        const float b2 = F.inp(I_CB2)[i * 64 + lane];
        float a0 = b2, a1 = b2, a2 = b2, a3 = b2;
#pragma unroll 8
        for (int cc = 0; cc < 256; ++cc) { const float w = w2s[cc * 64 + lane]; const f32x4 h4 = *(const LAS f32x4*)(hd + cc * 4);
            a0 += h4[0] * w; a1 += h4[1] * w; a2 += h4[2] * w; a3 += h4[3] * w; }
        const float av[4] = {a0, a1, a2, a3};
#pragma unroll
        for (int r = 0; r < 4; ++r) { const int n = n0 + r;
            bf16* dst = (bf16*)(F.wsp() + (i ? WS_VC : WS_KC)) + (size_t)bh * 256 * 64 + (size_t)(n >> 6) * 4096 + (i ? vfrag_off(n & 63, lane) : kfrag_off(n & 63, lane));
            *dst = (n == 255) ? (bf16)0 : (bf16)f2bf(av[r]); }
    }
}

__device__ __forceinline__ void score_tile(const bf16* krow, const LAS float* qs, float (&s)[4]) {
    s[0] = s[1] = s[2] = s[3] = 0.f;
#pragma unroll
    for (int c = 0; c < 8; ++c) { const u32x4 kv = *(const u32x4*)(krow + 8 * c);
#pragma unroll
        for (int w = 0; w < 4; ++w) { const f32x4 qa = *(const LAS f32x4*)(qs + (8 * c + 2 * w) * 4), qb = *(const LAS f32x4*)(qs + (8 * c + 2 * w + 1) * 4);
            const float ka = bflo(kv[w]), kb = bfhi(kv[w]);
            s[0] += ka * qa[0] + kb * qb[0]; s[1] += ka * qa[1] + kb * qb[1]; s[2] += ka * qa[2] + kb * qb[2]; s[3] += ka * qa[3] + kb * qb[3]; } }
}
__device__ __forceinline__ void attend_tile(const bf16* Kt, const bf16* Vt, bool valid, const LAS float* qs, LAS float* pbuf, float (&mr)[4], float (&l)[4], float (&o)[4], int lane) {
    float s[4]; score_tile(Kt + (size_t)lane * 64, qs, s);
    f32x4 p4;
#pragma unroll
    for (int g = 0; g < 4; ++g) {
        const float sg = valid ? s[g] : -INFINITY; const float tm = wave_max(sg); const float mn = fmaxf(mr[g], tm);
        const float mref = (mn == -INFINITY) ? 0.f : mn;
        const float alpha = __builtin_amdgcn_exp2f(mr[g] - mref); const float p = valid ? __builtin_amdgcn_exp2f(sg - mref) : 0.f;
        l[g] = l[g] * alpha + wave_sum(p); o[g] *= alpha; mr[g] = mn; p4[g] = p;
    }
    LDS_WAIT(); asm volatile("" ::: "memory");
    *(LAS f32x4*)(pbuf + lane * 4) = p4;
    LDS_WAIT(); asm volatile("" ::: "memory");
#pragma unroll 8
    for (int k = 0; k < 64; ++k) { const f32x4 pk = *(const LAS f32x4*)(pbuf + k * 4); const float vv = bf2f(Vt[(size_t)k * 64 + lane]);
        o[0] += pk[0] * vv; o[1] += pk[1] * vv; o[2] += pk[2] * vv; o[3] += pk[3] * vv; }
    LDS_WAIT(); asm volatile("" ::: "memory");
}
__device__ __forceinline__ void p_attn_simple(Frame& F) {
    LAS float* qs = (LAS float*)(F.lds + F.wave * 16384);
    LAS float* pbuf = qs + 256;
    LAS float* psum = pbuf + 1024;
    const bf16* Q = (const bf16*)(F.wsp() + WS_Q); const float* GATE = (const float*)(F.wsp() + WS_GATE); bf16* O = (bf16*)(F.wsp() + WS_O);
    const bf16* KVb = (const bf16*)(F.wsp() + WS_KV);
    const int lane = F.lane;
    for (int it = F.gw; it < 16 * SEQ; it += F.NGW) {
        const int bh = it & 15, t = it >> 4, b = bh >> 2, hk = bh & 3, m = b * SEQ + t;
        LDS_WAIT(); asm volatile("" ::: "memory");
        { f32x4 q4; for (int g = 0; g < 4; ++g) q4[g] = bf2f(Q[(size_t)m * DM + (hk * 4 + g) * 64 + lane]); *(LAS f32x4*)(qs + lane * 4) = q4; }
        LDS_WAIT(); asm volatile("" ::: "memory");
        const bf16* KC = (const bf16*)(F.wsp() + WS_KC) + (size_t)bh * 256 * 64; const bf16* VC = (const bf16*)(F.wsp() + WS_VC) + (size_t)bh * 256 * 64;
        const int nv = t >= 31 ? ((t - 31) >> 4) + 1 : 0;
        float sc[4][4];
#pragma unroll
        for (int i = 0; i < 4; ++i) { float s[4] = {0.f, 0.f, 0.f, 0.f}; if (64 * i < nv) score_tile(KC + (size_t)(64 * i + lane) * 64, qs, s);
            const bool v = (64 * i + lane) < nv;
#pragma unroll
            for (int g = 0; g < 4; ++g) sc[i][g] = v ? s[g] : -INFINITY; }
        float oc[4];
#pragma unroll
        for (int g = 0; g < 4; ++g) {
            const float mx = wave_max(fmaxf(fmaxf(sc[0][g], sc[1][g]), fmaxf(sc[2][g], sc[3][g]))); const float mref = (mx == -INFINITY) ? 0.f : mx;
            float e[4]; float ls = 0.f;
#pragma unroll
            for (int i = 0; i < 4; ++i) { e[i] = __builtin_amdgcn_exp2f(sc[i][g] - mref); ls += e[i]; }
            const float inv = 1.f / fmaxf(wave_sum(ls), 1e-30f);
#pragma unroll
            for (int i = 0; i < 4; ++i) sc[i][g] = e[i] * inv;
        }
#pragma unroll
        for (int i = 0; i < 4; ++i) { *(LAS f32x4*)(pbuf + (64 * i + lane) * 4) = (f32x4){sc[i][0], sc[i][1], sc[i][2], sc[i][3]};
            psum[64 * i + lane + 1] = (sc[i][0] + sc[i][1]) + (sc[i][2] + sc[i][3]); }
        if (lane == 0) psum[0] = 0.f;
        LDS_WAIT(); asm volatile("" ::: "memory");
        oc[0] = oc[1] = oc[2] = oc[3] = 0.f;
        for (int n = 0; n < nv; ++n) { const f32x4 pk = *(const LAS f32x4*)(pbuf + n * 4); const float vv = bf2f(VC[(size_t)n * 64 + lane]);
            oc[0] += pk[0] * vv; oc[1] += pk[1] * vv; oc[2] += pk[2] * vv; oc[3] += pk[3] * vv; }
        const float imp = 0.5f * psum[4 * lane] + psum[4 * lane + 1] + psum[4 * lane + 2] + psum[4 * lane + 3] + 0.5f * psum[4 * lane + 4];
        const int cur = t >> 6;
        const bool allowed = lane <= cur, forced = allowed && (lane == 0 || lane == cur || lane == cur - 1);
        const float score = forced ? 1e9f : (allowed ? imp : -1e30f);
        int rank = 0;
#pragma unroll
        for (int j = 0; j < 64; ++j) { const float sj = __shfl(score, j); rank += (sj > score || (sj == score && j < lane)) ? 1 : 0; }
        const unsigned long long mask = __ballot(rank < 16 && score > -0.5e30f);
        LDS_WAIT(); asm volatile("" ::: "memory");
        const bf16* KS = KVb + 2 * KVBUF_ELEMS + (size_t)bh * KVROWS * 64; const bf16* VS = KVb + 3 * KVBUF_ELEMS + (size_t)bh * KVROWS * 64;
        float ms[4] = {-INFINITY, -INFINITY, -INFINITY, -INFINITY}, ls[4] = {0.f, 0.f, 0.f, 0.f}, os[4] = {0.f, 0.f, 0.f, 0.f};
        for (unsigned long long mk = mask; mk; mk &= mk - 1) { const int j = __builtin_ctzll(mk);
            attend_tile(KS + (size_t)j * 64 * 64, VS + (size_t)j * 64 * 64, (64 * j + lane) <= t, qs, pbuf, ms, ls, os, lane); }
        const bf16* KW = KVb + 4 * KVBUF_ELEMS + (size_t)bh * KVROWS * 64; const bf16* VW = KVb + 5 * KVBUF_ELEMS + (size_t)bh * KVROWS * 64;
        float mw[4] = {-INFINITY, -INFINITY, -INFINITY, -INFINITY}, lw[4] = {0.f, 0.f, 0.f, 0.f}, ow[4] = {0.f, 0.f, 0.f, 0.f};
        const int lo = t - 511 > 0 ? t - 511 : 0;
        for (int j = lo >> 6; j <= (t >> 6); ++j) { const int pos = 64 * j + lane;
            attend_tile(KW + (size_t)j * 64 * 64, VW + (size_t)j * 64 * 64, pos >= lo && pos <= t, qs, pbuf, mw, lw, ow, lane); }
#pragma unroll
        for (int g = 0; g < 4; ++g) { const float* gp = GATE + (size_t)m * 48 + (hk * 4 + g) * 3;
            const float o = gp[0] * oc[g] + gp[1] * os[g] / fmaxf(ls[g], 1e-30f) + gp[2] * ow[g] / fmaxf(lw[g], 1e-30f);
            O[(size_t)m * DM + (hk * 4 + g) * 64 + lane] = (bf16)f2bf(o); }
    }
}

struct SchedCmp { const char* KV; const char* W1C; int G, c;
    __device__ __forceinline__ bool next(int it, pg8::Unit& u) const { const int L = it * G + c; if (c < 0 || L >= 64) return false;
        const int i = L >> 5, pm = (L >> 1) & 15, pn = L & 1;
        u.A = KV + ((size_t)i * KVBUF_ELEMS + (size_t)pm * KVROWS * 64) * 2; u.B = W1C + ((size_t)i * 512 * 1024 + (size_t)pn * 256 * 1024) * 2;
        u.row0 = i * 4096 + pm * 256; u.col0 = pn * 256; u.e = i; u.pos0 = 0; u.cnt = 0; return true; }
    __device__ __forceinline__ void voff(const pg8::Unit&, const int (&R)[2], const int (&C)[2], int K_, unsigned (&v)[2][2]) const { pg8::voff_plain(R, C, K_, v); }
};
struct SchedKVQG { const char* A0; const char* B0; const char* A1; const char* B1; int G, c, Lbase, Lend;
    __device__ __forceinline__ bool next(int it, pg8::Unit& u) const { const int L = Lbase + it * G + c; if (c < 0 || L >= Lend) return false;
        const int sec = L >= 384 ? 1 : 0, l = sec ? L - 384 : L, nn = sec ? 5 : 6, pm = l / nn, pn = l % nn;
        u.A = (sec ? A1 : A0) + (size_t)pm * 256 * DM * 2; u.B = (sec ? B1 : B0) + (size_t)pn * 256 * DM * 2;
        u.row0 = pm * 256; u.col0 = pn * 256; u.e = sec; u.pos0 = 0; u.cnt = 0; return true; }
    __device__ __forceinline__ void voff(const pg8::Unit&, const int (&R)[2], const int (&C)[2], int K_, unsigned (&v)[2][2]) const { pg8::voff_plain(R, C, K_, v); }
};
struct SchedMoe { LAS int* tb; LAS int* cn; const unsigned* LIST; const char* Abase; const char* Bbase; size_t bstride; int K, nN, colmul, G, c; bool gather; int Lbase, Lend;
    __device__ __forceinline__ bool next(int it, pg8::Unit& u) const { const int L = Lbase + it * G + c; if (c < 0 || L >= Lend) return false;
        const int mt = L / nN, pn = L % nN; int e = 0; while (tb[e + 1] <= mt) ++e;
        u.A = gather ? Abase : Abase + (size_t)mt * 256 * K * 2; u.B = Bbase + (size_t)e * bstride + (size_t)pn * 256 * K * 2;
        u.row0 = mt * 256; u.col0 = pn * colmul; u.e = e; u.pos0 = (mt - tb[e]) * 256; u.cnt = cn[e]; return true; }
    __device__ __forceinline__ void voff(const pg8::Unit& u, const int (&R)[2], const int (&C)[2], int K_, unsigned (&v)[2][2]) const {
        if (!gather) { pg8::voff_plain(R, C, K_, v); return; }
        const unsigned* le = LIST + (size_t)u.e * T;
#pragma unroll
        for (int h = 0; h < 2; ++h)
#pragma unroll
            for (int i = 0; i < 2; ++i) { const int pos = u.pos0 + h * 128 + R[i]; const unsigned tok = pos < u.cnt ? (le[pos] >> 1) : 0u; v[h][i] = (tok * (unsigned)K_ + (unsigned)C[i]) * 2u; }
    }
};
struct EpHU { bf16* H; __device__ __forceinline__ void pair(const pg8::Unit&, int r, int ch, f32x4 a, f32x4 b) const {
    f32x4 s; for (int q = 0; q < 4; ++q) s[q] = silu_f(a[q]) * b[q]; st_bf4(H + (size_t)r * FF + ch, s); }
    __device__ __forceinline__ void pair8(const pg8::Unit&, int r, int ch, f32x4 a0, f32x4 a1, f32x4 b0, f32x4 b1) const {
    f32x4 s0, s1; for (int q = 0; q < 4; ++q) { s0[q] = silu_f(a0[q]) * b0[q]; s1[q] = silu_f(a1[q]) * b1[q]; } st_bf8(H + (size_t)r * FF + ch, s0, s1); } };
struct EpYU { bf16* Y; const unsigned* LIST; const float* LW;
    __device__ __forceinline__ void operator()(const pg8::Unit& u, int r, int n, f32x4 v) const { const int pos = u.pos0 + (r - u.row0);
        if (pos < u.cnt) { const unsigned ts = LIST[(size_t)u.e * T + pos]; const float w = LW[(size_t)u.e * T + pos];
            st_bf4(Y + (size_t)(ts & 1u) * ((size_t)T * DM) + (size_t)(ts >> 1) * DM + n, v * w); } }
    __device__ __forceinline__ void op8(const pg8::Unit& u, int r, int n, f32x4 a, f32x4 b) const { const int pos = u.pos0 + (r - u.row0);
        if (pos < u.cnt) { const unsigned ts = LIST[(size_t)u.e * T + pos]; const float w = LW[(size_t)u.e * T + pos];
            st_bf8(Y + (size_t)(ts & 1u) * ((size_t)T * DM) + (size_t)(ts >> 1) * DM + n, a * w, b * w); } } };
template <int L>
__device__ __forceinline__ void p_moe(Frame& F, const XcdBarrier& bar, bool with_barriers) {
    moe_tables(F, L);
    LAS int* tb = (LAS int*)(F.lds + MISC_OFF + 128); LAS int* cn = tb + 20;
    const int G = gridDim.x, bx = blockIdx.x, vcu = (G % 8 == 0) ? (bx % 8) * (G / 8) + bx / 8 : bx;
    const int nt = tb[NE], n128 = nt < 128 ? nt : 128, Wg = 4 * (nt - n128) < G / 2 ? 4 * (nt - n128) : G / 2;
    const int D2 = (4 * n128 < 2 * (G - Wg)) ? 4 * n128 : 2 * (G - Wg);
#pragma unroll 1
    for (int part = 1; part <= 3; ++part) {
        int gc = -1, gG = 1, gb = 0, ge = 0, dc = -1, dG = 1, db = 0, de = 0;
        if (part == 1) { gc = vcu; gG = G; gb = 0; ge = 4 * n128; }
        else if (part == 2) { if (vcu < Wg) { gc = vcu; gG = Wg; gb = 4 * n128; ge = 4 * nt; } else { dc = vcu - Wg; dG = G - Wg; db = 0; de = D2; } }
        else { dc = vcu; dG = G; db = D2; de = 4 * nt; }
        {
            const SchedMoe S{tb, cn, (const unsigned*)(F.wsp() + WS_LIST) + (size_t)L * NE * T, (const char*)(F.wsp() + WS_U), (const char*)(F.wsp() + WS_WGU) + (size_t)L * NE * 1024 * 1024 * 2, (size_t)1024 * 1024 * 2, 1024, 4, 128, gG, gc, true, gb, ge};
            typedef pg8::EpiWrap<EpHU, true, true> E_;
            pg8::gemm_phase<E_, SchedMoe, true, true>(F.lds, 1024, S, E_{{(bf16*)(F.wsp() + WS_H)}});
        }
        {
            const SchedMoe S{tb, cn, nullptr, (const char*)(F.wsp() + WS_H), (const char*)(F.wsp() + WS_WDN) + (size_t)L * NE * 1024 * 512 * 2, (size_t)1024 * 512 * 2, 512, 4, 256, dG, dc, false, db, de};
            typedef pg8::EpiWrap<EpYU, false, true> E_;
            pg8::gemm_phase<E_, SchedMoe, true, false>(F.lds, 512, S, E_{{(bf16*)(F.wsp() + WS_Y0), (const unsigned*)(F.wsp() + WS_LIST) + (size_t)L * NE * T, (const float*)(F.wsp() + WS_LW) + (size_t)L * NE * T}});
        }
        if (part < 3 && with_barriers) xcd_barrier(bar);
    }
}
typedef float f32x16 __attribute__((ext_vector_type(16)));
#define MFMA32(a, b, c) __builtin_amdgcn_mfma_f32_32x32x16_bf16(a, b, c, 0, 0, 0)
constexpr size_t WS_MASK = WS_GATE + 3 * MiB;
constexpr int STG_STRIDE = 68, STG_BYTES = 32 * STG_STRIDE * 4;
__device__ __forceinline__ int crow(int r, int hi) { return (r & 3) + 8 * (r >> 2) + 4 * hi; }
__device__ __forceinline__ unsigned cvtpk(float lo, float hi) { f32x2v v = {lo, hi}; bf16x2_t b = __builtin_convertvector(v, bf16x2_t); return __builtin_bit_cast(unsigned, b); }
__device__ __forceinline__ float partner32(float x, int hi) { auto rr = __builtin_amdgcn_permlane32_swap(__builtin_bit_cast(unsigned, x), __builtin_bit_cast(unsigned, x), false, false);
    return __builtin_bit_cast(float, hi ? rr[0] : rr[1]); }
__device__ __forceinline__ float max3f(float a, float b, float c) { float r; asm("v_max3_f32 %0, %1, %2, %3" : "=v"(r) : "v"(a), "v"(b), "v"(c)); return r; }
__device__ __forceinline__ float max2f(float a, float b) { float r; asm("v_max_f32_e32 %0, %1, %2" : "=v"(r) : "v"(a), "v"(b)); return r; }
__device__ __forceinline__ float rowmax32(f32x16& p0, f32x16& p1, int hi) {
    asm volatile("s_nop 15\n\ts_nop 7" : "+v"(p0), "+v"(p1));
    float a = max3f(p0[0], p0[1], p1[0]), b = max3f(p0[2], p0[3], p1[1]); a = max3f(a, p1[2], p1[3]);
#pragma unroll
    for (int r = 4; r < 16; r += 4) { a = max3f(a, p0[r], p0[r + 1]); b = max3f(b, p0[r + 2], p0[r + 3]); a = max3f(a, p1[r], p1[r + 1]); b = max3f(b, p1[r + 2], p1[r + 3]); }
    const float m = max2f(a, b);
    return max2f(m, partner32(m, hi));
}
typedef __amdgpu_buffer_rsrc_t rsrc_t;
__device__ __forceinline__ rsrc_t make_rsrc(const void* base, unsigned bytes) { return __builtin_amdgcn_make_buffer_rsrc((void*)base, 0, (int)bytes, 0x00020000); }
__device__ __forceinline__ void load_frag8(bf16x8 (&f)[8], rsrc_t rs, unsigned vo, unsigned so) {
#pragma unroll
    for (int i = 0; i < 8; ++i) f[i] = __builtin_bit_cast(bf16x8, __builtin_amdgcn_raw_buffer_load_b128(rs, vo + i * 1024, so, 0));
}
__device__ __forceinline__ void qk_tile(f32x16& p0, f32x16& p1, const bf16x8 (&kf)[8], const LAS bf16x8* qs, const float cinit) {
    bf16x8 qr[4];
#pragma unroll
    for (int d0 = 0; d0 < 4; ++d0) qr[d0] = qs[d0 * 64];
    f32x16 c;
#pragma unroll
    for (int r = 0; r < 16; ++r) c[r] = cinit;
    p0 = MFMA32(kf[0], qr[0], c); p1 = MFMA32(kf[4], qr[0], c);
#pragma unroll
    for (int d0 = 1; d0 < 4; ++d0) { p0 = MFMA32(kf[d0], qr[d0], p0); p1 = MFMA32(kf[4 + d0], qr[d0], p1); }
}
__device__ __forceinline__ void qk_tile_lo(f32x16& p0, f32x16& p1, rsrc_t rs, unsigned vo, unsigned so, const LAS bf16x8* qs, const float cinit) {
    bf16x8 qr[4];
#pragma unroll
    for (int d0 = 0; d0 < 4; ++d0) qr[d0] = qs[d0 * 64];
#pragma unroll
    for (int r = 0; r < 16; ++r) { p0[r] = cinit; p1[r] = cinit; }
    { bf16x8 kf[4];
#pragma unroll
      for (int d0 = 0; d0 < 4; ++d0) kf[d0] = __builtin_bit_cast(bf16x8, __builtin_amdgcn_raw_buffer_load_b128(rs, vo + d0 * 1024, so, 0));
#pragma unroll
      for (int d0 = 0; d0 < 4; ++d0) p0 = MFMA32(kf[d0], qr[d0], p0); }
    asm volatile("" : "+v"(p0) :: "memory");
    { bf16x8 kf[4];
#pragma unroll
      for (int d0 = 0; d0 < 4; ++d0) kf[d0] = __builtin_bit_cast(bf16x8, __builtin_amdgcn_raw_buffer_load_b128(rs, vo + (4 + d0) * 1024, so, 0));
#pragma unroll
      for (int d0 = 0; d0 < 4; ++d0) p1 = MFMA32(kf[d0], qr[d0], p1); }
}
__device__ __forceinline__ void mask_tile(f32x16& p0, f32x16& p1, int lo, int lim, int hi) {
#pragma unroll
    for (int r = 0; r < 16; ++r) { const int k0 = crow(r, hi);
        if (!(k0 > lo && k0 <= lim)) p0[r] = -INFINITY;
        if (!(k0 + 32 > lo && k0 + 32 <= lim)) p1[r] = -INFINITY; }
}
__device__ __forceinline__ void pack_p(bf16x8 (&pa)[4], const f32x16& p0, const f32x16& p1) {
    u32x4 w0, w1, w2, w3;
#pragma unroll
    for (int q = 0; q < 4; ++q) { w0[q] = cvtpk(p0[2 * q], p0[2 * q + 1]); w1[q] = cvtpk(p0[8 + 2 * q], p0[9 + 2 * q]);
                                  w2[q] = cvtpk(p1[2 * q], p1[2 * q + 1]); w3[q] = cvtpk(p1[8 + 2 * q], p1[9 + 2 * q]); }
    pa[0] = __builtin_bit_cast(bf16x8, w0); pa[1] = __builtin_bit_cast(bf16x8, w1); pa[2] = __builtin_bit_cast(bf16x8, w2); pa[3] = __builtin_bit_cast(bf16x8, w3);
}
__device__ __forceinline__ void pv_tile(f32x16& o0, f32x16& o1, const bf16x8 (&pa)[4], const bf16x8 (&vf)[8]) {
#pragma unroll
    for (int ks = 0; ks < 4; ++ks) { o0 = MFMA32(pa[ks], vf[ks], o0); o1 = MFMA32(pa[ks], vf[4 + ks], o1); }
}
struct Sm { float mhat, l; f32x16 o0, o1, ol; };
__device__ __forceinline__ void sm_init(Sm& st) { st.mhat = 0.f; st.l = 0.f;
#pragma unroll
    for (int r = 0; r < 16; ++r) { st.o0[r] = 0.f; st.o1[r] = 0.f; st.ol[r] = 0.f; } }
__device__ __forceinline__ void sm_tile(Sm& st, f32x16& s0, f32x16& s1, bool first, const bf16x8 (&vf)[8], LAS float* wsf, int r32, int hi) {
    const float rm = rowmax32(s0, s1, hi);
    const bool need = first || (__any(rm > 8.0f) != 0);
    if (need) {
        const float dl = first ? ((rm == -INFINITY) ? 0.f : rm) : fmaxf(rm, 0.f);
        st.mhat += dl;
#pragma unroll
        for (int r = 0; r < 16; ++r) { s0[r] -= dl; s1[r] -= dl; }
        if (!first) {
            const float f = __builtin_amdgcn_exp2f(-dl);
            LDS_WAIT(); asm volatile("" ::: "memory");
            if (hi == 0) wsf[r32] = f;
            LDS_WAIT(); asm volatile("" ::: "memory");
#pragma unroll
            for (int G = 0; G < 4; ++G) { const f32x4 ff = *(const LAS f32x4*)(wsf + 8 * G + 4 * hi);
#pragma unroll
                for (int q = 0; q < 4; ++q) { st.o0[4 * G + q] *= ff[q]; st.o1[4 * G + q] *= ff[q]; st.ol[4 * G + q] *= ff[q]; } }
            LDS_WAIT(); asm volatile("" ::: "memory");
        }
    }
#pragma unroll
    for (int r = 0; r < 16; ++r) { s0[r] = __builtin_amdgcn_exp2f(s0[r]); s1[r] = __builtin_amdgcn_exp2f(s1[r]); }
    bf16x8 pa[4]; pack_p(pa, s0, s1);
    const bf16x8 ones = (bf16x8){0x3F80, 0x3F80, 0x3F80, 0x3F80, 0x3F80, 0x3F80, 0x3F80, 0x3F80};
#pragma unroll
    for (int ks = 0; ks < 4; ++ks) { st.o0 = MFMA32(pa[ks], vf[ks], st.o0); st.o1 = MFMA32(pa[ks], vf[4 + ks], st.o1); st.ol = MFMA32(pa[ks], ones, st.ol); }
}
template <bool NORM>
__device__ __forceinline__ void flush_branch(const f32x16& o0, const f32x16& o1, const f32x16& ol, const float* GATE, bf16* O, int m0, int hq, int br, bool accumulate,
                                             LAS float* stg, int lane) {
    asm volatile("" : "+v"(lane));
    const int r32 = lane & 31, hi = lane >> 5;
    LDS_WAIT(); asm volatile("" ::: "memory");
#pragma unroll
    for (int r = 0; r < 16; ++r) { const float iv = NORM ? __builtin_amdgcn_rcpf(fmaxf(ol[r], 1e-30f)) : 1.f;
        stg[crow(r, hi) * STG_STRIDE + r32] = o0[r] * iv; stg[crow(r, hi) * STG_STRIDE + 32 + r32] = o1[r] * iv; }
    LDS_WAIT(); asm volatile("" ::: "memory");
#pragma unroll
    for (int i = 0; i < 4; ++i) { const int row = i * 8 + (lane >> 3), ch = lane & 7;
        const f32x4 a = *(const LAS f32x4*)(stg + row * STG_STRIDE + ch * 8), b = *(const LAS f32x4*)(stg + row * STG_STRIDE + ch * 8 + 4);
        const float sc = GATE[(size_t)(m0 + row) * 48 + hq * 3 + br];
        bf16* op = O + (size_t)(m0 + row) * DM + hq * 64 + ch * 8;
        f32x4 x = a * sc, y = b * sc;
        if (accumulate) { const u32x4 old = *(const u32x4*)op; x += (f32x4){bflo(old.x), bfhi(old.x), bflo(old.y), bfhi(old.y)}; y += (f32x4){bflo(old.z), bfhi(old.z), bflo(old.w), bfhi(old.w)}; }
        u32x4 w; w.x = pk2(x[0], x[1]); w.y = pk2(x[2], x[3]); w.z = pk2(y[0], y[1]); w.w = pk2(y[2], y[3]);
        *(u32x4*)op = w; }
    LDS_WAIT(); asm volatile("" ::: "memory");
}
__device__ __forceinline__ void load_q(LAS bf16x8* qs, const bf16* Q, int m, int hq, int hi) {
    LDS_WAIT(); asm volatile("" ::: "memory");
#pragma unroll
    for (int d0 = 0; d0 < 4; ++d0) qs[d0 * 64] = *(const bf16x8*)(Q + (size_t)m * DM + hq * 64 + d0 * 16 + hi * 8);
    LDS_WAIT(); asm volatile("" ::: "memory");
}
__device__ __forceinline__ void p_attn_cmp(Frame& F) {
    LAS float* stg = (LAS float*)(F.lds + F.wave * 16384); LAS float* wsf = stg + 32 * STG_STRIDE;
    const bf16* Q = (const bf16*)(F.wsp() + WS_Q); const float* GATE = (const float*)(F.wsp() + WS_GATE); bf16* O = (bf16*)(F.wsp() + WS_O);
    unsigned long long* MASK = (unsigned long long*)(F.wsp() + WS_MASK);
    for (int it = F.gw; it < 16 * 128; it += F.NGW) {
        const int bh = it >> 7, blk = 127 - (it & 127), b = bh >> 2, hk = bh & 3, m0 = b * SEQ + blk * 32;
        const rsrc_t rs = make_rsrc(F.wsp() + WS_KC, 1u << 20);
        const unsigned soK = (unsigned)bh * 32768u, soV = 524288u + (unsigned)bh * 32768u;
        const int nvmax = ((blk * 32) >> 4) + 1, ntc = (nvmax + 63) >> 6;
        float mref0 = 0.f, mref1 = 0.f, mref2 = 0.f, mref3 = 0.f, inv0 = 0.f, inv1 = 0.f, inv2 = 0.f, inv3 = 0.f;
#pragma unroll 1
        for (int g = 0; g < 4; ++g) {
            int lane = F.lane; asm volatile("" : "+v"(lane));
            const int r32 = lane & 31, hi = lane >> 5, t = blk * 32 + r32, nvr = t >= 31 ? ((t - 31) >> 4) + 1 : 0;
            LAS bf16x8* qr = (LAS bf16x8*)(wsf + 64) + lane; load_q(qr, Q, m0 + r32, hk * 4 + g, hi);
            float mrun = -INFINITY, l = 0.f;
#pragma unroll 1
            for (int i = 0; i < ntc; ++i) {
                f32x16 s0, s1; qk_tile_lo(s0, s1, rs, (unsigned)lane * 16u, soK + (unsigned)i * 8192u, qr, 0.f); mask_tile(s0, s1, -1, nvr - 1 - 64 * i, hi);
                const float rm = rowmax32(s0, s1, hi), mn = fmaxf(mrun, rm), mr = (mn == -INFINITY) ? 0.f : mn;
                float sum = 0.f;
#pragma unroll
                for (int r = 0; r < 16; ++r) sum += __builtin_amdgcn_exp2f(s0[r] - mr) + __builtin_amdgcn_exp2f(s1[r] - mr);
                l = l * __builtin_amdgcn_exp2f(mrun - mr) + sum; mrun = mn;
            }
            const float ltot = l + partner32(l, hi);
            const float iv = 1.f / fmaxf(ltot, 1e-30f), mr_ = (mrun == -INFINITY) ? 0.f : mrun;
            if (g == 0) { inv0 = iv; mref0 = mr_; } else if (g == 1) { inv1 = iv; mref1 = mr_; } else if (g == 2) { inv2 = iv; mref2 = mr_; } else { inv3 = iv; mref3 = mr_; }
        }
        {
            float imp[32];
#pragma unroll
            for (int k = 0; k < 32; ++k) imp[k] = 0.f;
#pragma unroll 1
            for (int g = 0; g < 4; ++g) {
                int lane = F.lane; asm volatile("" : "+v"(lane));
                const int r32 = lane & 31, hi = lane >> 5, t = blk * 32 + r32, nvr = t >= 31 ? ((t - 31) >> 4) + 1 : 0;
                LAS bf16x8* qr = (LAS bf16x8*)(wsf + 64) + lane; load_q(qr, Q, m0 + r32, hk * 4 + g, hi);
                const float invg = g == 0 ? inv0 : g == 1 ? inv1 : g == 2 ? inv2 : inv3, mg = g == 0 ? mref0 : g == 1 ? mref1 : g == 2 ? mref2 : mref3;
#pragma unroll
                for (int i = 0; i < 4; ++i) if (i < ntc) {
                    asm volatile("" ::: "memory");
                    f32x16 s0, s1; qk_tile_lo(s0, s1, rs, (unsigned)lane * 16u, soK + (unsigned)i * 8192u, qr, -mg); mask_tile(s0, s1, -1, nvr - 1 - 64 * i, hi);
#pragma unroll
                    for (int r = 0; r < 16; ++r) { s0[r] = __builtin_amdgcn_exp2f(s0[r]) * invg; s1[r] = __builtin_amdgcn_exp2f(s1[r]) * invg; }
#pragma unroll
                    for (int G = 0; G < 4; ++G) {
                        { const int kq = 8 * i + G; const float e = s0[4 * G + 3], pe = partner32(e, hi);
                          imp[kq] += (s0[4 * G] + s0[4 * G + 1]) + s0[4 * G + 2] + 0.5f * e + (hi ? 0.5f * pe : 0.f);
                          if (kq + 1 < 32) imp[kq + 1] += hi ? 0.f : 0.5f * pe; }
                        { const int kq = 8 * i + 4 + G; const float e = s1[4 * G + 3], pe = partner32(e, hi);
                          imp[kq] += (s1[4 * G] + s1[4 * G + 1]) + s1[4 * G + 2] + 0.5f * e + (hi ? 0.5f * pe : 0.f);
                          if (kq + 1 < 32) imp[kq + 1] += hi ? 0.f : 0.5f * pe; }
                    }
                }
            }
            int lane = F.lane; asm volatile("" : "+v"(lane));
            const int r32 = lane & 31, hi = lane >> 5, cur = (blk * 32 + r32) >> 6;
            LDS_WAIT(); asm volatile("" ::: "memory");
#pragma unroll
            for (int k = 0; k < 32; ++k) { const int j = 2 * k + hi; const bool allowed = j <= cur, forced = allowed && (j == 0 || j == cur || j == cur - 1);
                stg[r32 * STG_STRIDE + j] = forced ? 1e9f : (allowed ? imp[k] : -1e30f); }
            LDS_WAIT(); asm volatile("" ::: "memory");
        }
        {
            int lane = F.lane; asm volatile("" : "+v"(lane));
            unsigned long long mymask = 0ull;
#pragma unroll 1
            for (int tok = 0; tok < 32; ++tok) {
                const float sc = stg[tok * STG_STRIDE + lane]; int rank = 0;
#pragma unroll
                for (int q = 0; q < 16; ++q) { const f32x4 v = *(const LAS f32x4*)(stg + tok * STG_STRIDE + 4 * q);
#pragma unroll
                    for (int e = 0; e < 4; ++e) rank += (v[e] > sc || (v[e] == sc && (4 * q + e) < lane)) ? 1 : 0; }
                const unsigned long long mk = __ballot(rank < 16 && sc > -0.5e30f);
                mymask = (lane == tok) ? mk : mymask;
            }
            if (lane < 32) MASK[(size_t)bh * SEQ + blk * 32 + lane] = mymask;
            LDS_WAIT(); asm volatile("" ::: "memory");
        }
#pragma unroll 1
        for (int g = 0; g < 4; ++g) {
            int lane = F.lane; asm volatile("" : "+v"(lane));
            const int r32 = lane & 31, hi = lane >> 5, t = blk * 32 + r32, nvr = t >= 31 ? ((t - 31) >> 4) + 1 : 0;
            LAS bf16x8* qr = (LAS bf16x8*)(wsf + 64) + lane; load_q(qr, Q, m0 + r32, hk * 4 + g, hi);
            const float invg = g == 0 ? inv0 : g == 1 ? inv1 : g == 2 ? inv2 : inv3, mg = g == 0 ? mref0 : g == 1 ? mref1 : g == 2 ? mref2 : mref3;
            f32x16 o0, o1;
#pragma unroll
            for (int r = 0; r < 16; ++r) { o0[r] = 0.f; o1[r] = 0.f; }
#pragma unroll 1
            for (int i = 0; i < ntc; ++i) {
                f32x16 s0, s1; qk_tile_lo(s0, s1, rs, (unsigned)lane * 16u, soK + (unsigned)i * 8192u, qr, -mg); mask_tile(s0, s1, -1, nvr - 1 - 64 * i, hi);
#pragma unroll
                for (int r = 0; r < 16; ++r) { s0[r] = __builtin_amdgcn_exp2f(s0[r]) * invg; s1[r] = __builtin_amdgcn_exp2f(s1[r]) * invg; }
                bf16x8 pa[4]; pack_p(pa, s0, s1);
                bf16x8 vf[8]; load_frag8(vf, rs, (unsigned)lane * 16u, soV + (unsigned)i * 8192u); pv_tile(o0, o1, pa, vf);
            }
            flush_branch<false>(o0, o1, o0, GATE, O, m0, hk * 4 + g, 0, false, stg, lane);
        }
    }
}
__device__ __forceinline__ void attn_main_item(Frame& F, int bh, int g, int blk, LAS float* stg, LAS float* wsf) {
    const bf16* Q = (const bf16*)(F.wsp() + WS_Q); const float* GATE = (const float*)(F.wsp() + WS_GATE); bf16* O = (bf16*)(F.wsp() + WS_O);
    const rsrc_t rs = make_rsrc(F.wsp() + WS_KV, (unsigned)(6 * KVBUF_ELEMS * 2));
    int lane = F.lane; asm volatile("" : "+v"(lane));
    const int r32 = lane & 31, hi = lane >> 5;
    const unsigned vo = (unsigned)lane * 16u;
    const int b = bh >> 2, hk = bh & 3, hq = hk * 4 + g, m0 = b * SEQ + blk * 32, c = blk >> 1, ql = (blk & 1) * 32 + r32;
    LAS bf16x8* qr = (LAS bf16x8*)(wsf + 64) + lane; load_q(qr, Q, m0 + r32, hq, hi);
    const unsigned long long mask = ((const unsigned long long*)(F.wsp() + WS_MASK))[(size_t)bh * SEQ + blk * 32 + r32];
    bf16x8 kf[8], vf[8];
    {
        const unsigned soK = (unsigned)((2 * KVBUF_ELEMS + (size_t)bh * KVROWS * 64) * 2), soV = (unsigned)((3 * KVBUF_ELEMS + (size_t)bh * KVROWS * 64) * 2);
        Sm st; sm_init(st);
        load_frag8(kf, rs, vo, soK);
#pragma unroll 1
        for (int j = 0; j <= c; ++j) {
            const bool sel = ((mask >> j) & 1ull) != 0ull;
            f32x16 s0, s1; qk_tile(s0, s1, kf, qr, sel ? -st.mhat : -INFINITY);
            asm volatile("" : "+v"(s0), "+v"(s1) :: "memory");
            load_frag8(vf, rs, vo, soV + (unsigned)j * 8192u);
            load_frag8(kf, rs, vo, soK + (unsigned)(j < c ? j + 1 : c) * 8192u);
            if (j == c) mask_tile(s0, s1, -1, ql, hi);
            sm_tile(st, s0, s1, j == 0, vf, wsf, r32, hi);
            asm volatile("" : "+v"(st.o0), "+v"(st.o1), "+v"(st.ol) :: "memory");
        }
        flush_branch<true>(st.o0, st.o1, st.ol, GATE, O, m0, hq, 1, true, stg, lane);
    }
    {
        const unsigned soK = (unsigned)((4 * KVBUF_ELEMS + (size_t)bh * KVROWS * 64) * 2), soV = (unsigned)((5 * KVBUF_ELEMS + (size_t)bh * KVROWS * 64) * 2);
        Sm st; sm_init(st);
        const int j0 = c >= 8 ? c - 8 : 0;
        load_frag8(kf, rs, vo, soK + (unsigned)j0 * 8192u);
#pragma unroll 1
        for (int j = j0; j <= c; ++j) {
            f32x16 s0, s1; qk_tile(s0, s1, kf, qr, -st.mhat);
            asm volatile("" : "+v"(s0), "+v"(s1) :: "memory");
            load_frag8(vf, rs, vo, soV + (unsigned)j * 8192u);
            load_frag8(kf, rs, vo, soK + (unsigned)(j < c ? j + 1 : c) * 8192u);
            if (j == c || j + 8 == c) mask_tile(s0, s1, (j + 8 == c) ? ql : -1, (j == c) ? ql : 63, hi);
            sm_tile(st, s0, s1, j == j0, vf, wsf, r32, hi);
            asm volatile("" : "+v"(st.o0), "+v"(st.o1), "+v"(st.ol) :: "memory");
        }
        flush_branch<true>(st.o0, st.o1, st.ol, GATE, O, m0, hq, 2, true, stg, lane);
    }
}
__device__ __forceinline__ void p_attn_main(Frame& F) {
    LAS float* stg = (LAS float*)(F.lds + F.wave * 16384); LAS float* wsf = stg + 32 * STG_STRIDE;
    for (int P = F.gw; P < 4096; P += F.NGW) {
        const int bh = P >> 8, rem = P & 255, g = rem & 3, k = rem >> 2;
        attn_main_item(F, bh, g, 127 - k, stg, wsf);
        attn_main_item(F, bh, g, k, stg, wsf);
    }
}
constexpr int AT_SLOT = 16384, AT_NSLOT = 4, AT_PW_OFF = AT_NSLOT * AT_SLOT, AT_PW_BYTES = STG_BYTES + 256 + 384, AT_MASK_OFF = AT_PW_OFF + 8 * AT_PW_BYTES;
static_assert(AT_MASK_OFF + 512 <= LDSCTL_OFF, "attention LDS map");
#define AT_WAIT_BAR(N) asm volatile("s_waitcnt vmcnt(" #N ") lgkmcnt(0)\n\ts_barrier" ::: "memory")
__device__ __forceinline__ void at_dma(const char* g, LAS unsigned char* l) { __builtin_amdgcn_global_load_lds((const unsigned*)g, (LAS unsigned*)l, 16, 0, 0); }
__device__ __forceinline__ void qk_tile_reg(f32x16& p0, f32x16& p1, const LAS unsigned char* ks, const bf16x8 (&qr)[4], const float cinit) {
    bf16x8 kf[8];
#pragma unroll
    for (int f = 0; f < 8; ++f) kf[f] = *(const LAS bf16x8*)(ks + f * 1024);
    __builtin_amdgcn_sched_barrier(0);
    f32x16 c;
#pragma unroll
    for (int r = 0; r < 16; ++r) c[r] = cinit;
    p0 = MFMA32(kf[0], qr[0], c); p1 = MFMA32(kf[4], qr[0], c);
#pragma unroll
    for (int d0 = 1; d0 < 4; ++d0) { p0 = MFMA32(kf[d0], qr[d0], p0); p1 = MFMA32(kf[4 + d0], qr[d0], p1); }
}
template <int V>
__device__ __forceinline__ void sm_tile_lds(Sm& st, f32x16& s0, f32x16& s1, bool first, const LAS unsigned char* vs, LAS float* wsf, int r32, int hi) {
    const float rm = rowmax32(s0, s1, hi);
    const bool need = first || (__any(rm > 8.0f) != 0);
    if (need) {
        const float dl = first ? ((rm == -INFINITY) ? 0.f : rm) : fmaxf(rm, 0.f);
        st.mhat += dl;
#pragma unroll
        for (int r = 0; r < 16; ++r) { s0[r] -= dl; s1[r] -= dl; }
        if (!first) {
            const float f = __builtin_amdgcn_exp2f(-dl);
            LDS_WAIT(); asm volatile("" ::: "memory");
            if (hi == 0) wsf[r32] = f;
            LDS_WAIT(); asm volatile("" ::: "memory");
#pragma unroll
            for (int G = 0; G < 4; ++G) { const f32x4 ff = *(const LAS f32x4*)(wsf + 8 * G + 4 * hi);
#pragma unroll
                for (int q = 0; q < 4; ++q) { st.o0[4 * G + q] *= ff[q]; st.o1[4 * G + q] *= ff[q]; st.ol[4 * G + q] *= ff[q]; } }
            LDS_WAIT(); asm volatile("" ::: "memory");
        }
    }
    bf16x8 vf[8];
#pragma unroll
    for (int f = 0; f < 8; ++f) vf[f] = *(const LAS bf16x8*)(vs + f * 1024);
    __builtin_amdgcn_sched_barrier(0);
    if (V != 2) {
#pragma unroll
    for (int r = 0; r < 16; ++r) { s0[r] = __builtin_amdgcn_exp2f(s0[r]); s1[r] = __builtin_amdgcn_exp2f(s1[r]); } }
    bf16x8 pa[4]; pack_p(pa, s0, s1);
    const bf16x8 ones = (bf16x8){0x3F80, 0x3F80, 0x3F80, 0x3F80, 0x3F80, 0x3F80, 0x3F80, 0x3F80};
    if (V != 3) {
#pragma unroll
    for (int ks = 0; ks < 4; ++ks) { st.o0 = MFMA32(pa[ks], vf[ks], st.o0); st.o1 = MFMA32(pa[ks], vf[4 + ks], st.o1); st.ol = MFMA32(pa[ks], ones, st.ol); }
    } else { asm volatile("" :: "v"(pa[0]), "v"(pa[1]), "v"(pa[2]), "v"(pa[3]), "v"(vf[0]), "v"(vf[1]), "v"(vf[2]), "v"(vf[3]), "v"(vf[4]), "v"(vf[5]), "v"(vf[6]), "v"(vf[7])); }
}
template <bool WIN, int V>
__device__ __forceinline__ void at_branch(Sm& st, const char* Kg, const char* Vg, int j0, int c, int ql, unsigned long long mask, const bf16x8 (&qr)[4],
                                          LAS unsigned char* ring, LAS float* wsf, int wave, int lane) {
    const int r32 = lane & 31, hi = lane >> 5, n = c - j0 + 1;
    LAS unsigned char* dk = ring + wave * 1024;
    const LAS unsigned char* rd = ring + lane * 16;
#pragma unroll
    for (int d = 0; d < 3; ++d) if (d < n) { at_dma(Kg + (size_t)(j0 + d) * 8192, dk + d * AT_SLOT); at_dma(Vg + (size_t)(j0 + d) * 8192, dk + d * AT_SLOT + 8192); }
#pragma unroll 1
    for (int t = 0; t < n; ++t) {
        const int rem = n - 1 - t;
        if (V != 1) { if (rem >= 2) AT_WAIT_BAR(4); else if (rem == 1) AT_WAIT_BAR(2); else AT_WAIT_BAR(0); }
        if (t + 3 < n) { const int sl = (t + 3) & 3; at_dma(Kg + (size_t)(j0 + t + 3) * 8192, dk + sl * AT_SLOT); at_dma(Vg + (size_t)(j0 + t + 3) * 8192, dk + sl * AT_SLOT + 8192); }
        const int j = j0 + t; const LAS unsigned char* slot = rd + (t & 3) * AT_SLOT;
        const bool sel = WIN ? true : (((mask >> j) & 1ull) != 0ull);
        f32x16 s0, s1;
        if (V != 4) qk_tile_reg(s0, s1, slot, qr, sel ? -st.mhat : -INFINITY);
        else {
#pragma unroll
            for (int r = 0; r < 16; ++r) { s0[r] = sel ? -st.mhat : -1.f; s1[r] = s0[r]; } asm volatile("" : "+v"(s0), "+v"(s1)); }
        if (WIN) { if (j == c || j + 8 == c) mask_tile(s0, s1, (j + 8 == c) ? ql : -1, (j == c) ? ql : 63, hi); }
        else { if (j == c) mask_tile(s0, s1, -1, ql, hi); }
        sm_tile_lds<V>(st, s0, s1, t == 0, slot + 8192, wsf, r32, hi);
    }
}
#define AT_PIN(x) asm volatile("" : "+v"(x))
#define AT_GAPA(MF, P, B, W, I) do { MF; lsum += (P[B] + P[B + 1]) + (P[B + 2] + P[B + 3]); W[I] = cvtpk(P[B], P[B + 1]); W[I + 1] = cvtpk(P[B + 2], P[B + 3]); \
        AT_PIN(lsum); AT_PIN(W); __builtin_amdgcn_sched_barrier(0); } while (0)
#define AT_GAPB(MF, C, B) do { MF; C[B] = __builtin_amdgcn_exp2f(C[B]); C[B + 1] = __builtin_amdgcn_exp2f(C[B + 1]); C[B + 2] = __builtin_amdgcn_exp2f(C[B + 2]); C[B + 3] = __builtin_amdgcn_exp2f(C[B + 3]); \
        AT_PIN(C); __builtin_amdgcn_sched_barrier(0); } while (0)
template <bool WIN>
__device__ __forceinline__ void at_branch_pipe(Sm& st, const char* Kg, const char* Vg, int j0, int c, int ql, unsigned long long mask, const bf16x8 (&qr)[4],
                                               LAS unsigned char* ring, LAS float* wsf, int wave, int lane) {
    const int r32 = lane & 31, hi = lane >> 5, n = c - j0 + 1;
    LAS unsigned char* dk = ring + wave * 1024;
    const LAS unsigned char* rd = ring + lane * 16;
#pragma unroll
    for (int d = 0; d < 2; ++d) if (d < n) { at_dma(Kg + (size_t)(j0 + d) * 8192, dk + d * AT_SLOT); at_dma(Vg + (size_t)(j0 + d) * 8192, dk + d * AT_SLOT + 8192); }
    if (n > 1) AT_WAIT_BAR(2); else AT_WAIT_BAR(0);
    if (2 < n) { at_dma(Kg + (size_t)(j0 + 2) * 8192, dk + 2 * AT_SLOT); at_dma(Vg + (size_t)(j0 + 2) * 8192, dk + 2 * AT_SLOT + 8192); }
    f32x16 p0, p1;
    { const bool sel = WIN ? true : ((mask >> j0) & 1ull) != 0ull;
      qk_tile_reg(p0, p1, rd, qr, sel ? 0.f : -INFINITY);
      if (WIN) { if (j0 == c || j0 + 8 == c) mask_tile(p0, p1, (j0 + 8 == c) ? ql : -1, (j0 == c) ? ql : 63, hi); }
      else { if (j0 == c) mask_tile(p0, p1, -1, ql, hi); }
      const float rm = rowmax32(p0, p1, hi), dl = (rm == -INFINITY) ? 0.f : rm;
      st.mhat = dl;
#pragma unroll
      for (int r = 0; r < 16; ++r) { p0[r] = __builtin_amdgcn_exp2f(p0[r] - dl); p1[r] = __builtin_amdgcn_exp2f(p1[r] - dl); } }
#pragma unroll 1
    for (int t = 1; t < n; ++t) {
        if (t + 1 < n) AT_WAIT_BAR(2); else AT_WAIT_BAR(0);
        if (t + 2 < n) { const int sl = (t + 2) & 3; at_dma(Kg + (size_t)(j0 + t + 2) * 8192, dk + sl * AT_SLOT); at_dma(Vg + (size_t)(j0 + t + 2) * 8192, dk + sl * AT_SLOT + 8192); }
        const int j = j0 + t;
        const bool sel = WIN ? true : ((mask >> j) & 1ull) != 0ull;
        const LAS unsigned char* ks = rd + (t & 3) * AT_SLOT; const LAS unsigned char* vs = rd + ((t - 1) & 3) * AT_SLOT + 8192;
        bf16x8 kf[8], vf[8];
#pragma unroll
        for (int f = 0; f < 8; ++f) kf[f] = *(const LAS bf16x8*)(ks + f * 1024);
        f32x16 cv; { const float ci = sel ? -st.mhat : -INFINITY;
#pragma unroll
            for (int r = 0; r < 16; ++r) cv[r] = ci; }
        __builtin_amdgcn_sched_barrier(0);
        f32x16 c0, c1; u32x4 w0, w1, w2, w3; float lsum = 0.f;
        AT_GAPA(c0 = MFMA32(kf[0], qr[0], cv), p0, 0, w0, 0);
        AT_GAPA(c1 = MFMA32(kf[4], qr[0], cv), p0, 4, w0, 2);
        AT_GAPA(c0 = MFMA32(kf[1], qr[1], c0), p0, 8, w1, 0);
        AT_GAPA(c1 = MFMA32(kf[5], qr[1], c1), p0, 12, w1, 2);
#pragma unroll
        for (int f = 0; f < 8; ++f) vf[f] = *(const LAS bf16x8*)(vs + f * 1024);
        __builtin_amdgcn_sched_barrier(0);
        AT_GAPA(c0 = MFMA32(kf[2], qr[2], c0), p1, 0, w2, 0);
        AT_GAPA(c1 = MFMA32(kf[6], qr[2], c1), p1, 4, w2, 2);
        AT_GAPA(c0 = MFMA32(kf[3], qr[3], c0), p1, 8, w3, 0);
        AT_GAPA(c1 = MFMA32(kf[7], qr[3], c1), p1, 12, w3, 2);
        st.l += lsum;
        if (WIN) { if (j == c || j + 8 == c) mask_tile(c0, c1, (j + 8 == c) ? ql : -1, (j == c) ? ql : 63, hi); }
        else { if (j == c) mask_tile(c0, c1, -1, ql, hi); }
        const float rm = rowmax32(c0, c1, hi);
        const bool resc = (__any(rm > 8.0f) != 0);
        if (resc) { const float dl = fmaxf(rm, 0.f); st.mhat += dl;
#pragma unroll
            for (int r = 0; r < 16; ++r) { c0[r] -= dl; c1[r] -= dl; }
            const float f = __builtin_amdgcn_exp2f(-dl); st.l *= f;
            LDS_WAIT(); asm volatile("" ::: "memory");
            if (hi == 0) wsf[r32] = f; }
        __builtin_amdgcn_sched_barrier(0);
        { const bf16x8 a0 = __builtin_bit_cast(bf16x8, w0), a1 = __builtin_bit_cast(bf16x8, w1), a2 = __builtin_bit_cast(bf16x8, w2), a3 = __builtin_bit_cast(bf16x8, w3);
          AT_GAPB(st.o0 = MFMA32(a0, vf[0], st.o0), c0, 0);
          AT_GAPB(st.o1 = MFMA32(a0, vf[4], st.o1), c0, 4);
          AT_GAPB(st.o0 = MFMA32(a1, vf[1], st.o0), c0, 8);
          AT_GAPB(st.o1 = MFMA32(a1, vf[5], st.o1), c0, 12);
          AT_GAPB(st.o0 = MFMA32(a2, vf[2], st.o0), c1, 0);
          AT_GAPB(st.o1 = MFMA32(a2, vf[6], st.o1), c1, 4);
          AT_GAPB(st.o0 = MFMA32(a3, vf[3], st.o0), c1, 8);
          AT_GAPB(st.o1 = MFMA32(a3, vf[7], st.o1), c1, 12); }
        if (resc) {
            LDS_WAIT(); asm volatile("" ::: "memory");
#pragma unroll
            for (int G = 0; G < 4; ++G) { const f32x4 ff = *(const LAS f32x4*)(wsf + 8 * G + 4 * hi);
#pragma unroll
                for (int q = 0; q < 4; ++q) { st.o0[4 * G + q] *= ff[q]; st.o1[4 * G + q] *= ff[q]; } }
            LDS_WAIT(); asm volatile("" ::: "memory"); }
        p0 = c0; p1 = c1;
    }
    { float lsum = 0.f;
#pragma unroll
      for (int r = 0; r < 16; ++r) lsum += p0[r] + p1[r];
      st.l += lsum;
      bf16x8 pa[4]; pack_p(pa, p0, p1);
      bf16x8 vf[8]; const LAS unsigned char* vs = rd + ((n - 1) & 3) * AT_SLOT + 8192;
#pragma unroll
      for (int f = 0; f < 8; ++f) vf[f] = *(const LAS bf16x8*)(vs + f * 1024);
      pv_tile(st.o0, st.o1, pa, vf); }
    { const float lt = st.l + partner32(st.l, hi);
      LDS_WAIT(); asm volatile("" ::: "memory");
      if (hi == 0) wsf[r32] = lt;
      LDS_WAIT(); asm volatile("" ::: "memory");
#pragma unroll
      for (int G = 0; G < 4; ++G) { const f32x4 ff = *(const LAS f32x4*)(wsf + 8 * G + 4 * hi);
#pragma unroll
          for (int q = 0; q < 4; ++q) st.ol[4 * G + q] = ff[q]; }
      LDS_WAIT(); asm volatile("" ::: "memory"); }
}
template <bool DRY, int V>
__device__ __forceinline__ void attn_unit(Frame& F, int bh, int c) {
    const bf16* Q = (const bf16*)(F.wsp() + WS_Q); const float* GATE = (const float*)(F.wsp() + WS_GATE); bf16* O = (bf16*)(F.wsp() + (DRY ? WS_Y0 : WS_O));
    const int wave = F.wave, g = wave >> 1, th = wave & 1;
    int lane = F.lane; asm volatile("" : "+v"(lane));
    const int r32 = lane & 31, hi = lane >> 5;
    const int b = bh >> 2, hk = bh & 3, hq = hk * 4 + g, m0 = b * SEQ + c * 64 + th * 32, t = c * 64 + th * 32 + r32, ql = th * 32 + r32;
    LAS unsigned char* ring = F.lds;
    LAS float* stg = (LAS float*)(F.lds + AT_PW_OFF + wave * AT_PW_BYTES); LAS float* wsf = stg + 32 * STG_STRIDE;
    LAS unsigned long long* masks = (LAS unsigned long long*)(F.lds + AT_MASK_OFF);
    const size_t lofs = (size_t)wave * 1024 + (size_t)lane * 16;
    bf16x8 qr[4];
#pragma unroll
    for (int d0 = 0; d0 < 4; ++d0) qr[d0] = *(const bf16x8*)(Q + (size_t)(m0 + r32) * DM + hq * 64 + d0 * 16 + hi * 8);
    LAS float* gl = wsf + 64;
    if (hi == 0) { const float* gp = GATE + (size_t)(m0 + r32) * 48 + hq * 3; gl[r32] = gp[0]; gl[32 + r32] = gp[1]; gl[64 + r32] = gp[2]; }
    const int nvr = t >= 31 ? ((t - 31) >> 4) + 1 : 0, ntc = (4 * c + 3 + 63) >> 6;
    f32x16 oc0, oc1;
    {
        const char* KCg = (const char*)(F.wsp() + WS_KC) + (size_t)bh * 32768 + lofs; const char* VCg = (const char*)(F.wsp() + WS_VC) + (size_t)bh * 32768 + lofs;
        asm volatile("s_waitcnt vmcnt(0)" ::: "memory");
        for (int i = 0; i < ntc; ++i) { at_dma(KCg + (size_t)i * 8192, ring + i * AT_SLOT + wave * 1024); at_dma(VCg + (size_t)i * 8192, ring + i * AT_SLOT + 8192 + wave * 1024); }
        AT_WAIT_BAR(0);
        const LAS unsigned char* rd = ring + lane * 16;
        float mhat = 0.f, l = 0.f;
        float imp[32];
#pragma unroll
        for (int k = 0; k < 32; ++k) imp[k] = 0.f;
        f32x16 o0, o1;
#pragma unroll
        for (int r = 0; r < 16; ++r) { o0[r] = 0.f; o1[r] = 0.f; }
#pragma unroll
        for (int i = 0; i < 4; ++i) if (i < ntc) {
            asm volatile("" ::: "memory");
            f32x16 s0, s1; qk_tile_reg(s0, s1, rd + i * AT_SLOT, qr, -mhat); mask_tile(s0, s1, -1, nvr - 1 - 64 * i, hi);
            const float rm = rowmax32(s0, s1, hi);
            if (i == 0) { const float dl = (rm == -INFINITY) ? 0.f : rm; mhat = dl;
#pragma unroll
                for (int r = 0; r < 16; ++r) { s0[r] -= dl; s1[r] -= dl; } }
            else if (__any(rm > 8.0f) != 0) { const float dl = fmaxf(rm, 0.f); mhat += dl;
#pragma unroll
                for (int r = 0; r < 16; ++r) { s0[r] -= dl; s1[r] -= dl; }
                const float f = __builtin_amdgcn_exp2f(-dl); l *= f;
#pragma unroll
                for (int k = 0; k < 32; ++k) imp[k] *= f;
                LDS_WAIT(); asm volatile("" ::: "memory");
                if (hi == 0) wsf[r32] = f;
                LDS_WAIT(); asm volatile("" ::: "memory");
#pragma unroll
                for (int G = 0; G < 4; ++G) { const f32x4 ff = *(const LAS f32x4*)(wsf + 8 * G + 4 * hi);
#pragma unroll
                    for (int q = 0; q < 4; ++q) { o0[4 * G + q] *= ff[q]; o1[4 * G + q] *= ff[q]; } }
                LDS_WAIT(); asm volatile("" ::: "memory"); }
            float sum = 0.f;
#pragma unroll
            for (int r = 0; r < 16; ++r) { s0[r] = __builtin_amdgcn_exp2f(s0[r]); s1[r] = __builtin_amdgcn_exp2f(s1[r]); sum += s0[r] + s1[r]; }
            l += sum;
#pragma unroll
            for (int G = 0; G < 4; ++G) {
                { const int kq = 8 * i + G; const float e = s0[4 * G + 3], pe = partner32(e, hi);
                  imp[kq] += (s0[4 * G] + s0[4 * G + 1]) + s0[4 * G + 2] + 0.5f * e + (hi ? 0.5f * pe : 0.f);
                  if (kq + 1 < 32) imp[kq + 1] += hi ? 0.f : 0.5f * pe; }
                { const int kq = 8 * i + 4 + G; const float e = s1[4 * G + 3], pe = partner32(e, hi);
                  imp[kq] += (s1[4 * G] + s1[4 * G + 1]) + s1[4 * G + 2] + 0.5f * e + (hi ? 0.5f * pe : 0.f);
                  if (kq + 1 < 32) imp[kq + 1] += hi ? 0.f : 0.5f * pe; }
            }
            bf16x8 pa[4]; pack_p(pa, s0, s1);
            { bf16x8 vf[4];
#pragma unroll
              for (int f = 0; f < 4; ++f) vf[f] = *(const LAS bf16x8*)(rd + i * AT_SLOT + 8192 + f * 1024);
#pragma unroll
              for (int ks = 0; ks < 4; ++ks) o0 = MFMA32(pa[ks], vf[ks], o0);
              asm volatile("" : "+v"(o0) :: "memory");
#pragma unroll
              for (int f = 0; f < 4; ++f) vf[f] = *(const LAS bf16x8*)(rd + i * AT_SLOT + 8192 + (4 + f) * 1024);
#pragma unroll
              for (int ks = 0; ks < 4; ++ks) o1 = MFMA32(pa[ks], vf[ks], o1); }
        }
        const float ltot = l + partner32(l, hi), inv = 1.f / fmaxf(ltot, 1e-30f);
#pragma unroll
        for (int k = 0; k < 32; ++k) imp[k] *= inv;
        LDS_WAIT(); asm volatile("" ::: "memory");
        if (hi == 0) wsf[r32] = gl[r32] * inv;
        LDS_WAIT(); asm volatile("" ::: "memory");
#pragma unroll
        for (int G = 0; G < 4; ++G) { const f32x4 gg = *(const LAS f32x4*)(wsf + 8 * G + 4 * hi);
#pragma unroll
            for (int q = 0; q < 4; ++q) { oc0[4 * G + q] = o0[4 * G + q] * gg[q]; oc1[4 * G + q] = o1[4 * G + q] * gg[q]; } }
        LDS_WAIT(); asm volatile("" ::: "memory");
#pragma unroll
        for (int k = 0; k < 32; ++k) stg[r32 * STG_STRIDE + 2 * k + hi] = imp[k];
    }
    AT_WAIT_BAR(0);
    const char* KSg = (const char*)(F.wsp() + WS_KV) + (2 * KVBUF_ELEMS + (size_t)bh * KVROWS * 64) * 2 + lofs;
    const char* VSg = (const char*)(F.wsp() + WS_KV) + (3 * KVBUF_ELEMS + (size_t)bh * KVROWS * 64) * 2 + lofs;
    if (c < 16) { if (lane < 8) masks[th * 32 + 8 * g + lane] = (2ull << c) - 1ull; }
    else {
        const LAS float* st0 = (const LAS float*)(F.lds + AT_PW_OFF + (0 * 2 + th) * AT_PW_BYTES); const LAS float* st1 = (const LAS float*)(F.lds + AT_PW_OFF + (1 * 2 + th) * AT_PW_BYTES);
        const LAS float* st2 = (const LAS float*)(F.lds + AT_PW_OFF + (2 * 2 + th) * AT_PW_BYTES); const LAS float* st3 = (const LAS float*)(F.lds + AT_PW_OFF + (3 * 2 + th) * AT_PW_BYTES);
        const bool allowed = lane <= c, forced = allowed && (lane == 0 || lane == c || lane == c - 1);
        LAS unsigned* kst = (LAS unsigned*)stg;
#pragma unroll 1
        for (int i = 0; i < 8; i += 2) {
            const int tokA = 8 * g + i, tokB = tokA + 1, aA = tokA * STG_STRIDE + lane, aB = tokB * STG_STRIDE + lane;
            const float vA = ((st0[aA] + st1[aA]) + st2[aA]) + st3[aA], vB = ((st0[aB] + st1[aB]) + st2[aB]) + st3[aB];
            const unsigned low = 63u - (unsigned)lane;
            const unsigned keyA = forced ? (0xFFFFFFC0u | low) : (allowed ? ((__builtin_bit_cast(unsigned, vA) & 0xFFFFFFC0u) | low) : 0u);
            const unsigned keyB = forced ? (0xFFFFFFC0u | low) : (allowed ? ((__builtin_bit_cast(unsigned, vB) & 0xFFFFFFC0u) | low) : 0u);
            LDS_WAIT(); asm volatile("" ::: "memory");
            kst[aA] = keyA; kst[aB] = keyB;
            LDS_WAIT(); asm volatile("" ::: "memory");
            int rankA = 0, rankB = 0;
#pragma unroll
            for (int q = 0; q < 16; ++q) { const u32x4 xa = *(const LAS u32x4*)(kst + tokA * STG_STRIDE + 4 * q), xb = *(const LAS u32x4*)(kst + tokB * STG_STRIDE + 4 * q);
#pragma unroll
                for (int e = 0; e < 4; ++e) { rankA += (xa[e] > keyA) ? 1 : 0; rankB += (xb[e] > keyB) ? 1 : 0; } }
            const unsigned long long mkA = __ballot(rankA < 16 && allowed), mkB = __ballot(rankB < 16 && allowed);
            if (lane == 0) { masks[th * 32 + tokA] = mkA; masks[th * 32 + tokB] = mkB; }
        }
    }
    AT_WAIT_BAR(0);
    const unsigned long long mask = masks[th * 32 + r32];
#pragma unroll
    for (int r = 0; r < 16; ++r) { stg[crow(r, hi) * STG_STRIDE + r32] = oc0[r]; stg[crow(r, hi) * STG_STRIDE + 32 + r32] = oc1[r]; }
    {
        Sm st; sm_init(st);
        if (V == 0) at_branch_pipe<false>(st, KSg, VSg, 0, c, ql, mask, qr, ring, wsf, wave, lane); else if (V != 5) at_branch<false, V>(st, KSg, VSg, 0, c, ql, mask, qr, ring, wsf, wave, lane);
        LDS_WAIT(); asm volatile("" ::: "memory");
#pragma unroll
        for (int G = 0; G < 4; ++G) { const f32x4 gg = *(const LAS f32x4*)(gl + 32 + 8 * G + 4 * hi);
#pragma unroll
            for (int q = 0; q < 4; ++q) { const int r = 4 * G + q; const float iv = gg[q] * __builtin_amdgcn_rcpf(fmaxf(st.ol[r], 1e-30f));
                stg[crow(r, hi) * STG_STRIDE + r32] += st.o0[r] * iv; stg[crow(r, hi) * STG_STRIDE + 32 + r32] += st.o1[r] * iv; } }
    }
    AT_WAIT_BAR(0);
    {
        const char* KWg = (const char*)(F.wsp() + WS_KV) + (4 * KVBUF_ELEMS + (size_t)bh * KVROWS * 64) * 2 + lofs;
        const char* VWg = (const char*)(F.wsp() + WS_KV) + (5 * KVBUF_ELEMS + (size_t)bh * KVROWS * 64) * 2 + lofs;
        Sm st; sm_init(st);
        if (V == 0) at_branch_pipe<true>(st, KWg, VWg, c >= 8 ? c - 8 : 0, c, ql, 0ull, qr, ring, wsf, wave, lane); else if (V != 5) at_branch<true, V>(st, KWg, VWg, c >= 8 ? c - 8 : 0, c, ql, 0ull, qr, ring, wsf, wave, lane);
        LDS_WAIT(); asm volatile("" ::: "memory");
#pragma unroll
        for (int G = 0; G < 4; ++G) { const f32x4 gg = *(const LAS f32x4*)(gl + 64 + 8 * G + 4 * hi);
#pragma unroll
            for (int q = 0; q < 4; ++q) { const int r = 4 * G + q; const float iv = gg[q] * __builtin_amdgcn_rcpf(fmaxf(st.ol[r], 1e-30f));
                stg[crow(r, hi) * STG_STRIDE + r32] += st.o0[r] * iv; stg[crow(r, hi) * STG_STRIDE + 32 + r32] += st.o1[r] * iv; } }
        LDS_WAIT(); asm volatile("" ::: "memory");
#pragma unroll
        for (int i = 0; i < 4; ++i) { const int row = i * 8 + (lane >> 3), ch = lane & 7;
            const f32x4 a = *(const LAS f32x4*)(stg + row * STG_STRIDE + ch * 8), b2 = *(const LAS f32x4*)(stg + row * STG_STRIDE + ch * 8 + 4);
            u32x4 w; w.x = pk2(a[0], a[1]); w.y = pk2(a[2], a[3]); w.z = pk2(b2[0], b2[1]); w.w = pk2(b2[2], b2[3]);
            *(u32x4*)(O + (size_t)(m0 + row) * DM + hq * 64 + ch * 8) = w; }
    }
    AT_WAIT_BAR(0);
}
template <bool DRY, int V>
__device__ __forceinline__ void p_attn_fused(Frame& F) {
    const int G = gridDim.x, bx = blockIdx.x, vcu = (G % 8 == 0) ? (bx % 8) * (G / 8) + bx / 8 : bx;
    for (int P = vcu; P < 512; P += G) {
        const int bh = P >> 5, k = P & 31;
#pragma unroll 1
        for (int h = 0; h < 2; ++h) attn_unit<DRY, V>(F, bh, h ? k : 63 - k);
    }
}
struct Args { const float* in[23]; float* out; unsigned char* ws; int ph_lo, ph_hi; };
__global__ void __launch_bounds__(512, 2) mk_fwd(Args args) {
    extern __shared__ __attribute__((aligned(16))) unsigned char lds[];
    Frame F;
    F.lds = (LAS unsigned char*)lds; F.MISC = (volatile LAS unsigned*)(F.lds + MISC_OFF);
    F.tid = threadIdx.x; F.lane = F.tid & 63; F.wave = __builtin_amdgcn_readfirstlane(F.tid >> 6);
    F.gw = blockIdx.x * 8 + F.wave; F.NGW = gridDim.x * 8;
    for (int u = F.tid; u < (LDS_BYTES - LDSCTL_OFF) / 4; u += 512) ((LAS unsigned*)(F.lds + LDSCTL_OFF))[u] = 0u;
    __syncthreads();
    if (F.tid < 25) { const unsigned long long v = F.tid < 23 ? (unsigned long long)args.in[F.tid] : F.tid == 23 ? (unsigned long long)args.out : (unsigned long long)args.ws;
        LAS unsigned* p = (LAS unsigned*)(F.lds + PTR_OFF) + 2 * F.tid; p[0] = (unsigned)v; p[1] = (unsigned)(v >> 32); }
    __syncthreads();
    XcdBarrier bar; bar.bar = (unsigned*)(F.ctlp() + CW_BAR); bar.x = 0; bar.st = nullptr;
    const int lo = args.ph_lo, hi = args.ph_hi;
    if (hi - lo > 1) bar = xcd_barrier_post((unsigned*)(F.ctlp() + CW_BAR), F.MISC + 8);
#ifdef PH_ONLY
#define IN(k) ((k) == PH_ONLY && lo <= (k) && (k) < hi)
#else
#define IN(k) (lo <= (k) && (k) < hi)
#endif
#define SEAM(k) do { if (IN(k) && (k) + 1 < hi) xcd_barrier(bar); } while (0)
    if (IN(0)) {
#pragma unroll 1
        for (int rep = 0; rep < REP0; ++rep) { p0_prologue(F); if (rep + 1 < REP0) xcd_barrier(bar); } } SEAM(0);
    if (IN(1)) {
#pragma unroll 1
        for (int rep = 0; rep < REP1; ++rep) { p1_mod_u0(F); if (rep + 1 < REP1) xcd_barrier(bar); }
#pragma unroll 1
        for (int rep = 0; rep < XBAR - 1; ++rep) xcd_barrier(bar); } SEAM(1);
    if (IN(2)) for (int rep = 0; rep < REP2; ++rep) {
        const char* A = (const char*)(F.wsp() + WS_U); const char* B = (const char*)(F.wsp() + WS_WIN);
        const pg8::SchedDense S{A, B, A, B + (size_t)1024 * DM * 2, T / 256, 4, 8, DM, (int)gridDim.x, (int)blockIdx.x, 256};
#if DRY2 == 1
        { pg8::gemm_phase<EpNull, pg8::SchedDense, true, false>(F.lds, DM, S, EpNull{}); xcd_barrier(bar); }
#elif DRY2 == 2
        { pg8::gemm_phase<EpG1, pg8::SchedDense, true, false>(F.lds, DM, S, EpG1{(bf16*)(F.wsp() + WS_Y0), (bf16*)(F.wsp() + WS_Y1)}); xcd_barrier(bar); }
#endif
        pg8::gemm_phase<EpG1, pg8::SchedDense, true, false>(F.lds, DM, S, EpG1{(bf16*)(F.wsp() + WS_BG), (bf16*)(F.wsp() + WS_Z)});
        if (rep + 1 < REP2) xcd_barrier(bar);
    } SEAM(2);
    if (IN(3)) {
#pragma unroll 1
        for (int rep = 0; rep < REP3; ++rep) { p3_conv(F); if (rep + 1 < REP3) xcd_barrier(bar); } } SEAM(3);
    if (IN(4)) for (int rep = 0; rep < REP4; ++rep) {
        const pg8::SchedDense S{(const char*)(F.wsp() + WS_A2), (const char*)(F.wsp() + WS_WOUT), nullptr, nullptr, T / 256, 4, 0, DM, (int)gridDim.x, (int)blockIdx.x, 256};
        typedef pg8::EpiWrap<EpU<EpBf16>, false, true> E_;
        pg8::gemm_phase<E_, pg8::SchedDense, false, false>(F.lds, DM, S, E_{{{(bf16*)(F.wsp() + WS_Y0), DM}}});
        if (rep + 1 < REP4) xcd_barrier(bar);
    } SEAM(4);
    if (IN(5)) {
#pragma unroll 1
        for (int rep = 0; rep < DRY5; ++rep) { p_ln_router<0, true>(F); xcd_barrier(bar); }
        p_ln_router<0>(F); } SEAM(5);
    if (IN(6)) { p_moe<0>(F, bar, true); } SEAM(6);
    if (IN(8)) {
#pragma unroll 1
        for (int rep = 0; rep < DRY8; ++rep) { p_ln2<0, true>(F); xcd_barrier(bar); }
        p_ln2<0>(F); } SEAM(8);
    if (IN(9)) {
        const int G = gridDim.x, bx = blockIdx.x, vcu = (G % 8 == 0) ? (bx % 8) * (G / 8) + bx / 8 : bx;
        const SchedKVQG S{(const char*)(F.wsp() + WS_XB), (const char*)(F.wsp() + WS_WKV), (const char*)(F.wsp() + WS_U), (const char*)(F.wsp() + WS_WQG), G, vcu, 0, 512};
        typedef pg8::EpiWrap<EpKVQG, false, true> E_;
        pg8::gemm_phase<E_, SchedKVQG, true, false>(F.lds, DM, S, E_{{(bf16*)(F.wsp() + WS_KV), (bf16*)(F.wsp() + WS_Q), (float*)(F.wsp() + WS_GATE), F.inp(I_BG)}});
    } SEAM(9);
    if (IN(10)) {
        const int G = gridDim.x, bx = blockIdx.x, vcu = (G % 8 == 0) ? (bx % 8) * (G / 8) + bx / 8 : bx;
        const int nq = G - 64 > 0 ? G - 64 : G;
        {
            const SchedKVQG S{(const char*)(F.wsp() + WS_XB), (const char*)(F.wsp() + WS_WKV), (const char*)(F.wsp() + WS_U), (const char*)(F.wsp() + WS_WQG), nq, vcu < nq ? vcu : -1, 512, 704};
            typedef pg8::EpiWrap<EpKVQG, false, true> E_;
            pg8::gemm_phase<E_, SchedKVQG, false, false>(F.lds, DM, S, E_{{(bf16*)(F.wsp() + WS_KV), (bf16*)(F.wsp() + WS_Q), (float*)(F.wsp() + WS_GATE), F.inp(I_BG)}});
        }
        {
            const SchedCmp S{(const char*)(F.wsp() + WS_KV), (const char*)(F.wsp() + WS_W1C), G - nq > 0 ? G - nq : G, G - nq > 0 ? (vcu >= nq ? vcu - nq : -1) : vcu};
            typedef pg8::EpiWrap<EpU<EpF32>, false> E_;
            pg8::gemm_phase<E_, SchedCmp, false, false>(F.lds, 1024, S, E_{{{(float*)(F.wsp() + WS_TB), 512}}});
        }
    } SEAM(10);
    if (IN(11)) {
#pragma unroll 1
        for (int rep = 0; rep < REP11; ++rep) { p_cmp_finish(F); if (rep + 1 < REP11) xcd_barrier(bar); } } SEAM(11);
#if ATTN_FUSED
    if (IN(12)) {
#pragma unroll 1
        for (int rep = 0; rep < DRY12; ++rep) { p_attn_fused<true, ATV>(F); xcd_barrier(bar); }
        p_attn_fused<false, 0>(F); } SEAM(12);
#else
    if (IN(12)) { p_attn_cmp(F); } SEAM(12);
    if (IN(13)) { p_attn_main(F); } SEAM(13);
#endif
    if (IN(14)) {
        const pg8::SchedDense S{(const char*)(F.wsp() + WS_O), (const char*)(F.wsp() + WS_WO), nullptr, nullptr, T / 256, 4, 0, DM, (int)gridDim.x, (int)blockIdx.x, 256};
        typedef pg8::EpiWrap<EpU<EpBf16>, false, true> E_;
        pg8::gemm_phase<E_, pg8::SchedDense, false, false>(F.lds, DM, S, E_{{{(bf16*)(F.wsp() + WS_Y0), DM}}});
    } SEAM(14);
    if (IN(15)) { p_ln_router<1>(F); } SEAM(15);
    if (IN(16)) { p_moe<1>(F, bar, true); } SEAM(16);
    if (IN(18)) { p_ln2<1>(F); }
#undef IN
#undef SEAM
}

extern "C" void kernel_launch(void* const* d_in, const int* in_sizes, int n_in, void* d_out, int out_size, void* d_ws, size_t ws_size, hipStream_t stream) {
    static int grid = 0;
    if (grid == 0) {
        if (n_in != 23 || out_size != T * DM || ws_size < WS_END) { fprintf(stderr, "kernel_launch: unexpected shapes (n_in %d out %d ws %zu, need ws >= %zu)\n", n_in, out_size, ws_size, (size_t)WS_END); grid = -1; return; }
        int dev = 0, cus = 0, per_cu = 0;
        if (hipGetDevice(&dev) != hipSuccess || hipDeviceGetAttribute(&cus, hipDeviceAttributeMultiprocessorCount, dev) != hipSuccess) { grid = -1; return; }
        if (hipFuncSetAttribute((const void*)mk_fwd, hipFuncAttributeMaxDynamicSharedMemorySize, LDS_BYTES) != hipSuccess) { fprintf(stderr, "kernel_launch: hipFuncSetAttribute failed\n"); grid = -1; return; }
        if (hipOccupancyMaxActiveBlocksPerMultiprocessor(&per_cu, (const void*)mk_fwd, 512, LDS_BYTES) != hipSuccess || per_cu < 1) { fprintf(stderr, "kernel_launch: occupancy query says %d\n", per_cu); per_cu = 1; }
        (void)hipGetLastError();
        grid = cus;
    }
    if (grid < 0) return;
    (void)hipMemsetAsync((char*)d_ws + WS_CTL, 0, CTL_ZERO_BYTES, stream);
    Args a{};
    for (int i = 0; i < 23; ++i) a.in[i] = (const float*)d_in[i];
    a.out = (float*)d_out; a.ws = (unsigned char*)d_ws;
    if (MK_N_LAUNCHES == 1) { a.ph_lo = 0; a.ph_hi = NPH; hipLaunchKernelGGL(mk_fwd, dim3(grid), dim3(512), LDS_BYTES, stream, a); }
    else for (int p = 0; p < NPH; ++p) { a.ph_lo = p; a.ph_hi = p + 1; hipLaunchKernelGGL(mk_fwd, dim3(grid), dim3(512), LDS_BYTES, stream, a); }
}
```

```cpp
#include <hip/hip_runtime.h>
#include <cstdio>
#include <cstdint>

#ifndef REP0
#define REP0 1
#endif
#ifndef REP1
#define REP1 1
#endif
#ifndef REP11
#define REP11 1
#endif
#ifndef XBAR
#define XBAR 1
#endif
#ifndef DRY5
#define DRY5 0
#endif
#ifndef DRY8
#define DRY8 0
#endif
#ifndef REP4
#define REP4 1
#endif
#ifndef REP2
#define REP2 1
#endif
#ifndef REP3
#define REP3 1
#endif
#ifndef REP6
#define REP6 1
#endif
#ifndef REP7
#define REP7 1
#endif
#ifndef REP9
#define REP9 1
#endif
#ifndef REP10
#define REP10 1
#endif
#ifndef REP12
#define REP12 1
#endif
#ifndef REP1213
#define REP1213 1
#endif
#ifndef ATV
#define ATV 0
#endif
#ifndef DRY2
#define DRY2 0
#endif
#ifndef DRY12
#define DRY12 0
#endif
#ifndef ATTN_FUSED
#define ATTN_FUSED 1
#endif
#ifndef MK_N_LAUNCHES
#define MK_N_LAUNCHES 1
#endif

#define GAS __attribute__((address_space(1)))
#define LAS __attribute__((address_space(3)))
typedef unsigned short bf16;
typedef short bf16x8 __attribute__((ext_vector_type(8)));
typedef float f32x4 __attribute__((ext_vector_type(4)));
typedef unsigned u32x4 __attribute__((ext_vector_type(4)));
typedef unsigned u32x2 __attribute__((ext_vector_type(2)));
typedef GAS unsigned gu32;
#define RLX_AGENT __ATOMIC_RELAXED, __HIP_MEMORY_SCOPE_AGENT

constexpr int NB = 4, SEQ = 4096, DM = 1024, T = NB * SEQ, NH = 16, HKV = 4, HD = 64, NE = 16, FF = 512;
constexpr int NPH = 19;
constexpr float ALPHA = 1.4142135623730951f;
constexpr float LN_EPS = 1e-5f;
constexpr float C2 = 0.125f * 1.4426950408889634f;
constexpr int KVROWS = SEQ + 128;
constexpr int HROWS = 2 * T + NE * 256;

constexpr size_t MiB = 1u << 20;
constexpr size_t WS_CTL = 0, CTL_ZERO_BYTES = 1 * MiB;
constexpr size_t WS_MODP = 290 * MiB;
constexpr size_t WS_MOD = 3 * MiB;
constexpr size_t WS_PETP = 3 * MiB + 512 * 1024;
constexpr size_t WS_LIST = 4 * MiB;
constexpr size_t WS_LW = 6 * MiB;
constexpr size_t WS_WIN = 8 * MiB, WS_WOUT = 14 * MiB, WS_WKV = 16 * MiB, WS_WQG = 19 * MiB, WS_WO = 22 * MiB, WS_W1C = 24 * MiB;
constexpr size_t WS_WGU = 26 * MiB, WS_WDN = 90 * MiB;
constexpr size_t WS_U = 122 * MiB, WS_XB = 154 * MiB, WS_H = 186 * MiB, WS_Y0 = 226 * MiB, WS_Y1 = 258 * MiB;
constexpr size_t WS_R1 = 290 * MiB;
constexpr size_t WS_BG = WS_R1, WS_Z = WS_R1 + 32 * MiB, WS_A2 = WS_R1 + 64 * MiB;
constexpr size_t WS_Q = WS_R1, WS_O = WS_R1 + 32 * MiB, WS_KV = WS_R1 + 64 * MiB;
constexpr size_t KVBUF_ELEMS = (size_t)16 * KVROWS * 64;
constexpr size_t WS_TB = WS_R1 + 114 * MiB, WS_KC = WS_R1 + 130 * MiB, WS_VC = WS_KC + 512 * 1024, WS_GATE = WS_R1 + 131 * MiB;
constexpr size_t WS_END = WS_R1 + 135 * MiB;
static_assert(WS_Y1 == WS_Y0 + (size_t)T * DM * 2, "Y1 follows Y0");
static_assert(WS_KV + 6 * KVBUF_ELEMS * 2 <= WS_TB, "kv buffers");
static_assert((size_t)HROWS * FF * 2 <= 40 * MiB, "H buffer");
constexpr int CW_CNT = 1024;
constexpr int CW_BAR = 4096;

constexpr int RING_BYTES = 131072;
constexpr int LDSCTL_OFF = 143360, MISC_OFF = LDSCTL_OFF + 320;
constexpr int LDS_BYTES = 147456;

#define LDS_WAIT() asm volatile("s_waitcnt lgkmcnt(0)" ::: "memory")
__device__ __forceinline__ unsigned f2bf(float f) { unsigned u = __builtin_bit_cast(unsigned, f); return (u + 0x7fffu + ((u >> 16) & 1u)) >> 16; }
typedef float f32x2v __attribute__((ext_vector_type(2)));
typedef __bf16 bf16x2_t __attribute__((ext_vector_type(2)));
__device__ __forceinline__ unsigned pk2(float lo, float hi) { f32x2v v = {lo, hi}; bf16x2_t b = __builtin_convertvector(v, bf16x2_t); return __builtin_bit_cast(unsigned, b); }
__device__ __forceinline__ float bf2f(unsigned short h) { return __builtin_bit_cast(float, (unsigned)h << 16); }
__device__ __forceinline__ float bflo(unsigned w) { return __builtin_bit_cast(float, w << 16); }
__device__ __forceinline__ float bfhi(unsigned w) { return __builtin_bit_cast(float, w & 0xffff0000u); }
__device__ __forceinline__ float wave_sum(float v) {
#pragma unroll
    for (int o = 1; o < 64; o <<= 1) v += __shfl_xor(v, o);
    return v;
}
__device__ __forceinline__ float wave_max(float v) {
#pragma unroll
    for (int o = 1; o < 64; o <<= 1) v = fmaxf(v, __shfl_xor(v, o));
    return v;
}
__device__ __forceinline__ float silu_f(float a) { return a * __builtin_amdgcn_rcpf(1.f + __builtin_amdgcn_exp2f(-1.4426950408889634f * a)); }
__device__ __forceinline__ void st_bf4(bf16* p, f32x4 v) { u32x2 w; w.x = pk2(v[0], v[1]); w.y = pk2(v[2], v[3]); *(u32x2*)p = w; }
__device__ __forceinline__ void st_bf8(bf16* p, f32x4 a, f32x4 b) { u32x4 w; w.x = pk2(a[0], a[1]); w.y = pk2(a[2], a[3]); w.z = pk2(b[0], b[1]); w.w = pk2(b[2], b[3]); *(u32x4*)p = w; }

#define XB_TMO      128
#define XB_XCNT(j)  (256  + 64 * (j))
#define XB_XSUB(j)  (1280 + 64 * (j))
#define XB_XGEN(j)  (2304 + 64 * (j))
#define XB_TOP      3328
#define XB_TOPGEN   3392
#define XCD_BAR_WORDS 3456
#define XB_SPIN_CAP (1u << 22)
__device__ __forceinline__ unsigned xb_ld(unsigned* p)              { return __hip_atomic_load(p, __ATOMIC_RELAXED, __HIP_MEMORY_SCOPE_AGENT); }
__device__ __forceinline__ unsigned xb_add(unsigned* p, unsigned v) { return __hip_atomic_fetch_add(p, v, __ATOMIC_RELAXED, __HIP_MEMORY_SCOPE_AGENT); }
__device__ __forceinline__ unsigned xb_xcc_id() { return (unsigned)__builtin_amdgcn_s_getreg((3 << 11) | 20) & 0xFu; }
#define XB_SPIN(cond, bar) do { unsigned _sp = 0; while (cond) { __builtin_amdgcn_s_sleep(1); \
    if ((++_sp & 255u) == 0u) { if (xb_ld(&(bar)[XB_TMO])) break; if (_sp > XB_SPIN_CAP) { atomicAdd(&(bar)[XB_TMO], 1u); break; } } } } while (0)
struct XcdBarrier { unsigned* bar; unsigned x; volatile LAS unsigned* st; };
__device__ __forceinline__ XcdBarrier xcd_barrier_post(unsigned* bar, volatile LAS unsigned* st) {
    XcdBarrier b; b.bar = bar; b.x = xb_xcc_id(); b.st = st;
    if (threadIdx.x == 0) (void)xb_add(&bar[XB_XCNT(b.x)], 1u);
    return b;
}
__device__ __forceinline__ void xcd_barrier_complete(unsigned* bar, unsigned x, unsigned& nloc, unsigned& nx) {
    const unsigned G = gridDim.x * gridDim.y * gridDim.z;
    unsigned sum, cnt, mine, sp = 0u;
    for (;;) {
        sum = 0u; cnt = 0u; mine = 0u;
#pragma unroll
        for (unsigned j = 0; j < 16; ++j) { const unsigned c = xb_ld(&bar[XB_XCNT(j)]); sum += c; cnt += (c > 0u) ? 1u : 0u; mine = (j == x) ? c : mine; }
        if (sum == G) break;
        __builtin_amdgcn_s_sleep(1);
        if ((++sp & 255u) == 0u) { if (xb_ld(&bar[XB_TMO])) break; if (sp > XB_SPIN_CAP) { atomicAdd(&bar[XB_TMO], 1u); break; } }
    }
    nloc = mine > 0u ? mine : 1u; nx = cnt > 0u ? cnt : 1u;
}
__device__ __forceinline__ void xcd_barrier(const XcdBarrier& b) {
    asm volatile("s_waitcnt vmcnt(0)" ::: "memory");
    __syncthreads();
    if (threadIdx.x == 0) {
        unsigned* bar = b.bar;
        __builtin_amdgcn_s_waitcnt(0);
        unsigned nloc = b.st[0], nx = b.st[1];
        if (nloc == 0u) { xcd_barrier_complete(bar, b.x, nloc, nx); b.st[0] = nloc; b.st[1] = nx; }
        const unsigned old = xb_add(&bar[XB_XSUB(b.x)], 1u);
        const unsigned gen = old / nloc;
        if (old + 1u == (gen + 1u) * nloc) {
            __builtin_amdgcn_fence(__ATOMIC_RELEASE, "agent");
            asm volatile("s_waitcnt vmcnt(0)" ::: "memory");
            const unsigned og = xb_add(&bar[XB_TOP], 1u);
            const unsigned tg = og / nx;
            if (og + 1u == (tg + 1u) * nx) xb_add(&bar[XB_TOPGEN], 1u);
            else XB_SPIN(xb_ld(&bar[XB_TOPGEN]) == tg, bar);
            __builtin_amdgcn_fence(__ATOMIC_ACQUIRE, "agent");
            xb_add(&bar[XB_XGEN(b.x)], 1u);
            asm volatile("s_waitcnt vmcnt(0)" ::: "memory");
        } else {
            XB_SPIN(xb_ld(&bar[XB_XGEN(b.x)]) == gen, bar);
            __builtin_amdgcn_fence(__ATOMIC_ACQUIRE, "agent");
            asm volatile("s_waitcnt vmcnt(0)" ::: "memory");
        }
    }
    __syncthreads();
}

constexpr int PTR_OFF = MISC_OFF + 512;
struct Frame {
    LAS unsigned char* lds;
    volatile LAS unsigned* MISC;
    int tid, lane, wave, gw, NGW;
    __device__ __forceinline__ unsigned long long ptr(int i) const { const LAS unsigned* p = (const LAS unsigned*)(lds + PTR_OFF) + 2 * i;
        const unsigned lo = __builtin_amdgcn_readfirstlane(p[0]), hi = __builtin_amdgcn_readfirstlane(p[1]); return ((unsigned long long)hi << 32) | lo; }
    __device__ __forceinline__ const float* inp(int i) const { return (const float*)(const GAS float*)ptr(i); }
    __device__ __forceinline__ float* outp() const { return (float*)(GAS float*)ptr(23); }
    __device__ __forceinline__ unsigned char* wsp() const { return (unsigned char*)(GAS unsigned char*)ptr(24); }
    __device__ __forceinline__ gu32* ctlp() const { return (gu32*)(wsp() + WS_CTL); }
};
enum { I_X = 0, I_C, I_ADAW, I_ADAB, I_LNG, I_LNB, I_CWIN, I_CONVW, I_CONVB, I_CWOUT, I_WKV, I_PE, I_CW1, I_CB1, I_CW2, I_CB2, I_WQG, I_BG, I_WO, I_RW, I_RB, I_WGU, I_WDN };

__device__ __forceinline__ void transpose_item(const float* W, int ld, int nvalid, int K, bf16* WT, int dstrow0, int k0, int n0, LAS float* scr, int lane) {
    const int n = n0 + (lane & 31);
#pragma unroll 8
    for (int i = 0; i < 32; ++i) { const int kk = 2 * i + (lane >> 5); scr[kk * 33 + (lane & 31)] = (n < nvalid) ? W[(size_t)(k0 + kk) * ld + n] : 0.f; }
    LDS_WAIT(); asm volatile("" ::: "memory");
    const int c = lane & 7;
#pragma unroll
    for (int j = 0; j < 4; ++j) { const int nl = (lane >> 3) + 8 * j; const LAS float* s = scr + (8 * c) * 33 + nl;
        u32x4 o; o.x = pk2(s[0 * 33], s[1 * 33]); o.y = pk2(s[2 * 33], s[3 * 33]); o.z = pk2(s[4 * 33], s[5 * 33]); o.w = pk2(s[6 * 33], s[7 * 33]);
        *(u32x4*)(WT + (size_t)(dstrow0 + nl) * K + k0 + 8 * c) = o; }
    LDS_WAIT(); asm volatile("" ::: "memory");
}
__device__ __forceinline__ int pairmap(int n0, int half) {
    return n0 < half ? ((n0 >> 7) * 256 + (n0 & 127)) : ((((n0 - half) >> 7) * 256) + 128 + ((n0 - half) & 127));
}
__device__ __forceinline__ void p0_prologue(Frame& F) {
    LAS float* scr = (LAS float*)(F.lds + F.wave * 16384);
    const int lane = F.lane;
    for (int r = F.gw; r < 768 + 256; r += F.NGW) {
        if (r < 768) {
            const int l = r / 384, rem = r % 384, dch = rem / 24, e = (rem % 24) * 256 + 4 * lane;
            const float* aw = F.inp(I_ADAW) + (size_t)l * 1024 * 6144 + e; const float* c = F.inp(I_C);
            f32x4 a0 = (f32x4){0.f, 0.f, 0.f, 0.f}, a1 = a0, a2 = a0, a3 = a0;
#pragma unroll 16
            for (int d = dch * 64; d < dch * 64 + 64; ++d) {
                const f32x4 w = *(const f32x4*)(aw + (size_t)d * 6144);
                const float c0 = c[d], c1 = c[1024 + d], c2 = c[2048 + d], c3 = c[3072 + d];
                a0 += w * (c0 / (1.f + __expf(-c0))); a1 += w * (c1 / (1.f + __expf(-c1))); a2 += w * (c2 / (1.f + __expf(-c2))); a3 += w * (c3 / (1.f + __expf(-c3)));
            }
            float* mp = (float*)(F.wsp() + WS_MODP) + (size_t)dch * 49152 + (size_t)(l * 4) * 6144 + e;
            *(f32x4*)mp = a0; *(f32x4*)(mp + 6144) = a1; *(f32x4*)(mp + 2 * 6144) = a2; *(f32x4*)(mp + 3 * 6144) = a3;
        } else {
            const int q = r - 768, i = q / 128, rem = q % 128, cch = rem / 32, kch = rem % 32, c = cch * 64 + lane;
            const float* pe = F.inp(I_PE) + i * 2048; const float* w1 = F.inp(I_CW1) + (size_t)i * 2048 * 256 + c;
            float a = 0.f;
#pragma unroll 16
            for (int kk = kch * 64; kk < kch * 64 + 64; ++kk) a += pe[kk] * w1[(size_t)kk * 256];
            ((float*)(F.wsp() + WS_PETP))[(kch * 2 + i) * 256 + c] = a;
        }
    }
    constexpr int I1 = 16 * 96, I2 = 512, I3 = 16 * 48, I4 = 16 * 40, I5 = 512, I6 = 512, I7 = 32 * 512, I8 = 32 * 256;
    constexpr int NITEMS = I1 + I2 + I3 + I4 + I5 + I6 + I7 + I8;
    for (int it = F.gw; it < NITEMS; it += F.NGW) {
        int r = it;
        if (r < I1) { const int kb = r / 96, nb = r % 96, n0 = nb * 32;
            const int dr = n0 < 1024 ? n0 : 1024 + pairmap(n0 - 1024, 1024);
            transpose_item(F.inp(I_CWIN), 3072, 3072, 1024, (bf16*)(F.wsp() + WS_WIN), dr, kb * 64, n0, scr, lane); continue; } r -= I1;
        if (r < I2) { transpose_item(F.inp(I_CWOUT), 1024, 1024, 1024, (bf16*)(F.wsp() + WS_WOUT), (r % 32) * 32, (r / 32) * 64, (r % 32) * 32, scr, lane); continue; } r -= I2;
        if (r < I3) { transpose_item(F.inp(I_WKV), 1536, 1536, 1024, (bf16*)(F.wsp() + WS_WKV), (r % 48) * 32, (r / 48) * 64, (r % 48) * 32, scr, lane); continue; } r -= I3;
        if (r < I4) { transpose_item(F.inp(I_WQG), 1072, 1072, 1024, (bf16*)(F.wsp() + WS_WQG), (r % 40) * 32, (r / 40) * 64, (r % 40) * 32, scr, lane); continue; } r -= I4;
        if (r < I5) { transpose_item(F.inp(I_WO), 1024, 1024, 1024, (bf16*)(F.wsp() + WS_WO), (r % 32) * 32, (r / 32) * 64, (r % 32) * 32, scr, lane); continue; } r -= I5;
        if (r < I6) { const int sub = r / 128, q = r % 128, i = sub >> 1, hh = sub & 1;
            transpose_item(F.inp(I_CW1) + (size_t)i * 2048 * 256 + (size_t)hh * 1024 * 256, 256, 256, 1024, (bf16*)(F.wsp() + WS_W1C) + (size_t)i * 512 * 1024, hh * 256 + (q % 8) * 32, (q / 8) * 64, (q % 8) * 32, scr, lane); continue; } r -= I6;
        if (r < I7) { const int mi = r / 512, q = r % 512, n0 = (q % 32) * 32;
            transpose_item(F.inp(I_WGU) + (size_t)mi * 1024 * 1024, 1024, 1024, 1024, (bf16*)(F.wsp() + WS_WGU) + (size_t)mi * 1024 * 1024, pairmap(n0, 512), (q / 32) * 64, n0, scr, lane); continue; } r -= I7;
        { const int mi = r / 256, q = r % 256, n0 = (q % 32) * 32;
            transpose_item(F.inp(I_WDN) + (size_t)mi * 512 * 1024, 1024, 1024, 512, (bf16*)(F.wsp() + WS_WDN) + (size_t)mi * 1024 * 512, n0, (q / 32) * 64, n0, scr, lane); }
    }
}
__device__ __forceinline__ f32x4 mod4_partials(const Frame& F, int l, int b, int e) {
    f32x4 s = *(const f32x4*)(F.inp(I_ADAB) + l * 6144 + e);
    const float* mp = (const float*)(F.wsp() + WS_MODP) + (size_t)(l * 4 + b) * 6144 + e;
#pragma unroll
    for (int d = 0; d < 16; ++d) s += *(const f32x4*)(mp + (size_t)d * 49152);
    return s;
}
__device__ __forceinline__ void p1_mod_u0(Frame& F) {
    float* MOD = (float*)(F.wsp() + WS_MOD);
    for (int ch = F.gw; ch < 768; ch += F.NGW) {
        const int idx = ch * 64 + F.lane, lb = idx / 6144, e = idx % 6144;
        float s = F.inp(I_ADAB)[(lb >> 2) * 6144 + e];
        const float* mp = (const float*)(F.wsp() + WS_MODP) + idx;
#pragma unroll
        for (int d = 0; d < 16; ++d) s += mp[(size_t)d * 49152];
        MOD[idx] = s;
    }
    bf16* U = (bf16*)(F.wsp() + WS_U);
    for (int m0 = F.gw * 8; m0 < T; m0 += F.NGW * 8) {
        const int b = m0 >> 12;
        f32x4 sh[4], sc[4];
#pragma unroll
        for (int j = 0; j < 4; ++j) { const int col = 4 * F.lane + 256 * j; sh[j] = mod4_partials(F, 0, b, col); sc[j] = mod4_partials(F, 0, b, 1024 + col) + 1.0f; }
        for (int m = m0; m < m0 + 8; ++m) {
#pragma unroll
            for (int j = 0; j < 4; ++j) { const int col = 4 * F.lane + 256 * j; const f32x4 v = *(const f32x4*)(F.inp(I_X) + (size_t)m * DM + col);
                st_bf4(U + (size_t)m * DM + col, v * sc[j] + sh[j]); }
        }
    }
}

template <bool PAIR, class AR, class EP>
__device__ __forceinline__ void gemm_wave_tile(const AR& arow, const bf16* Btile, int K, int m0, int nbase, const EP& ep, int lane) {
    const int fr = lane & 15, fq = lane >> 4;
    f32x4 acc[4][4];
#pragma unroll
    for (int i = 0; i < 4; ++i)
#pragma unroll
        for (int j = 0; j < 4; ++j) acc[i][j] = (f32x4){0.f, 0.f, 0.f, 0.f};
    const bf16* ap[4]; const bf16* bp[4];
#pragma unroll
    for (int i = 0; i < 4; ++i) ap[i] = arow(m0 + 16 * i + fr) + 8 * fq;
#pragma unroll
    for (int j = 0; j < 4; ++j) { const int nr = PAIR ? ((j & 1) * 16 + (j >> 1) * 128) : 16 * j; bp[j] = Btile + (size_t)(nr + fr) * K + 8 * fq; }
    for (int k0 = 0; k0 < K; k0 += 32) {
        bf16x8 a[4], b[4];
#pragma unroll
        for (int i = 0; i < 4; ++i) a[i] = *(const bf16x8*)(ap[i] + k0);
#pragma unroll
        for (int j = 0; j < 4; ++j) b[j] = *(const bf16x8*)(bp[j] + k0);
#pragma unroll
        for (int i = 0; i < 4; ++i)
#pragma unroll
            for (int j = 0; j < 4; ++j) acc[i][j] = __builtin_amdgcn_mfma_f32_16x16x32_bf16(b[j], a[i], acc[i][j], 0, 0, 0);
    }
#pragma unroll
    for (int i = 0; i < 4; ++i) {
        const int m = m0 + 16 * i + fr;
        if constexpr (PAIR) {
#pragma unroll
            for (int j = 0; j < 2; ++j) ep.pair(m, nbase + 16 * j + 4 * fq, acc[i][j], acc[i][j + 2]);
        } else {
#pragma unroll
            for (int j = 0; j < 4; ++j) ep(m, nbase + 16 * j + 4 * fq, acc[i][j]);
        }
    }
}
struct ARowPlain { const bf16* A; int K; __device__ __forceinline__ const bf16* operator()(int m) const { return A + (size_t)m * K; } };

struct EpBf16 { bf16* O; int ld; __device__ __forceinline__ void operator()(int m, int n, f32x4 v) const { st_bf4(O + (size_t)m * ld + n, v); }
    __device__ __forceinline__ void op8(int m, int n, f32x4 a, f32x4 b) const { st_bf8(O + (size_t)m * ld + n, a, b); } };
struct EpMulPair { bf16* O; int ld; __device__ __forceinline__ void pair(int m, int ch, f32x4 a, f32x4 b) const { st_bf4(O + (size_t)m * ld + ch, a * b); }
    __device__ __forceinline__ void pair8(int m, int ch, f32x4 a0, f32x4 a1, f32x4 b0, f32x4 b1) const { st_bf8(O + (size_t)m * ld + ch, a0 * b0, a1 * b1); } };
struct EpSiluPair { bf16* O; int ld; __device__ __forceinline__ void pair(int m, int ch, f32x4 a, f32x4 b) const {
    f32x4 s; for (int r = 0; r < 4; ++r) s[r] = silu_f(a[r]) * b[r]; st_bf4(O + (size_t)m * ld + ch, s); } };
__device__ __forceinline__ f32x4 ld_bf4(const bf16* p) { const u32x2 w = *(const u32x2*)p; return (f32x4){bflo(w.x), bfhi(w.x), bflo(w.y), bfhi(w.y)}; }
struct EpRes { const float* base; bf16* out; const float* gmod;
    __device__ __forceinline__ void operator()(int m, int n, f32x4 v) const { const int b = m >> 12; const f32x4 g = *(const f32x4*)(gmod + b * 6144 + n);
        const f32x4 x = *(const f32x4*)(base + (size_t)m * DM + n); st_bf4(out + (size_t)m * DM + n, x * ALPHA + g * v); } };
struct EpResB { bf16* res; const float* gmod;
    __device__ __forceinline__ void operator()(int m, int n, f32x4 v) const { const int b = m >> 12; const f32x4 g = *(const f32x4*)(gmod + b * 6144 + n);
        bf16* p = res + (size_t)m * DM + n; st_bf4(p, ld_bf4(p) * ALPHA + g * v); } };
__device__ __forceinline__ int kfrag_off(int kk, int d) { return ((((kk >> 5) * 4 + (d >> 4)) * 2 + ((d >> 3) & 1)) * 32 + (kk & 31)) * 8 + (d & 7); }
__device__ __forceinline__ int vfrag_off(int kk, int d) { return ((((d >> 5) * 4 + (kk >> 4)) * 2 + ((kk >> 2) & 1)) * 32 + (d & 31)) * 8 + ((((kk >> 3) & 1) << 2) | (kk & 3)); }
struct EpKV { bf16* KV; __device__ __forceinline__ void operator()(int m, int n, f32x4 v) const {
    const int j = n >> 8, hk = (n >> 6) & 3, d = n & 63, b = m >> 12, t = m & 4095;
    bf16* base = KV + (size_t)j * KVBUF_ELEMS + (size_t)(b * 4 + hk) * KVROWS * 64;
    if (j < 2) st_bf4(base + (size_t)t * 64 + d, v);
    else if ((j & 1) == 0) st_bf4(base + (size_t)(t >> 6) * 4096 + kfrag_off(t & 63, d), v);
    else { bf16* tp = base + (size_t)(t >> 6) * 4096;
        for (int r = 0; r < 4; ++r) tp[vfrag_off(t & 63, d + r)] = (bf16)f2bf(v[r]); } }
    __device__ __forceinline__ void op8(int m, int n, f32x4 a, f32x4 c) const {
    const int j = n >> 8, hk = (n >> 6) & 3, d = n & 63, b = m >> 12, t = m & 4095;
    bf16* base = KV + (size_t)j * KVBUF_ELEMS + (size_t)(b * 4 + hk) * KVROWS * 64;
    if (j < 2) st_bf8(base + (size_t)t * 64 + d, a, c);
    else if ((j & 1) == 0) st_bf8(base + (size_t)(t >> 6) * 4096 + kfrag_off(t & 63, d), a, c);
    else { bf16* tp = base + (size_t)(t >> 6) * 4096;
        for (int r = 0; r < 4; ++r) { tp[vfrag_off(t & 63, d + r)] = (bf16)f2bf(a[r]); tp[vfrag_off(t & 63, d + 4 + r)] = (bf16)f2bf(c[r]); } } } };
struct EpQG { bf16* Q; float* GATE; const float* bg; __device__ __forceinline__ void operator()(int m, int n, f32x4 v) const {
    if (n < 1024) st_bf4(Q + (size_t)m * DM + n, v * C2);
    else { for (int r = 0; r < 4; ++r) { const int i = n - 1024 + r; if (i < 48) GATE[(size_t)m * 48 + i] = 1.f / (1.f + __expf(-(v[r] + bg[i]))); } } }
    __device__ __forceinline__ void op8(int m, int n, f32x4 a, f32x4 c) const {
    if (n < 1024) st_bf8(Q + (size_t)m * DM + n, a * C2, c * C2);
    else { (*this)(m, n, a); (*this)(m, n + 4, c); } } };
struct EpF32 { float* O; int ld; __device__ __forceinline__ void operator()(int m, int n, f32x4 v) const { *(f32x4*)(O + (size_t)m * ld + n) = v; } };

template <bool PAIR, class AR, class EP>
__device__ __forceinline__ void gemm_dense(Frame& F, const AR& arow, const bf16* Bt, int K, int nM64, int nN64, int chbase, const EP& ep) {
    const int total = nM64 * nN64;
    for (int it = F.gw; it < total; it += F.NGW) {
        const int ni = it % nN64, mt = it / nN64;
        if constexpr (PAIR) { const int pn = ni >> 2, q = ni & 3;
            gemm_wave_tile<true>(arow, Bt + (size_t)(pn * 256 + q * 32) * K, K, mt * 64, chbase + pn * 128 + q * 32, ep, F.lane);
        } else gemm_wave_tile<false>(arow, Bt + (size_t)(ni * 64) * K, K, mt * 64, chbase + ni * 64, ep, F.lane);
    }
}

namespace pg8 {
#define PG8_LAS __attribute__((address_space(3)))
constexpr int BM = 256, BK = 64, HALF = 128, HTB = HALF * BK * 2, STAGE_BYTES = 8 * HTB, NXCD = 8, WGM = 8;
__device__ __forceinline__ int lds_byte(int r, int c) { const int st = (r >> 4) * 2 + (c >> 5), rr = r & 15, cc = c & 31, ob = rr * 64 + cc * 2; return st * 1024 + (ob ^ (((ob >> 9) & 1) << 5)); }
__device__ __forceinline__ void stage_rc(int b, int& R, int& C) { const int st = b / 1024, sb = b % 1024, swz = sb ^ (((sb >> 9) & 1) << 5); R = (st >> 1) * 16 + swz / 64; C = (st & 1) * 32 + (swz % 64) / 2; }
struct Unit { const char* A; const char* B; int row0, col0, e, pos0, cnt; };
__device__ __forceinline__ bool static_order(int i, int G, int c, int nM, int nN, int& pm, int& pn) {
    const int nwg = nM * nN; const long L = (long)i * G + c; if (L >= nwg) return false;
    int wgid = (int)L; { const int q = nwg / NXCD, r = nwg % NXCD, xcd = wgid % NXCD, off = wgid / NXCD; wgid = (xcd < r ? xcd * (q + 1) : r * (q + 1) + (xcd - r) * q) + off; }
    const int nig = WGM * nN, gid = wgid / nig, fm = gid * WGM, gsz = (nM - fm) < WGM ? (nM - fm) : WGM;
    pm = fm + ((wgid % nig) % gsz); pn = (wgid % nig) / gsz; return true;
}
__device__ __forceinline__ void voff_plain(const int (&R)[2], const int (&C)[2], int K, unsigned (&v)[2][2]) {
#pragma unroll
    for (int h = 0; h < 2; ++h)
#pragma unroll
        for (int i = 0; i < 2; ++i) v[h][i] = (unsigned)((h * HALF + R[i]) * K + C[i]) * 2u;
}
__device__ __forceinline__ int perm32(int rho) { const int n = rho >> 4, i = rho & 15; return 8 * (i >> 2) + 4 * n + (i & 3); }
template <class EP, bool PAIR, bool PERM_ = false> struct EpiWrap {
    static constexpr bool PERM = PERM_;
    EP ep;
    __device__ __forceinline__ void operator()(const f32x4 (&acc)[2][2][4][2], const Unit& u, int wr, int wc, int fr, int fq) const {
#pragma unroll
        for (int ai = 0; ai < 2; ++ai)
#pragma unroll
            for (int m = 0; m < 4; ++m) { const int row = u.row0 + ai * HALF + wr * 64 + m * 16 + fr;
                if constexpr (PERM_) {
                    if constexpr (PAIR) ep.pair8(u, row, u.col0 + wc * 32 + 8 * fq, acc[ai][0][m][0], acc[ai][0][m][1], acc[ai][1][m][0], acc[ai][1][m][1]);
                    else {
#pragma unroll
                        for (int bj = 0; bj < 2; ++bj) ep.op8(u, row, u.col0 + bj * HALF + wc * 32 + 8 * fq, acc[ai][bj][m][0], acc[ai][bj][m][1]); }
                } else if constexpr (PAIR) {
#pragma unroll
                    for (int n = 0; n < 2; ++n) ep.pair(u, row, u.col0 + wc * 32 + 16 * n + 4 * fq, acc[ai][0][m][n], acc[ai][1][m][n]);
                } else {
#pragma unroll
                    for (int bj = 0; bj < 2; ++bj)
#pragma unroll
                        for (int n = 0; n < 2; ++n) ep(u, row, u.col0 + bj * HALF + wc * 32 + 16 * n + 4 * fq, acc[ai][bj][m][n]);
                } }
    }
};
template <class Epi, class Sched, bool ALIGN_EPI, bool GATHER>
__device__ __forceinline__ void gemm_phase(PG8_LAS unsigned char* lds, const int K, const Sched& S, const Epi& E) {
    const int tid = threadIdx.x, wid = __builtin_amdgcn_readfirstlane(tid >> 6), lane = tid & 63, wr = wid >> 2, wc = wid & 3, fr = lane & 15, fq = lane >> 4;
    const int nt = K / BK;
    int R[2], C[2]; unsigned voffB[2]; unsigned vC[2][2], vN[2][2];
#pragma unroll
    for (int i = 0; i < 2; ++i) { stage_rc(tid * 16 + i * 8192, R[i], C[i]); const int Rb = Epi::PERM ? ((R[i] & ~31) | perm32(R[i] & 31)) : R[i]; voffB[i] = (unsigned)(Rb * K + C[i]) * 2u; }
    const size_t kstep = (size_t)(BK * 2);
    const size_t hstep = (size_t)HALF * K * 2;
    const unsigned ldsw = (unsigned)wid * 1024u;
    const int aoff = lds_byte(wr * 64 + fr, fq * 8), boff = lds_byte(wc * 32 + fr, fq * 8);
#define PG8_SA(b, h) (((b) * 2 + (h)) * HTB)
#define PG8_SB(b, h) ((4 + (b) * 2 + (h)) * HTB)
#define PG8_STAGE(bufoff, gbase, voff) do { _Pragma("unroll") for (int _i = 0; _i < 2; ++_i) \
        __builtin_amdgcn_global_load_lds((const unsigned*)((const char*)(gbase) + (voff)[_i]), (PG8_LAS unsigned*)(lds + (bufoff) + ldsw + _i * 8192), 16, 0, 0); } while (0)
#define PG8_LDA(dst, b, h) do { _Pragma("unroll") for (int m = 0; m < 4; ++m) _Pragma("unroll") for (int k = 0; k < 2; ++k) dst[m][k] = *(const PG8_LAS bf16x8*)(lds + PG8_SA(b, h) + aoff + m * 2048 + k * 1024); } while (0)
#define PG8_LDB(dst, b, h) do { _Pragma("unroll") for (int n = 0; n < 2; ++n) _Pragma("unroll") for (int k = 0; k < 2; ++k) dst[n][k] = *(const PG8_LAS bf16x8*)(lds + PG8_SB(b, h) + boff + n * 2048 + k * 1024); } while (0)
#define PG8_MMA(ai, bj, At, Bt) do { __builtin_amdgcn_s_setprio(1); _Pragma("unroll") for (int m = 0; m < 4; ++m) _Pragma("unroll") for (int n = 0; n < 2; ++n) _Pragma("unroll") for (int k = 0; k < 2; ++k) \
        acc[ai][bj][m][n] = __builtin_amdgcn_mfma_f32_16x16x32_bf16(Bt[n][k], At[m][k], acc[ai][bj][m][n], 0, 0, 0); __builtin_amdgcn_s_setprio(0); } while (0)
#define PG8_WAIT_V(n) asm volatile("s_waitcnt vmcnt(" #n ")" ::: "memory")
#define PG8_WAIT_L(n) asm volatile("s_waitcnt lgkmcnt(" #n ")" ::: "memory")
#define PG8_BAR __builtin_amdgcn_s_barrier()
#define PG8_SCHED __builtin_amdgcn_sched_barrier(0)
    Unit cur, nxt; int ui = 0;
    if (!S.next(0, cur)) return;
    S.voff(cur, R, C, K, vC);
    f32x4 acc[2][2][4][2];
#pragma unroll
    for (int a = 0; a < 2; ++a)
#pragma unroll
        for (int b = 0; b < 2; ++b)
#pragma unroll
            for (int m = 0; m < 4; ++m)
#pragma unroll
                for (int n = 0; n < 2; ++n) acc[a][b][m][n] = (f32x4){0.f, 0.f, 0.f, 0.f};
    bf16x8 At[4][2], B0[2][2], B1[2][2];
    const char* cA = cur.A; const char* cB = cur.B;
    PG8_STAGE(PG8_SB(0, 0), cB, voffB); PG8_STAGE(PG8_SB(0, 1), cB + hstep, voffB); PG8_STAGE(PG8_SA(0, 0), cA, vC[0]); PG8_STAGE(PG8_SA(0, 1), cA, vC[1]);
    if (wr == 1) PG8_BAR;
    PG8_WAIT_V(2); PG8_BAR;
    PG8_STAGE(PG8_SB(1, 0), cB + kstep, voffB); PG8_STAGE(PG8_SA(1, 0), cA + kstep, vC[0]); PG8_STAGE(PG8_SB(1, 1), cB + hstep + kstep, voffB);
    PG8_WAIT_V(6); PG8_BAR;
    for (;;) {
        const bool has_next = S.next(ui + 1, nxt);
        const char* nA = has_next ? nxt.A : cA; const char* nB = has_next ? nxt.B : cB;
        if constexpr (GATHER) { if (has_next) S.voff(nxt, R, C, K, vN); else { vN[0][0] = vC[0][0]; vN[0][1] = vC[0][1]; vN[1][0] = vC[1][0]; vN[1][1] = vC[1][1]; } }
        for (int t = 0; t < nt; t += 2) {
            const bool last = (t == nt - 2);
            const char* a1 = cA + (size_t)(t + 1) * kstep;
            const char* a2 = last ? nA : cA + (size_t)(t + 2) * kstep; const char* b2 = last ? nB : cB + (size_t)(t + 2) * kstep;
            const char* a3 = a2 + kstep; const char* b3 = b2 + kstep;
            unsigned v2[2][2];
#pragma unroll
            for (int h = 0; h < 2; ++h)
#pragma unroll
                for (int i = 0; i < 2; ++i) v2[h][i] = (GATHER && last) ? vN[h][i] : vC[h][i];
            PG8_LDB(B0, 0, 0); PG8_LDB(B1, 0, 1); PG8_SCHED; PG8_LDA(At, 0, 0); PG8_STAGE(PG8_SA(1, 1), a1, vC[1]);
            PG8_WAIT_V(8); PG8_WAIT_L(0); PG8_BAR; PG8_MMA(0, 0, At, B0); PG8_MMA(0, 1, At, B1); PG8_BAR; PG8_SCHED;
            PG8_LDA(At, 0, 1); PG8_STAGE(PG8_SB(0, 0), b2, voffB); PG8_STAGE(PG8_SB(0, 1), b2 + hstep, voffB); PG8_STAGE(PG8_SA(0, 0), a2, v2[0]);
            PG8_WAIT_V(8); PG8_WAIT_L(0); PG8_BAR; PG8_MMA(1, 0, At, B0); PG8_MMA(1, 1, At, B1); PG8_BAR; PG8_SCHED;
            PG8_LDB(B0, 1, 0); PG8_LDB(B1, 1, 1); PG8_SCHED; PG8_LDA(At, 1, 0); PG8_STAGE(PG8_SA(0, 1), a2, v2[1]);
            PG8_WAIT_V(8); PG8_WAIT_L(0); PG8_BAR; PG8_MMA(0, 0, At, B0); PG8_MMA(0, 1, At, B1); PG8_BAR; PG8_SCHED;
            PG8_LDA(At, 1, 1); PG8_STAGE(PG8_SB(1, 0), b3, voffB); PG8_STAGE(PG8_SB(1, 1), b3 + hstep, voffB); PG8_STAGE(PG8_SA(1, 0), a3, v2[0]);
            PG8_WAIT_V(8); PG8_WAIT_L(0); PG8_BAR; PG8_MMA(1, 0, At, B0); PG8_MMA(1, 1, At, B1); PG8_BAR; PG8_SCHED;
        }
        if constexpr (ALIGN_EPI) { if (wr == 0) PG8_BAR; }
        E(acc, cur, wr, wc, fr, fq);
        if (!has_next) break;
#pragma unroll
        for (int a = 0; a < 2; ++a)
#pragma unroll
            for (int b = 0; b < 2; ++b)
#pragma unroll
                for (int m = 0; m < 4; ++m)
#pragma unroll
                    for (int n = 0; n < 2; ++n) acc[a][b][m][n] = (f32x4){0.f, 0.f, 0.f, 0.f};
        cur = nxt; cA = nA; cB = nB; ++ui;
        if constexpr (GATHER) { vC[0][0] = vN[0][0]; vC[0][1] = vN[0][1]; vC[1][0] = vN[1][0]; vC[1][1] = vN[1][1]; }
        if constexpr (ALIGN_EPI) { if (wr == 1) PG8_BAR; }
    }
    PG8_WAIT_V(0);
    if constexpr (!ALIGN_EPI) { if (wr == 0) PG8_BAR; }
    PG8_BAR;
#undef PG8_SA
#undef PG8_SB
#undef PG8_STAGE
#undef PG8_LDA
#undef PG8_LDB
#undef PG8_MMA
#undef PG8_WAIT_V
#undef PG8_WAIT_L
#undef PG8_BAR
#undef PG8_SCHED
}
struct SchedDense {
    const char* A0; const char* B0; const char* A1; const char* B1; int nM, nN0, nN1, K, G, c, colmul;
    __device__ __forceinline__ bool next(int i, Unit& u) const {
        int pm, pn; if (!static_order(i, G, c, nM, nN0 + nN1, pm, pn)) return false;
        const int sec = pn >= nN0 ? 1 : 0, pl = pn - (sec ? nN0 : 0);
        u.A = (sec ? A1 : A0) + (size_t)pm * 256 * K * 2; u.B = (sec ? B1 : B0) + (size_t)pl * 256 * K * 2;
        u.row0 = pm * 256; u.col0 = pl * colmul; u.e = sec; u.pos0 = 0; u.cnt = 0; return true;
    }
    __device__ __forceinline__ void voff(const Unit&, const int (&R)[2], const int (&C)[2], int K_, unsigned (&v)[2][2]) const { voff_plain(R, C, K_, v); }
};
}
template <class EP> struct EpU { EP ep; __device__ __forceinline__ void operator()(const pg8::Unit&, int m, int n, f32x4 v) const { ep(m, n, v); }
    __device__ __forceinline__ void op8(const pg8::Unit&, int m, int n, f32x4 a, f32x4 b) const { ep.op8(m, n, a, b); } };
template <class EP> struct EpUP { EP ep; __device__ __forceinline__ void pair(const pg8::Unit&, int m, int ch, f32x4 a, f32x4 b) const { ep.pair(m, ch, a, b); }
    __device__ __forceinline__ void pair8(const pg8::Unit&, int m, int ch, f32x4 a0, f32x4 a1, f32x4 b0, f32x4 b1) const { ep.pair8(m, ch, a0, a1, b0, b1); } };
struct EpG1 { static constexpr bool PERM = true; bf16* BG; bf16* Z;
    __device__ __forceinline__ void operator()(const f32x4 (&acc)[2][2][4][2], const pg8::Unit& u, int wr, int wc, int fr, int fq) const {
        if (u.e == 0) { pg8::EpiWrap<EpU<EpBf16>, false, true> w{{{BG, DM}}}; w(acc, u, wr, wc, fr, fq); }
        else { pg8::Unit u2 = u; u2.col0 = u.col0 >> 1; pg8::EpiWrap<EpUP<EpMulPair>, true, true> w{{{Z, DM}}}; w(acc, u2, wr, wc, fr, fq); }
    } };
struct EpNull { static constexpr bool PERM = false; __device__ __forceinline__ void operator()(const f32x4 (&acc)[2][2][4][2], const pg8::Unit&, int, int, int, int) const {
#pragma unroll
    for (int a = 0; a < 2; ++a)
#pragma unroll
        for (int b = 0; b < 2; ++b)
#pragma unroll
            for (int m = 0; m < 4; ++m)
#pragma unroll
                for (int n = 0; n < 2; ++n) asm volatile("" :: "v"(acc[a][b][m][n])); } };
struct EpKVQG { bf16* KV; bf16* Q; float* GATE; const float* bg;
    __device__ __forceinline__ void operator()(const pg8::Unit& u, int m, int n, f32x4 v) const { if (u.e == 0) { EpKV e{KV}; e(m, n, v); } else { EpQG e{Q, GATE, bg}; e(m, n, v); } }
    __device__ __forceinline__ void op8(const pg8::Unit& u, int m, int n, f32x4 a, f32x4 b) const { if (u.e == 0) { EpKV e{KV}; e.op8(m, n, a, b); } else { EpQG e{Q, GATE, bg}; e.op8(m, n, a, b); } } };

__device__ __forceinline__ void p3_conv(Frame& F) {
    const bf16* BG = (const bf16*)(F.wsp() + WS_BG); const bf16* Z = (const bf16*)(F.wsp() + WS_Z); bf16* A2 = (bf16*)(F.wsp() + WS_A2);
    const float* cw = F.inp(I_CONVW); const float* cb = F.inp(I_CONVB);
    const int gt = F.gw * 64 + F.lane, NT_ = F.NGW * 64;
    for (int it = gt; it < T * 128; it += NT_) {
        const int m = it >> 7, ch = (it & 127) * 8, t = m & 4095;
        const u32x4 bg = *(const u32x4*)(BG + (size_t)m * DM + ch);
        const u32x4 z0 = *(const u32x4*)(Z + (size_t)m * DM + ch);
        u32x4 z1 = (u32x4){0, 0, 0, 0}, z2 = (u32x4){0, 0, 0, 0};
        if (t >= 1) z1 = *(const u32x4*)(Z + (size_t)(m - 1) * DM + ch);
        if (t >= 2) z2 = *(const u32x4*)(Z + (size_t)(m - 2) * DM + ch);
        u32x4 o;
#pragma unroll
        for (int w = 0; w < 4; ++w) {
            const int c = ch + 2 * w;
            const float r0 = bflo(bg[w]) * (cw[c] * bflo(z2[w]) + cw[1024 + c] * bflo(z1[w]) + cw[2048 + c] * bflo(z0[w]) + cb[c]);
            const float r1 = bfhi(bg[w]) * (cw[c + 1] * bfhi(z2[w]) + cw[1024 + c + 1] * bfhi(z1[w]) + cw[2048 + c + 1] * bfhi(z0[w]) + cb[c + 1]);
            o[w] = pk2(r0, r1);
        }
        *(u32x4*)(A2 + (size_t)m * DM + ch) = o;
    }
}

__device__ __forceinline__ void ln_row(f32x4 (&v)[4], const float* g, const float* bb, int lane) {
    float s = 0.f;
#pragma unroll
    for (int j = 0; j < 4; ++j) s += (v[j][0] + v[j][1]) + (v[j][2] + v[j][3]);
    const float mean = wave_sum(s) * (1.f / DM); float s2 = 0.f;
#pragma unroll
    for (int j = 0; j < 4; ++j) { v[j] = v[j] - mean; s2 += (v[j][0] * v[j][0] + v[j][1] * v[j][1]) + (v[j][2] * v[j][2] + v[j][3] * v[j][3]); }
    const float rstd = 1.f / sqrtf(wave_sum(s2) * (1.f / DM) + LN_EPS);
#pragma unroll
    for (int j = 0; j < 4; ++j) { const int col = 4 * lane + 256 * j; v[j] = v[j] * rstd * *(const f32x4*)(g + col) + *(const f32x4*)(bb + col); }
}
template <int L, bool DRY = false>
__device__ __forceinline__ void p_ln_router(Frame& F) {
    bf16* RES = (bf16*)(F.wsp() + WS_XB); bf16* U = (bf16*)(F.wsp() + WS_U);
    bf16* RESO = DRY ? (bf16*)(F.wsp() + WS_Y0) : RES; if (DRY) U = (bf16*)(F.wsp() + WS_H);
    const float* MOD = (const float*)(F.wsp() + WS_MOD) + (size_t)L * 4 * 6144;
    const float* rw = F.inp(I_RW); const float* rb = F.inp(I_RB);
    gu32* cnt = F.ctlp() + CW_CNT + L * 1024;
    unsigned* LIST = (unsigned*)(F.wsp() + WS_LIST) + (size_t)L * NE * T; float* LW = (float*)(F.wsp() + WS_LW) + (size_t)L * NE * T;
    const int lane = F.lane;
    LAS int* ae = (LAS int*)F.lds; LAS float* aw = (LAS float*)(F.lds + 512); LAS int* base = (LAS int*)(F.lds + 1024);
    constexpr int RS = 2064, AST_OFF = 2048, ALO_OFF = AST_OFF + 16 * RS, PST_OFF = ALO_OFF + 16 * RS;
    static_assert(PST_OFF + 8192 <= LDSCTL_OFF, "router LDS map");
    const int r16 = lane & 15, kg = lane >> 4;
    bf16x8 Bh[4], Bl[4];
#pragma unroll
    for (int s_ = 0; s_ < 4; ++s_) { u32x4 hh, ll;
#pragma unroll
        for (int i = 0; i < 4; ++i) { const int k = 128 * F.wave + 32 * s_ + 8 * kg + 2 * i; const float a = rw[(size_t)k * 16 + r16], b_ = rw[(size_t)(k + 1) * 16 + r16];
            const unsigned h = pk2(a, b_); hh[i] = h; ll[i] = pk2(a - bflo(h), b_ - bfhi(h)); }
        Bh[s_] = __builtin_bit_cast(bf16x8, hh); Bl[s_] = __builtin_bit_cast(bf16x8, ll); }
    const int nchunk = T / 64;
    for (int ch = blockIdx.x; ch < nchunk; ch += gridDim.x) {
      const bf16* YB = (const bf16*)(F.wsp() + WS_Y0); const float* XF = F.inp(I_X);
      u32x2 yn[4]; f32x4 xn[4];
#pragma unroll
      for (int j = 0; j < 4; ++j) { const size_t o = (size_t)(ch * 64 + F.wave * 2) * DM + 4 * lane + 256 * j; yn[j] = *(const u32x2*)(YB + o);
          if (L == 0) xn[j] = *(const f32x4*)(XF + o); else xn[j] = ld_bf4(RES + o); }
#pragma unroll 2
      for (int rr = 0; rr < 8; ++rr) {
        const int pass = rr >> 1, sub = rr & 1, lrow = pass * 16 + F.wave * 2 + sub, m = ch * 64 + lrow;
        const int b = m >> 12;
        f32x4 v[4];
#pragma unroll
        for (int j = 0; j < 4; ++j) { const f32x4 g1 = *(const f32x4*)(MOD + b * 6144 + 2 * 1024 + 4 * lane + 256 * j);
            v[j] = xn[j] * ALPHA + g1 * (f32x4){bflo(yn[j].x), bfhi(yn[j].x), bflo(yn[j].y), bfhi(yn[j].y)}; }
        if (rr < 7) {
#pragma unroll
            for (int j = 0; j < 4; ++j) { const size_t o = (size_t)(m + (sub ? 15 : 1)) * DM + 4 * lane + 256 * j; yn[j] = *(const u32x2*)(YB + o);
                if (L == 0) xn[j] = *(const f32x4*)(XF + o); else xn[j] = ld_bf4(RES + o); } }
        ln_row(v, F.inp(I_LNG) + (L * 2 + 0) * DM, F.inp(I_LNB) + (L * 2 + 0) * DM, lane);
        {
            LAS unsigned char* arow = F.lds + AST_OFF + (F.wave * 2 + sub) * RS + lane * 8;
#pragma unroll
            for (int j = 0; j < 4; ++j) { const int col = 4 * lane + 256 * j;
                st_bf4(RESO + (size_t)m * DM + col, v[j]);
                const f32x4 u = v[j] * (*(const f32x4*)(MOD + b * 6144 + 4 * 1024 + col) + 1.0f) + *(const f32x4*)(MOD + b * 6144 + 3 * 1024 + col);
                u32x2 hh, ll; hh.x = pk2(u[0], u[1]); hh.y = pk2(u[2], u[3]);
                ll.x = pk2(u[0] - bflo(hh.x), u[1] - bfhi(hh.x)); ll.y = pk2(u[2] - bflo(hh.y), u[3] - bfhi(hh.y));
                *(u32x2*)(U + (size_t)m * DM + col) = hh;
                *(LAS u32x2*)(arow + j * 512) = hh; *(LAS u32x2*)(arow + 16 * RS + j * 512) = ll; }
        }
        if (sub == 0) continue;
        __syncthreads();
        float lgv;
        {
            f32x4 acc = (f32x4){0.f, 0.f, 0.f, 0.f};
            const LAS unsigned char* ap = F.lds + AST_OFF + r16 * RS + (128 * F.wave + 8 * kg) * 2;
#pragma unroll
            for (int s_ = 0; s_ < 4; ++s_) { const bf16x8 ah = *(const LAS bf16x8*)(ap + s_ * 64), al = *(const LAS bf16x8*)(ap + 16 * RS + s_ * 64);
                acc = __builtin_amdgcn_mfma_f32_16x16x32_bf16(ah, Bh[s_], acc, 0, 0, 0);
                acc = __builtin_amdgcn_mfma_f32_16x16x32_bf16(al, Bh[s_], acc, 0, 0, 0);
                acc = __builtin_amdgcn_mfma_f32_16x16x32_bf16(ah, Bl[s_], acc, 0, 0, 0); }
            *(LAS f32x4*)(F.lds + PST_OFF + ((F.wave * 4 + kg) * 16 + r16) * 16) = acc;
            __syncthreads();
            const int rho = 2 * F.wave + (kg & 1); float sm = 0.f;
#pragma unroll
            for (int x = 0; x < 4; ++x) sm += *(const LAS float*)(F.lds + PST_OFF + ((((kg >> 1) * 4 + x) * 4 + (rho >> 2)) * 16 + r16) * 16 + (rho & 3) * 4);
            lgv = sm + __shfl_xor(sm, 32);
        }
#pragma unroll 1
        for (int sb = 0; sb < 2; ++sb) {
        const int lrow2 = pass * 16 + F.wave * 2 + sb;
        float lg[16];
#pragma unroll
        for (int e = 0; e < 16; ++e) lg[e] = __builtin_bit_cast(float, __builtin_amdgcn_readlane(__builtin_bit_cast(int, lgv), 16 * sb + e));
        float mx = lg[0];
#pragma unroll
        for (int e = 1; e < 16; ++e) mx = fmaxf(mx, lg[e]);
        float aff[16], bi[16]; float sum = 0.f;
#pragma unroll
        for (int e = 0; e < 16; ++e) { aff[e] = __expf(lg[e] - mx); sum += aff[e]; }
        const float inv = 1.f / sum;
#pragma unroll
        for (int e = 0; e < 16; ++e) { aff[e] *= inv; bi[e] = aff[e] + rb[e]; }
        float gs[4];
#pragma unroll
        for (int g = 0; g < 4; ++g) { const float a0 = bi[4 * g], a1 = bi[4 * g + 1], a2 = bi[4 * g + 2], a3 = bi[4 * g + 3];
            const float t1 = fmaxf(a0, a1), t2 = fminf(a0, a1), u1 = fmaxf(a2, a3), u2 = fminf(a2, a3);
            gs[g] = fmaxf(t1, u1) + fmaxf(fminf(t1, u1), fmaxf(t2, u2)); }
        int best = 0; float bv = gs[0];
#pragma unroll
        for (int g = 1; g < 4; ++g) if (gs[g] > bv) { bv = gs[g]; best = g; }
        float cb_[4], ca_[4];
#pragma unroll
        for (int i = 0; i < 4; ++i) { cb_[i] = best == 0 ? bi[i] : best == 1 ? bi[4 + i] : best == 2 ? bi[8 + i] : bi[12 + i];
                                      ca_[i] = best == 0 ? aff[i] : best == 1 ? aff[4 + i] : best == 2 ? aff[8 + i] : aff[12 + i]; }
        int i0 = 0; float b0 = cb_[0];
#pragma unroll
        for (int i = 1; i < 4; ++i) if (cb_[i] > b0) { b0 = cb_[i]; i0 = i; }
        int i1 = -1; float b1 = -3.0e38f;
#pragma unroll
        for (int i = 0; i < 4; ++i) if (i != i0 && cb_[i] > b1) { b1 = cb_[i]; i1 = i; }
        const float w0 = i0 == 0 ? ca_[0] : i0 == 1 ? ca_[1] : i0 == 2 ? ca_[2] : ca_[3];
        const float w1 = i1 == 0 ? ca_[0] : i1 == 1 ? ca_[1] : i1 == 2 ? ca_[2] : ca_[3];
        const float ws_ = 1.f / (w0 + w1);
        if (lane == 0) { ae[2 * lrow2] = best * 4 + i0; ae[2 * lrow2 + 1] = best * 4 + i1; aw[2 * lrow2] = w0 * ws_; aw[2 * lrow2 + 1] = w1 * ws_; }
        }
      }
      __syncthreads();
      if (DRY) continue;
      if (F.tid < NE) { int c = 0; for (int i = 0; i < 128; ++i) c += (ae[i] == F.tid) ? 1 : 0;
          base[F.tid] = c ? (int)__hip_atomic_fetch_add(cnt + F.tid * 64, (unsigned)c, RLX_AGENT) : 0; }
      __syncthreads();
      if (F.tid < 128) { const int e = ae[F.tid]; int rk = 0; for (int i = 0; i < F.tid; ++i) rk += (ae[i] == e) ? 1 : 0;
          const int pos = base[e] + rk; const unsigned m = (unsigned)(ch * 64 + (F.tid >> 1));
          LIST[(size_t)e * T + pos] = m * 2u + (unsigned)(F.tid & 1); LW[(size_t)e * T + pos] = aw[F.tid]; }
      __syncthreads();
    }
}
template <int L, bool DRY = false>
__device__ __forceinline__ void p_ln2(Frame& F) {
    bf16* RES = (bf16*)(F.wsp() + WS_XB); bf16* U = (bf16*)(F.wsp() + WS_U); float* OUT = F.outp();
    bf16* RESO = DRY ? (bf16*)(F.wsp() + WS_R1) : RES; if (DRY) { U = (bf16*)(F.wsp() + WS_H); }
    const bf16* Y0 = (const bf16*)(F.wsp() + WS_Y0); const bf16* Y1 = (const bf16*)(F.wsp() + WS_Y1);
    const float* MOD = (const float*)(F.wsp() + WS_MOD) + (size_t)L * 4 * 6144;
    const float* MODN = (const float*)(F.wsp() + WS_MOD) + (size_t)1 * 4 * 6144;
    const int lane = F.lane;
    for (int m = F.gw; m < T; m += F.NGW) {
        const int b = m >> 12;
        f32x4 v[4];
#pragma unroll
        for (int j = 0; j < 4; ++j) { const int col = 4 * lane + 256 * j;
            const f32x4 x = ld_bf4(RES + (size_t)m * DM + col);
            const u32x2 a = *(const u32x2*)(Y0 + (size_t)m * DM + col), c = *(const u32x2*)(Y1 + (size_t)m * DM + col);
            const f32x4 y = (f32x4){bflo(a.x) + bflo(c.x), bfhi(a.x) + bfhi(c.x), bflo(a.y) + bflo(c.y), bfhi(a.y) + bfhi(c.y)};
            v[j] = x * ALPHA + *(const f32x4*)(MOD + b * 6144 + 5 * 1024 + col) * y; }
        ln_row(v, F.inp(I_LNG) + (L * 2 + 1) * DM, F.inp(I_LNB) + (L * 2 + 1) * DM, lane);
#pragma unroll
        for (int j = 0; j < 4; ++j) { const int col = 4 * lane + 256 * j;
            if (L == 1) *(f32x4*)(OUT + (size_t)m * DM + col) = v[j];
            if (L == 0) { st_bf4(RESO + (size_t)m * DM + col, v[j]);
                st_bf4(U + (size_t)m * DM + col, v[j] * (*(const f32x4*)(MODN + b * 6144 + 1024 + col) + 1.0f) + *(const f32x4*)(MODN + b * 6144 + col)); } }
    }
}

__device__ __forceinline__ void moe_tables(Frame& F, int L) {
    LAS int* tb = (LAS int*)(F.lds + MISC_OFF + 128); LAS int* cn = tb + 20;
    __syncthreads();
    if (F.tid == 0) { int acc = 0; for (int e = 0; e < NE; ++e) { const int c = (int)__hip_atomic_load(F.ctlp() + CW_CNT + L * 1024 + e * 64, RLX_AGENT); cn[e] = c; tb[e] = acc; acc += (c + 255) >> 8; } tb[NE] = acc; }
    __syncthreads();
}
struct ARowMoe { const bf16* U; const unsigned* list; int rbase, cnt;
    __device__ __forceinline__ const bf16* operator()(int r) const { const int pos = r - rbase; const unsigned tok = pos < cnt ? (list[pos] >> 1) : 0u; return U + (size_t)tok * DM; } };
struct EpY { bf16* Y; const unsigned* list; const float* lw; int rbase, cnt;
    __device__ __forceinline__ void operator()(int r, int n, f32x4 v) const { const int pos = r - rbase; if (pos < cnt) { const unsigned ts = list[pos]; const float w = lw[pos];
        st_bf4(Y + (size_t)(ts & 1u) * ((size_t)T * DM) + (size_t)(ts >> 1) * DM + n, v * w); } } };
template <int L>
__device__ __forceinline__ void p_moe_gu(Frame& F) {
    moe_tables(F, L);
    LAS int* tb = (LAS int*)(F.lds + MISC_OFF + 128); LAS int* cn = tb + 20;
    const unsigned* LIST = (const unsigned*)(F.wsp() + WS_LIST) + (size_t)L * NE * T;
    const int total = tb[NE] * 4 * 16;
    for (int it = F.gw; it < total; it += F.NGW) {
        const int ni = it & 15, mt = it >> 4; int e = 0; while (tb[e + 1] * 4 <= mt) ++e;
        const ARowMoe ar{(const bf16*)(F.wsp() + WS_U), LIST + (size_t)e * T, tb[e] * 256, cn[e]};
        const EpSiluPair ep{(bf16*)(F.wsp() + WS_H), FF};
        const int pn = ni >> 2, q = ni & 3;
        gemm_wave_tile<true>(ar, (const bf16*)(F.wsp() + WS_WGU) + (size_t)(L * NE + e) * 1024 * 1024 + (size_t)(pn * 256 + q * 32) * 1024, 1024, mt * 64, pn * 128 + q * 32, ep, F.lane);
    }
}
template <int L>
__device__ __forceinline__ void p_moe_down(Frame& F) {
    moe_tables(F, L);
    LAS int* tb = (LAS int*)(F.lds + MISC_OFF + 128); LAS int* cn = tb + 20;
    const unsigned* LIST = (const unsigned*)(F.wsp() + WS_LIST) + (size_t)L * NE * T; const float* LW = (const float*)(F.wsp() + WS_LW) + (size_t)L * NE * T;
    const int total = tb[NE] * 4 * 16;
    for (int it = F.gw; it < total; it += F.NGW) {
        const int ni = it & 15, mt = it >> 4; int e = 0; while (tb[e + 1] * 4 <= mt) ++e;
        const ARowPlain ar{(const bf16*)(F.wsp() + WS_H), FF};
        const EpY ep{(bf16*)(F.wsp() + WS_Y0), LIST + (size_t)e * T, LW + (size_t)e * T, tb[e] * 256, cn[e]};
        gemm_wave_tile<false>(ar, (const bf16*)(F.wsp() + WS_WDN) + (size_t)(L * NE + e) * 1024 * 512 + (size_t)(ni * 64) * 512, 512, mt * 64, ni * 64, ep, F.lane);
    }
}

struct ARowCmp { const bf16* KVi; __device__ __forceinline__ const bf16* operator()(int R) const { return KVi + ((size_t)(R >> 8) * KVROWS + (size_t)(R & 255) * 16) * 64; } };
__device__ __forceinline__ float gelu_tanh(float x) { const float u = 0.7978845608028654f * (x + 0.044715f * x * x * x); const float e = __expf(2.f * u); const float th = 1.f - 2.f / (e + 1.f); return 0.5f * x * (1.f + th); }
__device__ __forceinline__ void p_cmp_finish(Frame& F) {
    LAS float* w2s = (LAS float*)F.lds;
    LAS float* hd = (LAS float*)(F.lds + 65536 + F.wave * 4096);
    const float* TB = (const float*)(F.wsp() + WS_TB); const float* PETP = (const float*)(F.wsp() + WS_PETP);
    const int lane = F.lane;
    for (int base = blockIdx.x * 32; base < 2 * 16 * 256; base += gridDim.x * 32) {
        const int i = base >> 12;
        __syncthreads();
        for (int u = F.tid; u < 4096; u += 512) *(LAS f32x4*)(w2s + 4 * u) = *(const f32x4*)(F.inp(I_CW2) + (size_t)i * 256 * 64 + 4 * u);
        const int it0 = base + F.wave * 4, bh = (it0 >> 8) & 15, n0 = it0 & 255, c = 4 * lane;
        f32x4 pe = *(const f32x4*)(F.inp(I_CB1) + i * 256 + c);
#pragma unroll
        for (int k = 0; k < 32; ++k) pe += *(const f32x4*)(PETP + (k * 2 + i) * 256 + c);
#pragma unroll
        for (int r = 0; r < 4; ++r) { const int n = n0 + r;
            f32x4 h = (f32x4){0.f, 0.f, 0.f, 0.f};
            if (n < 255) { const float* r0 = TB + ((size_t)i * 4096 + bh * 256 + n) * 512; h = *(const f32x4*)(r0 + c) + *(const f32x4*)(r0 + 512 + 256 + c) + pe; }
#pragma unroll
            for (int q = 0; q < 4; ++q) hd[(c + q) * 4 + r] = gelu_tanh(h[q]); }
        __syncthreads();
        const float b2 = F.inp(I_CB2)[i * 64 + lane];
        float a0 = b2, a1 = b2, a2 = b2, a3 = b2;
#pragma unroll 8
        for (int cc = 0; cc < 256; ++cc) { const float w = w2s[cc * 64 + lane]; const f32x4 h4 = *(const LAS f32x4*)(hd + cc * 4);
            a0 += h4[0] * w; a1 += h4[1] * w; a2 += h4[2] * w; a3 += h4[3] * w; }
        const float av[4] = {a0, a1, a2, a3};
#pragma unroll
        for (int r = 0; r < 4; ++r) { const int n = n0 + r;
            bf16* dst = (bf16*)(F.wsp() + (i ? WS_VC : WS_KC)) + (size_t)bh * 256 * 64 + (size_t)(n >> 6) * 4096 + (i ? vfrag_off(n & 63, lane) : kfrag_off(n & 63, lane));
            *dst = (n == 255) ? (bf16)0 : (bf16)f2bf(av[r]); }
    }
}

__device__ __forceinline__ void score_tile(const bf16* krow, const LAS float* qs, float (&s)[4]) {
    s[0] = s[1] = s[2] = s[3] = 0.f;
#pragma unroll
    for (int c = 0; c < 8; ++c) { const u32x4 kv = *(const u32x4*)(krow + 8 * c);
#pragma unroll
        for (int w = 0; w < 4; ++w) { const f32x4 qa = *(const LAS f32x4*)(qs + (8 * c + 2 * w) * 4), qb = *(const LAS f32x4*)(qs + (8 * c + 2 * w + 1) * 4);
            const float ka = bflo(kv[w]), kb = bfhi(kv[w]);
            s[0] += ka * qa[0] + kb * qb[0]; s[1] += ka * qa[1] + kb * qb[1]; s[2] += ka * qa[2] + kb * qb[2]; s[3] += ka * qa[3] + kb * qb[3]; } }
}
__device__ __forceinline__ void attend_tile(const bf16* Kt, const bf16* Vt, bool valid, const LAS float* qs, LAS float* pbuf, float (&mr)[4], float (&l)[4], float (&o)[4], int lane) {
    float s[4]; score_tile(Kt + (size_t)lane * 64, qs, s);
    f32x4 p4;
#pragma unroll
    for (int g = 0; g < 4; ++g) {
        const float sg = valid ? s[g] : -INFINITY; const float tm = wave_max(sg); const float mn = fmaxf(mr[g], tm);
        const float mref = (mn == -INFINITY) ? 0.f : mn;
        const float alpha = __builtin_amdgcn_exp2f(mr[g] - mref); const float p = valid ? __builtin_amdgcn_exp2f(sg - mref) : 0.f;
        l[g] = l[g] * alpha + wave_sum(p); o[g] *= alpha; mr[g] = mn; p4[g] = p;
    }
    LDS_WAIT(); asm volatile("" ::: "memory");
    *(LAS f32x4*)(pbuf + lane * 4) = p4;
    LDS_WAIT(); asm volatile("" ::: "memory");
#pragma unroll 8
    for (int k = 0; k < 64; ++k) { const f32x4 pk = *(const LAS f32x4*)(pbuf + k * 4); const float vv = bf2f(Vt[(size_t)k * 64 + lane]);
        o[0] += pk[0] * vv; o[1] += pk[1] * vv; o[2] += pk[2] * vv; o[3] += pk[3] * vv; }
    LDS_WAIT(); asm volatile("" ::: "memory");
}
__device__ __forceinline__ void p_attn_simple(Frame& F) {
    LAS float* qs = (LAS float*)(F.lds + F.wave * 16384);
    LAS float* pbuf = qs + 256;
    LAS float* psum = pbuf + 1024;
    const bf16* Q = (const bf16*)(F.wsp() + WS_Q); const float* GATE = (const float*)(F.wsp() + WS_GATE); bf16* O = (bf16*)(F.wsp() + WS_O);
    const bf16* KVb = (const bf16*)(F.wsp() + WS_KV);
    const int lane = F.lane;
    for (int it = F.gw; it < 16 * SEQ; it += F.NGW) {
        const int bh = it & 15, t = it >> 4, b = bh >> 2, hk = bh & 3, m = b * SEQ + t;
        LDS_WAIT(); asm volatile("" ::: "memory");
        { f32x4 q4; for (int g = 0; g < 4; ++g) q4[g] = bf2f(Q[(size_t)m * DM + (hk * 4 + g) * 64 + lane]); *(LAS f32x4*)(qs + lane * 4) = q4; }
        LDS_WAIT(); asm volatile("" ::: "memory");
        const bf16* KC = (const bf16*)(F.wsp() + WS_KC) + (size_t)bh * 256 * 64; const bf16* VC = (const bf16*)(F.wsp() + WS_VC) + (size_t)bh * 256 * 64;
        const int nv = t >= 31 ? ((t - 31) >> 4) + 1 : 0;
        float sc[4][4];
#pragma unroll
        for (int i = 0; i < 4; ++i) { float s[4] = {0.f, 0.f, 0.f, 0.f}; if (64 * i < nv) score_tile(KC + (size_t)(64 * i + lane) * 64, qs, s);
            const bool v = (64 * i + lane) < nv;
#pragma unroll
            for (int g = 0; g < 4; ++g) sc[i][g] = v ? s[g] : -INFINITY; }
        float oc[4];
#pragma unroll
        for (int g = 0; g < 4; ++g) {
            const float mx = wave_max(fmaxf(fmaxf(sc[0][g], sc[1][g]), fmaxf(sc[2][g], sc[3][g]))); const float mref = (mx == -INFINITY) ? 0.f : mx;
            float e[4]; float ls = 0.f;
#pragma unroll
            for (int i = 0; i < 4; ++i) { e[i] = __builtin_amdgcn_exp2f(sc[i][g] - mref); ls += e[i]; }
            const float inv = 1.f / fmaxf(wave_sum(ls), 1e-30f);
#pragma unroll
            for (int i = 0; i < 4; ++i) sc[i][g] = e[i] * inv;
        }
#pragma unroll
        for (int i = 0; i < 4; ++i) { *(LAS f32x4*)(pbuf + (64 * i + lane) * 4) = (f32x4){sc[i][0], sc[i][1], sc[i][2], sc[i][3]};
            psum[64 * i + lane + 1] = (sc[i][0] + sc[i][1]) + (sc[i][2] + sc[i][3]); }
        if (lane == 0) psum[0] = 0.f;
        LDS_WAIT(); asm volatile("" ::: "memory");
        oc[0] = oc[1] = oc[2] = oc[3] = 0.f;
        for (int n = 0; n < nv; ++n) { const f32x4 pk = *(const LAS f32x4*)(pbuf + n * 4); const float vv = bf2f(VC[(size_t)n * 64 + lane]);
            oc[0] += pk[0] * vv; oc[1] += pk[1] * vv; oc[2] += pk[2] * vv; oc[3] += pk[3] * vv; }
        const float imp = 0.5f * psum[4 * lane] + psum[4 * lane + 1] + psum[4 * lane + 2] + psum[4 * lane + 3] + 0.5f * psum[4 * lane + 4];
        const int cur = t >> 6;
        const bool allowed = lane <= cur, forced = allowed && (lane == 0 || lane == cur || lane == cur - 1);
        const float score = forced ? 1e9f : (allowed ? imp : -1e30f);
        int rank = 0;
#pragma unroll
        for (int j = 0; j < 64; ++j) { const float sj = __shfl(score, j); rank += (sj > score || (sj == score && j < lane)) ? 1 : 0; }
        const unsigned long long mask = __ballot(rank < 16 && score > -0.5e30f);
        LDS_WAIT(); asm volatile("" ::: "memory");
        const bf16* KS = KVb + 2 * KVBUF_ELEMS + (size_t)bh * KVROWS * 64; const bf16* VS = KVb + 3 * KVBUF_ELEMS + (size_t)bh * KVROWS * 64;
        float ms[4] = {-INFINITY, -INFINITY, -INFINITY, -INFINITY}, ls[4] = {0.f, 0.f, 0.f, 0.f}, os[4] = {0.f, 0.f, 0.f, 0.f};
        for (unsigned long long mk = mask; mk; mk &= mk - 1) { const int j = __builtin_ctzll(mk);
            attend_tile(KS + (size_t)j * 64 * 64, VS + (size_t)j * 64 * 64, (64 * j + lane) <= t, qs, pbuf, ms, ls, os, lane); }
        const bf16* KW = KVb + 4 * KVBUF_ELEMS + (size_t)bh * KVROWS * 64; const bf16* VW = KVb + 5 * KVBUF_ELEMS + (size_t)bh * KVROWS * 64;
        float mw[4] = {-INFINITY, -INFINITY, -INFINITY, -INFINITY}, lw[4] = {0.f, 0.f, 0.f, 0.f}, ow[4] = {0.f, 0.f, 0.f, 0.f};
        const int lo = t - 511 > 0 ? t - 511 : 0;
        for (int j = lo >> 6; j <= (t >> 6); ++j) { const int pos = 64 * j + lane;
            attend_tile(KW + (size_t)j * 64 * 64, VW + (size_t)j * 64 * 64, pos >= lo && pos <= t, qs, pbuf, mw, lw, ow, lane); }
#pragma unroll
        for (int g = 0; g < 4; ++g) { const float* gp = GATE + (size_t)m * 48 + (hk * 4 + g) * 3;
            const float o = gp[0] * oc[g] + gp[1] * os[g] / fmaxf(ls[g], 1e-30f) + gp[2] * ow[g] / fmaxf(lw[g], 1e-30f);
            O[(size_t)m * DM + (hk * 4 + g) * 64 + lane] = (bf16)f2bf(o); }
    }
}

struct SchedCmp { const char* KV; const char* W1C; int G, c;
    __device__ __forceinline__ bool next(int it, pg8::Unit& u) const { const int L = it * G + c; if (c < 0 || L >= 64) return false;
        const int i = L >> 5, pm = (L >> 1) & 15, pn = L & 1;
        u.A = KV + ((size_t)i * KVBUF_ELEMS + (size_t)pm * KVROWS * 64) * 2; u.B = W1C + ((size_t)i * 512 * 1024 + (size_t)pn * 256 * 1024) * 2;
        u.row0 = i * 4096 + pm * 256; u.col0 = pn * 256; u.e = i; u.pos0 = 0; u.cnt = 0; return true; }
    __device__ __forceinline__ void voff(const pg8::Unit&, const int (&R)[2], const int (&C)[2], int K_, unsigned (&v)[2][2]) const { pg8::voff_plain(R, C, K_, v); }
};
struct SchedKVQG { const char* A0; const char* B0; const char* A1; const char* B1; int G, c, Lbase, Lend;
    __device__ __forceinline__ bool next(int it, pg8::Unit& u) const { const int L = Lbase + it * G + c; if (c < 0 || L >= Lend) return false;
        const int sec = L >= 384 ? 1 : 0, l = sec ? L - 384 : L, nn = sec ? 5 : 6, pm = l / nn, pn = l % nn;
        u.A = (sec ? A1 : A0) + (size_t)pm * 256 * DM * 2; u.B = (sec ? B1 : B0) + (size_t)pn * 256 * DM * 2;
        u.row0 = pm * 256; u.col0 = pn * 256; u.e = sec; u.pos0 = 0; u.cnt = 0; return true; }
    __device__ __forceinline__ void voff(const pg8::Unit&, const int (&R)[2], const int (&C)[2], int K_, unsigned (&v)[2][2]) const { pg8::voff_plain(R, C, K_, v); }
};
struct SchedMoe { LAS int* tb; LAS int* cn; const unsigned* LIST; const char* Abase; const char* Bbase; size_t bstride; int K, nN, colmul, G, c; bool gather; int Lbase, Lend;
    __device__ __forceinline__ bool next(int it, pg8::Unit& u) const { const int L = Lbase + it * G + c; if (c < 0 || L >= Lend) return false;
        const int mt = L / nN, pn = L % nN; int e = 0; while (tb[e + 1] <= mt) ++e;
        u.A = gather ? Abase : Abase + (size_t)mt * 256 * K * 2; u.B = Bbase + (size_t)e * bstride + (size_t)pn * 256 * K * 2;
        u.row0 = mt * 256; u.col0 = pn * colmul; u.e = e; u.pos0 = (mt - tb[e]) * 256; u.cnt = cn[e]; return true; }
    __device__ __forceinline__ void voff(const pg8::Unit& u, const int (&R)[2], const int (&C)[2], int K_, unsigned (&v)[2][2]) const {
        if (!gather) { pg8::voff_plain(R, C, K_, v); return; }
        const unsigned* le = LIST + (size_t)u.e * T;
#pragma unroll
        for (int h = 0; h < 2; ++h)
#pragma unroll
            for (int i = 0; i < 2; ++i) { const int pos = u.pos0 + h * 128 + R[i]; const unsigned tok = pos < u.cnt ? (le[pos] >> 1) : 0u; v[h][i] = (tok * (unsigned)K_ + (unsigned)C[i]) * 2u; }
    }
};
struct EpHU { bf16* H; __device__ __forceinline__ void pair(const pg8::Unit&, int r, int ch, f32x4 a, f32x4 b) const {
    f32x4 s; for (int q = 0; q < 4; ++q) s[q] = silu_f(a[q]) * b[q]; st_bf4(H + (size_t)r * FF + ch, s); }
    __device__ __forceinline__ void pair8(const pg8::Unit&, int r, int ch, f32x4 a0, f32x4 a1, f32x4 b0, f32x4 b1) const {
    f32x4 s0, s1; for (int q = 0; q < 4; ++q) { s0[q] = silu_f(a0[q]) * b0[q]; s1[q] = silu_f(a1[q]) * b1[q]; } st_bf8(H + (size_t)r * FF + ch, s0, s1); } };
struct EpYU { bf16* Y; const unsigned* LIST; const float* LW;
    __device__ __forceinline__ void operator()(const pg8::Unit& u, int r, int n, f32x4 v) const { const int pos = u.pos0 + (r - u.row0);
        if (pos < u.cnt) { const unsigned ts = LIST[(size_t)u.e * T + pos]; const float w = LW[(size_t)u.e * T + pos];
            st_bf4(Y + (size_t)(ts & 1u) * ((size_t)T * DM) + (size_t)(ts >> 1) * DM + n, v * w); } }
    __device__ __forceinline__ void op8(const pg8::Unit& u, int r, int n, f32x4 a, f32x4 b) const { const int pos = u.pos0 + (r - u.row0);
        if (pos < u.cnt) { const unsigned ts = LIST[(size_t)u.e * T + pos]; const float w = LW[(size_t)u.e * T + pos];
            st_bf8(Y + (size_t)(ts & 1u) * ((size_t)T * DM) + (size_t)(ts >> 1) * DM + n, a * w, b * w); } } };
struct EpYUAll { static constexpr bool PERM = true; EpYU ep;
    __device__ __forceinline__ void operator()(const f32x4 (&acc)[2][2][4][2], const pg8::Unit& u, int wr, int wc, int fr, int fq) const {
        unsigned ts[2][4]; float w[2][4];
        const unsigned* le = ep.LIST + (size_t)u.e * T; const float* lw = ep.LW + (size_t)u.e * T;
#pragma unroll
        for (int ai = 0; ai < 2; ++ai)
#pragma unroll
            for (int m = 0; m < 4; ++m) { const int pos = u.pos0 + ai * pg8::HALF + wr * 64 + m * 16 + fr; const int pc = pos < u.cnt ? pos : u.cnt - 1;
                const unsigned t_ = le[pc]; ts[ai][m] = pos < u.cnt ? t_ : 0xFFFFFFFFu; w[ai][m] = lw[pc]; }
#pragma unroll
        for (int ai = 0; ai < 2; ++ai)
#pragma unroll
            for (int m = 0; m < 4; ++m) if (ts[ai][m] != 0xFFFFFFFFu) {
                bf16* yr = ep.Y + (size_t)(ts[ai][m] & 1u) * ((size_t)T * DM) + (size_t)(ts[ai][m] >> 1) * DM + u.col0 + wc * 32 + 8 * fq;
#pragma unroll
                for (int bj = 0; bj < 2; ++bj) st_bf8(yr + bj * pg8::HALF, acc[ai][bj][m][0] * w[ai][m], acc[ai][bj][m][1] * w[ai][m]); }
    } };
template <int L>
__device__ __forceinline__ void p_moe(Frame& F, const XcdBarrier& bar, bool with_barriers) {
    moe_tables(F, L);
    LAS int* tb = (LAS int*)(F.lds + MISC_OFF + 128); LAS int* cn = tb + 20;
    const int G = gridDim.x, bx = blockIdx.x, vcu = (G % 8 == 0) ? (bx % 8) * (G / 8) + bx / 8 : bx;
    const int nt = tb[NE], n128 = nt < 128 ? nt : 128, Wg = 4 * (nt - n128) < G / 2 ? 4 * (nt - n128) : G / 2;
    const int D2 = (4 * n128 < 2 * (G - Wg)) ? 4 * n128 : 2 * (G - Wg);
#pragma unroll 1
    for (int part = 1; part <= 3; ++part) {
        int gc = -1, gG = 1, gb = 0, ge = 0, dc = -1, dG = 1, db = 0, de = 0;
        if (part == 1) { gc = vcu; gG = G; gb = 0; ge = 4 * n128; }
        else if (part == 2) { if (vcu < Wg) { gc = vcu; gG = Wg; gb = 4 * n128; ge = 4 * nt; } else { dc = vcu - Wg; dG = G - Wg; db = 0; de = D2; } }
        else { dc = vcu; dG = G; db = D2; de = 4 * nt; }
        {
            const SchedMoe S{tb, cn, (const unsigned*)(F.wsp() + WS_LIST) + (size_t)L * NE * T, (const char*)(F.wsp() + WS_U), (const char*)(F.wsp() + WS_WGU) + (size_t)L * NE * 1024 * 1024 * 2, (size_t)1024 * 1024 * 2, 1024, 4, 128, gG, gc, true, gb, ge};
            typedef pg8::EpiWrap<EpHU, true, true> E_;
            pg8::gemm_phase<E_, SchedMoe, true, true>(F.lds, 1024, S, E_{{(bf16*)(F.wsp() + WS_H)}});
        }
        {
            const SchedMoe S{tb, cn, nullptr, (const char*)(F.wsp() + WS_H), (const char*)(F.wsp() + WS_WDN) + (size_t)L * NE * 1024 * 512 * 2, (size_t)1024 * 512 * 2, 512, 4, 256, dG, dc, false, db, de};
            typedef EpYUAll E_;
            pg8::gemm_phase<E_, SchedMoe, true, false>(F.lds, 512, S, E_{{(bf16*)(F.wsp() + WS_Y0), (const unsigned*)(F.wsp() + WS_LIST) + (size_t)L * NE * T, (const float*)(F.wsp() + WS_LW) + (size_t)L * NE * T}});
        }
        if (part < 3 && with_barriers) xcd_barrier(bar);
    }
}
typedef float f32x16 __attribute__((ext_vector_type(16)));
#define MFMA32(a, b, c) __builtin_amdgcn_mfma_f32_32x32x16_bf16(a, b, c, 0, 0, 0)
constexpr size_t WS_MASK = WS_GATE + 3 * MiB;
constexpr int STG_STRIDE = 68, STG_BYTES = 32 * STG_STRIDE * 4;
__device__ __forceinline__ int crow(int r, int hi) { return (r & 3) + 8 * (r >> 2) + 4 * hi; }
__device__ __forceinline__ unsigned cvtpk(float lo, float hi) { f32x2v v = {lo, hi}; bf16x2_t b = __builtin_convertvector(v, bf16x2_t); return __builtin_bit_cast(unsigned, b); }
__device__ __forceinline__ float partner32(float x, int hi) { auto rr = __builtin_amdgcn_permlane32_swap(__builtin_bit_cast(unsigned, x), __builtin_bit_cast(unsigned, x), false, false);
    return __builtin_bit_cast(float, hi ? rr[0] : rr[1]); }
__device__ __forceinline__ float max3f(float a, float b, float c) { float r; asm("v_max3_f32 %0, %1, %2, %3" : "=v"(r) : "v"(a), "v"(b), "v"(c)); return r; }
__device__ __forceinline__ float max2f(float a, float b) { float r; asm("v_max_f32_e32 %0, %1, %2" : "=v"(r) : "v"(a), "v"(b)); return r; }
__device__ __forceinline__ float rowmax32(f32x16& p0, f32x16& p1, int hi) {
    asm volatile("s_nop 15\n\ts_nop 7" : "+v"(p0), "+v"(p1));
    float a = max3f(p0[0], p0[1], p1[0]), b = max3f(p0[2], p0[3], p1[1]); a = max3f(a, p1[2], p1[3]);
#pragma unroll
    for (int r = 4; r < 16; r += 4) { a = max3f(a, p0[r], p0[r + 1]); b = max3f(b, p0[r + 2], p0[r + 3]); a = max3f(a, p1[r], p1[r + 1]); b = max3f(b, p1[r + 2], p1[r + 3]); }
    const float m = max2f(a, b);
    return max2f(m, partner32(m, hi));
}
typedef __amdgpu_buffer_rsrc_t rsrc_t;
__device__ __forceinline__ rsrc_t make_rsrc(const void* base, unsigned bytes) { return __builtin_amdgcn_make_buffer_rsrc((void*)base, 0, (int)bytes, 0x00020000); }
__device__ __forceinline__ void load_frag8(bf16x8 (&f)[8], rsrc_t rs, unsigned vo, unsigned so) {
#pragma unroll
    for (int i = 0; i < 8; ++i) f[i] = __builtin_bit_cast(bf16x8, __builtin_amdgcn_raw_buffer_load_b128(rs, vo + i * 1024, so, 0));
}
__device__ __forceinline__ void qk_tile(f32x16& p0, f32x16& p1, const bf16x8 (&kf)[8], const LAS bf16x8* qs, const float cinit) {
    bf16x8 qr[4];
#pragma unroll
    for (int d0 = 0; d0 < 4; ++d0) qr[d0] = qs[d0 * 64];
    f32x16 c;
#pragma unroll
    for (int r = 0; r < 16; ++r) c[r] = cinit;
    p0 = MFMA32(kf[0], qr[0], c); p1 = MFMA32(kf[4], qr[0], c);
#pragma unroll
    for (int d0 = 1; d0 < 4; ++d0) { p0 = MFMA32(kf[d0], qr[d0], p0); p1 = MFMA32(kf[4 + d0], qr[d0], p1); }
}
__device__ __forceinline__ void qk_tile_lo(f32x16& p0, f32x16& p1, rsrc_t rs, unsigned vo, unsigned so, const LAS bf16x8* qs, const float cinit) {
    bf16x8 qr[4];
#pragma unroll
    for (int d0 = 0; d0 < 4; ++d0) qr[d0] = qs[d0 * 64];
#pragma unroll
    for (int r = 0; r < 16; ++r) { p0[r] = cinit; p1[r] = cinit; }
    { bf16x8 kf[4];
#pragma unroll
      for (int d0 = 0; d0 < 4; ++d0) kf[d0] = __builtin_bit_cast(bf16x8, __builtin_amdgcn_raw_buffer_load_b128(rs, vo + d0 * 1024, so, 0));
#pragma unroll
      for (int d0 = 0; d0 < 4; ++d0) p0 = MFMA32(kf[d0], qr[d0], p0); }
    asm volatile("" : "+v"(p0) :: "memory");
    { bf16x8 kf[4];
#pragma unroll
      for (int d0 = 0; d0 < 4; ++d0) kf[d0] = __builtin_bit_cast(bf16x8, __builtin_amdgcn_raw_buffer_load_b128(rs, vo + (4 + d0) * 1024, so, 0));
#pragma unroll
      for (int d0 = 0; d0 < 4; ++d0) p1 = MFMA32(kf[d0], qr[d0], p1); }
}
__device__ __forceinline__ void mask_tile(f32x16& p0, f32x16& p1, int lo, int lim, int hi) {
#pragma unroll
    for (int r = 0; r < 16; ++r) { const int k0 = crow(r, hi);
        if (!(k0 > lo && k0 <= lim)) p0[r] = -INFINITY;
        if (!(k0 + 32 > lo && k0 + 32 <= lim)) p1[r] = -INFINITY; }
}
__device__ __forceinline__ void pack_p(bf16x8 (&pa)[4], const f32x16& p0, const f32x16& p1) {
    u32x4 w0, w1, w2, w3;
#pragma unroll
    for (int q = 0; q < 4; ++q) { w0[q] = cvtpk(p0[2 * q], p0[2 * q + 1]); w1[q] = cvtpk(p0[8 + 2 * q], p0[9 + 2 * q]);
                                  w2[q] = cvtpk(p1[2 * q], p1[2 * q + 1]); w3[q] = cvtpk(p1[8 + 2 * q], p1[9 + 2 * q]); }
    pa[0] = __builtin_bit_cast(bf16x8, w0); pa[1] = __builtin_bit_cast(bf16x8, w1); pa[2] = __builtin_bit_cast(bf16x8, w2); pa[3] = __builtin_bit_cast(bf16x8, w3);
}
__device__ __forceinline__ void pv_tile(f32x16& o0, f32x16& o1, const bf16x8 (&pa)[4], const bf16x8 (&vf)[8]) {
#pragma unroll
    for (int ks = 0; ks < 4; ++ks) { o0 = MFMA32(pa[ks], vf[ks], o0); o1 = MFMA32(pa[ks], vf[4 + ks], o1); }
}
struct Sm { float mhat, l; f32x16 o0, o1, ol; };
__device__ __forceinline__ void sm_init(Sm& st) { st.mhat = 0.f; st.l = 0.f;
#pragma unroll
    for (int r = 0; r < 16; ++r) { st.o0[r] = 0.f; st.o1[r] = 0.f; st.ol[r] = 0.f; } }
__device__ __forceinline__ void sm_tile(Sm& st, f32x16& s0, f32x16& s1, bool first, const bf16x8 (&vf)[8], LAS float* wsf, int r32, int hi) {
    const float rm = rowmax32(s0, s1, hi);
    const bool need = first || (__any(rm > 8.0f) != 0);
    if (need) {
        const float dl = first ? ((rm == -INFINITY) ? 0.f : rm) : fmaxf(rm, 0.f);
        st.mhat += dl;
#pragma unroll
        for (int r = 0; r < 16; ++r) { s0[r] -= dl; s1[r] -= dl; }
        if (!first) {
            const float f = __builtin_amdgcn_exp2f(-dl);
            LDS_WAIT(); asm volatile("" ::: "memory");
            if (hi == 0) wsf[r32] = f;
            LDS_WAIT(); asm volatile("" ::: "memory");
#pragma unroll
            for (int G = 0; G < 4; ++G) { const f32x4 ff = *(const LAS f32x4*)(wsf + 8 * G + 4 * hi);
#pragma unroll
                for (int q = 0; q < 4; ++q) { st.o0[4 * G + q] *= ff[q]; st.o1[4 * G + q] *= ff[q]; st.ol[4 * G + q] *= ff[q]; } }
            LDS_WAIT(); asm volatile("" ::: "memory");
        }
    }
#pragma unroll
    for (int r = 0; r < 16; ++r) { s0[r] = __builtin_amdgcn_exp2f(s0[r]); s1[r] = __builtin_amdgcn_exp2f(s1[r]); }
    bf16x8 pa[4]; pack_p(pa, s0, s1);
    const bf16x8 ones = (bf16x8){0x3F80, 0x3F80, 0x3F80, 0x3F80, 0x3F80, 0x3F80, 0x3F80, 0x3F80};
#pragma unroll
    for (int ks = 0; ks < 4; ++ks) { st.o0 = MFMA32(pa[ks], vf[ks], st.o0); st.o1 = MFMA32(pa[ks], vf[4 + ks], st.o1); st.ol = MFMA32(pa[ks], ones, st.ol); }
}
template <bool NORM>
__device__ __forceinline__ void flush_branch(const f32x16& o0, const f32x16& o1, const f32x16& ol, const float* GATE, bf16* O, int m0, int hq, int br, bool accumulate,
                                             LAS float* stg, int lane) {
    asm volatile("" : "+v"(lane));
    const int r32 = lane & 31, hi = lane >> 5;
    LDS_WAIT(); asm volatile("" ::: "memory");
#pragma unroll
    for (int r = 0; r < 16; ++r) { const float iv = NORM ? __builtin_amdgcn_rcpf(fmaxf(ol[r], 1e-30f)) : 1.f;
        stg[crow(r, hi) * STG_STRIDE + r32] = o0[r] * iv; stg[crow(r, hi) * STG_STRIDE + 32 + r32] = o1[r] * iv; }
    LDS_WAIT(); asm volatile("" ::: "memory");
#pragma unroll
    for (int i = 0; i < 4; ++i) { const int row = i * 8 + (lane >> 3), ch = lane & 7;
        const f32x4 a = *(const LAS f32x4*)(stg + row * STG_STRIDE + ch * 8), b = *(const LAS f32x4*)(stg + row * STG_STRIDE + ch * 8 + 4);
        const float sc = GATE[(size_t)(m0 + row) * 48 + hq * 3 + br];
        bf16* op = O + (size_t)(m0 + row) * DM + hq * 64 + ch * 8;
        f32x4 x = a * sc, y = b * sc;
        if (accumulate) { const u32x4 old = *(const u32x4*)op; x += (f32x4){bflo(old.x), bfhi(old.x), bflo(old.y), bfhi(old.y)}; y += (f32x4){bflo(old.z), bfhi(old.z), bflo(old.w), bfhi(old.w)}; }
        u32x4 w; w.x = pk2(x[0], x[1]); w.y = pk2(x[2], x[3]); w.z = pk2(y[0], y[1]); w.w = pk2(y[2], y[3]);
        *(u32x4*)op = w; }
    LDS_WAIT(); asm volatile("" ::: "memory");
}
__device__ __forceinline__ void load_q(LAS bf16x8* qs, const bf16* Q, int m, int hq, int hi) {
    LDS_WAIT(); asm volatile("" ::: "memory");
#pragma unroll
    for (int d0 = 0; d0 < 4; ++d0) qs[d0 * 64] = *(const bf16x8*)(Q + (size_t)m * DM + hq * 64 + d0 * 16 + hi * 8);
    LDS_WAIT(); asm volatile("" ::: "memory");
}
__device__ __forceinline__ void p_attn_cmp(Frame& F) {
    LAS float* stg = (LAS float*)(F.lds + F.wave * 16384); LAS float* wsf = stg + 32 * STG_STRIDE;
    const bf16* Q = (const bf16*)(F.wsp() + WS_Q); const float* GATE = (const float*)(F.wsp() + WS_GATE); bf16* O = (bf16*)(F.wsp() + WS_O);
    unsigned long long* MASK = (unsigned long long*)(F.wsp() + WS_MASK);
    for (int it = F.gw; it < 16 * 128; it += F.NGW) {
        const int bh = it >> 7, blk = 127 - (it & 127), b = bh >> 2, hk = bh & 3, m0 = b * SEQ + blk * 32;
        const rsrc_t rs = make_rsrc(F.wsp() + WS_KC, 1u << 20);
        const unsigned soK = (unsigned)bh * 32768u, soV = 524288u + (unsigned)bh * 32768u;
        const int nvmax = ((blk * 32) >> 4) + 1, ntc = (nvmax + 63) >> 6;
        float mref0 = 0.f, mref1 = 0.f, mref2 = 0.f, mref3 = 0.f, inv0 = 0.f, inv1 = 0.f, inv2 = 0.f, inv3 = 0.f;
#pragma unroll 1
        for (int g = 0; g < 4; ++g) {
            int lane = F.lane; asm volatile("" : "+v"(lane));
            const int r32 = lane & 31, hi = lane >> 5, t = blk * 32 + r32, nvr = t >= 31 ? ((t - 31) >> 4) + 1 : 0;
            LAS bf16x8* qr = (LAS bf16x8*)(wsf + 64) + lane; load_q(qr, Q, m0 + r32, hk * 4 + g, hi);
            float mrun = -INFINITY, l = 0.f;
#pragma unroll 1
            for (int i = 0; i < ntc; ++i) {
                f32x16 s0, s1; qk_tile_lo(s0, s1, rs, (unsigned)lane * 16u, soK + (unsigned)i * 8192u, qr, 0.f); mask_tile(s0, s1, -1, nvr - 1 - 64 * i, hi);
                const float rm = rowmax32(s0, s1, hi), mn = fmaxf(mrun, rm), mr = (mn == -INFINITY) ? 0.f : mn;
                float sum = 0.f;
#pragma unroll
                for (int r = 0; r < 16; ++r) sum += __builtin_amdgcn_exp2f(s0[r] - mr) + __builtin_amdgcn_exp2f(s1[r] - mr);
                l = l * __builtin_amdgcn_exp2f(mrun - mr) + sum; mrun = mn;
            }
            const float ltot = l + partner32(l, hi);
            const float iv = 1.f / fmaxf(ltot, 1e-30f), mr_ = (mrun == -INFINITY) ? 0.f : mrun;
            if (g == 0) { inv0 = iv; mref0 = mr_; } else if (g == 1) { inv1 = iv; mref1 = mr_; } else if (g == 2) { inv2 = iv; mref2 = mr_; } else { inv3 = iv; mref3 = mr_; }
        }
        {
            float imp[32];
#pragma unroll
            for (int k = 0; k < 32; ++k) imp[k] = 0.f;
#pragma unroll 1
            for (int g = 0; g < 4; ++g) {
                int lane = F.lane; asm volatile("" : "+v"(lane));
                const int r32 = lane & 31, hi = lane >> 5, t = blk * 32 + r32, nvr = t >= 31 ? ((t - 31) >> 4) + 1 : 0;
                LAS bf16x8* qr = (LAS bf16x8*)(wsf + 64) + lane; load_q(qr, Q, m0 + r32, hk * 4 + g, hi);
                const float invg = g == 0 ? inv0 : g == 1 ? inv1 : g == 2 ? inv2 : inv3, mg = g == 0 ? mref0 : g == 1 ? mref1 : g == 2 ? mref2 : mref3;
#pragma unroll
                for (int i = 0; i < 4; ++i) if (i < ntc) {
                    asm volatile("" ::: "memory");
                    f32x16 s0, s1; qk_tile_lo(s0, s1, rs, (unsigned)lane * 16u, soK + (unsigned)i * 8192u, qr, -mg); mask_tile(s0, s1, -1, nvr - 1 - 64 * i, hi);
#pragma unroll
                    for (int r = 0; r < 16; ++r) { s0[r] = __builtin_amdgcn_exp2f(s0[r]) * invg; s1[r] = __builtin_amdgcn_exp2f(s1[r]) * invg; }
#pragma unroll
                    for (int G = 0; G < 4; ++G) {
                        { const int kq = 8 * i + G; const float e = s0[4 * G + 3], pe = partner32(e, hi);
                          imp[kq] += (s0[4 * G] + s0[4 * G + 1]) + s0[4 * G + 2] + 0.5f * e + (hi ? 0.5f * pe : 0.f);
                          if (kq + 1 < 32) imp[kq + 1] += hi ? 0.f : 0.5f * pe; }
                        { const int kq = 8 * i + 4 + G; const float e = s1[4 * G + 3], pe = partner32(e, hi);
                          imp[kq] += (s1[4 * G] + s1[4 * G + 1]) + s1[4 * G + 2] + 0.5f * e + (hi ? 0.5f * pe : 0.f);
                          if (kq + 1 < 32) imp[kq + 1] += hi ? 0.f : 0.5f * pe; }
                    }
                }
            }
            int lane = F.lane; asm volatile("" : "+v"(lane));
            const int r32 = lane & 31, hi = lane >> 5, cur = (blk * 32 + r32) >> 6;
            LDS_WAIT(); asm volatile("" ::: "memory");
#pragma unroll
            for (int k = 0; k < 32; ++k) { const int j = 2 * k + hi; const bool allowed = j <= cur, forced = allowed && (j == 0 || j == cur || j == cur - 1);
                stg[r32 * STG_STRIDE + j] = forced ? 1e9f : (allowed ? imp[k] : -1e30f); }
            LDS_WAIT(); asm volatile("" ::: "memory");
        }
        {
            int lane = F.lane; asm volatile("" : "+v"(lane));
            unsigned long long mymask = 0ull;
#pragma unroll 1
            for (int tok = 0; tok < 32; ++tok) {
                const float sc = stg[tok * STG_STRIDE + lane]; int rank = 0;
#pragma unroll
                for (int q = 0; q < 16; ++q) { const f32x4 v = *(const LAS f32x4*)(stg + tok * STG_STRIDE + 4 * q);
#pragma unroll
                    for (int e = 0; e < 4; ++e) rank += (v[e] > sc || (v[e] == sc && (4 * q + e) < lane)) ? 1 : 0; }
                const unsigned long long mk = __ballot(rank < 16 && sc > -0.5e30f);
                mymask = (lane == tok) ? mk : mymask;
            }
            if (lane < 32) MASK[(size_t)bh * SEQ + blk * 32 + lane] = mymask;
            LDS_WAIT(); asm volatile("" ::: "memory");
        }
#pragma unroll 1
        for (int g = 0; g < 4; ++g) {
            int lane = F.lane; asm volatile("" : "+v"(lane));
            const int r32 = lane & 31, hi = lane >> 5, t = blk * 32 + r32, nvr = t >= 31 ? ((t - 31) >> 4) + 1 : 0;
            LAS bf16x8* qr = (LAS bf16x8*)(wsf + 64) + lane; load_q(qr, Q, m0 + r32, hk * 4 + g, hi);
            const float invg = g == 0 ? inv0 : g == 1 ? inv1 : g == 2 ? inv2 : inv3, mg = g == 0 ? mref0 : g == 1 ? mref1 : g == 2 ? mref2 : mref3;
            f32x16 o0, o1;
#pragma unroll
            for (int r = 0; r < 16; ++r) { o0[r] = 0.f; o1[r] = 0.f; }
#pragma unroll 1
            for (int i = 0; i < ntc; ++i) {
                f32x16 s0, s1; qk_tile_lo(s0, s1, rs, (unsigned)lane * 16u, soK + (unsigned)i * 8192u, qr, -mg); mask_tile(s0, s1, -1, nvr - 1 - 64 * i, hi);
#pragma unroll
                for (int r = 0; r < 16; ++r) { s0[r] = __builtin_amdgcn_exp2f(s0[r]) * invg; s1[r] = __builtin_amdgcn_exp2f(s1[r]) * invg; }
                bf16x8 pa[4]; pack_p(pa, s0, s1);
                bf16x8 vf[8]; load_frag8(vf, rs, (unsigned)lane * 16u, soV + (unsigned)i * 8192u); pv_tile(o0, o1, pa, vf);
            }
            flush_branch<false>(o0, o1, o0, GATE, O, m0, hk * 4 + g, 0, false, stg, lane);
        }
    }
}
__device__ __forceinline__ void attn_main_item(Frame& F, int bh, int g, int blk, LAS float* stg, LAS float* wsf) {
    const bf16* Q = (const bf16*)(F.wsp() + WS_Q); const float* GATE = (const float*)(F.wsp() + WS_GATE); bf16* O = (bf16*)(F.wsp() + WS_O);
    const rsrc_t rs = make_rsrc(F.wsp() + WS_KV, (unsigned)(6 * KVBUF_ELEMS * 2));
    int lane = F.lane; asm volatile("" : "+v"(lane));
    const int r32 = lane & 31, hi = lane >> 5;
    const unsigned vo = (unsigned)lane * 16u;
    const int b = bh >> 2, hk = bh & 3, hq = hk * 4 + g, m0 = b * SEQ + blk * 32, c = blk >> 1, ql = (blk & 1) * 32 + r32;
    LAS bf16x8* qr = (LAS bf16x8*)(wsf + 64) + lane; load_q(qr, Q, m0 + r32, hq, hi);
    const unsigned long long mask = ((const unsigned long long*)(F.wsp() + WS_MASK))[(size_t)bh * SEQ + blk * 32 + r32];
    bf16x8 kf[8], vf[8];
    {
        const unsigned soK = (unsigned)((2 * KVBUF_ELEMS + (size_t)bh * KVROWS * 64) * 2), soV = (unsigned)((3 * KVBUF_ELEMS + (size_t)bh * KVROWS * 64) * 2);
        Sm st; sm_init(st);
        load_frag8(kf, rs, vo, soK);
#pragma unroll 1
        for (int j = 0; j <= c; ++j) {
            const bool sel = ((mask >> j) & 1ull) != 0ull;
            f32x16 s0, s1; qk_tile(s0, s1, kf, qr, sel ? -st.mhat : -INFINITY);
            asm volatile("" : "+v"(s0), "+v"(s1) :: "memory");
            load_frag8(vf, rs, vo, soV + (unsigned)j * 8192u);
            load_frag8(kf, rs, vo, soK + (unsigned)(j < c ? j + 1 : c) * 8192u);
            if (j == c) mask_tile(s0, s1, -1, ql, hi);
            sm_tile(st, s0, s1, j == 0, vf, wsf, r32, hi);
            asm volatile("" : "+v"(st.o0), "+v"(st.o1), "+v"(st.ol) :: "memory");
        }
        flush_branch<true>(st.o0, st.o1, st.ol, GATE, O, m0, hq, 1, true, stg, lane);
    }
    {
        const unsigned soK = (unsigned)((4 * KVBUF_ELEMS + (size_t)bh * KVROWS * 64) * 2), soV = (unsigned)((5 * KVBUF_ELEMS + (size_t)bh * KVROWS * 64) * 2);
        Sm st; sm_init(st);
        const int j0 = c >= 8 ? c - 8 : 0;
        load_frag8(kf, rs, vo, soK + (unsigned)j0 * 8192u);
#pragma unroll 1
        for (int j = j0; j <= c; ++j) {
            f32x16 s0, s1; qk_tile(s0, s1, kf, qr, -st.mhat);
            asm volatile("" : "+v"(s0), "+v"(s1) :: "memory");
            load_frag8(vf, rs, vo, soV + (unsigned)j * 8192u);
            load_frag8(kf, rs, vo, soK + (unsigned)(j < c ? j + 1 : c) * 8192u);
            if (j == c || j + 8 == c) mask_tile(s0, s1, (j + 8 == c) ? ql : -1, (j == c) ? ql : 63, hi);
            sm_tile(st, s0, s1, j == j0, vf, wsf, r32, hi);
            asm volatile("" : "+v"(st.o0), "+v"(st.o1), "+v"(st.ol) :: "memory");
        }
        flush_branch<true>(st.o0, st.o1, st.ol, GATE, O, m0, hq, 2, true, stg, lane);
    }
}
__device__ __forceinline__ void p_attn_main(Frame& F) {
    LAS float* stg = (LAS float*)(F.lds + F.wave * 16384); LAS float* wsf = stg + 32 * STG_STRIDE;
    for (int P = F.gw; P < 4096; P += F.NGW) {
        const int bh = P >> 8, rem = P & 255, g = rem & 3, k = rem >> 2;
        attn_main_item(F, bh, g, 127 - k, stg, wsf);
        attn_main_item(F, bh, g, k, stg, wsf);
    }
}
constexpr int AT_SLOT = 16384, AT_NSLOT = 4, AT_PW_OFF = AT_NSLOT * AT_SLOT, AT_PW_BYTES = STG_BYTES + 256 + 384, AT_MASK_OFF = AT_PW_OFF + 8 * AT_PW_BYTES;
static_assert(AT_MASK_OFF + 512 <= LDSCTL_OFF, "attention LDS map");
#define AT_WAIT_BAR(N) asm volatile("s_waitcnt vmcnt(" #N ") lgkmcnt(0)\n\ts_barrier" ::: "memory")
__device__ __forceinline__ void at_dma(const char* g, LAS unsigned char* l) { __builtin_amdgcn_global_load_lds((const unsigned*)g, (LAS unsigned*)l, 16, 0, 0); }
__device__ __forceinline__ void qk_tile_reg(f32x16& p0, f32x16& p1, const LAS unsigned char* ks, const bf16x8 (&qr)[4], const float cinit) {
    bf16x8 kf[8];
#pragma unroll
    for (int f = 0; f < 8; ++f) kf[f] = *(const LAS bf16x8*)(ks + f * 1024);
    __builtin_amdgcn_sched_barrier(0);
    f32x16 c;
#pragma unroll
    for (int r = 0; r < 16; ++r) c[r] = cinit;
    p0 = MFMA32(kf[0], qr[0], c); p1 = MFMA32(kf[4], qr[0], c);
#pragma unroll
    for (int d0 = 1; d0 < 4; ++d0) { p0 = MFMA32(kf[d0], qr[d0], p0); p1 = MFMA32(kf[4 + d0], qr[d0], p1); }
}
template <int V>
__device__ __forceinline__ void sm_tile_lds(Sm& st, f32x16& s0, f32x16& s1, bool first, const LAS unsigned char* vs, LAS float* wsf, int r32, int hi) {
    const float rm = rowmax32(s0, s1, hi);
    const bool need = first || (__any(rm > 8.0f) != 0);
    if (need) {
        const float dl = first ? ((rm == -INFINITY) ? 0.f : rm) : fmaxf(rm, 0.f);
        st.mhat += dl;
#pragma unroll
        for (int r = 0; r < 16; ++r) { s0[r] -= dl; s1[r] -= dl; }
        if (!first) {
            const float f = __builtin_amdgcn_exp2f(-dl);
            LDS_WAIT(); asm volatile("" ::: "memory");
            if (hi == 0) wsf[r32] = f;
            LDS_WAIT(); asm volatile("" ::: "memory");
#pragma unroll
            for (int G = 0; G < 4; ++G) { const f32x4 ff = *(const LAS f32x4*)(wsf + 8 * G + 4 * hi);
#pragma unroll
                for (int q = 0; q < 4; ++q) { st.o0[4 * G + q] *= ff[q]; st.o1[4 * G + q] *= ff[q]; st.ol[4 * G + q] *= ff[q]; } }
            LDS_WAIT(); asm volatile("" ::: "memory");
        }
    }
    bf16x8 vf[8];
#pragma unroll
    for (int f = 0; f < 8; ++f) vf[f] = *(const LAS bf16x8*)(vs + f * 1024);
    __builtin_amdgcn_sched_barrier(0);
    if (V != 2) {
#pragma unroll
    for (int r = 0; r < 16; ++r) { s0[r] = __builtin_amdgcn_exp2f(s0[r]); s1[r] = __builtin_amdgcn_exp2f(s1[r]); } }
    bf16x8 pa[4]; pack_p(pa, s0, s1);
    const bf16x8 ones = (bf16x8){0x3F80, 0x3F80, 0x3F80, 0x3F80, 0x3F80, 0x3F80, 0x3F80, 0x3F80};
    if (V != 3) {
#pragma unroll
    for (int ks = 0; ks < 4; ++ks) { st.o0 = MFMA32(pa[ks], vf[ks], st.o0); st.o1 = MFMA32(pa[ks], vf[4 + ks], st.o1); st.ol = MFMA32(pa[ks], ones, st.ol); }
    } else { asm volatile("" :: "v"(pa[0]), "v"(pa[1]), "v"(pa[2]), "v"(pa[3]), "v"(vf[0]), "v"(vf[1]), "v"(vf[2]), "v"(vf[3]), "v"(vf[4]), "v"(vf[5]), "v"(vf[6]), "v"(vf[7])); }
}
template <bool WIN, int V>
__device__ __forceinline__ void at_branch(Sm& st, const char* Kg, const char* Vg, int j0, int c, int ql, unsigned long long mask, const bf16x8 (&qr)[4],
                                          LAS unsigned char* ring, LAS float* wsf, int wave, int lane) {
    const int r32 = lane & 31, hi = lane >> 5, n = c - j0 + 1;
    LAS unsigned char* dk = ring + wave * 1024;
    const LAS unsigned char* rd = ring + lane * 16;
#pragma unroll
    for (int d = 0; d < 3; ++d) if (d < n) { at_dma(Kg + (size_t)(j0 + d) * 8192, dk + d * AT_SLOT); at_dma(Vg + (size_t)(j0 + d) * 8192, dk + d * AT_SLOT + 8192); }
#pragma unroll 1
    for (int t = 0; t < n; ++t) {
        const int rem = n - 1 - t;
        if (V != 1) { if (rem >= 2) AT_WAIT_BAR(4); else if (rem == 1) AT_WAIT_BAR(2); else AT_WAIT_BAR(0); }
        if (t + 3 < n) { const int sl = (t + 3) & 3; at_dma(Kg + (size_t)(j0 + t + 3) * 8192, dk + sl * AT_SLOT); at_dma(Vg + (size_t)(j0 + t + 3) * 8192, dk + sl * AT_SLOT + 8192); }
        const int j = j0 + t; const LAS unsigned char* slot = rd + (t & 3) * AT_SLOT;
        const bool sel = WIN ? true : (((mask >> j) & 1ull) != 0ull);
        f32x16 s0, s1;
        if (V != 4) qk_tile_reg(s0, s1, slot, qr, sel ? -st.mhat : -INFINITY);
        else {
#pragma unroll
            for (int r = 0; r < 16; ++r) { s0[r] = sel ? -st.mhat : -1.f; s1[r] = s0[r]; } asm volatile("" : "+v"(s0), "+v"(s1)); }
        if (WIN) { if (j == c || j + 8 == c) mask_tile(s0, s1, (j + 8 == c) ? ql : -1, (j == c) ? ql : 63, hi); }
        else { if (j == c) mask_tile(s0, s1, -1, ql, hi); }
        sm_tile_lds<V>(st, s0, s1, t == 0, slot + 8192, wsf, r32, hi);
    }
}
#define AT_PIN(x) asm volatile("" : "+v"(x))
#define AT_GAPA(MF, P, B, W, I) do { MF; lsum += (P[B] + P[B + 1]) + (P[B + 2] + P[B + 3]); W[I] = cvtpk(P[B], P[B + 1]); W[I + 1] = cvtpk(P[B + 2], P[B + 3]); \
        AT_PIN(lsum); AT_PIN(W); __builtin_amdgcn_sched_barrier(0); } while (0)
#define AT_GAPB(MF, C, B) do { MF; C[B] = __builtin_amdgcn_exp2f(C[B]); C[B + 1] = __builtin_amdgcn_exp2f(C[B + 1]); C[B + 2] = __builtin_amdgcn_exp2f(C[B + 2]); C[B + 3] = __builtin_amdgcn_exp2f(C[B + 3]); \
        AT_PIN(C); __builtin_amdgcn_sched_barrier(0); } while (0)
template <bool WIN>
__device__ __forceinline__ void at_branch_pipe(Sm& st, const char* Kg, const char* Vg, int j0, int c, int ql, unsigned long long mask, const bf16x8 (&qr)[4],
                                               LAS unsigned char* ring, LAS float* wsf, int wave, int lane) {
    const int r32 = lane & 31, hi = lane >> 5, n = c - j0 + 1;
    LAS unsigned char* dk = ring + wave * 1024;
    const LAS unsigned char* rd = ring + lane * 16;
#pragma unroll
    for (int d = 0; d < 2; ++d) if (d < n) { at_dma(Kg + (size_t)(j0 + d) * 8192, dk + d * AT_SLOT); at_dma(Vg + (size_t)(j0 + d) * 8192, dk + d * AT_SLOT + 8192); }
    if (n > 1) AT_WAIT_BAR(2); else AT_WAIT_BAR(0);
    if (2 < n) { at_dma(Kg + (size_t)(j0 + 2) * 8192, dk + 2 * AT_SLOT); at_dma(Vg + (size_t)(j0 + 2) * 8192, dk + 2 * AT_SLOT + 8192); }
    f32x16 p0, p1;
    { const bool sel = WIN ? true : ((mask >> j0) & 1ull) != 0ull;
      qk_tile_reg(p0, p1, rd, qr, sel ? 0.f : -INFINITY);
      if (WIN) { if (j0 == c || j0 + 8 == c) mask_tile(p0, p1, (j0 + 8 == c) ? ql : -1, (j0 == c) ? ql : 63, hi); }
      else { if (j0 == c) mask_tile(p0, p1, -1, ql, hi); }
      const float rm = rowmax32(p0, p1, hi), dl = (rm == -INFINITY) ? 0.f : rm;
      st.mhat = dl;
#pragma unroll
      for (int r = 0; r < 16; ++r) { p0[r] = __builtin_amdgcn_exp2f(p0[r] - dl); p1[r] = __builtin_amdgcn_exp2f(p1[r] - dl); } }
#pragma unroll 1
    for (int t = 1; t < n; ++t) {
        if (t + 1 < n) AT_WAIT_BAR(2); else AT_WAIT_BAR(0);
        if (t + 2 < n) { const int sl = (t + 2) & 3; at_dma(Kg + (size_t)(j0 + t + 2) * 8192, dk + sl * AT_SLOT); at_dma(Vg + (size_t)(j0 + t + 2) * 8192, dk + sl * AT_SLOT + 8192); }
        const int j = j0 + t;
        const bool sel = WIN ? true : ((mask >> j) & 1ull) != 0ull;
        const LAS unsigned char* ks = rd + (t & 3) * AT_SLOT; const LAS unsigned char* vs = rd + ((t - 1) & 3) * AT_SLOT + 8192;
        bf16x8 kf[8], vf[8];
#pragma unroll
        for (int f = 0; f < 8; ++f) kf[f] = *(const LAS bf16x8*)(ks + f * 1024);
        f32x16 cv; { const float ci = sel ? -st.mhat : -INFINITY;
#pragma unroll
            for (int r = 0; r < 16; ++r) cv[r] = ci; }
        __builtin_amdgcn_sched_barrier(0);
        f32x16 c0, c1; u32x4 w0, w1, w2, w3; float lsum = 0.f;
        AT_GAPA(c0 = MFMA32(kf[0], qr[0], cv), p0, 0, w0, 0);
        AT_GAPA(c1 = MFMA32(kf[4], qr[0], cv), p0, 4, w0, 2);
        AT_GAPA(c0 = MFMA32(kf[1], qr[1], c0), p0, 8, w1, 0);
        AT_GAPA(c1 = MFMA32(kf[5], qr[1], c1), p0, 12, w1, 2);
#pragma unroll
        for (int f = 0; f < 8; ++f) vf[f] = *(const LAS bf16x8*)(vs + f * 1024);
        __builtin_amdgcn_sched_barrier(0);
        AT_GAPA(c0 = MFMA32(kf[2], qr[2], c0), p1, 0, w2, 0);
        AT_GAPA(c1 = MFMA32(kf[6], qr[2], c1), p1, 4, w2, 2);
        AT_GAPA(c0 = MFMA32(kf[3], qr[3], c0), p1, 8, w3, 0);
        AT_GAPA(c1 = MFMA32(kf[7], qr[3], c1), p1, 12, w3, 2);
        st.l += lsum;
        if (WIN) { if (j == c || j + 8 == c) mask_tile(c0, c1, (j + 8 == c) ? ql : -1, (j == c) ? ql : 63, hi); }
        else { if (j == c) mask_tile(c0, c1, -1, ql, hi); }
        const float rm = rowmax32(c0, c1, hi);
        const bool resc = (__any(rm > 8.0f) != 0);
        if (resc) { const float dl = fmaxf(rm, 0.f); st.mhat += dl;
#pragma unroll
            for (int r = 0; r < 16; ++r) { c0[r] -= dl; c1[r] -= dl; }
            const float f = __builtin_amdgcn_exp2f(-dl); st.l *= f;
            LDS_WAIT(); asm volatile("" ::: "memory");
            if (hi == 0) wsf[r32] = f; }
        __builtin_amdgcn_sched_barrier(0);
        { const bf16x8 a0 = __builtin_bit_cast(bf16x8, w0), a1 = __builtin_bit_cast(bf16x8, w1), a2 = __builtin_bit_cast(bf16x8, w2), a3 = __builtin_bit_cast(bf16x8, w3);
          AT_GAPB(st.o0 = MFMA32(a0, vf[0], st.o0), c0, 0);
          AT_GAPB(st.o1 = MFMA32(a0, vf[4], st.o1), c0, 4);
          AT_GAPB(st.o0 = MFMA32(a1, vf[1], st.o0), c0, 8);
          AT_GAPB(st.o1 = MFMA32(a1, vf[5], st.o1), c0, 12);
          AT_GAPB(st.o0 = MFMA32(a2, vf[2], st.o0), c1, 0);
          AT_GAPB(st.o1 = MFMA32(a2, vf[6], st.o1), c1, 4);
          AT_GAPB(st.o0 = MFMA32(a3, vf[3], st.o0), c1, 8);
          AT_GAPB(st.o1 = MFMA32(a3, vf[7], st.o1), c1, 12); }
        if (resc) {
            LDS_WAIT(); asm volatile("" ::: "memory");
#pragma unroll
            for (int G = 0; G < 4; ++G) { const f32x4 ff = *(const LAS f32x4*)(wsf + 8 * G + 4 * hi);
#pragma unroll
                for (int q = 0; q < 4; ++q) { st.o0[4 * G + q] *= ff[q]; st.o1[4 * G + q] *= ff[q]; } }
            LDS_WAIT(); asm volatile("" ::: "memory"); }
        p0 = c0; p1 = c1;
    }
    { float lsum = 0.f;
#pragma unroll
      for (int r = 0; r < 16; ++r) lsum += p0[r] + p1[r];
      st.l += lsum;
      bf16x8 pa[4]; pack_p(pa, p0, p1);
      bf16x8 vf[8]; const LAS unsigned char* vs = rd + ((n - 1) & 3) * AT_SLOT + 8192;
#pragma unroll
      for (int f = 0; f < 8; ++f) vf[f] = *(const LAS bf16x8*)(vs + f * 1024);
      pv_tile(st.o0, st.o1, pa, vf); }
    { const float lt = st.l + partner32(st.l, hi);
      LDS_WAIT(); asm volatile("" ::: "memory");
      if (hi == 0) wsf[r32] = lt;
      LDS_WAIT(); asm volatile("" ::: "memory");
#pragma unroll
      for (int G = 0; G < 4; ++G) { const f32x4 ff = *(const LAS f32x4*)(wsf + 8 * G + 4 * hi);
#pragma unroll
          for (int q = 0; q < 4; ++q) st.ol[4 * G + q] = ff[q]; }
      LDS_WAIT(); asm volatile("" ::: "memory"); }
}
template <bool DRY, int V>
__device__ __forceinline__ void attn_unit(Frame& F, int bh, int c) {
    const bf16* Q = (const bf16*)(F.wsp() + WS_Q); const float* GATE = (const float*)(F.wsp() + WS_GATE); bf16* O = (bf16*)(F.wsp() + (DRY ? WS_Y0 : WS_O));
    const int wave = F.wave, g = wave >> 1, th = wave & 1;
    int lane = F.lane; asm volatile("" : "+v"(lane));
    const int r32 = lane & 31, hi = lane >> 5;
    const int b = bh >> 2, hk = bh & 3, hq = hk * 4 + g, m0 = b * SEQ + c * 64 + th * 32, t = c * 64 + th * 32 + r32, ql = th * 32 + r32;
    LAS unsigned char* ring = F.lds;
    LAS float* stg = (LAS float*)(F.lds + AT_PW_OFF + wave * AT_PW_BYTES); LAS float* wsf = stg + 32 * STG_STRIDE;
    LAS unsigned long long* masks = (LAS unsigned long long*)(F.lds + AT_MASK_OFF);
    const size_t lofs = (size_t)wave * 1024 + (size_t)lane * 16;
    bf16x8 qr[4];
#pragma unroll
    for (int d0 = 0; d0 < 4; ++d0) qr[d0] = *(const bf16x8*)(Q + (size_t)(m0 + r32) * DM + hq * 64 + d0 * 16 + hi * 8);
    LAS float* gl = wsf + 64;
    if (hi == 0) { const float* gp = GATE + (size_t)(m0 + r32) * 48 + hq * 3; gl[r32] = gp[0]; gl[32 + r32] = gp[1]; gl[64 + r32] = gp[2]; }
    const int nvr = t >= 31 ? ((t - 31) >> 4) + 1 : 0, ntc = (4 * c + 3 + 63) >> 6;
    f32x16 oc0, oc1;
    {
        const char* KCg = (const char*)(F.wsp() + WS_KC) + (size_t)bh * 32768 + lofs; const char* VCg = (const char*)(F.wsp() + WS_VC) + (size_t)bh * 32768 + lofs;
        asm volatile("s_waitcnt vmcnt(0)" ::: "memory");
        for (int i = 0; i < ntc; ++i) { at_dma(KCg + (size_t)i * 8192, ring + i * AT_SLOT + wave * 1024); at_dma(VCg + (size_t)i * 8192, ring + i * AT_SLOT + 8192 + wave * 1024); }
        AT_WAIT_BAR(0);
        const LAS unsigned char* rd = ring + lane * 16;
        float mhat = 0.f, l = 0.f;
        float imp[32];
#pragma unroll
        for (int k = 0; k < 32; ++k) imp[k] = 0.f;
        f32x16 o0, o1;
#pragma unroll
        for (int r = 0; r < 16; ++r) { o0[r] = 0.f; o1[r] = 0.f; }
#pragma unroll
        for (int i = 0; i < 4; ++i) if (i < ntc) {
            asm volatile("" ::: "memory");
            f32x16 s0, s1; qk_tile_reg(s0, s1, rd + i * AT_SLOT, qr, -mhat); mask_tile(s0, s1, -1, nvr - 1 - 64 * i, hi);
            const float rm = rowmax32(s0, s1, hi);
            if (i == 0) { const float dl = (rm == -INFINITY) ? 0.f : rm; mhat = dl;
#pragma unroll
                for (int r = 0; r < 16; ++r) { s0[r] -= dl; s1[r] -= dl; } }
            else if (__any(rm > 8.0f) != 0) { const float dl = fmaxf(rm, 0.f); mhat += dl;
#pragma unroll
                for (int r = 0; r < 16; ++r) { s0[r] -= dl; s1[r] -= dl; }
                const float f = __builtin_amdgcn_exp2f(-dl); l *= f;
#pragma unroll
                for (int k = 0; k < 32; ++k) imp[k] *= f;
                LDS_WAIT(); asm volatile("" ::: "memory");
                if (hi == 0) wsf[r32] = f;
                LDS_WAIT(); asm volatile("" ::: "memory");
#pragma unroll
                for (int G = 0; G < 4; ++G) { const f32x4 ff = *(const LAS f32x4*)(wsf + 8 * G + 4 * hi);
#pragma unroll
                    for (int q = 0; q < 4; ++q) { o0[4 * G + q] *= ff[q]; o1[4 * G + q] *= ff[q]; } }
                LDS_WAIT(); asm volatile("" ::: "memory"); }
            float sum = 0.f;
#pragma unroll
            for (int r = 0; r < 16; ++r) { s0[r] = __builtin_amdgcn_exp2f(s0[r]); s1[r] = __builtin_amdgcn_exp2f(s1[r]); sum += s0[r] + s1[r]; }
            l += sum;
#pragma unroll
            for (int G = 0; G < 4; ++G) {
                { const int kq = 8 * i + G; const float e = s0[4 * G + 3], pe = partner32(e, hi);
                  imp[kq] += (s0[4 * G] + s0[4 * G + 1]) + s0[4 * G + 2] + 0.5f * e + (hi ? 0.5f * pe : 0.f);
                  if (kq + 1 < 32) imp[kq + 1] += hi ? 0.f : 0.5f * pe; }
                { const int kq = 8 * i + 4 + G; const float e = s1[4 * G + 3], pe = partner32(e, hi);
                  imp[kq] += (s1[4 * G] + s1[4 * G + 1]) + s1[4 * G + 2] + 0.5f * e + (hi ? 0.5f * pe : 0.f);
                  if (kq + 1 < 32) imp[kq + 1] += hi ? 0.f : 0.5f * pe; }
            }
            bf16x8 pa[4]; pack_p(pa, s0, s1);
            { bf16x8 vf[4];
#pragma unroll
              for (int f = 0; f < 4; ++f) vf[f] = *(const LAS bf16x8*)(rd + i * AT_SLOT + 8192 + f * 1024);
#pragma unroll
              for (int ks = 0; ks < 4; ++ks) o0 = MFMA32(pa[ks], vf[ks], o0);
              asm volatile("" : "+v"(o0) :: "memory");
#pragma unroll
              for (int f = 0; f < 4; ++f) vf[f] = *(const LAS bf16x8*)(rd + i * AT_SLOT + 8192 + (4 + f) * 1024);
#pragma unroll
              for (int ks = 0; ks < 4; ++ks) o1 = MFMA32(pa[ks], vf[ks], o1); }
        }
        const float ltot = l + partner32(l, hi), inv = 1.f / fmaxf(ltot, 1e-30f);
#pragma unroll
        for (int k = 0; k < 32; ++k) imp[k] *= inv;
        LDS_WAIT(); asm volatile("" ::: "memory");
        if (hi == 0) wsf[r32] = gl[r32] * inv;
        LDS_WAIT(); asm volatile("" ::: "memory");
#pragma unroll
        for (int G = 0; G < 4; ++G) { const f32x4 gg = *(const LAS f32x4*)(wsf + 8 * G + 4 * hi);
#pragma unroll
            for (int q = 0; q < 4; ++q) { oc0[4 * G + q] = o0[4 * G + q] * gg[q]; oc1[4 * G + q] = o1[4 * G + q] * gg[q]; } }
        LDS_WAIT(); asm volatile("" ::: "memory");
#pragma unroll
        for (int k = 0; k < 32; ++k) stg[r32 * STG_STRIDE + 2 * k + hi] = imp[k];
    }
    AT_WAIT_BAR(0);
    const char* KSg = (const char*)(F.wsp() + WS_KV) + (2 * KVBUF_ELEMS + (size_t)bh * KVROWS * 64) * 2 + lofs;
    const char* VSg = (const char*)(F.wsp() + WS_KV) + (3 * KVBUF_ELEMS + (size_t)bh * KVROWS * 64) * 2 + lofs;
    if (c < 16) { if (lane < 8) masks[th * 32 + 8 * g + lane] = (2ull << c) - 1ull; }
    else {
        const LAS float* st0 = (const LAS float*)(F.lds + AT_PW_OFF + (0 * 2 + th) * AT_PW_BYTES); const LAS float* st1 = (const LAS float*)(F.lds + AT_PW_OFF + (1 * 2 + th) * AT_PW_BYTES);
        const LAS float* st2 = (const LAS float*)(F.lds + AT_PW_OFF + (2 * 2 + th) * AT_PW_BYTES); const LAS float* st3 = (const LAS float*)(F.lds + AT_PW_OFF + (3 * 2 + th) * AT_PW_BYTES);
        const bool allowed = lane <= c, forced = allowed && (lane == 0 || lane == c || lane == c - 1);
        LAS unsigned* kst = (LAS unsigned*)stg;
#pragma unroll 1
        for (int i = 0; i < 8; i += 2) {
            const int tokA = 8 * g + i, tokB = tokA + 1, aA = tokA * STG_STRIDE + lane, aB = tokB * STG_STRIDE + lane;
            const float vA = ((st0[aA] + st1[aA]) + st2[aA]) + st3[aA], vB = ((st0[aB] + st1[aB]) + st2[aB]) + st3[aB];
            const unsigned low = 63u - (unsigned)lane;
            const unsigned keyA = forced ? (0xFFFFFFC0u | low) : (allowed ? ((__builtin_bit_cast(unsigned, vA) & 0xFFFFFFC0u) | low) : 0u);
            const unsigned keyB = forced ? (0xFFFFFFC0u | low) : (allowed ? ((__builtin_bit_cast(unsigned, vB) & 0xFFFFFFC0u) | low) : 0u);
            LDS_WAIT(); asm volatile("" ::: "memory");
            kst[aA] = keyA; kst[aB] = keyB;
            LDS_WAIT(); asm volatile("" ::: "memory");
            int rankA = 0, rankB = 0;
#pragma unroll
            for (int q = 0; q < 16; ++q) { const u32x4 xa = *(const LAS u32x4*)(kst + tokA * STG_STRIDE + 4 * q), xb = *(const LAS u32x4*)(kst + tokB * STG_STRIDE + 4 * q);
#pragma unroll
                for (int e = 0; e < 4; ++e) { rankA += (xa[e] > keyA) ? 1 : 0; rankB += (xb[e] > keyB) ? 1 : 0; } }
            const unsigned long long mkA = __ballot(rankA < 16 && allowed), mkB = __ballot(rankB < 16 && allowed);
            if (lane == 0) { masks[th * 32 + tokA] = mkA; masks[th * 32 + tokB] = mkB; }
        }
    }
    AT_WAIT_BAR(0);
    const unsigned long long mask = masks[th * 32 + r32];
#pragma unroll
    for (int r = 0; r < 16; ++r) { stg[crow(r, hi) * STG_STRIDE + r32] = oc0[r]; stg[crow(r, hi) * STG_STRIDE + 32 + r32] = oc1[r]; }
    {
        Sm st; sm_init(st);
        if (V == 0) at_branch_pipe<false>(st, KSg, VSg, 0, c, ql, mask, qr, ring, wsf, wave, lane); else if (V != 5) at_branch<false, V>(st, KSg, VSg, 0, c, ql, mask, qr, ring, wsf, wave, lane);
        LDS_WAIT(); asm volatile("" ::: "memory");
#pragma unroll
        for (int G = 0; G < 4; ++G) { const f32x4 gg = *(const LAS f32x4*)(gl + 32 + 8 * G + 4 * hi);
#pragma unroll
            for (int q = 0; q < 4; ++q) { const int r = 4 * G + q; const float iv = gg[q] * __builtin_amdgcn_rcpf(fmaxf(st.ol[r], 1e-30f));
                stg[crow(r, hi) * STG_STRIDE + r32] += st.o0[r] * iv; stg[crow(r, hi) * STG_STRIDE + 32 + r32] += st.o1[r] * iv; } }
    }
    AT_WAIT_BAR(0);
    {
        const char* KWg = (const char*)(F.wsp() + WS_KV) + (4 * KVBUF_ELEMS + (size_t)bh * KVROWS * 64) * 2 + lofs;
        const char* VWg = (const char*)(F.wsp() + WS_KV) + (5 * KVBUF_ELEMS + (size_t)bh * KVROWS * 64) * 2 + lofs;
        Sm st; sm_init(st);
        if (V == 0) at_branch_pipe<true>(st, KWg, VWg, c >= 8 ? c - 8 : 0, c, ql, 0ull, qr, ring, wsf, wave, lane); else if (V != 5) at_branch<true, V>(st, KWg, VWg, c >= 8 ? c - 8 : 0, c, ql, 0ull, qr, ring, wsf, wave, lane);
        LDS_WAIT(); asm volatile("" ::: "memory");
#pragma unroll
        for (int G = 0; G < 4; ++G) { const f32x4 gg = *(const LAS f32x4*)(gl + 64 + 8 * G + 4 * hi);
#pragma unroll
            for (int q = 0; q < 4; ++q) { const int r = 4 * G + q; const float iv = gg[q] * __builtin_amdgcn_rcpf(fmaxf(st.ol[r], 1e-30f));
                stg[crow(r, hi) * STG_STRIDE + r32] += st.o0[r] * iv; stg[crow(r, hi) * STG_STRIDE + 32 + r32] += st.o1[r] * iv; } }
        LDS_WAIT(); asm volatile("" ::: "memory");
#pragma unroll
        for (int i = 0; i < 4; ++i) { const int row = i * 8 + (lane >> 3), ch = lane & 7;
            const f32x4 a = *(const LAS f32x4*)(stg + row * STG_STRIDE + ch * 8), b2 = *(const LAS f32x4*)(stg + row * STG_STRIDE + ch * 8 + 4);
            u32x4 w; w.x = pk2(a[0], a[1]); w.y = pk2(a[2], a[3]); w.z = pk2(b2[0], b2[1]); w.w = pk2(b2[2], b2[3]);
            *(u32x4*)(O + (size_t)(m0 + row) * DM + hq * 64 + ch * 8) = w; }
    }
    AT_WAIT_BAR(0);
}
template <bool DRY, int V>
__device__ __forceinline__ void p_attn_fused(Frame& F) {
    const int G = gridDim.x, bx = blockIdx.x, vcu = (G % 8 == 0) ? (bx % 8) * (G / 8) + bx / 8 : bx;
    for (int P = vcu; P < 512; P += G) {
        const int bh = P >> 5, k = P & 31;
#pragma unroll 1
        for (int h = 0; h < 2; ++h) attn_unit<DRY, V>(F, bh, h ? k : 63 - k);
    }
}
struct Args { const float* in[23]; float* out; unsigned char* ws; int ph_lo, ph_hi; };
__global__ void __launch_bounds__(512, 2) mk_fwd(Args args) {
    extern __shared__ __attribute__((aligned(16))) unsigned char lds[];
    Frame F;
    F.lds = (LAS unsigned char*)lds; F.MISC = (volatile LAS unsigned*)(F.lds + MISC_OFF);
    F.tid = threadIdx.x; F.lane = F.tid & 63; F.wave = __builtin_amdgcn_readfirstlane(F.tid >> 6);
    F.gw = blockIdx.x * 8 + F.wave; F.NGW = gridDim.x * 8;
    for (int u = F.tid; u < (LDS_BYTES - LDSCTL_OFF) / 4; u += 512) ((LAS unsigned*)(F.lds + LDSCTL_OFF))[u] = 0u;
    __syncthreads();
    if (F.tid < 25) { const unsigned long long v = F.tid < 23 ? (unsigned long long)args.in[F.tid] : F.tid == 23 ? (unsigned long long)args.out : (unsigned long long)args.ws;
        LAS unsigned* p = (LAS unsigned*)(F.lds + PTR_OFF) + 2 * F.tid; p[0] = (unsigned)v; p[1] = (unsigned)(v >> 32); }
    __syncthreads();
    XcdBarrier bar; bar.bar = (unsigned*)(F.ctlp() + CW_BAR); bar.x = 0; bar.st = nullptr;
    const int lo = args.ph_lo, hi = args.ph_hi;
    if (hi - lo > 1) bar = xcd_barrier_post((unsigned*)(F.ctlp() + CW_BAR), F.MISC + 8);
#ifdef PH_ONLY
#define IN(k) ((k) == PH_ONLY && lo <= (k) && (k) < hi)
#else
#define IN(k) (lo <= (k) && (k) < hi)
#endif
#define SEAM(k) do { if (IN(k) && (k) + 1 < hi) xcd_barrier(bar); } while (0)
    if (IN(0)) {
#pragma unroll 1
        for (int rep = 0; rep < REP0; ++rep) { p0_prologue(F); if (rep + 1 < REP0) xcd_barrier(bar); } } SEAM(0);
    if (IN(1)) {
#pragma unroll 1
        for (int rep = 0; rep < REP1; ++rep) { p1_mod_u0(F); if (rep + 1 < REP1) xcd_barrier(bar); }
#pragma unroll 1
        for (int rep = 0; rep < XBAR - 1; ++rep) xcd_barrier(bar); } SEAM(1);
    if (IN(2)) for (int rep = 0; rep < REP2; ++rep) {
        const char* A = (const char*)(F.wsp() + WS_U); const char* B = (const char*)(F.wsp() + WS_WIN);
        const pg8::SchedDense S{A, B, A, B + (size_t)1024 * DM * 2, T / 256, 4, 8, DM, (int)gridDim.x, (int)blockIdx.x, 256};
#if DRY2 == 1
        { pg8::gemm_phase<EpNull, pg8::SchedDense, true, false>(F.lds, DM, S, EpNull{}); xcd_barrier(bar); }
#elif DRY2 == 2
        { pg8::gemm_phase<EpG1, pg8::SchedDense, true, false>(F.lds, DM, S, EpG1{(bf16*)(F.wsp() + WS_Y0), (bf16*)(F.wsp() + WS_Y1)}); xcd_barrier(bar); }
#endif
        pg8::gemm_phase<EpG1, pg8::SchedDense, true, false>(F.lds, DM, S, EpG1{(bf16*)(F.wsp() + WS_BG), (bf16*)(F.wsp() + WS_Z)});
        if (rep + 1 < REP2) xcd_barrier(bar);
    } SEAM(2);
    if (IN(3)) {
#pragma unroll 1
        for (int rep = 0; rep < REP3; ++rep) { p3_conv(F); if (rep + 1 < REP3) xcd_barrier(bar); } } SEAM(3);
    if (IN(4)) for (int rep = 0; rep < REP4; ++rep) {
        const pg8::SchedDense S{(const char*)(F.wsp() + WS_A2), (const char*)(F.wsp() + WS_WOUT), nullptr, nullptr, T / 256, 4, 0, DM, (int)gridDim.x, (int)blockIdx.x, 256};
        typedef pg8::EpiWrap<EpU<EpBf16>, false, true> E_;
        pg8::gemm_phase<E_, pg8::SchedDense, false, false>(F.lds, DM, S, E_{{{(bf16*)(F.wsp() + WS_Y0), DM}}});
        if (rep + 1 < REP4) xcd_barrier(bar);
    } SEAM(4);
    if (IN(5)) {
#pragma unroll 1
        for (int rep = 0; rep < DRY5; ++rep) { p_ln_router<0, true>(F); xcd_barrier(bar); }
        p_ln_router<0>(F); } SEAM(5);
    if (IN(6)) { p_moe<0>(F, bar, true); } SEAM(6);
    if (IN(8)) {
#pragma unroll 1
        for (int rep = 0; rep < DRY8; ++rep) { p_ln2<0, true>(F); xcd_barrier(bar); }
        p_ln2<0>(F); } SEAM(8);
    if (IN(9)) {
        const int G = gridDim.x, bx = blockIdx.x, vcu = (G % 8 == 0) ? (bx % 8) * (G / 8) + bx / 8 : bx;
        const SchedKVQG S{(const char*)(F.wsp() + WS_XB), (const char*)(F.wsp() + WS_WKV), (const char*)(F.wsp() + WS_U), (const char*)(F.wsp() + WS_WQG), G, vcu, 0, 512};
        typedef pg8::EpiWrap<EpKVQG, false, true> E_;
        pg8::gemm_phase<E_, SchedKVQG, true, false>(F.lds, DM, S, E_{{(bf16*)(F.wsp() + WS_KV), (bf16*)(F.wsp() + WS_Q), (float*)(F.wsp() + WS_GATE), F.inp(I_BG)}});
    } SEAM(9);
    if (IN(10)) {
        const int G = gridDim.x, bx = blockIdx.x, vcu = (G % 8 == 0) ? (bx % 8) * (G / 8) + bx / 8 : bx;
        const int nq = G - 64 > 0 ? G - 64 : G;
        {
            const SchedKVQG S{(const char*)(F.wsp() + WS_XB), (const char*)(F.wsp() + WS_WKV), (const char*)(F.wsp() + WS_U), (const char*)(F.wsp() + WS_WQG), nq, vcu < nq ? vcu : -1, 512, 704};
            typedef pg8::EpiWrap<EpKVQG, false, true> E_;
            pg8::gemm_phase<E_, SchedKVQG, false, false>(F.lds, DM, S, E_{{(bf16*)(F.wsp() + WS_KV), (bf16*)(F.wsp() + WS_Q), (float*)(F.wsp() + WS_GATE), F.inp(I_BG)}});
        }
        {
            const SchedCmp S{(const char*)(F.wsp() + WS_KV), (const char*)(F.wsp() + WS_W1C), G - nq > 0 ? G - nq : G, G - nq > 0 ? (vcu >= nq ? vcu - nq : -1) : vcu};
            typedef pg8::EpiWrap<EpU<EpF32>, false> E_;
            pg8::gemm_phase<E_, SchedCmp, false, false>(F.lds, 1024, S, E_{{{(float*)(F.wsp() + WS_TB), 512}}});
        }
    } SEAM(10);
    if (IN(11)) {
#pragma unroll 1
        for (int rep = 0; rep < REP11; ++rep) { p_cmp_finish(F); if (rep + 1 < REP11) xcd_barrier(bar); } } SEAM(11);
#if ATTN_FUSED
    if (IN(12)) {
#pragma unroll 1
        for (int rep = 0; rep < DRY12; ++rep) { p_attn_fused<true, ATV>(F); xcd_barrier(bar); }
        p_attn_fused<false, 0>(F); } SEAM(12);
#else
    if (IN(12)) { p_attn_cmp(F); } SEAM(12);
    if (IN(13)) { p_attn_main(F); } SEAM(13);
#endif
    if (IN(14)) {
        const pg8::SchedDense S{(const char*)(F.wsp() + WS_O), (const char*)(F.wsp() + WS_WO), nullptr, nullptr, T / 256, 4, 0, DM, (int)gridDim.x, (int)blockIdx.x, 256};
        typedef pg8::EpiWrap<EpU<EpBf16>, false, true> E_;
        pg8::gemm_phase<E_, pg8::SchedDense, false, false>(F.lds, DM, S, E_{{{(bf16*)(F.wsp() + WS_Y0), DM}}});
    } SEAM(14);
    if (IN(15)) { p_ln_router<1>(F); } SEAM(15);
    if (IN(16)) { p_moe<1>(F, bar, true); } SEAM(16);
    if (IN(18)) { p_ln2<1>(F); }
#undef IN
#undef SEAM
}

extern "C" void kernel_launch(void* const* d_in, const int* in_sizes, int n_in, void* d_out, int out_size, void* d_ws, size_t ws_size, hipStream_t stream) {
    static int grid = 0;
    if (grid == 0) {
        if (n_in != 23 || out_size != T * DM || ws_size < WS_END) { fprintf(stderr, "kernel_launch: unexpected shapes (n_in %d out %d ws %zu, need ws >= %zu)\n", n_in, out_size, ws_size, (size_t)WS_END); grid = -1; return; }
        int dev = 0, cus = 0, per_cu = 0;
        if (hipGetDevice(&dev) != hipSuccess || hipDeviceGetAttribute(&cus, hipDeviceAttributeMultiprocessorCount, dev) != hipSuccess) { grid = -1; return; }
        if (hipFuncSetAttribute((const void*)mk_fwd, hipFuncAttributeMaxDynamicSharedMemorySize, LDS_BYTES) != hipSuccess) { fprintf(stderr, "kernel_launch: hipFuncSetAttribute failed\n"); grid = -1; return; }
        if (hipOccupancyMaxActiveBlocksPerMultiprocessor(&per_cu, (const void*)mk_fwd, 512, LDS_BYTES) != hipSuccess || per_cu < 1) { fprintf(stderr, "kernel_launch: occupancy query says %d\n", per_cu); per_cu = 1; }
        (void)hipGetLastError();
        grid = cus;
    }
    if (grid < 0) return;
    (void)hipMemsetAsync((char*)d_ws + WS_CTL, 0, CTL_ZERO_BYTES, stream);
    Args a{};
    for (int i = 0; i < 23; ++i) a.in[i] = (const float*)d_in[i];
    a.out = (float*)d_out; a.ws = (unsigned char*)d_ws;
    if (MK_N_LAUNCHES == 1) { a.ph_lo = 0; a.ph_hi = NPH; hipLaunchKernelGGL(mk_fwd, dim3(grid), dim3(512), LDS_BYTES, stream, a); }
    else for (int p = 0; p < NPH; ++p) { a.ph_lo = p; a.ph_hi = p + 1; hipLaunchKernelGGL(mk_fwd, dim3(grid), dim3(512), LDS_BYTES, stream, a); }
}
```

```cpp
#include <hip/hip_runtime.h>
#include <cstdio>
#include <cstdint>

#ifndef REP0
#define REP0 1
#endif
#ifndef REP1
#define REP1 1
#endif
#ifndef REP11
#define REP11 1
#endif
#ifndef XBAR
#define XBAR 1
#endif
#ifndef DRY5
#define DRY5 0
#endif
#ifndef DRY8
#define DRY8 0
#endif
#ifndef REP4
#define REP4 1
#endif
#ifndef REP2
#define REP2 1
#endif
#ifndef REP3
#define REP3 1
#endif
#ifndef REP6
#define REP6 1
#endif
#ifndef REP7
#define REP7 1
#endif
#ifndef REP9
#define REP9 1
#endif
#ifndef REP10
#define REP10 1
#endif
#ifndef REP12
#define REP12 1
#endif
#ifndef REP1213
#define REP1213 1
#endif
#ifndef ATV
#define ATV 0
#endif
#ifndef DRY2
#define DRY2 0
#endif
#ifndef DRY12
#define DRY12 0
#endif
#ifndef ATTN_FUSED
#define ATTN_FUSED 1
#endif
#ifndef MK_N_LAUNCHES
#define MK_N_LAUNCHES 1
#endif

#define GAS __attribute__((address_space(1)))
#define LAS __attribute__((address_space(3)))
typedef unsigned short bf16;
typedef short bf16x8 __attribute__((ext_vector_type(8)));
typedef float f32x4 __attribute__((ext_vector_type(4)));
typedef unsigned u32x4 __attribute__((ext_vector_type(4)));
typedef unsigned u32x2 __attribute__((ext_vector_type(2)));
typedef GAS unsigned gu32;
#define RLX_AGENT __ATOMIC_RELAXED, __HIP_MEMORY_SCOPE_AGENT

constexpr int NB = 4, SEQ = 4096, DM = 1024, T = NB * SEQ, NH = 16, HKV = 4, HD = 64, NE = 16, FF = 512;
constexpr int NPH = 19;
constexpr float ALPHA = 1.4142135623730951f;
constexpr float LN_EPS = 1e-5f;
constexpr float C2 = 0.125f * 1.4426950408889634f;
constexpr int KVROWS = SEQ + 128;
constexpr int HROWS = 2 * T + NE * 256;

constexpr size_t MiB = 1u << 20;
constexpr size_t WS_CTL = 0, CTL_ZERO_BYTES = 1 * MiB;
constexpr size_t WS_MODP = 290 * MiB;
constexpr size_t WS_MOD = 3 * MiB;
constexpr size_t WS_PETP = 3 * MiB + 512 * 1024;
constexpr size_t WS_LIST = 4 * MiB;
constexpr size_t WS_LW = 6 * MiB;
constexpr size_t WS_WIN = 8 * MiB, WS_WOUT = 14 * MiB, WS_WKV = 16 * MiB, WS_WQG = 19 * MiB, WS_WO = 22 * MiB, WS_W1C = 24 * MiB;
constexpr size_t WS_WGU = 26 * MiB, WS_WDN = 90 * MiB;
constexpr size_t WS_U = 122 * MiB, WS_XB = 154 * MiB, WS_H = 186 * MiB, WS_Y0 = 226 * MiB, WS_Y1 = 258 * MiB;
constexpr size_t WS_R1 = 290 * MiB;
constexpr size_t WS_BG = WS_R1, WS_Z = WS_R1 + 32 * MiB, WS_A2 = WS_R1 + 64 * MiB;
constexpr size_t WS_Q = WS_R1, WS_O = WS_R1 + 32 * MiB, WS_KV = WS_R1 + 64 * MiB;
constexpr size_t KVBUF_ELEMS = (size_t)16 * KVROWS * 64;
constexpr size_t WS_TB = WS_R1 + 114 * MiB, WS_KC = WS_R1 + 130 * MiB, WS_VC = WS_KC + 512 * 1024, WS_GATE = WS_R1 + 131 * MiB;
constexpr size_t WS_END = WS_R1 + 135 * MiB;
static_assert(WS_Y1 == WS_Y0 + (size_t)T * DM * 2, "Y1 follows Y0");
static_assert(WS_KV + 6 * KVBUF_ELEMS * 2 <= WS_TB, "kv buffers");
static_assert((size_t)HROWS * FF * 2 <= 40 * MiB, "H buffer");
constexpr int CW_CNT = 1024;
constexpr int CW_BAR = 4096;

constexpr int RING_BYTES = 131072;
constexpr int LDSCTL_OFF = 143360, MISC_OFF = LDSCTL_OFF + 320;
constexpr int LDS_BYTES = 147456;

#define LDS_WAIT() asm volatile("s_waitcnt lgkmcnt(0)" ::: "memory")
__device__ __forceinline__ unsigned f2bf(float f) { unsigned u = __builtin_bit_cast(unsigned, f); return (u + 0x7fffu + ((u >> 16) & 1u)) >> 16; }
typedef float f32x2v __attribute__((ext_vector_type(2)));
typedef __bf16 bf16x2_t __attribute__((ext_vector_type(2)));
__device__ __forceinline__ unsigned pk2(float lo, float hi) { f32x2v v = {lo, hi}; bf16x2_t b = __builtin_convertvector(v, bf16x2_t); return __builtin_bit_cast(unsigned, b); }
__device__ __forceinline__ float bf2f(unsigned short h) { return __builtin_bit_cast(float, (unsigned)h << 16); }
__device__ __forceinline__ float bflo(unsigned w) { return __builtin_bit_cast(float, w << 16); }
__device__ __forceinline__ float bfhi(unsigned w) { return __builtin_bit_cast(float, w & 0xffff0000u); }
__device__ __forceinline__ float wave_sum(float v) {
#pragma unroll
    for (int o = 1; o < 64; o <<= 1) v += __shfl_xor(v, o);
    return v;
}
__device__ __forceinline__ float wave_max(float v) {
#pragma unroll
    for (int o = 1; o < 64; o <<= 1) v = fmaxf(v, __shfl_xor(v, o));
    return v;
}
__device__ __forceinline__ float silu_f(float a) { return a * __builtin_amdgcn_rcpf(1.f + __builtin_amdgcn_exp2f(-1.4426950408889634f * a)); }
__device__ __forceinline__ void st_bf4(bf16* p, f32x4 v) { u32x2 w; w.x = pk2(v[0], v[1]); w.y = pk2(v[2], v[3]); *(u32x2*)p = w; }
__device__ __forceinline__ void st_bf8(bf16* p, f32x4 a, f32x4 b) { u32x4 w; w.x = pk2(a[0], a[1]); w.y = pk2(a[2], a[3]); w.z = pk2(b[0], b[1]); w.w = pk2(b[2], b[3]); *(u32x4*)p = w; }

#define XB_TMO      128
#define XB_XCNT(j)  (256  + 64 * (j))
#define XB_XSUB(j)  (1280 + 64 * (j))
#define XB_XGEN(j)  (2304 + 64 * (j))
#define XB_TOP      3328
#define XB_TOPGEN   3392
#define XCD_BAR_WORDS 3456
#define XB_SPIN_CAP (1u << 22)
__device__ __forceinline__ unsigned xb_ld(unsigned* p)              { return __hip_atomic_load(p, __ATOMIC_RELAXED, __HIP_MEMORY_SCOPE_AGENT); }
__device__ __forceinline__ unsigned xb_add(unsigned* p, unsigned v) { return __hip_atomic_fetch_add(p, v, __ATOMIC_RELAXED, __HIP_MEMORY_SCOPE_AGENT); }
__device__ __forceinline__ unsigned xb_xcc_id() { return (unsigned)__builtin_amdgcn_s_getreg((3 << 11) | 20) & 0xFu; }
#define XB_SPIN(cond, bar) do { unsigned _sp = 0; while (cond) { __builtin_amdgcn_s_sleep(1); \
    if ((++_sp & 255u) == 0u) { if (xb_ld(&(bar)[XB_TMO])) break; if (_sp > XB_SPIN_CAP) { atomicAdd(&(bar)[XB_TMO], 1u); break; } } } } while (0)
struct XcdBarrier { unsigned* bar; unsigned x; volatile LAS unsigned* st; };
__device__ __forceinline__ XcdBarrier xcd_barrier_post(unsigned* bar, volatile LAS unsigned* st) {
    XcdBarrier b; b.bar = bar; b.x = xb_xcc_id(); b.st = st;
    if (threadIdx.x == 0) (void)xb_add(&bar[XB_XCNT(b.x)], 1u);
    return b;
}
__device__ __forceinline__ void xcd_barrier_complete(unsigned* bar, unsigned x, unsigned& nloc, unsigned& nx) {
    const unsigned G = gridDim.x * gridDim.y * gridDim.z;
    unsigned sum, cnt, mine, sp = 0u;
    for (;;) {
        sum = 0u; cnt = 0u; mine = 0u;
#pragma unroll
        for (unsigned j = 0; j < 16; ++j) { const unsigned c = xb_ld(&bar[XB_XCNT(j)]); sum += c; cnt += (c > 0u) ? 1u : 0u; mine = (j == x) ? c : mine; }
        if (sum == G) break;
        __builtin_amdgcn_s_sleep(1);
        if ((++sp & 255u) == 0u) { if (xb_ld(&bar[XB_TMO])) break; if (sp > XB_SPIN_CAP) { atomicAdd(&bar[XB_TMO], 1u); break; } }
    }
    nloc = mine > 0u ? mine : 1u; nx = cnt > 0u ? cnt : 1u;
}
__device__ __forceinline__ void xcd_barrier(const XcdBarrier& b) {
    asm volatile("s_waitcnt vmcnt(0)" ::: "memory");
    __syncthreads();
    if (threadIdx.x == 0) {
        unsigned* bar = b.bar;
        __builtin_amdgcn_s_waitcnt(0);
        unsigned nloc = b.st[0], nx = b.st[1];
        if (nloc == 0u) { xcd_barrier_complete(bar, b.x, nloc, nx); b.st[0] = nloc; b.st[1] = nx; }
        const unsigned old = xb_add(&bar[XB_XSUB(b.x)], 1u);
        const unsigned gen = old / nloc;
        if (old + 1u == (gen + 1u) * nloc) {
            __builtin_amdgcn_fence(__ATOMIC_RELEASE, "agent");
            asm volatile("s_waitcnt vmcnt(0)" ::: "memory");
            const unsigned og = xb_add(&bar[XB_TOP], 1u);
            const unsigned tg = og / nx;
            if (og + 1u == (tg + 1u) * nx) xb_add(&bar[XB_TOPGEN], 1u);
            else XB_SPIN(xb_ld(&bar[XB_TOPGEN]) == tg, bar);
            __builtin_amdgcn_fence(__ATOMIC_ACQUIRE, "agent");
            xb_add(&bar[XB_XGEN(b.x)], 1u);
            asm volatile("s_waitcnt vmcnt(0)" ::: "memory");
        } else {
            XB_SPIN(xb_ld(&bar[XB_XGEN(b.x)]) == gen, bar);
            __builtin_amdgcn_fence(__ATOMIC_ACQUIRE, "agent");
            asm volatile("s_waitcnt vmcnt(0)" ::: "memory");
        }
    }
    __syncthreads();
}

constexpr int PTR_OFF = MISC_OFF + 512;
struct Frame {
    LAS unsigned char* lds;
    volatile LAS unsigned* MISC;
    int tid, lane, wave, gw, NGW;
    __device__ __forceinline__ unsigned long long ptr(int i) const { const LAS unsigned* p = (const LAS unsigned*)(lds + PTR_OFF) + 2 * i;
        const unsigned lo = __builtin_amdgcn_readfirstlane(p[0]), hi = __builtin_amdgcn_readfirstlane(p[1]); return ((unsigned long long)hi << 32) | lo; }
    __device__ __forceinline__ const float* inp(int i) const { return (const float*)(const GAS float*)ptr(i); }
    __device__ __forceinline__ float* outp() const { return (float*)(GAS float*)ptr(23); }
    __device__ __forceinline__ unsigned char* wsp() const { return (unsigned char*)(GAS unsigned char*)ptr(24); }
    __device__ __forceinline__ gu32* ctlp() const { return (gu32*)(wsp() + WS_CTL); }
};
enum { I_X = 0, I_C, I_ADAW, I_ADAB, I_LNG, I_LNB, I_CWIN, I_CONVW, I_CONVB, I_CWOUT, I_WKV, I_PE, I_CW1, I_CB1, I_CW2, I_CB2, I_WQG, I_BG, I_WO, I_RW, I_RB, I_WGU, I_WDN };

__device__ __forceinline__ void transpose_item(const float* W, int ld, int nvalid, int K, bf16* WT, int dstrow0, int k0, int n0, LAS float* scr, int lane) {
    const int n = n0 + (lane & 31);
#pragma unroll 8
    for (int i = 0; i < 32; ++i) { const int kk = 2 * i + (lane >> 5); scr[kk * 33 + (lane & 31)] = (n < nvalid) ? W[(size_t)(k0 + kk) * ld + n] : 0.f; }
    LDS_WAIT(); asm volatile("" ::: "memory");
    const int c = lane & 7;
#pragma unroll
    for (int j = 0; j < 4; ++j) { const int nl = (lane >> 3) + 8 * j; const LAS float* s = scr + (8 * c) * 33 + nl;
        u32x4 o; o.x = pk2(s[0 * 33], s[1 * 33]); o.y = pk2(s[2 * 33], s[3 * 33]); o.z = pk2(s[4 * 33], s[5 * 33]); o.w = pk2(s[6 * 33], s[7 * 33]);
        *(u32x4*)(WT + (size_t)(dstrow0 + nl) * K + k0 + 8 * c) = o; }
    LDS_WAIT(); asm volatile("" ::: "memory");
}
__device__ __forceinline__ int pairmap(int n0, int half) {
    return n0 < half ? ((n0 >> 7) * 256 + (n0 & 127)) : ((((n0 - half) >> 7) * 256) + 128 + ((n0 - half) & 127));
}
__device__ __forceinline__ void p0_prologue(Frame& F) {
    LAS float* scr = (LAS float*)(F.lds + F.wave * 16384);
    const int lane = F.lane;
    for (int r = F.gw; r < 768 + 256; r += F.NGW) {
        if (r < 768) {
            const int l = r / 384, rem = r % 384, dch = rem / 24, e = (rem % 24) * 256 + 4 * lane;
            const float* aw = F.inp(I_ADAW) + (size_t)l * 1024 * 6144 + e; const float* c = F.inp(I_C);
            f32x4 a0 = (f32x4){0.f, 0.f, 0.f, 0.f}, a1 = a0, a2 = a0, a3 = a0;
#pragma unroll 16
            for (int d = dch * 64; d < dch * 64 + 64; ++d) {
                const f32x4 w = *(const f32x4*)(aw + (size_t)d * 6144);
                const float c0 = c[d], c1 = c[1024 + d], c2 = c[2048 + d], c3 = c[3072 + d];
                a0 += w * (c0 / (1.f + __expf(-c0))); a1 += w * (c1 / (1.f + __expf(-c1))); a2 += w * (c2 / (1.f + __expf(-c2))); a3 += w * (c3 / (1.f + __expf(-c3)));
            }
            float* mp = (float*)(F.wsp() + WS_MODP) + (size_t)dch * 49152 + (size_t)(l * 4) * 6144 + e;
            *(f32x4*)mp = a0; *(f32x4*)(mp + 6144) = a1; *(f32x4*)(mp + 2 * 6144) = a2; *(f32x4*)(mp + 3 * 6144) = a3;
        } else {
            const int q = r - 768, i = q / 128, rem = q % 128, cch = rem / 32, kch = rem % 32, c = cch * 64 + lane;
            const float* pe = F.inp(I_PE) + i * 2048; const float* w1 = F.inp(I_CW1) + (size_t)i * 2048 * 256 + c;
            float a = 0.f;
#pragma unroll 16
            for (int kk = kch * 64; kk < kch * 64 + 64; ++kk) a += pe[kk] * w1[(size_t)kk * 256];
            ((float*)(F.wsp() + WS_PETP))[(kch * 2 + i) * 256 + c] = a;
        }
    }
    constexpr int I1 = 16 * 96, I2 = 512, I3 = 16 * 48, I4 = 16 * 40, I5 = 512, I6 = 512, I7 = 32 * 512, I8 = 32 * 256;
    constexpr int NITEMS = I1 + I2 + I3 + I4 + I5 + I6 + I7 + I8;
    for (int it = F.gw; it < NITEMS; it += F.NGW) {
        int r = it;
        if (r < I1) { const int kb = r / 96, nb = r % 96, n0 = nb * 32;
            const int dr = n0 < 1024 ? n0 : 1024 + pairmap(n0 - 1024, 1024);
            transpose_item(F.inp(I_CWIN), 3072, 3072, 1024, (bf16*)(F.wsp() + WS_WIN), dr, kb * 64, n0, scr, lane); continue; } r -= I1;
        if (r < I2) { transpose_item(F.inp(I_CWOUT), 1024, 1024, 1024, (bf16*)(F.wsp() + WS_WOUT), (r % 32) * 32, (r / 32) * 64, (r % 32) * 32, scr, lane); continue; } r -= I2;
        if (r < I3) { transpose_item(F.inp(I_WKV), 1536, 1536, 1024, (bf16*)(F.wsp() + WS_WKV), (r % 48) * 32, (r / 48) * 64, (r % 48) * 32, scr, lane); continue; } r -= I3;
        if (r < I4) { transpose_item(F.inp(I_WQG), 1072, 1072, 1024, (bf16*)(F.wsp() + WS_WQG), (r % 40) * 32, (r / 40) * 64, (r % 40) * 32, scr, lane); continue; } r -= I4;
        if (r < I5) { transpose_item(F.inp(I_WO), 1024, 1024, 1024, (bf16*)(F.wsp() + WS_WO), (r % 32) * 32, (r / 32) * 64, (r % 32) * 32, scr, lane); continue; } r -= I5;
        if (r < I6) { const int sub = r / 128, q = r % 128, i = sub >> 1, hh = sub & 1;
            transpose_item(F.inp(I_CW1) + (size_t)i * 2048 * 256 + (size_t)hh * 1024 * 256, 256, 256, 1024, (bf16*)(F.wsp() + WS_W1C) + (size_t)i * 512 * 1024, hh * 256 + (q % 8) * 32, (q / 8) * 64, (q % 8) * 32, scr, lane); continue; } r -= I6;
        if (r < I7) { const int mi = r / 512, q = r % 512, n0 = (q % 32) * 32;
            transpose_item(F.inp(I_WGU) + (size_t)mi * 1024 * 1024, 1024, 1024, 1024, (bf16*)(F.wsp() + WS_WGU) + (size_t)mi * 1024 * 1024, pairmap(n0, 512), (q / 32) * 64, n0, scr, lane); continue; } r -= I7;
        { const int mi = r / 256, q = r % 256, n0 = (q % 32) * 32;
            transpose_item(F.inp(I_WDN) + (size_t)mi * 512 * 1024, 1024, 1024, 512, (bf16*)(F.wsp() + WS_WDN) + (size_t)mi * 1024 * 512, n0, (q / 32) * 64, n0, scr, lane); }
    }
}
__device__ __forceinline__ f32x4 mod4_partials(const Frame& F, int l, int b, int e) {
    f32x4 s = *(const f32x4*)(F.inp(I_ADAB) + l * 6144 + e);
    const float* mp = (const float*)(F.wsp() + WS_MODP) + (size_t)(l * 4 + b) * 6144 + e;
#pragma unroll
    for (int d = 0; d < 16; ++d) s += *(const f32x4*)(mp + (size_t)d * 49152);
    return s;
}
__device__ __forceinline__ void p1_mod_u0(Frame& F) {
    float* MOD = (float*)(F.wsp() + WS_MOD);
    for (int ch = F.gw; ch < 768; ch += F.NGW) {
        const int idx = ch * 64 + F.lane, lb = idx / 6144, e = idx % 6144;
        float s = F.inp(I_ADAB)[(lb >> 2) * 6144 + e];
        const float* mp = (const float*)(F.wsp() + WS_MODP) + idx;
#pragma unroll
        for (int d = 0; d < 16; ++d) s += mp[(size_t)d * 49152];
        MOD[idx] = s;
    }
    bf16* U = (bf16*)(F.wsp() + WS_U);
    LAS f32x4* msh = (LAS f32x4*)F.lds;
    for (int c0 = blockIdx.x * 64; c0 < T; c0 += gridDim.x * 64) {
        const int b = c0 >> 12;
        __syncthreads();
        { const int t = F.tid, e = 4 * (t & 255) + (t >> 8) * 1024; f32x4 v = mod4_partials(F, 0, b, e); if (t >= 256) v = v + 1.0f; msh[t] = v; }
        __syncthreads();
        f32x4 sh[4], sc[4];
#pragma unroll
        for (int j = 0; j < 4; ++j) { sh[j] = msh[F.lane + 64 * j]; sc[j] = msh[256 + F.lane + 64 * j]; }
        const int m0 = c0 + F.wave * 8;
#pragma unroll 1
        for (int m = m0; m < m0 + 8; m += 2) {
            f32x4 v[2][4];
#pragma unroll
            for (int r = 0; r < 2; ++r)
#pragma unroll
                for (int j = 0; j < 4; ++j) v[r][j] = *(const f32x4*)(F.inp(I_X) + (size_t)(m + r) * DM + 4 * F.lane + 256 * j);
#pragma unroll
            for (int r = 0; r < 2; ++r)
#pragma unroll
                for (int j = 0; j < 4; ++j) st_bf4(U + (size_t)(m + r) * DM + 4 * F.lane + 256 * j, v[r][j] * sc[j] + sh[j]);
        }
    }
}
template <bool PAIR, class AR, class EP>
__device__ __forceinline__ void gemm_wave_tile(const AR& arow, const bf16* Btile, int K, int m0, int nbase, const EP& ep, int lane) {
    const int fr = lane & 15, fq = lane >> 4;
    f32x4 acc[4][4];
#pragma unroll
    for (int i = 0; i < 4; ++i)
#pragma unroll
        for (int j = 0; j < 4; ++j) acc[i][j] = (f32x4){0.f, 0.f, 0.f, 0.f};
    const bf16* ap[4]; const bf16* bp[4];
#pragma unroll
    for (int i = 0; i < 4; ++i) ap[i] = arow(m0 + 16 * i + fr) + 8 * fq;
#pragma unroll
    for (int j = 0; j < 4; ++j) { const int nr = PAIR ? ((j & 1) * 16 + (j >> 1) * 128) : 16 * j; bp[j] = Btile + (size_t)(nr + fr) * K + 8 * fq; }
    for (int k0 = 0; k0 < K; k0 += 32) {
        bf16x8 a[4], b[4];
#pragma unroll
        for (int i = 0; i < 4; ++i) a[i] = *(const bf16x8*)(ap[i] + k0);
#pragma unroll
        for (int j = 0; j < 4; ++j) b[j] = *(const bf16x8*)(bp[j] + k0);
#pragma unroll
        for (int i = 0; i < 4; ++i)
#pragma unroll
            for (int j = 0; j < 4; ++j) acc[i][j] = __builtin_amdgcn_mfma_f32_16x16x32_bf16(b[j], a[i], acc[i][j], 0, 0, 0);
    }
#pragma unroll
    for (int i = 0; i < 4; ++i) {
        const int m = m0 + 16 * i + fr;
        if constexpr (PAIR) {
#pragma unroll
            for (int j = 0; j < 2; ++j) ep.pair(m, nbase + 16 * j + 4 * fq, acc[i][j], acc[i][j + 2]);
        } else {
#pragma unroll
            for (int j = 0; j < 4; ++j) ep(m, nbase + 16 * j + 4 * fq, acc[i][j]);
        }
    }
}
struct ARowPlain { const bf16* A; int K; __device__ __forceinline__ const bf16* operator()(int m) const { return A + (size_t)m * K; } };

struct EpBf16 { bf16* O; int ld; __device__ __forceinline__ void operator()(int m, int n, f32x4 v) const { st_bf4(O + (size_t)m * ld + n, v); }
    __device__ __forceinline__ void op8(int m, int n, f32x4 a, f32x4 b) const { st_bf8(O + (size_t)m * ld + n, a, b); } };
struct EpMulPair { bf16* O; int ld; __device__ __forceinline__ void pair(int m, int ch, f32x4 a, f32x4 b) const { st_bf4(O + (size_t)m * ld + ch, a * b); }
    __device__ __forceinline__ void pair8(int m, int ch, f32x4 a0, f32x4 a1, f32x4 b0, f32x4 b1) const { st_bf8(O + (size_t)m * ld + ch, a0 * b0, a1 * b1); } };
struct EpSiluPair { bf16* O; int ld; __device__ __forceinline__ void pair(int m, int ch, f32x4 a, f32x4 b) const {
    f32x4 s; for (int r = 0; r < 4; ++r) s[r] = silu_f(a[r]) * b[r]; st_bf4(O + (size_t)m * ld + ch, s); } };
__device__ __forceinline__ f32x4 ld_bf4(const bf16* p) { const u32x2 w = *(const u32x2*)p; return (f32x4){bflo(w.x), bfhi(w.x), bflo(w.y), bfhi(w.y)}; }
struct EpRes { const float* base; bf16* out; const float* gmod;
    __device__ __forceinline__ void operator()(int m, int n, f32x4 v) const { const int b = m >> 12; const f32x4 g = *(const f32x4*)(gmod + b * 6144 + n);
        const f32x4 x = *(const f32x4*)(base + (size_t)m * DM + n); st_bf4(out + (size_t)m * DM + n, x * ALPHA + g * v); } };
struct EpResB { bf16* res; const float* gmod;
    __device__ __forceinline__ void operator()(int m, int n, f32x4 v) const { const int b = m >> 12; const f32x4 g = *(const f32x4*)(gmod + b * 6144 + n);
        bf16* p = res + (size_t)m * DM + n; st_bf4(p, ld_bf4(p) * ALPHA + g * v); } };
__device__ __forceinline__ int kfrag_off(int kk, int d) { return ((((kk >> 5) * 4 + (d >> 4)) * 2 + ((d >> 3) & 1)) * 32 + (kk & 31)) * 8 + (d & 7); }
__device__ __forceinline__ int vfrag_off(int kk, int d) { return ((((d >> 5) * 4 + (kk >> 4)) * 2 + ((kk >> 2) & 1)) * 32 + (d & 31)) * 8 + ((((kk >> 3) & 1) << 2) | (kk & 3)); }
struct EpKV { bf16* KV; __device__ __forceinline__ void operator()(int m, int n, f32x4 v) const {
    const int j = n >> 8, hk = (n >> 6) & 3, d = n & 63, b = m >> 12, t = m & 4095;
    bf16* base = KV + (size_t)j * KVBUF_ELEMS + (size_t)(b * 4 + hk) * KVROWS * 64;
    if (j < 2) st_bf4(base + (size_t)t * 64 + d, v);
    else if ((j & 1) == 0) st_bf4(base + (size_t)(t >> 6) * 4096 + kfrag_off(t & 63, d), v);
    else { bf16* tp = base + (size_t)(t >> 6) * 4096;
        for (int r = 0; r < 4; ++r) tp[vfrag_off(t & 63, d + r)] = (bf16)f2bf(v[r]); } }
    __device__ __forceinline__ void op8(int m, int n, f32x4 a, f32x4 c) const {
    const int j = n >> 8, hk = (n >> 6) & 3, d = n & 63, b = m >> 12, t = m & 4095;
    bf16* base = KV + (size_t)j * KVBUF_ELEMS + (size_t)(b * 4 + hk) * KVROWS * 64;
    if (j < 2) st_bf8(base + (size_t)t * 64 + d, a, c);
    else if ((j & 1) == 0) st_bf8(base + (size_t)(t >> 6) * 4096 + kfrag_off(t & 63, d), a, c);
    else { bf16* tp = base + (size_t)(t >> 6) * 4096;
        for (int r = 0; r < 4; ++r) { tp[vfrag_off(t & 63, d + r)] = (bf16)f2bf(a[r]); tp[vfrag_off(t & 63, d + 4 + r)] = (bf16)f2bf(c[r]); } } } };
struct EpQG { bf16* Q; float* GATE; const float* bg; __device__ __forceinline__ void operator()(int m, int n, f32x4 v) const {
    if (n < 1024) st_bf4(Q + (size_t)m * DM + n, v * C2);
    else { for (int r = 0; r < 4; ++r) { const int i = n - 1024 + r; if (i < 48) GATE[(size_t)m * 48 + i] = 1.f / (1.f + __expf(-(v[r] + bg[i]))); } } }
    __device__ __forceinline__ void op8(int m, int n, f32x4 a, f32x4 c) const {
    if (n < 1024) st_bf8(Q + (size_t)m * DM + n, a * C2, c * C2);
    else { (*this)(m, n, a); (*this)(m, n + 4, c); } } };
struct EpF32 { float* O; int ld; __device__ __forceinline__ void operator()(int m, int n, f32x4 v) const { *(f32x4*)(O + (size_t)m * ld + n) = v; } };

template <bool PAIR, class AR, class EP>
__device__ __forceinline__ void gemm_dense(Frame& F, const AR& arow, const bf16* Bt, int K, int nM64, int nN64, int chbase, const EP& ep) {
    const int total = nM64 * nN64;
    for (int it = F.gw; it < total; it += F.NGW) {
        const int ni = it % nN64, mt = it / nN64;
        if constexpr (PAIR) { const int pn = ni >> 2, q = ni & 3;
            gemm_wave_tile<true>(arow, Bt + (size_t)(pn * 256 + q * 32) * K, K, mt * 64, chbase + pn * 128 + q * 32, ep, F.lane);
        } else gemm_wave_tile<false>(arow, Bt + (size_t)(ni * 64) * K, K, mt * 64, chbase + ni * 64, ep, F.lane);
    }
}

namespace pg8 {
#define PG8_LAS __attribute__((address_space(3)))
constexpr int BM = 256, BK = 64, HALF = 128, HTB = HALF * BK * 2, STAGE_BYTES = 8 * HTB, NXCD = 8, WGM = 8;
__device__ __forceinline__ int lds_byte(int r, int c) { const int st = (r >> 4) * 2 + (c >> 5), rr = r & 15, cc = c & 31, ob = rr * 64 + cc * 2; return st * 1024 + (ob ^ (((ob >> 9) & 1) << 5)); }
__device__ __forceinline__ void stage_rc(int b, int& R, int& C) { const int st = b / 1024, sb = b % 1024, swz = sb ^ (((sb >> 9) & 1) << 5); R = (st >> 1) * 16 + swz / 64; C = (st & 1) * 32 + (swz % 64) / 2; }
struct Unit { const char* A; const char* B; int row0, col0, e, pos0, cnt; };
__device__ __forceinline__ bool static_order(int i, int G, int c, int nM, int nN, int& pm, int& pn) {
    const int nwg = nM * nN; const long L = (long)i * G + c; if (L >= nwg) return false;
    int wgid = (int)L; { const int q = nwg / NXCD, r = nwg % NXCD, xcd = wgid % NXCD, off = wgid / NXCD; wgid = (xcd < r ? xcd * (q + 1) : r * (q + 1) + (xcd - r) * q) + off; }
    const int nig = WGM * nN, gid = wgid / nig, fm = gid * WGM, gsz = (nM - fm) < WGM ? (nM - fm) : WGM;
    pm = fm + ((wgid % nig) % gsz); pn = (wgid % nig) / gsz; return true;
}
__device__ __forceinline__ void voff_plain(const int (&R)[2], const int (&C)[2], int K, unsigned (&v)[2][2]) {
#pragma unroll
    for (int h = 0; h < 2; ++h)
#pragma unroll
        for (int i = 0; i < 2; ++i) v[h][i] = (unsigned)((h * HALF + R[i]) * K + C[i]) * 2u;
}
__device__ __forceinline__ int perm32(int rho) { const int n = rho >> 4, i = rho & 15; return 8 * (i >> 2) + 4 * n + (i & 3); }
template <class EP, bool PAIR, bool PERM_ = false> struct EpiWrap {
    static constexpr bool PERM = PERM_;
    EP ep;
    __device__ __forceinline__ void operator()(const f32x4 (&acc)[2][2][4][2], const Unit& u, int wr, int wc, int fr, int fq) const {
#pragma unroll
        for (int ai = 0; ai < 2; ++ai)
#pragma unroll
            for (int m = 0; m < 4; ++m) { const int row = u.row0 + ai * HALF + wr * 64 + m * 16 + fr;
                if constexpr (PERM_) {
                    if constexpr (PAIR) ep.pair8(u, row, u.col0 + wc * 32 + 8 * fq, acc[ai][0][m][0], acc[ai][0][m][1], acc[ai][1][m][0], acc[ai][1][m][1]);
                    else {
#pragma unroll
                        for (int bj = 0; bj < 2; ++bj) ep.op8(u, row, u.col0 + bj * HALF + wc * 32 + 8 * fq, acc[ai][bj][m][0], acc[ai][bj][m][1]); }
                } else if constexpr (PAIR) {
#pragma unroll
                    for (int n = 0; n < 2; ++n) ep.pair(u, row, u.col0 + wc * 32 + 16 * n + 4 * fq, acc[ai][0][m][n], acc[ai][1][m][n]);
                } else {
#pragma unroll
                    for (int bj = 0; bj < 2; ++bj)
#pragma unroll
                        for (int n = 0; n < 2; ++n) ep(u, row, u.col0 + bj * HALF + wc * 32 + 16 * n + 4 * fq, acc[ai][bj][m][n]);
                } }
    }
};
template <class Epi, class Sched, bool ALIGN_EPI, bool GATHER>
__device__ __forceinline__ void gemm_phase(PG8_LAS unsigned char* lds, const int K, const Sched& S, const Epi& E) {
    const int tid = threadIdx.x, wid = __builtin_amdgcn_readfirstlane(tid >> 6), lane = tid & 63, wr = wid >> 2, wc = wid & 3, fr = lane & 15, fq = lane >> 4;
    const int nt = K / BK;
    int R[2], C[2]; unsigned voffB[2]; unsigned vC[2][2], vN[2][2];
#pragma unroll
    for (int i = 0; i < 2; ++i) { stage_rc(tid * 16 + i * 8192, R[i], C[i]); const int Rb = Epi::PERM ? ((R[i] & ~31) | perm32(R[i] & 31)) : R[i]; voffB[i] = (unsigned)(Rb * K + C[i]) * 2u; }
    const size_t kstep = (size_t)(BK * 2);
    const size_t hstep = (size_t)HALF * K * 2;
    const unsigned ldsw = (unsigned)wid * 1024u;
    const int aoff = lds_byte(wr * 64 + fr, fq * 8), boff = lds_byte(wc * 32 + fr, fq * 8);
#define PG8_SA(b, h) (((b) * 2 + (h)) * HTB)
#define PG8_SB(b, h) ((4 + (b) * 2 + (h)) * HTB)
#define PG8_STAGE(bufoff, gbase, voff) do { _Pragma("unroll") for (int _i = 0; _i < 2; ++_i) \
        __builtin_amdgcn_global_load_lds((const unsigned*)((const char*)(gbase) + (voff)[_i]), (PG8_LAS unsigned*)(lds + (bufoff) + ldsw + _i * 8192), 16, 0, 0); } while (0)
#define PG8_LDA(dst, b, h) do { _Pragma("unroll") for (int m = 0; m < 4; ++m) _Pragma("unroll") for (int k = 0; k < 2; ++k) dst[m][k] = *(const PG8_LAS bf16x8*)(lds + PG8_SA(b, h) + aoff + m * 2048 + k * 1024); } while (0)
#define PG8_LDB(dst, b, h) do { _Pragma("unroll") for (int n = 0; n < 2; ++n) _Pragma("unroll") for (int k = 0; k < 2; ++k) dst[n][k] = *(const PG8_LAS bf16x8*)(lds + PG8_SB(b, h) + boff + n * 2048 + k * 1024); } while (0)
#define PG8_MMA(ai, bj, At, Bt) do { __builtin_amdgcn_s_setprio(1); _Pragma("unroll") for (int m = 0; m < 4; ++m) _Pragma("unroll") for (int n = 0; n < 2; ++n) _Pragma("unroll") for (int k = 0; k < 2; ++k) \
        acc[ai][bj][m][n] = __builtin_amdgcn_mfma_f32_16x16x32_bf16(Bt[n][k], At[m][k], acc[ai][bj][m][n], 0, 0, 0); __builtin_amdgcn_s_setprio(0); } while (0)
#define PG8_WAIT_V(n) asm volatile("s_waitcnt vmcnt(" #n ")" ::: "memory")
#define PG8_WAIT_L(n) asm volatile("s_waitcnt lgkmcnt(" #n ")" ::: "memory")
#define PG8_BAR __builtin_amdgcn_s_barrier()
#define PG8_SCHED __builtin_amdgcn_sched_barrier(0)
    Unit cur, nxt; int ui = 0;
    if (!S.next(0, cur)) return;
    S.voff(cur, R, C, K, vC);
    f32x4 acc[2][2][4][2];
#pragma unroll
    for (int a = 0; a < 2; ++a)
#pragma unroll
        for (int b = 0; b < 2; ++b)
#pragma unroll
            for (int m = 0; m < 4; ++m)
#pragma unroll
                for (int n = 0; n < 2; ++n) acc[a][b][m][n] = (f32x4){0.f, 0.f, 0.f, 0.f};
    bf16x8 At[4][2], B0[2][2], B1[2][2];
    const char* cA = cur.A; const char* cB = cur.B;
    PG8_STAGE(PG8_SB(0, 0), cB, voffB); PG8_STAGE(PG8_SB(0, 1), cB + hstep, voffB); PG8_STAGE(PG8_SA(0, 0), cA, vC[0]); PG8_STAGE(PG8_SA(0, 1), cA, vC[1]);
    if (wr == 1) PG8_BAR;
    PG8_WAIT_V(2); PG8_BAR;
    PG8_STAGE(PG8_SB(1, 0), cB + kstep, voffB); PG8_STAGE(PG8_SA(1, 0), cA + kstep, vC[0]); PG8_STAGE(PG8_SB(1, 1), cB + hstep + kstep, voffB);
    PG8_WAIT_V(6); PG8_BAR;
    for (;;) {
        const bool has_next = S.next(ui + 1, nxt);
        const char* nA = has_next ? nxt.A : cA; const char* nB = has_next ? nxt.B : cB;
        if constexpr (GATHER) { if (has_next) S.voff(nxt, R, C, K, vN); else { vN[0][0] = vC[0][0]; vN[0][1] = vC[0][1]; vN[1][0] = vC[1][0]; vN[1][1] = vC[1][1]; } }
        for (int t = 0; t < nt; t += 2) {
            const bool last = (t == nt - 2);
            const char* a1 = cA + (size_t)(t + 1) * kstep;
            const char* a2 = last ? nA : cA + (size_t)(t + 2) * kstep; const char* b2 = last ? nB : cB + (size_t)(t + 2) * kstep;
            const char* a3 = a2 + kstep; const char* b3 = b2 + kstep;
            unsigned v2[2][2];
#pragma unroll
            for (int h = 0; h < 2; ++h)
#pragma unroll
                for (int i = 0; i < 2; ++i) v2[h][i] = (GATHER && last) ? vN[h][i] : vC[h][i];
            PG8_LDB(B0, 0, 0); PG8_LDB(B1, 0, 1); PG8_SCHED; PG8_LDA(At, 0, 0); PG8_STAGE(PG8_SA(1, 1), a1, vC[1]);
            PG8_WAIT_V(8); PG8_WAIT_L(0); PG8_BAR; PG8_MMA(0, 0, At, B0); PG8_MMA(0, 1, At, B1); PG8_BAR; PG8_SCHED;
            PG8_LDA(At, 0, 1); PG8_STAGE(PG8_SB(0, 0), b2, voffB); PG8_STAGE(PG8_SB(0, 1), b2 + hstep, voffB); PG8_STAGE(PG8_SA(0, 0), a2, v2[0]);
            PG8_WAIT_V(8); PG8_WAIT_L(0); PG8_BAR; PG8_MMA(1, 0, At, B0); PG8_MMA(1, 1, At, B1); PG8_BAR; PG8_SCHED;
            PG8_LDB(B0, 1, 0); PG8_LDB(B1, 1, 1); PG8_SCHED; PG8_LDA(At, 1, 0); PG8_STAGE(PG8_SA(0, 1), a2, v2[1]);
            PG8_WAIT_V(8); PG8_WAIT_L(0); PG8_BAR; PG8_MMA(0, 0, At, B0); PG8_MMA(0, 1, At, B1); PG8_BAR; PG8_SCHED;
            PG8_LDA(At, 1, 1); PG8_STAGE(PG8_SB(1, 0), b3, voffB); PG8_STAGE(PG8_SB(1, 1), b3 + hstep, voffB); PG8_STAGE(PG8_SA(1, 0), a3, v2[0]);
            PG8_WAIT_V(8); PG8_WAIT_L(0); PG8_BAR; PG8_MMA(1, 0, At, B0); PG8_MMA(1, 1, At, B1); PG8_BAR; PG8_SCHED;
        }
        if constexpr (ALIGN_EPI) { if (wr == 0) PG8_BAR; }
        E(acc, cur, wr, wc, fr, fq);
        if (!has_next) break;
#pragma unroll
        for (int a = 0; a < 2; ++a)
#pragma unroll
            for (int b = 0; b < 2; ++b)
#pragma unroll
                for (int m = 0; m < 4; ++m)
#pragma unroll
                    for (int n = 0; n < 2; ++n) acc[a][b][m][n] = (f32x4){0.f, 0.f, 0.f, 0.f};
        cur = nxt; cA = nA; cB = nB; ++ui;
        if constexpr (GATHER) { vC[0][0] = vN[0][0]; vC[0][1] = vN[0][1]; vC[1][0] = vN[1][0]; vC[1][1] = vN[1][1]; }
        if constexpr (ALIGN_EPI) { if (wr == 1) PG8_BAR; }
    }
    PG8_WAIT_V(0);
    if constexpr (!ALIGN_EPI) { if (wr == 0) PG8_BAR; }
    PG8_BAR;
#undef PG8_SA
#undef PG8_SB
#undef PG8_STAGE
#undef PG8_LDA
#undef PG8_LDB
#undef PG8_MMA
#undef PG8_WAIT_V
#undef PG8_WAIT_L
#undef PG8_BAR
#undef PG8_SCHED
}
struct SchedDense {
    const char* A0; const char* B0; const char* A1; const char* B1; int nM, nN0, nN1, K, G, c, colmul;
    __device__ __forceinline__ bool next(int i, Unit& u) const {
        int pm, pn; if (!static_order(i, G, c, nM, nN0 + nN1, pm, pn)) return false;
        const int sec = pn >= nN0 ? 1 : 0, pl = pn - (sec ? nN0 : 0);
        u.A = (sec ? A1 : A0) + (size_t)pm * 256 * K * 2; u.B = (sec ? B1 : B0) + (size_t)pl * 256 * K * 2;
        u.row0 = pm * 256; u.col0 = pl * colmul; u.e = sec; u.pos0 = 0; u.cnt = 0; return true;
    }
    __device__ __forceinline__ void voff(const Unit&, const int (&R)[2], const int (&C)[2], int K_, unsigned (&v)[2][2]) const { voff_plain(R, C, K_, v); }
};
}
template <class EP> struct EpU { EP ep; __device__ __forceinline__ void operator()(const pg8::Unit&, int m, int n, f32x4 v) const { ep(m, n, v); }
    __device__ __forceinline__ void op8(const pg8::Unit&, int m, int n, f32x4 a, f32x4 b) const { ep.op8(m, n, a, b); } };
template <class EP> struct EpUP { EP ep; __device__ __forceinline__ void pair(const pg8::Unit&, int m, int ch, f32x4 a, f32x4 b) const { ep.pair(m, ch, a, b); }
    __device__ __forceinline__ void pair8(const pg8::Unit&, int m, int ch, f32x4 a0, f32x4 a1, f32x4 b0, f32x4 b1) const { ep.pair8(m, ch, a0, a1, b0, b1); } };
struct EpG1 { static constexpr bool PERM = true; bf16* BG; bf16* Z;
    __device__ __forceinline__ void operator()(const f32x4 (&acc)[2][2][4][2], const pg8::Unit& u, int wr, int wc, int fr, int fq) const {
        if (u.e == 0) { pg8::EpiWrap<EpU<EpBf16>, false, true> w{{{BG, DM}}}; w(acc, u, wr, wc, fr, fq); }
        else { pg8::Unit u2 = u; u2.col0 = u.col0 >> 1; pg8::EpiWrap<EpUP<EpMulPair>, true, true> w{{{Z, DM}}}; w(acc, u2, wr, wc, fr, fq); }
    } };
struct EpNull { static constexpr bool PERM = false; __device__ __forceinline__ void operator()(const f32x4 (&acc)[2][2][4][2], const pg8::Unit&, int, int, int, int) const {
#pragma unroll
    for (int a = 0; a < 2; ++a)
#pragma unroll
        for (int b = 0; b < 2; ++b)
#pragma unroll
            for (int m = 0; m < 4; ++m)
#pragma unroll
                for (int n = 0; n < 2; ++n) asm volatile("" :: "v"(acc[a][b][m][n])); } };
struct EpKVQG { bf16* KV; bf16* Q; float* GATE; const float* bg;
    __device__ __forceinline__ void operator()(const pg8::Unit& u, int m, int n, f32x4 v) const { if (u.e == 0) { EpKV e{KV}; e(m, n, v); } else { EpQG e{Q, GATE, bg}; e(m, n, v); } }
    __device__ __forceinline__ void op8(const pg8::Unit& u, int m, int n, f32x4 a, f32x4 b) const { if (u.e == 0) { EpKV e{KV}; e.op8(m, n, a, b); } else { EpQG e{Q, GATE, bg}; e.op8(m, n, a, b); } } };

__device__ __forceinline__ void p3_conv(Frame& F) {
    const bf16* BG = (const bf16*)(F.wsp() + WS_BG); const bf16* Z = (const bf16*)(F.wsp() + WS_Z); bf16* A2 = (bf16*)(F.wsp() + WS_A2);
    const float* cw = F.inp(I_CONVW); const float* cb = F.inp(I_CONVB);
    const int gt = F.gw * 64 + F.lane, NT_ = F.NGW * 64;
    for (int it = gt; it < T * 128; it += NT_) {
        const int m = it >> 7, ch = (it & 127) * 8, t = m & 4095;
        const u32x4 bg = *(const u32x4*)(BG + (size_t)m * DM + ch);
        const u32x4 z0 = *(const u32x4*)(Z + (size_t)m * DM + ch);
        u32x4 z1 = (u32x4){0, 0, 0, 0}, z2 = (u32x4){0, 0, 0, 0};
        if (t >= 1) z1 = *(const u32x4*)(Z + (size_t)(m - 1) * DM + ch);
        if (t >= 2) z2 = *(const u32x4*)(Z + (size_t)(m - 2) * DM + ch);
        u32x4 o;
#pragma unroll
        for (int w = 0; w < 4; ++w) {
            const int c = ch + 2 * w;
            const float r0 = bflo(bg[w]) * (cw[c] * bflo(z2[w]) + cw[1024 + c] * bflo(z1[w]) + cw[2048 + c] * bflo(z0[w]) + cb[c]);
            const float r1 = bfhi(bg[w]) * (cw[c + 1] * bfhi(z2[w]) + cw[1024 + c + 1] * bfhi(z1[w]) + cw[2048 + c + 1] * bfhi(z0[w]) + cb[c + 1]);
            o[w] = pk2(r0, r1);
        }
        *(u32x4*)(A2 + (size_t)m * DM + ch) = o;
    }
}

__device__ __forceinline__ void ln_row(f32x4 (&v)[4], const float* g, const float* bb, int lane) {
    float s = 0.f;
#pragma unroll
    for (int j = 0; j < 4; ++j) s += (v[j][0] + v[j][1]) + (v[j][2] + v[j][3]);
    const float mean = wave_sum(s) * (1.f / DM); float s2 = 0.f;
#pragma unroll
    for (int j = 0; j < 4; ++j) { v[j] = v[j] - mean; s2 += (v[j][0] * v[j][0] + v[j][1] * v[j][1]) + (v[j][2] * v[j][2] + v[j][3] * v[j][3]); }
    const float rstd = 1.f / sqrtf(wave_sum(s2) * (1.f / DM) + LN_EPS);
#pragma unroll
    for (int j = 0; j < 4; ++j) { const int col = 4 * lane + 256 * j; v[j] = v[j] * rstd * *(const f32x4*)(g + col) + *(const f32x4*)(bb + col); }
}
template <int L, bool DRY = false>
__device__ __forceinline__ void p_ln_router(Frame& F) {
    bf16* RES = (bf16*)(F.wsp() + WS_XB); bf16* U = (bf16*)(F.wsp() + WS_U);
    bf16* RESO = DRY ? (bf16*)(F.wsp() + WS_Y0) : RES; if (DRY) U = (bf16*)(F.wsp() + WS_H);
    const float* MOD = (const float*)(F.wsp() + WS_MOD) + (size_t)L * 4 * 6144;
    const float* rw = F.inp(I_RW); const float* rb = F.inp(I_RB);
    gu32* cnt = F.ctlp() + CW_CNT + L * 1024;
    unsigned* LIST = (unsigned*)(F.wsp() + WS_LIST) + (size_t)L * NE * T; float* LW = (float*)(F.wsp() + WS_LW) + (size_t)L * NE * T;
    const int lane = F.lane;
    LAS int* ae = (LAS int*)F.lds; LAS float* aw = (LAS float*)(F.lds + 512); LAS int* base = (LAS int*)(F.lds + 1024);
    constexpr int RS = 2064, AST_OFF = 2048, ALO_OFF = AST_OFF + 16 * RS, PST_OFF = ALO_OFF + 16 * RS;
    static_assert(PST_OFF + 8192 <= LDSCTL_OFF, "router LDS map");
    const int r16 = lane & 15, kg = lane >> 4;
    bf16x8 Bh[4], Bl[4];
#pragma unroll
    for (int s_ = 0; s_ < 4; ++s_) { u32x4 hh, ll;
#pragma unroll
        for (int i = 0; i < 4; ++i) { const int k = 128 * F.wave + 32 * s_ + 8 * kg + 2 * i; const float a = rw[(size_t)k * 16 + r16], b_ = rw[(size_t)(k + 1) * 16 + r16];
            const unsigned h = pk2(a, b_); hh[i] = h; ll[i] = pk2(a - bflo(h), b_ - bfhi(h)); }
        Bh[s_] = __builtin_bit_cast(bf16x8, hh); Bl[s_] = __builtin_bit_cast(bf16x8, ll); }
    const int nchunk = T / 64;
    for (int ch = blockIdx.x; ch < nchunk; ch += gridDim.x) {
      const bf16* YB = (const bf16*)(F.wsp() + WS_Y0); const float* XF = F.inp(I_X);
      u32x2 yn[4]; f32x4 xn[4];
#pragma unroll
      for (int j = 0; j < 4; ++j) { const size_t o = (size_t)(ch * 64 + F.wave * 2) * DM + 4 * lane + 256 * j; yn[j] = *(const u32x2*)(YB + o);
          if (L == 0) xn[j] = *(const f32x4*)(XF + o); else xn[j] = ld_bf4(RES + o); }
#pragma unroll 2
      for (int rr = 0; rr < 8; ++rr) {
        const int pass = rr >> 1, sub = rr & 1, lrow = pass * 16 + F.wave * 2 + sub, m = ch * 64 + lrow;
        const int b = m >> 12;
        f32x4 v[4];
#pragma unroll
        for (int j = 0; j < 4; ++j) { const f32x4 g1 = *(const f32x4*)(MOD + b * 6144 + 2 * 1024 + 4 * lane + 256 * j);
            v[j] = xn[j] * ALPHA + g1 * (f32x4){bflo(yn[j].x), bfhi(yn[j].x), bflo(yn[j].y), bfhi(yn[j].y)}; }
        if (rr < 7) {
#pragma unroll
            for (int j = 0; j < 4; ++j) { const size_t o = (size_t)(m + (sub ? 15 : 1)) * DM + 4 * lane + 256 * j; yn[j] = *(const u32x2*)(YB + o);
                if (L == 0) xn[j] = *(const f32x4*)(XF + o); else xn[j] = ld_bf4(RES + o); } }
        ln_row(v, F.inp(I_LNG) + (L * 2 + 0) * DM, F.inp(I_LNB) + (L * 2 + 0) * DM, lane);
        {
            LAS unsigned char* arow = F.lds + AST_OFF + (F.wave * 2 + sub) * RS + lane * 8;
#pragma unroll
            for (int j = 0; j < 4; ++j) { const int col = 4 * lane + 256 * j;
                st_bf4(RESO + (size_t)m * DM + col, v[j]);
                const f32x4 u = v[j] * (*(const f32x4*)(MOD + b * 6144 + 4 * 1024 + col) + 1.0f) + *(const f32x4*)(MOD + b * 6144 + 3 * 1024 + col);
                u32x2 hh, ll; hh.x = pk2(u[0], u[1]); hh.y = pk2(u[2], u[3]);
                ll.x = pk2(u[0] - bflo(hh.x), u[1] - bfhi(hh.x)); ll.y = pk2(u[2] - bflo(hh.y), u[3] - bfhi(hh.y));
                *(u32x2*)(U + (size_t)m * DM + col) = hh;
                *(LAS u32x2*)(arow + j * 512) = hh; *(LAS u32x2*)(arow + 16 * RS + j * 512) = ll; }
        }
        if (sub == 0) continue;
        __syncthreads();
        float lgv;
        {
            f32x4 acc = (f32x4){0.f, 0.f, 0.f, 0.f};
            const LAS unsigned char* ap = F.lds + AST_OFF + r16 * RS + (128 * F.wave + 8 * kg) * 2;
#pragma unroll
            for (int s_ = 0; s_ < 4; ++s_) { const bf16x8 ah = *(const LAS bf16x8*)(ap + s_ * 64), al = *(const LAS bf16x8*)(ap + 16 * RS + s_ * 64);
                acc = __builtin_amdgcn_mfma_f32_16x16x32_bf16(ah, Bh[s_], acc, 0, 0, 0);
                acc = __builtin_amdgcn_mfma_f32_16x16x32_bf16(al, Bh[s_], acc, 0, 0, 0);
                acc = __builtin_amdgcn_mfma_f32_16x16x32_bf16(ah, Bl[s_], acc, 0, 0, 0); }
            *(LAS f32x4*)(F.lds + PST_OFF + ((F.wave * 4 + kg) * 16 + r16) * 16) = acc;
            __syncthreads();
            const int rho = 2 * F.wave + (kg & 1); float sm = 0.f;
#pragma unroll
            for (int x = 0; x < 4; ++x) sm += *(const LAS float*)(F.lds + PST_OFF + ((((kg >> 1) * 4 + x) * 4 + (rho >> 2)) * 16 + r16) * 16 + (rho & 3) * 4);
            lgv = sm + __shfl_xor(sm, 32);
        }
#pragma unroll 1
        for (int sb = 0; sb < 2; ++sb) {
        const int lrow2 = pass * 16 + F.wave * 2 + sb;
        float lg[16];
#pragma unroll
        for (int e = 0; e < 16; ++e) lg[e] = __builtin_bit_cast(float, __builtin_amdgcn_readlane(__builtin_bit_cast(int, lgv), 16 * sb + e));
        float mx = lg[0];
#pragma unroll
        for (int e = 1; e < 16; ++e) mx = fmaxf(mx, lg[e]);
        float aff[16], bi[16]; float sum = 0.f;
#pragma unroll
        for (int e = 0; e < 16; ++e) { aff[e] = __expf(lg[e] - mx); sum += aff[e]; }
        const float inv = 1.f / sum;
#pragma unroll
        for (int e = 0; e < 16; ++e) { aff[e] *= inv; bi[e] = aff[e] + rb[e]; }
        float gs[4];
#pragma unroll
        for (int g = 0; g < 4; ++g) { const float a0 = bi[4 * g], a1 = bi[4 * g + 1], a2 = bi[4 * g + 2], a3 = bi[4 * g + 3];
            const float t1 = fmaxf(a0, a1), t2 = fminf(a0, a1), u1 = fmaxf(a2, a3), u2 = fminf(a2, a3);
            gs[g] = fmaxf(t1, u1) + fmaxf(fminf(t1, u1), fmaxf(t2, u2)); }
        int best = 0; float bv = gs[0];
#pragma unroll
        for (int g = 1; g < 4; ++g) if (gs[g] > bv) { bv = gs[g]; best = g; }
        float cb_[4], ca_[4];
#pragma unroll
        for (int i = 0; i < 4; ++i) { cb_[i] = best == 0 ? bi[i] : best == 1 ? bi[4 + i] : best == 2 ? bi[8 + i] : bi[12 + i];
                                      ca_[i] = best == 0 ? aff[i] : best == 1 ? aff[4 + i] : best == 2 ? aff[8 + i] : aff[12 + i]; }
        int i0 = 0; float b0 = cb_[0];
#pragma unroll
        for (int i = 1; i < 4; ++i) if (cb_[i] > b0) { b0 = cb_[i]; i0 = i; }
        int i1 = -1; float b1 = -3.0e38f;
#pragma unroll
        for (int i = 0; i < 4; ++i) if (i != i0 && cb_[i] > b1) { b1 = cb_[i]; i1 = i; }
        const float w0 = i0 == 0 ? ca_[0] : i0 == 1 ? ca_[1] : i0 == 2 ? ca_[2] : ca_[3];
        const float w1 = i1 == 0 ? ca_[0] : i1 == 1 ? ca_[1] : i1 == 2 ? ca_[2] : ca_[3];
        const float ws_ = 1.f / (w0 + w1);
        if (lane == 0) { ae[2 * lrow2] = best * 4 + i0; ae[2 * lrow2 + 1] = best * 4 + i1; aw[2 * lrow2] = w0 * ws_; aw[2 * lrow2 + 1] = w1 * ws_; }
        }
      }
      __syncthreads();
      if (DRY) continue;
      if (F.tid < NE) { int c = 0; for (int i = 0; i < 128; ++i) c += (ae[i] == F.tid) ? 1 : 0;
          base[F.tid] = c ? (int)__hip_atomic_fetch_add(cnt + F.tid * 64, (unsigned)c, RLX_AGENT) : 0; }
      __syncthreads();
      if (F.tid < 128) { const int e = ae[F.tid]; int rk = 0; for (int i = 0; i < F.tid; ++i) rk += (ae[i] == e) ? 1 : 0;
          const int pos = base[e] + rk; const unsigned m = (unsigned)(ch * 64 + (F.tid >> 1));
          LIST[(size_t)e * T + pos] = m * 2u + (unsigned)(F.tid & 1); LW[(size_t)e * T + pos] = aw[F.tid]; }
      __syncthreads();
    }
}
template <int L, bool DRY = false>
__device__ __forceinline__ void p_ln2(Frame& F) {
    bf16* RES = (bf16*)(F.wsp() + WS_XB); bf16* U = (bf16*)(F.wsp() + WS_U); float* OUT = F.outp();
    bf16* RESO = DRY ? (bf16*)(F.wsp() + WS_R1) : RES; if (DRY) { U = (bf16*)(F.wsp() + WS_H); }
    const bf16* Y0 = (const bf16*)(F.wsp() + WS_Y0); const bf16* Y1 = (const bf16*)(F.wsp() + WS_Y1);
    const float* MOD = (const float*)(F.wsp() + WS_MOD) + (size_t)L * 4 * 6144;
    const float* MODN = (const float*)(F.wsp() + WS_MOD) + (size_t)1 * 4 * 6144;
    const int lane = F.lane;
    for (int m = F.gw; m < T; m += F.NGW) {
        const int b = m >> 12;
        f32x4 v[4];
#pragma unroll
        for (int j = 0; j < 4; ++j) { const int col = 4 * lane + 256 * j;
            const f32x4 x = ld_bf4(RES + (size_t)m * DM + col);
            const u32x2 a = *(const u32x2*)(Y0 + (size_t)m * DM + col), c = *(const u32x2*)(Y1 + (size_t)m * DM + col);
            const f32x4 y = (f32x4){bflo(a.x) + bflo(c.x), bfhi(a.x) + bfhi(c.x), bflo(a.y) + bflo(c.y), bfhi(a.y) + bfhi(c.y)};
            v[j] = x * ALPHA + *(const f32x4*)(MOD + b * 6144 + 5 * 1024 + col) * y; }
        ln_row(v, F.inp(I_LNG) + (L * 2 + 1) * DM, F.inp(I_LNB) + (L * 2 + 1) * DM, lane);
#pragma unroll
        for (int j = 0; j < 4; ++j) { const int col = 4 * lane + 256 * j;
            if (L == 1) *(f32x4*)(OUT + (size_t)m * DM + col) = v[j];
            if (L == 0) { st_bf4(RESO + (size_t)m * DM + col, v[j]);
                st_bf4(U + (size_t)m * DM + col, v[j] * (*(const f32x4*)(MODN + b * 6144 + 1024 + col) + 1.0f) + *(const f32x4*)(MODN + b * 6144 + col)); } }
    }
}

__device__ __forceinline__ void moe_tables(Frame& F, int L) {
    LAS int* tb = (LAS int*)(F.lds + MISC_OFF + 128); LAS int* cn = tb + 20;
    __syncthreads();
    if (F.tid == 0) { int acc = 0; for (int e = 0; e < NE; ++e) { const int c = (int)__hip_atomic_load(F.ctlp() + CW_CNT + L * 1024 + e * 64, RLX_AGENT); cn[e] = c; tb[e] = acc; acc += (c + 255) >> 8; } tb[NE] = acc; }
    __syncthreads();
}
struct ARowMoe { const bf16* U; const unsigned* list; int rbase, cnt;
    __device__ __forceinline__ const bf16* operator()(int r) const { const int pos = r - rbase; const unsigned tok = pos < cnt ? (list[pos] >> 1) : 0u; return U + (size_t)tok * DM; } };
struct EpY { bf16* Y; const unsigned* list; const float* lw; int rbase, cnt;
    __device__ __forceinline__ void operator()(int r, int n, f32x4 v) const { const int pos = r - rbase; if (pos < cnt) { const unsigned ts = list[pos]; const float w = lw[pos];
        st_bf4(Y + (size_t)(ts & 1u) * ((size_t)T * DM) + (size_t)(ts >> 1) * DM + n, v * w); } } };
template <int L>
__device__ __forceinline__ void p_moe_gu(Frame& F) {
    moe_tables(F, L);
    LAS int* tb = (LAS int*)(F.lds + MISC_OFF + 128); LAS int* cn = tb + 20;
    const unsigned* LIST = (const unsigned*)(F.wsp() + WS_LIST) + (size_t)L * NE * T;
    const int total = tb[NE] * 4 * 16;
    for (int it = F.gw; it < total; it += F.NGW) {
        const int ni = it & 15, mt = it >> 4; int e = 0; while (tb[e + 1] * 4 <= mt) ++e;
        const ARowMoe ar{(const bf16*)(F.wsp() + WS_U), LIST + (size_t)e * T, tb[e] * 256, cn[e]};
        const EpSiluPair ep{(bf16*)(F.wsp() + WS_H), FF};
        const int pn = ni >> 2, q = ni & 3;
        gemm_wave_tile<true>(ar, (const bf16*)(F.wsp() + WS_WGU) + (size_t)(L * NE + e) * 1024 * 1024 + (size_t)(pn * 256 + q * 32) * 1024, 1024, mt * 64, pn * 128 + q * 32, ep, F.lane);
    }
}
template <int L>
__device__ __forceinline__ void p_moe_down(Frame& F) {
    moe_tables(F, L);
    LAS int* tb = (LAS int*)(F.lds + MISC_OFF + 128); LAS int* cn = tb + 20;
    const unsigned* LIST = (const unsigned*)(F.wsp() + WS_LIST) + (size_t)L * NE * T; const float* LW = (const float*)(F.wsp() + WS_LW) + (size_t)L * NE * T;
    const int total = tb[NE] * 4 * 16;
    for (int it = F.gw; it < total; it += F.NGW) {
        const int ni = it & 15, mt = it >> 4; int e = 0; while (tb[e + 1] * 4 <= mt) ++e;
        const ARowPlain ar{(const bf16*)(F.wsp() + WS_H), FF};
        const EpY ep{(bf16*)(F.wsp() + WS_Y0), LIST + (size_t)e * T, LW + (size_t)e * T, tb[e] * 256, cn[e]};
        gemm_wave_tile<false>(ar, (const bf16*)(F.wsp() + WS_WDN) + (size_t)(L * NE + e) * 1024 * 512 + (size_t)(ni * 64) * 512, 512, mt * 64, ni * 64, ep, F.lane);
    }
}

struct ARowCmp { const bf16* KVi; __device__ __forceinline__ const bf16* operator()(int R) const { return KVi + ((size_t)(R >> 8) * KVROWS + (size_t)(R & 255) * 16) * 64; } };
__device__ __forceinline__ float gelu_tanh(float x) { const float u = 0.7978845608028654f * (x + 0.044715f * x * x * x); const float e = __expf(2.f * u); const float th = 1.f - 2.f / (e + 1.f); return 0.5f * x * (1.f + th); }
__device__ __forceinline__ void p_cmp_finish(Frame& F) {
    LAS float* w2s = (LAS float*)F.lds;
    LAS float* hd = (LAS float*)(F.lds + 65536 + F.wave * 4096);
    const float* TB = (const float*)(F.wsp() + WS_TB); const float* PETP = (const float*)(F.wsp() + WS_PETP);
    const int lane = F.lane;
    for (int base = blockIdx.x * 32; base < 2 * 16 * 256; base += gridDim.x * 32) {
        const int i = base >> 12;
        __syncthreads();
        for (int u = F.tid; u < 4096; u += 512) *(LAS f32x4*)(w2s + 4 * u) = *(const f32x4*)(F.inp(I_CW2) + (size_t)i * 256 * 64 + 4 * u);
        const int it0 = base + F.wave * 4, bh = (it0 >> 8) & 15, n0 = it0 & 255, c = 4 * lane;
        f32x4 pe = *(const f32x4*)(F.inp(I_CB1) + i * 256 + c);
#pragma unroll
        for (int k = 0; k < 32; ++k) pe += *(const f32x4*)(PETP + (k * 2 + i) * 256 + c);
#pragma unroll
        for (int r = 0; r < 4; ++r) { const int n = n0 + r;
            f32x4 h = (f32x4){0.f, 0.f, 0.f, 0.f};
            if (n < 255) { const float* r0 = TB + ((size_t)i * 4096 + bh * 256 + n) * 512; h = *(const f32x4*)(r0 + c) + *(const f32x4*)(r0 + 512 + 256 + c) + pe; }
#pragma unroll
            for (int q = 0; q < 4; ++q) hd[(c + q) * 4 + r] = gelu_tanh(h[q]); }
        __syncthreads();
        const float b2 = F.inp(I_CB2)[i * 64 + lane];
        float a0 = b2, a1 = b2, a2 = b2, a3 = b2;
#pragma unroll 8
        for (int cc = 0; cc < 256; ++cc) { const float w = w2s[cc * 64 + lane]; const f32x4 h4 = *(const LAS f32x4*)(hd + cc * 4);
            a0 += h4[0] * w; a1 += h4[1] * w; a2 += h4[2] * w; a3 += h4[3] * w; }
        const float av[4] = {a0, a1, a2, a3};
#pragma unroll
        for (int r = 0; r < 4; ++r) { const int n = n0 + r;
            bf16* dst = (bf16*)(F.wsp() + (i ? WS_VC : WS_KC)) + (size_t)bh * 256 * 64 + (size_t)(n >> 6) * 4096 + (i ? vfrag_off(n & 63, lane) : kfrag_off(n & 63, lane));
            *dst = (n == 255) ? (bf16)0 : (bf16)f2bf(av[r]); }
    }
}

__device__ __forceinline__ void score_tile(const bf16* krow, const LAS float* qs, float (&s)[4]) {
    s[0] = s[1] = s[2] = s[3] = 0.f;
#pragma unroll
    for (int c = 0; c < 8; ++c) { const u32x4 kv = *(const u32x4*)(krow + 8 * c);
#pragma unroll
        for (int w = 0; w < 4; ++w) { const f32x4 qa = *(const LAS f32x4*)(qs + (8 * c + 2 * w) * 4), qb = *(const LAS f32x4*)(qs + (8 * c + 2 * w + 1) * 4);
            const float ka = bflo(kv[w]), kb = bfhi(kv[w]);
            s[0] += ka * qa[0] + kb * qb[0]; s[1] += ka * qa[1] + kb * qb[1]; s[2] += ka * qa[2] + kb * qb[2]; s[3] += ka * qa[3] + kb * qb[3]; } }
}
__device__ __forceinline__ void attend_tile(const bf16* Kt, const bf16* Vt, bool valid, const LAS float* qs, LAS float* pbuf, float (&mr)[4], float (&l)[4], float (&o)[4], int lane) {
    float s[4]; score_tile(Kt + (size_t)lane * 64, qs, s);
    f32x4 p4;
#pragma unroll
    for (int g = 0; g < 4; ++g) {
        const float sg = valid ? s[g] : -INFINITY; const float tm = wave_max(sg); const float mn = fmaxf(mr[g], tm);
        const float mref = (mn == -INFINITY) ? 0.f : mn;
        const float alpha = __builtin_amdgcn_exp2f(mr[g] - mref); const float p = valid ? __builtin_amdgcn_exp2f(sg - mref) : 0.f;
        l[g] = l[g] * alpha + wave_sum(p); o[g] *= alpha; mr[g] = mn; p4[g] = p;
    }
    LDS_WAIT(); asm volatile("" ::: "memory");
    *(LAS f32x4*)(pbuf + lane * 4) = p4;
    LDS_WAIT(); asm volatile("" ::: "memory");
#pragma unroll 8
    for (int k = 0; k < 64; ++k) { const f32x4 pk = *(const LAS f32x4*)(pbuf + k * 4); const float vv = bf2f(Vt[(size_t)k * 64 + lane]);
        o[0] += pk[0] * vv; o[1] += pk[1] * vv; o[2] += pk[2] * vv; o[3] += pk[3] * vv; }
    LDS_WAIT(); asm volatile("" ::: "memory");
}
__device__ __forceinline__ void p_attn_simple(Frame& F) {
    LAS float* qs = (LAS float*)(F.lds + F.wave * 16384);
    LAS float* pbuf = qs + 256;
    LAS float* psum = pbuf + 1024;
    const bf16* Q = (const bf16*)(F.wsp() + WS_Q); const float* GATE = (const float*)(F.wsp() + WS_GATE); bf16* O = (bf16*)(F.wsp() + WS_O);
    const bf16* KVb = (const bf16*)(F.wsp() + WS_KV);
    const int lane = F.lane;
    for (int it = F.gw; it < 16 * SEQ; it += F.NGW) {
        const int bh = it & 15, t = it >> 4, b = bh >> 2, hk = bh & 3, m = b * SEQ + t;
        LDS_WAIT(); asm volatile("" ::: "memory");
        { f32x4 q4; for (int g = 0; g < 4; ++g) q4[g] = bf2f(Q[(size_t)m * DM + (hk * 4 + g) * 64 + lane]); *(LAS f32x4*)(qs + lane * 4) = q4; }
        LDS_WAIT(); asm volatile("" ::: "memory");
        const bf16* KC = (const bf16*)(F.wsp() + WS_KC) + (size_t)bh * 256 * 64; const bf16* VC = (const bf16*)(F.wsp() + WS_VC) + (size_t)bh * 256 * 64;
        const int nv = t >= 31 ? ((t - 31) >> 4) + 1 : 0;
        float sc[4][4];
#pragma unroll
        for (int i = 0; i < 4; ++i) { float s[4] = {0.f, 0.f, 0.f, 0.f}; if (64 * i < nv) score_tile(KC + (size_t)(64 * i + lane) * 64, qs, s);
            const bool v = (64 * i + lane) < nv;
#pragma unroll
            for (int g = 0; g < 4; ++g) sc[i][g] = v ? s[g] : -INFINITY; }
        float oc[4];
#pragma unroll
        for (int g = 0; g < 4; ++g) {
            const float mx = wave_max(fmaxf(fmaxf(sc[0][g], sc[1][g]), fmaxf(sc[2][g], sc[3][g]))); const float mref = (mx == -INFINITY) ? 0.f : mx;
            float e[4]; float ls = 0.f;
#pragma unroll
            for (int i = 0; i < 4; ++i) { e[i] = __builtin_amdgcn_exp2f(sc[i][g] - mref); ls += e[i]; }
            const float inv = 1.f / fmaxf(wave_sum(ls), 1e-30f);
#pragma unroll
            for (int i = 0; i < 4; ++i) sc[i][g] = e[i] * inv;
        }
#pragma unroll
        for (int i = 0; i < 4; ++i) { *(LAS f32x4*)(pbuf + (64 * i + lane) * 4) = (f32x4){sc[i][0], sc[i][1], sc[i][2], sc[i][3]};
            psum[64 * i + lane + 1] = (sc[i][0] + sc[i][1]) + (sc[i][2] + sc[i][3]); }
        if (lane == 0) psum[0] = 0.f;
        LDS_WAIT(); asm volatile("" ::: "memory");
        oc[0] = oc[1] = oc[2] = oc[3] = 0.f;
        for (int n = 0; n < nv; ++n) { const f32x4 pk = *(const LAS f32x4*)(pbuf + n * 4); const float vv = bf2f(VC[(size_t)n * 64 + lane]);
            oc[0] += pk[0] * vv; oc[1] += pk[1] * vv; oc[2] += pk[2] * vv; oc[3] += pk[3] * vv; }
        const float imp = 0.5f * psum[4 * lane] + psum[4 * lane + 1] + psum[4 * lane + 2] + psum[4 * lane + 3] + 0.5f * psum[4 * lane + 4];
        const int cur = t >> 6;
        const bool allowed = lane <= cur, forced = allowed && (lane == 0 || lane == cur || lane == cur - 1);
        const float score = forced ? 1e9f : (allowed ? imp : -1e30f);
        int rank = 0;
#pragma unroll
        for (int j = 0; j < 64; ++j) { const float sj = __shfl(score, j); rank += (sj > score || (sj == score && j < lane)) ? 1 : 0; }
        const unsigned long long mask = __ballot(rank < 16 && score > -0.5e30f);
        LDS_WAIT(); asm volatile("" ::: "memory");
        const bf16* KS = KVb + 2 * KVBUF_ELEMS + (size_t)bh * KVROWS * 64; const bf16* VS = KVb + 3 * KVBUF_ELEMS + (size_t)bh * KVROWS * 64;
        float ms[4] = {-INFINITY, -INFINITY, -INFINITY, -INFINITY}, ls[4] = {0.f, 0.f, 0.f, 0.f}, os[4] = {0.f, 0.f, 0.f, 0.f};
        for (unsigned long long mk = mask; mk; mk &= mk - 1) { const int j = __builtin_ctzll(mk);
            attend_tile(KS + (size_t)j * 64 * 64, VS + (size_t)j * 64 * 64, (64 * j + lane) <= t, qs, pbuf, ms, ls, os, lane); }
        const bf16* KW = KVb + 4 * KVBUF_ELEMS + (size_t)bh * KVROWS * 64; const bf16* VW = KVb + 5 * KVBUF_ELEMS + (size_t)bh * KVROWS * 64;
        float mw[4] = {-INFINITY, -INFINITY, -INFINITY, -INFINITY}, lw[4] = {0.f, 0.f, 0.f, 0.f}, ow[4] = {0.f, 0.f, 0.f, 0.f};
        const int lo = t - 511 > 0 ? t - 511 : 0;
        for (int j = lo >> 6; j <= (t >> 6); ++j) { const int pos = 64 * j + lane;
            attend_tile(KW + (size_t)j * 64 * 64, VW + (size_t)j * 64 * 64, pos >= lo && pos <= t, qs, pbuf, mw, lw, ow, lane); }
#pragma unroll
        for (int g = 0; g < 4; ++g) { const float* gp = GATE + (size_t)m * 48 + (hk * 4 + g) * 3;
            const float o = gp[0] * oc[g] + gp[1] * os[g] / fmaxf(ls[g], 1e-30f) + gp[2] * ow[g] / fmaxf(lw[g], 1e-30f);
            O[(size_t)m * DM + (hk * 4 + g) * 64 + lane] = (bf16)f2bf(o); }
    }
}

struct SchedCmp { const char* KV; const char* W1C; int G, c;
    __device__ __forceinline__ bool next(int it, pg8::Unit& u) const { const int L = it * G + c; if (c < 0 || L >= 64) return false;
        const int i = L >> 5, pm = (L >> 1) & 15, pn = L & 1;
        u.A = KV + ((size_t)i * KVBUF_ELEMS + (size_t)pm * KVROWS * 64) * 2; u.B = W1C + ((size_t)i * 512 * 1024 + (size_t)pn * 256 * 1024) * 2;
        u.row0 = i * 4096 + pm * 256; u.col0 = pn * 256; u.e = i; u.pos0 = 0; u.cnt = 0; return true; }
    __device__ __forceinline__ void voff(const pg8::Unit&, const int (&R)[2], const int (&C)[2], int K_, unsigned (&v)[2][2]) const { pg8::voff_plain(R, C, K_, v); }
};
struct SchedKVQG { const char* A0; const char* B0; const char* A1; const char* B1; int G, c, Lbase, Lend;
    __device__ __forceinline__ bool next(int it, pg8::Unit& u) const { const int L = Lbase + it * G + c; if (c < 0 || L >= Lend) return false;
        const int sec = L >= 384 ? 1 : 0, l = sec ? L - 384 : L, nn = sec ? 5 : 6, pm = l / nn, pn = l % nn;
        u.A = (sec ? A1 : A0) + (size_t)pm * 256 * DM * 2; u.B = (sec ? B1 : B0) + (size_t)pn * 256 * DM * 2;
        u.row0 = pm * 256; u.col0 = pn * 256; u.e = sec; u.pos0 = 0; u.cnt = 0; return true; }
    __device__ __forceinline__ void voff(const pg8::Unit&, const int (&R)[2], const int (&C)[2], int K_, unsigned (&v)[2][2]) const { pg8::voff_plain(R, C, K_, v); }
};
struct SchedMoe { LAS int* tb; LAS int* cn; const unsigned* LIST; const char* Abase; const char* Bbase; size_t bstride; int K, nN, colmul, G, c; bool gather; int Lbase, Lend;
    __device__ __forceinline__ bool next(int it, pg8::Unit& u) const { const int L = Lbase + it * G + c; if (c < 0 || L >= Lend) return false;
        const int mt = L / nN, pn = L % nN; int e = 0; while (tb[e + 1] <= mt) ++e;
        u.A = gather ? Abase : Abase + (size_t)mt * 256 * K * 2; u.B = Bbase + (size_t)e * bstride + (size_t)pn * 256 * K * 2;
        u.row0 = mt * 256; u.col0 = pn * colmul; u.e = e; u.pos0 = (mt - tb[e]) * 256; u.cnt = cn[e]; return true; }
    __device__ __forceinline__ void voff(const pg8::Unit& u, const int (&R)[2], const int (&C)[2], int K_, unsigned (&v)[2][2]) const {
        if (!gather) { pg8::voff_plain(R, C, K_, v); return; }
        const unsigned* le = LIST + (size_t)u.e * T;
#pragma unroll
        for (int h = 0; h < 2; ++h)
#pragma unroll
            for (int i = 0; i < 2; ++i) { const int pos = u.pos0 + h * 128 + R[i]; const unsigned tok = pos < u.cnt ? (le[pos] >> 1) : 0u; v[h][i] = (tok * (unsigned)K_ + (unsigned)C[i]) * 2u; }
    }
};
struct EpHU { bf16* H; __device__ __forceinline__ void pair(const pg8::Unit&, int r, int ch, f32x4 a, f32x4 b) const {
    f32x4 s; for (int q = 0; q < 4; ++q) s[q] = silu_f(a[q]) * b[q]; st_bf4(H + (size_t)r * FF + ch, s); }
    __device__ __forceinline__ void pair8(const pg8::Unit&, int r, int ch, f32x4 a0, f32x4 a1, f32x4 b0, f32x4 b1) const {
    f32x4 s0, s1; for (int q = 0; q < 4; ++q) { s0[q] = silu_f(a0[q]) * b0[q]; s1[q] = silu_f(a1[q]) * b1[q]; } st_bf8(H + (size_t)r * FF + ch, s0, s1); } };
struct EpYU { bf16* Y; const unsigned* LIST; const float* LW;
    __device__ __forceinline__ void operator()(const pg8::Unit& u, int r, int n, f32x4 v) const { const int pos = u.pos0 + (r - u.row0);
        if (pos < u.cnt) { const unsigned ts = LIST[(size_t)u.e * T + pos]; const float w = LW[(size_t)u.e * T + pos];
            st_bf4(Y + (size_t)(ts & 1u) * ((size_t)T * DM) + (size_t)(ts >> 1) * DM + n, v * w); } }
    __device__ __forceinline__ void op8(const pg8::Unit& u, int r, int n, f32x4 a, f32x4 b) const { const int pos = u.pos0 + (r - u.row0);
        if (pos < u.cnt) { const unsigned ts = LIST[(size_t)u.e * T + pos]; const float w = LW[(size_t)u.e * T + pos];
            st_bf8(Y + (size_t)(ts & 1u) * ((size_t)T * DM) + (size_t)(ts >> 1) * DM + n, a * w, b * w); } } };
struct EpYUAll { static constexpr bool PERM = true; EpYU ep;
    __device__ __forceinline__ void operator()(const f32x4 (&acc)[2][2][4][2], const pg8::Unit& u, int wr, int wc, int fr, int fq) const {
        unsigned ts[2][4]; float w[2][4];
        const unsigned* le = ep.LIST + (size_t)u.e * T; const float* lw = ep.LW + (size_t)u.e * T;
#pragma unroll
        for (int ai = 0; ai < 2; ++ai)
#pragma unroll
            for (int m = 0; m < 4; ++m) { const int pos = u.pos0 + ai * pg8::HALF + wr * 64 + m * 16 + fr; const int pc = pos < u.cnt ? pos : u.cnt - 1;
                const unsigned t_ = le[pc]; ts[ai][m] = pos < u.cnt ? t_ : 0xFFFFFFFFu; w[ai][m] = lw[pc]; }
#pragma unroll
        for (int ai = 0; ai < 2; ++ai)
#pragma unroll
            for (int m = 0; m < 4; ++m) if (ts[ai][m] != 0xFFFFFFFFu) {
                bf16* yr = ep.Y + (size_t)(ts[ai][m] & 1u) * ((size_t)T * DM) + (size_t)(ts[ai][m] >> 1) * DM + u.col0 + wc * 32 + 8 * fq;
#pragma unroll
                for (int bj = 0; bj < 2; ++bj) st_bf8(yr + bj * pg8::HALF, acc[ai][bj][m][0] * w[ai][m], acc[ai][bj][m][1] * w[ai][m]); }
    } };
template <int L>
__device__ __forceinline__ void p_moe(Frame& F, const XcdBarrier& bar, bool with_barriers) {
    moe_tables(F, L);
    LAS int* tb = (LAS int*)(F.lds + MISC_OFF + 128); LAS int* cn = tb + 20;
    const int G = gridDim.x, bx = blockIdx.x, vcu = (G % 8 == 0) ? (bx % 8) * (G / 8) + bx / 8 : bx;
    const int nt = tb[NE], n128 = nt < 128 ? nt : 128, Wg = 4 * (nt - n128) < G / 2 ? 4 * (nt - n128) : G / 2;
    const int D2 = (4 * n128 < 2 * (G - Wg)) ? 4 * n128 : 2 * (G - Wg);
#pragma unroll 1
    for (int part = 1; part <= 3; ++part) {
        int gc = -1, gG = 1, gb = 0, ge = 0, dc = -1, dG = 1, db = 0, de = 0;
        if (part == 1) { gc = vcu; gG = G; gb = 0; ge = 4 * n128; }
        else if (part == 2) { if (vcu < Wg) { gc = vcu; gG = Wg; gb = 4 * n128; ge = 4 * nt; } else { dc = vcu - Wg; dG = G - Wg; db = 0; de = D2; } }
        else { dc = vcu; dG = G; db = D2; de = 4 * nt; }
        {
            const SchedMoe S{tb, cn, (const unsigned*)(F.wsp() + WS_LIST) + (size_t)L * NE * T, (const char*)(F.wsp() + WS_U), (const char*)(F.wsp() + WS_WGU) + (size_t)L * NE * 1024 * 1024 * 2, (size_t)1024 * 1024 * 2, 1024, 4, 128, gG, gc, true, gb, ge};
            typedef pg8::EpiWrap<EpHU, true, true> E_;
            pg8::gemm_phase<E_, SchedMoe, true, true>(F.lds, 1024, S, E_{{(bf16*)(F.wsp() + WS_H)}});
        }
        {
            const SchedMoe S{tb, cn, nullptr, (const char*)(F.wsp() + WS_H), (const char*)(F.wsp() + WS_WDN) + (size_t)L * NE * 1024 * 512 * 2, (size_t)1024 * 512 * 2, 512, 4, 256, dG, dc, false, db, de};
            typedef EpYUAll E_;
            pg8::gemm_phase<E_, SchedMoe, true, false>(F.lds, 512, S, E_{{(bf16*)(F.wsp() + WS_Y0), (const unsigned*)(F.wsp() + WS_LIST) + (size_t)L * NE * T, (const float*)(F.wsp() + WS_LW) + (size_t)L * NE * T}});
        }
        if (part < 3 && with_barriers) xcd_barrier(bar);
    }
}
typedef float f32x16 __attribute__((ext_vector_type(16)));
#define MFMA32(a, b, c) __builtin_amdgcn_mfma_f32_32x32x16_bf16(a, b, c, 0, 0, 0)
constexpr size_t WS_MASK = WS_GATE + 3 * MiB;
constexpr int STG_STRIDE = 68, STG_BYTES = 32 * STG_STRIDE * 4;
__device__ __forceinline__ int crow(int r, int hi) { return (r & 3) + 8 * (r >> 2) + 4 * hi; }
__device__ __forceinline__ unsigned cvtpk(float lo, float hi) { f32x2v v = {lo, hi}; bf16x2_t b = __builtin_convertvector(v, bf16x2_t); return __builtin_bit_cast(unsigned, b); }
__device__ __forceinline__ float partner32(float x, int hi) { auto rr = __builtin_amdgcn_permlane32_swap(__builtin_bit_cast(unsigned, x), __builtin_bit_cast(unsigned, x), false, false);
    return __builtin_bit_cast(float, hi ? rr[0] : rr[1]); }
__device__ __forceinline__ float max3f(float a, float b, float c) { float r; asm("v_max3_f32 %0, %1, %2, %3" : "=v"(r) : "v"(a), "v"(b), "v"(c)); return r; }
__device__ __forceinline__ float max2f(float a, float b) { float r; asm("v_max_f32_e32 %0, %1, %2" : "=v"(r) : "v"(a), "v"(b)); return r; }
__device__ __forceinline__ float rowmax32(f32x16& p0, f32x16& p1, int hi) {
    asm volatile("s_nop 15\n\ts_nop 7" : "+v"(p0), "+v"(p1));
    float a = max3f(p0[0], p0[1], p1[0]), b = max3f(p0[2], p0[3], p1[1]); a = max3f(a, p1[2], p1[3]);
#pragma unroll
    for (int r = 4; r < 16; r += 4) { a = max3f(a, p0[r], p0[r + 1]); b = max3f(b, p0[r + 2], p0[r + 3]); a = max3f(a, p1[r], p1[r + 1]); b = max3f(b, p1[r + 2], p1[r + 3]); }
    const float m = max2f(a, b);
    return max2f(m, partner32(m, hi));
}
typedef __amdgpu_buffer_rsrc_t rsrc_t;
__device__ __forceinline__ rsrc_t make_rsrc(const void* base, unsigned bytes) { return __builtin_amdgcn_make_buffer_rsrc((void*)base, 0, (int)bytes, 0x00020000); }
__device__ __forceinline__ void load_frag8(bf16x8 (&f)[8], rsrc_t rs, unsigned vo, unsigned so) {
#pragma unroll
    for (int i = 0; i < 8; ++i) f[i] = __builtin_bit_cast(bf16x8, __builtin_amdgcn_raw_buffer_load_b128(rs, vo + i * 1024, so, 0));
}
__device__ __forceinline__ void qk_tile(f32x16& p0, f32x16& p1, const bf16x8 (&kf)[8], const LAS bf16x8* qs, const float cinit) {
    bf16x8 qr[4];
#pragma unroll
    for (int d0 = 0; d0 < 4; ++d0) qr[d0] = qs[d0 * 64];
    f32x16 c;
#pragma unroll
    for (int r = 0; r < 16; ++r) c[r] = cinit;
    p0 = MFMA32(kf[0], qr[0], c); p1 = MFMA32(kf[4], qr[0], c);
#pragma unroll
    for (int d0 = 1; d0 < 4; ++d0) { p0 = MFMA32(kf[d0], qr[d0], p0); p1 = MFMA32(kf[4 + d0], qr[d0], p1); }
}
__device__ __forceinline__ void qk_tile_lo(f32x16& p0, f32x16& p1, rsrc_t rs, unsigned vo, unsigned so, const LAS bf16x8* qs, const float cinit) {
    bf16x8 qr[4];
#pragma unroll
    for (int d0 = 0; d0 < 4; ++d0) qr[d0] = qs[d0 * 64];
#pragma unroll
    for (int r = 0; r < 16; ++r) { p0[r] = cinit; p1[r] = cinit; }
    { bf16x8 kf[4];
#pragma unroll
      for (int d0 = 0; d0 < 4; ++d0) kf[d0] = __builtin_bit_cast(bf16x8, __builtin_amdgcn_raw_buffer_load_b128(rs, vo + d0 * 1024, so, 0));
#pragma unroll
      for (int d0 = 0; d0 < 4; ++d0) p0 = MFMA32(kf[d0], qr[d0], p0); }
    asm volatile("" : "+v"(p0) :: "memory");
    { bf16x8 kf[4];
#pragma unroll
      for (int d0 = 0; d0 < 4; ++d0) kf[d0] = __builtin_bit_cast(bf16x8, __builtin_amdgcn_raw_buffer_load_b128(rs, vo + (4 + d0) * 1024, so, 0));
#pragma unroll
      for (int d0 = 0; d0 < 4; ++d0) p1 = MFMA32(kf[d0], qr[d0], p1); }
}
__device__ __forceinline__ void mask_tile(f32x16& p0, f32x16& p1, int lo, int lim, int hi) {
#pragma unroll
    for (int r = 0; r < 16; ++r) { const int k0 = crow(r, hi);
        if (!(k0 > lo && k0 <= lim)) p0[r] = -INFINITY;
        if (!(k0 + 32 > lo && k0 + 32 <= lim)) p1[r] = -INFINITY; }
}
__device__ __forceinline__ void pack_p(bf16x8 (&pa)[4], const f32x16& p0, const f32x16& p1) {
    u32x4 w0, w1, w2, w3;
#pragma unroll
    for (int q = 0; q < 4; ++q) { w0[q] = cvtpk(p0[2 * q], p0[2 * q + 1]); w1[q] = cvtpk(p0[8 + 2 * q], p0[9 + 2 * q]);
                                  w2[q] = cvtpk(p1[2 * q], p1[2 * q + 1]); w3[q] = cvtpk(p1[8 + 2 * q], p1[9 + 2 * q]); }
    pa[0] = __builtin_bit_cast(bf16x8, w0); pa[1] = __builtin_bit_cast(bf16x8, w1); pa[2] = __builtin_bit_cast(bf16x8, w2); pa[3] = __builtin_bit_cast(bf16x8, w3);
}
__device__ __forceinline__ void pv_tile(f32x16& o0, f32x16& o1, const bf16x8 (&pa)[4], const bf16x8 (&vf)[8]) {
#pragma unroll
    for (int ks = 0; ks < 4; ++ks) { o0 = MFMA32(pa[ks], vf[ks], o0); o1 = MFMA32(pa[ks], vf[4 + ks], o1); }
}
struct Sm { float mhat, l; f32x16 o0, o1, ol; };
__device__ __forceinline__ void sm_init(Sm& st) { st.mhat = 0.f; st.l = 0.f;
#pragma unroll
    for (int r = 0; r < 16; ++r) { st.o0[r] = 0.f; st.o1[r] = 0.f; st.ol[r] = 0.f; } }
__device__ __forceinline__ void sm_tile(Sm& st, f32x16& s0, f32x16& s1, bool first, const bf16x8 (&vf)[8], LAS float* wsf, int r32, int hi) {
    const float rm = rowmax32(s0, s1, hi);
    const bool need = first || (__any(rm > 8.0f) != 0);
    if (need) {
        const float dl = first ? ((rm == -INFINITY) ? 0.f : rm) : fmaxf(rm, 0.f);
        st.mhat += dl;
#pragma unroll
        for (int r = 0; r < 16; ++r) { s0[r] -= dl; s1[r] -= dl; }
        if (!first) {
            const float f = __builtin_amdgcn_exp2f(-dl);
            LDS_WAIT(); asm volatile("" ::: "memory");
            if (hi == 0) wsf[r32] = f;
            LDS_WAIT(); asm volatile("" ::: "memory");
#pragma unroll
            for (int G = 0; G < 4; ++G) { const f32x4 ff = *(const LAS f32x4*)(wsf + 8 * G + 4 * hi);
#pragma unroll
                for (int q = 0; q < 4; ++q) { st.o0[4 * G + q] *= ff[q]; st.o1[4 * G + q] *= ff[q]; st.ol[4 * G + q] *= ff[q]; } }
            LDS_WAIT(); asm volatile("" ::: "memory");
        }
    }
#pragma unroll
    for (int r = 0; r < 16; ++r) { s0[r] = __builtin_amdgcn_exp2f(s0[r]); s1[r] = __builtin_amdgcn_exp2f(s1[r]); }
    bf16x8 pa[4]; pack_p(pa, s0, s1);
    const bf16x8 ones = (bf16x8){0x3F80, 0x3F80, 0x3F80, 0x3F80, 0x3F80, 0x3F80, 0x3F80, 0x3F80};
#pragma unroll
    for (int ks = 0; ks < 4; ++ks) { st.o0 = MFMA32(pa[ks], vf[ks], st.o0); st.o1 = MFMA32(pa[ks], vf[4 + ks], st.o1); st.ol = MFMA32(pa[ks], ones, st.ol); }
}
template <bool NORM>
__device__ __forceinline__ void flush_branch(const f32x16& o0, const f32x16& o1, const f32x16& ol, const float* GATE, bf16* O, int m0, int hq, int br, bool accumulate,
                                             LAS float* stg, int lane) {
    asm volatile("" : "+v"(lane));
    const int r32 = lane & 31, hi = lane >> 5;
    LDS_WAIT(); asm volatile("" ::: "memory");
#pragma unroll
    for (int r = 0; r < 16; ++r) { const float iv = NORM ? __builtin_amdgcn_rcpf(fmaxf(ol[r], 1e-30f)) : 1.f;
        stg[crow(r, hi) * STG_STRIDE + r32] = o0[r] * iv; stg[crow(r, hi) * STG_STRIDE + 32 + r32] = o1[r] * iv; }
    LDS_WAIT(); asm volatile("" ::: "memory");
#pragma unroll
    for (int i = 0; i < 4; ++i) { const int row = i * 8 + (lane >> 3), ch = lane & 7;
        const f32x4 a = *(const LAS f32x4*)(stg + row * STG_STRIDE + ch * 8), b = *(const LAS f32x4*)(stg + row * STG_STRIDE + ch * 8 + 4);
        const float sc = GATE[(size_t)(m0 + row) * 48 + hq * 3 + br];
        bf16* op = O + (size_t)(m0 + row) * DM + hq * 64 + ch * 8;
        f32x4 x = a * sc, y = b * sc;
        if (accumulate) { const u32x4 old = *(const u32x4*)op; x += (f32x4){bflo(old.x), bfhi(old.x), bflo(old.y), bfhi(old.y)}; y += (f32x4){bflo(old.z), bfhi(old.z), bflo(old.w), bfhi(old.w)}; }
        u32x4 w; w.x = pk2(x[0], x[1]); w.y = pk2(x[2], x[3]); w.z = pk2(y[0], y[1]); w.w = pk2(y[2], y[3]);
        *(u32x4*)op = w; }
    LDS_WAIT(); asm volatile("" ::: "memory");
}
__device__ __forceinline__ void load_q(LAS bf16x8* qs, const bf16* Q, int m, int hq, int hi) {
    LDS_WAIT(); asm volatile("" ::: "memory");
#pragma unroll
    for (int d0 = 0; d0 < 4; ++d0) qs[d0 * 64] = *(const bf16x8*)(Q + (size_t)m * DM + hq * 64 + d0 * 16 + hi * 8);
    LDS_WAIT(); asm volatile("" ::: "memory");
}
__device__ __forceinline__ void p_attn_cmp(Frame& F) {
    LAS float* stg = (LAS float*)(F.lds + F.wave * 16384); LAS float* wsf = stg + 32 * STG_STRIDE;
    const bf16* Q = (const bf16*)(F.wsp() + WS_Q); const float* GATE = (const float*)(F.wsp() + WS_GATE); bf16* O = (bf16*)(F.wsp() + WS_O);
    unsigned long long* MASK = (unsigned long long*)(F.wsp() + WS_MASK);
    for (int it = F.gw; it < 16 * 128; it += F.NGW) {
        const int bh = it >> 7, blk = 127 - (it & 127), b = bh >> 2, hk = bh & 3, m0 = b * SEQ + blk * 32;
        const rsrc_t rs = make_rsrc(F.wsp() + WS_KC, 1u << 20);
        const unsigned soK = (unsigned)bh * 32768u, soV = 524288u + (unsigned)bh * 32768u;
        const int nvmax = ((blk * 32) >> 4) + 1, ntc = (nvmax + 63) >> 6;
        float mref0 = 0.f, mref1 = 0.f, mref2 = 0.f, mref3 = 0.f, inv0 = 0.f, inv1 = 0.f, inv2 = 0.f, inv3 = 0.f;
#pragma unroll 1
        for (int g = 0; g < 4; ++g) {
            int lane = F.lane; asm volatile("" : "+v"(lane));
            const int r32 = lane & 31, hi = lane >> 5, t = blk * 32 + r32, nvr = t >= 31 ? ((t - 31) >> 4) + 1 : 0;
            LAS bf16x8* qr = (LAS bf16x8*)(wsf + 64) + lane; load_q(qr, Q, m0 + r32, hk * 4 + g, hi);
            float mrun = -INFINITY, l = 0.f;
#pragma unroll 1
            for (int i = 0; i < ntc; ++i) {
                f32x16 s0, s1; qk_tile_lo(s0, s1, rs, (unsigned)lane * 16u, soK + (unsigned)i * 8192u, qr, 0.f); mask_tile(s0, s1, -1, nvr - 1 - 64 * i, hi);
                const float rm = rowmax32(s0, s1, hi), mn = fmaxf(mrun, rm), mr = (mn == -INFINITY) ? 0.f : mn;
                float sum = 0.f;
#pragma unroll
                for (int r = 0; r < 16; ++r) sum += __builtin_amdgcn_exp2f(s0[r] - mr) + __builtin_amdgcn_exp2f(s1[r] - mr);
                l = l * __builtin_amdgcn_exp2f(mrun - mr) + sum; mrun = mn;
            }
            const float ltot = l + partner32(l, hi);
            const float iv = 1.f / fmaxf(ltot, 1e-30f), mr_ = (mrun == -INFINITY) ? 0.f : mrun;
            if (g == 0) { inv0 = iv; mref0 = mr_; } else if (g == 1) { inv1 = iv; mref1 = mr_; } else if (g == 2) { inv2 = iv; mref2 = mr_; } else { inv3 = iv; mref3 = mr_; }
        }
        {
            float imp[32];
#pragma unroll
            for (int k = 0; k < 32; ++k) imp[k] = 0.f;
#pragma unroll 1
            for (int g = 0; g < 4; ++g) {
                int lane = F.lane; asm volatile("" : "+v"(lane));
                const int r32 = lane & 31, hi = lane >> 5, t = blk * 32 + r32, nvr = t >= 31 ? ((t - 31) >> 4) + 1 : 0;
                LAS bf16x8* qr = (LAS bf16x8*)(wsf + 64) + lane; load_q(qr, Q, m0 + r32, hk * 4 + g, hi);
                const float invg = g == 0 ? inv0 : g == 1 ? inv1 : g == 2 ? inv2 : inv3, mg = g == 0 ? mref0 : g == 1 ? mref1 : g == 2 ? mref2 : mref3;
#pragma unroll
                for (int i = 0; i < 4; ++i) if (i < ntc) {
                    asm volatile("" ::: "memory");
                    f32x16 s0, s1; qk_tile_lo(s0, s1, rs, (unsigned)lane * 16u, soK + (unsigned)i * 8192u, qr, -mg); mask_tile(s0, s1, -1, nvr - 1 - 64 * i, hi);
#pragma unroll
                    for (int r = 0; r < 16; ++r) { s0[r] = __builtin_amdgcn_exp2f(s0[r]) * invg; s1[r] = __builtin_amdgcn_exp2f(s1[r]) * invg; }
#pragma unroll
                    for (int G = 0; G < 4; ++G) {
                        { const int kq = 8 * i + G; const float e = s0[4 * G + 3], pe = partner32(e, hi);
                          imp[kq] += (s0[4 * G] + s0[4 * G + 1]) + s0[4 * G + 2] + 0.5f * e + (hi ? 0.5f * pe : 0.f);
                          if (kq + 1 < 32) imp[kq + 1] += hi ? 0.f : 0.5f * pe; }
                        { const int kq = 8 * i + 4 + G; const float e = s1[4 * G + 3], pe = partner32(e, hi);
                          imp[kq] += (s1[4 * G] + s1[4 * G + 1]) + s1[4 * G + 2] + 0.5f * e + (hi ? 0.5f * pe : 0.f);
                          if (kq + 1 < 32) imp[kq + 1] += hi ? 0.f : 0.5f * pe; }
                    }
                }
            }
            int lane = F.lane; asm volatile("" : "+v"(lane));
            const int r32 = lane & 31, hi = lane >> 5, cur = (blk * 32 + r32) >> 6;
            LDS_WAIT(); asm volatile("" ::: "memory");
#pragma unroll
            for (int k = 0; k < 32; ++k) { const int j = 2 * k + hi; const bool allowed = j <= cur, forced = allowed && (j == 0 || j == cur || j == cur - 1);
                stg[r32 * STG_STRIDE + j] = forced ? 1e9f : (allowed ? imp[k] : -1e30f); }
            LDS_WAIT(); asm volatile("" ::: "memory");
        }
        {
            int lane = F.lane; asm volatile("" : "+v"(lane));
            unsigned long long mymask = 0ull;
#pragma unroll 1
            for (int tok = 0; tok < 32; ++tok) {
                const float sc = stg[tok * STG_STRIDE + lane]; int rank = 0;
#pragma unroll
                for (int q = 0; q < 16; ++q) { const f32x4 v = *(const LAS f32x4*)(stg + tok * STG_STRIDE + 4 * q);
#pragma unroll
                    for (int e = 0; e < 4; ++e) rank += (v[e] > sc || (v[e] == sc && (4 * q + e) < lane)) ? 1 : 0; }
                const unsigned long long mk = __ballot(rank < 16 && sc > -0.5e30f);
                mymask = (lane == tok) ? mk : mymask;
            }
            if (lane < 32) MASK[(size_t)bh * SEQ + blk * 32 + lane] = mymask;
            LDS_WAIT(); asm volatile("" ::: "memory");
        }
#pragma unroll 1
        for (int g = 0; g < 4; ++g) {
            int lane = F.lane; asm volatile("" : "+v"(lane));
            const int r32 = lane & 31, hi = lane >> 5, t = blk * 32 + r32, nvr = t >= 31 ? ((t - 31) >> 4) + 1 : 0;
            LAS bf16x8* qr = (LAS bf16x8*)(wsf + 64) + lane; load_q(qr, Q, m0 + r32, hk * 4 + g, hi);
            const float invg = g == 0 ? inv0 : g == 1 ? inv1 : g == 2 ? inv2 : inv3, mg = g == 0 ? mref0 : g == 1 ? mref1 : g == 2 ? mref2 : mref3;
            f32x16 o0, o1;
#pragma unroll
            for (int r = 0; r < 16; ++r) { o0[r] = 0.f; o1[r] = 0.f; }
#pragma unroll 1
            for (int i = 0; i < ntc; ++i) {
                f32x16 s0, s1; qk_tile_lo(s0, s1, rs, (unsigned)lane * 16u, soK + (unsigned)i * 8192u, qr, -mg); mask_tile(s0, s1, -1, nvr - 1 - 64 * i, hi);
#pragma unroll
                for (int r = 0; r < 16; ++r) { s0[r] = __builtin_amdgcn_exp2f(s0[r]) * invg; s1[r] = __builtin_amdgcn_exp2f(s1[r]) * invg; }
                bf16x8 pa[4]; pack_p(pa, s0, s1);
                bf16x8 vf[8]; load_frag8(vf, rs, (unsigned)lane * 16u, soV + (unsigned)i * 8192u); pv_tile(o0, o1, pa, vf);
            }
            flush_branch<false>(o0, o1, o0, GATE, O, m0, hk * 4 + g, 0, false, stg, lane);
        }
    }
}
__device__ __forceinline__ void attn_main_item(Frame& F, int bh, int g, int blk, LAS float* stg, LAS float* wsf) {
    const bf16* Q = (const bf16*)(F.wsp() + WS_Q); const float* GATE = (const float*)(F.wsp() + WS_GATE); bf16* O = (bf16*)(F.wsp() + WS_O);
    const rsrc_t rs = make_rsrc(F.wsp() + WS_KV, (unsigned)(6 * KVBUF_ELEMS * 2));
    int lane = F.lane; asm volatile("" : "+v"(lane));
    const int r32 = lane & 31, hi = lane >> 5;
    const unsigned vo = (unsigned)lane * 16u;
    const int b = bh >> 2, hk = bh & 3, hq = hk * 4 + g, m0 = b * SEQ + blk * 32, c = blk >> 1, ql = (blk & 1) * 32 + r32;
    LAS bf16x8* qr = (LAS bf16x8*)(wsf + 64) + lane; load_q(qr, Q, m0 + r32, hq, hi);
    const unsigned long long mask = ((const unsigned long long*)(F.wsp() + WS_MASK))[(size_t)bh * SEQ + blk * 32 + r32];
    bf16x8 kf[8], vf[8];
    {
        const unsigned soK = (unsigned)((2 * KVBUF_ELEMS + (size_t)bh * KVROWS * 64) * 2), soV = (unsigned)((3 * KVBUF_ELEMS + (size_t)bh * KVROWS * 64) * 2);
        Sm st; sm_init(st);
        load_frag8(kf, rs, vo, soK);
#pragma unroll 1
        for (int j = 0; j <= c; ++j) {
            const bool sel = ((mask >> j) & 1ull) != 0ull;
            f32x16 s0, s1; qk_tile(s0, s1, kf, qr, sel ? -st.mhat : -INFINITY);
            asm volatile("" : "+v"(s0), "+v"(s1) :: "memory");
            load_frag8(vf, rs, vo, soV + (unsigned)j * 8192u);
            load_frag8(kf, rs, vo, soK + (unsigned)(j < c ? j + 1 : c) * 8192u);
            if (j == c) mask_tile(s0, s1, -1, ql, hi);
            sm_tile(st, s0, s1, j == 0, vf, wsf, r32, hi);
            asm volatile("" : "+v"(st.o0), "+v"(st.o1), "+v"(st.ol) :: "memory");
        }
        flush_branch<true>(st.o0, st.o1, st.ol, GATE, O, m0, hq, 1, true, stg, lane);
    }
    {
        const unsigned soK = (unsigned)((4 * KVBUF_ELEMS + (size_t)bh * KVROWS * 64) * 2), soV = (unsigned)((5 * KVBUF_ELEMS + (size_t)bh * KVROWS * 64) * 2);
        Sm st; sm_init(st);
        const int j0 = c >= 8 ? c - 8 : 0;
        load_frag8(kf, rs, vo, soK + (unsigned)j0 * 8192u);
#pragma unroll 1
        for (int j = j0; j <= c; ++j) {
            f32x16 s0, s1; qk_tile(s0, s1, kf, qr, -st.mhat);
            asm volatile("" : "+v"(s0), "+v"(s1) :: "memory");
            load_frag8(vf, rs, vo, soV + (unsigned)j * 8192u);
            load_frag8(kf, rs, vo, soK + (unsigned)(j < c ? j + 1 : c) * 8192u);
            if (j == c || j + 8 == c) mask_tile(s0, s1, (j + 8 == c) ? ql : -1, (j == c) ? ql : 63, hi);
            sm_tile(st, s0, s1, j == j0, vf, wsf, r32, hi);
            asm volatile("" : "+v"(st.o0), "+v"(st.o1), "+v"(st.ol) :: "memory");
        }
        flush_branch<true>(st.o0, st.o1, st.ol, GATE, O, m0, hq, 2, true, stg, lane);
    }
}
__device__ __forceinline__ void p_attn_main(Frame& F) {
    LAS float* stg = (LAS float*)(F.lds + F.wave * 16384); LAS float* wsf = stg + 32 * STG_STRIDE;
    for (int P = F.gw; P < 4096; P += F.NGW) {
        const int bh = P >> 8, rem = P & 255, g = rem & 3, k = rem >> 2;
        attn_main_item(F, bh, g, 127 - k, stg, wsf);
        attn_main_item(F, bh, g, k, stg, wsf);
    }
}
constexpr int AT_SLOT = 16384, AT_NSLOT = 4, AT_PW_OFF = AT_NSLOT * AT_SLOT, AT_PW_BYTES = STG_BYTES + 256 + 384, AT_MASK_OFF = AT_PW_OFF + 8 * AT_PW_BYTES;
static_assert(AT_MASK_OFF + 512 <= LDSCTL_OFF, "attention LDS map");
#define AT_WAIT_BAR(N) asm volatile("s_waitcnt vmcnt(" #N ") lgkmcnt(0)\n\ts_barrier" ::: "memory")
__device__ __forceinline__ void at_dma(const char* g, LAS unsigned char* l) { __builtin_amdgcn_global_load_lds((const unsigned*)g, (LAS unsigned*)l, 16, 0, 0); }
__device__ __forceinline__ void qk_tile_reg(f32x16& p0, f32x16& p1, const LAS unsigned char* ks, const bf16x8 (&qr)[4], const float cinit) {
    bf16x8 kf[8];
#pragma unroll
    for (int f = 0; f < 8; ++f) kf[f] = *(const LAS bf16x8*)(ks + f * 1024);
    __builtin_amdgcn_sched_barrier(0);
    f32x16 c;
#pragma unroll
    for (int r = 0; r < 16; ++r) c[r] = cinit;
    p0 = MFMA32(kf[0], qr[0], c); p1 = MFMA32(kf[4], qr[0], c);
#pragma unroll
    for (int d0 = 1; d0 < 4; ++d0) { p0 = MFMA32(kf[d0], qr[d0], p0); p1 = MFMA32(kf[4 + d0], qr[d0], p1); }
}
template <int V>
__device__ __forceinline__ void sm_tile_lds(Sm& st, f32x16& s0, f32x16& s1, bool first, const LAS unsigned char* vs, LAS float* wsf, int r32, int hi) {
    const float rm = rowmax32(s0, s1, hi);
    const bool need = first || (__any(rm > 8.0f) != 0);
    if (need) {
        const float dl = first ? ((rm == -INFINITY) ? 0.f : rm) : fmaxf(rm, 0.f);
        st.mhat += dl;
#pragma unroll
        for (int r = 0; r < 16; ++r) { s0[r] -= dl; s1[r] -= dl; }
        if (!first) {
            const float f = __builtin_amdgcn_exp2f(-dl);
            LDS_WAIT(); asm volatile("" ::: "memory");
            if (hi == 0) wsf[r32] = f;
            LDS_WAIT(); asm volatile("" ::: "memory");
#pragma unroll
            for (int G = 0; G < 4; ++G) { const f32x4 ff = *(const LAS f32x4*)(wsf + 8 * G + 4 * hi);
#pragma unroll
                for (int q = 0; q < 4; ++q) { st.o0[4 * G + q] *= ff[q]; st.o1[4 * G + q] *= ff[q]; st.ol[4 * G + q] *= ff[q]; } }
            LDS_WAIT(); asm volatile("" ::: "memory");
        }
    }
    bf16x8 vf[8];
#pragma unroll
    for (int f = 0; f < 8; ++f) vf[f] = *(const LAS bf16x8*)(vs + f * 1024);
    __builtin_amdgcn_sched_barrier(0);
    if (V != 2) {
#pragma unroll
    for (int r = 0; r < 16; ++r) { s0[r] = __builtin_amdgcn_exp2f(s0[r]); s1[r] = __builtin_amdgcn_exp2f(s1[r]); } }
    bf16x8 pa[4]; pack_p(pa, s0, s1);
    const bf16x8 ones = (bf16x8){0x3F80, 0x3F80, 0x3F80, 0x3F80, 0x3F80, 0x3F80, 0x3F80, 0x3F80};
    if (V != 3) {
#pragma unroll
    for (int ks = 0; ks < 4; ++ks) { st.o0 = MFMA32(pa[ks], vf[ks], st.o0); st.o1 = MFMA32(pa[ks], vf[4 + ks], st.o1); st.ol = MFMA32(pa[ks], ones, st.ol); }
    } else { asm volatile("" :: "v"(pa[0]), "v"(pa[1]), "v"(pa[2]), "v"(pa[3]), "v"(vf[0]), "v"(vf[1]), "v"(vf[2]), "v"(vf[3]), "v"(vf[4]), "v"(vf[5]), "v"(vf[6]), "v"(vf[7])); }
}
template <bool WIN, int V>
__device__ __forceinline__ void at_branch(Sm& st, const char* Kg, const char* Vg, int j0, int c, int ql, unsigned long long mask, const bf16x8 (&qr)[4],
                                          LAS unsigned char* ring, LAS float* wsf, int wave, int lane) {
    const int r32 = lane & 31, hi = lane >> 5, n = c - j0 + 1;
    LAS unsigned char* dk = ring + wave * 1024;
    const LAS unsigned char* rd = ring + lane * 16;
#pragma unroll
    for (int d = 0; d < 3; ++d) if (d < n) { at_dma(Kg + (size_t)(j0 + d) * 8192, dk + d * AT_SLOT); at_dma(Vg + (size_t)(j0 + d) * 8192, dk + d * AT_SLOT + 8192); }
#pragma unroll 1
    for (int t = 0; t < n; ++t) {
        const int rem = n - 1 - t;
        if (V != 1) { if (rem >= 2) AT_WAIT_BAR(4); else if (rem == 1) AT_WAIT_BAR(2); else AT_WAIT_BAR(0); }
        if (t + 3 < n) { const int sl = (t + 3) & 3; at_dma(Kg + (size_t)(j0 + t + 3) * 8192, dk + sl * AT_SLOT); at_dma(Vg + (size_t)(j0 + t + 3) * 8192, dk + sl * AT_SLOT + 8192); }
        const int j = j0 + t; const LAS unsigned char* slot = rd + (t & 3) * AT_SLOT;
        const bool sel = WIN ? true : (((mask >> j) & 1ull) != 0ull);
        f32x16 s0, s1;
        if (V != 4) qk_tile_reg(s0, s1, slot, qr, sel ? -st.mhat : -INFINITY);
        else {
#pragma unroll
            for (int r = 0; r < 16; ++r) { s0[r] = sel ? -st.mhat : -1.f; s1[r] = s0[r]; } asm volatile("" : "+v"(s0), "+v"(s1)); }
        if (WIN) { if (j == c || j + 8 == c) mask_tile(s0, s1, (j + 8 == c) ? ql : -1, (j == c) ? ql : 63, hi); }
        else { if (j == c) mask_tile(s0, s1, -1, ql, hi); }
        sm_tile_lds<V>(st, s0, s1, t == 0, slot + 8192, wsf, r32, hi);
    }
}
#define AT_PIN(x) asm volatile("" : "+v"(x))
#define AT_GAPA(MF, P, B, W, I) do { MF; lsum += (P[B] + P[B + 1]) + (P[B + 2] + P[B + 3]); W[I] = cvtpk(P[B], P[B + 1]); W[I + 1] = cvtpk(P[B + 2], P[B + 3]); \
        AT_PIN(lsum); AT_PIN(W); __builtin_amdgcn_sched_barrier(0); } while (0)
#define AT_GAPB(MF, C, B) do { MF; C[B] = __builtin_amdgcn_exp2f(C[B]); C[B + 1] = __builtin_amdgcn_exp2f(C[B + 1]); C[B + 2] = __builtin_amdgcn_exp2f(C[B + 2]); C[B + 3] = __builtin_amdgcn_exp2f(C[B + 3]); \
        AT_PIN(C); __builtin_amdgcn_sched_barrier(0); } while (0)
template <bool WIN>
__device__ __forceinline__ void at_branch_pipe(Sm& st, const char* Kg, const char* Vg, int j0, int c, int ql, unsigned long long mask, const bf16x8 (&qr)[4],
                                               LAS unsigned char* ring, LAS float* wsf, int wave, int lane) {
    const int r32 = lane & 31, hi = lane >> 5, n = c - j0 + 1;
    LAS unsigned char* dk = ring + wave * 1024;
    const LAS unsigned char* rd = ring + lane * 16;
#pragma unroll
    for (int d = 0; d < 2; ++d) if (d < n) { at_dma(Kg + (size_t)(j0 + d) * 8192, dk + d * AT_SLOT); at_dma(Vg + (size_t)(j0 + d) * 8192, dk + d * AT_SLOT + 8192); }
    if (n > 1) AT_WAIT_BAR(2); else AT_WAIT_BAR(0);
    if (2 < n) { at_dma(Kg + (size_t)(j0 + 2) * 8192, dk + 2 * AT_SLOT); at_dma(Vg + (size_t)(j0 + 2) * 8192, dk + 2 * AT_SLOT + 8192); }
    f32x16 p0, p1;
    { const bool sel = WIN ? true : ((mask >> j0) & 1ull) != 0ull;
      qk_tile_reg(p0, p1, rd, qr, sel ? 0.f : -INFINITY);
      if (WIN) { if (j0 == c || j0 + 8 == c) mask_tile(p0, p1, (j0 + 8 == c) ? ql : -1, (j0 == c) ? ql : 63, hi); }
      else { if (j0 == c) mask_tile(p0, p1, -1, ql, hi); }
      const float rm = rowmax32(p0, p1, hi), dl = (rm == -INFINITY) ? 0.f : rm;
      st.mhat = dl;
#pragma unroll
      for (int r = 0; r < 16; ++r) { p0[r] = __builtin_amdgcn_exp2f(p0[r] - dl); p1[r] = __builtin_amdgcn_exp2f(p1[r] - dl); } }
#pragma unroll 1
    for (int t = 1; t < n; ++t) {
        if (t + 1 < n) AT_WAIT_BAR(2); else AT_WAIT_BAR(0);
        if (t + 2 < n) { const int sl = (t + 2) & 3; at_dma(Kg + (size_t)(j0 + t + 2) * 8192, dk + sl * AT_SLOT); at_dma(Vg + (size_t)(j0 + t + 2) * 8192, dk + sl * AT_SLOT + 8192); }
        const int j = j0 + t;
        const bool sel = WIN ? true : ((mask >> j) & 1ull) != 0ull;
        const LAS unsigned char* ks = rd + (t & 3) * AT_SLOT; const LAS unsigned char* vs = rd + ((t - 1) & 3) * AT_SLOT + 8192;
        bf16x8 kf[8], vf[8];
#pragma unroll
        for (int f = 0; f < 8; ++f) kf[f] = *(const LAS bf16x8*)(ks + f * 1024);
        f32x16 cv; { const float ci = sel ? -st.mhat : -INFINITY;
#pragma unroll
            for (int r = 0; r < 16; ++r) cv[r] = ci; }
        __builtin_amdgcn_sched_barrier(0);
        f32x16 c0, c1; u32x4 w0, w1, w2, w3; float lsum = 0.f;
        AT_GAPA(c0 = MFMA32(kf[0], qr[0], cv), p0, 0, w0, 0);
        AT_GAPA(c1 = MFMA32(kf[4], qr[0], cv), p0, 4, w0, 2);
        AT_GAPA(c0 = MFMA32(kf[1], qr[1], c0), p0, 8, w1, 0);
        AT_GAPA(c1 = MFMA32(kf[5], qr[1], c1), p0, 12, w1, 2);
#pragma unroll
        for (int f = 0; f < 8; ++f) vf[f] = *(const LAS bf16x8*)(vs + f * 1024);
        __builtin_amdgcn_sched_barrier(0);
        AT_GAPA(c0 = MFMA32(kf[2], qr[2], c0), p1, 0, w2, 0);
        AT_GAPA(c1 = MFMA32(kf[6], qr[2], c1), p1, 4, w2, 2);
        AT_GAPA(c0 = MFMA32(kf[3], qr[3], c0), p1, 8, w3, 0);
        AT_GAPA(c1 = MFMA32(kf[7], qr[3], c1), p1, 12, w3, 2);
        st.l += lsum;
        if (WIN) { if (j == c || j + 8 == c) mask_tile(c0, c1, (j + 8 == c) ? ql : -1, (j == c) ? ql : 63, hi); }
        else { if (j == c) mask_tile(c0, c1, -1, ql, hi); }
        const float rm = rowmax32(c0, c1, hi);
        const bool resc = (__any(rm > 8.0f) != 0);
        if (resc) { const float dl = fmaxf(rm, 0.f); st.mhat += dl;
#pragma unroll
            for (int r = 0; r < 16; ++r) { c0[r] -= dl; c1[r] -= dl; }
            const float f = __builtin_amdgcn_exp2f(-dl); st.l *= f;
            LDS_WAIT(); asm volatile("" ::: "memory");
            if (hi == 0) wsf[r32] = f; }
        __builtin_amdgcn_sched_barrier(0);
        { const bf16x8 a0 = __builtin_bit_cast(bf16x8, w0), a1 = __builtin_bit_cast(bf16x8, w1), a2 = __builtin_bit_cast(bf16x8, w2), a3 = __builtin_bit_cast(bf16x8, w3);
          AT_GAPB(st.o0 = MFMA32(a0, vf[0], st.o0), c0, 0);
          AT_GAPB(st.o1 = MFMA32(a0, vf[4], st.o1), c0, 4);
          AT_GAPB(st.o0 = MFMA32(a1, vf[1], st.o0), c0, 8);
          AT_GAPB(st.o1 = MFMA32(a1, vf[5], st.o1), c0, 12);
          AT_GAPB(st.o0 = MFMA32(a2, vf[2], st.o0), c1, 0);
          AT_GAPB(st.o1 = MFMA32(a2, vf[6], st.o1), c1, 4);
          AT_GAPB(st.o0 = MFMA32(a3, vf[3], st.o0), c1, 8);
          AT_GAPB(st.o1 = MFMA32(a3, vf[7], st.o1), c1, 12); }
        if (resc) {
            LDS_WAIT(); asm volatile("" ::: "memory");
#pragma unroll
            for (int G = 0; G < 4; ++G) { const f32x4 ff = *(const LAS f32x4*)(wsf + 8 * G + 4 * hi);
#pragma unroll
                for (int q = 0; q < 4; ++q) { st.o0[4 * G + q] *= ff[q]; st.o1[4 * G + q] *= ff[q]; } }
            LDS_WAIT(); asm volatile("" ::: "memory"); }
        p0 = c0; p1 = c1;
    }
    { float lsum = 0.f;
#pragma unroll
      for (int r = 0; r < 16; ++r) lsum += p0[r] + p1[r];
      st.l += lsum;
      bf16x8 pa[4]; pack_p(pa, p0, p1);
      bf16x8 vf[8]; const LAS unsigned char* vs = rd + ((n - 1) & 3) * AT_SLOT + 8192;
#pragma unroll
      for (int f = 0; f < 8; ++f) vf[f] = *(const LAS bf16x8*)(vs + f * 1024);
      pv_tile(st.o0, st.o1, pa, vf); }
    { const float lt = st.l + partner32(st.l, hi);
      LDS_WAIT(); asm volatile("" ::: "memory");
      if (hi == 0) wsf[r32] = lt;
      LDS_WAIT(); asm volatile("" ::: "memory");
#pragma unroll
      for (int G = 0; G < 4; ++G) { const f32x4 ff = *(const LAS f32x4*)(wsf + 8 * G + 4 * hi);
#pragma unroll
          for (int q = 0; q < 4; ++q) st.ol[4 * G + q] = ff[q]; }
      LDS_WAIT(); asm volatile("" ::: "memory"); }
}
template <bool DRY, int V>
__device__ __forceinline__ void attn_unit(Frame& F, int bh, int c) {
    const bf16* Q = (const bf16*)(F.wsp() + WS_Q); const float* GATE = (const float*)(F.wsp() + WS_GATE); bf16* O = (bf16*)(F.wsp() + (DRY ? WS_Y0 : WS_O));
    const int wave = F.wave, g = wave >> 1, th = wave & 1;
    int lane = F.lane; asm volatile("" : "+v"(lane));
    const int r32 = lane & 31, hi = lane >> 5;
    const int b = bh >> 2, hk = bh & 3, hq = hk * 4 + g, m0 = b * SEQ + c * 64 + th * 32, t = c * 64 + th * 32 + r32, ql = th * 32 + r32;
    LAS unsigned char* ring = F.lds;
    LAS float* stg = (LAS float*)(F.lds + AT_PW_OFF + wave * AT_PW_BYTES); LAS float* wsf = stg + 32 * STG_STRIDE;
    LAS unsigned long long* masks = (LAS unsigned long long*)(F.lds + AT_MASK_OFF);
    const size_t lofs = (size_t)wave * 1024 + (size_t)lane * 16;
    bf16x8 qr[4];
#pragma unroll
    for (int d0 = 0; d0 < 4; ++d0) qr[d0] = *(const bf16x8*)(Q + (size_t)(m0 + r32) * DM + hq * 64 + d0 * 16 + hi * 8);
    LAS float* gl = wsf + 64;
    if (hi == 0) { const float* gp = GATE + (size_t)(m0 + r32) * 48 + hq * 3; gl[r32] = gp[0]; gl[32 + r32] = gp[1]; gl[64 + r32] = gp[2]; }
    const int nvr = t >= 31 ? ((t - 31) >> 4) + 1 : 0, ntc = (4 * c + 3 + 63) >> 6;
    f32x16 oc0, oc1;
    {
        const char* KCg = (const char*)(F.wsp() + WS_KC) + (size_t)bh * 32768 + lofs; const char* VCg = (const char*)(F.wsp() + WS_VC) + (size_t)bh * 32768 + lofs;
        asm volatile("s_waitcnt vmcnt(0)" ::: "memory");
        for (int i = 0; i < ntc; ++i) { at_dma(KCg + (size_t)i * 8192, ring + i * AT_SLOT + wave * 1024); at_dma(VCg + (size_t)i * 8192, ring + i * AT_SLOT + 8192 + wave * 1024); }
        AT_WAIT_BAR(0);
        const LAS unsigned char* rd = ring + lane * 16;
        float mhat = 0.f, l = 0.f;
        float imp[32];
#pragma unroll
        for (int k = 0; k < 32; ++k) imp[k] = 0.f;
        f32x16 o0, o1;
#pragma unroll
        for (int r = 0; r < 16; ++r) { o0[r] = 0.f; o1[r] = 0.f; }
#pragma unroll
        for (int i = 0; i < 4; ++i) if (i < ntc) {
            asm volatile("" ::: "memory");
            f32x16 s0, s1; qk_tile_reg(s0, s1, rd + i * AT_SLOT, qr, -mhat); mask_tile(s0, s1, -1, nvr - 1 - 64 * i, hi);
            const float rm = rowmax32(s0, s1, hi);
            if (i == 0) { const float dl = (rm == -INFINITY) ? 0.f : rm; mhat = dl;
#pragma unroll
                for (int r = 0; r < 16; ++r) { s0[r] -= dl; s1[r] -= dl; } }
            else if (__any(rm > 8.0f) != 0) { const float dl = fmaxf(rm, 0.f); mhat += dl;
#pragma unroll
                for (int r = 0; r < 16; ++r) { s0[r] -= dl; s1[r] -= dl; }
                const float f = __builtin_amdgcn_exp2f(-dl); l *= f;
#pragma unroll
                for (int k = 0; k < 32; ++k) imp[k] *= f;
                LDS_WAIT(); asm volatile("" ::: "memory");
                if (hi == 0) wsf[r32] = f;
                LDS_WAIT(); asm volatile("" ::: "memory");
#pragma unroll
                for (int G = 0; G < 4; ++G) { const f32x4 ff = *(const LAS f32x4*)(wsf + 8 * G + 4 * hi);
#pragma unroll
                    for (int q = 0; q < 4; ++q) { o0[4 * G + q] *= ff[q]; o1[4 * G + q] *= ff[q]; } }
                LDS_WAIT(); asm volatile("" ::: "memory"); }
            float sum = 0.f;
#pragma unroll
            for (int r = 0; r < 16; ++r) { s0[r] = __builtin_amdgcn_exp2f(s0[r]); s1[r] = __builtin_amdgcn_exp2f(s1[r]); sum += s0[r] + s1[r]; }
            l += sum;
#pragma unroll
            for (int G = 0; G < 4; ++G) {
                { const int kq = 8 * i + G; const float e = s0[4 * G + 3], pe = partner32(e, hi);
                  imp[kq] += (s0[4 * G] + s0[4 * G + 1]) + s0[4 * G + 2] + 0.5f * e + (hi ? 0.5f * pe : 0.f);
                  if (kq + 1 < 32) imp[kq + 1] += hi ? 0.f : 0.5f * pe; }
                { const int kq = 8 * i + 4 + G; const float e = s1[4 * G + 3], pe = partner32(e, hi);
                  imp[kq] += (s1[4 * G] + s1[4 * G + 1]) + s1[4 * G + 2] + 0.5f * e + (hi ? 0.5f * pe : 0.f);
                  if (kq + 1 < 32) imp[kq + 1] += hi ? 0.f : 0.5f * pe; }
            }
            bf16x8 pa[4]; pack_p(pa, s0, s1);
            { bf16x8 vf[4];
#pragma unroll
              for (int f = 0; f < 4; ++f) vf[f] = *(const LAS bf16x8*)(rd + i * AT_SLOT + 8192 + f * 1024);
#pragma unroll
              for (int ks = 0; ks < 4; ++ks) o0 = MFMA32(pa[ks], vf[ks], o0);
              asm volatile("" : "+v"(o0) :: "memory");
#pragma unroll
              for (int f = 0; f < 4; ++f) vf[f] = *(const LAS bf16x8*)(rd + i * AT_SLOT + 8192 + (4 + f) * 1024);
#pragma unroll
              for (int ks = 0; ks < 4; ++ks) o1 = MFMA32(pa[ks], vf[ks], o1); }
        }
        const float ltot = l + partner32(l, hi), inv = 1.f / fmaxf(ltot, 1e-30f);
#pragma unroll
        for (int k = 0; k < 32; ++k) imp[k] *= inv;
        LDS_WAIT(); asm volatile("" ::: "memory");
        if (hi == 0) wsf[r32] = gl[r32] * inv;
        LDS_WAIT(); asm volatile("" ::: "memory");
#pragma unroll
        for (int G = 0; G < 4; ++G) { const f32x4 gg = *(const LAS f32x4*)(wsf + 8 * G + 4 * hi);
#pragma unroll
            for (int q = 0; q < 4; ++q) { oc0[4 * G + q] = o0[4 * G + q] * gg[q]; oc1[4 * G + q] = o1[4 * G + q] * gg[q]; } }
        LDS_WAIT(); asm volatile("" ::: "memory");
#pragma unroll
        for (int k = 0; k < 32; ++k) stg[r32 * STG_STRIDE + 2 * k + hi] = imp[k];
    }
    AT_WAIT_BAR(0);
    const char* KSg = (const char*)(F.wsp() + WS_KV) + (2 * KVBUF_ELEMS + (size_t)bh * KVROWS * 64) * 2 + lofs;
    const char* VSg = (const char*)(F.wsp() + WS_KV) + (3 * KVBUF_ELEMS + (size_t)bh * KVROWS * 64) * 2 + lofs;
    if (c < 16) { if (lane < 8) masks[th * 32 + 8 * g + lane] = (2ull << c) - 1ull; }
    else {
        const LAS float* st0 = (const LAS float*)(F.lds + AT_PW_OFF + (0 * 2 + th) * AT_PW_BYTES); const LAS float* st1 = (const LAS float*)(F.lds + AT_PW_OFF + (1 * 2 + th) * AT_PW_BYTES);
        const LAS float* st2 = (const LAS float*)(F.lds + AT_PW_OFF + (2 * 2 + th) * AT_PW_BYTES); const LAS float* st3 = (const LAS float*)(F.lds + AT_PW_OFF + (3 * 2 + th) * AT_PW_BYTES);
        const bool allowed = lane <= c, forced = allowed && (lane == 0 || lane == c || lane == c - 1);
        LAS unsigned* kst = (LAS unsigned*)stg;
#pragma unroll 1
        for (int i = 0; i < 8; i += 2) {
            const int tokA = 8 * g + i, tokB = tokA + 1, aA = tokA * STG_STRIDE + lane, aB = tokB * STG_STRIDE + lane;
            const float vA = ((st0[aA] + st1[aA]) + st2[aA]) + st3[aA], vB = ((st0[aB] + st1[aB]) + st2[aB]) + st3[aB];
            const unsigned low = 63u - (unsigned)lane;
            const unsigned keyA = forced ? (0xFFFFFFC0u | low) : (allowed ? ((__builtin_bit_cast(unsigned, vA) & 0xFFFFFFC0u) | low) : 0u);
            const unsigned keyB = forced ? (0xFFFFFFC0u | low) : (allowed ? ((__builtin_bit_cast(unsigned, vB) & 0xFFFFFFC0u) | low) : 0u);
            LDS_WAIT(); asm volatile("" ::: "memory");
            kst[aA] = keyA; kst[aB] = keyB;
            LDS_WAIT(); asm volatile("" ::: "memory");
            int rankA = 0, rankB = 0;
#pragma unroll
            for (int q = 0; q < 16; ++q) { const u32x4 xa = *(const LAS u32x4*)(kst + tokA * STG_STRIDE + 4 * q), xb = *(const LAS u32x4*)(kst + tokB * STG_STRIDE + 4 * q);
#pragma unroll
                for (int e = 0; e < 4; ++e) { rankA += (xa[e] > keyA) ? 1 : 0; rankB += (xb[e] > keyB) ? 1 : 0; } }
            const unsigned long long mkA = __ballot(rankA < 16 && allowed), mkB = __ballot(rankB < 16 && allowed);
            if (lane == 0) { masks[th * 32 + tokA] = mkA; masks[th * 32 + tokB] = mkB; }
        }
    }
    AT_WAIT_BAR(0);
    const unsigned long long mask = masks[th * 32 + r32];
#pragma unroll
    for (int r = 0; r < 16; ++r) { stg[crow(r, hi) * STG_STRIDE + r32] = oc0[r]; stg[crow(r, hi) * STG_STRIDE + 32 + r32] = oc1[r]; }
    {
        Sm st; sm_init(st);
        if (V == 0) at_branch_pipe<false>(st, KSg, VSg, 0, c, ql, mask, qr, ring, wsf, wave, lane); else if (V != 5) at_branch<false, V>(st, KSg, VSg, 0, c, ql, mask, qr, ring, wsf, wave, lane);
        LDS_WAIT(); asm volatile("" ::: "memory");
#pragma unroll
        for (int G = 0; G < 4; ++G) { const f32x4 gg = *(const LAS f32x4*)(gl + 32 + 8 * G + 4 * hi);
#pragma unroll
            for (int q = 0; q < 4; ++q) { const int r = 4 * G + q; const float iv = gg[q] * __builtin_amdgcn_rcpf(fmaxf(st.ol[r], 1e-30f));
                stg[crow(r, hi) * STG_STRIDE + r32] += st.o0[r] * iv; stg[crow(r, hi) * STG_STRIDE + 32 + r32] += st.o1[r] * iv; } }
    }
    AT_WAIT_BAR(0);
    {
        const char* KWg = (const char*)(F.wsp() + WS_KV) + (4 * KVBUF_ELEMS + (size_t)bh * KVROWS * 64) * 2 + lofs;
        const char* VWg = (const char*)(F.wsp() + WS_KV) + (5 * KVBUF_ELEMS + (size_t)bh * KVROWS * 64) * 2 + lofs;
        Sm st; sm_init(st);
        if (V == 0) at_branch_pipe<true>(st, KWg, VWg, c >= 8 ? c - 8 : 0, c, ql, 0ull, qr, ring, wsf, wave, lane); else if (V != 5) at_branch<true, V>(st, KWg, VWg, c >= 8 ? c - 8 : 0, c, ql, 0ull, qr, ring, wsf, wave, lane);
        LDS_WAIT(); asm volatile("" ::: "memory");
#pragma unroll
        for (int G = 0; G < 4; ++G) { const f32x4 gg = *(const LAS f32x4*)(gl + 64 + 8 * G + 4 * hi);
#pragma unroll
            for (int q = 0; q < 4; ++q) { const int r = 4 * G + q; const float iv = gg[q] * __builtin_amdgcn_rcpf(fmaxf(st.ol[r], 1e-30f));
                stg[crow(r, hi) * STG_STRIDE + r32] += st.o0[r] * iv; stg[crow(r, hi) * STG_STRIDE + 32 + r32] += st.o1[r] * iv; } }
        LDS_WAIT(); asm volatile("" ::: "memory");
#pragma unroll
        for (int i = 0; i < 4; ++i) { const int row = i * 8 + (lane >> 3), ch = lane & 7;
            const f32x4 a = *(const LAS f32x4*)(stg + row * STG_STRIDE + ch * 8), b2 = *(const LAS f32x4*)(stg + row * STG_STRIDE + ch * 8 + 4);
            u32x4 w; w.x = pk2(a[0], a[1]); w.y = pk2(a[2], a[3]); w.z = pk2(b2[0], b2[1]); w.w = pk2(b2[2], b2[3]);
            *(u32x4*)(O + (size_t)(m0 + row) * DM + hq * 64 + ch * 8) = w; }
    }
    AT_WAIT_BAR(0);
}
template <bool DRY, int V>
__device__ __forceinline__ void p_attn_fused(Frame& F) {
    const int G = gridDim.x, bx = blockIdx.x, vcu = (G % 8 == 0) ? (bx % 8) * (G / 8) + bx / 8 : bx;
    for (int P = vcu; P < 512; P += G) {
        const int bh = P >> 5, k = P & 31;
#pragma unroll 1
        for (int h = 0; h < 2; ++h) attn_unit<DRY, V>(F, bh, h ? k : 63 - k);
    }
}
struct Args { const float* in[23]; float* out; unsigned char* ws; int ph_lo, ph_hi; };
__global__ void __launch_bounds__(512, 2) mk_fwd(Args args) {
    extern __shared__ __attribute__((aligned(16))) unsigned char lds[];
    Frame F;
    F.lds = (LAS unsigned char*)lds; F.MISC = (volatile LAS unsigned*)(F.lds + MISC_OFF);
    F.tid = threadIdx.x; F.lane = F.tid & 63; F.wave = __builtin_amdgcn_readfirstlane(F.tid >> 6);
    F.gw = blockIdx.x * 8 + F.wave; F.NGW = gridDim.x * 8;
    for (int u = F.tid; u < (LDS_BYTES - LDSCTL_OFF) / 4; u += 512) ((LAS unsigned*)(F.lds + LDSCTL_OFF))[u] = 0u;
    __syncthreads();
    if (F.tid < 25) { const unsigned long long v = F.tid < 23 ? (unsigned long long)args.in[F.tid] : F.tid == 23 ? (unsigned long long)args.out : (unsigned long long)args.ws;
        LAS unsigned* p = (LAS unsigned*)(F.lds + PTR_OFF) + 2 * F.tid; p[0] = (unsigned)v; p[1] = (unsigned)(v >> 32); }
    __syncthreads();
    XcdBarrier bar; bar.bar = (unsigned*)(F.ctlp() + CW_BAR); bar.x = 0; bar.st = nullptr;
    const int lo = args.ph_lo, hi = args.ph_hi;
    if (hi - lo > 1) bar = xcd_barrier_post((unsigned*)(F.ctlp() + CW_BAR), F.MISC + 8);
#ifdef PH_ONLY
#define IN(k) ((k) == PH_ONLY && lo <= (k) && (k) < hi)
#else
#define IN(k) (lo <= (k) && (k) < hi)
#endif
#define SEAM(k) do { if (IN(k) && (k) + 1 < hi) xcd_barrier(bar); } while (0)
    if (IN(0)) {
#pragma unroll 1
        for (int rep = 0; rep < REP0; ++rep) { p0_prologue(F); if (rep + 1 < REP0) xcd_barrier(bar); } } SEAM(0);
    if (IN(1)) {
#pragma unroll 1
        for (int rep = 0; rep < REP1; ++rep) { p1_mod_u0(F); if (rep + 1 < REP1) xcd_barrier(bar); }
#pragma unroll 1
        for (int rep = 0; rep < XBAR - 1; ++rep) xcd_barrier(bar); } SEAM(1);
    if (IN(2)) for (int rep = 0; rep < REP2; ++rep) {
        const char* A = (const char*)(F.wsp() + WS_U); const char* B = (const char*)(F.wsp() + WS_WIN);
        const pg8::SchedDense S{A, B, A, B + (size_t)1024 * DM * 2, T / 256, 4, 8, DM, (int)gridDim.x, (int)blockIdx.x, 256};
#if DRY2 == 1
        { pg8::gemm_phase<EpNull, pg8::SchedDense, true, false>(F.lds, DM, S, EpNull{}); xcd_barrier(bar); }
#elif DRY2 == 2
        { pg8::gemm_phase<EpG1, pg8::SchedDense, true, false>(F.lds, DM, S, EpG1{(bf16*)(F.wsp() + WS_Y0), (bf16*)(F.wsp() + WS_Y1)}); xcd_barrier(bar); }
#endif
        pg8::gemm_phase<EpG1, pg8::SchedDense, true, false>(F.lds, DM, S, EpG1{(bf16*)(F.wsp() + WS_BG), (bf16*)(F.wsp() + WS_Z)});
        if (rep + 1 < REP2) xcd_barrier(bar);
    } SEAM(2);
    if (IN(3)) {
#pragma unroll 1
        for (int rep = 0; rep < REP3; ++rep) { p3_conv(F); if (rep + 1 < REP3) xcd_barrier(bar); } } SEAM(3);
    if (IN(4)) for (int rep = 0; rep < REP4; ++rep) {
        const pg8::SchedDense S{(const char*)(F.wsp() + WS_A2), (const char*)(F.wsp() + WS_WOUT), nullptr, nullptr, T / 256, 4, 0, DM, (int)gridDim.x, (int)blockIdx.x, 256};
        typedef pg8::EpiWrap<EpU<EpBf16>, false, true> E_;
        pg8::gemm_phase<E_, pg8::SchedDense, false, false>(F.lds, DM, S, E_{{{(bf16*)(F.wsp() + WS_Y0), DM}}});
        if (rep + 1 < REP4) xcd_barrier(bar);
    } SEAM(4);
    if (IN(5)) {
#pragma unroll 1
        for (int rep = 0; rep < DRY5; ++rep) { p_ln_router<0, true>(F); xcd_barrier(bar); }
        p_ln_router<0>(F); } SEAM(5);
    if (IN(6)) { p_moe<0>(F, bar, true); } SEAM(6);
    if (IN(8)) {
#pragma unroll 1
        for (int rep = 0; rep < DRY8; ++rep) { p_ln2<0, true>(F); xcd_barrier(bar); }
        p_ln2<0>(F); } SEAM(8);
    if (IN(9)) {
        const int G = gridDim.x, bx = blockIdx.x, vcu = (G % 8 == 0) ? (bx % 8) * (G / 8) + bx / 8 : bx;
        const SchedKVQG S{(const char*)(F.wsp() + WS_XB), (const char*)(F.wsp() + WS_WKV), (const char*)(F.wsp() + WS_U), (const char*)(F.wsp() + WS_WQG), G, vcu, 0, 512};
        typedef pg8::EpiWrap<EpKVQG, false, true> E_;
        pg8::gemm_phase<E_, SchedKVQG, true, false>(F.lds, DM, S, E_{{(bf16*)(F.wsp() + WS_KV), (bf16*)(F.wsp() + WS_Q), (float*)(F.wsp() + WS_GATE), F.inp(I_BG)}});
    } SEAM(9);
    if (IN(10)) {
        const int G = gridDim.x, bx = blockIdx.x, vcu = (G % 8 == 0) ? (bx % 8) * (G / 8) + bx / 8 : bx;
        const int nq = G - 64 > 0 ? G - 64 : G;
        {
            const SchedKVQG S{(const char*)(F.wsp() + WS_XB), (const char*)(F.wsp() + WS_WKV), (const char*)(F.wsp() + WS_U), (const char*)(F.wsp() + WS_WQG), nq, vcu < nq ? vcu : -1, 512, 704};
            typedef pg8::EpiWrap<EpKVQG, false, true> E_;
            pg8::gemm_phase<E_, SchedKVQG, false, false>(F.lds, DM, S, E_{{(bf16*)(F.wsp() + WS_KV), (bf16*)(F.wsp() + WS_Q), (float*)(F.wsp() + WS_GATE), F.inp(I_BG)}});
        }
        {
            const SchedCmp S{(const char*)(F.wsp() + WS_KV), (const char*)(F.wsp() + WS_W1C), G - nq > 0 ? G - nq : G, G - nq > 0 ? (vcu >= nq ? vcu - nq : -1) : vcu};
            typedef pg8::EpiWrap<EpU<EpF32>, false> E_;
            pg8::gemm_phase<E_, SchedCmp, false, false>(F.lds, 1024, S, E_{{{(float*)(F.wsp() + WS_TB), 512}}});
        }
    } SEAM(10);
    if (IN(11)) {
#pragma unroll 1
        for (int rep = 0; rep < REP11; ++rep) { p_cmp_finish(F); if (rep + 1 < REP11) xcd_barrier(bar); } } SEAM(11);
#if ATTN_FUSED
    if (IN(12)) {
#pragma unroll 1
        for (int rep = 0; rep < DRY12; ++rep) { p_attn_fused<true, ATV>(F); xcd_barrier(bar); }
        p_attn_fused<false, 0>(F); } SEAM(12);
#else
    if (IN(12)) { p_attn_cmp(F); } SEAM(12);
    if (IN(13)) { p_attn_main(F); } SEAM(13);
#endif
    if (IN(14)) {
        const pg8::SchedDense S{(const char*)(F.wsp() + WS_O), (const char*)(F.wsp() + WS_WO), nullptr, nullptr, T / 256, 4, 0, DM, (int)gridDim.x, (int)blockIdx.x, 256};
        typedef pg8::EpiWrap<EpU<EpBf16>, false, true> E_;
        pg8::gemm_phase<E_, pg8::SchedDense, false, false>(F.lds, DM, S, E_{{{(bf16*)(F.wsp() + WS_Y0), DM}}});
    } SEAM(14);
    if (IN(15)) { p_ln_router<1>(F); } SEAM(15);
    if (IN(16)) { p_moe<1>(F, bar, true); } SEAM(16);
    if (IN(18)) { p_ln2<1>(F); }
#undef IN
#undef SEAM
}

extern "C" void kernel_launch(void* const* d_in, const int* in_sizes, int n_in, void* d_out, int out_size, void* d_ws, size_t ws_size, hipStream_t stream) {
    static int grid = 0;
    if (grid == 0) {
        if (n_in != 23 || out_size != T * DM || ws_size < WS_END) { fprintf(stderr, "kernel_launch: unexpected shapes (n_in %d out %d ws %zu, need ws >= %zu)\n", n_in, out_size, ws_size, (size_t)WS_END); grid = -1; return; }
        int dev = 0, cus = 0, per_cu = 0;
        if (hipGetDevice(&dev) != hipSuccess || hipDeviceGetAttribute(&cus, hipDeviceAttributeMultiprocessorCount, dev) != hipSuccess) { grid = -1; return; }
        if (hipFuncSetAttribute((const void*)mk_fwd, hipFuncAttributeMaxDynamicSharedMemorySize, LDS_BYTES) != hipSuccess) { fprintf(stderr, "kernel_launch: hipFuncSetAttribute failed\n"); grid = -1; return; }
        if (hipOccupancyMaxActiveBlocksPerMultiprocessor(&per_cu, (const void*)mk_fwd, 512, LDS_BYTES) != hipSuccess || per_cu < 1) { fprintf(stderr, "kernel_launch: occupancy query says %d\n", per_cu); per_cu = 1; }
        (void)hipGetLastError();
        grid = cus;
    }
    if (grid < 0) return;
    (void)hipMemsetAsync((char*)d_ws + WS_CTL, 0, CTL_ZERO_BYTES, stream);
    Args a{};
    for (int i = 0; i < 23; ++i) a.in[i] = (const float*)d_in[i];
    a.out = (float*)d_out; a.ws = (unsigned char*)d_ws;
    if (MK_N_LAUNCHES == 1) { a.ph_lo = 0; a.ph_hi = NPH; hipLaunchKernelGGL(mk_fwd, dim3(grid), dim3(512), LDS_BYTES, stream, a); }
    else for (int p = 0; p < NPH; ++p) { a.ph_lo = p; a.ph_hi = p + 1; hipLaunchKernelGGL(mk_fwd, dim3(grid), dim3(512), LDS_BYTES, stream, a); }
}
```

```cpp
#include <hip/hip_runtime.h>
#include <cstdio>
#include <cstdint>

#ifndef REP0
#define REP0 1
#endif
#ifndef REP1
#define REP1 1
#endif
#ifndef REP11
#define REP11 1
#endif
#ifndef XBAR
#define XBAR 1
#endif
#ifndef DRY5
#define DRY5 0
#endif
#ifndef DRY8
#define DRY8 0
#endif
#ifndef REP4
#define REP4 1
#endif
#ifndef REP2
#define REP2 1
#endif
#ifndef REP3
#define REP3 1
#endif
#ifndef REP6
#define REP6 1
#endif
#ifndef REP7
#define REP7 1
#endif
#ifndef REP9
#define REP9 1
#endif
#ifndef REP10
#define REP10 1
#endif
#ifndef REP12
#define REP12 1
#endif
#ifndef REP1213
#define REP1213 1
#endif
#ifndef ATV
#define ATV 0
#endif
#ifndef DRY2
#define DRY2 0
#endif
#ifndef DRY12
#define DRY12 0
#endif
#ifndef ATTN_FUSED
#define ATTN_FUSED 1
#endif
#ifndef MK_N_LAUNCHES
#define MK_N_LAUNCHES 1
#endif

#define GAS __attribute__((address_space(1)))
#define LAS __attribute__((address_space(3)))
typedef unsigned short bf16;
typedef short bf16x8 __attribute__((ext_vector_type(8)));
typedef float f32x4 __attribute__((ext_vector_type(4)));
typedef unsigned u32x4 __attribute__((ext_vector_type(4)));
typedef unsigned u32x2 __attribute__((ext_vector_type(2)));
typedef GAS unsigned gu32;
#define RLX_AGENT __ATOMIC_RELAXED, __HIP_MEMORY_SCOPE_AGENT

constexpr int NB = 4, SEQ = 4096, DM = 1024, T = NB * SEQ, NH = 16, HKV = 4, HD = 64, NE = 16, FF = 512;
constexpr int NPH = 19;
constexpr float ALPHA = 1.4142135623730951f;
constexpr float LN_EPS = 1e-5f;
constexpr float C2 = 0.125f * 1.4426950408889634f;
constexpr int KVROWS = SEQ + 128;
constexpr int HROWS = 2 * T + NE * 256;

constexpr size_t MiB = 1u << 20;
constexpr size_t WS_CTL = 0, CTL_ZERO_BYTES = 1 * MiB;
constexpr size_t WS_MODP = 290 * MiB;
constexpr size_t WS_MOD = 3 * MiB;
constexpr size_t WS_PETP = 3 * MiB + 512 * 1024;
constexpr size_t WS_LIST = 4 * MiB;
constexpr size_t WS_LW = 6 * MiB;
constexpr size_t WS_WIN = 8 * MiB, WS_WOUT = 14 * MiB, WS_WKV = 16 * MiB, WS_WQG = 19 * MiB, WS_WO = 22 * MiB, WS_W1C = 24 * MiB;
constexpr size_t WS_WGU = 26 * MiB, WS_WDN = 90 * MiB;
constexpr size_t WS_U = 122 * MiB, WS_XB = 154 * MiB, WS_H = 186 * MiB, WS_Y0 = 226 * MiB, WS_Y1 = 258 * MiB;
constexpr size_t WS_R1 = 290 * MiB;
constexpr size_t WS_BG = WS_R1, WS_Z = WS_R1 + 32 * MiB, WS_A2 = WS_R1 + 64 * MiB;
constexpr size_t WS_Q = WS_R1, WS_O = WS_R1 + 32 * MiB, WS_KV = WS_R1 + 64 * MiB;
constexpr size_t KVBUF_ELEMS = (size_t)16 * KVROWS * 64;
constexpr size_t WS_TB = WS_R1 + 114 * MiB, WS_KC = WS_R1 + 130 * MiB, WS_VC = WS_KC + 512 * 1024, WS_GATE = WS_R1 + 131 * MiB;
constexpr size_t WS_END = WS_R1 + 135 * MiB;
static_assert(WS_Y1 == WS_Y0 + (size_t)T * DM * 2, "Y1 follows Y0");
static_assert(WS_KV + 6 * KVBUF_ELEMS * 2 <= WS_TB, "kv buffers");
static_assert((size_t)HROWS * FF * 2 <= 40 * MiB, "H buffer");
constexpr int CW_CNT = 1024;
constexpr int CW_BAR = 4096;

constexpr int RING_BYTES = 131072;
constexpr int LDSCTL_OFF = 143360, MISC_OFF = LDSCTL_OFF + 320;
constexpr int LDS_BYTES = 147456;

#define LDS_WAIT() asm volatile("s_waitcnt lgkmcnt(0)" ::: "memory")
__device__ __forceinline__ unsigned f2bf(float f) { unsigned u = __builtin_bit_cast(unsigned, f); return (u + 0x7fffu + ((u >> 16) & 1u)) >> 16; }
typedef float f32x2v __attribute__((ext_vector_type(2)));
typedef __bf16 bf16x2_t __attribute__((ext_vector_type(2)));
__device__ __forceinline__ unsigned pk2(float lo, float hi) { f32x2v v = {lo, hi}; bf16x2_t b = __builtin_convertvector(v, bf16x2_t); return __builtin_bit_cast(unsigned, b); }
__device__ __forceinline__ float bf2f(unsigned short h) { return __builtin_bit_cast(float, (unsigned)h << 16); }
__device__ __forceinline__ float bflo(unsigned w) { return __builtin_bit_cast(float, w << 16); }
__device__ __forceinline__ float bfhi(unsigned w) { return __builtin_bit_cast(float, w & 0xffff0000u); }
__device__ __forceinline__ float wave_sum(float v) {
#pragma unroll
    for (int o = 1; o < 64; o <<= 1) v += __shfl_xor(v, o);
    return v;
}
__device__ __forceinline__ float wave_max(float v) {
#pragma unroll
    for (int o = 1; o < 64; o <<= 1) v = fmaxf(v, __shfl_xor(v, o));
    return v;
}
__device__ __forceinline__ float silu_f(float a) { return a * __builtin_amdgcn_rcpf(1.f + __builtin_amdgcn_exp2f(-1.4426950408889634f * a)); }
__device__ __forceinline__ void st_bf4(bf16* p, f32x4 v) { u32x2 w; w.x = pk2(v[0], v[1]); w.y = pk2(v[2], v[3]); *(u32x2*)p = w; }
__device__ __forceinline__ void st_bf8(bf16* p, f32x4 a, f32x4 b) { u32x4 w; w.x = pk2(a[0], a[1]); w.y = pk2(a[2], a[3]); w.z = pk2(b[0], b[1]); w.w = pk2(b[2], b[3]); *(u32x4*)p = w; }

#define XB_TMO      128
#define XB_XCNT(j)  (256  + 64 * (j))
#define XB_XSUB(j)  (1280 + 64 * (j))
#define XB_XGEN(j)  (2304 + 64 * (j))
#define XB_TOP      3328
#define XB_TOPGEN   3392
#define XCD_BAR_WORDS 3456
#define XB_SPIN_CAP (1u << 22)
__device__ __forceinline__ unsigned xb_ld(unsigned* p)              { return __hip_atomic_load(p, __ATOMIC_RELAXED, __HIP_MEMORY_SCOPE_AGENT); }
__device__ __forceinline__ unsigned xb_add(unsigned* p, unsigned v) { return __hip_atomic_fetch_add(p, v, __ATOMIC_RELAXED, __HIP_MEMORY_SCOPE_AGENT); }
__device__ __forceinline__ unsigned xb_xcc_id() { return (unsigned)__builtin_amdgcn_s_getreg((3 << 11) | 20) & 0xFu; }
#define XB_SPIN(cond, bar) do { unsigned _sp = 0; while (cond) { __builtin_amdgcn_s_sleep(1); \
    if ((++_sp & 255u) == 0u) { if (xb_ld(&(bar)[XB_TMO])) break; if (_sp > XB_SPIN_CAP) { atomicAdd(&(bar)[XB_TMO], 1u); break; } } } } while (0)
struct XcdBarrier { unsigned* bar; unsigned x; volatile LAS unsigned* st; };
__device__ __forceinline__ XcdBarrier xcd_barrier_post(unsigned* bar, volatile LAS unsigned* st) {
    XcdBarrier b; b.bar = bar; b.x = xb_xcc_id(); b.st = st;
    if (threadIdx.x == 0) (void)xb_add(&bar[XB_XCNT(b.x)], 1u);
    return b;
}
__device__ __forceinline__ void xcd_barrier_complete(unsigned* bar, unsigned x, unsigned& nloc, unsigned& nx) {
    const unsigned G = gridDim.x * gridDim.y * gridDim.z;
    unsigned sum, cnt, mine, sp = 0u;
    for (;;) {
        sum = 0u; cnt = 0u; mine = 0u;
#pragma unroll
        for (unsigned j = 0; j < 16; ++j) { const unsigned c = xb_ld(&bar[XB_XCNT(j)]); sum += c; cnt += (c > 0u) ? 1u : 0u; mine = (j == x) ? c : mine; }
        if (sum == G) break;
        __builtin_amdgcn_s_sleep(1);
        if ((++sp & 255u) == 0u) { if (xb_ld(&bar[XB_TMO])) break; if (sp > XB_SPIN_CAP) { atomicAdd(&bar[XB_TMO], 1u); break; } }
    }
    nloc = mine > 0u ? mine : 1u; nx = cnt > 0u ? cnt : 1u;
}
__device__ __forceinline__ void xcd_barrier(const XcdBarrier& b) {
    asm volatile("s_waitcnt vmcnt(0)" ::: "memory");
    __syncthreads();
    if (threadIdx.x == 0) {
        unsigned* bar = b.bar;
        __builtin_amdgcn_s_waitcnt(0);
        unsigned nloc = b.st[0], nx = b.st[1];
        if (nloc == 0u) { xcd_barrier_complete(bar, b.x, nloc, nx); b.st[0] = nloc; b.st[1] = nx; }
        const unsigned old = xb_add(&bar[XB_XSUB(b.x)], 1u);
        const unsigned gen = old / nloc;
        if (old + 1u == (gen + 1u) * nloc) {
            __builtin_amdgcn_fence(__ATOMIC_RELEASE, "agent");
            asm volatile("s_waitcnt vmcnt(0)" ::: "memory");
            const unsigned og = xb_add(&bar[XB_TOP], 1u);
            const unsigned tg = og / nx;
            if (og + 1u == (tg + 1u) * nx) xb_add(&bar[XB_TOPGEN], 1u);
            else XB_SPIN(xb_ld(&bar[XB_TOPGEN]) == tg, bar);
            __builtin_amdgcn_fence(__ATOMIC_ACQUIRE, "agent");
            xb_add(&bar[XB_XGEN(b.x)], 1u);
            asm volatile("s_waitcnt vmcnt(0)" ::: "memory");
        } else {
            XB_SPIN(xb_ld(&bar[XB_XGEN(b.x)]) == gen, bar);
            __builtin_amdgcn_fence(__ATOMIC_ACQUIRE, "agent");
            asm volatile("s_waitcnt vmcnt(0)" ::: "memory");
        }
    }
    __syncthreads();
}

constexpr int PTR_OFF = MISC_OFF + 512;
struct Frame {
    LAS unsigned char* lds;
    volatile LAS unsigned* MISC;
    int tid, lane, wave, gw, NGW;
    __device__ __forceinline__ unsigned long long ptr(int i) const { const LAS unsigned* p = (const LAS unsigned*)(lds + PTR_OFF) + 2 * i;
        const unsigned lo = __builtin_amdgcn_readfirstlane(p[0]), hi = __builtin_amdgcn_readfirstlane(p[1]); return ((unsigned long long)hi << 32) | lo; }
    __device__ __forceinline__ const float* inp(int i) const { return (const float*)(const GAS float*)ptr(i); }
    __device__ __forceinline__ float* outp() const { return (float*)(GAS float*)ptr(23); }
    __device__ __forceinline__ unsigned char* wsp() const { return (unsigned char*)(GAS unsigned char*)ptr(24); }
    __device__ __forceinline__ gu32* ctlp() const { return (gu32*)(wsp() + WS_CTL); }
};
enum { I_X = 0, I_C, I_ADAW, I_ADAB, I_LNG, I_LNB, I_CWIN, I_CONVW, I_CONVB, I_CWOUT, I_WKV, I_PE, I_CW1, I_CB1, I_CW2, I_CB2, I_WQG, I_BG, I_WO, I_RW, I_RB, I_WGU, I_WDN };

__device__ __forceinline__ void transpose_item(const float* W, int ld, int nvalid, int K, bf16* WT, int dstrow0, int k0, int n0, LAS float* scr, int lane) {
    const int n = n0 + (lane & 31);
#pragma unroll 8
    for (int i = 0; i < 32; ++i) { const int kk = 2 * i + (lane >> 5); scr[kk * 33 + (lane & 31)] = (n < nvalid) ? W[(size_t)(k0 + kk) * ld + n] : 0.f; }
    LDS_WAIT(); asm volatile("" ::: "memory");
    const int c = lane & 7;
#pragma unroll
    for (int j = 0; j < 4; ++j) { const int nl = (lane >> 3) + 8 * j; const LAS float* s = scr + (8 * c) * 33 + nl;
        u32x4 o; o.x = pk2(s[0 * 33], s[1 * 33]); o.y = pk2(s[2 * 33], s[3 * 33]); o.z = pk2(s[4 * 33], s[5 * 33]); o.w = pk2(s[6 * 33], s[7 * 33]);
        *(u32x4*)(WT + (size_t)(dstrow0 + nl) * K + k0 + 8 * c) = o; }
    LDS_WAIT(); asm volatile("" ::: "memory");
}
__device__ __forceinline__ int pairmap(int n0, int half) {
    return n0 < half ? ((n0 >> 7) * 256 + (n0 & 127)) : ((((n0 - half) >> 7) * 256) + 128 + ((n0 - half) & 127));
}
__device__ __forceinline__ void p0_prologue(Frame& F) {
    LAS float* scr = (LAS float*)(F.lds + F.wave * 16384);
    const int lane = F.lane;
    for (int r = F.gw; r < 768 + 256; r += F.NGW) {
        if (r < 768) {
            const int l = r / 384, rem = r % 384, dch = rem / 24, e = (rem % 24) * 256 + 4 * lane;
            const float* aw = F.inp(I_ADAW) + (size_t)l * 1024 * 6144 + e; const float* c = F.inp(I_C);
            f32x4 a0 = (f32x4){0.f, 0.f, 0.f, 0.f}, a1 = a0, a2 = a0, a3 = a0;
#pragma unroll 16
            for (int d = dch * 64; d < dch * 64 + 64; ++d) {
                const f32x4 w = *(const f32x4*)(aw + (size_t)d * 6144);
                const float c0 = c[d], c1 = c[1024 + d], c2 = c[2048 + d], c3 = c[3072 + d];
                a0 += w * (c0 / (1.f + __expf(-c0))); a1 += w * (c1 / (1.f + __expf(-c1))); a2 += w * (c2 / (1.f + __expf(-c2))); a3 += w * (c3 / (1.f + __expf(-c3)));
            }
            float* mp = (float*)(F.wsp() + WS_MODP) + (size_t)dch * 49152 + (size_t)(l * 4) * 6144 + e;
            *(f32x4*)mp = a0; *(f32x4*)(mp + 6144) = a1; *(f32x4*)(mp + 2 * 6144) = a2; *(f32x4*)(mp + 3 * 6144) = a3;
        } else {
            const int q = r - 768, i = q / 128, rem = q % 128, cch = rem / 32, kch = rem % 32, c = cch * 64 + lane;
            const float* pe = F.inp(I_PE) + i * 2048; const float* w1 = F.inp(I_CW1) + (size_t)i * 2048 * 256 + c;
            float a = 0.f;
#pragma unroll 16
            for (int kk = kch * 64; kk < kch * 64 + 64; ++kk) a += pe[kk] * w1[(size_t)kk * 256];
            ((float*)(F.wsp() + WS_PETP))[(kch * 2 + i) * 256 + c] = a;
        }
    }
    constexpr int I1 = 16 * 96, I2 = 512, I3 = 16 * 48, I4 = 16 * 40, I5 = 512, I6 = 512, I7 = 32 * 512, I8 = 32 * 256;
    constexpr int NITEMS = I1 + I2 + I3 + I4 + I5 + I6 + I7 + I8;
    for (int it = F.gw; it < NITEMS; it += F.NGW) {
        int r = it;
        if (r < I1) { const int kb = r / 96, nb = r % 96, n0 = nb * 32;
            const int dr = n0 < 1024 ? n0 : 1024 + pairmap(n0 - 1024, 1024);
            transpose_item(F.inp(I_CWIN), 3072, 3072, 1024, (bf16*)(F.wsp() + WS_WIN), dr, kb * 64, n0, scr, lane); continue; } r -= I1;
        if (r < I2) { transpose_item(F.inp(I_CWOUT), 1024, 1024, 1024, (bf16*)(F.wsp() + WS_WOUT), (r % 32) * 32, (r / 32) * 64, (r % 32) * 32, scr, lane); continue; } r -= I2;
        if (r < I3) { transpose_item(F.inp(I_WKV), 1536, 1536, 1024, (bf16*)(F.wsp() + WS_WKV), (r % 48) * 32, (r / 48) * 64, (r % 48) * 32, scr, lane); continue; } r -= I3;
        if (r < I4) { transpose_item(F.inp(I_WQG), 1072, 1072, 1024, (bf16*)(F.wsp() + WS_WQG), (r % 40) * 32, (r / 40) * 64, (r % 40) * 32, scr, lane); continue; } r -= I4;
        if (r < I5) { transpose_item(F.inp(I_WO), 1024, 1024, 1024, (bf16*)(F.wsp() + WS_WO), (r % 32) * 32, (r / 32) * 64, (r % 32) * 32, scr, lane); continue; } r -= I5;
        if (r < I6) { const int sub = r / 128, q = r % 128, i = sub >> 1, hh = sub & 1;
            transpose_item(F.inp(I_CW1) + (size_t)i * 2048 * 256 + (size_t)hh * 1024 * 256, 256, 256, 1024, (bf16*)(F.wsp() + WS_W1C) + (size_t)i * 512 * 1024, hh * 256 + (q % 8) * 32, (q / 8) * 64, (q % 8) * 32, scr, lane); continue; } r -= I6;
        if (r < I7) { const int mi = r / 512, q = r % 512, n0 = (q % 32) * 32;
            transpose_item(F.inp(I_WGU) + (size_t)mi * 1024 * 1024, 1024, 1024, 1024, (bf16*)(F.wsp() + WS_WGU) + (size_t)mi * 1024 * 1024, pairmap(n0, 512), (q / 32) * 64, n0, scr, lane); continue; } r -= I7;
        { const int mi = r / 256, q = r % 256, n0 = (q % 32) * 32;
            transpose_item(F.inp(I_WDN) + (size_t)mi * 512 * 1024, 1024, 1024, 512, (bf16*)(F.wsp() + WS_WDN) + (size_t)mi * 1024 * 512, n0, (q / 32) * 64, n0, scr, lane); }
    }
}
__device__ __forceinline__ f32x4 mod4_partials(const Frame& F, int l, int b, int e) {
    f32x4 s = *(const f32x4*)(F.inp(I_ADAB) + l * 6144 + e);
    const float* mp = (const float*)(F.wsp() + WS_MODP) + (size_t)(l * 4 + b) * 6144 + e;
#pragma unroll
    for (int d = 0; d < 16; ++d) s += *(const f32x4*)(mp + (size_t)d * 49152);
    return s;
}
__device__ __forceinline__ void p1_mod_u0(Frame& F) {
    float* MOD = (float*)(F.wsp() + WS_MOD);
    for (int ch = F.gw; ch < 768; ch += F.NGW) {
        const int idx = ch * 64 + F.lane, lb = idx / 6144, e = idx % 6144;
        float s = F.inp(I_ADAB)[(lb >> 2) * 6144 + e];
        const float* mp = (const float*)(F.wsp() + WS_MODP) + idx;
#pragma unroll
        for (int d = 0; d < 16; ++d) s += mp[(size_t)d * 49152];
        MOD[idx] = s;
    }
    bf16* U = (bf16*)(F.wsp() + WS_U);
    LAS f32x4* msh = (LAS f32x4*)F.lds;
    for (int c0 = blockIdx.x * 64; c0 < T; c0 += gridDim.x * 64) {
        const int b = c0 >> 12;
        __syncthreads();
        { const int t = F.tid, e = 4 * (t & 255) + (t >> 8) * 1024; f32x4 v = mod4_partials(F, 0, b, e); if (t >= 256) v = v + 1.0f; msh[t] = v; }
        __syncthreads();
        f32x4 sh[4], sc[4];
#pragma unroll
        for (int j = 0; j < 4; ++j) { sh[j] = msh[F.lane + 64 * j]; sc[j] = msh[256 + F.lane + 64 * j]; }
        const int m0 = c0 + F.wave * 8;
#pragma unroll 1
        for (int m = m0; m < m0 + 8; m += 2) {
            f32x4 v[2][4];
#pragma unroll
            for (int r = 0; r < 2; ++r)
#pragma unroll
                for (int j = 0; j < 4; ++j) v[r][j] = *(const f32x4*)(F.inp(I_X) + (size_t)(m + r) * DM + 4 * F.lane + 256 * j);
#pragma unroll
            for (int r = 0; r < 2; ++r)
#pragma unroll
                for (int j = 0; j < 4; ++j) st_bf4(U + (size_t)(m + r) * DM + 4 * F.lane + 256 * j, v[r][j] * sc[j] + sh[j]);
        }
    }
}
template <bool PAIR, class AR, class EP>
__device__ __forceinline__ void gemm_wave_tile(const AR& arow, const bf16* Btile, int K, int m0, int nbase, const EP& ep, int lane) {
    const int fr = lane & 15, fq = lane >> 4;
    f32x4 acc[4][4];
#pragma unroll
    for (int i = 0; i < 4; ++i)
#pragma unroll
        for (int j = 0; j < 4; ++j) acc[i][j] = (f32x4){0.f, 0.f, 0.f, 0.f};
    const bf16* ap[4]; const bf16* bp[4];
#pragma unroll
    for (int i = 0; i < 4; ++i) ap[i] = arow(m0 + 16 * i + fr) + 8 * fq;
#pragma unroll
    for (int j = 0; j < 4; ++j) { const int nr = PAIR ? ((j & 1) * 16 + (j >> 1) * 128) : 16 * j; bp[j] = Btile + (size_t)(nr + fr) * K + 8 * fq; }
    for (int k0 = 0; k0 < K; k0 += 32) {
        bf16x8 a[4], b[4];
#pragma unroll
        for (int i = 0; i < 4; ++i) a[i] = *(const bf16x8*)(ap[i] + k0);
#pragma unroll
        for (int j = 0; j < 4; ++j) b[j] = *(const bf16x8*)(bp[j] + k0);
#pragma unroll
        for (int i = 0; i < 4; ++i)
#pragma unroll
            for (int j = 0; j < 4; ++j) acc[i][j] = __builtin_amdgcn_mfma_f32_16x16x32_bf16(b[j], a[i], acc[i][j], 0, 0, 0);
    }
#pragma unroll
    for (int i = 0; i < 4; ++i) {
        const int m = m0 + 16 * i + fr;
        if constexpr (PAIR) {
#pragma unroll
            for (int j = 0; j < 2; ++j) ep.pair(m, nbase + 16 * j + 4 * fq, acc[i][j], acc[i][j + 2]);
        } else {
#pragma unroll
            for (int j = 0; j < 4; ++j) ep(m, nbase + 16 * j + 4 * fq, acc[i][j]);
        }
    }
}
struct ARowPlain { const bf16* A; int K; __device__ __forceinline__ const bf16* operator()(int m) const { return A + (size_t)m * K; } };

struct EpBf16 { bf16* O; int ld; __device__ __forceinline__ void operator()(int m, int n, f32x4 v) const { st_bf4(O + (size_t)m * ld + n, v); }
    __device__ __forceinline__ void op8(int m, int n, f32x4 a, f32x4 b) const { st_bf8(O + (size_t)m * ld + n, a, b); } };
struct EpMulPair { bf16* O; int ld; __device__ __forceinline__ void pair(int m, int ch, f32x4 a, f32x4 b) const { st_bf4(O + (size_t)m * ld + ch, a * b); }
    __device__ __forceinline__ void pair8(int m, int ch, f32x4 a0, f32x4 a1, f32x4 b0, f32x4 b1) const { st_bf8(O + (size_t)m * ld + ch, a0 * b0, a1 * b1); } };
struct EpSiluPair { bf16* O; int ld; __device__ __forceinline__ void pair(int m, int ch, f32x4 a, f32x4 b) const {
    f32x4 s; for (int r = 0; r < 4; ++r) s[r] = silu_f(a[r]) * b[r]; st_bf4(O + (size_t)m * ld + ch, s); } };
__device__ __forceinline__ f32x4 ld_bf4(const bf16* p) { const u32x2 w = *(const u32x2*)p; return (f32x4){bflo(w.x), bfhi(w.x), bflo(w.y), bfhi(w.y)}; }
struct EpRes { const float* base; bf16* out; const float* gmod;
    __device__ __forceinline__ void operator()(int m, int n, f32x4 v) const { const int b = m >> 12; const f32x4 g = *(const f32x4*)(gmod + b * 6144 + n);
        const f32x4 x = *(const f32x4*)(base + (size_t)m * DM + n); st_bf4(out + (size_t)m * DM + n, x * ALPHA + g * v); } };
struct EpResB { bf16* res; const float* gmod;
    __device__ __forceinline__ void operator()(int m, int n, f32x4 v) const { const int b = m >> 12; const f32x4 g = *(const f32x4*)(gmod + b * 6144 + n);
        bf16* p = res + (size_t)m * DM + n; st_bf4(p, ld_bf4(p) * ALPHA + g * v); } };
__device__ __forceinline__ int kfrag_off(int kk, int d) { return ((((kk >> 5) * 4 + (d >> 4)) * 2 + ((d >> 3) & 1)) * 32 + (kk & 31)) * 8 + (d & 7); }
__device__ __forceinline__ int vfrag_off(int kk, int d) { return ((((d >> 5) * 4 + (kk >> 4)) * 2 + ((kk >> 2) & 1)) * 32 + (d & 31)) * 8 + ((((kk >> 3) & 1) << 2) | (kk & 3)); }
struct EpKV { bf16* KV; __device__ __forceinline__ void operator()(int m, int n, f32x4 v) const {
    const int j = n >> 8, hk = (n >> 6) & 3, d = n & 63, b = m >> 12, t = m & 4095;
    bf16* base = KV + (size_t)j * KVBUF_ELEMS + (size_t)(b * 4 + hk) * KVROWS * 64;
    if (j < 2) st_bf4(base + (size_t)t * 64 + d, v);
    else if ((j & 1) == 0) st_bf4(base + (size_t)(t >> 6) * 4096 + kfrag_off(t & 63, d), v);
    else { bf16* tp = base + (size_t)(t >> 6) * 4096;
        for (int r = 0; r < 4; ++r) tp[vfrag_off(t & 63, d + r)] = (bf16)f2bf(v[r]); } }
    __device__ __forceinline__ void op8(int m, int n, f32x4 a, f32x4 c) const {
    const int j = n >> 8, hk = (n >> 6) & 3, d = n & 63, b = m >> 12, t = m & 4095;
    bf16* base = KV + (size_t)j * KVBUF_ELEMS + (size_t)(b * 4 + hk) * KVROWS * 64;
    if (j < 2) st_bf8(base + (size_t)t * 64 + d, a, c);
    else if ((j & 1) == 0) st_bf8(base + (size_t)(t >> 6) * 4096 + kfrag_off(t & 63, d), a, c);
    else { bf16* tp = base + (size_t)(t >> 6) * 4096;
        for (int r = 0; r < 4; ++r) { tp[vfrag_off(t & 63, d + r)] = (bf16)f2bf(a[r]); tp[vfrag_off(t & 63, d + 4 + r)] = (bf16)f2bf(c[r]); } } } };
struct EpQG { bf16* Q; float* GATE; const float* bg; __device__ __forceinline__ void operator()(int m, int n, f32x4 v) const {
    if (n < 1024) st_bf4(Q + (size_t)m * DM + n, v * C2);
    else { for (int r = 0; r < 4; ++r) { const int i = n - 1024 + r; if (i < 48) GATE[(size_t)m * 48 + i] = 1.f / (1.f + __expf(-(v[r] + bg[i]))); } } }
    __device__ __forceinline__ void op8(int m, int n, f32x4 a, f32x4 c) const {
    if (n < 1024) st_bf8(Q + (size_t)m * DM + n, a * C2, c * C2);
    else { (*this)(m, n, a); (*this)(m, n + 4, c); } } };
struct EpF32 { float* O; int ld; __device__ __forceinline__ void operator()(int m, int n, f32x4 v) const { *(f32x4*)(O + (size_t)m * ld + n) = v; } };

template <bool PAIR, class AR, class EP>
__device__ __forceinline__ void gemm_dense(Frame& F, const AR& arow, const bf16* Bt, int K, int nM64, int nN64, int chbase, const EP& ep) {
    const int total = nM64 * nN64;
    for (int it = F.gw; it < total; it += F.NGW) {
        const int ni = it % nN64, mt = it / nN64;
        if constexpr (PAIR) { const int pn = ni >> 2, q = ni & 3;
            gemm_wave_tile<true>(arow, Bt + (size_t)(pn * 256 + q * 32) * K, K, mt * 64, chbase + pn * 128 + q * 32, ep, F.lane);
        } else gemm_wave_tile<false>(arow, Bt + (size_t)(ni * 64) * K, K, mt * 64, chbase + ni * 64, ep, F.lane);
    }
}

namespace pg8 {
#define PG8_LAS __attribute__((address_space(3)))
constexpr int BM = 256, BK = 64, HALF = 128, HTB = HALF * BK * 2, STAGE_BYTES = 8 * HTB, NXCD = 8, WGM = 8;
__device__ __forceinline__ int lds_byte(int r, int c) { const int st = (r >> 4) * 2 + (c >> 5), rr = r & 15, cc = c & 31, ob = rr * 64 + cc * 2; return st * 1024 + (ob ^ (((ob >> 9) & 1) << 5)); }
__device__ __forceinline__ void stage_rc(int b, int& R, int& C) { const int st = b / 1024, sb = b % 1024, swz = sb ^ (((sb >> 9) & 1) << 5); R = (st >> 1) * 16 + swz / 64; C = (st & 1) * 32 + (swz % 64) / 2; }
struct Unit { const char* A; const char* B; int row0, col0, e, pos0, cnt; };
__device__ __forceinline__ bool static_order(int i, int G, int c, int nM, int nN, int& pm, int& pn) {
    const int nwg = nM * nN; const long L = (long)i * G + c; if (L >= nwg) return false;
    int wgid = (int)L; { const int q = nwg / NXCD, r = nwg % NXCD, xcd = wgid % NXCD, off = wgid / NXCD; wgid = (xcd < r ? xcd * (q + 1) : r * (q + 1) + (xcd - r) * q) + off; }
    const int nig = WGM * nN, gid = wgid / nig, fm = gid * WGM, gsz = (nM - fm) < WGM ? (nM - fm) : WGM;
    pm = fm + ((wgid % nig) % gsz); pn = (wgid % nig) / gsz; return true;
}
__device__ __forceinline__ void voff_plain(const int (&R)[2], const int (&C)[2], int K, unsigned (&v)[2][2]) {
#pragma unroll
    for (int h = 0; h < 2; ++h)
#pragma unroll
        for (int i = 0; i < 2; ++i) v[h][i] = (unsigned)((h * HALF + R[i]) * K + C[i]) * 2u;
}
__device__ __forceinline__ int perm32(int rho) { const int n = rho >> 4, i = rho & 15; return 8 * (i >> 2) + 4 * n + (i & 3); }
template <class EP, bool PAIR, bool PERM_ = false> struct EpiWrap {
    static constexpr bool PERM = PERM_;
    EP ep;
    __device__ __forceinline__ void operator()(const f32x4 (&acc)[2][2][4][2], const Unit& u, int wr, int wc, int fr, int fq) const {
#pragma unroll
        for (int ai = 0; ai < 2; ++ai)
#pragma unroll
            for (int m = 0; m < 4; ++m) { const int row = u.row0 + ai * HALF + wr * 64 + m * 16 + fr;
                if constexpr (PERM_) {
                    if constexpr (PAIR) ep.pair8(u, row, u.col0 + wc * 32 + 8 * fq, acc[ai][0][m][0], acc[ai][0][m][1], acc[ai][1][m][0], acc[ai][1][m][1]);
                    else {
#pragma unroll
                        for (int bj = 0; bj < 2; ++bj) ep.op8(u, row, u.col0 + bj * HALF + wc * 32 + 8 * fq, acc[ai][bj][m][0], acc[ai][bj][m][1]); }
                } else if constexpr (PAIR) {
#pragma unroll
                    for (int n = 0; n < 2; ++n) ep.pair(u, row, u.col0 + wc * 32 + 16 * n + 4 * fq, acc[ai][0][m][n], acc[ai][1][m][n]);
                } else {
#pragma unroll
                    for (int bj = 0; bj < 2; ++bj)
#pragma unroll
                        for (int n = 0; n < 2; ++n) ep(u, row, u.col0 + bj * HALF + wc * 32 + 16 * n + 4 * fq, acc[ai][bj][m][n]);
                } }
    }
};
template <class Epi, class Sched, bool ALIGN_EPI, bool GATHER>
__device__ __forceinline__ void gemm_phase(PG8_LAS unsigned char* lds, const int K, const Sched& S, const Epi& E) {
    const int tid = threadIdx.x, wid = __builtin_amdgcn_readfirstlane(tid >> 6), lane = tid & 63, wr = wid >> 2, wc = wid & 3, fr = lane & 15, fq = lane >> 4;
    const int nt = K / BK;
    int R[2], C[2]; unsigned voffB[2]; unsigned vC[2][2], vN[2][2];
#pragma unroll
    for (int i = 0; i < 2; ++i) { stage_rc(tid * 16 + i * 8192, R[i], C[i]); const int Rb = Epi::PERM ? ((R[i] & ~31) | perm32(R[i] & 31)) : R[i]; voffB[i] = (unsigned)(Rb * K + C[i]) * 2u; }
    const size_t kstep = (size_t)(BK * 2);
    const size_t hstep = (size_t)HALF * K * 2;
    const unsigned ldsw = (unsigned)wid * 1024u;
    const int aoff = lds_byte(wr * 64 + fr, fq * 8), boff = lds_byte(wc * 32 + fr, fq * 8);
#define PG8_SA(b, h) (((b) * 2 + (h)) * HTB)
#define PG8_SB(b, h) ((4 + (b) * 2 + (h)) * HTB)
#define PG8_STAGE(bufoff, gbase, voff) do { _Pragma("unroll") for (int _i = 0; _i < 2; ++_i) \
        __builtin_amdgcn_global_load_lds((const unsigned*)((const char*)(gbase) + (voff)[_i]), (PG8_LAS unsigned*)(lds + (bufoff) + ldsw + _i * 8192), 16, 0, 0); } while (0)
#define PG8_LDA(dst, b, h) do { _Pragma("unroll") for (int m = 0; m < 4; ++m) _Pragma("unroll") for (int k = 0; k < 2; ++k) dst[m][k] = *(const PG8_LAS bf16x8*)(lds + PG8_SA(b, h) + aoff + m * 2048 + k * 1024); } while (0)
#define PG8_LDB(dst, b, h) do { _Pragma("unroll") for (int n = 0; n < 2; ++n) _Pragma("unroll") for (int k = 0; k < 2; ++k) dst[n][k] = *(const PG8_LAS bf16x8*)(lds + PG8_SB(b, h) + boff + n * 2048 + k * 1024); } while (0)
#define PG8_MMA(ai, bj, At, Bt) do { __builtin_amdgcn_s_setprio(1); _Pragma("unroll") for (int m = 0; m < 4; ++m) _Pragma("unroll") for (int n = 0; n < 2; ++n) _Pragma("unroll") for (int k = 0; k < 2; ++k) \
        acc[ai][bj][m][n] = __builtin_amdgcn_mfma_f32_16x16x32_bf16(Bt[n][k], At[m][k], acc[ai][bj][m][n], 0, 0, 0); __builtin_amdgcn_s_setprio(0); } while (0)
#define PG8_WAIT_V(n) asm volatile("s_waitcnt vmcnt(" #n ")" ::: "memory")
#define PG8_WAIT_L(n) asm volatile("s_waitcnt lgkmcnt(" #n ")" ::: "memory")
#define PG8_BAR __builtin_amdgcn_s_barrier()
#define PG8_SCHED __builtin_amdgcn_sched_barrier(0)
    Unit cur, nxt; int ui = 0;
    if (!S.next(0, cur)) return;
    S.voff(cur, R, C, K, vC);
    f32x4 acc[2][2][4][2];
#pragma unroll
    for (int a = 0; a < 2; ++a)
#pragma unroll
        for (int b = 0; b < 2; ++b)
#pragma unroll
            for (int m = 0; m < 4; ++m)
#pragma unroll
                for (int n = 0; n < 2; ++n) acc[a][b][m][n] = (f32x4){0.f, 0.f, 0.f, 0.f};
    bf16x8 At[4][2], B0[2][2], B1[2][2];
    const char* cA = cur.A; const char* cB = cur.B;
    PG8_STAGE(PG8_SB(0, 0), cB, voffB); PG8_STAGE(PG8_SB(0, 1), cB + hstep, voffB); PG8_STAGE(PG8_SA(0, 0), cA, vC[0]); PG8_STAGE(PG8_SA(0, 1), cA, vC[1]);
    if (wr == 1) PG8_BAR;
    PG8_WAIT_V(2); PG8_BAR;
    PG8_STAGE(PG8_SB(1, 0), cB + kstep, voffB); PG8_STAGE(PG8_SA(1, 0), cA + kstep, vC[0]); PG8_STAGE(PG8_SB(1, 1), cB + hstep + kstep, voffB);
    PG8_WAIT_V(6); PG8_BAR;
    for (;;) {
        const bool has_next = S.next(ui + 1, nxt);
        const char* nA = has_next ? nxt.A : cA; const char* nB = has_next ? nxt.B : cB;
        if constexpr (GATHER) { if (has_next) S.voff(nxt, R, C, K, vN); else { vN[0][0] = vC[0][0]; vN[0][1] = vC[0][1]; vN[1][0] = vC[1][0]; vN[1][1] = vC[1][1]; } }
        for (int t = 0; t < nt; t += 2) {
            const bool last = (t == nt - 2);
            const char* a1 = cA + (size_t)(t + 1) * kstep;
            const char* a2 = last ? nA : cA + (size_t)(t + 2) * kstep; const char* b2 = last ? nB : cB + (size_t)(t + 2) * kstep;
            const char* a3 = a2 + kstep; const char* b3 = b2 + kstep;
            unsigned v2[2][2];
#pragma unroll
            for (int h = 0; h < 2; ++h)
#pragma unroll
                for (int i = 0; i < 2; ++i) v2[h][i] = (GATHER && last) ? vN[h][i] : vC[h][i];
            PG8_LDB(B0, 0, 0); PG8_LDB(B1, 0, 1); PG8_SCHED; PG8_LDA(At, 0, 0); PG8_STAGE(PG8_SA(1, 1), a1, vC[1]);
            PG8_WAIT_V(8); PG8_WAIT_L(0); PG8_BAR; PG8_MMA(0, 0, At, B0); PG8_MMA(0, 1, At, B1); PG8_BAR; PG8_SCHED;
            PG8_LDA(At, 0, 1); PG8_STAGE(PG8_SB(0, 0), b2, voffB); PG8_STAGE(PG8_SB(0, 1), b2 + hstep, voffB); PG8_STAGE(PG8_SA(0, 0), a2, v2[0]);
            PG8_WAIT_V(8); PG8_WAIT_L(0); PG8_BAR; PG8_MMA(1, 0, At, B0); PG8_MMA(1, 1, At, B1); PG8_BAR; PG8_SCHED;
            PG8_LDB(B0, 1, 0); PG8_LDB(B1, 1, 1); PG8_SCHED; PG8_LDA(At, 1, 0); PG8_STAGE(PG8_SA(0, 1), a2, v2[1]);
            PG8_WAIT_V(8); PG8_WAIT_L(0); PG8_BAR; PG8_MMA(0, 0, At, B0); PG8_MMA(0, 1, At, B1); PG8_BAR; PG8_SCHED;
            PG8_LDA(At, 1, 1); PG8_STAGE(PG8_SB(1, 0), b3, voffB); PG8_STAGE(PG8_SB(1, 1), b3 + hstep, voffB); PG8_STAGE(PG8_SA(1, 0), a3, v2[0]);
            PG8_WAIT_V(8); PG8_WAIT_L(0); PG8_BAR; PG8_MMA(1, 0, At, B0); PG8_MMA(1, 1, At, B1); PG8_BAR; PG8_SCHED;
        }
        if constexpr (ALIGN_EPI) { if (wr == 0) PG8_BAR; }
        E(acc, cur, wr, wc, fr, fq);
        if (!has_next) break;
#pragma unroll
        for (int a = 0; a < 2; ++a)
#pragma unroll
            for (int b = 0; b < 2; ++b)
#pragma unroll
                for (int m = 0; m < 4; ++m)
#pragma unroll
                    for (int n = 0; n < 2; ++n) acc[a][b][m][n] = (f32x4){0.f, 0.f, 0.f, 0.f};
        cur = nxt; cA = nA; cB = nB; ++ui;
        if constexpr (GATHER) { vC[0][0] = vN[0][0]; vC[0][1] = vN[0][1]; vC[1][0] = vN[1][0]; vC[1][1] = vN[1][1]; }
        if constexpr (ALIGN_EPI) { if (wr == 1) PG8_BAR; }
    }
    PG8_WAIT_V(0);
    if constexpr (!ALIGN_EPI) { if (wr == 0) PG8_BAR; }
    PG8_BAR;
#undef PG8_SA
#undef PG8_SB
#undef PG8_STAGE
#undef PG8_LDA
#undef PG8_LDB
#undef PG8_MMA
#undef PG8_WAIT_V
#undef PG8_WAIT_L
#undef PG8_BAR
#undef PG8_SCHED
}
struct SchedDense {
    const char* A0; const char* B0; const char* A1; const char* B1; int nM, nN0, nN1, K, G, c, colmul;
    __device__ __forceinline__ bool next(int i, Unit& u) const {
        int pm, pn; if (!static_order(i, G, c, nM, nN0 + nN1, pm, pn)) return false;
        const int sec = pn >= nN0 ? 1 : 0, pl = pn - (sec ? nN0 : 0);
        u.A = (sec ? A1 : A0) + (size_t)pm * 256 * K * 2; u.B = (sec ? B1 : B0) + (size_t)pl * 256 * K * 2;
        u.row0 = pm * 256; u.col0 = pl * colmul; u.e = sec; u.pos0 = 0; u.cnt = 0; return true;
    }
    __device__ __forceinline__ void voff(const Unit&, const int (&R)[2], const int (&C)[2], int K_, unsigned (&v)[2][2]) const { voff_plain(R, C, K_, v); }
};
}
template <class EP> struct EpU { EP ep; __device__ __forceinline__ void operator()(const pg8::Unit&, int m, int n, f32x4 v) const { ep(m, n, v); }
    __device__ __forceinline__ void op8(const pg8::Unit&, int m, int n, f32x4 a, f32x4 b) const { ep.op8(m, n, a, b); } };
template <class EP> struct EpUP { EP ep; __device__ __forceinline__ void pair(const pg8::Unit&, int m, int ch, f32x4 a, f32x4 b) const { ep.pair(m, ch, a, b); }
    __device__ __forceinline__ void pair8(const pg8::Unit&, int m, int ch, f32x4 a0, f32x4 a1, f32x4 b0, f32x4 b1) const { ep.pair8(m, ch, a0, a1, b0, b1); } };
struct EpG1 { static constexpr bool PERM = true; bf16* BG; bf16* Z;
    __device__ __forceinline__ void operator()(const f32x4 (&acc)[2][2][4][2], const pg8::Unit& u, int wr, int wc, int fr, int fq) const {
        if (u.e == 0) { pg8::EpiWrap<EpU<EpBf16>, false, true> w{{{BG, DM}}}; w(acc, u, wr, wc, fr, fq); }
        else { pg8::Unit u2 = u; u2.col0 = u.col0 >> 1; pg8::EpiWrap<EpUP<EpMulPair>, true, true> w{{{Z, DM}}}; w(acc, u2, wr, wc, fr, fq); }
    } };
struct EpNull { static constexpr bool PERM = false; __device__ __forceinline__ void operator()(const f32x4 (&acc)[2][2][4][2], const pg8::Unit&, int, int, int, int) const {
#pragma unroll
    for (int a = 0; a < 2; ++a)
#pragma unroll
        for (int b = 0; b < 2; ++b)
#pragma unroll
            for (int m = 0; m < 4; ++m)
#pragma unroll
                for (int n = 0; n < 2; ++n) asm volatile("" :: "v"(acc[a][b][m][n])); } };
struct EpKVQG { bf16* KV; bf16* Q; float* GATE; const float* bg;
    __device__ __forceinline__ void operator()(const pg8::Unit& u, int m, int n, f32x4 v) const { if (u.e == 0) { EpKV e{KV}; e(m, n, v); } else { EpQG e{Q, GATE, bg}; e(m, n, v); } }
    __device__ __forceinline__ void op8(const pg8::Unit& u, int m, int n, f32x4 a, f32x4 b) const { if (u.e == 0) { EpKV e{KV}; e.op8(m, n, a, b); } else { EpQG e{Q, GATE, bg}; e.op8(m, n, a, b); } } };

__device__ __forceinline__ void p3_conv(Frame& F) {
    const bf16* BG = (const bf16*)(F.wsp() + WS_BG); const bf16* Z = (const bf16*)(F.wsp() + WS_Z); bf16* A2 = (bf16*)(F.wsp() + WS_A2);
    const float* cw = F.inp(I_CONVW); const float* cb = F.inp(I_CONVB);
    const int gt = F.gw * 64 + F.lane, NT_ = F.NGW * 64;
    for (int it = gt; it < T * 128; it += NT_) {
        const int m = it >> 7, ch = (it & 127) * 8, t = m & 4095;
        const u32x4 bg = *(const u32x4*)(BG + (size_t)m * DM + ch);
        const u32x4 z0 = *(const u32x4*)(Z + (size_t)m * DM + ch);
        u32x4 z1 = (u32x4){0, 0, 0, 0}, z2 = (u32x4){0, 0, 0, 0};
        if (t >= 1) z1 = *(const u32x4*)(Z + (size_t)(m - 1) * DM + ch);
        if (t >= 2) z2 = *(const u32x4*)(Z + (size_t)(m - 2) * DM + ch);
        u32x4 o;
#pragma unroll
        for (int w = 0; w < 4; ++w) {
            const int c = ch + 2 * w;
            const float r0 = bflo(bg[w]) * (cw[c] * bflo(z2[w]) + cw[1024 + c] * bflo(z1[w]) + cw[2048 + c] * bflo(z0[w]) + cb[c]);
            const float r1 = bfhi(bg[w]) * (cw[c + 1] * bfhi(z2[w]) + cw[1024 + c + 1] * bfhi(z1[w]) + cw[2048 + c + 1] * bfhi(z0[w]) + cb[c + 1]);
            o[w] = pk2(r0, r1);
        }
        *(u32x4*)(A2 + (size_t)m * DM + ch) = o;
    }
}

__device__ __forceinline__ void ln_row(f32x4 (&v)[4], const float* g, const float* bb, int lane) {
    float s = 0.f;
#pragma unroll
    for (int j = 0; j < 4; ++j) s += (v[j][0] + v[j][1]) + (v[j][2] + v[j][3]);
    const float mean = wave_sum(s) * (1.f / DM); float s2 = 0.f;
#pragma unroll
    for (int j = 0; j < 4; ++j) { v[j] = v[j] - mean; s2 += (v[j][0] * v[j][0] + v[j][1] * v[j][1]) + (v[j][2] * v[j][2] + v[j][3] * v[j][3]); }
    const float rstd = 1.f / sqrtf(wave_sum(s2) * (1.f / DM) + LN_EPS);
#pragma unroll
    for (int j = 0; j < 4; ++j) { const int col = 4 * lane + 256 * j; v[j] = v[j] * rstd * *(const f32x4*)(g + col) + *(const f32x4*)(bb + col); }
}
template <int L, bool DRY = false>
__device__ __forceinline__ void p_ln_router(Frame& F) {
    bf16* RES = (bf16*)(F.wsp() + WS_XB); bf16* U = (bf16*)(F.wsp() + WS_U);
    bf16* RESO = DRY ? (bf16*)(F.wsp() + WS_Y0) : RES; if (DRY) U = (bf16*)(F.wsp() + WS_H);
    const float* MOD = (const float*)(F.wsp() + WS_MOD) + (size_t)L * 4 * 6144;
    const float* rw = F.inp(I_RW); const float* rb = F.inp(I_RB);
    gu32* cnt = F.ctlp() + CW_CNT + L * 1024;
    unsigned* LIST = (unsigned*)(F.wsp() + WS_LIST) + (size_t)L * NE * T; float* LW = (float*)(F.wsp() + WS_LW) + (size_t)L * NE * T;
    const int lane = F.lane;
    LAS int* ae = (LAS int*)F.lds; LAS float* aw = (LAS float*)(F.lds + 512); LAS int* base = (LAS int*)(F.lds + 1024);
    constexpr int RS = 2064, AST_OFF = 2048, ALO_OFF = AST_OFF + 16 * RS, PST_OFF = ALO_OFF + 16 * RS;
    static_assert(PST_OFF + 8192 <= LDSCTL_OFF, "router LDS map");
    const int r16 = lane & 15, kg = lane >> 4;
    bf16x8 Bh[4], Bl[4];
#pragma unroll
    for (int s_ = 0; s_ < 4; ++s_) { u32x4 hh, ll;
#pragma unroll
        for (int i = 0; i < 4; ++i) { const int k = 128 * F.wave + 32 * s_ + 8 * kg + 2 * i; const float a = rw[(size_t)k * 16 + r16], b_ = rw[(size_t)(k + 1) * 16 + r16];
            const unsigned h = pk2(a, b_); hh[i] = h; ll[i] = pk2(a - bflo(h), b_ - bfhi(h)); }
        Bh[s_] = __builtin_bit_cast(bf16x8, hh); Bl[s_] = __builtin_bit_cast(bf16x8, ll); }
    const int nchunk = T / 64;
    for (int ch = blockIdx.x; ch < nchunk; ch += gridDim.x) {
      const bf16* YB = (const bf16*)(F.wsp() + WS_Y0); const float* XF = F.inp(I_X);
      u32x2 yn[4]; f32x4 xn[4];
#pragma unroll
      for (int j = 0; j < 4; ++j) { const size_t o = (size_t)(ch * 64 + F.wave * 2) * DM + 4 * lane + 256 * j; yn[j] = *(const u32x2*)(YB + o);
          if (L == 0) xn[j] = *(const f32x4*)(XF + o); else xn[j] = ld_bf4(RES + o); }
#pragma unroll 2
      for (int rr = 0; rr < 8; ++rr) {
        const int pass = rr >> 1, sub = rr & 1, lrow = pass * 16 + F.wave * 2 + sub, m = ch * 64 + lrow;
        const int b = m >> 12;
        f32x4 v[4];
#pragma unroll
        for (int j = 0; j < 4; ++j) { const f32x4 g1 = *(const f32x4*)(MOD + b * 6144 + 2 * 1024 + 4 * lane + 256 * j);
            v[j] = xn[j] * ALPHA + g1 * (f32x4){bflo(yn[j].x), bfhi(yn[j].x), bflo(yn[j].y), bfhi(yn[j].y)}; }
        if (rr < 7) {
#pragma unroll
            for (int j = 0; j < 4; ++j) { const size_t o = (size_t)(m + (sub ? 15 : 1)) * DM + 4 * lane + 256 * j; yn[j] = *(const u32x2*)(YB + o);
                if (L == 0) xn[j] = *(const f32x4*)(XF + o); else xn[j] = ld_bf4(RES + o); } }
        ln_row(v, F.inp(I_LNG) + (L * 2 + 0) * DM, F.inp(I_LNB) + (L * 2 + 0) * DM, lane);
        {
            LAS unsigned char* arow = F.lds + AST_OFF + (F.wave * 2 + sub) * RS + lane * 8;
#pragma unroll
            for (int j = 0; j < 4; ++j) { const int col = 4 * lane + 256 * j;
                st_bf4(RESO + (size_t)m * DM + col, v[j]);
                const f32x4 u = v[j] * (*(const f32x4*)(MOD + b * 6144 + 4 * 1024 + col) + 1.0f) + *(const f32x4*)(MOD + b * 6144 + 3 * 1024 + col);
                u32x2 hh, ll; hh.x = pk2(u[0], u[1]); hh.y = pk2(u[2], u[3]);
                ll.x = pk2(u[0] - bflo(hh.x), u[1] - bfhi(hh.x)); ll.y = pk2(u[2] - bflo(hh.y), u[3] - bfhi(hh.y));
                *(u32x2*)(U + (size_t)m * DM + col) = hh;
                *(LAS u32x2*)(arow + j * 512) = hh; *(LAS u32x2*)(arow + 16 * RS + j * 512) = ll; }
        }
        if (sub == 0) continue;
        __syncthreads();
        float lgv;
        {
            f32x4 acc = (f32x4){0.f, 0.f, 0.f, 0.f};
            const LAS unsigned char* ap = F.lds + AST_OFF + r16 * RS + (128 * F.wave + 8 * kg) * 2;
#pragma unroll
            for (int s_ = 0; s_ < 4; ++s_) { const bf16x8 ah = *(const LAS bf16x8*)(ap + s_ * 64), al = *(const LAS bf16x8*)(ap + 16 * RS + s_ * 64);
                acc = __builtin_amdgcn_mfma_f32_16x16x32_bf16(ah, Bh[s_], acc, 0, 0, 0);
                acc = __builtin_amdgcn_mfma_f32_16x16x32_bf16(al, Bh[s_], acc, 0, 0, 0);
                acc = __builtin_amdgcn_mfma_f32_16x16x32_bf16(ah, Bl[s_], acc, 0, 0, 0); }
            *(LAS f32x4*)(F.lds + PST_OFF + ((F.wave * 4 + kg) * 16 + r16) * 16) = acc;
            __syncthreads();
            const int rho = 2 * F.wave + (kg & 1); float sm = 0.f;
#pragma unroll
            for (int x = 0; x < 4; ++x) sm += *(const LAS float*)(F.lds + PST_OFF + ((((kg >> 1) * 4 + x) * 4 + (rho >> 2)) * 16 + r16) * 16 + (rho & 3) * 4);
            lgv = sm + __shfl_xor(sm, 32);
        }
#pragma unroll 1
        for (int sb = 0; sb < 2; ++sb) {
        const int lrow2 = pass * 16 + F.wave * 2 + sb;
        float lg[16];
#pragma unroll
        for (int e = 0; e < 16; ++e) lg[e] = __builtin_bit_cast(float, __builtin_amdgcn_readlane(__builtin_bit_cast(int, lgv), 16 * sb + e));
        float mx = lg[0];
#pragma unroll
        for (int e = 1; e < 16; ++e) mx = fmaxf(mx, lg[e]);
        float aff[16], bi[16]; float sum = 0.f;
#pragma unroll
        for (int e = 0; e < 16; ++e) { aff[e] = __expf(lg[e] - mx); sum += aff[e]; }
        const float inv = 1.f / sum;
#pragma unroll
        for (int e = 0; e < 16; ++e) { aff[e] *= inv; bi[e] = aff[e] + rb[e]; }
        float gs[4];
#pragma unroll
        for (int g = 0; g < 4; ++g) { const float a0 = bi[4 * g], a1 = bi[4 * g + 1], a2 = bi[4 * g + 2], a3 = bi[4 * g + 3];
            const float t1 = fmaxf(a0, a1), t2 = fminf(a0, a1), u1 = fmaxf(a2, a3), u2 = fminf(a2, a3);
            gs[g] = fmaxf(t1, u1) + fmaxf(fminf(t1, u1), fmaxf(t2, u2)); }
        int best = 0; float bv = gs[0];
#pragma unroll
        for (int g = 1; g < 4; ++g) if (gs[g] > bv) { bv = gs[g]; best = g; }
        float cb_[4], ca_[4];
#pragma unroll
        for (int i = 0; i < 4; ++i) { cb_[i] = best == 0 ? bi[i] : best == 1 ? bi[4 + i] : best == 2 ? bi[8 + i] : bi[12 + i];
                                      ca_[i] = best == 0 ? aff[i] : best == 1 ? aff[4 + i] : best == 2 ? aff[8 + i] : aff[12 + i]; }
        int i0 = 0; float b0 = cb_[0];
#pragma unroll
        for (int i = 1; i < 4; ++i) if (cb_[i] > b0) { b0 = cb_[i]; i0 = i; }
        int i1 = -1; float b1 = -3.0e38f;
#pragma unroll
        for (int i = 0; i < 4; ++i) if (i != i0 && cb_[i] > b1) { b1 = cb_[i]; i1 = i; }
        const float w0 = i0 == 0 ? ca_[0] : i0 == 1 ? ca_[1] : i0 == 2 ? ca_[2] : ca_[3];
        const float w1 = i1 == 0 ? ca_[0] : i1 == 1 ? ca_[1] : i1 == 2 ? ca_[2] : ca_[3];
        const float ws_ = 1.f / (w0 + w1);
        if (lane == 0) { ae[2 * lrow2] = best * 4 + i0; ae[2 * lrow2 + 1] = best * 4 + i1; aw[2 * lrow2] = w0 * ws_; aw[2 * lrow2 + 1] = w1 * ws_; }
        }
      }
      __syncthreads();
      if (DRY) continue;
      if (F.tid < NE) { int c = 0; for (int i = 0; i < 128; ++i) c += (ae[i] == F.tid) ? 1 : 0;
          base[F.tid] = c ? (int)__hip_atomic_fetch_add(cnt + F.tid * 64, (unsigned)c, RLX_AGENT) : 0; }
      __syncthreads();
      if (F.tid < 128) { const int e = ae[F.tid]; int rk = 0; for (int i = 0; i < F.tid; ++i) rk += (ae[i] == e) ? 1 : 0;
          const int pos = base[e] + rk; const unsigned m = (unsigned)(ch * 64 + (F.tid >> 1));
          LIST[(size_t)e * T + pos] = m * 2u + (unsigned)(F.tid & 1); LW[(size_t)e * T + pos] = aw[F.tid]; }
      __syncthreads();
    }
}
template <int L, bool DRY = false>
__device__ __forceinline__ void p_ln2(Frame& F) {
    bf16* RES = (bf16*)(F.wsp() + WS_XB); bf16* U = (bf16*)(F.wsp() + WS_U); float* OUT = F.outp();
    bf16* RESO = DRY ? (bf16*)(F.wsp() + WS_R1) : RES; if (DRY) { U = (bf16*)(F.wsp() + WS_H); }
    const bf16* Y0 = (const bf16*)(F.wsp() + WS_Y0); const bf16* Y1 = (const bf16*)(F.wsp() + WS_Y1);
    const float* MOD = (const float*)(F.wsp() + WS_MOD) + (size_t)L * 4 * 6144;
    const float* MODN = (const float*)(F.wsp() + WS_MOD) + (size_t)1 * 4 * 6144;
    const int lane = F.lane;
    for (int m = F.gw; m < T; m += F.NGW) {
        const int b = m >> 12;
        f32x4 v[4];
#pragma unroll
        for (int j = 0; j < 4; ++j) { const int col = 4 * lane + 256 * j;
            const f32x4 x = ld_bf4(RES + (size_t)m * DM + col);
            const u32x2 a = *(const u32x2*)(Y0 + (size_t)m * DM + col), c = *(const u32x2*)(Y1 + (size_t)m * DM + col);
            const f32x4 y = (f32x4){bflo(a.x) + bflo(c.x), bfhi(a.x) + bfhi(c.x), bflo(a.y) + bflo(c.y), bfhi(a.y) + bfhi(c.y)};
            v[j] = x * ALPHA + *(const f32x4*)(MOD + b * 6144 + 5 * 1024 + col) * y; }
        ln_row(v, F.inp(I_LNG) + (L * 2 + 1) * DM, F.inp(I_LNB) + (L * 2 + 1) * DM, lane);
#pragma unroll
        for (int j = 0; j < 4; ++j) { const int col = 4 * lane + 256 * j;
            if (L == 1) *(f32x4*)(OUT + (size_t)m * DM + col) = v[j];
            if (L == 0) { st_bf4(RESO + (size_t)m * DM + col, v[j]);
                st_bf4(U + (size_t)m * DM + col, v[j] * (*(const f32x4*)(MODN + b * 6144 + 1024 + col) + 1.0f) + *(const f32x4*)(MODN + b * 6144 + col)); } }
    }
}

__device__ __forceinline__ void moe_tables(Frame& F, int L) {
    LAS int* tb = (LAS int*)(F.lds + MISC_OFF + 128); LAS int* cn = tb + 20;
    __syncthreads();
    if (F.tid == 0) { int acc = 0; for (int e = 0; e < NE; ++e) { const int c = (int)__hip_atomic_load(F.ctlp() + CW_CNT + L * 1024 + e * 64, RLX_AGENT); cn[e] = c; tb[e] = acc; acc += (c + 255) >> 8; } tb[NE] = acc; }
    __syncthreads();
}
struct ARowMoe { const bf16* U; const unsigned* list; int rbase, cnt;
    __device__ __forceinline__ const bf16* operator()(int r) const { const int pos = r - rbase; const unsigned tok = pos < cnt ? (list[pos] >> 1) : 0u; return U + (size_t)tok * DM; } };
struct EpY { bf16* Y; const unsigned* list; const float* lw; int rbase, cnt;
    __device__ __forceinline__ void operator()(int r, int n, f32x4 v) const { const int pos = r - rbase; if (pos < cnt) { const unsigned ts = list[pos]; const float w = lw[pos];
        st_bf4(Y + (size_t)(ts & 1u) * ((size_t)T * DM) + (size_t)(ts >> 1) * DM + n, v * w); } } };
template <int L>
__device__ __forceinline__ void p_moe_gu(Frame& F) {
    moe_tables(F, L);
    LAS int* tb = (LAS int*)(F.lds + MISC_OFF + 128); LAS int* cn = tb + 20;
    const unsigned* LIST = (const unsigned*)(F.wsp() + WS_LIST) + (size_t)L * NE * T;
    const int total = tb[NE] * 4 * 16;
    for (int it = F.gw; it < total; it += F.NGW) {
        const int ni = it & 15, mt = it >> 4; int e = 0; while (tb[e + 1] * 4 <= mt) ++e;
        const ARowMoe ar{(const bf16*)(F.wsp() + WS_U), LIST + (size_t)e * T, tb[e] * 256, cn[e]};
        const EpSiluPair ep{(bf16*)(F.wsp() + WS_H), FF};
        const int pn = ni >> 2, q = ni & 3;
        gemm_wave_tile<true>(ar, (const bf16*)(F.wsp() + WS_WGU) + (size_t)(L * NE + e) * 1024 * 1024 + (size_t)(pn * 256 + q * 32) * 1024, 1024, mt * 64, pn * 128 + q * 32, ep, F.lane);
    }
}
template <int L>
__device__ __forceinline__ void p_moe_down(Frame& F) {
    moe_tables(F, L);
    LAS int* tb = (LAS int*)(F.lds + MISC_OFF + 128); LAS int* cn = tb + 20;
    const unsigned* LIST = (const unsigned*)(F.wsp() + WS_LIST) + (size_t)L * NE * T; const float* LW = (const float*)(F.wsp() + WS_LW) + (size_t)L * NE * T;
    const int total = tb[NE] * 4 * 16;
    for (int it = F.gw; it < total; it += F.NGW) {
        const int ni = it & 15, mt = it >> 4; int e = 0; while (tb[e + 1] * 4 <= mt) ++e;
        const ARowPlain ar{(const bf16*)(F.wsp() + WS_H), FF};
        const EpY ep{(bf16*)(F.wsp() + WS_Y0), LIST + (size_t)e * T, LW + (size_t)e * T, tb[e] * 256, cn[e]};
        gemm_wave_tile<false>(ar, (const bf16*)(F.wsp() + WS_WDN) + (size_t)(L * NE + e) * 1024 * 512 + (size_t)(ni * 64) * 512, 512, mt * 64, ni * 64, ep, F.lane);
    }
}

struct ARowCmp { const bf16* KVi; __device__ __forceinline__ const bf16* operator()(int R) const { return KVi + ((size_t)(R >> 8) * KVROWS + (size_t)(R & 255) * 16) * 64; } };
__device__ __forceinline__ float gelu_tanh(float x) { const float u = 0.7978845608028654f * (x + 0.044715f * x * x * x); const float e = __expf(2.f * u); const float th = 1.f - 2.f / (e + 1.f); return 0.5f * x * (1.f + th); }
__device__ __forceinline__ void p_cmp_finish(Frame& F) {
    LAS float* w2s = (LAS float*)F.lds;
    LAS float* hd = (LAS float*)(F.lds + 65536 + F.wave * 4096);
    const float* TB = (const float*)(F.wsp() + WS_TB); const float* PETP = (const float*)(F.wsp() + WS_PETP);
    const int lane = F.lane;
    for (int base = blockIdx.x * 32; base < 2 * 16 * 256; base += gridDim.x * 32) {
        const int i = base >> 12;
        __syncthreads();
        for (int u = F.tid; u < 4096; u += 512) *(LAS f32x4*)(w2s + 4 * u) = *(const f32x4*)(F.inp(I_CW2) + (size_t)i * 256 * 64 + 4 * u);
        const int it0 = base + F.wave * 4, bh = (it0 >> 8) & 15, n0 = it0 & 255, c = 4 * lane;
        f32x4 pe = *(const f32x4*)(F.inp(I_CB1) + i * 256 + c);
#pragma unroll
        for (int k = 0; k < 32; ++k) pe += *(const f32x4*)(PETP + (k * 2 + i) * 256 + c);
#pragma unroll
        for (int r = 0; r < 4; ++r) { const int n = n0 + r;
            f32x4 h = (f32x4){0.f, 0.f, 0.f, 0.f};
            if (n < 255) { const float* r0 = TB + ((size_t)i * 4096 + bh * 256 + n) * 512; h = *(const f32x4*)(r0 + c) + *(const f32x4*)(r0 + 512 + 256 + c) + pe; }
#pragma unroll
            for (int q = 0; q < 4; ++q) hd[(c + q) * 4 + r] = gelu_tanh(h[q]); }
        __syncthreads();
        const float b2 = F.inp(I_CB2)[i * 64 + lane];
        float a0 = b2, a1 = b2, a2 = b2, a3 = b2;
#pragma unroll 8
        for (int cc = 0; cc < 256; ++cc) { const float w = w2s[cc * 64 + lane]; const f32x4 h4 = *(const LAS f32x4*)(hd + cc * 4);
            a0 += h4[0] * w; a1 += h4[1] * w; a2 += h4[2] * w; a3 += h4[3] * w; }
        const float av[4] = {a0, a1, a2, a3};
#pragma unroll
        for (int r = 0; r < 4; ++r) { const int n = n0 + r;
            bf16* dst = (bf16*)(F.wsp() + (i ? WS_VC : WS_KC)) + (size_t)bh * 256 * 64 + (size_t)(n >> 6) * 4096 + (i ? vfrag_off(n & 63, lane) : kfrag_off(n & 63, lane));
            *dst = (n == 255) ? (bf16)0 : (bf16)f2bf(av[r]); }
    }
}

__device__ __forceinline__ void score_tile(const bf16* krow, const LAS float* qs, float (&s)[4]) {
    s[0] = s[1] = s[2] = s[3] = 0.f;
#pragma unroll
    for (int c = 0; c < 8; ++c) { const u32x4 kv = *(const u32x4*)(krow + 8 * c);
#pragma unroll
        for (int w = 0; w < 4; ++w) { const f32x4 qa = *(const LAS f32x4*)(qs + (8 * c + 2 * w) * 4), qb = *(const LAS f32x4*)(qs + (8 * c + 2 * w + 1) * 4);
            const float ka = bflo(kv[w]), kb = bfhi(kv[w]);
            s[0] += ka * qa[0] + kb * qb[0]; s[1] += ka * qa[1] + kb * qb[1]; s[2] += ka * qa[2] + kb * qb[2]; s[3] += ka * qa[3] + kb * qb[3]; } }
}
__device__ __forceinline__ void attend_tile(const bf16* Kt, const bf16* Vt, bool valid, const LAS float* qs, LAS float* pbuf, float (&mr)[4], float (&l)[4], float (&o)[4], int lane) {
    float s[4]; score_tile(Kt + (size_t)lane * 64, qs, s);
    f32x4 p4;
#pragma unroll
    for (int g = 0; g < 4; ++g) {
        const float sg = valid ? s[g] : -INFINITY; const float tm = wave_max(sg); const float mn = fmaxf(mr[g], tm);
        const float mref = (mn == -INFINITY) ? 0.f : mn;
        const float alpha = __builtin_amdgcn_exp2f(mr[g] - mref); const float p = valid ? __builtin_amdgcn_exp2f(sg - mref) : 0.f;
        l[g] = l[g] * alpha + wave_sum(p); o[g] *= alpha; mr[g] = mn; p4[g] = p;
    }
    LDS_WAIT(); asm volatile("" ::: "memory");
    *(LAS f32x4*)(pbuf + lane * 4) = p4;
    LDS_WAIT(); asm volatile("" ::: "memory");
#pragma unroll 8
    for (int k = 0; k < 64; ++k) { const f32x4 pk = *(const LAS f32x4*)(pbuf + k * 4); const float vv = bf2f(Vt[(size_t)k * 64 + lane]);
        o[0] += pk[0] * vv; o[1] += pk[1] * vv; o[2] += pk[2] * vv; o[3] += pk[3] * vv; }
    LDS_WAIT(); asm volatile("" ::: "memory");
}
__device__ __forceinline__ void p_attn_simple(Frame& F) {
    LAS float* qs = (LAS float*)(F.lds + F.wave * 16384);
    LAS float* pbuf = qs + 256;
    LAS float* psum = pbuf + 1024;
    const bf16* Q = (const bf16*)(F.wsp() + WS_Q); const float* GATE = (const float*)(F.wsp() + WS_GATE); bf16* O = (bf16*)(F.wsp() + WS_O);
    const bf16* KVb = (const bf16*)(F.wsp() + WS_KV);
    const int lane = F.lane;
    for (int it = F.gw; it < 16 * SEQ; it += F.NGW) {
        const int bh = it & 15, t = it >> 4, b = bh >> 2, hk = bh & 3, m = b * SEQ + t;
        LDS_WAIT(); asm volatile("" ::: "memory");
        { f32x4 q4; for (int g = 0; g < 4; ++g) q4[g] = bf2f(Q[(size_t)m * DM + (hk * 4 + g) * 64 + lane]); *(LAS f32x4*)(qs + lane * 4) = q4; }
        LDS_WAIT(); asm volatile("" ::: "memory");
        const bf16* KC = (const bf16*)(F.wsp() + WS_KC) + (size_t)bh * 256 * 64; const bf16* VC = (const bf16*)(F.wsp() + WS_VC) + (size_t)bh * 256 * 64;
        const int nv = t >= 31 ? ((t - 31) >> 4) + 1 : 0;
        float sc[4][4];
#pragma unroll
        for (int i = 0; i < 4; ++i) { float s[4] = {0.f, 0.f, 0.f, 0.f}; if (64 * i < nv) score_tile(KC + (size_t)(64 * i + lane) * 64, qs, s);
            const bool v = (64 * i + lane) < nv;
#pragma unroll
            for (int g = 0; g < 4; ++g) sc[i][g] = v ? s[g] : -INFINITY; }
        float oc[4];
#pragma unroll
        for (int g = 0; g < 4; ++g) {
            const float mx = wave_max(fmaxf(fmaxf(sc[0][g], sc[1][g]), fmaxf(sc[2][g], sc[3][g]))); const float mref = (mx == -INFINITY) ? 0.f : mx;
            float e[4]; float ls = 0.f;
#pragma unroll
            for (int i = 0; i < 4; ++i) { e[i] = __builtin_amdgcn_exp2f(sc[i][g] - mref); ls += e[i]; }
            const float inv = 1.f / fmaxf(wave_sum(ls), 1e-30f);
#pragma unroll
            for (int i = 0; i < 4; ++i) sc[i][g] = e[i] * inv;
        }
#pragma unroll
        for (int i = 0; i < 4; ++i) { *(LAS f32x4*)(pbuf + (64 * i + lane) * 4) = (f32x4){sc[i][0], sc[i][1], sc[i][2], sc[i][3]};
            psum[64 * i + lane + 1] = (sc[i][0] + sc[i][1]) + (sc[i][2] + sc[i][3]); }
        if (lane == 0) psum[0] = 0.f;
        LDS_WAIT(); asm volatile("" ::: "memory");
        oc[0] = oc[1] = oc[2] = oc[3] = 0.f;
        for (int n = 0; n < nv; ++n) { const f32x4 pk = *(const LAS f32x4*)(pbuf + n * 4); const float vv = bf2f(VC[(size_t)n * 64 + lane]);
            oc[0] += pk[0] * vv; oc[1] += pk[1] * vv; oc[2] += pk[2] * vv; oc[3] += pk[3] * vv; }
        const float imp = 0.5f * psum[4 * lane] + psum[4 * lane + 1] + psum[4 * lane + 2] + psum[4 * lane + 3] + 0.5f * psum[4 * lane + 4];
        const int cur = t >> 6;
        const bool allowed = lane <= cur, forced = allowed && (lane == 0 || lane == cur || lane == cur - 1);
        const float score = forced ? 1e9f : (allowed ? imp : -1e30f);
        int rank = 0;
#pragma unroll
        for (int j = 0; j < 64; ++j) { const float sj = __shfl(score, j); rank += (sj > score || (sj == score && j < lane)) ? 1 : 0; }
        const unsigned long long mask = __ballot(rank < 16 && score > -0.5e30f);
        LDS_WAIT(); asm volatile("" ::: "memory");
        const bf16* KS = KVb + 2 * KVBUF_ELEMS + (size_t)bh * KVROWS * 64; const bf16* VS = KVb + 3 * KVBUF_ELEMS + (size_t)bh * KVROWS * 64;
        float ms[4] = {-INFINITY, -INFINITY, -INFINITY, -INFINITY}, ls[4] = {0.f, 0.f, 0.f, 0.f}, os[4] = {0.f, 0.f, 0.f, 0.f};
        for (unsigned long long mk = mask; mk; mk &= mk - 1) { const int j = __builtin_ctzll(mk);
            attend_tile(KS + (size_t)j * 64 * 64, VS + (size_t)j * 64 * 64, (64 * j + lane) <= t, qs, pbuf, ms, ls, os, lane); }
        const bf16* KW = KVb + 4 * KVBUF_ELEMS + (size_t)bh * KVROWS * 64; const bf16* VW = KVb + 5 * KVBUF_ELEMS + (size_t)bh * KVROWS * 64;
        float mw[4] = {-INFINITY, -INFINITY, -INFINITY, -INFINITY}, lw[4] = {0.f, 0.f, 0.f, 0.f}, ow[4] = {0.f, 0.f, 0.f, 0.f};
        const int lo = t - 511 > 0 ? t - 511 : 0;
        for (int j = lo >> 6; j <= (t >> 6); ++j) { const int pos = 64 * j + lane;
            attend_tile(KW + (size_t)j * 64 * 64, VW + (size_t)j * 64 * 64, pos >= lo && pos <= t, qs, pbuf, mw, lw, ow, lane); }
#pragma unroll
        for (int g = 0; g < 4; ++g) { const float* gp = GATE + (size_t)m * 48 + (hk * 4 + g) * 3;
            const float o = gp[0] * oc[g] + gp[1] * os[g] / fmaxf(ls[g], 1e-30f) + gp[2] * ow[g] / fmaxf(lw[g], 1e-30f);
            O[(size_t)m * DM + (hk * 4 + g) * 64 + lane] = (bf16)f2bf(o); }
    }
}

struct SchedCmp { const char* KV; const char* W1C; int G, c;
    __device__ __forceinline__ bool next(int it, pg8::Unit& u) const { const int L = it * G + c; if (c < 0 || L >= 64) return false;
        const int i = L >> 5, pm = (L >> 1) & 15, pn = L & 1;
        u.A = KV + ((size_t)i * KVBUF_ELEMS + (size_t)pm * KVROWS * 64) * 2; u.B = W1C + ((size_t)i * 512 * 1024 + (size_t)pn * 256 * 1024) * 2;
        u.row0 = i * 4096 + pm * 256; u.col0 = pn * 256; u.e = i; u.pos0 = 0; u.cnt = 0; return true; }
    __device__ __forceinline__ void voff(const pg8::Unit&, const int (&R)[2], const int (&C)[2], int K_, unsigned (&v)[2][2]) const { pg8::voff_plain(R, C, K_, v); }
};
struct SchedKVQG { const char* A0; const char* B0; const char* A1; const char* B1; int G, c, Lbase, Lend;
    __device__ __forceinline__ bool next(int it, pg8::Unit& u) const { const int L = Lbase + it * G + c; if (c < 0 || L >= Lend) return false;
        const int sec = L >= 384 ? 1 : 0, l = sec ? L - 384 : L, nn = sec ? 5 : 6, pm = l / nn, pn = l % nn;
        u.A = (sec ? A1 : A0) + (size_t)pm * 256 * DM * 2; u.B = (sec ? B1 : B0) + (size_t)pn * 256 * DM * 2;
        u.row0 = pm * 256; u.col0 = pn * 256; u.e = sec; u.pos0 = 0; u.cnt = 0; return true; }
    __device__ __forceinline__ void voff(const pg8::Unit&, const int (&R)[2], const int (&C)[2], int K_, unsigned (&v)[2][2]) const { pg8::voff_plain(R, C, K_, v); }
};
struct SchedMoe { LAS int* tb; LAS int* cn; const unsigned* LIST; const char* Abase; const char* Bbase; size_t bstride; int K, nN, colmul, G, c; bool gather; int Lbase, Lend;
    __device__ __forceinline__ bool next(int it, pg8::Unit& u) const { const int L = Lbase + it * G + c; if (c < 0 || L >= Lend) return false;
        const int mt = L / nN, pn = L % nN; int e = 0; while (tb[e + 1] <= mt) ++e;
        u.A = gather ? Abase : Abase + (size_t)mt * 256 * K * 2; u.B = Bbase + (size_t)e * bstride + (size_t)pn * 256 * K * 2;
        u.row0 = mt * 256; u.col0 = pn * colmul; u.e = e; u.pos0 = (mt - tb[e]) * 256; u.cnt = cn[e]; return true; }
    __device__ __forceinline__ void voff(const pg8::Unit& u, const int (&R)[2], const int (&C)[2], int K_, unsigned (&v)[2][2]) const {
        if (!gather) { pg8::voff_plain(R, C, K_, v); return; }
        const unsigned* le = LIST + (size_t)u.e * T; unsigned tk[2][2];
#pragma unroll
        for (int h = 0; h < 2; ++h)
#pragma unroll
            for (int i = 0; i < 2; ++i) { const int pos = u.pos0 + h * 128 + R[i]; tk[h][i] = le[pos < u.cnt ? pos : u.cnt - 1]; }
#pragma unroll
        for (int h = 0; h < 2; ++h)
#pragma unroll
            for (int i = 0; i < 2; ++i) v[h][i] = ((tk[h][i] >> 1) * (unsigned)K_ + (unsigned)C[i]) * 2u;
    }
};
struct EpHU { bf16* H; __device__ __forceinline__ void pair(const pg8::Unit&, int r, int ch, f32x4 a, f32x4 b) const {
    f32x4 s; for (int q = 0; q < 4; ++q) s[q] = silu_f(a[q]) * b[q]; st_bf4(H + (size_t)r * FF + ch, s); }
    __device__ __forceinline__ void pair8(const pg8::Unit&, int r, int ch, f32x4 a0, f32x4 a1, f32x4 b0, f32x4 b1) const {
    f32x4 s0, s1; for (int q = 0; q < 4; ++q) { s0[q] = silu_f(a0[q]) * b0[q]; s1[q] = silu_f(a1[q]) * b1[q]; } st_bf8(H + (size_t)r * FF + ch, s0, s1); } };
struct EpYU { bf16* Y; const unsigned* LIST; const float* LW;
    __device__ __forceinline__ void operator()(const pg8::Unit& u, int r, int n, f32x4 v) const { const int pos = u.pos0 + (r - u.row0);
        if (pos < u.cnt) { const unsigned ts = LIST[(size_t)u.e * T + pos]; const float w = LW[(size_t)u.e * T + pos];
            st_bf4(Y + (size_t)(ts & 1u) * ((size_t)T * DM) + (size_t)(ts >> 1) * DM + n, v * w); } }
    __device__ __forceinline__ void op8(const pg8::Unit& u, int r, int n, f32x4 a, f32x4 b) const { const int pos = u.pos0 + (r - u.row0);
        if (pos < u.cnt) { const unsigned ts = LIST[(size_t)u.e * T + pos]; const float w = LW[(size_t)u.e * T + pos];
            st_bf8(Y + (size_t)(ts & 1u) * ((size_t)T * DM) + (size_t)(ts >> 1) * DM + n, a * w, b * w); } } };
struct EpYUAll { static constexpr bool PERM = true; EpYU ep;
    __device__ __forceinline__ void operator()(const f32x4 (&acc)[2][2][4][2], const pg8::Unit& u, int wr, int wc, int fr, int fq) const {
        unsigned ts[2][4]; float w[2][4];
        const unsigned* le = ep.LIST + (size_t)u.e * T; const float* lw = ep.LW + (size_t)u.e * T;
#pragma unroll
        for (int ai = 0; ai < 2; ++ai)
#pragma unroll
            for (int m = 0; m < 4; ++m) { const int pos = u.pos0 + ai * pg8::HALF + wr * 64 + m * 16 + fr; const int pc = pos < u.cnt ? pos : u.cnt - 1;
                const unsigned t_ = le[pc]; ts[ai][m] = pos < u.cnt ? t_ : 0xFFFFFFFFu; w[ai][m] = lw[pc]; }
#pragma unroll
        for (int ai = 0; ai < 2; ++ai)
#pragma unroll
            for (int m = 0; m < 4; ++m) if (ts[ai][m] != 0xFFFFFFFFu) {
                bf16* yr = ep.Y + (size_t)(ts[ai][m] & 1u) * ((size_t)T * DM) + (size_t)(ts[ai][m] >> 1) * DM + u.col0 + wc * 32 + 8 * fq;
#pragma unroll
                for (int bj = 0; bj < 2; ++bj) st_bf8(yr + bj * pg8::HALF, acc[ai][bj][m][0] * w[ai][m], acc[ai][bj][m][1] * w[ai][m]); }
    } };
template <int L>
__device__ __forceinline__ void p_moe(Frame& F, const XcdBarrier& bar, bool with_barriers) {
    moe_tables(F, L);
    LAS int* tb = (LAS int*)(F.lds + MISC_OFF + 128); LAS int* cn = tb + 20;
    const int G = gridDim.x, bx = blockIdx.x, vcu = (G % 8 == 0) ? (bx % 8) * (G / 8) + bx / 8 : bx;
    const int nt = tb[NE], n128 = nt < 128 ? nt : 128, Wg = 4 * (nt - n128) < G / 2 ? 4 * (nt - n128) : G / 2;
    const int D2 = (4 * n128 < 2 * (G - Wg)) ? 4 * n128 : 2 * (G - Wg);
#pragma unroll 1
    for (int part = 1; part <= 3; ++part) {
        int gc = -1, gG = 1, gb = 0, ge = 0, dc = -1, dG = 1, db = 0, de = 0;
        if (part == 1) { gc = vcu; gG = G; gb = 0; ge = 4 * n128; }
        else if (part == 2) { if (vcu < Wg) { gc = vcu; gG = Wg; gb = 4 * n128; ge = 4 * nt; } else { dc = vcu - Wg; dG = G - Wg; db = 0; de = D2; } }
        else { dc = vcu; dG = G; db = D2; de = 4 * nt; }
        {
            const SchedMoe S{tb, cn, (const unsigned*)(F.wsp() + WS_LIST) + (size_t)L * NE * T, (const char*)(F.wsp() + WS_U), (const char*)(F.wsp() + WS_WGU) + (size_t)L * NE * 1024 * 1024 * 2, (size_t)1024 * 1024 * 2, 1024, 4, 128, gG, gc, true, gb, ge};
            typedef pg8::EpiWrap<EpHU, true, true> E_;
            pg8::gemm_phase<E_, SchedMoe, true, true>(F.lds, 1024, S, E_{{(bf16*)(F.wsp() + WS_H)}});
        }
        {
            const SchedMoe S{tb, cn, nullptr, (const char*)(F.wsp() + WS_H), (const char*)(F.wsp() + WS_WDN) + (size_t)L * NE * 1024 * 512 * 2, (size_t)1024 * 512 * 2, 512, 4, 256, dG, dc, false, db, de};
            typedef EpYUAll E_;
            pg8::gemm_phase<E_, SchedMoe, true, false>(F.lds, 512, S, E_{{(bf16*)(F.wsp() + WS_Y0), (const unsigned*)(F.wsp() + WS_LIST) + (size_t)L * NE * T, (const float*)(F.wsp() + WS_LW) + (size_t)L * NE * T}});
        }
        if (part < 3 && with_barriers) xcd_barrier(bar);
    }
}
typedef float f32x16 __attribute__((ext_vector_type(16)));
#define MFMA32(a, b, c) __builtin_amdgcn_mfma_f32_32x32x16_bf16(a, b, c, 0, 0, 0)
constexpr size_t WS_MASK = WS_GATE + 3 * MiB;
constexpr int STG_STRIDE = 68, STG_BYTES = 32 * STG_STRIDE * 4;
__device__ __forceinline__ int crow(int r, int hi) { return (r & 3) + 8 * (r >> 2) + 4 * hi; }
__device__ __forceinline__ unsigned cvtpk(float lo, float hi) { f32x2v v = {lo, hi}; bf16x2_t b = __builtin_convertvector(v, bf16x2_t); return __builtin_bit_cast(unsigned, b); }
__device__ __forceinline__ float partner32(float x, int hi) { auto rr = __builtin_amdgcn_permlane32_swap(__builtin_bit_cast(unsigned, x), __builtin_bit_cast(unsigned, x), false, false);
    return __builtin_bit_cast(float, hi ? rr[0] : rr[1]); }
__device__ __forceinline__ float max3f(float a, float b, float c) { float r; asm("v_max3_f32 %0, %1, %2, %3" : "=v"(r) : "v"(a), "v"(b), "v"(c)); return r; }
__device__ __forceinline__ float max2f(float a, float b) { float r; asm("v_max_f32_e32 %0, %1, %2" : "=v"(r) : "v"(a), "v"(b)); return r; }
__device__ __forceinline__ float rowmax32(f32x16& p0, f32x16& p1, int hi) {
    asm volatile("s_nop 15\n\ts_nop 7" : "+v"(p0), "+v"(p1));
    float a = max3f(p0[0], p0[1], p1[0]), b = max3f(p0[2], p0[3], p1[1]); a = max3f(a, p1[2], p1[3]);
#pragma unroll
    for (int r = 4; r < 16; r += 4) { a = max3f(a, p0[r], p0[r + 1]); b = max3f(b, p0[r + 2], p0[r + 3]); a = max3f(a, p1[r], p1[r + 1]); b = max3f(b, p1[r + 2], p1[r + 3]); }
    const float m = max2f(a, b);
    return max2f(m, partner32(m, hi));
}
typedef __amdgpu_buffer_rsrc_t rsrc_t;
__device__ __forceinline__ rsrc_t make_rsrc(const void* base, unsigned bytes) { return __builtin_amdgcn_make_buffer_rsrc((void*)base, 0, (int)bytes, 0x00020000); }
__device__ __forceinline__ void load_frag8(bf16x8 (&f)[8], rsrc_t rs, unsigned vo, unsigned so) {
#pragma unroll
    for (int i = 0; i < 8; ++i) f[i] = __builtin_bit_cast(bf16x8, __builtin_amdgcn_raw_buffer_load_b128(rs, vo + i * 1024, so, 0));
}
__device__ __forceinline__ void qk_tile(f32x16& p0, f32x16& p1, const bf16x8 (&kf)[8], const LAS bf16x8* qs, const float cinit) {
    bf16x8 qr[4];
#pragma unroll
    for (int d0 = 0; d0 < 4; ++d0) qr[d0] = qs[d0 * 64];
    f32x16 c;
#pragma unroll
    for (int r = 0; r < 16; ++r) c[r] = cinit;
    p0 = MFMA32(kf[0], qr[0], c); p1 = MFMA32(kf[4], qr[0], c);
#pragma unroll
    for (int d0 = 1; d0 < 4; ++d0) { p0 = MFMA32(kf[d0], qr[d0], p0); p1 = MFMA32(kf[4 + d0], qr[d0], p1); }
}
__device__ __forceinline__ void qk_tile_lo(f32x16& p0, f32x16& p1, rsrc_t rs, unsigned vo, unsigned so, const LAS bf16x8* qs, const float cinit) {
    bf16x8 qr[4];
#pragma unroll
    for (int d0 = 0; d0 < 4; ++d0) qr[d0] = qs[d0 * 64];
#pragma unroll
    for (int r = 0; r < 16; ++r) { p0[r] = cinit; p1[r] = cinit; }
    { bf16x8 kf[4];
#pragma unroll
      for (int d0 = 0; d0 < 4; ++d0) kf[d0] = __builtin_bit_cast(bf16x8, __builtin_amdgcn_raw_buffer_load_b128(rs, vo + d0 * 1024, so, 0));
#pragma unroll
      for (int d0 = 0; d0 < 4; ++d0) p0 = MFMA32(kf[d0], qr[d0], p0); }
    asm volatile("" : "+v"(p0) :: "memory");
    { bf16x8 kf[4];
#pragma unroll
      for (int d0 = 0; d0 < 4; ++d0) kf[d0] = __builtin_bit_cast(bf16x8, __builtin_amdgcn_raw_buffer_load_b128(rs, vo + (4 + d0) * 1024, so, 0));
#pragma unroll
      for (int d0 = 0; d0 < 4; ++d0) p1 = MFMA32(kf[d0], qr[d0], p1); }
}
__device__ __forceinline__ void mask_tile(f32x16& p0, f32x16& p1, int lo, int lim, int hi) {
#pragma unroll
    for (int r = 0; r < 16; ++r) { const int k0 = crow(r, hi);
        if (!(k0 > lo && k0 <= lim)) p0[r] = -INFINITY;
        if (!(k0 + 32 > lo && k0 + 32 <= lim)) p1[r] = -INFINITY; }
}
__device__ __forceinline__ void pack_p(bf16x8 (&pa)[4], const f32x16& p0, const f32x16& p1) {
    u32x4 w0, w1, w2, w3;
#pragma unroll
    for (int q = 0; q < 4; ++q) { w0[q] = cvtpk(p0[2 * q], p0[2 * q + 1]); w1[q] = cvtpk(p0[8 + 2 * q], p0[9 + 2 * q]);
                                  w2[q] = cvtpk(p1[2 * q], p1[2 * q + 1]); w3[q] = cvtpk(p1[8 + 2 * q], p1[9 + 2 * q]); }
    pa[0] = __builtin_bit_cast(bf16x8, w0); pa[1] = __builtin_bit_cast(bf16x8, w1); pa[2] = __builtin_bit_cast(bf16x8, w2); pa[3] = __builtin_bit_cast(bf16x8, w3);
}
__device__ __forceinline__ void pv_tile(f32x16& o0, f32x16& o1, const bf16x8 (&pa)[4], const bf16x8 (&vf)[8]) {
#pragma unroll
    for (int ks = 0; ks < 4; ++ks) { o0 = MFMA32(pa[ks], vf[ks], o0); o1 = MFMA32(pa[ks], vf[4 + ks], o1); }
}
struct Sm { float mhat, l; f32x16 o0, o1, ol; };
__device__ __forceinline__ void sm_init(Sm& st) { st.mhat = 0.f; st.l = 0.f;
#pragma unroll
    for (int r = 0; r < 16; ++r) { st.o0[r] = 0.f; st.o1[r] = 0.f; st.ol[r] = 0.f; } }
__device__ __forceinline__ void sm_tile(Sm& st, f32x16& s0, f32x16& s1, bool first, const bf16x8 (&vf)[8], LAS float* wsf, int r32, int hi) {
    const float rm = rowmax32(s0, s1, hi);
    const bool need = first || (__any(rm > 8.0f) != 0);
    if (need) {
        const float dl = first ? ((rm == -INFINITY) ? 0.f : rm) : fmaxf(rm, 0.f);
        st.mhat += dl;
#pragma unroll
        for (int r = 0; r < 16; ++r) { s0[r] -= dl; s1[r] -= dl; }
        if (!first) {
            const float f = __builtin_amdgcn_exp2f(-dl);
            LDS_WAIT(); asm volatile("" ::: "memory");
            if (hi == 0) wsf[r32] = f;
            LDS_WAIT(); asm volatile("" ::: "memory");
#pragma unroll
            for (int G = 0; G < 4; ++G) { const f32x4 ff = *(const LAS f32x4*)(wsf + 8 * G + 4 * hi);
#pragma unroll
                for (int q = 0; q < 4; ++q) { st.o0[4 * G + q] *= ff[q]; st.o1[4 * G + q] *= ff[q]; st.ol[4 * G + q] *= ff[q]; } }
            LDS_WAIT(); asm volatile("" ::: "memory");
        }
    }
#pragma unroll
    for (int r = 0; r < 16; ++r) { s0[r] = __builtin_amdgcn_exp2f(s0[r]); s1[r] = __builtin_amdgcn_exp2f(s1[r]); }
    bf16x8 pa[4]; pack_p(pa, s0, s1);
    const bf16x8 ones = (bf16x8){0x3F80, 0x3F80, 0x3F80, 0x3F80, 0x3F80, 0x3F80, 0x3F80, 0x3F80};
#pragma unroll
    for (int ks = 0; ks < 4; ++ks) { st.o0 = MFMA32(pa[ks], vf[ks], st.o0); st.o1 = MFMA32(pa[ks], vf[4 + ks], st.o1); st.ol = MFMA32(pa[ks], ones, st.ol); }
}
template <bool NORM>
__device__ __forceinline__ void flush_branch(const f32x16& o0, const f32x16& o1, const f32x16& ol, const float* GATE, bf16* O, int m0, int hq, int br, bool accumulate,
                                             LAS float* stg, int lane) {
    asm volatile("" : "+v"(lane));
    const int r32 = lane & 31, hi = lane >> 5;
    LDS_WAIT(); asm volatile("" ::: "memory");
#pragma unroll
    for (int r = 0; r < 16; ++r) { const float iv = NORM ? __builtin_amdgcn_rcpf(fmaxf(ol[r], 1e-30f)) : 1.f;
        stg[crow(r, hi) * STG_STRIDE + r32] = o0[r] * iv; stg[crow(r, hi) * STG_STRIDE + 32 + r32] = o1[r] * iv; }
    LDS_WAIT(); asm volatile("" ::: "memory");
#pragma unroll
    for (int i = 0; i < 4; ++i) { const int row = i * 8 + (lane >> 3), ch = lane & 7;
        const f32x4 a = *(const LAS f32x4*)(stg + row * STG_STRIDE + ch * 8), b = *(const LAS f32x4*)(stg + row * STG_STRIDE + ch * 8 + 4);
        const float sc = GATE[(size_t)(m0 + row) * 48 + hq * 3 + br];
        bf16* op = O + (size_t)(m0 + row) * DM + hq * 64 + ch * 8;
        f32x4 x = a * sc, y = b * sc;
        if (accumulate) { const u32x4 old = *(const u32x4*)op; x += (f32x4){bflo(old.x), bfhi(old.x), bflo(old.y), bfhi(old.y)}; y += (f32x4){bflo(old.z), bfhi(old.z), bflo(old.w), bfhi(old.w)}; }
        u32x4 w; w.x = pk2(x[0], x[1]); w.y = pk2(x[2], x[3]); w.z = pk2(y[0], y[1]); w.w = pk2(y[2], y[3]);
        *(u32x4*)op = w; }
    LDS_WAIT(); asm volatile("" ::: "memory");
}
__device__ __forceinline__ void load_q(LAS bf16x8* qs, const bf16* Q, int m, int hq, int hi) {
    LDS_WAIT(); asm volatile("" ::: "memory");
#pragma unroll
    for (int d0 = 0; d0 < 4; ++d0) qs[d0 * 64] = *(const bf16x8*)(Q + (size_t)m * DM + hq * 64 + d0 * 16 + hi * 8);
    LDS_WAIT(); asm volatile("" ::: "memory");
}
__device__ __forceinline__ void p_attn_cmp(Frame& F) {
    LAS float* stg = (LAS float*)(F.lds + F.wave * 16384); LAS float* wsf = stg + 32 * STG_STRIDE;
    const bf16* Q = (const bf16*)(F.wsp() + WS_Q); const float* GATE = (const float*)(F.wsp() + WS_GATE); bf16* O = (bf16*)(F.wsp() + WS_O);
    unsigned long long* MASK = (unsigned long long*)(F.wsp() + WS_MASK);
    for (int it = F.gw; it < 16 * 128; it += F.NGW) {
        const int bh = it >> 7, blk = 127 - (it & 127), b = bh >> 2, hk = bh & 3, m0 = b * SEQ + blk * 32;
        const rsrc_t rs = make_rsrc(F.wsp() + WS_KC, 1u << 20);
        const unsigned soK = (unsigned)bh * 32768u, soV = 524288u + (unsigned)bh * 32768u;
        const int nvmax = ((blk * 32) >> 4) + 1, ntc = (nvmax + 63) >> 6;
        float mref0 = 0.f, mref1 = 0.f, mref2 = 0.f, mref3 = 0.f, inv0 = 0.f, inv1 = 0.f, inv2 = 0.f, inv3 = 0.f;
#pragma unroll 1
        for (int g = 0; g < 4; ++g) {
            int lane = F.lane; asm volatile("" : "+v"(lane));
            const int r32 = lane & 31, hi = lane >> 5, t = blk * 32 + r32, nvr = t >= 31 ? ((t - 31) >> 4) + 1 : 0;
            LAS bf16x8* qr = (LAS bf16x8*)(wsf + 64) + lane; load_q(qr, Q, m0 + r32, hk * 4 + g, hi);
            float mrun = -INFINITY, l = 0.f;
#pragma unroll 1
            for (int i = 0; i < ntc; ++i) {
                f32x16 s0, s1; qk_tile_lo(s0, s1, rs, (unsigned)lane * 16u, soK + (unsigned)i * 8192u, qr, 0.f); mask_tile(s0, s1, -1, nvr - 1 - 64 * i, hi);
                const float rm = rowmax32(s0, s1, hi), mn = fmaxf(mrun, rm), mr = (mn == -INFINITY) ? 0.f : mn;
                float sum = 0.f;
#pragma unroll
                for (int r = 0; r < 16; ++r) sum += __builtin_amdgcn_exp2f(s0[r] - mr) + __builtin_amdgcn_exp2f(s1[r] - mr);
                l = l * __builtin_amdgcn_exp2f(mrun - mr) + sum; mrun = mn;
            }
            const float ltot = l + partner32(l, hi);
            const float iv = 1.f / fmaxf(ltot, 1e-30f), mr_ = (mrun == -INFINITY) ? 0.f : mrun;
            if (g == 0) { inv0 = iv; mref0 = mr_; } else if (g == 1) { inv1 = iv; mref1 = mr_; } else if (g == 2) { inv2 = iv; mref2 = mr_; } else { inv3 = iv; mref3 = mr_; }
        }
        {
            float imp[32];
#pragma unroll
            for (int k = 0; k < 32; ++k) imp[k] = 0.f;
#pragma unroll 1
            for (int g = 0; g < 4; ++g) {
                int lane = F.lane; asm volatile("" : "+v"(lane));
                const int r32 = lane & 31, hi = lane >> 5, t = blk * 32 + r32, nvr = t >= 31 ? ((t - 31) >> 4) + 1 : 0;
                LAS bf16x8* qr = (LAS bf16x8*)(wsf + 64) + lane; load_q(qr, Q, m0 + r32, hk * 4 + g, hi);
                const float invg = g == 0 ? inv0 : g == 1 ? inv1 : g == 2 ? inv2 : inv3, mg = g == 0 ? mref0 : g == 1 ? mref1 : g == 2 ? mref2 : mref3;
#pragma unroll
                for (int i = 0; i < 4; ++i) if (i < ntc) {
                    asm volatile("" ::: "memory");
                    f32x16 s0, s1; qk_tile_lo(s0, s1, rs, (unsigned)lane * 16u, soK + (unsigned)i * 8192u, qr, -mg); mask_tile(s0, s1, -1, nvr - 1 - 64 * i, hi);
#pragma unroll
                    for (int r = 0; r < 16; ++r) { s0[r] = __builtin_amdgcn_exp2f(s0[r]) * invg; s1[r] = __builtin_amdgcn_exp2f(s1[r]) * invg; }
#pragma unroll
                    for (int G = 0; G < 4; ++G) {
                        { const int kq = 8 * i + G; const float e = s0[4 * G + 3], pe = partner32(e, hi);
                          imp[kq] += (s0[4 * G] + s0[4 * G + 1]) + s0[4 * G + 2] + 0.5f * e + (hi ? 0.5f * pe : 0.f);
                          if (kq + 1 < 32) imp[kq + 1] += hi ? 0.f : 0.5f * pe; }
                        { const int kq = 8 * i + 4 + G; const float e = s1[4 * G + 3], pe = partner32(e, hi);
                          imp[kq] += (s1[4 * G] + s1[4 * G + 1]) + s1[4 * G + 2] + 0.5f * e + (hi ? 0.5f * pe : 0.f);
                          if (kq + 1 < 32) imp[kq + 1] += hi ? 0.f : 0.5f * pe; }
                    }
                }
            }
            int lane = F.lane; asm volatile("" : "+v"(lane));
            const int r32 = lane & 31, hi = lane >> 5, cur = (blk * 32 + r32) >> 6;
            LDS_WAIT(); asm volatile("" ::: "memory");
#pragma unroll
            for (int k = 0; k < 32; ++k) { const int j = 2 * k + hi; const bool allowed = j <= cur, forced = allowed && (j == 0 || j == cur || j == cur - 1);
                stg[r32 * STG_STRIDE + j] = forced ? 1e9f : (allowed ? imp[k] : -1e30f); }
            LDS_WAIT(); asm volatile("" ::: "memory");
        }
        {
            int lane = F.lane; asm volatile("" : "+v"(lane));
            unsigned long long mymask = 0ull;
#pragma unroll 1
            for (int tok = 0; tok < 32; ++tok) {
                const float sc = stg[tok * STG_STRIDE + lane]; int rank = 0;
#pragma unroll
                for (int q = 0; q < 16; ++q) { const f32x4 v = *(const LAS f32x4*)(stg + tok * STG_STRIDE + 4 * q);
#pragma unroll
                    for (int e = 0; e < 4; ++e) rank += (v[e] > sc || (v[e] == sc && (4 * q + e) < lane)) ? 1 : 0; }
                const unsigned long long mk = __ballot(rank < 16 && sc > -0.5e30f);
                mymask = (lane == tok) ? mk : mymask;
            }
            if (lane < 32) MASK[(size_t)bh * SEQ + blk * 32 + lane] = mymask;
            LDS_WAIT(); asm volatile("" ::: "memory");
        }
#pragma unroll 1
        for (int g = 0; g < 4; ++g) {
            int lane = F.lane; asm volatile("" : "+v"(lane));
            const int r32 = lane & 31, hi = lane >> 5, t = blk * 32 + r32, nvr = t >= 31 ? ((t - 31) >> 4) + 1 : 0;
            LAS bf16x8* qr = (LAS bf16x8*)(wsf + 64) + lane; load_q(qr, Q, m0 + r32, hk * 4 + g, hi);
            const float invg = g == 0 ? inv0 : g == 1 ? inv1 : g == 2 ? inv2 : inv3, mg = g == 0 ? mref0 : g == 1 ? mref1 : g == 2 ? mref2 : mref3;
            f32x16 o0, o1;
#pragma unroll
            for (int r = 0; r < 16; ++r) { o0[r] = 0.f; o1[r] = 0.f; }
#pragma unroll 1
            for (int i = 0; i < ntc; ++i) {
                f32x16 s0, s1; qk_tile_lo(s0, s1, rs, (unsigned)lane * 16u, soK + (unsigned)i * 8192u, qr, -mg); mask_tile(s0, s1, -1, nvr - 1 - 64 * i, hi);
#pragma unroll
                for (int r = 0; r < 16; ++r) { s0[r] = __builtin_amdgcn_exp2f(s0[r]) * invg; s1[r] = __builtin_amdgcn_exp2f(s1[r]) * invg; }
                bf16x8 pa[4]; pack_p(pa, s0, s1);
                bf16x8 vf[8]; load_frag8(vf, rs, (unsigned)lane * 16u, soV + (unsigned)i * 8192u); pv_tile(o0, o1, pa, vf);
            }
            flush_branch<false>(o0, o1, o0, GATE, O, m0, hk * 4 + g, 0, false, stg, lane);
        }
    }
}
__device__ __forceinline__ void attn_main_item(Frame& F, int bh, int g, int blk, LAS float* stg, LAS float* wsf) {
    const bf16* Q = (const bf16*)(F.wsp() + WS_Q); const float* GATE = (const float*)(F.wsp() + WS_GATE); bf16* O = (bf16*)(F.wsp() + WS_O);
    const rsrc_t rs = make_rsrc(F.wsp() + WS_KV, (unsigned)(6 * KVBUF_ELEMS * 2));
    int lane = F.lane; asm volatile("" : "+v"(lane));
    const int r32 = lane & 31, hi = lane >> 5;
    const unsigned vo = (unsigned)lane * 16u;
    const int b = bh >> 2, hk = bh & 3, hq = hk * 4 + g, m0 = b * SEQ + blk * 32, c = blk >> 1, ql = (blk & 1) * 32 + r32;
    LAS bf16x8* qr = (LAS bf16x8*)(wsf + 64) + lane; load_q(qr, Q, m0 + r32, hq, hi);
    const unsigned long long mask = ((const unsigned long long*)(F.wsp() + WS_MASK))[(size_t)bh * SEQ + blk * 32 + r32];
    bf16x8 kf[8], vf[8];
    {
        const unsigned soK = (unsigned)((2 * KVBUF_ELEMS + (size_t)bh * KVROWS * 64) * 2), soV = (unsigned)((3 * KVBUF_ELEMS + (size_t)bh * KVROWS * 64) * 2);
        Sm st; sm_init(st);
        load_frag8(kf, rs, vo, soK);
#pragma unroll 1
        for (int j = 0; j <= c; ++j) {
            const bool sel = ((mask >> j) & 1ull) != 0ull;
            f32x16 s0, s1; qk_tile(s0, s1, kf, qr, sel ? -st.mhat : -INFINITY);
            asm volatile("" : "+v"(s0), "+v"(s1) :: "memory");
            load_frag8(vf, rs, vo, soV + (unsigned)j * 8192u);
            load_frag8(kf, rs, vo, soK + (unsigned)(j < c ? j + 1 : c) * 8192u);
            if (j == c) mask_tile(s0, s1, -1, ql, hi);
            sm_tile(st, s0, s1, j == 0, vf, wsf, r32, hi);
            asm volatile("" : "+v"(st.o0), "+v"(st.o1), "+v"(st.ol) :: "memory");
        }
        flush_branch<true>(st.o0, st.o1, st.ol, GATE, O, m0, hq, 1, true, stg, lane);
    }
    {
        const unsigned soK = (unsigned)((4 * KVBUF_ELEMS + (size_t)bh * KVROWS * 64) * 2), soV = (unsigned)((5 * KVBUF_ELEMS + (size_t)bh * KVROWS * 64) * 2);
        Sm st; sm_init(st);
        const int j0 = c >= 8 ? c - 8 : 0;
        load_frag8(kf, rs, vo, soK + (unsigned)j0 * 8192u);
#pragma unroll 1
        for (int j = j0; j <= c; ++j) {
            f32x16 s0, s1; qk_tile(s0, s1, kf, qr, -st.mhat);
            asm volatile("" : "+v"(s0), "+v"(s1) :: "memory");
            load_frag8(vf, rs, vo, soV + (unsigned)j * 8192u);
            load_frag8(kf, rs, vo, soK + (unsigned)(j < c ? j + 1 : c) * 8192u);
            if (j == c || j + 8 == c) mask_tile(s0, s1, (j + 8 == c) ? ql : -1, (j == c) ? ql : 63, hi);
            sm_tile(st, s0, s1, j == j0, vf, wsf, r32, hi);
            asm volatile("" : "+v"(st.o0), "+v"(st.o1), "+v"(st.ol) :: "memory");
        }
        flush_branch<true>(st.o0, st.o1, st.ol, GATE, O, m0, hq, 2, true, stg, lane);
    }
}
__device__ __forceinline__ void p_attn_main(Frame& F) {
    LAS float* stg = (LAS float*)(F.lds + F.wave * 16384); LAS float* wsf = stg + 32 * STG_STRIDE;
    for (int P = F.gw; P < 4096; P += F.NGW) {
        const int bh = P >> 8, rem = P & 255, g = rem & 3, k = rem >> 2;
        attn_main_item(F, bh, g, 127 - k, stg, wsf);
        attn_main_item(F, bh, g, k, stg, wsf);
    }
}
constexpr int AT_SLOT = 16384, AT_NSLOT = 4, AT_PW_OFF = AT_NSLOT * AT_SLOT, AT_PW_BYTES = STG_BYTES + 256 + 384, AT_MASK_OFF = AT_PW_OFF + 8 * AT_PW_BYTES;
static_assert(AT_MASK_OFF + 512 <= LDSCTL_OFF, "attention LDS map");
#define AT_WAIT_BAR(N) asm volatile("s_waitcnt vmcnt(" #N ") lgkmcnt(0)\n\ts_barrier" ::: "memory")
__device__ __forceinline__ void at_dma(const char* g, LAS unsigned char* l) { __builtin_amdgcn_global_load_lds((const unsigned*)g, (LAS unsigned*)l, 16, 0, 0); }
__device__ __forceinline__ void qk_tile_reg(f32x16& p0, f32x16& p1, const LAS unsigned char* ks, const bf16x8 (&qr)[4], const float cinit) {
    bf16x8 kf[8];
#pragma unroll
    for (int f = 0; f < 8; ++f) kf[f] = *(const LAS bf16x8*)(ks + f * 1024);
    __builtin_amdgcn_sched_barrier(0);
    f32x16 c;
#pragma unroll
    for (int r = 0; r < 16; ++r) c[r] = cinit;
    p0 = MFMA32(kf[0], qr[0], c); p1 = MFMA32(kf[4], qr[0], c);
#pragma unroll
    for (int d0 = 1; d0 < 4; ++d0) { p0 = MFMA32(kf[d0], qr[d0], p0); p1 = MFMA32(kf[4 + d0], qr[d0], p1); }
}
template <int V>
__device__ __forceinline__ void sm_tile_lds(Sm& st, f32x16& s0, f32x16& s1, bool first, const LAS unsigned char* vs, LAS float* wsf, int r32, int hi) {
    const float rm = rowmax32(s0, s1, hi);
    const bool need = first || (__any(rm > 8.0f) != 0);
    if (need) {
        const float dl = first ? ((rm == -INFINITY) ? 0.f : rm) : fmaxf(rm, 0.f);
        st.mhat += dl;
#pragma unroll
        for (int r = 0; r < 16; ++r) { s0[r] -= dl; s1[r] -= dl; }
        if (!first) {
            const float f = __builtin_amdgcn_exp2f(-dl);
            LDS_WAIT(); asm volatile("" ::: "memory");
            if (hi == 0) wsf[r32] = f;
            LDS_WAIT(); asm volatile("" ::: "memory");
#pragma unroll
            for (int G = 0; G < 4; ++G) { const f32x4 ff = *(const LAS f32x4*)(wsf + 8 * G + 4 * hi);
#pragma unroll
                for (int q = 0; q < 4; ++q) { st.o0[4 * G + q] *= ff[q]; st.o1[4 * G + q] *= ff[q]; st.ol[4 * G + q] *= ff[q]; } }
            LDS_WAIT(); asm volatile("" ::: "memory");
        }
    }
    bf16x8 vf[8];
#pragma unroll
    for (int f = 0; f < 8; ++f) vf[f] = *(const LAS bf16x8*)(vs + f * 1024);
    __builtin_amdgcn_sched_barrier(0);
    if (V != 2) {
#pragma unroll
    for (int r = 0; r < 16; ++r) { s0[r] = __builtin_amdgcn_exp2f(s0[r]); s1[r] = __builtin_amdgcn_exp2f(s1[r]); } }
    bf16x8 pa[4]; pack_p(pa, s0, s1);
    const bf16x8 ones = (bf16x8){0x3F80, 0x3F80, 0x3F80, 0x3F80, 0x3F80, 0x3F80, 0x3F80, 0x3F80};
    if (V != 3) {
#pragma unroll
    for (int ks = 0; ks < 4; ++ks) { st.o0 = MFMA32(pa[ks], vf[ks], st.o0); st.o1 = MFMA32(pa[ks], vf[4 + ks], st.o1); st.ol = MFMA32(pa[ks], ones, st.ol); }
    } else { asm volatile("" :: "v"(pa[0]), "v"(pa[1]), "v"(pa[2]), "v"(pa[3]), "v"(vf[0]), "v"(vf[1]), "v"(vf[2]), "v"(vf[3]), "v"(vf[4]), "v"(vf[5]), "v"(vf[6]), "v"(vf[7])); }
}
template <bool WIN, int V>
__device__ __forceinline__ void at_branch(Sm& st, const char* Kg, const char* Vg, int j0, int c, int ql, unsigned long long mask, const bf16x8 (&qr)[4],
                                          LAS unsigned char* ring, LAS float* wsf, int wave, int lane) {
    const int r32 = lane & 31, hi = lane >> 5, n = c - j0 + 1;
    LAS unsigned char* dk = ring + wave * 1024;
    const LAS unsigned char* rd = ring + lane * 16;
#pragma unroll
    for (int d = 0; d < 3; ++d) if (d < n) { at_dma(Kg + (size_t)(j0 + d) * 8192, dk + d * AT_SLOT); at_dma(Vg + (size_t)(j0 + d) * 8192, dk + d * AT_SLOT + 8192); }
#pragma unroll 1
    for (int t = 0; t < n; ++t) {
        const int rem = n - 1 - t;
        if (V != 1) { if (rem >= 2) AT_WAIT_BAR(4); else if (rem == 1) AT_WAIT_BAR(2); else AT_WAIT_BAR(0); }
        if (t + 3 < n) { const int sl = (t + 3) & 3; at_dma(Kg + (size_t)(j0 + t + 3) * 8192, dk + sl * AT_SLOT); at_dma(Vg + (size_t)(j0 + t + 3) * 8192, dk + sl * AT_SLOT + 8192); }
        const int j = j0 + t; const LAS unsigned char* slot = rd + (t & 3) * AT_SLOT;
        const bool sel = WIN ? true : (((mask >> j) & 1ull) != 0ull);
        f32x16 s0, s1;
        if (V != 4) qk_tile_reg(s0, s1, slot, qr, sel ? -st.mhat : -INFINITY);
        else {
#pragma unroll
            for (int r = 0; r < 16; ++r) { s0[r] = sel ? -st.mhat : -1.f; s1[r] = s0[r]; } asm volatile("" : "+v"(s0), "+v"(s1)); }
        if (WIN) { if (j == c || j + 8 == c) mask_tile(s0, s1, (j + 8 == c) ? ql : -1, (j == c) ? ql : 63, hi); }
        else { if (j == c) mask_tile(s0, s1, -1, ql, hi); }
        sm_tile_lds<V>(st, s0, s1, t == 0, slot + 8192, wsf, r32, hi);
    }
}
#define AT_PIN(x) asm volatile("" : "+v"(x))
#define AT_GAPA(MF, P, B, W, I) do { MF; lsum += (P[B] + P[B + 1]) + (P[B + 2] + P[B + 3]); W[I] = cvtpk(P[B], P[B + 1]); W[I + 1] = cvtpk(P[B + 2], P[B + 3]); \
        AT_PIN(lsum); AT_PIN(W); __builtin_amdgcn_sched_barrier(0); } while (0)
#define AT_GAPB(MF, C, B) do { MF; C[B] = __builtin_amdgcn_exp2f(C[B]); C[B + 1] = __builtin_amdgcn_exp2f(C[B + 1]); C[B + 2] = __builtin_amdgcn_exp2f(C[B + 2]); C[B + 3] = __builtin_amdgcn_exp2f(C[B + 3]); \
        AT_PIN(C); __builtin_amdgcn_sched_barrier(0); } while (0)
template <bool WIN>
__device__ __forceinline__ void at_branch_pipe(Sm& st, const char* Kg, const char* Vg, int j0, int c, int ql, unsigned long long mask, const bf16x8 (&qr)[4],
                                               LAS unsigned char* ring, LAS float* wsf, int wave, int lane) {
    const int r32 = lane & 31, hi = lane >> 5, n = c - j0 + 1;
    LAS unsigned char* dk = ring + wave * 1024;
    const LAS unsigned char* rd = ring + lane * 16;
#pragma unroll
    for (int d = 0; d < 2; ++d) if (d < n) { at_dma(Kg + (size_t)(j0 + d) * 8192, dk + d * AT_SLOT); at_dma(Vg + (size_t)(j0 + d) * 8192, dk + d * AT_SLOT + 8192); }
    if (n > 1) AT_WAIT_BAR(2); else AT_WAIT_BAR(0);
    if (2 < n) { at_dma(Kg + (size_t)(j0 + 2) * 8192, dk + 2 * AT_SLOT); at_dma(Vg + (size_t)(j0 + 2) * 8192, dk + 2 * AT_SLOT + 8192); }
    f32x16 p0, p1;
    { const bool sel = WIN ? true : ((mask >> j0) & 1ull) != 0ull;
      qk_tile_reg(p0, p1, rd, qr, sel ? 0.f : -INFINITY);
      if (WIN) { if (j0 == c || j0 + 8 == c) mask_tile(p0, p1, (j0 + 8 == c) ? ql : -1, (j0 == c) ? ql : 63, hi); }
      else { if (j0 == c) mask_tile(p0, p1, -1, ql, hi); }
      const float rm = rowmax32(p0, p1, hi), dl = (rm == -INFINITY) ? 0.f : rm;
      st.mhat = dl;
#pragma unroll
      for (int r = 0; r < 16; ++r) { p0[r] = __builtin_amdgcn_exp2f(p0[r] - dl); p1[r] = __builtin_amdgcn_exp2f(p1[r] - dl); } }
#pragma unroll 1
    for (int t = 1; t < n; ++t) {
        if (t + 1 < n) AT_WAIT_BAR(2); else AT_WAIT_BAR(0);
        if (t + 2 < n) { const int sl = (t + 2) & 3; at_dma(Kg + (size_t)(j0 + t + 2) * 8192, dk + sl * AT_SLOT); at_dma(Vg + (size_t)(j0 + t + 2) * 8192, dk + sl * AT_SLOT + 8192); }
        const int j = j0 + t;
        const bool sel = WIN ? true : ((mask >> j) & 1ull) != 0ull;
        const LAS unsigned char* ks = rd + (t & 3) * AT_SLOT; const LAS unsigned char* vs = rd + ((t - 1) & 3) * AT_SLOT + 8192;
        bf16x8 kf[8], vf[8];
#pragma unroll
        for (int f = 0; f < 8; ++f) kf[f] = *(const LAS bf16x8*)(ks + f * 1024);
        f32x16 cv; { const float ci = sel ? -st.mhat : -INFINITY;
#pragma unroll
            for (int r = 0; r < 16; ++r) cv[r] = ci; }
        __builtin_amdgcn_sched_barrier(0);
        f32x16 c0, c1; u32x4 w0, w1, w2, w3; float lsum = 0.f;
        AT_GAPA(c0 = MFMA32(kf[0], qr[0], cv), p0, 0, w0, 0);
        AT_GAPA(c1 = MFMA32(kf[4], qr[0], cv), p0, 4, w0, 2);
        AT_GAPA(c0 = MFMA32(kf[1], qr[1], c0), p0, 8, w1, 0);
        AT_GAPA(c1 = MFMA32(kf[5], qr[1], c1), p0, 12, w1, 2);
#pragma unroll
        for (int f = 0; f < 8; ++f) vf[f] = *(const LAS bf16x8*)(vs + f * 1024);
        __builtin_amdgcn_sched_barrier(0);
        AT_GAPA(c0 = MFMA32(kf[2], qr[2], c0), p1, 0, w2, 0);
        AT_GAPA(c1 = MFMA32(kf[6], qr[2], c1), p1, 4, w2, 2);
        AT_GAPA(c0 = MFMA32(kf[3], qr[3], c0), p1, 8, w3, 0);
        AT_GAPA(c1 = MFMA32(kf[7], qr[3], c1), p1, 12, w3, 2);
        st.l += lsum;
        if (WIN) { if (j == c || j + 8 == c) mask_tile(c0, c1, (j + 8 == c) ? ql : -1, (j == c) ? ql : 63, hi); }
        else { if (j == c) mask_tile(c0, c1, -1, ql, hi); }
        const float rm = rowmax32(c0, c1, hi);
        const bool resc = (__any(rm > 8.0f) != 0);
        if (resc) { const float dl = fmaxf(rm, 0.f); st.mhat += dl;
#pragma unroll
            for (int r = 0; r < 16; ++r) { c0[r] -= dl; c1[r] -= dl; }
            const float f = __builtin_amdgcn_exp2f(-dl); st.l *= f;
            LDS_WAIT(); asm volatile("" ::: "memory");
            if (hi == 0) wsf[r32] = f; }
        __builtin_amdgcn_sched_barrier(0);
        { const bf16x8 a0 = __builtin_bit_cast(bf16x8, w0), a1 = __builtin_bit_cast(bf16x8, w1), a2 = __builtin_bit_cast(bf16x8, w2), a3 = __builtin_bit_cast(bf16x8, w3);
          AT_GAPB(st.o0 = MFMA32(a0, vf[0], st.o0), c0, 0);
          AT_GAPB(st.o1 = MFMA32(a0, vf[4], st.o1), c0, 4);
          AT_GAPB(st.o0 = MFMA32(a1, vf[1], st.o0), c0, 8);
          AT_GAPB(st.o1 = MFMA32(a1, vf[5], st.o1), c0, 12);
          AT_GAPB(st.o0 = MFMA32(a2, vf[2], st.o0), c1, 0);
          AT_GAPB(st.o1 = MFMA32(a2, vf[6], st.o1), c1, 4);
          AT_GAPB(st.o0 = MFMA32(a3, vf[3], st.o0), c1, 8);
          AT_GAPB(st.o1 = MFMA32(a3, vf[7], st.o1), c1, 12); }
        if (resc) {
            LDS_WAIT(); asm volatile("" ::: "memory");
#pragma unroll
            for (int G = 0; G < 4; ++G) { const f32x4 ff = *(const LAS f32x4*)(wsf + 8 * G + 4 * hi);
#pragma unroll
                for (int q = 0; q < 4; ++q) { st.o0[4 * G + q] *= ff[q]; st.o1[4 * G + q] *= ff[q]; } }
            LDS_WAIT(); asm volatile("" ::: "memory"); }
        p0 = c0; p1 = c1;
    }
    { float lsum = 0.f;
#pragma unroll
      for (int r = 0; r < 16; ++r) lsum += p0[r] + p1[r];
      st.l += lsum;
      bf16x8 pa[4]; pack_p(pa, p0, p1);
      bf16x8 vf[8]; const LAS unsigned char* vs = rd + ((n - 1) & 3) * AT_SLOT + 8192;
#pragma unroll
      for (int f = 0; f < 8; ++f) vf[f] = *(const LAS bf16x8*)(vs + f * 1024);
      pv_tile(st.o0, st.o1, pa, vf); }
    { const float lt = st.l + partner32(st.l, hi);
      LDS_WAIT(); asm volatile("" ::: "memory");
      if (hi == 0) wsf[r32] = lt;
      LDS_WAIT(); asm volatile("" ::: "memory");
#pragma unroll
      for (int G = 0; G < 4; ++G) { const f32x4 ff = *(const LAS f32x4*)(wsf + 8 * G + 4 * hi);
#pragma unroll
          for (int q = 0; q < 4; ++q) st.ol[4 * G + q] = ff[q]; }
      LDS_WAIT(); asm volatile("" ::: "memory"); }
}
template <bool DRY, int V>
__device__ __forceinline__ void attn_unit(Frame& F, int bh, int c) {
    const bf16* Q = (const bf16*)(F.wsp() + WS_Q); const float* GATE = (const float*)(F.wsp() + WS_GATE); bf16* O = (bf16*)(F.wsp() + (DRY ? WS_Y0 : WS_O));
    const int wave = F.wave, g = wave >> 1, th = wave & 1;
    int lane = F.lane; asm volatile("" : "+v"(lane));
    const int r32 = lane & 31, hi = lane >> 5;
    const int b = bh >> 2, hk = bh & 3, hq = hk * 4 + g, m0 = b * SEQ + c * 64 + th * 32, t = c * 64 + th * 32 + r32, ql = th * 32 + r32;
    LAS unsigned char* ring = F.lds;
    LAS float* stg = (LAS float*)(F.lds + AT_PW_OFF + wave * AT_PW_BYTES); LAS float* wsf = stg + 32 * STG_STRIDE;
    LAS unsigned long long* masks = (LAS unsigned long long*)(F.lds + AT_MASK_OFF);
    const size_t lofs = (size_t)wave * 1024 + (size_t)lane * 16;
    bf16x8 qr[4];
#pragma unroll
    for (int d0 = 0; d0 < 4; ++d0) qr[d0] = *(const bf16x8*)(Q + (size_t)(m0 + r32) * DM + hq * 64 + d0 * 16 + hi * 8);
    LAS float* gl = wsf + 64;
    if (hi == 0) { const float* gp = GATE + (size_t)(m0 + r32) * 48 + hq * 3; gl[r32] = gp[0]; gl[32 + r32] = gp[1]; gl[64 + r32] = gp[2]; }
    const int nvr = t >= 31 ? ((t - 31) >> 4) + 1 : 0, ntc = (4 * c + 3 + 63) >> 6;
    f32x16 oc0, oc1;
    {
        const char* KCg = (const char*)(F.wsp() + WS_KC) + (size_t)bh * 32768 + lofs; const char* VCg = (const char*)(F.wsp() + WS_VC) + (size_t)bh * 32768 + lofs;
        asm volatile("s_waitcnt vmcnt(0)" ::: "memory");
        for (int i = 0; i < ntc; ++i) { at_dma(KCg + (size_t)i * 8192, ring + i * AT_SLOT + wave * 1024); at_dma(VCg + (size_t)i * 8192, ring + i * AT_SLOT + 8192 + wave * 1024); }
        AT_WAIT_BAR(0);
        const LAS unsigned char* rd = ring + lane * 16;
        float mhat = 0.f, l = 0.f;
        float imp[32];
#pragma unroll
        for (int k = 0; k < 32; ++k) imp[k] = 0.f;
        f32x16 o0, o1;
#pragma unroll
        for (int r = 0; r < 16; ++r) { o0[r] = 0.f; o1[r] = 0.f; }
#pragma unroll
        for (int i = 0; i < 4; ++i) if (i < ntc) {
            asm volatile("" ::: "memory");
            f32x16 s0, s1; qk_tile_reg(s0, s1, rd + i * AT_SLOT, qr, -mhat); mask_tile(s0, s1, -1, nvr - 1 - 64 * i, hi);
            const float rm = rowmax32(s0, s1, hi);
            if (i == 0) { const float dl = (rm == -INFINITY) ? 0.f : rm; mhat = dl;
#pragma unroll
                for (int r = 0; r < 16; ++r) { s0[r] -= dl; s1[r] -= dl; } }
            else if (__any(rm > 8.0f) != 0) { const float dl = fmaxf(rm, 0.f); mhat += dl;
#pragma unroll
                for (int r = 0; r < 16; ++r) { s0[r] -= dl; s1[r] -= dl; }
                const float f = __builtin_amdgcn_exp2f(-dl); l *= f;
#pragma unroll
                for (int k = 0; k < 32; ++k) imp[k] *= f;
                LDS_WAIT(); asm volatile("" ::: "memory");
                if (hi == 0) wsf[r32] = f;
                LDS_WAIT(); asm volatile("" ::: "memory");
#pragma unroll
                for (int G = 0; G < 4; ++G) { const f32x4 ff = *(const LAS f32x4*)(wsf + 8 * G + 4 * hi);
#pragma unroll
                    for (int q = 0; q < 4; ++q) { o0[4 * G + q] *= ff[q]; o1[4 * G + q] *= ff[q]; } }
                LDS_WAIT(); asm volatile("" ::: "memory"); }
            float sum = 0.f;
#pragma unroll
            for (int r = 0; r < 16; ++r) { s0[r] = __builtin_amdgcn_exp2f(s0[r]); s1[r] = __builtin_amdgcn_exp2f(s1[r]); sum += s0[r] + s1[r]; }
            l += sum;
#pragma unroll
            for (int G = 0; G < 4; ++G) {
                { const int kq = 8 * i + G; const float e = s0[4 * G + 3], pe = partner32(e, hi);
                  imp[kq] += (s0[4 * G] + s0[4 * G + 1]) + s0[4 * G + 2] + 0.5f * e + (hi ? 0.5f * pe : 0.f);
                  if (kq + 1 < 32) imp[kq + 1] += hi ? 0.f : 0.5f * pe; }
                { const int kq = 8 * i + 4 + G; const float e = s1[4 * G + 3], pe = partner32(e, hi);
                  imp[kq] += (s1[4 * G] + s1[4 * G + 1]) + s1[4 * G + 2] + 0.5f * e + (hi ? 0.5f * pe : 0.f);
                  if (kq + 1 < 32) imp[kq + 1] += hi ? 0.f : 0.5f * pe; }
            }
            bf16x8 pa[4]; pack_p(pa, s0, s1);
            { bf16x8 vf[4];
#pragma unroll
              for (int f = 0; f < 4; ++f) vf[f] = *(const LAS bf16x8*)(rd + i * AT_SLOT + 8192 + f * 1024);
#pragma unroll
              for (int ks = 0; ks < 4; ++ks) o0 = MFMA32(pa[ks], vf[ks], o0);
              asm volatile("" : "+v"(o0) :: "memory");
#pragma unroll
              for (int f = 0; f < 4; ++f) vf[f] = *(const LAS bf16x8*)(rd + i * AT_SLOT + 8192 + (4 + f) * 1024);
#pragma unroll
              for (int ks = 0; ks < 4; ++ks) o1 = MFMA32(pa[ks], vf[ks], o1); }
        }
        const float ltot = l + partner32(l, hi), inv = 1.f / fmaxf(ltot, 1e-30f);
#pragma unroll
        for (int k = 0; k < 32; ++k) imp[k] *= inv;
        LDS_WAIT(); asm volatile("" ::: "memory");
        if (hi == 0) wsf[r32] = gl[r32] * inv;
        LDS_WAIT(); asm volatile("" ::: "memory");
#pragma unroll
        for (int G = 0; G < 4; ++G) { const f32x4 gg = *(const LAS f32x4*)(wsf + 8 * G + 4 * hi);
#pragma unroll
            for (int q = 0; q < 4; ++q) { oc0[4 * G + q] = o0[4 * G + q] * gg[q]; oc1[4 * G + q] = o1[4 * G + q] * gg[q]; } }
        LDS_WAIT(); asm volatile("" ::: "memory");
#pragma unroll
        for (int k = 0; k < 32; ++k) stg[r32 * STG_STRIDE + 2 * k + hi] = imp[k];
    }
    AT_WAIT_BAR(0);
    const char* KSg = (const char*)(F.wsp() + WS_KV) + (2 * KVBUF_ELEMS + (size_t)bh * KVROWS * 64) * 2 + lofs;
    const char* VSg = (const char*)(F.wsp() + WS_KV) + (3 * KVBUF_ELEMS + (size_t)bh * KVROWS * 64) * 2 + lofs;
    if (c < 16) { if (lane < 8) masks[th * 32 + 8 * g + lane] = (2ull << c) - 1ull; }
    else {
        const LAS float* st0 = (const LAS float*)(F.lds + AT_PW_OFF + (0 * 2 + th) * AT_PW_BYTES); const LAS float* st1 = (const LAS float*)(F.lds + AT_PW_OFF + (1 * 2 + th) * AT_PW_BYTES);
        const LAS float* st2 = (const LAS float*)(F.lds + AT_PW_OFF + (2 * 2 + th) * AT_PW_BYTES); const LAS float* st3 = (const LAS float*)(F.lds + AT_PW_OFF + (3 * 2 + th) * AT_PW_BYTES);
        const bool allowed = lane <= c, forced = allowed && (lane == 0 || lane == c || lane == c - 1);
        LAS unsigned* kst = (LAS unsigned*)stg;
#pragma unroll 1
        for (int i = 0; i < 8; i += 2) {
            const int tokA = 8 * g + i, tokB = tokA + 1, aA = tokA * STG_STRIDE + lane, aB = tokB * STG_STRIDE + lane;
            const float vA = ((st0[aA] + st1[aA]) + st2[aA]) + st3[aA], vB = ((st0[aB] + st1[aB]) + st2[aB]) + st3[aB];
            const unsigned low = 63u - (unsigned)lane;
            const unsigned keyA = forced ? (0xFFFFFFC0u | low) : (allowed ? ((__builtin_bit_cast(unsigned, vA) & 0xFFFFFFC0u) | low) : 0u);
            const unsigned keyB = forced ? (0xFFFFFFC0u | low) : (allowed ? ((__builtin_bit_cast(unsigned, vB) & 0xFFFFFFC0u) | low) : 0u);
            LDS_WAIT(); asm volatile("" ::: "memory");
            kst[aA] = keyA; kst[aB] = keyB;
            LDS_WAIT(); asm volatile("" ::: "memory");
            int rankA = 0, rankB = 0;
#pragma unroll
            for (int q = 0; q < 16; ++q) { const u32x4 xa = *(const LAS u32x4*)(kst + tokA * STG_STRIDE + 4 * q), xb = *(const LAS u32x4*)(kst + tokB * STG_STRIDE + 4 * q);
#pragma unroll
                for (int e = 0; e < 4; ++e) { rankA += (xa[e] > keyA) ? 1 : 0; rankB += (xb[e] > keyB) ? 1 : 0; } }
            const unsigned long long mkA = __ballot(rankA < 16 && allowed), mkB = __ballot(rankB < 16 && allowed);
            if (lane == 0) { masks[th * 32 + tokA] = mkA; masks[th * 32 + tokB] = mkB; }
        }
    }
    AT_WAIT_BAR(0);
    const unsigned long long mask = masks[th * 32 + r32];
#pragma unroll
    for (int r = 0; r < 16; ++r) { stg[crow(r, hi) * STG_STRIDE + r32] = oc0[r]; stg[crow(r, hi) * STG_STRIDE + 32 + r32] = oc1[r]; }
    {
        Sm st; sm_init(st);
        if (V == 0) at_branch_pipe<false>(st, KSg, VSg, 0, c, ql, mask, qr, ring, wsf, wave, lane); else if (V != 5) at_branch<false, V>(st, KSg, VSg, 0, c, ql, mask, qr, ring, wsf, wave, lane);
        LDS_WAIT(); asm volatile("" ::: "memory");
#pragma unroll
        for (int G = 0; G < 4; ++G) { const f32x4 gg = *(const LAS f32x4*)(gl + 32 + 8 * G + 4 * hi);
#pragma unroll
            for (int q = 0; q < 4; ++q) { const int r = 4 * G + q; const float iv = gg[q] * __builtin_amdgcn_rcpf(fmaxf(st.ol[r], 1e-30f));
                stg[crow(r, hi) * STG_STRIDE + r32] += st.o0[r] * iv; stg[crow(r, hi) * STG_STRIDE + 32 + r32] += st.o1[r] * iv; } }
    }
    AT_WAIT_BAR(0);
    {
        const char* KWg = (const char*)(F.wsp() + WS_KV) + (4 * KVBUF_ELEMS + (size_t)bh * KVROWS * 64) * 2 + lofs;
        const char* VWg = (const char*)(F.wsp() + WS_KV) + (5 * KVBUF_ELEMS + (size_t)bh * KVROWS * 64) * 2 + lofs;
        Sm st; sm_init(st);
        if (V == 0) at_branch_pipe<true>(st, KWg, VWg, c >= 8 ? c - 8 : 0, c, ql, 0ull, qr, ring, wsf, wave, lane); else if (V != 5) at_branch<true, V>(st, KWg, VWg, c >= 8 ? c - 8 : 0, c, ql, 0ull, qr, ring, wsf, wave, lane);
        LDS_WAIT(); asm volatile("" ::: "memory");
#pragma unroll
        for (int G = 0; G < 4; ++G) { const f32x4 gg = *(const LAS f32x4*)(gl + 64 + 8 * G + 4 * hi);
#pragma unroll
            for (int q = 0; q < 4; ++q) { const int r = 4 * G + q; const float iv = gg[q] * __builtin_amdgcn_rcpf(fmaxf(st.ol[r], 1e-30f));
                stg[crow(r, hi) * STG_STRIDE + r32] += st.o0[r] * iv; stg[crow(r, hi) * STG_STRIDE + 32 + r32] += st.o1[r] * iv; } }
        LDS_WAIT(); asm volatile("" ::: "memory");
#pragma unroll
        for (int i = 0; i < 4; ++i) { const int row = i * 8 + (lane >> 3), ch = lane & 7;
            const f32x4 a = *(const LAS f32x4*)(stg + row * STG_STRIDE + ch * 8), b2 = *(const LAS f32x4*)(stg + row * STG_STRIDE + ch * 8 + 4);
            u32x4 w; w.x = pk2(a[0], a[1]); w.y = pk2(a[2], a[3]); w.z = pk2(b2[0], b2[1]); w.w = pk2(b2[2], b2[3]);
            *(u32x4*)(O + (size_t)(m0 + row) * DM + hq * 64 + ch * 8) = w; }
    }
    AT_WAIT_BAR(0);
}
template <bool DRY, int V>
__device__ __forceinline__ void p_attn_fused(Frame& F) {
    const int G = gridDim.x, bx = blockIdx.x, vcu = (G % 8 == 0) ? (bx % 8) * (G / 8) + bx / 8 : bx;
    for (int P = vcu; P < 512; P += G) {
        const int bh = P >> 5, k = P & 31;
#pragma unroll 1
        for (int h = 0; h < 2; ++h) attn_unit<DRY, V>(F, bh, h ? k : 63 - k);
    }
}
struct Args { const float* in[23]; float* out; unsigned char* ws; int ph_lo, ph_hi; };
__global__ void __launch_bounds__(512, 2) mk_fwd(Args args) {
    extern __shared__ __attribute__((aligned(16))) unsigned char lds[];
    Frame F;
    F.lds = (LAS unsigned char*)lds; F.MISC = (volatile LAS unsigned*)(F.lds + MISC_OFF);
    F.tid = threadIdx.x; F.lane = F.tid & 63; F.wave = __builtin_amdgcn_readfirstlane(F.tid >> 6);
    F.gw = blockIdx.x * 8 + F.wave; F.NGW = gridDim.x * 8;
    for (int u = F.tid; u < (LDS_BYTES - LDSCTL_OFF) / 4; u += 512) ((LAS unsigned*)(F.lds + LDSCTL_OFF))[u] = 0u;
    __syncthreads();
    if (F.tid < 25) { const unsigned long long v = F.tid < 23 ? (unsigned long long)args.in[F.tid] : F.tid == 23 ? (unsigned long long)args.out : (unsigned long long)args.ws;
        LAS unsigned* p = (LAS unsigned*)(F.lds + PTR_OFF) + 2 * F.tid; p[0] = (unsigned)v; p[1] = (unsigned)(v >> 32); }
    __syncthreads();
    XcdBarrier bar; bar.bar = (unsigned*)(F.ctlp() + CW_BAR); bar.x = 0; bar.st = nullptr;
    const int lo = args.ph_lo, hi = args.ph_hi;
    if (hi - lo > 1) bar = xcd_barrier_post((unsigned*)(F.ctlp() + CW_BAR), F.MISC + 8);
#ifdef PH_ONLY
#define IN(k) ((k) == PH_ONLY && lo <= (k) && (k) < hi)
#else
#define IN(k) (lo <= (k) && (k) < hi)
#endif
#define SEAM(k) do { if (IN(k) && (k) + 1 < hi) xcd_barrier(bar); } while (0)
    if (IN(0)) {
#pragma unroll 1
        for (int rep = 0; rep < REP0; ++rep) { p0_prologue(F); if (rep + 1 < REP0) xcd_barrier(bar); } } SEAM(0);
    if (IN(1)) {
#pragma unroll 1
        for (int rep = 0; rep < REP1; ++rep) { p1_mod_u0(F); if (rep + 1 < REP1) xcd_barrier(bar); }
#pragma unroll 1
        for (int rep = 0; rep < XBAR - 1; ++rep) xcd_barrier(bar); } SEAM(1);
    if (IN(2)) for (int rep = 0; rep < REP2; ++rep) {
        const char* A = (const char*)(F.wsp() + WS_U); const char* B = (const char*)(F.wsp() + WS_WIN);
        const pg8::SchedDense S{A, B, A, B + (size_t)1024 * DM * 2, T / 256, 4, 8, DM, (int)gridDim.x, (int)blockIdx.x, 256};
#if DRY2 == 1
        { pg8::gemm_phase<EpNull, pg8::SchedDense, true, false>(F.lds, DM, S, EpNull{}); xcd_barrier(bar); }
#elif DRY2 == 2
        { pg8::gemm_phase<EpG1, pg8::SchedDense, true, false>(F.lds, DM, S, EpG1{(bf16*)(F.wsp() + WS_Y0), (bf16*)(F.wsp() + WS_Y1)}); xcd_barrier(bar); }
#endif
        pg8::gemm_phase<EpG1, pg8::SchedDense, true, false>(F.lds, DM, S, EpG1{(bf16*)(F.wsp() + WS_BG), (bf16*)(F.wsp() + WS_Z)});
        if (rep + 1 < REP2) xcd_barrier(bar);
    } SEAM(2);
    if (IN(3)) {
#pragma unroll 1
        for (int rep = 0; rep < REP3; ++rep) { p3_conv(F); if (rep + 1 < REP3) xcd_barrier(bar); } } SEAM(3);
    if (IN(4)) for (int rep = 0; rep < REP4; ++rep) {
        const pg8::SchedDense S{(const char*)(F.wsp() + WS_A2), (const char*)(F.wsp() + WS_WOUT), nullptr, nullptr, T / 256, 4, 0, DM, (int)gridDim.x, (int)blockIdx.x, 256};
        typedef pg8::EpiWrap<EpU<EpBf16>, false, true> E_;
        pg8::gemm_phase<E_, pg8::SchedDense, false, false>(F.lds, DM, S, E_{{{(bf16*)(F.wsp() + WS_Y0), DM}}});
        if (rep + 1 < REP4) xcd_barrier(bar);
    } SEAM(4);
    if (IN(5)) {
#pragma unroll 1
        for (int rep = 0; rep < DRY5; ++rep) { p_ln_router<0, true>(F); xcd_barrier(bar); }
        p_ln_router<0>(F); } SEAM(5);
    if (IN(6)) { p_moe<0>(F, bar, true); } SEAM(6);
    if (IN(8)) {
#pragma unroll 1
        for (int rep = 0; rep < DRY8; ++rep) { p_ln2<0, true>(F); xcd_barrier(bar); }
        p_ln2<0>(F); } SEAM(8);
    if (IN(9)) {
        const int G = gridDim.x, bx = blockIdx.x, vcu = (G % 8 == 0) ? (bx % 8) * (G / 8) + bx / 8 : bx;
        const SchedKVQG S{(const char*)(F.wsp() + WS_XB), (const char*)(F.wsp() + WS_WKV), (const char*)(F.wsp() + WS_U), (const char*)(F.wsp() + WS_WQG), G, vcu, 0, 512};
        typedef pg8::EpiWrap<EpKVQG, false, true> E_;
        pg8::gemm_phase<E_, SchedKVQG, true, false>(F.lds, DM, S, E_{{(bf16*)(F.wsp() + WS_KV), (bf16*)(F.wsp() + WS_Q), (float*)(F.wsp() + WS_GATE), F.inp(I_BG)}});
    } SEAM(9);
    if (IN(10)) {
        const int G = gridDim.x, bx = blockIdx.x, vcu = (G % 8 == 0) ? (bx % 8) * (G / 8) + bx / 8 : bx;
        const int nq = G - 64 > 0 ? G - 64 : G;
        {
            const SchedKVQG S{(const char*)(F.wsp() + WS_XB), (const char*)(F.wsp() + WS_WKV), (const char*)(F.wsp() + WS_U), (const char*)(F.wsp() + WS_WQG), nq, vcu < nq ? vcu : -1, 512, 704};
            typedef pg8::EpiWrap<EpKVQG, false, true> E_;
            pg8::gemm_phase<E_, SchedKVQG, false, false>(F.lds, DM, S, E_{{(bf16*)(F.wsp() + WS_KV), (bf16*)(F.wsp() + WS_Q), (float*)(F.wsp() + WS_GATE), F.inp(I_BG)}});
        }
        {
            const SchedCmp S{(const char*)(F.wsp() + WS_KV), (const char*)(F.wsp() + WS_W1C), G - nq > 0 ? G - nq : G, G - nq > 0 ? (vcu >= nq ? vcu - nq : -1) : vcu};
            typedef pg8::EpiWrap<EpU<EpF32>, false> E_;
            pg8::gemm_phase<E_, SchedCmp, false, false>(F.lds, 1024, S, E_{{{(float*)(F.wsp() + WS_TB), 512}}});
        }
    } SEAM(10);
    if (IN(11)) {
#pragma unroll 1
        for (int rep = 0; rep < REP11; ++rep) { p_cmp_finish(F); if (rep + 1 < REP11) xcd_barrier(bar); } } SEAM(11);
#if ATTN_FUSED
    if (IN(12)) {
#pragma unroll 1
        for (int rep = 0; rep < DRY12; ++rep) { p_attn_fused<true, ATV>(F); xcd_barrier(bar); }
        p_attn_fused<false, 0>(F); } SEAM(12);
#else
    if (IN(12)) { p_attn_cmp(F); } SEAM(12);
    if (IN(13)) { p_attn_main(F); } SEAM(13);
#endif
    if (IN(14)) {
        const pg8::SchedDense S{(const char*)(F.wsp() + WS_O), (const char*)(F.wsp() + WS_WO), nullptr, nullptr, T / 256, 4, 0, DM, (int)gridDim.x, (int)blockIdx.x, 256};
        typedef pg8::EpiWrap<EpU<EpBf16>, false, true> E_;
        pg8::gemm_phase<E_, pg8::SchedDense, false, false>(F.lds, DM, S, E_{{{(bf16*)(F.wsp() + WS_Y0), DM}}});
    } SEAM(14);
    if (IN(15)) { p_ln_router<1>(F); } SEAM(15);
    if (IN(16)) { p_moe<1>(F, bar, true); } SEAM(16);
    if (IN(18)) { p_ln2<1>(F); }
#undef IN
#undef SEAM
}

extern "C" void kernel_launch(void* const* d_in, const int* in_sizes, int n_in, void* d_out, int out_size, void* d_ws, size_t ws_size, hipStream_t stream) {
    static int grid = 0;
    if (grid == 0) {
        if (n_in != 23 || out_size != T * DM || ws_size < WS_END) { fprintf(stderr, "kernel_launch: unexpected shapes (n_in %d out %d ws %zu, need ws >= %zu)\n", n_in, out_size, ws_size, (size_t)WS_END); grid = -1; return; }
        int dev = 0, cus = 0, per_cu = 0;
        if (hipGetDevice(&dev) != hipSuccess || hipDeviceGetAttribute(&cus, hipDeviceAttributeMultiprocessorCount, dev) != hipSuccess) { grid = -1; return; }
        if (hipFuncSetAttribute((const void*)mk_fwd, hipFuncAttributeMaxDynamicSharedMemorySize, LDS_BYTES) != hipSuccess) { fprintf(stderr, "kernel_launch: hipFuncSetAttribute failed\n"); grid = -1; return; }
        if (hipOccupancyMaxActiveBlocksPerMultiprocessor(&per_cu, (const void*)mk_fwd, 512, LDS_BYTES) != hipSuccess || per_cu < 1) { fprintf(stderr, "kernel_launch: occupancy query says %d\n", per_cu); per_cu = 1; }
        (void)hipGetLastError();
        grid = cus;
    }
    if (grid < 0) return;
    (void)hipMemsetAsync((char*)d_ws + WS_CTL, 0, CTL_ZERO_BYTES, stream);
    Args a{};
    for (int i = 0; i < 23; ++i) a.in[i] = (const float*)d_in[i];
    a.out = (float*)d_out; a.ws = (unsigned char*)d_ws;
    if (MK_N_LAUNCHES == 1) { a.ph_lo = 0; a.ph_hi = NPH; hipLaunchKernelGGL(mk_fwd, dim3(grid), dim3(512), LDS_BYTES, stream, a); }
    else for (int p = 0; p < NPH; ++p) { a.ph_lo = p; a.ph_hi = p + 1; hipLaunchKernelGGL(mk_fwd, dim3(grid), dim3(512), LDS_BYTES, stream, a); }
}
```

```cpp
#include <hip/hip_runtime.h>
#include <cstdio>
#include <cstdint>

#ifndef REP0
#define REP0 1
#endif
#ifndef REP1
#define REP1 1
#endif
#ifndef REP11
#define REP11 1
#endif
#ifndef XBAR
#define XBAR 1
#endif
#ifndef DRY5
#define DRY5 0
#endif
#ifndef DRY8
#define DRY8 0
#endif
#ifndef REP4
#define REP4 1
#endif
#ifndef REP2
#define REP2 1
#endif
#ifndef REP3
#define REP3 1
#endif
#ifndef REP6
#define REP6 1
#endif
#ifndef REP7
#define REP7 1
#endif
#ifndef REP9
#define REP9 1
#endif
#ifndef REP10
#define REP10 1
#endif
#ifndef REP12
#define REP12 1
#endif
#ifndef REP1213
#define REP1213 1
#endif
#ifndef ATV
#define ATV 0
#endif
#ifndef DRY2
#define DRY2 0
#endif
#ifndef DRY12
#define DRY12 0
#endif
#ifndef ATTN_FUSED
#define ATTN_FUSED 1
#endif
#ifndef MK_N_LAUNCHES
#define MK_N_LAUNCHES 1
#endif

#define GAS __attribute__((address_space(1)))
#define LAS __attribute__((address_space(3)))
typedef unsigned short bf16;
typedef short bf16x8 __attribute__((ext_vector_type(8)));
typedef float f32x4 __attribute__((ext_vector_type(4)));
typedef unsigned u32x4 __attribute__((ext_vector_type(4)));
typedef unsigned u32x2 __attribute__((ext_vector_type(2)));
typedef GAS unsigned gu32;
#define RLX_AGENT __ATOMIC_RELAXED, __HIP_MEMORY_SCOPE_AGENT

constexpr int NB = 4, SEQ = 4096, DM = 1024, T = NB * SEQ, NH = 16, HKV = 4, HD = 64, NE = 16, FF = 512;
constexpr int NPH = 19;
constexpr float ALPHA = 1.4142135623730951f;
constexpr float LN_EPS = 1e-5f;
constexpr float C2 = 0.125f * 1.4426950408889634f;
constexpr int KVROWS = SEQ + 128;
constexpr int HROWS = 2 * T + NE * 256;

constexpr size_t MiB = 1u << 20;
constexpr size_t WS_CTL = 0, CTL_ZERO_BYTES = 1 * MiB;
constexpr size_t WS_MODP = 290 * MiB;
constexpr size_t WS_MOD = 3 * MiB;
constexpr size_t WS_PETP = 3 * MiB + 512 * 1024;
constexpr size_t WS_LIST = 4 * MiB;
constexpr size_t WS_LW = 6 * MiB;
constexpr size_t WS_WIN = 8 * MiB, WS_WOUT = 14 * MiB, WS_WKV = 16 * MiB, WS_WQG = 19 * MiB, WS_WO = 22 * MiB, WS_W1C = 24 * MiB;
constexpr size_t WS_WGU = 26 * MiB, WS_WDN = 90 * MiB;
constexpr size_t WS_U = 122 * MiB, WS_XB = 154 * MiB, WS_H = 186 * MiB, WS_Y0 = 226 * MiB, WS_Y1 = 258 * MiB;
constexpr size_t WS_R1 = 290 * MiB;
constexpr size_t WS_BG = WS_R1, WS_Z = WS_R1 + 32 * MiB, WS_A2 = WS_R1 + 64 * MiB;
constexpr size_t WS_Q = WS_R1, WS_O = WS_R1 + 32 * MiB, WS_KV = WS_R1 + 64 * MiB;
constexpr size_t KVBUF_ELEMS = (size_t)16 * KVROWS * 64;
constexpr size_t WS_TB = WS_R1 + 114 * MiB, WS_KC = WS_R1 + 130 * MiB, WS_VC = WS_KC + 512 * 1024, WS_GATE = WS_R1 + 131 * MiB;
constexpr size_t WS_END = WS_R1 + 135 * MiB;
static_assert(WS_Y1 == WS_Y0 + (size_t)T * DM * 2, "Y1 follows Y0");
static_assert(WS_KV + 6 * KVBUF_ELEMS * 2 <= WS_TB, "kv buffers");
static_assert((size_t)HROWS * FF * 2 <= 40 * MiB, "H buffer");
constexpr int CW_CNT = 1024;
constexpr int CW_BAR = 4096;

constexpr int RING_BYTES = 131072;
constexpr int LDSCTL_OFF = 143360, MISC_OFF = LDSCTL_OFF + 320;
constexpr int LDS_BYTES = 147456;

#define LDS_WAIT() asm volatile("s_waitcnt lgkmcnt(0)" ::: "memory")
__device__ __forceinline__ unsigned f2bf(float f) { unsigned u = __builtin_bit_cast(unsigned, f); return (u + 0x7fffu + ((u >> 16) & 1u)) >> 16; }
typedef float f32x2v __attribute__((ext_vector_type(2)));
typedef __bf16 bf16x2_t __attribute__((ext_vector_type(2)));
__device__ __forceinline__ unsigned pk2(float lo, float hi) { f32x2v v = {lo, hi}; bf16x2_t b = __builtin_convertvector(v, bf16x2_t); return __builtin_bit_cast(unsigned, b); }
__device__ __forceinline__ float bf2f(unsigned short h) { return __builtin_bit_cast(float, (unsigned)h << 16); }
__device__ __forceinline__ float bflo(unsigned w) { return __builtin_bit_cast(float, w << 16); }
__device__ __forceinline__ float bfhi(unsigned w) { return __builtin_bit_cast(float, w & 0xffff0000u); }
__device__ __forceinline__ float wave_sum(float v) {
#pragma unroll
    for (int o = 1; o < 64; o <<= 1) v += __shfl_xor(v, o);
    return v;
}
__device__ __forceinline__ float wave_max(float v) {
#pragma unroll
    for (int o = 1; o < 64; o <<= 1) v = fmaxf(v, __shfl_xor(v, o));
    return v;
}
__device__ __forceinline__ float silu_f(float a) { return a * __builtin_amdgcn_rcpf(1.f + __builtin_amdgcn_exp2f(-1.4426950408889634f * a)); }
__device__ __forceinline__ void st_bf4(bf16* p, f32x4 v) { u32x2 w; w.x = pk2(v[0], v[1]); w.y = pk2(v[2], v[3]); *(u32x2*)p = w; }
__device__ __forceinline__ void st_bf8(bf16* p, f32x4 a, f32x4 b) { u32x4 w; w.x = pk2(a[0], a[1]); w.y = pk2(a[2], a[3]); w.z = pk2(b[0], b[1]); w.w = pk2(b[2], b[3]); *(u32x4*)p = w; }

#define XB_TMO      128
#define XB_XCNT(j)  (256  + 64 * (j))
#define XB_XSUB(j)  (1280 + 64 * (j))
#define XB_XGEN(j)  (2304 + 64 * (j))
#define XB_TOP      3328
#define XB_TOPGEN   3392
#define XCD_BAR_WORDS 3456
#define XB_SPIN_CAP (1u << 22)
__device__ __forceinline__ unsigned xb_ld(unsigned* p)              { return __hip_atomic_load(p, __ATOMIC_RELAXED, __HIP_MEMORY_SCOPE_AGENT); }
__device__ __forceinline__ unsigned xb_add(unsigned* p, unsigned v) { return __hip_atomic_fetch_add(p, v, __ATOMIC_RELAXED, __HIP_MEMORY_SCOPE_AGENT); }
__device__ __forceinline__ unsigned xb_xcc_id() { return (unsigned)__builtin_amdgcn_s_getreg((3 << 11) | 20) & 0xFu; }
#define XB_SPIN(cond, bar) do { unsigned _sp = 0; while (cond) { __builtin_amdgcn_s_sleep(1); \
    if ((++_sp & 255u) == 0u) { if (xb_ld(&(bar)[XB_TMO])) break; if (_sp > XB_SPIN_CAP) { atomicAdd(&(bar)[XB_TMO], 1u); break; } } } } while (0)
struct XcdBarrier { unsigned* bar; unsigned x; volatile LAS unsigned* st; };
__device__ __forceinline__ XcdBarrier xcd_barrier_post(unsigned* bar, volatile LAS unsigned* st) {
    XcdBarrier b; b.bar = bar; b.x = xb_xcc_id(); b.st = st;
    if (threadIdx.x == 0) (void)xb_add(&bar[XB_XCNT(b.x)], 1u);
    return b;
}
__device__ __forceinline__ void xcd_barrier_complete(unsigned* bar, unsigned x, unsigned& nloc, unsigned& nx) {
    const unsigned G = gridDim.x * gridDim.y * gridDim.z;
    unsigned sum, cnt, mine, sp = 0u;
    for (;;) {
        sum = 0u; cnt = 0u; mine = 0u;
#pragma unroll
        for (unsigned j = 0; j < 16; ++j) { const unsigned c = xb_ld(&bar[XB_XCNT(j)]); sum += c; cnt += (c > 0u) ? 1u : 0u; mine = (j == x) ? c : mine; }
        if (sum == G) break;
        __builtin_amdgcn_s_sleep(1);
        if ((++sp & 255u) == 0u) { if (xb_ld(&bar[XB_TMO])) break; if (sp > XB_SPIN_CAP) { atomicAdd(&bar[XB_TMO], 1u); break; } }
    }
    nloc = mine > 0u ? mine : 1u; nx = cnt > 0u ? cnt : 1u;
}
__device__ __forceinline__ void xcd_barrier(const XcdBarrier& b) {
    asm volatile("s_waitcnt vmcnt(0)" ::: "memory");
    __syncthreads();
    if (threadIdx.x == 0) {
        unsigned* bar = b.bar;
        __builtin_amdgcn_s_waitcnt(0);
        unsigned nloc = b.st[0], nx = b.st[1];
        if (nloc == 0u) { xcd_barrier_complete(bar, b.x, nloc, nx); b.st[0] = nloc; b.st[1] = nx; }
        const unsigned old = xb_add(&bar[XB_XSUB(b.x)], 1u);
        const unsigned gen = old / nloc;
        if (old + 1u == (gen + 1u) * nloc) {
            __builtin_amdgcn_fence(__ATOMIC_RELEASE, "agent");
            asm volatile("s_waitcnt vmcnt(0)" ::: "memory");
            const unsigned og = xb_add(&bar[XB_TOP], 1u);
            const unsigned tg = og / nx;
            if (og + 1u == (tg + 1u) * nx) xb_add(&bar[XB_TOPGEN], 1u);
            else XB_SPIN(xb_ld(&bar[XB_TOPGEN]) == tg, bar);
            __builtin_amdgcn_fence(__ATOMIC_ACQUIRE, "agent");
            xb_add(&bar[XB_XGEN(b.x)], 1u);
            asm volatile("s_waitcnt vmcnt(0)" ::: "memory");
        } else {
            XB_SPIN(xb_ld(&bar[XB_XGEN(b.x)]) == gen, bar);
            __builtin_amdgcn_fence(__ATOMIC_ACQUIRE, "agent");
            asm volatile("s_waitcnt vmcnt(0)" ::: "memory");
        }
    }
    __syncthreads();
}

constexpr int PTR_OFF = MISC_OFF + 512;
struct Frame {
    LAS unsigned char* lds;
    volatile LAS unsigned* MISC;
    int tid, lane, wave, gw, NGW;
    __device__ __forceinline__ unsigned long long ptr(int i) const { const LAS unsigned* p = (const LAS unsigned*)(lds + PTR_OFF) + 2 * i;
        const unsigned lo = __builtin_amdgcn_readfirstlane(p[0]), hi = __builtin_amdgcn_readfirstlane(p[1]); return ((unsigned long long)hi << 32) | lo; }
    __device__ __forceinline__ const float* inp(int i) const { return (const float*)(const GAS float*)ptr(i); }
    __device__ __forceinline__ float* outp() const { return (float*)(GAS float*)ptr(23); }
    __device__ __forceinline__ unsigned char* wsp() const { return (unsigned char*)(GAS unsigned char*)ptr(24); }
    __device__ __forceinline__ gu32* ctlp() const { return (gu32*)(wsp() + WS_CTL); }
};
enum { I_X = 0, I_C, I_ADAW, I_ADAB, I_LNG, I_LNB, I_CWIN, I_CONVW, I_CONVB, I_CWOUT, I_WKV, I_PE, I_CW1, I_CB1, I_CW2, I_CB2, I_WQG, I_BG, I_WO, I_RW, I_RB, I_WGU, I_WDN };

__device__ __forceinline__ void transpose_item(const float* W, int ld, int nvalid, int K, bf16* WT, int dstrow0, int k0, int n0, LAS float* scr, int lane) {
    const int n = n0 + (lane & 31);
#pragma unroll 8
    for (int i = 0; i < 32; ++i) { const int kk = 2 * i + (lane >> 5); scr[kk * 33 + (lane & 31)] = (n < nvalid) ? W[(size_t)(k0 + kk) * ld + n] : 0.f; }
    LDS_WAIT(); asm volatile("" ::: "memory");
    const int c = lane & 7;
#pragma unroll
    for (int j = 0; j < 4; ++j) { const int nl = (lane >> 3) + 8 * j; const LAS float* s = scr + (8 * c) * 33 + nl;
        u32x4 o; o.x = pk2(s[0 * 33], s[1 * 33]); o.y = pk2(s[2 * 33], s[3 * 33]); o.z = pk2(s[4 * 33], s[5 * 33]); o.w = pk2(s[6 * 33], s[7 * 33]);
        *(u32x4*)(WT + (size_t)(dstrow0 + nl) * K + k0 + 8 * c) = o; }
    LDS_WAIT(); asm volatile("" ::: "memory");
}
__device__ __forceinline__ int pairmap(int n0, int half) {
    return n0 < half ? ((n0 >> 7) * 256 + (n0 & 127)) : ((((n0 - half) >> 7) * 256) + 128 + ((n0 - half) & 127));
}
__device__ __forceinline__ void p0_prologue(Frame& F) {
    LAS float* scr = (LAS float*)(F.lds + F.wave * 16384);
    const int lane = F.lane;
    for (int r = F.gw; r < 768 + 256; r += F.NGW) {
        if (r < 768) {
            const int l = r / 384, rem = r % 384, dch = rem / 24, e = (rem % 24) * 256 + 4 * lane;
            const float* aw = F.inp(I_ADAW) + (size_t)l * 1024 * 6144 + e; const float* c = F.inp(I_C);
            f32x4 a0 = (f32x4){0.f, 0.f, 0.f, 0.f}, a1 = a0, a2 = a0, a3 = a0;
#pragma unroll 16
            for (int d = dch * 64; d < dch * 64 + 64; ++d) {
                const f32x4 w = *(const f32x4*)(aw + (size_t)d * 6144);
                const float c0 = c[d], c1 = c[1024 + d], c2 = c[2048 + d], c3 = c[3072 + d];
                a0 += w * (c0 / (1.f + __expf(-c0))); a1 += w * (c1 / (1.f + __expf(-c1))); a2 += w * (c2 / (1.f + __expf(-c2))); a3 += w * (c3 / (1.f + __expf(-c3)));
            }
            float* mp = (float*)(F.wsp() + WS_MODP) + (size_t)dch * 49152 + (size_t)(l * 4) * 6144 + e;
            *(f32x4*)mp = a0; *(f32x4*)(mp + 6144) = a1; *(f32x4*)(mp + 2 * 6144) = a2; *(f32x4*)(mp + 3 * 6144) = a3;
        } else {
            const int q = r - 768, i = q / 128, rem = q % 128, cch = rem / 32, kch = rem % 32, c = cch * 64 + lane;
            const float* pe = F.inp(I_PE) + i * 2048; const float* w1 = F.inp(I_CW1) + (size_t)i * 2048 * 256 + c;
            float a = 0.f;
#pragma unroll 16
            for (int kk = kch * 64; kk < kch * 64 + 64; ++kk) a += pe[kk] * w1[(size_t)kk * 256];
            ((float*)(F.wsp() + WS_PETP))[(kch * 2 + i) * 256 + c] = a;
        }
    }
    constexpr int I1 = 16 * 96, I2 = 512, I3 = 16 * 48, I4 = 16 * 40, I5 = 512, I6 = 512, I7 = 32 * 512, I8 = 32 * 256;
    constexpr int NITEMS = I1 + I2 + I3 + I4 + I5 + I6 + I7 + I8;
    for (int it = F.gw; it < NITEMS; it += F.NGW) {
        int r = it;
        if (r < I1) { const int kb = r / 96, nb = r % 96, n0 = nb * 32;
            const int dr = n0 < 1024 ? n0 : 1024 + pairmap(n0 - 1024, 1024);
            transpose_item(F.inp(I_CWIN), 3072, 3072, 1024, (bf16*)(F.wsp() + WS_WIN), dr, kb * 64, n0, scr, lane); continue; } r -= I1;
        if (r < I2) { transpose_item(F.inp(I_CWOUT), 1024, 1024, 1024, (bf16*)(F.wsp() + WS_WOUT), (r % 32) * 32, (r / 32) * 64, (r % 32) * 32, scr, lane); continue; } r -= I2;
        if (r < I3) { transpose_item(F.inp(I_WKV), 1536, 1536, 1024, (bf16*)(F.wsp() + WS_WKV), (r % 48) * 32, (r / 48) * 64, (r % 48) * 32, scr, lane); continue; } r -= I3;
        if (r < I4) { transpose_item(F.inp(I_WQG), 1072, 1072, 1024, (bf16*)(F.wsp() + WS_WQG), (r % 40) * 32, (r / 40) * 64, (r % 40) * 32, scr, lane); continue; } r -= I4;
        if (r < I5) { transpose_item(F.inp(I_WO), 1024, 1024, 1024, (bf16*)(F.wsp() + WS_WO), (r % 32) * 32, (r / 32) * 64, (r % 32) * 32, scr, lane); continue; } r -= I5;
        if (r < I6) { const int sub = r / 128, q = r % 128, i = sub >> 1, hh = sub & 1;
            transpose_item(F.inp(I_CW1) + (size_t)i * 2048 * 256 + (size_t)hh * 1024 * 256, 256, 256, 1024, (bf16*)(F.wsp() + WS_W1C) + (size_t)i * 512 * 1024, hh * 256 + (q % 8) * 32, (q / 8) * 64, (q % 8) * 32, scr, lane); continue; } r -= I6;
        if (r < I7) { const int mi = r / 512, q = r % 512, n0 = (q % 32) * 32;
            transpose_item(F.inp(I_WGU) + (size_t)mi * 1024 * 1024, 1024, 1024, 1024, (bf16*)(F.wsp() + WS_WGU) + (size_t)mi * 1024 * 1024, pairmap(n0, 512), (q / 32) * 64, n0, scr, lane); continue; } r -= I7;
        { const int mi = r / 256, q = r % 256, n0 = (q % 32) * 32;
            transpose_item(F.inp(I_WDN) + (size_t)mi * 512 * 1024, 1024, 1024, 512, (bf16*)(F.wsp() + WS_WDN) + (size_t)mi * 1024 * 512, n0, (q / 32) * 64, n0, scr, lane); }
    }
}
__device__ __forceinline__ f32x4 mod4_partials(const Frame& F, int l, int b, int e) {
    f32x4 s = *(const f32x4*)(F.inp(I_ADAB) + l * 6144 + e);
    const float* mp = (const float*)(F.wsp() + WS_MODP) + (size_t)(l * 4 + b) * 6144 + e;
#pragma unroll
    for (int d = 0; d < 16; ++d) s += *(const f32x4*)(mp + (size_t)d * 49152);
    return s;
}
__device__ __forceinline__ void p1_mod_u0(Frame& F) {
    float* MOD = (float*)(F.wsp() + WS_MOD);
    for (int ch = F.gw; ch < 768; ch += F.NGW) {
        const int idx = ch * 64 + F.lane, lb = idx / 6144, e = idx % 6144;
        float s = F.inp(I_ADAB)[(lb >> 2) * 6144 + e];
        const float* mp = (const float*)(F.wsp() + WS_MODP) + idx;
#pragma unroll
        for (int d = 0; d < 16; ++d) s += mp[(size_t)d * 49152];
        MOD[idx] = s;
    }
    for (int q = F.gw; q < 2; q += F.NGW) { const int i = q, c = 4 * F.lane;
        f32x4 pe = *(const f32x4*)(F.inp(I_CB1) + i * 256 + c); const float* PETP = (const float*)(F.wsp() + WS_PETP);
#pragma unroll
        for (int k = 0; k < 32; ++k) pe += *(const f32x4*)(PETP + (k * 2 + i) * 256 + c);
        *(f32x4*)((float*)(F.wsp() + WS_PETP) + 64 * 256 + i * 256 + c) = pe; }
    bf16* U = (bf16*)(F.wsp() + WS_U);
    LAS f32x4* msh = (LAS f32x4*)F.lds;
    for (int c0 = blockIdx.x * 64; c0 < T; c0 += gridDim.x * 64) {
        const int b = c0 >> 12;
        __syncthreads();
        { const int t = F.tid, e = 4 * (t & 255) + (t >> 8) * 1024; f32x4 v = mod4_partials(F, 0, b, e); if (t >= 256) v = v + 1.0f; msh[t] = v; }
        __syncthreads();
        f32x4 sh[4], sc[4];
#pragma unroll
        for (int j = 0; j < 4; ++j) { sh[j] = msh[F.lane + 64 * j]; sc[j] = msh[256 + F.lane + 64 * j]; }
        const int m0 = c0 + F.wave * 8;
#pragma unroll 1
        for (int m = m0; m < m0 + 8; m += 2) {
            f32x4 v[2][4];
#pragma unroll
            for (int r = 0; r < 2; ++r)
#pragma unroll
                for (int j = 0; j < 4; ++j) v[r][j] = *(const f32x4*)(F.inp(I_X) + (size_t)(m + r) * DM + 4 * F.lane + 256 * j);
#pragma unroll
            for (int r = 0; r < 2; ++r)
#pragma unroll
                for (int j = 0; j < 4; ++j) st_bf4(U + (size_t)(m + r) * DM + 4 * F.lane + 256 * j, v[r][j] * sc[j] + sh[j]);
        }
    }
}
template <bool PAIR, class AR, class EP>
__device__ __forceinline__ void gemm_wave_tile(const AR& arow, const bf16* Btile, int K, int m0, int nbase, const EP& ep, int lane) {
    const int fr = lane & 15, fq = lane >> 4;
    f32x4 acc[4][4];
#pragma unroll
    for (int i = 0; i < 4; ++i)
#pragma unroll
        for (int j = 0; j < 4; ++j) acc[i][j] = (f32x4){0.f, 0.f, 0.f, 0.f};
    const bf16* ap[4]; const bf16* bp[4];
#pragma unroll
    for (int i = 0; i < 4; ++i) ap[i] = arow(m0 + 16 * i + fr) + 8 * fq;
#pragma unroll
    for (int j = 0; j < 4; ++j) { const int nr = PAIR ? ((j & 1) * 16 + (j >> 1) * 128) : 16 * j; bp[j] = Btile + (size_t)(nr + fr) * K + 8 * fq; }
    for (int k0 = 0; k0 < K; k0 += 32) {
        bf16x8 a[4], b[4];
#pragma unroll
        for (int i = 0; i < 4; ++i) a[i] = *(const bf16x8*)(ap[i] + k0);
#pragma unroll
        for (int j = 0; j < 4; ++j) b[j] = *(const bf16x8*)(bp[j] + k0);
#pragma unroll
        for (int i = 0; i < 4; ++i)
#pragma unroll
            for (int j = 0; j < 4; ++j) acc[i][j] = __builtin_amdgcn_mfma_f32_16x16x32_bf16(b[j], a[i], acc[i][j], 0, 0, 0);
    }
#pragma unroll
    for (int i = 0; i < 4; ++i) {
        const int m = m0 + 16 * i + fr;
        if constexpr (PAIR) {
#pragma unroll
            for (int j = 0; j < 2; ++j) ep.pair(m, nbase + 16 * j + 4 * fq, acc[i][j], acc[i][j + 2]);
        } else {
#pragma unroll
            for (int j = 0; j < 4; ++j) ep(m, nbase + 16 * j + 4 * fq, acc[i][j]);
        }
    }
}
struct ARowPlain { const bf16* A; int K; __device__ __forceinline__ const bf16* operator()(int m) const { return A + (size_t)m * K; } };

struct EpBf16 { bf16* O; int ld; __device__ __forceinline__ void operator()(int m, int n, f32x4 v) const { st_bf4(O + (size_t)m * ld + n, v); }
    __device__ __forceinline__ void op8(int m, int n, f32x4 a, f32x4 b) const { st_bf8(O + (size_t)m * ld + n, a, b); } };
struct EpMulPair { bf16* O; int ld; __device__ __forceinline__ void pair(int m, int ch, f32x4 a, f32x4 b) const { st_bf4(O + (size_t)m * ld + ch, a * b); }
    __device__ __forceinline__ void pair8(int m, int ch, f32x4 a0, f32x4 a1, f32x4 b0, f32x4 b1) const { st_bf8(O + (size_t)m * ld + ch, a0 * b0, a1 * b1); } };
struct EpSiluPair { bf16* O; int ld; __device__ __forceinline__ void pair(int m, int ch, f32x4 a, f32x4 b) const {
    f32x4 s; for (int r = 0; r < 4; ++r) s[r] = silu_f(a[r]) * b[r]; st_bf4(O + (size_t)m * ld + ch, s); } };
__device__ __forceinline__ f32x4 ld_bf4(const bf16* p) { const u32x2 w = *(const u32x2*)p; return (f32x4){bflo(w.x), bfhi(w.x), bflo(w.y), bfhi(w.y)}; }
struct EpRes { const float* base; bf16* out; const float* gmod;
    __device__ __forceinline__ void operator()(int m, int n, f32x4 v) const { const int b = m >> 12; const f32x4 g = *(const f32x4*)(gmod + b * 6144 + n);
        const f32x4 x = *(const f32x4*)(base + (size_t)m * DM + n); st_bf4(out + (size_t)m * DM + n, x * ALPHA + g * v); } };
struct EpResB { bf16* res; const float* gmod;
    __device__ __forceinline__ void operator()(int m, int n, f32x4 v) const { const int b = m >> 12; const f32x4 g = *(const f32x4*)(gmod + b * 6144 + n);
        bf16* p = res + (size_t)m * DM + n; st_bf4(p, ld_bf4(p) * ALPHA + g * v); } };
__device__ __forceinline__ int kfrag_off(int kk, int d) { return ((((kk >> 5) * 4 + (d >> 4)) * 2 + ((d >> 3) & 1)) * 32 + (kk & 31)) * 8 + (d & 7); }
__device__ __forceinline__ int vfrag_off(int kk, int d) { return ((((d >> 5) * 4 + (kk >> 4)) * 2 + ((kk >> 2) & 1)) * 32 + (d & 31)) * 8 + ((((kk >> 3) & 1) << 2) | (kk & 3)); }
struct EpKV { bf16* KV; __device__ __forceinline__ void operator()(int m, int n, f32x4 v) const {
    const int j = n >> 8, hk = (n >> 6) & 3, d = n & 63, b = m >> 12, t = m & 4095;
    bf16* base = KV + (size_t)j * KVBUF_ELEMS + (size_t)(b * 4 + hk) * KVROWS * 64;
    if (j < 2) st_bf4(base + (size_t)t * 64 + d, v);
    else if ((j & 1) == 0) st_bf4(base + (size_t)(t >> 6) * 4096 + kfrag_off(t & 63, d), v);
    else { bf16* tp = base + (size_t)(t >> 6) * 4096;
        for (int r = 0; r < 4; ++r) tp[vfrag_off(t & 63, d + r)] = (bf16)f2bf(v[r]); } }
    __device__ __forceinline__ void op8(int m, int n, f32x4 a, f32x4 c) const {
    const int j = n >> 8, hk = (n >> 6) & 3, d = n & 63, b = m >> 12, t = m & 4095;
    bf16* base = KV + (size_t)j * KVBUF_ELEMS + (size_t)(b * 4 + hk) * KVROWS * 64;
    if (j < 2) st_bf8(base + (size_t)t * 64 + d, a, c);
    else if ((j & 1) == 0) st_bf8(base + (size_t)(t >> 6) * 4096 + kfrag_off(t & 63, d), a, c);
    else { bf16* tp = base + (size_t)(t >> 6) * 4096;
        for (int r = 0; r < 4; ++r) { tp[vfrag_off(t & 63, d + r)] = (bf16)f2bf(a[r]); tp[vfrag_off(t & 63, d + 4 + r)] = (bf16)f2bf(c[r]); } } } };
struct EpQG { bf16* Q; float* GATE; const float* bg; __device__ __forceinline__ void operator()(int m, int n, f32x4 v) const {
    if (n < 1024) st_bf4(Q + (size_t)m * DM + n, v * C2);
    else { for (int r = 0; r < 4; ++r) { const int i = n - 1024 + r; if (i < 48) GATE[(size_t)m * 48 + i] = 1.f / (1.f + __expf(-(v[r] + bg[i]))); } } }
    __device__ __forceinline__ void op8(int m, int n, f32x4 a, f32x4 c) const {
    if (n < 1024) st_bf8(Q + (size_t)m * DM + n, a * C2, c * C2);
    else { (*this)(m, n, a); (*this)(m, n + 4, c); } } };
struct EpF32 { float* O; int ld; __device__ __forceinline__ void operator()(int m, int n, f32x4 v) const { *(f32x4*)(O + (size_t)m * ld + n) = v; } };

template <bool PAIR, class AR, class EP>
__device__ __forceinline__ void gemm_dense(Frame& F, const AR& arow, const bf16* Bt, int K, int nM64, int nN64, int chbase, const EP& ep) {
    const int total = nM64 * nN64;
    for (int it = F.gw; it < total; it += F.NGW) {
        const int ni = it % nN64, mt = it / nN64;
        if constexpr (PAIR) { const int pn = ni >> 2, q = ni & 3;
            gemm_wave_tile<true>(arow, Bt + (size_t)(pn * 256 + q * 32) * K, K, mt * 64, chbase + pn * 128 + q * 32, ep, F.lane);
        } else gemm_wave_tile<false>(arow, Bt + (size_t)(ni * 64) * K, K, mt * 64, chbase + ni * 64, ep, F.lane);
    }
}

namespace pg8 {
#define PG8_LAS __attribute__((address_space(3)))
constexpr int BM = 256, BK = 64, HALF = 128, HTB = HALF * BK * 2, STAGE_BYTES = 8 * HTB, NXCD = 8, WGM = 8;
__device__ __forceinline__ int lds_byte(int r, int c) { const int st = (r >> 4) * 2 + (c >> 5), rr = r & 15, cc = c & 31, ob = rr * 64 + cc * 2; return st * 1024 + (ob ^ (((ob >> 9) & 1) << 5)); }
__device__ __forceinline__ void stage_rc(int b, int& R, int& C) { const int st = b / 1024, sb = b % 1024, swz = sb ^ (((sb >> 9) & 1) << 5); R = (st >> 1) * 16 + swz / 64; C = (st & 1) * 32 + (swz % 64) / 2; }
struct Unit { const char* A; const char* B; int row0, col0, e, pos0, cnt; };
__device__ __forceinline__ bool static_order(int i, int G, int c, int nM, int nN, int& pm, int& pn) {
    const int nwg = nM * nN; const long L = (long)i * G + c; if (L >= nwg) return false;
    int wgid = (int)L; { const int q = nwg / NXCD, r = nwg % NXCD, xcd = wgid % NXCD, off = wgid / NXCD; wgid = (xcd < r ? xcd * (q + 1) : r * (q + 1) + (xcd - r) * q) + off; }
    const int nig = WGM * nN, gid = wgid / nig, fm = gid * WGM, gsz = (nM - fm) < WGM ? (nM - fm) : WGM;
    pm = fm + ((wgid % nig) % gsz); pn = (wgid % nig) / gsz; return true;
}
__device__ __forceinline__ void voff_plain(const int (&R)[2], const int (&C)[2], int K, unsigned (&v)[2][2]) {
#pragma unroll
    for (int h = 0; h < 2; ++h)
#pragma unroll
        for (int i = 0; i < 2; ++i) v[h][i] = (unsigned)((h * HALF + R[i]) * K + C[i]) * 2u;
}
__device__ __forceinline__ int perm32(int rho) { const int n = rho >> 4, i = rho & 15; return 8 * (i >> 2) + 4 * n + (i & 3); }
template <class EP, bool PAIR, bool PERM_ = false> struct EpiWrap {
    static constexpr bool PERM = PERM_;
    EP ep;
    __device__ __forceinline__ void operator()(const f32x4 (&acc)[2][2][4][2], const Unit& u, int wr, int wc, int fr, int fq) const {
#pragma unroll
        for (int ai = 0; ai < 2; ++ai)
#pragma unroll
            for (int m = 0; m < 4; ++m) { const int row = u.row0 + ai * HALF + wr * 64 + m * 16 + fr;
                if constexpr (PERM_) {
                    if constexpr (PAIR) ep.pair8(u, row, u.col0 + wc * 32 + 8 * fq, acc[ai][0][m][0], acc[ai][0][m][1], acc[ai][1][m][0], acc[ai][1][m][1]);
                    else {
#pragma unroll
                        for (int bj = 0; bj < 2; ++bj) ep.op8(u, row, u.col0 + bj * HALF + wc * 32 + 8 * fq, acc[ai][bj][m][0], acc[ai][bj][m][1]); }
                } else if constexpr (PAIR) {
#pragma unroll
                    for (int n = 0; n < 2; ++n) ep.pair(u, row, u.col0 + wc * 32 + 16 * n + 4 * fq, acc[ai][0][m][n], acc[ai][1][m][n]);
                } else {
#pragma unroll
                    for (int bj = 0; bj < 2; ++bj)
#pragma unroll
                        for (int n = 0; n < 2; ++n) ep(u, row, u.col0 + bj * HALF + wc * 32 + 16 * n + 4 * fq, acc[ai][bj][m][n]);
                } }
    }
};
template <class Epi, class Sched, bool ALIGN_EPI, bool GATHER>
__device__ __forceinline__ void gemm_phase(PG8_LAS unsigned char* lds, const int K, const Sched& S, const Epi& E) {
    const int tid = threadIdx.x, wid = __builtin_amdgcn_readfirstlane(tid >> 6), lane = tid & 63, wr = wid >> 2, wc = wid & 3, fr = lane & 15, fq = lane >> 4;
    const int nt = K / BK;
    int R[2], C[2]; unsigned voffB[2]; unsigned vC[2][2], vN[2][2];
#pragma unroll
    for (int i = 0; i < 2; ++i) { stage_rc(tid * 16 + i * 8192, R[i], C[i]); const int Rb = Epi::PERM ? ((R[i] & ~31) | perm32(R[i] & 31)) : R[i]; voffB[i] = (unsigned)(Rb * K + C[i]) * 2u; }
    const size_t kstep = (size_t)(BK * 2);
    const size_t hstep = (size_t)HALF * K * 2;
    const unsigned ldsw = (unsigned)wid * 1024u;
    const int aoff = lds_byte(wr * 64 + fr, fq * 8), boff = lds_byte(wc * 32 + fr, fq * 8);
#define PG8_SA(b, h) (((b) * 2 + (h)) * HTB)
#define PG8_SB(b, h) ((4 + (b) * 2 + (h)) * HTB)
#define PG8_STAGE(bufoff, gbase, voff) do { _Pragma("unroll") for (int _i = 0; _i < 2; ++_i) \
        __builtin_amdgcn_global_load_lds((const unsigned*)((const char*)(gbase) + (voff)[_i]), (PG8_LAS unsigned*)(lds + (bufoff) + ldsw + _i * 8192), 16, 0, 0); } while (0)
#define PG8_LDA(dst, b, h) do { _Pragma("unroll") for (int m = 0; m < 4; ++m) _Pragma("unroll") for (int k = 0; k < 2; ++k) dst[m][k] = *(const PG8_LAS bf16x8*)(lds + PG8_SA(b, h) + aoff + m * 2048 + k * 1024); } while (0)
#define PG8_LDB(dst, b, h) do { _Pragma("unroll") for (int n = 0; n < 2; ++n) _Pragma("unroll") for (int k = 0; k < 2; ++k) dst[n][k] = *(const PG8_LAS bf16x8*)(lds + PG8_SB(b, h) + boff + n * 2048 + k * 1024); } while (0)
#define PG8_MMA(ai, bj, At, Bt) do { __builtin_amdgcn_s_setprio(1); _Pragma("unroll") for (int m = 0; m < 4; ++m) _Pragma("unroll") for (int n = 0; n < 2; ++n) _Pragma("unroll") for (int k = 0; k < 2; ++k) \
        acc[ai][bj][m][n] = __builtin_amdgcn_mfma_f32_16x16x32_bf16(Bt[n][k], At[m][k], acc[ai][bj][m][n], 0, 0, 0); __builtin_amdgcn_s_setprio(0); } while (0)
#define PG8_WAIT_V(n) asm volatile("s_waitcnt vmcnt(" #n ")" ::: "memory")
#define PG8_WAIT_L(n) asm volatile("s_waitcnt lgkmcnt(" #n ")" ::: "memory")
#define PG8_BAR __builtin_amdgcn_s_barrier()
#define PG8_SCHED __builtin_amdgcn_sched_barrier(0)
    Unit cur, nxt; int ui = 0;
    if (!S.next(0, cur)) return;
    S.voff(cur, R, C, K, vC);
    f32x4 acc[2][2][4][2];
#pragma unroll
    for (int a = 0; a < 2; ++a)
#pragma unroll
        for (int b = 0; b < 2; ++b)
#pragma unroll
            for (int m = 0; m < 4; ++m)
#pragma unroll
                for (int n = 0; n < 2; ++n) acc[a][b][m][n] = (f32x4){0.f, 0.f, 0.f, 0.f};
    bf16x8 At[4][2], B0[2][2], B1[2][2];
    const char* cA = cur.A; const char* cB = cur.B;
    PG8_STAGE(PG8_SB(0, 0), cB, voffB); PG8_STAGE(PG8_SB(0, 1), cB + hstep, voffB); PG8_STAGE(PG8_SA(0, 0), cA, vC[0]); PG8_STAGE(PG8_SA(0, 1), cA, vC[1]);
    if (wr == 1) PG8_BAR;
    PG8_WAIT_V(2); PG8_BAR;
    PG8_STAGE(PG8_SB(1, 0), cB + kstep, voffB); PG8_STAGE(PG8_SA(1, 0), cA + kstep, vC[0]); PG8_STAGE(PG8_SB(1, 1), cB + hstep + kstep, voffB);
    PG8_WAIT_V(6); PG8_BAR;
    for (;;) {
        const bool has_next = S.next(ui + 1, nxt);
        const char* nA = has_next ? nxt.A : cA; const char* nB = has_next ? nxt.B : cB;
        if constexpr (GATHER) { if (has_next) S.voff(nxt, R, C, K, vN); else { vN[0][0] = vC[0][0]; vN[0][1] = vC[0][1]; vN[1][0] = vC[1][0]; vN[1][1] = vC[1][1]; } }
        for (int t = 0; t < nt; t += 2) {
            const bool last = (t == nt - 2);
            const char* a1 = cA + (size_t)(t + 1) * kstep;
            const char* a2 = last ? nA : cA + (size_t)(t + 2) * kstep; const char* b2 = last ? nB : cB + (size_t)(t + 2) * kstep;
            const char* a3 = a2 + kstep; const char* b3 = b2 + kstep;
            unsigned v2[2][2];
#pragma unroll
            for (int h = 0; h < 2; ++h)
#pragma unroll
                for (int i = 0; i < 2; ++i) v2[h][i] = (GATHER && last) ? vN[h][i] : vC[h][i];
            PG8_LDB(B0, 0, 0); PG8_LDB(B1, 0, 1); PG8_SCHED; PG8_LDA(At, 0, 0); PG8_STAGE(PG8_SA(1, 1), a1, vC[1]);
            PG8_WAIT_V(8); PG8_WAIT_L(0); PG8_BAR; PG8_MMA(0, 0, At, B0); PG8_MMA(0, 1, At, B1); PG8_BAR; PG8_SCHED;
            PG8_LDA(At, 0, 1); PG8_STAGE(PG8_SB(0, 0), b2, voffB); PG8_STAGE(PG8_SB(0, 1), b2 + hstep, voffB); PG8_STAGE(PG8_SA(0, 0), a2, v2[0]);
            PG8_WAIT_V(8); PG8_WAIT_L(0); PG8_BAR; PG8_MMA(1, 0, At, B0); PG8_MMA(1, 1, At, B1); PG8_BAR; PG8_SCHED;
            PG8_LDB(B0, 1, 0); PG8_LDB(B1, 1, 1); PG8_SCHED; PG8_LDA(At, 1, 0); PG8_STAGE(PG8_SA(0, 1), a2, v2[1]);
            PG8_WAIT_V(8); PG8_WAIT_L(0); PG8_BAR; PG8_MMA(0, 0, At, B0); PG8_MMA(0, 1, At, B1); PG8_BAR; PG8_SCHED;
            PG8_LDA(At, 1, 1); PG8_STAGE(PG8_SB(1, 0), b3, voffB); PG8_STAGE(PG8_SB(1, 1), b3 + hstep, voffB); PG8_STAGE(PG8_SA(1, 0), a3, v2[0]);
            PG8_WAIT_V(8); PG8_WAIT_L(0); PG8_BAR; PG8_MMA(1, 0, At, B0); PG8_MMA(1, 1, At, B1); PG8_BAR; PG8_SCHED;
        }
        if constexpr (ALIGN_EPI) { if (wr == 0) PG8_BAR; }
        E(acc, cur, wr, wc, fr, fq);
        if (!has_next) break;
#pragma unroll
        for (int a = 0; a < 2; ++a)
#pragma unroll
            for (int b = 0; b < 2; ++b)
#pragma unroll
                for (int m = 0; m < 4; ++m)
#pragma unroll
                    for (int n = 0; n < 2; ++n) acc[a][b][m][n] = (f32x4){0.f, 0.f, 0.f, 0.f};
        cur = nxt; cA = nA; cB = nB; ++ui;
        if constexpr (GATHER) { vC[0][0] = vN[0][0]; vC[0][1] = vN[0][1]; vC[1][0] = vN[1][0]; vC[1][1] = vN[1][1]; }
        if constexpr (ALIGN_EPI) { if (wr == 1) PG8_BAR; }
    }
    PG8_WAIT_V(0);
    if constexpr (!ALIGN_EPI) { if (wr == 0) PG8_BAR; }
    PG8_BAR;
#undef PG8_SA
#undef PG8_SB
#undef PG8_STAGE
#undef PG8_LDA
#undef PG8_LDB
#undef PG8_MMA
#undef PG8_WAIT_V
#undef PG8_WAIT_L
#undef PG8_BAR
#undef PG8_SCHED
}
struct SchedDense {
    const char* A0; const char* B0; const char* A1; const char* B1; int nM, nN0, nN1, K, G, c, colmul;
    __device__ __forceinline__ bool next(int i, Unit& u) const {
        int pm, pn; if (!static_order(i, G, c, nM, nN0 + nN1, pm, pn)) return false;
        const int sec = pn >= nN0 ? 1 : 0, pl = pn - (sec ? nN0 : 0);
        u.A = (sec ? A1 : A0) + (size_t)pm * 256 * K * 2; u.B = (sec ? B1 : B0) + (size_t)pl * 256 * K * 2;
        u.row0 = pm * 256; u.col0 = pl * colmul; u.e = sec; u.pos0 = 0; u.cnt = 0; return true;
    }
    __device__ __forceinline__ void voff(const Unit&, const int (&R)[2], const int (&C)[2], int K_, unsigned (&v)[2][2]) const { voff_plain(R, C, K_, v); }
};
}
template <class EP> struct EpU { EP ep; __device__ __forceinline__ void operator()(const pg8::Unit&, int m, int n, f32x4 v) const { ep(m, n, v); }
    __device__ __forceinline__ void op8(const pg8::Unit&, int m, int n, f32x4 a, f32x4 b) const { ep.op8(m, n, a, b); } };
template <class EP> struct EpUP { EP ep; __device__ __forceinline__ void pair(const pg8::Unit&, int m, int ch, f32x4 a, f32x4 b) const { ep.pair(m, ch, a, b); }
    __device__ __forceinline__ void pair8(const pg8::Unit&, int m, int ch, f32x4 a0, f32x4 a1, f32x4 b0, f32x4 b1) const { ep.pair8(m, ch, a0, a1, b0, b1); } };
struct EpG1 { static constexpr bool PERM = true; bf16* BG; bf16* Z;
    __device__ __forceinline__ void operator()(const f32x4 (&acc)[2][2][4][2], const pg8::Unit& u, int wr, int wc, int fr, int fq) const {
        if (u.e == 0) { pg8::EpiWrap<EpU<EpBf16>, false, true> w{{{BG, DM}}}; w(acc, u, wr, wc, fr, fq); }
        else { pg8::Unit u2 = u; u2.col0 = u.col0 >> 1; pg8::EpiWrap<EpUP<EpMulPair>, true, true> w{{{Z, DM}}}; w(acc, u2, wr, wc, fr, fq); }
    } };
struct EpNull { static constexpr bool PERM = false; __device__ __forceinline__ void operator()(const f32x4 (&acc)[2][2][4][2], const pg8::Unit&, int, int, int, int) const {
#pragma unroll
    for (int a = 0; a < 2; ++a)
#pragma unroll
        for (int b = 0; b < 2; ++b)
#pragma unroll
            for (int m = 0; m < 4; ++m)
#pragma unroll
                for (int n = 0; n < 2; ++n) asm volatile("" :: "v"(acc[a][b][m][n])); } };
struct EpKVQG { bf16* KV; bf16* Q; float* GATE; const float* bg;
    __device__ __forceinline__ void operator()(const pg8::Unit& u, int m, int n, f32x4 v) const { if (u.e == 0) { EpKV e{KV}; e(m, n, v); } else { EpQG e{Q, GATE, bg}; e(m, n, v); } }
    __device__ __forceinline__ void op8(const pg8::Unit& u, int m, int n, f32x4 a, f32x4 b) const { if (u.e == 0) { EpKV e{KV}; e.op8(m, n, a, b); } else { EpQG e{Q, GATE, bg}; e.op8(m, n, a, b); } } };

__device__ __forceinline__ void p3_conv(Frame& F) {
    const bf16* BG = (const bf16*)(F.wsp() + WS_BG); const bf16* Z = (const bf16*)(F.wsp() + WS_Z); bf16* A2 = (bf16*)(F.wsp() + WS_A2);
    const float* cw = F.inp(I_CONVW); const float* cb = F.inp(I_CONVB);
    const int gt = F.gw * 64 + F.lane, NT_ = F.NGW * 64;
    for (int it = gt; it < T * 128; it += NT_) {
        const int m = it >> 7, ch = (it & 127) * 8, t = m & 4095;
        const u32x4 bg = *(const u32x4*)(BG + (size_t)m * DM + ch);
        const u32x4 z0 = *(const u32x4*)(Z + (size_t)m * DM + ch);
        u32x4 z1 = (u32x4){0, 0, 0, 0}, z2 = (u32x4){0, 0, 0, 0};
        if (t >= 1) z1 = *(const u32x4*)(Z + (size_t)(m - 1) * DM + ch);
        if (t >= 2) z2 = *(const u32x4*)(Z + (size_t)(m - 2) * DM + ch);
        u32x4 o;
#pragma unroll
        for (int w = 0; w < 4; ++w) {
            const int c = ch + 2 * w;
            const float r0 = bflo(bg[w]) * (cw[c] * bflo(z2[w]) + cw[1024 + c] * bflo(z1[w]) + cw[2048 + c] * bflo(z0[w]) + cb[c]);
            const float r1 = bfhi(bg[w]) * (cw[c + 1] * bfhi(z2[w]) + cw[1024 + c + 1] * bfhi(z1[w]) + cw[2048 + c + 1] * bfhi(z0[w]) + cb[c + 1]);
            o[w] = pk2(r0, r1);
        }
        *(u32x4*)(A2 + (size_t)m * DM + ch) = o;
    }
}

__device__ __forceinline__ void ln_row(f32x4 (&v)[4], const float* g, const float* bb, int lane) {
    float s = 0.f;
#pragma unroll
    for (int j = 0; j < 4; ++j) s += (v[j][0] + v[j][1]) + (v[j][2] + v[j][3]);
    const float mean = wave_sum(s) * (1.f / DM); float s2 = 0.f;
#pragma unroll
    for (int j = 0; j < 4; ++j) { v[j] = v[j] - mean; s2 += (v[j][0] * v[j][0] + v[j][1] * v[j][1]) + (v[j][2] * v[j][2] + v[j][3] * v[j][3]); }
    const float rstd = 1.f / sqrtf(wave_sum(s2) * (1.f / DM) + LN_EPS);
#pragma unroll
    for (int j = 0; j < 4; ++j) { const int col = 4 * lane + 256 * j; v[j] = v[j] * rstd * *(const f32x4*)(g + col) + *(const f32x4*)(bb + col); }
}
template <int L, bool DRY = false>
__device__ __forceinline__ void p_ln_router(Frame& F) {
    bf16* RES = (bf16*)(F.wsp() + WS_XB); bf16* U = (bf16*)(F.wsp() + WS_U);
    bf16* RESO = DRY ? (bf16*)(F.wsp() + WS_Y0) : RES; if (DRY) U = (bf16*)(F.wsp() + WS_H);
    const float* MOD = (const float*)(F.wsp() + WS_MOD) + (size_t)L * 4 * 6144;
    const float* rw = F.inp(I_RW); const float* rb = F.inp(I_RB);
    gu32* cnt = F.ctlp() + CW_CNT + L * 1024;
    unsigned* LIST = (unsigned*)(F.wsp() + WS_LIST) + (size_t)L * NE * T; float* LW = (float*)(F.wsp() + WS_LW) + (size_t)L * NE * T;
    const int lane = F.lane;
    LAS int* ae = (LAS int*)F.lds; LAS float* aw = (LAS float*)(F.lds + 512); LAS int* base = (LAS int*)(F.lds + 1024);
    constexpr int RS = 2064, AST_OFF = 2048, ALO_OFF = AST_OFF + 16 * RS, PST_OFF = ALO_OFF + 16 * RS;
    static_assert(PST_OFF + 8192 <= LDSCTL_OFF, "router LDS map");
    const int r16 = lane & 15, kg = lane >> 4;
    bf16x8 Bh[4], Bl[4];
#pragma unroll
    for (int s_ = 0; s_ < 4; ++s_) { u32x4 hh, ll;
#pragma unroll
        for (int i = 0; i < 4; ++i) { const int k = 128 * F.wave + 32 * s_ + 8 * kg + 2 * i; const float a = rw[(size_t)k * 16 + r16], b_ = rw[(size_t)(k + 1) * 16 + r16];
            const unsigned h = pk2(a, b_); hh[i] = h; ll[i] = pk2(a - bflo(h), b_ - bfhi(h)); }
        Bh[s_] = __builtin_bit_cast(bf16x8, hh); Bl[s_] = __builtin_bit_cast(bf16x8, ll); }
    const int nchunk = T / 64;
    for (int ch = blockIdx.x; ch < nchunk; ch += gridDim.x) {
      const bf16* YB = (const bf16*)(F.wsp() + WS_Y0); const float* XF = F.inp(I_X);
      u32x2 yn[4]; f32x4 xn[4];
#pragma unroll
      for (int j = 0; j < 4; ++j) { const size_t o = (size_t)(ch * 64 + F.wave * 2) * DM + 4 * lane + 256 * j; yn[j] = *(const u32x2*)(YB + o);
          if (L == 0) xn[j] = *(const f32x4*)(XF + o); else xn[j] = ld_bf4(RES + o); }
#pragma unroll 2
      for (int rr = 0; rr < 8; ++rr) {
        const int pass = rr >> 1, sub = rr & 1, lrow = pass * 16 + F.wave * 2 + sub, m = ch * 64 + lrow;
        const int b = m >> 12;
        f32x4 v[4];
#pragma unroll
        for (int j = 0; j < 4; ++j) { const f32x4 g1 = *(const f32x4*)(MOD + b * 6144 + 2 * 1024 + 4 * lane + 256 * j);
            v[j] = xn[j] * ALPHA + g1 * (f32x4){bflo(yn[j].x), bfhi(yn[j].x), bflo(yn[j].y), bfhi(yn[j].y)}; }
        if (rr < 7) {
#pragma unroll
            for (int j = 0; j < 4; ++j) { const size_t o = (size_t)(m + (sub ? 15 : 1)) * DM + 4 * lane + 256 * j; yn[j] = *(const u32x2*)(YB + o);
                if (L == 0) xn[j] = *(const f32x4*)(XF + o); else xn[j] = ld_bf4(RES + o); } }
        ln_row(v, F.inp(I_LNG) + (L * 2 + 0) * DM, F.inp(I_LNB) + (L * 2 + 0) * DM, lane);
        {
            LAS unsigned char* arow = F.lds + AST_OFF + (F.wave * 2 + sub) * RS + lane * 8;
#pragma unroll
            for (int j = 0; j < 4; ++j) { const int col = 4 * lane + 256 * j;
                st_bf4(RESO + (size_t)m * DM + col, v[j]);
                const f32x4 u = v[j] * (*(const f32x4*)(MOD + b * 6144 + 4 * 1024 + col) + 1.0f) + *(const f32x4*)(MOD + b * 6144 + 3 * 1024 + col);
                u32x2 hh, ll; hh.x = pk2(u[0], u[1]); hh.y = pk2(u[2], u[3]);
                ll.x = pk2(u[0] - bflo(hh.x), u[1] - bfhi(hh.x)); ll.y = pk2(u[2] - bflo(hh.y), u[3] - bfhi(hh.y));
                *(u32x2*)(U + (size_t)m * DM + col) = hh;
                *(LAS u32x2*)(arow + j * 512) = hh; *(LAS u32x2*)(arow + 16 * RS + j * 512) = ll; }
        }
        if (sub == 0) continue;
        __syncthreads();
        float lgv;
        {
            f32x4 acc = (f32x4){0.f, 0.f, 0.f, 0.f};
            const LAS unsigned char* ap = F.lds + AST_OFF + r16 * RS + (128 * F.wave + 8 * kg) * 2;
#pragma unroll
            for (int s_ = 0; s_ < 4; ++s_) { const bf16x8 ah = *(const LAS bf16x8*)(ap + s_ * 64), al = *(const LAS bf16x8*)(ap + 16 * RS + s_ * 64);
                acc = __builtin_amdgcn_mfma_f32_16x16x32_bf16(ah, Bh[s_], acc, 0, 0, 0);
                acc = __builtin_amdgcn_mfma_f32_16x16x32_bf16(al, Bh[s_], acc, 0, 0, 0);
                acc = __builtin_amdgcn_mfma_f32_16x16x32_bf16(ah, Bl[s_], acc, 0, 0, 0); }
            *(LAS f32x4*)(F.lds + PST_OFF + ((F.wave * 4 + kg) * 16 + r16) * 16) = acc;
            __syncthreads();
            const int rho = 2 * F.wave + (kg & 1); float sm = 0.f;
#pragma unroll
            for (int x = 0; x < 4; ++x) sm += *(const LAS float*)(F.lds + PST_OFF + ((((kg >> 1) * 4 + x) * 4 + (rho >> 2)) * 16 + r16) * 16 + (rho & 3) * 4);
            lgv = sm + __shfl_xor(sm, 32);
        }
#pragma unroll 1
        for (int sb = 0; sb < 2; ++sb) {
        const int lrow2 = pass * 16 + F.wave * 2 + sb;
        float lg[16];
#pragma unroll
        for (int e = 0; e < 16; ++e) lg[e] = __builtin_bit_cast(float, __builtin_amdgcn_readlane(__builtin_bit_cast(int, lgv), 16 * sb + e));
        float mx = lg[0];
#pragma unroll
        for (int e = 1; e < 16; ++e) mx = fmaxf(mx, lg[e]);
        float aff[16], bi[16]; float sum = 0.f;
#pragma unroll
        for (int e = 0; e < 16; ++e) { aff[e] = __expf(lg[e] - mx); sum += aff[e]; }
        const float inv = 1.f / sum;
#pragma unroll
        for (int e = 0; e < 16; ++e) { aff[e] *= inv; bi[e] = aff[e] + rb[e]; }
        float gs[4];
#pragma unroll
        for (int g = 0; g < 4; ++g) { const float a0 = bi[4 * g], a1 = bi[4 * g + 1], a2 = bi[4 * g + 2], a3 = bi[4 * g + 3];
            const float t1 = fmaxf(a0, a1), t2 = fminf(a0, a1), u1 = fmaxf(a2, a3), u2 = fminf(a2, a3);
            gs[g] = fmaxf(t1, u1) + fmaxf(fminf(t1, u1), fmaxf(t2, u2)); }
        int best = 0; float bv = gs[0];
#pragma unroll
        for (int g = 1; g < 4; ++g) if (gs[g] > bv) { bv = gs[g]; best = g; }
        float cb_[4], ca_[4];
#pragma unroll
        for (int i = 0; i < 4; ++i) { cb_[i] = best == 0 ? bi[i] : best == 1 ? bi[4 + i] : best == 2 ? bi[8 + i] : bi[12 + i];
                                      ca_[i] = best == 0 ? aff[i] : best == 1 ? aff[4 + i] : best == 2 ? aff[8 + i] : aff[12 + i]; }
        int i0 = 0; float b0 = cb_[0];
#pragma unroll
        for (int i = 1; i < 4; ++i) if (cb_[i] > b0) { b0 = cb_[i]; i0 = i; }
        int i1 = -1; float b1 = -3.0e38f;
#pragma unroll
        for (int i = 0; i < 4; ++i) if (i != i0 && cb_[i] > b1) { b1 = cb_[i]; i1 = i; }
        const float w0 = i0 == 0 ? ca_[0] : i0 == 1 ? ca_[1] : i0 == 2 ? ca_[2] : ca_[3];
        const float w1 = i1 == 0 ? ca_[0] : i1 == 1 ? ca_[1] : i1 == 2 ? ca_[2] : ca_[3];
        const float ws_ = 1.f / (w0 + w1);
        if (lane == 0) { ae[2 * lrow2] = best * 4 + i0; ae[2 * lrow2 + 1] = best * 4 + i1; aw[2 * lrow2] = w0 * ws_; aw[2 * lrow2 + 1] = w1 * ws_; }
        }
      }
      __syncthreads();
      if (DRY) continue;
      if (F.tid < NE) { int c = 0; for (int i = 0; i < 128; ++i) c += (ae[i] == F.tid) ? 1 : 0;
          base[F.tid] = c ? (int)__hip_atomic_fetch_add(cnt + F.tid * 64, (unsigned)c, RLX_AGENT) : 0; }
      __syncthreads();
      if (F.tid < 128) { const int e = ae[F.tid]; int rk = 0; for (int i = 0; i < F.tid; ++i) rk += (ae[i] == e) ? 1 : 0;
          const int pos = base[e] + rk; const unsigned m = (unsigned)(ch * 64 + (F.tid >> 1));
          LIST[(size_t)e * T + pos] = m * 2u + (unsigned)(F.tid & 1); LW[(size_t)e * T + pos] = aw[F.tid]; }
      __syncthreads();
    }
}
template <int L, bool DRY = false>
__device__ __forceinline__ void p_ln2(Frame& F) {
    bf16* RES = (bf16*)(F.wsp() + WS_XB); bf16* U = (bf16*)(F.wsp() + WS_U); float* OUT = F.outp();
    bf16* RESO = DRY ? (bf16*)(F.wsp() + WS_R1) : RES; if (DRY) { U = (bf16*)(F.wsp() + WS_H); }
    const bf16* Y0 = (const bf16*)(F.wsp() + WS_Y0); const bf16* Y1 = (const bf16*)(F.wsp() + WS_Y1);
    const float* MOD = (const float*)(F.wsp() + WS_MOD) + (size_t)L * 4 * 6144;
    const float* MODN = (const float*)(F.wsp() + WS_MOD) + (size_t)1 * 4 * 6144;
    const int lane = F.lane;
    for (int m = F.gw; m < T; m += F.NGW) {
        const int b = m >> 12;
        f32x4 v[4];
#pragma unroll
        for (int j = 0; j < 4; ++j) { const int col = 4 * lane + 256 * j;
            const f32x4 x = ld_bf4(RES + (size_t)m * DM + col);
            const u32x2 a = *(const u32x2*)(Y0 + (size_t)m * DM + col), c = *(const u32x2*)(Y1 + (size_t)m * DM + col);
            const f32x4 y = (f32x4){bflo(a.x) + bflo(c.x), bfhi(a.x) + bfhi(c.x), bflo(a.y) + bflo(c.y), bfhi(a.y) + bfhi(c.y)};
            v[j] = x * ALPHA + *(const f32x4*)(MOD + b * 6144 + 5 * 1024 + col) * y; }
        ln_row(v, F.inp(I_LNG) + (L * 2 + 1) * DM, F.inp(I_LNB) + (L * 2 + 1) * DM, lane);
#pragma unroll
        for (int j = 0; j < 4; ++j) { const int col = 4 * lane + 256 * j;
            if (L == 1) *(f32x4*)(OUT + (size_t)m * DM + col) = v[j];
            if (L == 0) { st_bf4(RESO + (size_t)m * DM + col, v[j]);
                st_bf4(U + (size_t)m * DM + col, v[j] * (*(const f32x4*)(MODN + b * 6144 + 1024 + col) + 1.0f) + *(const f32x4*)(MODN + b * 6144 + col)); } }
    }
}

__device__ __forceinline__ void moe_tables(Frame& F, int L) {
    LAS int* tb = (LAS int*)(F.lds + MISC_OFF + 128); LAS int* cn = tb + 20;
    __syncthreads();
    if (F.tid == 0) { int acc = 0; for (int e = 0; e < NE; ++e) { const int c = (int)__hip_atomic_load(F.ctlp() + CW_CNT + L * 1024 + e * 64, RLX_AGENT); cn[e] = c; tb[e] = acc; acc += (c + 255) >> 8; } tb[NE] = acc; }
    __syncthreads();
}
struct ARowMoe { const bf16* U; const unsigned* list; int rbase, cnt;
    __device__ __forceinline__ const bf16* operator()(int r) const { const int pos = r - rbase; const unsigned tok = pos < cnt ? (list[pos] >> 1) : 0u; return U + (size_t)tok * DM; } };
struct EpY { bf16* Y; const unsigned* list; const float* lw; int rbase, cnt;
    __device__ __forceinline__ void operator()(int r, int n, f32x4 v) const { const int pos = r - rbase; if (pos < cnt) { const unsigned ts = list[pos]; const float w = lw[pos];
        st_bf4(Y + (size_t)(ts & 1u) * ((size_t)T * DM) + (size_t)(ts >> 1) * DM + n, v * w); } } };
template <int L>
__device__ __forceinline__ void p_moe_gu(Frame& F) {
    moe_tables(F, L);
    LAS int* tb = (LAS int*)(F.lds + MISC_OFF + 128); LAS int* cn = tb + 20;
    const unsigned* LIST = (const unsigned*)(F.wsp() + WS_LIST) + (size_t)L * NE * T;
    const int total = tb[NE] * 4 * 16;
    for (int it = F.gw; it < total; it += F.NGW) {
        const int ni = it & 15, mt = it >> 4; int e = 0; while (tb[e + 1] * 4 <= mt) ++e;
        const ARowMoe ar{(const bf16*)(F.wsp() + WS_U), LIST + (size_t)e * T, tb[e] * 256, cn[e]};
        const EpSiluPair ep{(bf16*)(F.wsp() + WS_H), FF};
        const int pn = ni >> 2, q = ni & 3;
        gemm_wave_tile<true>(ar, (const bf16*)(F.wsp() + WS_WGU) + (size_t)(L * NE + e) * 1024 * 1024 + (size_t)(pn * 256 + q * 32) * 1024, 1024, mt * 64, pn * 128 + q * 32, ep, F.lane);
    }
}
template <int L>
__device__ __forceinline__ void p_moe_down(Frame& F) {
    moe_tables(F, L);
    LAS int* tb = (LAS int*)(F.lds + MISC_OFF + 128); LAS int* cn = tb + 20;
    const unsigned* LIST = (const unsigned*)(F.wsp() + WS_LIST) + (size_t)L * NE * T; const float* LW = (const float*)(F.wsp() + WS_LW) + (size_t)L * NE * T;
    const int total = tb[NE] * 4 * 16;
    for (int it = F.gw; it < total; it += F.NGW) {
        const int ni = it & 15, mt = it >> 4; int e = 0; while (tb[e + 1] * 4 <= mt) ++e;
        const ARowPlain ar{(const bf16*)(F.wsp() + WS_H), FF};
        const EpY ep{(bf16*)(F.wsp() + WS_Y0), LIST + (size_t)e * T, LW + (size_t)e * T, tb[e] * 256, cn[e]};
        gemm_wave_tile<false>(ar, (const bf16*)(F.wsp() + WS_WDN) + (size_t)(L * NE + e) * 1024 * 512 + (size_t)(ni * 64) * 512, 512, mt * 64, ni * 64, ep, F.lane);
    }
}

struct ARowCmp { const bf16* KVi; __device__ __forceinline__ const bf16* operator()(int R) const { return KVi + ((size_t)(R >> 8) * KVROWS + (size_t)(R & 255) * 16) * 64; } };
__device__ __forceinline__ float gelu_tanh(float x) { const float u = 0.7978845608028654f * (x + 0.044715f * x * x * x); const float e = __expf(2.f * u); const float th = 1.f - 2.f / (e + 1.f); return 0.5f * x * (1.f + th); }
__device__ __forceinline__ void p_cmp_finish(Frame& F) {
    LAS float* w2s = (LAS float*)F.lds;
    LAS float* hd = (LAS float*)(F.lds + 65536 + F.wave * 4096);
    const float* TB = (const float*)(F.wsp() + WS_TB); const float* PETP = (const float*)(F.wsp() + WS_PETP);
    const int lane = F.lane;
    for (int base = blockIdx.x * 32; base < 2 * 16 * 256; base += gridDim.x * 32) {
        const int i = base >> 12;
        __syncthreads();
        for (int u = F.tid; u < 4096; u += 512) *(LAS f32x4*)(w2s + 4 * u) = *(const f32x4*)(F.inp(I_CW2) + (size_t)i * 256 * 64 + 4 * u);
        const int it0 = base + F.wave * 4, bh = (it0 >> 8) & 15, n0 = it0 & 255, c = 4 * lane;
        const f32x4 pe = *(const f32x4*)(PETP + 64 * 256 + i * 256 + c);
#pragma unroll
        for (int r = 0; r < 4; ++r) { const int n = n0 + r;
            f32x4 h = (f32x4){0.f, 0.f, 0.f, 0.f};
            if (n < 255) { const float* r0 = TB + ((size_t)i * 4096 + bh * 256 + n) * 512; h = *(const f32x4*)(r0 + c) + *(const f32x4*)(r0 + 512 + 256 + c) + pe; }
#pragma unroll
            for (int q = 0; q < 4; ++q) hd[(c + q) * 4 + r] = gelu_tanh(h[q]); }
        __syncthreads();
        const float b2 = F.inp(I_CB2)[i * 64 + lane];
        float a0 = b2, a1 = b2, a2 = b2, a3 = b2;
#pragma unroll 8
        for (int cc = 0; cc < 256; ++cc) { const float w = w2s[cc * 64 + lane]; const f32x4 h4 = *(const LAS f32x4*)(hd + cc * 4);
            a0 += h4[0] * w; a1 += h4[1] * w; a2 += h4[2] * w; a3 += h4[3] * w; }
        const float av[4] = {a0, a1, a2, a3};
#pragma unroll
        for (int r = 0; r < 4; ++r) { const int n = n0 + r;
            bf16* dst = (bf16*)(F.wsp() + (i ? WS_VC : WS_KC)) + (size_t)bh * 256 * 64 + (size_t)(n >> 6) * 4096 + (i ? vfrag_off(n & 63, lane) : kfrag_off(n & 63, lane));
            *dst = (n == 255) ? (bf16)0 : (bf16)f2bf(av[r]); }
    }
}

__device__ __forceinline__ void score_tile(const bf16* krow, const LAS float* qs, float (&s)[4]) {
    s[0] = s[1] = s[2] = s[3] = 0.f;
#pragma unroll
    for (int c = 0; c < 8; ++c) { const u32x4 kv = *(const u32x4*)(krow + 8 * c);
#pragma unroll
        for (int w = 0; w < 4; ++w) { const f32x4 qa = *(const LAS f32x4*)(qs + (8 * c + 2 * w) * 4), qb = *(const LAS f32x4*)(qs + (8 * c + 2 * w + 1) * 4);
            const float ka = bflo(kv[w]), kb = bfhi(kv[w]);
            s[0] += ka * qa[0] + kb * qb[0]; s[1] += ka * qa[1] + kb * qb[1]; s[2] += ka * qa[2] + kb * qb[2]; s[3] += ka * qa[3] + kb * qb[3]; } }
}
__device__ __forceinline__ void attend_tile(const bf16* Kt, const bf16* Vt, bool valid, const LAS float* qs, LAS float* pbuf, float (&mr)[4], float (&l)[4], float (&o)[4], int lane) {
    float s[4]; score_tile(Kt + (size_t)lane * 64, qs, s);
    f32x4 p4;
#pragma unroll
    for (int g = 0; g < 4; ++g) {
        const float sg = valid ? s[g] : -INFINITY; const float tm = wave_max(sg); const float mn = fmaxf(mr[g], tm);
        const float mref = (mn == -INFINITY) ? 0.f : mn;
        const float alpha = __builtin_amdgcn_exp2f(mr[g] - mref); const float p = valid ? __builtin_amdgcn_exp2f(sg - mref) : 0.f;
        l[g] = l[g] * alpha + wave_sum(p); o[g] *= alpha; mr[g] = mn; p4[g] = p;
    }
    LDS_WAIT(); asm volatile("" ::: "memory");
    *(LAS f32x4*)(pbuf + lane * 4) = p4;
    LDS_WAIT(); asm volatile("" ::: "memory");
#pragma unroll 8
    for (int k = 0; k < 64; ++k) { const f32x4 pk = *(const LAS f32x4*)(pbuf + k * 4); const float vv = bf2f(Vt[(size_t)k * 64 + lane]);
        o[0] += pk[0] * vv; o[1] += pk[1] * vv; o[2] += pk[2] * vv; o[3] += pk[3] * vv; }
    LDS_WAIT(); asm volatile("" ::: "memory");
}
__device__ __forceinline__ void p_attn_simple(Frame& F) {
    LAS float* qs = (LAS float*)(F.lds + F.wave * 16384);
    LAS float* pbuf = qs + 256;
    LAS float* psum = pbuf + 1024;
    const bf16* Q = (const bf16*)(F.wsp() + WS_Q); const float* GATE = (const float*)(F.wsp() + WS_GATE); bf16* O = (bf16*)(F.wsp() + WS_O);
    const bf16* KVb = (const bf16*)(F.wsp() + WS_KV);
    const int lane = F.lane;
    for (int it = F.gw; it < 16 * SEQ; it += F.NGW) {
        const int bh = it & 15, t = it >> 4, b = bh >> 2, hk = bh & 3, m = b * SEQ + t;
        LDS_WAIT(); asm volatile("" ::: "memory");
        { f32x4 q4; for (int g = 0; g < 4; ++g) q4[g] = bf2f(Q[(size_t)m * DM + (hk * 4 + g) * 64 + lane]); *(LAS f32x4*)(qs + lane * 4) = q4; }
        LDS_WAIT(); asm volatile("" ::: "memory");
        const bf16* KC = (const bf16*)(F.wsp() + WS_KC) + (size_t)bh * 256 * 64; const bf16* VC = (const bf16*)(F.wsp() + WS_VC) + (size_t)bh * 256 * 64;
        const int nv = t >= 31 ? ((t - 31) >> 4) + 1 : 0;
        float sc[4][4];
#pragma unroll
        for (int i = 0; i < 4; ++i) { float s[4] = {0.f, 0.f, 0.f, 0.f}; if (64 * i < nv) score_tile(KC + (size_t)(64 * i + lane) * 64, qs, s);
            const bool v = (64 * i + lane) < nv;
#pragma unroll
            for (int g = 0; g < 4; ++g) sc[i][g] = v ? s[g] : -INFINITY; }
        float oc[4];
#pragma unroll
        for (int g = 0; g < 4; ++g) {
            const float mx = wave_max(fmaxf(fmaxf(sc[0][g], sc[1][g]), fmaxf(sc[2][g], sc[3][g]))); const float mref = (mx == -INFINITY) ? 0.f : mx;
            float e[4]; float ls = 0.f;
#pragma unroll
            for (int i = 0; i < 4; ++i) { e[i] = __builtin_amdgcn_exp2f(sc[i][g] - mref); ls += e[i]; }
            const float inv = 1.f / fmaxf(wave_sum(ls), 1e-30f);
#pragma unroll
            for (int i = 0; i < 4; ++i) sc[i][g] = e[i] * inv;
        }
#pragma unroll
        for (int i = 0; i < 4; ++i) { *(LAS f32x4*)(pbuf + (64 * i + lane) * 4) = (f32x4){sc[i][0], sc[i][1], sc[i][2], sc[i][3]};
            psum[64 * i + lane + 1] = (sc[i][0] + sc[i][1]) + (sc[i][2] + sc[i][3]); }
        if (lane == 0) psum[0] = 0.f;
        LDS_WAIT(); asm volatile("" ::: "memory");
        oc[0] = oc[1] = oc[2] = oc[3] = 0.f;
        for (int n = 0; n < nv; ++n) { const f32x4 pk = *(const LAS f32x4*)(pbuf + n * 4); const float vv = bf2f(VC[(size_t)n * 64 + lane]);
            oc[0] += pk[0] * vv; oc[1] += pk[1] * vv; oc[2] += pk[2] * vv; oc[3] += pk[3] * vv; }
        const float imp = 0.5f * psum[4 * lane] + psum[4 * lane + 1] + psum[4 * lane + 2] + psum[4 * lane + 3] + 0.5f * psum[4 * lane + 4];
        const int cur = t >> 6;
        const bool allowed = lane <= cur, forced = allowed && (lane == 0 || lane == cur || lane == cur - 1);
        const float score = forced ? 1e9f : (allowed ? imp : -1e30f);
        int rank = 0;
#pragma unroll
        for (int j = 0; j < 64; ++j) { const float sj = __shfl(score, j); rank += (sj > score || (sj == score && j < lane)) ? 1 : 0; }
        const unsigned long long mask = __ballot(rank < 16 && score > -0.5e30f);
        LDS_WAIT(); asm volatile("" ::: "memory");
        const bf16* KS = KVb + 2 * KVBUF_ELEMS + (size_t)bh * KVROWS * 64; const bf16* VS = KVb + 3 * KVBUF_ELEMS + (size_t)bh * KVROWS * 64;
        float ms[4] = {-INFINITY, -INFINITY, -INFINITY, -INFINITY}, ls[4] = {0.f, 0.f, 0.f, 0.f}, os[4] = {0.f, 0.f, 0.f, 0.f};
        for (unsigned long long mk = mask; mk; mk &= mk - 1) { const int j = __builtin_ctzll(mk);
            attend_tile(KS + (size_t)j * 64 * 64, VS + (size_t)j * 64 * 64, (64 * j + lane) <= t, qs, pbuf, ms, ls, os, lane); }
        const bf16* KW = KVb + 4 * KVBUF_ELEMS + (size_t)bh * KVROWS * 64; const bf16* VW = KVb + 5 * KVBUF_ELEMS + (size_t)bh * KVROWS * 64;
        float mw[4] = {-INFINITY, -INFINITY, -INFINITY, -INFINITY}, lw[4] = {0.f, 0.f, 0.f, 0.f}, ow[4] = {0.f, 0.f, 0.f, 0.f};
        const int lo = t - 511 > 0 ? t - 511 : 0;
        for (int j = lo >> 6; j <= (t >> 6); ++j) { const int pos = 64 * j + lane;
            attend_tile(KW + (size_t)j * 64 * 64, VW + (size_t)j * 64 * 64, pos >= lo && pos <= t, qs, pbuf, mw, lw, ow, lane); }
#pragma unroll
        for (int g = 0; g < 4; ++g) { const float* gp = GATE + (size_t)m * 48 + (hk * 4 + g) * 3;
            const float o = gp[0] * oc[g] + gp[1] * os[g] / fmaxf(ls[g], 1e-30f) + gp[2] * ow[g] / fmaxf(lw[g], 1e-30f);
            O[(size_t)m * DM + (hk * 4 + g) * 64 + lane] = (bf16)f2bf(o); }
    }
}

struct SchedCmp { const char* KV; const char* W1C; int G, c;
    __device__ __forceinline__ bool next(int it, pg8::Unit& u) const { const int L = it * G + c; if (c < 0 || L >= 64) return false;
        const int i = L >> 5, pm = (L >> 1) & 15, pn = L & 1;
        u.A = KV + ((size_t)i * KVBUF_ELEMS + (size_t)pm * KVROWS * 64) * 2; u.B = W1C + ((size_t)i * 512 * 1024 + (size_t)pn * 256 * 1024) * 2;
        u.row0 = i * 4096 + pm * 256; u.col0 = pn * 256; u.e = i; u.pos0 = 0; u.cnt = 0; return true; }
    __device__ __forceinline__ void voff(const pg8::Unit&, const int (&R)[2], const int (&C)[2], int K_, unsigned (&v)[2][2]) const { pg8::voff_plain(R, C, K_, v); }
};
struct SchedKVQG { const char* A0; const char* B0; const char* A1; const char* B1; int G, c, Lbase, Lend;
    __device__ __forceinline__ bool next(int it, pg8::Unit& u) const { const int L = Lbase + it * G + c; if (c < 0 || L >= Lend) return false;
        const int sec = L >= 384 ? 1 : 0, l = sec ? L - 384 : L, nn = sec ? 5 : 6, pm = l / nn, pn = l % nn;
        u.A = (sec ? A1 : A0) + (size_t)pm * 256 * DM * 2; u.B = (sec ? B1 : B0) + (size_t)pn * 256 * DM * 2;
        u.row0 = pm * 256; u.col0 = pn * 256; u.e = sec; u.pos0 = 0; u.cnt = 0; return true; }
    __device__ __forceinline__ void voff(const pg8::Unit&, const int (&R)[2], const int (&C)[2], int K_, unsigned (&v)[2][2]) const { pg8::voff_plain(R, C, K_, v); }
};
struct SchedMoe { LAS int* tb; LAS int* cn; const unsigned* LIST; const char* Abase; const char* Bbase; size_t bstride; int K, nN, colmul, G, c; bool gather; int Lbase, Lend;
    __device__ __forceinline__ bool next(int it, pg8::Unit& u) const { const int L = Lbase + it * G + c; if (c < 0 || L >= Lend) return false;
        const int mt = L / nN, pn = L % nN; int e = 0; while (tb[e + 1] <= mt) ++e;
        u.A = gather ? Abase : Abase + (size_t)mt * 256 * K * 2; u.B = Bbase + (size_t)e * bstride + (size_t)pn * 256 * K * 2;
        u.row0 = mt * 256; u.col0 = pn * colmul; u.e = e; u.pos0 = (mt - tb[e]) * 256; u.cnt = cn[e]; return true; }
    __device__ __forceinline__ void voff(const pg8::Unit& u, const int (&R)[2], const int (&C)[2], int K_, unsigned (&v)[2][2]) const {
        if (!gather) { pg8::voff_plain(R, C, K_, v); return; }
        const unsigned* le = LIST + (size_t)u.e * T; unsigned tk[2][2];
#pragma unroll
        for (int h = 0; h < 2; ++h)
#pragma unroll
            for (int i = 0; i < 2; ++i) { const int pos = u.pos0 + h * 128 + R[i]; tk[h][i] = le[pos < u.cnt ? pos : u.cnt - 1]; }
#pragma unroll
        for (int h = 0; h < 2; ++h)
#pragma unroll
            for (int i = 0; i < 2; ++i) v[h][i] = ((tk[h][i] >> 1) * (unsigned)K_ + (unsigned)C[i]) * 2u;
    }
};
struct EpHU { bf16* H; __device__ __forceinline__ void pair(const pg8::Unit&, int r, int ch, f32x4 a, f32x4 b) const {
    f32x4 s; for (int q = 0; q < 4; ++q) s[q] = silu_f(a[q]) * b[q]; st_bf4(H + (size_t)r * FF + ch, s); }
    __device__ __forceinline__ void pair8(const pg8::Unit&, int r, int ch, f32x4 a0, f32x4 a1, f32x4 b0, f32x4 b1) const {
    f32x4 s0, s1; for (int q = 0; q < 4; ++q) { s0[q] = silu_f(a0[q]) * b0[q]; s1[q] = silu_f(a1[q]) * b1[q]; } st_bf8(H + (size_t)r * FF + ch, s0, s1); } };
struct EpYU { bf16* Y; const unsigned* LIST; const float* LW;
    __device__ __forceinline__ void operator()(const pg8::Unit& u, int r, int n, f32x4 v) const { const int pos = u.pos0 + (r - u.row0);
        if (pos < u.cnt) { const unsigned ts = LIST[(size_t)u.e * T + pos]; const float w = LW[(size_t)u.e * T + pos];
            st_bf4(Y + (size_t)(ts & 1u) * ((size_t)T * DM) + (size_t)(ts >> 1) * DM + n, v * w); } }
    __device__ __forceinline__ void op8(const pg8::Unit& u, int r, int n, f32x4 a, f32x4 b) const { const int pos = u.pos0 + (r - u.row0);
        if (pos < u.cnt) { const unsigned ts = LIST[(size_t)u.e * T + pos]; const float w = LW[(size_t)u.e * T + pos];
            st_bf8(Y + (size_t)(ts & 1u) * ((size_t)T * DM) + (size_t)(ts >> 1) * DM + n, a * w, b * w); } } };
struct EpYUAll { static constexpr bool PERM = true; EpYU ep;
    __device__ __forceinline__ void operator()(const f32x4 (&acc)[2][2][4][2], const pg8::Unit& u, int wr, int wc, int fr, int fq) const {
        unsigned ts[2][4]; float w[2][4];
        const unsigned* le = ep.LIST + (size_t)u.e * T; const float* lw = ep.LW + (size_t)u.e * T;
#pragma unroll
        for (int ai = 0; ai < 2; ++ai)
#pragma unroll
            for (int m = 0; m < 4; ++m) { const int pos = u.pos0 + ai * pg8::HALF + wr * 64 + m * 16 + fr; const int pc = pos < u.cnt ? pos : u.cnt - 1;
                const unsigned t_ = le[pc]; ts[ai][m] = pos < u.cnt ? t_ : 0xFFFFFFFFu; w[ai][m] = lw[pc]; }
#pragma unroll
        for (int ai = 0; ai < 2; ++ai)
#pragma unroll
            for (int m = 0; m < 4; ++m) if (ts[ai][m] != 0xFFFFFFFFu) {
                bf16* yr = ep.Y + (size_t)(ts[ai][m] & 1u) * ((size_t)T * DM) + (size_t)(ts[ai][m] >> 1) * DM + u.col0 + wc * 32 + 8 * fq;
#pragma unroll
                for (int bj = 0; bj < 2; ++bj) st_bf8(yr + bj * pg8::HALF, acc[ai][bj][m][0] * w[ai][m], acc[ai][bj][m][1] * w[ai][m]); }
    } };
template <int L>
__device__ __forceinline__ void p_moe(Frame& F, const XcdBarrier& bar, bool with_barriers) {
    moe_tables(F, L);
    LAS int* tb = (LAS int*)(F.lds + MISC_OFF + 128); LAS int* cn = tb + 20;
    const int G = gridDim.x, bx = blockIdx.x, vcu = (G % 8 == 0) ? (bx % 8) * (G / 8) + bx / 8 : bx;
    const int nt = tb[NE], n128 = nt < 128 ? nt : 128, Wg = 4 * (nt - n128) < G / 2 ? 4 * (nt - n128) : G / 2;
    const int D2 = (4 * n128 < 2 * (G - Wg)) ? 4 * n128 : 2 * (G - Wg);
#pragma unroll 1
    for (int part = 1; part <= 3; ++part) {
        int gc = -1, gG = 1, gb = 0, ge = 0, dc = -1, dG = 1, db = 0, de = 0;
        if (part == 1) { gc = vcu; gG = G; gb = 0; ge = 4 * n128; }
        else if (part == 2) { if (vcu < Wg) { gc = vcu; gG = Wg; gb = 4 * n128; ge = 4 * nt; } else { dc = vcu - Wg; dG = G - Wg; db = 0; de = D2; } }
        else { dc = vcu; dG = G; db = D2; de = 4 * nt; }
        {
            const SchedMoe S{tb, cn, (const unsigned*)(F.wsp() + WS_LIST) + (size_t)L * NE * T, (const char*)(F.wsp() + WS_U), (const char*)(F.wsp() + WS_WGU) + (size_t)L * NE * 1024 * 1024 * 2, (size_t)1024 * 1024 * 2, 1024, 4, 128, gG, gc, true, gb, ge};
            typedef pg8::EpiWrap<EpHU, true, true> E_;
            pg8::gemm_phase<E_, SchedMoe, true, true>(F.lds, 1024, S, E_{{(bf16*)(F.wsp() + WS_H)}});
        }
        {
            const SchedMoe S{tb, cn, nullptr, (const char*)(F.wsp() + WS_H), (const char*)(F.wsp() + WS_WDN) + (size_t)L * NE * 1024 * 512 * 2, (size_t)1024 * 512 * 2, 512, 4, 256, dG, dc, false, db, de};
            typedef EpYUAll E_;
            pg8::gemm_phase<E_, SchedMoe, true, false>(F.lds, 512, S, E_{{(bf16*)(F.wsp() + WS_Y0), (const unsigned*)(F.wsp() + WS_LIST) + (size_t)L * NE * T, (const float*)(F.wsp() + WS_LW) + (size_t)L * NE * T}});
        }
        if (part < 3 && with_barriers) xcd_barrier(bar);
    }
}
typedef float f32x16 __attribute__((ext_vector_type(16)));
#define MFMA32(a, b, c) __builtin_amdgcn_mfma_f32_32x32x16_bf16(a, b, c, 0, 0, 0)
constexpr size_t WS_MASK = WS_GATE + 3 * MiB;
constexpr int STG_STRIDE = 68, STG_BYTES = 32 * STG_STRIDE * 4;
__device__ __forceinline__ int crow(int r, int hi) { return (r & 3) + 8 * (r >> 2) + 4 * hi; }
__device__ __forceinline__ unsigned cvtpk(float lo, float hi) { f32x2v v = {lo, hi}; bf16x2_t b = __builtin_convertvector(v, bf16x2_t); return __builtin_bit_cast(unsigned, b); }
__device__ __forceinline__ float partner32(float x, int hi) { auto rr = __builtin_amdgcn_permlane32_swap(__builtin_bit_cast(unsigned, x), __builtin_bit_cast(unsigned, x), false, false);
    return __builtin_bit_cast(float, hi ? rr[0] : rr[1]); }
__device__ __forceinline__ float max3f(float a, float b, float c) { float r; asm("v_max3_f32 %0, %1, %2, %3" : "=v"(r) : "v"(a), "v"(b), "v"(c)); return r; }
__device__ __forceinline__ float max2f(float a, float b) { float r; asm("v_max_f32_e32 %0, %1, %2" : "=v"(r) : "v"(a), "v"(b)); return r; }
__device__ __forceinline__ float rowmax32(f32x16& p0, f32x16& p1, int hi) {
    asm volatile("s_nop 15\n\ts_nop 7" : "+v"(p0), "+v"(p1));
    float a = max3f(p0[0], p0[1], p1[0]), b = max3f(p0[2], p0[3], p1[1]); a = max3f(a, p1[2], p1[3]);
#pragma unroll
    for (int r = 4; r < 16; r += 4) { a = max3f(a, p0[r], p0[r + 1]); b = max3f(b, p0[r + 2], p0[r + 3]); a = max3f(a, p1[r], p1[r + 1]); b = max3f(b, p1[r + 2], p1[r + 3]); }
    const float m = max2f(a, b);
    return max2f(m, partner32(m, hi));
}
typedef __amdgpu_buffer_rsrc_t rsrc_t;
__device__ __forceinline__ rsrc_t make_rsrc(const void* base, unsigned bytes) { return __builtin_amdgcn_make_buffer_rsrc((void*)base, 0, (int)bytes, 0x00020000); }
__device__ __forceinline__ void load_frag8(bf16x8 (&f)[8], rsrc_t rs, unsigned vo, unsigned so) {
#pragma unroll
    for (int i = 0; i < 8; ++i) f[i] = __builtin_bit_cast(bf16x8, __builtin_amdgcn_raw_buffer_load_b128(rs, vo + i * 1024, so, 0));
}
__device__ __forceinline__ void qk_tile(f32x16& p0, f32x16& p1, const bf16x8 (&kf)[8], const LAS bf16x8* qs, const float cinit) {
    bf16x8 qr[4];
#pragma unroll
    for (int d0 = 0; d0 < 4; ++d0) qr[d0] = qs[d0 * 64];
    f32x16 c;
#pragma unroll
    for (int r = 0; r < 16; ++r) c[r] = cinit;
    p0 = MFMA32(kf[0], qr[0], c); p1 = MFMA32(kf[4], qr[0], c);
#pragma unroll
    for (int d0 = 1; d0 < 4; ++d0) { p0 = MFMA32(kf[d0], qr[d0], p0); p1 = MFMA32(kf[4 + d0], qr[d0], p1); }
}
__device__ __forceinline__ void qk_tile_lo(f32x16& p0, f32x16& p1, rsrc_t rs, unsigned vo, unsigned so, const LAS bf16x8* qs, const float cinit) {
    bf16x8 qr[4];
#pragma unroll
    for (int d0 = 0; d0 < 4; ++d0) qr[d0] = qs[d0 * 64];
#pragma unroll
    for (int r = 0; r < 16; ++r) { p0[r] = cinit; p1[r] = cinit; }
    { bf16x8 kf[4];
#pragma unroll
      for (int d0 = 0; d0 < 4; ++d0) kf[d0] = __builtin_bit_cast(bf16x8, __builtin_amdgcn_raw_buffer_load_b128(rs, vo + d0 * 1024, so, 0));
#pragma unroll
      for (int d0 = 0; d0 < 4; ++d0) p0 = MFMA32(kf[d0], qr[d0], p0); }
    asm volatile("" : "+v"(p0) :: "memory");
    { bf16x8 kf[4];
#pragma unroll
      for (int d0 = 0; d0 < 4; ++d0) kf[d0] = __builtin_bit_cast(bf16x8, __builtin_amdgcn_raw_buffer_load_b128(rs, vo + (4 + d0) * 1024, so, 0));
#pragma unroll
      for (int d0 = 0; d0 < 4; ++d0) p1 = MFMA32(kf[d0], qr[d0], p1); }
}
__device__ __forceinline__ void mask_tile(f32x16& p0, f32x16& p1, int lo, int lim, int hi) {
#pragma unroll
    for (int r = 0; r < 16; ++r) { const int k0 = crow(r, hi);
        if (!(k0 > lo && k0 <= lim)) p0[r] = -INFINITY;
        if (!(k0 + 32 > lo && k0 + 32 <= lim)) p1[r] = -INFINITY; }
}
__device__ __forceinline__ void pack_p(bf16x8 (&pa)[4], const f32x16& p0, const f32x16& p1) {
    u32x4 w0, w1, w2, w3;
#pragma unroll
    for (int q = 0; q < 4; ++q) { w0[q] = cvtpk(p0[2 * q], p0[2 * q + 1]); w1[q] = cvtpk(p0[8 + 2 * q], p0[9 + 2 * q]);
                                  w2[q] = cvtpk(p1[2 * q], p1[2 * q + 1]); w3[q] = cvtpk(p1[8 + 2 * q], p1[9 + 2 * q]); }
    pa[0] = __builtin_bit_cast(bf16x8, w0); pa[1] = __builtin_bit_cast(bf16x8, w1); pa[2] = __builtin_bit_cast(bf16x8, w2); pa[3] = __builtin_bit_cast(bf16x8, w3);
}
__device__ __forceinline__ void pv_tile(f32x16& o0, f32x16& o1, const bf16x8 (&pa)[4], const bf16x8 (&vf)[8]) {
#pragma unroll
    for (int ks = 0; ks < 4; ++ks) { o0 = MFMA32(pa[ks], vf[ks], o0); o1 = MFMA32(pa[ks], vf[4 + ks], o1); }
}
struct Sm { float mhat, l; f32x16 o0, o1, ol; };
__device__ __forceinline__ void sm_init(Sm& st) { st.mhat = 0.f; st.l = 0.f;
#pragma unroll
    for (int r = 0; r < 16; ++r) { st.o0[r] = 0.f; st.o1[r] = 0.f; st.ol[r] = 0.f; } }
__device__ __forceinline__ void sm_tile(Sm& st, f32x16& s0, f32x16& s1, bool first, const bf16x8 (&vf)[8], LAS float* wsf, int r32, int hi) {
    const float rm = rowmax32(s0, s1, hi);
    const bool need = first || (__any(rm > 8.0f) != 0);
    if (need) {
        const float dl = first ? ((rm == -INFINITY) ? 0.f : rm) : fmaxf(rm, 0.f);
        st.mhat += dl;
#pragma unroll
        for (int r = 0; r < 16; ++r) { s0[r] -= dl; s1[r] -= dl; }
        if (!first) {
            const float f = __builtin_amdgcn_exp2f(-dl);
            LDS_WAIT(); asm volatile("" ::: "memory");
            if (hi == 0) wsf[r32] = f;
            LDS_WAIT(); asm volatile("" ::: "memory");
#pragma unroll
            for (int G = 0; G < 4; ++G) { const f32x4 ff = *(const LAS f32x4*)(wsf + 8 * G + 4 * hi);
#pragma unroll
                for (int q = 0; q < 4; ++q) { st.o0[4 * G + q] *= ff[q]; st.o1[4 * G + q] *= ff[q]; st.ol[4 * G + q] *= ff[q]; } }
            LDS_WAIT(); asm volatile("" ::: "memory");
        }
    }
#pragma unroll
    for (int r = 0; r < 16; ++r) { s0[r] = __builtin_amdgcn_exp2f(s0[r]); s1[r] = __builtin_amdgcn_exp2f(s1[r]); }
    bf16x8 pa[4]; pack_p(pa, s0, s1);
    const bf16x8 ones = (bf16x8){0x3F80, 0x3F80, 0x3F80, 0x3F80, 0x3F80, 0x3F80, 0x3F80, 0x3F80};
#pragma unroll
    for (int ks = 0; ks < 4; ++ks) { st.o0 = MFMA32(pa[ks], vf[ks], st.o0); st.o1 = MFMA32(pa[ks], vf[4 + ks], st.o1); st.ol = MFMA32(pa[ks], ones, st.ol); }
}
template <bool NORM>
__device__ __forceinline__ void flush_branch(const f32x16& o0, const f32x16& o1, const f32x16& ol, const float* GATE, bf16* O, int m0, int hq, int br, bool accumulate,
                                             LAS float* stg, int lane) {
    asm volatile("" : "+v"(lane));
    const int r32 = lane & 31, hi = lane >> 5;
    LDS_WAIT(); asm volatile("" ::: "memory");
#pragma unroll
    for (int r = 0; r < 16; ++r) { const float iv = NORM ? __builtin_amdgcn_rcpf(fmaxf(ol[r], 1e-30f)) : 1.f;
        stg[crow(r, hi) * STG_STRIDE + r32] = o0[r] * iv; stg[crow(r, hi) * STG_STRIDE + 32 + r32] = o1[r] * iv; }
    LDS_WAIT(); asm volatile("" ::: "memory");
#pragma unroll
    for (int i = 0; i < 4; ++i) { const int row = i * 8 + (lane >> 3), ch = lane & 7;
        const f32x4 a = *(const LAS f32x4*)(stg + row * STG_STRIDE + ch * 8), b = *(const LAS f32x4*)(stg + row * STG_STRIDE + ch * 8 + 4);
        const float sc = GATE[(size_t)(m0 + row) * 48 + hq * 3 + br];
        bf16* op = O + (size_t)(m0 + row) * DM + hq * 64 + ch * 8;
        f32x4 x = a * sc, y = b * sc;
        if (accumulate) { const u32x4 old = *(const u32x4*)op; x += (f32x4){bflo(old.x), bfhi(old.x), bflo(old.y), bfhi(old.y)}; y += (f32x4){bflo(old.z), bfhi(old.z), bflo(old.w), bfhi(old.w)}; }
        u32x4 w; w.x = pk2(x[0], x[1]); w.y = pk2(x[2], x[3]); w.z = pk2(y[0], y[1]); w.w = pk2(y[2], y[3]);
        *(u32x4*)op = w; }
    LDS_WAIT(); asm volatile("" ::: "memory");
}
__device__ __forceinline__ void load_q(LAS bf16x8* qs, const bf16* Q, int m, int hq, int hi) {
    LDS_WAIT(); asm volatile("" ::: "memory");
#pragma unroll
    for (int d0 = 0; d0 < 4; ++d0) qs[d0 * 64] = *(const bf16x8*)(Q + (size_t)m * DM + hq * 64 + d0 * 16 + hi * 8);
    LDS_WAIT(); asm volatile("" ::: "memory");
}
__device__ __forceinline__ void p_attn_cmp(Frame& F) {
    LAS float* stg = (LAS float*)(F.lds + F.wave * 16384); LAS float* wsf = stg + 32 * STG_STRIDE;
    const bf16* Q = (const bf16*)(F.wsp() + WS_Q); const float* GATE = (const float*)(F.wsp() + WS_GATE); bf16* O = (bf16*)(F.wsp() + WS_O);
    unsigned long long* MASK = (unsigned long long*)(F.wsp() + WS_MASK);
    for (int it = F.gw; it < 16 * 128; it += F.NGW) {
        const int bh = it >> 7, blk = 127 - (it & 127), b = bh >> 2, hk = bh & 3, m0 = b * SEQ + blk * 32;
        const rsrc_t rs = make_rsrc(F.wsp() + WS_KC, 1u << 20);
        const unsigned soK = (unsigned)bh * 32768u, soV = 524288u + (unsigned)bh * 32768u;
        const int nvmax = ((blk * 32) >> 4) + 1, ntc = (nvmax + 63) >> 6;
        float mref0 = 0.f, mref1 = 0.f, mref2 = 0.f, mref3 = 0.f, inv0 = 0.f, inv1 = 0.f, inv2 = 0.f, inv3 = 0.f;
#pragma unroll 1
        for (int g = 0; g < 4; ++g) {
            int lane = F.lane; asm volatile("" : "+v"(lane));
            const int r32 = lane & 31, hi = lane >> 5, t = blk * 32 + r32, nvr = t >= 31 ? ((t - 31) >> 4) + 1 : 0;
            LAS bf16x8* qr = (LAS bf16x8*)(wsf + 64) + lane; load_q(qr, Q, m0 + r32, hk * 4 + g, hi);
            float mrun = -INFINITY, l = 0.f;
#pragma unroll 1
            for (int i = 0; i < ntc; ++i) {
                f32x16 s0, s1; qk_tile_lo(s0, s1, rs, (unsigned)lane * 16u, soK + (unsigned)i * 8192u, qr, 0.f); mask_tile(s0, s1, -1, nvr - 1 - 64 * i, hi);
                const float rm = rowmax32(s0, s1, hi), mn = fmaxf(mrun, rm), mr = (mn == -INFINITY) ? 0.f : mn;
                float sum = 0.f;
#pragma unroll
                for (int r = 0; r < 16; ++r) sum += __builtin_amdgcn_exp2f(s0[r] - mr) + __builtin_amdgcn_exp2f(s1[r] - mr);
                l = l * __builtin_amdgcn_exp2f(mrun - mr) + sum; mrun = mn;
            }
            const float ltot = l + partner32(l, hi);
            const float iv = 1.f / fmaxf(ltot, 1e-30f), mr_ = (mrun == -INFINITY) ? 0.f : mrun;
            if (g == 0) { inv0 = iv; mref0 = mr_; } else if (g == 1) { inv1 = iv; mref1 = mr_; } else if (g == 2) { inv2 = iv; mref2 = mr_; } else { inv3 = iv; mref3 = mr_; }
        }
        {
            float imp[32];
#pragma unroll
            for (int k = 0; k < 32; ++k) imp[k] = 0.f;
#pragma unroll 1
            for (int g = 0; g < 4; ++g) {
                int lane = F.lane; asm volatile("" : "+v"(lane));
                const int r32 = lane & 31, hi = lane >> 5, t = blk * 32 + r32, nvr = t >= 31 ? ((t - 31) >> 4) + 1 : 0;
                LAS bf16x8* qr = (LAS bf16x8*)(wsf + 64) + lane; load_q(qr, Q, m0 + r32, hk * 4 + g, hi);
                const float invg = g == 0 ? inv0 : g == 1 ? inv1 : g == 2 ? inv2 : inv3, mg = g == 0 ? mref0 : g == 1 ? mref1 : g == 2 ? mref2 : mref3;
#pragma unroll
                for (int i = 0; i < 4; ++i) if (i < ntc) {
                    asm volatile("" ::: "memory");
                    f32x16 s0, s1; qk_tile_lo(s0, s1, rs, (unsigned)lane * 16u, soK + (unsigned)i * 8192u, qr, -mg); mask_tile(s0, s1, -1, nvr - 1 - 64 * i, hi);
#pragma unroll
                    for (int r = 0; r < 16; ++r) { s0[r] = __builtin_amdgcn_exp2f(s0[r]) * invg; s1[r] = __builtin_amdgcn_exp2f(s1[r]) * invg; }
#pragma unroll
                    for (int G = 0; G < 4; ++G) {
                        { const int kq = 8 * i + G; const float e = s0[4 * G + 3], pe = partner32(e, hi);
                          imp[kq] += (s0[4 * G] + s0[4 * G + 1]) + s0[4 * G + 2] + 0.5f * e + (hi ? 0.5f * pe : 0.f);
                          if (kq + 1 < 32) imp[kq + 1] += hi ? 0.f : 0.5f * pe; }
                        { const int kq = 8 * i + 4 + G; const float e = s1[4 * G + 3], pe = partner32(e, hi);
                          imp[kq] += (s1[4 * G] + s1[4 * G + 1]) + s1[4 * G + 2] + 0.5f * e + (hi ? 0.5f * pe : 0.f);
                          if (kq + 1 < 32) imp[kq + 1] += hi ? 0.f : 0.5f * pe; }
                    }
                }
            }
            int lane = F.lane; asm volatile("" : "+v"(lane));
            const int r32 = lane & 31, hi = lane >> 5, cur = (blk * 32 + r32) >> 6;
            LDS_WAIT(); asm volatile("" ::: "memory");
#pragma unroll
            for (int k = 0; k < 32; ++k) { const int j = 2 * k + hi; const bool allowed = j <= cur, forced = allowed && (j == 0 || j == cur || j == cur - 1);
                stg[r32 * STG_STRIDE + j] = forced ? 1e9f : (allowed ? imp[k] : -1e30f); }
            LDS_WAIT(); asm volatile("" ::: "memory");
        }
        {
            int lane = F.lane; asm volatile("" : "+v"(lane));
            unsigned long long mymask = 0ull;
#pragma unroll 1
            for (int tok = 0; tok < 32; ++tok) {
                const float sc = stg[tok * STG_STRIDE + lane]; int rank = 0;
#pragma unroll
                for (int q = 0; q < 16; ++q) { const f32x4 v = *(const LAS f32x4*)(stg + tok * STG_STRIDE + 4 * q);
#pragma unroll
                    for (int e = 0; e < 4; ++e) rank += (v[e] > sc || (v[e] == sc && (4 * q + e) < lane)) ? 1 : 0; }
                const unsigned long long mk = __ballot(rank < 16 && sc > -0.5e30f);
                mymask = (lane == tok) ? mk : mymask;
            }
            if (lane < 32) MASK[(size_t)bh * SEQ + blk * 32 + lane] = mymask;
            LDS_WAIT(); asm volatile("" ::: "memory");
        }
#pragma unroll 1
        for (int g = 0; g < 4; ++g) {
            int lane = F.lane; asm volatile("" : "+v"(lane));
            const int r32 = lane & 31, hi = lane >> 5, t = blk * 32 + r32, nvr = t >= 31 ? ((t - 31) >> 4) + 1 : 0;
            LAS bf16x8* qr = (LAS bf16x8*)(wsf + 64) + lane; load_q(qr, Q, m0 + r32, hk * 4 + g, hi);
            const float invg = g == 0 ? inv0 : g == 1 ? inv1 : g == 2 ? inv2 : inv3, mg = g == 0 ? mref0 : g == 1 ? mref1 : g == 2 ? mref2 : mref3;
            f32x16 o0, o1;
#pragma unroll
            for (int r = 0; r < 16; ++r) { o0[r] = 0.f; o1[r] = 0.f; }
#pragma unroll 1
            for (int i = 0; i < ntc; ++i) {
                f32x16 s0, s1; qk_tile_lo(s0, s1, rs, (unsigned)lane * 16u, soK + (unsigned)i * 8192u, qr, -mg); mask_tile(s0, s1, -1, nvr - 1 - 64 * i, hi);
#pragma unroll
                for (int r = 0; r < 16; ++r) { s0[r] = __builtin_amdgcn_exp2f(s0[r]) * invg; s1[r] = __builtin_amdgcn_exp2f(s1[r]) * invg; }
                bf16x8 pa[4]; pack_p(pa, s0, s1);
                bf16x8 vf[8]; load_frag8(vf, rs, (unsigned)lane * 16u, soV + (unsigned)i * 8192u); pv_tile(o0, o1, pa, vf);
            }
            flush_branch<false>(o0, o1, o0, GATE, O, m0, hk * 4 + g, 0, false, stg, lane);
        }
    }
}
__device__ __forceinline__ void attn_main_item(Frame& F, int bh, int g, int blk, LAS float* stg, LAS float* wsf) {
    const bf16* Q = (const bf16*)(F.wsp() + WS_Q); const float* GATE = (const float*)(F.wsp() + WS_GATE); bf16* O = (bf16*)(F.wsp() + WS_O);
    const rsrc_t rs = make_rsrc(F.wsp() + WS_KV, (unsigned)(6 * KVBUF_ELEMS * 2));
    int lane = F.lane; asm volatile("" : "+v"(lane));
    const int r32 = lane & 31, hi = lane >> 5;
    const unsigned vo = (unsigned)lane * 16u;
    const int b = bh >> 2, hk = bh & 3, hq = hk * 4 + g, m0 = b * SEQ + blk * 32, c = blk >> 1, ql = (blk & 1) * 32 + r32;
    LAS bf16x8* qr = (LAS bf16x8*)(wsf + 64) + lane; load_q(qr, Q, m0 + r32, hq, hi);
    const unsigned long long mask = ((const unsigned long long*)(F.wsp() + WS_MASK))[(size_t)bh * SEQ + blk * 32 + r32];
    bf16x8 kf[8], vf[8];
    {
        const unsigned soK = (unsigned)((2 * KVBUF_ELEMS + (size_t)bh * KVROWS * 64) * 2), soV = (unsigned)((3 * KVBUF_ELEMS + (size_t)bh * KVROWS * 64) * 2);
        Sm st; sm_init(st);
        load_frag8(kf, rs, vo, soK);
#pragma unroll 1
        for (int j = 0; j <= c; ++j) {
            const bool sel = ((mask >> j) & 1ull) != 0ull;
            f32x16 s0, s1; qk_tile(s0, s1, kf, qr, sel ? -st.mhat : -INFINITY);
            asm volatile("" : "+v"(s0), "+v"(s1) :: "memory");
            load_frag8(vf, rs, vo, soV + (unsigned)j * 8192u);
            load_frag8(kf, rs, vo, soK + (unsigned)(j < c ? j + 1 : c) * 8192u);
            if (j == c) mask_tile(s0, s1, -1, ql, hi);
            sm_tile(st, s0, s1, j == 0, vf, wsf, r32, hi);
            asm volatile("" : "+v"(st.o0), "+v"(st.o1), "+v"(st.ol) :: "memory");
        }
        flush_branch<true>(st.o0, st.o1, st.ol, GATE, O, m0, hq, 1, true, stg, lane);
    }
    {
        const unsigned soK = (unsigned)((4 * KVBUF_ELEMS + (size_t)bh * KVROWS * 64) * 2), soV = (unsigned)((5 * KVBUF_ELEMS + (size_t)bh * KVROWS * 64) * 2);
        Sm st; sm_init(st);
        const int j0 = c >= 8 ? c - 8 : 0;
        load_frag8(kf, rs, vo, soK + (unsigned)j0 * 8192u);
#pragma unroll 1
        for (int j = j0; j <= c; ++j) {
            f32x16 s0, s1; qk_tile(s0, s1, kf, qr, -st.mhat);
            asm volatile("" : "+v"(s0), "+v"(s1) :: "memory");
            load_frag8(vf, rs, vo, soV + (unsigned)j * 8192u);
            load_frag8(kf, rs, vo, soK + (unsigned)(j < c ? j + 1 : c) * 8192u);
            if (j == c || j + 8 == c) mask_tile(s0, s1, (j + 8 == c) ? ql : -1, (j == c) ? ql : 63, hi);
            sm_tile(st, s0, s1, j == j0, vf, wsf, r32, hi);
            asm volatile("" : "+v"(st.o0), "+v"(st.o1), "+v"(st.ol) :: "memory");
        }
        flush_branch<true>(st.o0, st.o1, st.ol, GATE, O, m0, hq, 2, true, stg, lane);
    }
}
__device__ __forceinline__ void p_attn_main(Frame& F) {
    LAS float* stg = (LAS float*)(F.lds + F.wave * 16384); LAS float* wsf = stg + 32 * STG_STRIDE;
    for (int P = F.gw; P < 4096; P += F.NGW) {
        const int bh = P >> 8, rem = P & 255, g = rem & 3, k = rem >> 2;
        attn_main_item(F, bh, g, 127 - k, stg, wsf);
        attn_main_item(F, bh, g, k, stg, wsf);
    }
}
constexpr int AT_SLOT = 16384, AT_NSLOT = 4, AT_PW_OFF = AT_NSLOT * AT_SLOT, AT_PW_BYTES = STG_BYTES + 256 + 384, AT_MASK_OFF = AT_PW_OFF + 8 * AT_PW_BYTES;
static_assert(AT_MASK_OFF + 512 <= LDSCTL_OFF, "attention LDS map");
#define AT_WAIT_BAR(N) asm volatile("s_waitcnt vmcnt(" #N ") lgkmcnt(0)\n\ts_barrier" ::: "memory")
__device__ __forceinline__ void at_dma(const char* g, LAS unsigned char* l) { __builtin_amdgcn_global_load_lds((const unsigned*)g, (LAS unsigned*)l, 16, 0, 0); }
__device__ __forceinline__ void qk_tile_reg(f32x16& p0, f32x16& p1, const LAS unsigned char* ks, const bf16x8 (&qr)[4], const float cinit) {
    bf16x8 kf[8];
#pragma unroll
    for (int f = 0; f < 8; ++f) kf[f] = *(const LAS bf16x8*)(ks + f * 1024);
    __builtin_amdgcn_sched_barrier(0);
    f32x16 c;
#pragma unroll
    for (int r = 0; r < 16; ++r) c[r] = cinit;
    p0 = MFMA32(kf[0], qr[0], c); p1 = MFMA32(kf[4], qr[0], c);
#pragma unroll
    for (int d0 = 1; d0 < 4; ++d0) { p0 = MFMA32(kf[d0], qr[d0], p0); p1 = MFMA32(kf[4 + d0], qr[d0], p1); }
}
template <int V>
__device__ __forceinline__ void sm_tile_lds(Sm& st, f32x16& s0, f32x16& s1, bool first, const LAS unsigned char* vs, LAS float* wsf, int r32, int hi) {
    const float rm = rowmax32(s0, s1, hi);
    const bool need = first || (__any(rm > 8.0f) != 0);
    if (need) {
        const float dl = first ? ((rm == -INFINITY) ? 0.f : rm) : fmaxf(rm, 0.f);
        st.mhat += dl;
#pragma unroll
        for (int r = 0; r < 16; ++r) { s0[r] -= dl; s1[r] -= dl; }
        if (!first) {
            const float f = __builtin_amdgcn_exp2f(-dl);
            LDS_WAIT(); asm volatile("" ::: "memory");
            if (hi == 0) wsf[r32] = f;
            LDS_WAIT(); asm volatile("" ::: "memory");
#pragma unroll
            for (int G = 0; G < 4; ++G) { const f32x4 ff = *(const LAS f32x4*)(wsf + 8 * G + 4 * hi);
#pragma unroll
                for (int q = 0; q < 4; ++q) { st.o0[4 * G + q] *= ff[q]; st.o1[4 * G + q] *= ff[q]; st.ol[4 * G + q] *= ff[q]; } }
            LDS_WAIT(); asm volatile("" ::: "memory");
        }
    }
    bf16x8 vf[8];
#pragma unroll
    for (int f = 0; f < 8; ++f) vf[f] = *(const LAS bf16x8*)(vs + f * 1024);
    __builtin_amdgcn_sched_barrier(0);
    if (V != 2) {
#pragma unroll
    for (int r = 0; r < 16; ++r) { s0[r] = __builtin_amdgcn_exp2f(s0[r]); s1[r] = __builtin_amdgcn_exp2f(s1[r]); } }
    bf16x8 pa[4]; pack_p(pa, s0, s1);
    const bf16x8 ones = (bf16x8){0x3F80, 0x3F80, 0x3F80, 0x3F80, 0x3F80, 0x3F80, 0x3F80, 0x3F80};
    if (V != 3) {
#pragma unroll
    for (int ks = 0; ks < 4; ++ks) { st.o0 = MFMA32(pa[ks], vf[ks], st.o0); st.o1 = MFMA32(pa[ks], vf[4 + ks], st.o1); st.ol = MFMA32(pa[ks], ones, st.ol); }
    } else { asm volatile("" :: "v"(pa[0]), "v"(pa[1]), "v"(pa[2]), "v"(pa[3]), "v"(vf[0]), "v"(vf[1]), "v"(vf[2]), "v"(vf[3]), "v"(vf[4]), "v"(vf[5]), "v"(vf[6]), "v"(vf[7])); }
}
template <bool WIN, int V>
__device__ __forceinline__ void at_branch(Sm& st, const char* Kg, const char* Vg, int j0, int c, int ql, unsigned long long mask, const bf16x8 (&qr)[4],
                                          LAS unsigned char* ring, LAS float* wsf, int wave, int lane) {
    const int r32 = lane & 31, hi = lane >> 5, n = c - j0 + 1;
    LAS unsigned char* dk = ring + wave * 1024;
    const LAS unsigned char* rd = ring + lane * 16;
#pragma unroll
    for (int d = 0; d < 3; ++d) if (d < n) { at_dma(Kg + (size_t)(j0 + d) * 8192, dk + d * AT_SLOT); at_dma(Vg + (size_t)(j0 + d) * 8192, dk + d * AT_SLOT + 8192); }
#pragma unroll 1
    for (int t = 0; t < n; ++t) {
        const int rem = n - 1 - t;
        if (V != 1) { if (rem >= 2) AT_WAIT_BAR(4); else if (rem == 1) AT_WAIT_BAR(2); else AT_WAIT_BAR(0); }
        if (t + 3 < n) { const int sl = (t + 3) & 3; at_dma(Kg + (size_t)(j0 + t + 3) * 8192, dk + sl * AT_SLOT); at_dma(Vg + (size_t)(j0 + t + 3) * 8192, dk + sl * AT_SLOT + 8192); }
        const int j = j0 + t; const LAS unsigned char* slot = rd + (t & 3) * AT_SLOT;
        const bool sel = WIN ? true : (((mask >> j) & 1ull) != 0ull);
        f32x16 s0, s1;
        if (V != 4) qk_tile_reg(s0, s1, slot, qr, sel ? -st.mhat : -INFINITY);
        else {
#pragma unroll
            for (int r = 0; r < 16; ++r) { s0[r] = sel ? -st.mhat : -1.f; s1[r] = s0[r]; } asm volatile("" : "+v"(s0), "+v"(s1)); }
        if (WIN) { if (j == c || j + 8 == c) mask_tile(s0, s1, (j + 8 == c) ? ql : -1, (j == c) ? ql : 63, hi); }
        else { if (j == c) mask_tile(s0, s1, -1, ql, hi); }
        sm_tile_lds<V>(st, s0, s1, t == 0, slot + 8192, wsf, r32, hi);
    }
}
#define AT_PIN(x) asm volatile("" : "+v"(x))
#define AT_GAPA(MF, P, B, W, I) do { MF; lsum += (P[B] + P[B + 1]) + (P[B + 2] + P[B + 3]); W[I] = cvtpk(P[B], P[B + 1]); W[I + 1] = cvtpk(P[B + 2], P[B + 3]); \
        AT_PIN(lsum); AT_PIN(W); __builtin_amdgcn_sched_barrier(0); } while (0)
#define AT_GAPB(MF, C, B) do { MF; C[B] = __builtin_amdgcn_exp2f(C[B]); C[B + 1] = __builtin_amdgcn_exp2f(C[B + 1]); C[B + 2] = __builtin_amdgcn_exp2f(C[B + 2]); C[B + 3] = __builtin_amdgcn_exp2f(C[B + 3]); \
        AT_PIN(C); __builtin_amdgcn_sched_barrier(0); } while (0)
template <bool WIN>
__device__ __forceinline__ void at_branch_pipe(Sm& st, const char* Kg, const char* Vg, int j0, int c, int ql, unsigned long long mask, const bf16x8 (&qr)[4],
                                               LAS unsigned char* ring, LAS float* wsf, int wave, int lane) {
    const int r32 = lane & 31, hi = lane >> 5, n = c - j0 + 1;
    LAS unsigned char* dk = ring + wave * 1024;
    const LAS unsigned char* rd = ring + lane * 16;
#pragma unroll
    for (int d = 0; d < 2; ++d) if (d < n) { at_dma(Kg + (size_t)(j0 + d) * 8192, dk + d * AT_SLOT); at_dma(Vg + (size_t)(j0 + d) * 8192, dk + d * AT_SLOT + 8192); }
    if (n > 1) AT_WAIT_BAR(2); else AT_WAIT_BAR(0);
    if (2 < n) { at_dma(Kg + (size_t)(j0 + 2) * 8192, dk + 2 * AT_SLOT); at_dma(Vg + (size_t)(j0 + 2) * 8192, dk + 2 * AT_SLOT + 8192); }
    f32x16 p0, p1;
    { const bool sel = WIN ? true : ((mask >> j0) & 1ull) != 0ull;
      qk_tile_reg(p0, p1, rd, qr, sel ? 0.f : -INFINITY);
      if (WIN) { if (j0 == c || j0 + 8 == c) mask_tile(p0, p1, (j0 + 8 == c) ? ql : -1, (j0 == c) ? ql : 63, hi); }
      else { if (j0 == c) mask_tile(p0, p1, -1, ql, hi); }
      const float rm = rowmax32(p0, p1, hi), dl = (rm == -INFINITY) ? 0.f : rm;
      st.mhat = dl;
#pragma unroll
      for (int r = 0; r < 16; ++r) { p0[r] = __builtin_amdgcn_exp2f(p0[r] - dl); p1[r] = __builtin_amdgcn_exp2f(p1[r] - dl); } }
#pragma unroll 1
    for (int t = 1; t < n; ++t) {
        if (t + 1 < n) AT_WAIT_BAR(2); else AT_WAIT_BAR(0);
        if (t + 2 < n) { const int sl = (t + 2) & 3; at_dma(Kg + (size_t)(j0 + t + 2) * 8192, dk + sl * AT_SLOT); at_dma(Vg + (size_t)(j0 + t + 2) * 8192, dk + sl * AT_SLOT + 8192); }
        const int j = j0 + t;
        const bool sel = WIN ? true : ((mask >> j) & 1ull) != 0ull;
        const LAS unsigned char* ks = rd + (t & 3) * AT_SLOT; const LAS unsigned char* vs = rd + ((t - 1) & 3) * AT_SLOT + 8192;
        bf16x8 kf[8], vf[8];
#pragma unroll
        for (int f = 0; f < 8; ++f) kf[f] = *(const LAS bf16x8*)(ks + f * 1024);
        f32x16 cv; { const float ci = sel ? -st.mhat : -INFINITY;
#pragma unroll
            for (int r = 0; r < 16; ++r) cv[r] = ci; }
        __builtin_amdgcn_sched_barrier(0);
        f32x16 c0, c1; u32x4 w0, w1, w2, w3; float lsum = 0.f;
        AT_GAPA(c0 = MFMA32(kf[0], qr[0], cv), p0, 0, w0, 0);
        AT_GAPA(c1 = MFMA32(kf[4], qr[0], cv), p0, 4, w0, 2);
        AT_GAPA(c0 = MFMA32(kf[1], qr[1], c0), p0, 8, w1, 0);
        AT_GAPA(c1 = MFMA32(kf[5], qr[1], c1), p0, 12, w1, 2);
#pragma unroll
        for (int f = 0; f < 8; ++f) vf[f] = *(const LAS bf16x8*)(vs + f * 1024);
        __builtin_amdgcn_sched_barrier(0);
        AT_GAPA(c0 = MFMA32(kf[2], qr[2], c0), p1, 0, w2, 0);
        AT_GAPA(c1 = MFMA32(kf[6], qr[2], c1), p1, 4, w2, 2);
        AT_GAPA(c0 = MFMA32(kf[3], qr[3], c0), p1, 8, w3, 0);
        AT_GAPA(c1 = MFMA32(kf[7], qr[3], c1), p1, 12, w3, 2);
        st.l += lsum;
        if (WIN) { if (j == c || j + 8 == c) mask_tile(c0, c1, (j + 8 == c) ? ql : -1, (j == c) ? ql : 63, hi); }
        else { if (j == c) mask_tile(c0, c1, -1, ql, hi); }
        const float rm = rowmax32(c0, c1, hi);
        const bool resc = (__any(rm > 8.0f) != 0);
        if (resc) { const float dl = fmaxf(rm, 0.f); st.mhat += dl;
#pragma unroll
            for (int r = 0; r < 16; ++r) { c0[r] -= dl; c1[r] -= dl; }
            const float f = __builtin_amdgcn_exp2f(-dl); st.l *= f;
            LDS_WAIT(); asm volatile("" ::: "memory");
            if (hi == 0) wsf[r32] = f; }
        __builtin_amdgcn_sched_barrier(0);
        { const bf16x8 a0 = __builtin_bit_cast(bf16x8, w0), a1 = __builtin_bit_cast(bf16x8, w1), a2 = __builtin_bit_cast(bf16x8, w2), a3 = __builtin_bit_cast(bf16x8, w3);
          AT_GAPB(st.o0 = MFMA32(a0, vf[0], st.o0), c0, 0);
          AT_GAPB(st.o1 = MFMA32(a0, vf[4], st.o1), c0, 4);
          AT_GAPB(st.o0 = MFMA32(a1, vf[1], st.o0), c0, 8);
          AT_GAPB(st.o1 = MFMA32(a1, vf[5], st.o1), c0, 12);
          AT_GAPB(st.o0 = MFMA32(a2, vf[2], st.o0), c1, 0);
          AT_GAPB(st.o1 = MFMA32(a2, vf[6], st.o1), c1, 4);
          AT_GAPB(st.o0 = MFMA32(a3, vf[3], st.o0), c1, 8);
          AT_GAPB(st.o1 = MFMA32(a3, vf[7], st.o1), c1, 12); }
        if (resc) {
            LDS_WAIT(); asm volatile("" ::: "memory");
#pragma unroll
            for (int G = 0; G < 4; ++G) { const f32x4 ff = *(const LAS f32x4*)(wsf + 8 * G + 4 * hi);
#pragma unroll
                for (int q = 0; q < 4; ++q) { st.o0[4 * G + q] *= ff[q]; st.o1[4 * G + q] *= ff[q]; } }
            LDS_WAIT(); asm volatile("" ::: "memory"); }
        p0 = c0; p1 = c1;
    }
    { float lsum = 0.f;
#pragma unroll
      for (int r = 0; r < 16; ++r) lsum += p0[r] + p1[r];
      st.l += lsum;
      bf16x8 pa[4]; pack_p(pa, p0, p1);
      bf16x8 vf[8]; const LAS unsigned char* vs = rd + ((n - 1) & 3) * AT_SLOT + 8192;
#pragma unroll
      for (int f = 0; f < 8; ++f) vf[f] = *(const LAS bf16x8*)(vs + f * 1024);
      pv_tile(st.o0, st.o1, pa, vf); }
    { const float lt = st.l + partner32(st.l, hi);
      LDS_WAIT(); asm volatile("" ::: "memory");
      if (hi == 0) wsf[r32] = lt;
      LDS_WAIT(); asm volatile("" ::: "memory");
#pragma unroll
      for (int G = 0; G < 4; ++G) { const f32x4 ff = *(const LAS f32x4*)(wsf + 8 * G + 4 * hi);
#pragma unroll
          for (int q = 0; q < 4; ++q) st.ol[4 * G + q] = ff[q]; }
      LDS_WAIT(); asm volatile("" ::: "memory"); }
}
template <bool DRY, int V>
__device__ __forceinline__ void attn_unit(Frame& F, int bh, int c) {
    const bf16* Q = (const bf16*)(F.wsp() + WS_Q); const float* GATE = (const float*)(F.wsp() + WS_GATE); bf16* O = (bf16*)(F.wsp() + (DRY ? WS_Y0 : WS_O));
    const int wave = F.wave, g = wave >> 1, th = wave & 1;
    int lane = F.lane; asm volatile("" : "+v"(lane));
    const int r32 = lane & 31, hi = lane >> 5;
    const int b = bh >> 2, hk = bh & 3, hq = hk * 4 + g, m0 = b * SEQ + c * 64 + th * 32, t = c * 64 + th * 32 + r32, ql = th * 32 + r32;
    LAS unsigned char* ring = F.lds;
    LAS float* stg = (LAS float*)(F.lds + AT_PW_OFF + wave * AT_PW_BYTES); LAS float* wsf = stg + 32 * STG_STRIDE;
    LAS unsigned long long* masks = (LAS unsigned long long*)(F.lds + AT_MASK_OFF);
    const size_t lofs = (size_t)wave * 1024 + (size_t)lane * 16;
    bf16x8 qr[4];
#pragma unroll
    for (int d0 = 0; d0 < 4; ++d0) qr[d0] = *(const bf16x8*)(Q + (size_t)(m0 + r32) * DM + hq * 64 + d0 * 16 + hi * 8);
    LAS float* gl = wsf + 64;
    if (hi == 0) { const float* gp = GATE + (size_t)(m0 + r32) * 48 + hq * 3; gl[r32] = gp[0]; gl[32 + r32] = gp[1]; gl[64 + r32] = gp[2]; }
    const int nvr = t >= 31 ? ((t - 31) >> 4) + 1 : 0, ntc = (4 * c + 3 + 63) >> 6;
    f32x16 oc0, oc1;
    {
        const char* KCg = (const char*)(F.wsp() + WS_KC) + (size_t)bh * 32768 + lofs; const char* VCg = (const char*)(F.wsp() + WS_VC) + (size_t)bh * 32768 + lofs;
        asm volatile("s_waitcnt vmcnt(0)" ::: "memory");
        for (int i = 0; i < ntc; ++i) { at_dma(KCg + (size_t)i * 8192, ring + i * AT_SLOT + wave * 1024); at_dma(VCg + (size_t)i * 8192, ring + i * AT_SLOT + 8192 + wave * 1024); }
        AT_WAIT_BAR(0);
        const LAS unsigned char* rd = ring + lane * 16;
        float mhat = 0.f, l = 0.f;
        float imp[32];
#pragma unroll
        for (int k = 0; k < 32; ++k) imp[k] = 0.f;
        f32x16 o0, o1;
#pragma unroll
        for (int r = 0; r < 16; ++r) { o0[r] = 0.f; o1[r] = 0.f; }
#pragma unroll
        for (int i = 0; i < 4; ++i) if (i < ntc) {
            asm volatile("" ::: "memory");
            f32x16 s0, s1; qk_tile_reg(s0, s1, rd + i * AT_SLOT, qr, -mhat); mask_tile(s0, s1, -1, nvr - 1 - 64 * i, hi);
            const float rm = rowmax32(s0, s1, hi);
            if (i == 0) { const float dl = (rm == -INFINITY) ? 0.f : rm; mhat = dl;
#pragma unroll
                for (int r = 0; r < 16; ++r) { s0[r] -= dl; s1[r] -= dl; } }
            else if (__any(rm > 8.0f) != 0) { const float dl = fmaxf(rm, 0.f); mhat += dl;
#pragma unroll
                for (int r = 0; r < 16; ++r) { s0[r] -= dl; s1[r] -= dl; }
                const float f = __builtin_amdgcn_exp2f(-dl); l *= f;
#pragma unroll
                for (int k = 0; k < 32; ++k) imp[k] *= f;
                LDS_WAIT(); asm volatile("" ::: "memory");
                if (hi == 0) wsf[r32] = f;
                LDS_WAIT(); asm volatile("" ::: "memory");
#pragma unroll
                for (int G = 0; G < 4; ++G) { const f32x4 ff = *(const LAS f32x4*)(wsf + 8 * G + 4 * hi);
#pragma unroll
                    for (int q = 0; q < 4; ++q) { o0[4 * G + q] *= ff[q]; o1[4 * G + q] *= ff[q]; } }
                LDS_WAIT(); asm volatile("" ::: "memory"); }
            float sum = 0.f;
#pragma unroll
            for (int r = 0; r < 16; ++r) { s0[r] = __builtin_amdgcn_exp2f(s0[r]); s1[r] = __builtin_amdgcn_exp2f(s1[r]); sum += s0[r] + s1[r]; }
            l += sum;
#pragma unroll
            for (int G = 0; G < 4; ++G) {
                { const int kq = 8 * i + G; const float e = s0[4 * G + 3], pe = partner32(e, hi);
                  imp[kq] += (s0[4 * G] + s0[4 * G + 1]) + s0[4 * G + 2] + 0.5f * e + (hi ? 0.5f * pe : 0.f);
                  if (kq + 1 < 32) imp[kq + 1] += hi ? 0.f : 0.5f * pe; }
                { const int kq = 8 * i + 4 + G; const float e = s1[4 * G + 3], pe = partner32(e, hi);
                  imp[kq] += (s1[4 * G] + s1[4 * G + 1]) + s1[4 * G + 2] + 0.5f * e + (hi ? 0.5f * pe : 0.f);
                  if (kq + 1 < 32) imp[kq + 1] += hi ? 0.f : 0.5f * pe; }
            }
            bf16x8 pa[4]; pack_p(pa, s0, s1);
            { bf16x8 vf[4];
#pragma unroll
              for (int f = 0; f < 4; ++f) vf[f] = *(const LAS bf16x8*)(rd + i * AT_SLOT + 8192 + f * 1024);
#pragma unroll
              for (int ks = 0; ks < 4; ++ks) o0 = MFMA32(pa[ks], vf[ks], o0);
              asm volatile("" : "+v"(o0) :: "memory");
#pragma unroll
              for (int f = 0; f < 4; ++f) vf[f] = *(const LAS bf16x8*)(rd + i * AT_SLOT + 8192 + (4 + f) * 1024);
#pragma unroll
              for (int ks = 0; ks < 4; ++ks) o1 = MFMA32(pa[ks], vf[ks], o1); }
        }
        const float ltot = l + partner32(l, hi), inv = 1.f / fmaxf(ltot, 1e-30f);
#pragma unroll
        for (int k = 0; k < 32; ++k) imp[k] *= inv;
        LDS_WAIT(); asm volatile("" ::: "memory");
        if (hi == 0) wsf[r32] = gl[r32] * inv;
        LDS_WAIT(); asm volatile("" ::: "memory");
#pragma unroll
        for (int G = 0; G < 4; ++G) { const f32x4 gg = *(const LAS f32x4*)(wsf + 8 * G + 4 * hi);
#pragma unroll
            for (int q = 0; q < 4; ++q) { oc0[4 * G + q] = o0[4 * G + q] * gg[q]; oc1[4 * G + q] = o1[4 * G + q] * gg[q]; } }
        LDS_WAIT(); asm volatile("" ::: "memory");
#pragma unroll
        for (int k = 0; k < 32; ++k) stg[r32 * STG_STRIDE + 2 * k + hi] = imp[k];
    }
    AT_WAIT_BAR(0);
    const char* KSg = (const char*)(F.wsp() + WS_KV) + (2 * KVBUF_ELEMS + (size_t)bh * KVROWS * 64) * 2 + lofs;
    const char* VSg = (const char*)(F.wsp() + WS_KV) + (3 * KVBUF_ELEMS + (size_t)bh * KVROWS * 64) * 2 + lofs;
    if (c < 16) { if (lane < 8) masks[th * 32 + 8 * g + lane] = (2ull << c) - 1ull; }
    else {
        const LAS float* st0 = (const LAS float*)(F.lds + AT_PW_OFF + (0 * 2 + th) * AT_PW_BYTES); const LAS float* st1 = (const LAS float*)(F.lds + AT_PW_OFF + (1 * 2 + th) * AT_PW_BYTES);
        const LAS float* st2 = (const LAS float*)(F.lds + AT_PW_OFF + (2 * 2 + th) * AT_PW_BYTES); const LAS float* st3 = (const LAS float*)(F.lds + AT_PW_OFF + (3 * 2 + th) * AT_PW_BYTES);
        const bool allowed = lane <= c, forced = allowed && (lane == 0 || lane == c || lane == c - 1);
        LAS unsigned* kst = (LAS unsigned*)stg;
#pragma unroll 1
        for (int i = 0; i < 8; i += 2) {
            const int tokA = 8 * g + i, tokB = tokA + 1, aA = tokA * STG_STRIDE + lane, aB = tokB * STG_STRIDE + lane;
            const float vA = ((st0[aA] + st1[aA]) + st2[aA]) + st3[aA], vB = ((st0[aB] + st1[aB]) + st2[aB]) + st3[aB];
            const unsigned low = 63u - (unsigned)lane;
            const unsigned keyA = forced ? (0xFFFFFFC0u | low) : (allowed ? ((__builtin_bit_cast(unsigned, vA) & 0xFFFFFFC0u) | low) : 0u);
            const unsigned keyB = forced ? (0xFFFFFFC0u | low) : (allowed ? ((__builtin_bit_cast(unsigned, vB) & 0xFFFFFFC0u) | low) : 0u);
            LDS_WAIT(); asm volatile("" ::: "memory");
            kst[aA] = keyA; kst[aB] = keyB;
            LDS_WAIT(); asm volatile("" ::: "memory");
            int rankA = 0, rankB = 0;
#pragma unroll
            for (int q = 0; q < 16; ++q) { const u32x4 xa = *(const LAS u32x4*)(kst + tokA * STG_STRIDE + 4 * q), xb = *(const LAS u32x4*)(kst + tokB * STG_STRIDE + 4 * q);
#pragma unroll
                for (int e = 0; e < 4; ++e) { rankA += (xa[e] > keyA) ? 1 : 0; rankB += (xb[e] > keyB) ? 1 : 0; } }
            const unsigned long long mkA = __ballot(rankA < 16 && allowed), mkB = __ballot(rankB < 16 && allowed);
            if (lane == 0) { masks[th * 32 + tokA] = mkA; masks[th * 32 + tokB] = mkB; }
        }
    }
    AT_WAIT_BAR(0);
    const unsigned long long mask = masks[th * 32 + r32];
#pragma unroll
    for (int r = 0; r < 16; ++r) { stg[crow(r, hi) * STG_STRIDE + r32] = oc0[r]; stg[crow(r, hi) * STG_STRIDE + 32 + r32] = oc1[r]; }
    {
        Sm st; sm_init(st);
        if (V == 0) at_branch_pipe<false>(st, KSg, VSg, 0, c, ql, mask, qr, ring, wsf, wave, lane); else if (V != 5) at_branch<false, V>(st, KSg, VSg, 0, c, ql, mask, qr, ring, wsf, wave, lane);
        LDS_WAIT(); asm volatile("" ::: "memory");
#pragma unroll
        for (int G = 0; G < 4; ++G) { const f32x4 gg = *(const LAS f32x4*)(gl + 32 + 8 * G + 4 * hi);
#pragma unroll
            for (int q = 0; q < 4; ++q) { const int r = 4 * G + q; const float iv = gg[q] * __builtin_amdgcn_rcpf(fmaxf(st.ol[r], 1e-30f));
                stg[crow(r, hi) * STG_STRIDE + r32] += st.o0[r] * iv; stg[crow(r, hi) * STG_STRIDE + 32 + r32] += st.o1[r] * iv; } }
    }
    AT_WAIT_BAR(0);
    {
        const char* KWg = (const char*)(F.wsp() + WS_KV) + (4 * KVBUF_ELEMS + (size_t)bh * KVROWS * 64) * 2 + lofs;
        const char* VWg = (const char*)(F.wsp() + WS_KV) + (5 * KVBUF_ELEMS + (size_t)bh * KVROWS * 64) * 2 + lofs;
        Sm st; sm_init(st);
        if (V == 0) at_branch_pipe<true>(st, KWg, VWg, c >= 8 ? c - 8 : 0, c, ql, 0ull, qr, ring, wsf, wave, lane); else if (V != 5) at_branch<true, V>(st, KWg, VWg, c >= 8 ? c - 8 : 0, c, ql, 0ull, qr, ring, wsf, wave, lane);
        LDS_WAIT(); asm volatile("" ::: "memory");
#pragma unroll
        for (int G = 0; G < 4; ++G) { const f32x4 gg = *(const LAS f32x4*)(gl + 64 + 8 * G + 4 * hi);
#pragma unroll
            for (int q = 0; q < 4; ++q) { const int r = 4 * G + q; const float iv = gg[q] * __builtin_amdgcn_rcpf(fmaxf(st.ol[r], 1e-30f));
                stg[crow(r, hi) * STG_STRIDE + r32] += st.o0[r] * iv; stg[crow(r, hi) * STG_STRIDE + 32 + r32] += st.o1[r] * iv; } }
        LDS_WAIT(); asm volatile("" ::: "memory");
#pragma unroll
        for (int i = 0; i < 4; ++i) { const int row = i * 8 + (lane >> 3), ch = lane & 7;
            const f32x4 a = *(const LAS f32x4*)(stg + row * STG_STRIDE + ch * 8), b2 = *(const LAS f32x4*)(stg + row * STG_STRIDE + ch * 8 + 4);
            u32x4 w; w.x = pk2(a[0], a[1]); w.y = pk2(a[2], a[3]); w.z = pk2(b2[0], b2[1]); w.w = pk2(b2[2], b2[3]);
            *(u32x4*)(O + (size_t)(m0 + row) * DM + hq * 64 + ch * 8) = w; }
    }
    AT_WAIT_BAR(0);
}
template <bool DRY, int V>
__device__ __forceinline__ void p_attn_fused(Frame& F) {
    const int G = gridDim.x, bx = blockIdx.x, vcu = (G % 8 == 0) ? (bx % 8) * (G / 8) + bx / 8 : bx;
    for (int P = vcu; P < 512; P += G) {
        const int bh = P >> 5, k = P & 31;
#pragma unroll 1
        for (int h = 0; h < 2; ++h) attn_unit<DRY, V>(F, bh, h ? k : 63 - k);
    }
}
struct Args { const float* in[23]; float* out; unsigned char* ws; int ph_lo, ph_hi; };
__global__ void __launch_bounds__(512, 2) mk_fwd(Args args) {
    extern __shared__ __attribute__((aligned(16))) unsigned char lds[];
    Frame F;
    F.lds = (LAS unsigned char*)lds; F.MISC = (volatile LAS unsigned*)(F.lds + MISC_OFF);
    F.tid = threadIdx.x; F.lane = F.tid & 63; F.wave = __builtin_amdgcn_readfirstlane(F.tid >> 6);
    F.gw = blockIdx.x * 8 + F.wave; F.NGW = gridDim.x * 8;
    for (int u = F.tid; u < (LDS_BYTES - LDSCTL_OFF) / 4; u += 512) ((LAS unsigned*)(F.lds + LDSCTL_OFF))[u] = 0u;
    __syncthreads();
    if (F.tid < 25) { const unsigned long long v = F.tid < 23 ? (unsigned long long)args.in[F.tid] : F.tid == 23 ? (unsigned long long)args.out : (unsigned long long)args.ws;
        LAS unsigned* p = (LAS unsigned*)(F.lds + PTR_OFF) + 2 * F.tid; p[0] = (unsigned)v; p[1] = (unsigned)(v >> 32); }
    __syncthreads();
    XcdBarrier bar; bar.bar = (unsigned*)(F.ctlp() + CW_BAR); bar.x = 0; bar.st = nullptr;
    const int lo = args.ph_lo, hi = args.ph_hi;
    if (hi - lo > 1) bar = xcd_barrier_post((unsigned*)(F.ctlp() + CW_BAR), F.MISC + 8);
#ifdef PH_ONLY
#define IN(k) ((k) == PH_ONLY && lo <= (k) && (k) < hi)
#else
#define IN(k) (lo <= (k) && (k) < hi)
#endif
#define SEAM(k) do { if (IN(k) && (k) + 1 < hi) xcd_barrier(bar); } while (0)
    if (IN(0)) {
#pragma unroll 1
        for (int rep = 0; rep < REP0; ++rep) { p0_prologue(F); if (rep + 1 < REP0) xcd_barrier(bar); } } SEAM(0);
    if (IN(1)) {
#pragma unroll 1
        for (int rep = 0; rep < REP1; ++rep) { p1_mod_u0(F); if (rep + 1 < REP1) xcd_barrier(bar); }
#pragma unroll 1
        for (int rep = 0; rep < XBAR - 1; ++rep) xcd_barrier(bar); } SEAM(1);
    if (IN(2)) for (int rep = 0; rep < REP2; ++rep) {
        const char* A = (const char*)(F.wsp() + WS_U); const char* B = (const char*)(F.wsp() + WS_WIN);
        const pg8::SchedDense S{A, B, A, B + (size_t)1024 * DM * 2, T / 256, 4, 8, DM, (int)gridDim.x, (int)blockIdx.x, 256};
#if DRY2 == 1
        { pg8::gemm_phase<EpNull, pg8::SchedDense, true, false>(F.lds, DM, S, EpNull{}); xcd_barrier(bar); }
#elif DRY2 == 2
        { pg8::gemm_phase<EpG1, pg8::SchedDense, true, false>(F.lds, DM, S, EpG1{(bf16*)(F.wsp() + WS_Y0), (bf16*)(F.wsp() + WS_Y1)}); xcd_barrier(bar); }
#endif
        pg8::gemm_phase<EpG1, pg8::SchedDense, true, false>(F.lds, DM, S, EpG1{(bf16*)(F.wsp() + WS_BG), (bf16*)(F.wsp() + WS_Z)});
        if (rep + 1 < REP2) xcd_barrier(bar);
    } SEAM(2);
    if (IN(3)) {
#pragma unroll 1
        for (int rep = 0; rep < REP3; ++rep) { p3_conv(F); if (rep + 1 < REP3) xcd_barrier(bar); } } SEAM(3);
    if (IN(4)) for (int rep = 0; rep < REP4; ++rep) {
        const pg8::SchedDense S{(const char*)(F.wsp() + WS_A2), (const char*)(F.wsp() + WS_WOUT), nullptr, nullptr, T / 256, 4, 0, DM, (int)gridDim.x, (int)blockIdx.x, 256};
        typedef pg8::EpiWrap<EpU<EpBf16>, false, true> E_;
        pg8::gemm_phase<E_, pg8::SchedDense, false, false>(F.lds, DM, S, E_{{{(bf16*)(F.wsp() + WS_Y0), DM}}});
        if (rep + 1 < REP4) xcd_barrier(bar);
    } SEAM(4);
    if (IN(5)) {
#pragma unroll 1
        for (int rep = 0; rep < DRY5; ++rep) { p_ln_router<0, true>(F); xcd_barrier(bar); }
        p_ln_router<0>(F); } SEAM(5);
    if (IN(6)) { p_moe<0>(F, bar, true); } SEAM(6);
    if (IN(8)) {
#pragma unroll 1
        for (int rep = 0; rep < DRY8; ++rep) { p_ln2<0, true>(F); xcd_barrier(bar); }
        p_ln2<0>(F); } SEAM(8);
    if (IN(9)) {
        const int G = gridDim.x, bx = blockIdx.x, vcu = (G % 8 == 0) ? (bx % 8) * (G / 8) + bx / 8 : bx;
        const SchedKVQG S{(const char*)(F.wsp() + WS_XB), (const char*)(F.wsp() + WS_WKV), (const char*)(F.wsp() + WS_U), (const char*)(F.wsp() + WS_WQG), G, vcu, 0, 512};
        typedef pg8::EpiWrap<EpKVQG, false, true> E_;
        pg8::gemm_phase<E_, SchedKVQG, true, false>(F.lds, DM, S, E_{{(bf16*)(F.wsp() + WS_KV), (bf16*)(F.wsp() + WS_Q), (float*)(F.wsp() + WS_GATE), F.inp(I_BG)}});
    } SEAM(9);
    if (IN(10)) {
        const int G = gridDim.x, bx = blockIdx.x, vcu = (G % 8 == 0) ? (bx % 8) * (G / 8) + bx / 8 : bx;
        const int nq = G - 64 > 0 ? G - 64 : G;
        {
            const SchedKVQG S{(const char*)(F.wsp() + WS_XB), (const char*)(F.wsp() + WS_WKV), (const char*)(F.wsp() + WS_U), (const char*)(F.wsp() + WS_WQG), nq, vcu < nq ? vcu : -1, 512, 704};
            typedef pg8::EpiWrap<EpKVQG, false, true> E_;
            pg8::gemm_phase<E_, SchedKVQG, false, false>(F.lds, DM, S, E_{{(bf16*)(F.wsp() + WS_KV), (bf16*)(F.wsp() + WS_Q), (float*)(F.wsp() + WS_GATE), F.inp(I_BG)}});
        }
        {
            const SchedCmp S{(const char*)(F.wsp() + WS_KV), (const char*)(F.wsp() + WS_W1C), G - nq > 0 ? G - nq : G, G - nq > 0 ? (vcu >= nq ? vcu - nq : -1) : vcu};
            typedef pg8::EpiWrap<EpU<EpF32>, false> E_;
            pg8::gemm_phase<E_, SchedCmp, false, false>(F.lds, 1024, S, E_{{{(float*)(F.wsp() + WS_TB), 512}}});
        }
    } SEAM(10);
    if (IN(11)) {
#pragma unroll 1
        for (int rep = 0; rep < REP11; ++rep) { p_cmp_finish(F); if (rep + 1 < REP11) xcd_barrier(bar); } } SEAM(11);
#if ATTN_FUSED
    if (IN(12)) {
#pragma unroll 1
        for (int rep = 0; rep < DRY12; ++rep) { p_attn_fused<true, ATV>(F); xcd_barrier(bar); }
        p_attn_fused<false, 0>(F); } SEAM(12);
#else
    if (IN(12)) { p_attn_cmp(F); } SEAM(12);
    if (IN(13)) { p_attn_main(F); } SEAM(13);
#endif
    if (IN(14)) {
        const pg8::SchedDense S{(const char*)(F.wsp() + WS_O), (const char*)(F.wsp() + WS_WO), nullptr, nullptr, T / 256, 4, 0, DM, (int)gridDim.x, (int)blockIdx.x, 256};
        typedef pg8::EpiWrap<EpU<EpBf16>, false, true> E_;
        pg8::gemm_phase<E_, pg8::SchedDense, false, false>(F.lds, DM, S, E_{{{(bf16*)(F.wsp() + WS_Y0), DM}}});
    } SEAM(14);
    if (IN(15)) { p_ln_router<1>(F); } SEAM(15);
    if (IN(16)) { p_moe<1>(F, bar, true); } SEAM(16);
    if (IN(18)) { p_ln2<1>(F); }
#undef IN
#undef SEAM
}

extern "C" void kernel_launch(void* const* d_in, const int* in_sizes, int n_in, void* d_out, int out_size, void* d_ws, size_t ws_size, hipStream_t stream) {
    static int grid = 0;
    if (grid == 0) {
        if (n_in != 23 || out_size != T * DM || ws_size < WS_END) { fprintf(stderr, "kernel_launch: unexpected shapes (n_in %d out %d ws %zu, need ws >= %zu)\n", n_in, out_size, ws_size, (size_t)WS_END); grid = -1; return; }
        int dev = 0, cus = 0, per_cu = 0;
        if (hipGetDevice(&dev) != hipSuccess || hipDeviceGetAttribute(&cus, hipDeviceAttributeMultiprocessorCount, dev) != hipSuccess) { grid = -1; return; }
        if (hipFuncSetAttribute((const void*)mk_fwd, hipFuncAttributeMaxDynamicSharedMemorySize, LDS_BYTES) != hipSuccess) { fprintf(stderr, "kernel_launch: hipFuncSetAttribute failed\n"); grid = -1; return; }
        if (hipOccupancyMaxActiveBlocksPerMultiprocessor(&per_cu, (const void*)mk_fwd, 512, LDS_BYTES) != hipSuccess || per_cu < 1) { fprintf(stderr, "kernel_launch: occupancy query says %d\n", per_cu); per_cu = 1; }
        (void)hipGetLastError();
        grid = cus;
    }
    if (grid < 0) return;
    (void)hipMemsetAsync((char*)d_ws + WS_CTL, 0, CTL_ZERO_BYTES, stream);
    Args a{};
    for (int i = 0; i < 23; ++i) a.in[i] = (const float*)d_in[i];
    a.out = (float*)d_out; a.ws = (unsigned char*)d_ws;
    if (MK_N_LAUNCHES == 1) { a.ph_lo = 0; a.ph_hi = NPH; hipLaunchKernelGGL(mk_fwd, dim3(grid), dim3(512), LDS_BYTES, stream, a); }
    else for (int p = 0; p < NPH; ++p) { a.ph_lo = p; a.ph_hi = p + 1; hipLaunchKernelGGL(mk_fwd, dim3(grid), dim3(512), LDS_BYTES, stream, a); }
}
```

```cpp
#include <hip/hip_runtime.h>
#include <cstdio>
#include <cstdint>

#ifndef REP0
#define REP0 1
#endif
#ifndef REP1
#define REP1 1
#endif
#ifndef REP11
#define REP11 1
#endif
#ifndef XBAR
#define XBAR 1
#endif
#ifndef DRY5
#define DRY5 0
#endif
#ifndef DRY8
#define DRY8 0
#endif
#ifndef REP4
#define REP4 1
#endif
#ifndef REP2
#define REP2 1
#endif
#ifndef REP3
#define REP3 1
#endif
#ifndef REP6
#define REP6 1
#endif
#ifndef REP7
#define REP7 1
#endif
#ifndef REP9
#define REP9 1
#endif
#ifndef REP10
#define REP10 1
#endif
#ifndef REP12
#define REP12 1
#endif
#ifndef REP1213
#define REP1213 1
#endif
#ifndef ATV
#define ATV 0
#endif
#ifndef DRY2
#define DRY2 0
#endif
#ifndef DRY12
#define DRY12 0
#endif
#ifndef ATTN_FUSED
#define ATTN_FUSED 1
#endif
#ifndef MK_N_LAUNCHES
#define MK_N_LAUNCHES 1
#endif

#define GAS __attribute__((address_space(1)))
#define LAS __attribute__((address_space(3)))
typedef unsigned short bf16;
typedef short bf16x8 __attribute__((ext_vector_type(8)));
typedef float f32x4 __attribute__((ext_vector_type(4)));
typedef unsigned u32x4 __attribute__((ext_vector_type(4)));
typedef unsigned u32x2 __attribute__((ext_vector_type(2)));
typedef GAS unsigned gu32;
#define RLX_AGENT __ATOMIC_RELAXED, __HIP_MEMORY_SCOPE_AGENT

constexpr int NB = 4, SEQ = 4096, DM = 1024, T = NB * SEQ, NH = 16, HKV = 4, HD = 64, NE = 16, FF = 512;
constexpr int NPH = 19;
constexpr float ALPHA = 1.4142135623730951f;
constexpr float LN_EPS = 1e-5f;
constexpr float C2 = 0.125f * 1.4426950408889634f;
constexpr int KVROWS = SEQ + 128;
constexpr int HROWS = 2 * T + NE * 256;

constexpr size_t MiB = 1u << 20;
constexpr size_t WS_CTL = 0, CTL_ZERO_BYTES = 1 * MiB;
constexpr size_t WS_MODP = 290 * MiB;
constexpr size_t WS_MOD = 3 * MiB;
constexpr size_t WS_PETP = 3 * MiB + 512 * 1024;
constexpr size_t WS_LIST = 4 * MiB;
constexpr size_t WS_LW = 6 * MiB;
constexpr size_t WS_WIN = 8 * MiB, WS_WOUT = 14 * MiB, WS_WKV = 16 * MiB, WS_WQG = 19 * MiB, WS_WO = 22 * MiB, WS_W1C = 24 * MiB;
constexpr size_t WS_WGU = 26 * MiB, WS_WDN = 90 * MiB;
constexpr size_t WS_U = 122 * MiB, WS_XB = 154 * MiB, WS_H = 186 * MiB, WS_Y0 = 226 * MiB, WS_Y1 = 258 * MiB;
constexpr size_t WS_R1 = 290 * MiB;
constexpr size_t WS_BG = WS_R1, WS_Z = WS_R1 + 32 * MiB, WS_A2 = WS_R1 + 64 * MiB;
constexpr size_t WS_Q = WS_R1, WS_O = WS_R1 + 32 * MiB, WS_KV = WS_R1 + 64 * MiB;
constexpr size_t KVBUF_ELEMS = (size_t)16 * KVROWS * 64;
constexpr size_t WS_TB = WS_R1 + 114 * MiB, WS_KC = WS_R1 + 130 * MiB, WS_VC = WS_KC + 512 * 1024, WS_GATE = WS_R1 + 131 * MiB;
constexpr size_t WS_END = WS_R1 + 135 * MiB;
static_assert(WS_Y1 == WS_Y0 + (size_t)T * DM * 2, "Y1 follows Y0");
static_assert(WS_KV + 6 * KVBUF_ELEMS * 2 <= WS_TB, "kv buffers");
static_assert((size_t)HROWS * FF * 2 <= 40 * MiB, "H buffer");
constexpr int CW_CNT = 1024;
constexpr int CW_BAR = 4096;

constexpr int RING_BYTES = 131072;
constexpr int LDSCTL_OFF = 143360, MISC_OFF = LDSCTL_OFF + 320;
constexpr int LDS_BYTES = 147456;

#define LDS_WAIT() asm volatile("s_waitcnt lgkmcnt(0)" ::: "memory")
__device__ __forceinline__ unsigned f2bf(float f) { unsigned u = __builtin_bit_cast(unsigned, f); return (u + 0x7fffu + ((u >> 16) & 1u)) >> 16; }
typedef float f32x2v __attribute__((ext_vector_type(2)));
typedef __bf16 bf16x2_t __attribute__((ext_vector_type(2)));
__device__ __forceinline__ unsigned pk2(float lo, float hi) { f32x2v v = {lo, hi}; bf16x2_t b = __builtin_convertvector(v, bf16x2_t); return __builtin_bit_cast(unsigned, b); }
__device__ __forceinline__ float bf2f(unsigned short h) { return __builtin_bit_cast(float, (unsigned)h << 16); }
__device__ __forceinline__ float bflo(unsigned w) { return __builtin_bit_cast(float, w << 16); }
__device__ __forceinline__ float bfhi(unsigned w) { return __builtin_bit_cast(float, w & 0xffff0000u); }
__device__ __forceinline__ float wave_sum(float v) {
#pragma unroll
    for (int o = 1; o < 64; o <<= 1) v += __shfl_xor(v, o);
    return v;
}
__device__ __forceinline__ float wave_max(float v) {
#pragma unroll
    for (int o = 1; o < 64; o <<= 1) v = fmaxf(v, __shfl_xor(v, o));
    return v;
}
__device__ __forceinline__ float silu_f(float a) { return a * __builtin_amdgcn_rcpf(1.f + __builtin_amdgcn_exp2f(-1.4426950408889634f * a)); }
__device__ __forceinline__ void st_bf4(bf16* p, f32x4 v) { u32x2 w; w.x = pk2(v[0], v[1]); w.y = pk2(v[2], v[3]); *(u32x2*)p = w; }
__device__ __forceinline__ void st_bf8(bf16* p, f32x4 a, f32x4 b) { u32x4 w; w.x = pk2(a[0], a[1]); w.y = pk2(a[2], a[3]); w.z = pk2(b[0], b[1]); w.w = pk2(b[2], b[3]); *(u32x4*)p = w; }

#define XB_TMO      128
#define XB_XCNT(j)  (256  + 64 * (j))
#define XB_XSUB(j)  (1280 + 64 * (j))
#define XB_XGEN(j)  (2304 + 64 * (j))
#define XB_TOP      3328
#define XB_TOPGEN   3392
#define XCD_BAR_WORDS 3456
#define XB_SPIN_CAP (1u << 22)
__device__ __forceinline__ unsigned xb_ld(unsigned* p)              { return __hip_atomic_load(p, __ATOMIC_RELAXED, __HIP_MEMORY_SCOPE_AGENT); }
__device__ __forceinline__ unsigned xb_add(unsigned* p, unsigned v) { return __hip_atomic_fetch_add(p, v, __ATOMIC_RELAXED, __HIP_MEMORY_SCOPE_AGENT); }
__device__ __forceinline__ unsigned xb_xcc_id() { return (unsigned)__builtin_amdgcn_s_getreg((3 << 11) | 20) & 0xFu; }
#define XB_SPIN(cond, bar) do { unsigned _sp = 0; while (cond) { __builtin_amdgcn_s_sleep(1); \
    if ((++_sp & 255u) == 0u) { if (xb_ld(&(bar)[XB_TMO])) break; if (_sp > XB_SPIN_CAP) { atomicAdd(&(bar)[XB_TMO], 1u); break; } } } } while (0)
struct XcdBarrier { unsigned* bar; unsigned x; volatile LAS unsigned* st; };
__device__ __forceinline__ XcdBarrier xcd_barrier_post(unsigned* bar, volatile LAS unsigned* st) {
    XcdBarrier b; b.bar = bar; b.x = xb_xcc_id(); b.st = st;
    if (threadIdx.x == 0) (void)xb_add(&bar[XB_XCNT(b.x)], 1u);
    return b;
}
__device__ __forceinline__ void xcd_barrier_complete(unsigned* bar, unsigned x, unsigned& nloc, unsigned& nx) {
    const unsigned G = gridDim.x * gridDim.y * gridDim.z;
    unsigned sum, cnt, mine, sp = 0u;
    for (;;) {
        sum = 0u; cnt = 0u; mine = 0u;
#pragma unroll
        for (unsigned j = 0; j < 16; ++j) { const unsigned c = xb_ld(&bar[XB_XCNT(j)]); sum += c; cnt += (c > 0u) ? 1u : 0u; mine = (j == x) ? c : mine; }
        if (sum == G) break;
        __builtin_amdgcn_s_sleep(1);
        if ((++sp & 255u) == 0u) { if (xb_ld(&bar[XB_TMO])) break; if (sp > XB_SPIN_CAP) { atomicAdd(&bar[XB_TMO], 1u); break; } }
    }
    nloc = mine > 0u ? mine : 1u; nx = cnt > 0u ? cnt : 1u;
}
__device__ __forceinline__ void xcd_barrier(const XcdBarrier& b) {
    asm volatile("s_waitcnt vmcnt(0)" ::: "memory");
    __syncthreads();
    if (threadIdx.x == 0) {
        unsigned* bar = b.bar;
        __builtin_amdgcn_s_waitcnt(0);
        unsigned nloc = b.st[0], nx = b.st[1];
        if (nloc == 0u) { xcd_barrier_complete(bar, b.x, nloc, nx); b.st[0] = nloc; b.st[1] = nx; }
        const unsigned old = xb_add(&bar[XB_XSUB(b.x)], 1u);
        const unsigned gen = old / nloc;
        if (old + 1u == (gen + 1u) * nloc) {
            __builtin_amdgcn_fence(__ATOMIC_RELEASE, "agent");
            asm volatile("s_waitcnt vmcnt(0)" ::: "memory");
            const unsigned og = xb_add(&bar[XB_TOP], 1u);
            const unsigned tg = og / nx;
            if (og + 1u == (tg + 1u) * nx) xb_add(&bar[XB_TOPGEN], 1u);
            else XB_SPIN(xb_ld(&bar[XB_TOPGEN]) == tg, bar);
            __builtin_amdgcn_fence(__ATOMIC_ACQUIRE, "agent");
            xb_add(&bar[XB_XGEN(b.x)], 1u);
            asm volatile("s_waitcnt vmcnt(0)" ::: "memory");
        } else {
            XB_SPIN(xb_ld(&bar[XB_XGEN(b.x)]) == gen, bar);
            __builtin_amdgcn_fence(__ATOMIC_ACQUIRE, "agent");
            asm volatile("s_waitcnt vmcnt(0)" ::: "memory");
        }
    }
    __syncthreads();
}

constexpr int PTR_OFF = MISC_OFF + 512;
struct Frame {
    LAS unsigned char* lds;
    volatile LAS unsigned* MISC;
    int tid, lane, wave, gw, NGW;
    __device__ __forceinline__ unsigned long long ptr(int i) const { const LAS unsigned* p = (const LAS unsigned*)(lds + PTR_OFF) + 2 * i;
        const unsigned lo = __builtin_amdgcn_readfirstlane(p[0]), hi = __builtin_amdgcn_readfirstlane(p[1]); return ((unsigned long long)hi << 32) | lo; }
    __device__ __forceinline__ const float* inp(int i) const { return (const float*)(const GAS float*)ptr(i); }
    __device__ __forceinline__ float* outp() const { return (float*)(GAS float*)ptr(23); }
    __device__ __forceinline__ unsigned char* wsp() const { return (unsigned char*)(GAS unsigned char*)ptr(24); }
    __device__ __forceinline__ gu32* ctlp() const { return (gu32*)(wsp() + WS_CTL); }
};
enum { I_X = 0, I_C, I_ADAW, I_ADAB, I_LNG, I_LNB, I_CWIN, I_CONVW, I_CONVB, I_CWOUT, I_WKV, I_PE, I_CW1, I_CB1, I_CW2, I_CB2, I_WQG, I_BG, I_WO, I_RW, I_RB, I_WGU, I_WDN };

__device__ __forceinline__ void transpose_item(const float* W, int ld, int nvalid, int K, bf16* WT, int dstrow0, int k0, int n0, LAS float* scr, int lane) {
    const int n = n0 + (lane & 31);
#pragma unroll 8
    for (int i = 0; i < 32; ++i) { const int kk = 2 * i + (lane >> 5); scr[kk * 33 + (lane & 31)] = (n < nvalid) ? W[(size_t)(k0 + kk) * ld + n] : 0.f; }
    LDS_WAIT(); asm volatile("" ::: "memory");
    const int c = lane & 7;
#pragma unroll
    for (int j = 0; j < 4; ++j) { const int nl = (lane >> 3) + 8 * j; const LAS float* s = scr + (8 * c) * 33 + nl;
        u32x4 o; o.x = pk2(s[0 * 33], s[1 * 33]); o.y = pk2(s[2 * 33], s[3 * 33]); o.z = pk2(s[4 * 33], s[5 * 33]); o.w = pk2(s[6 * 33], s[7 * 33]);
        *(u32x4*)(WT + (size_t)(dstrow0 + nl) * K + k0 + 8 * c) = o; }
    LDS_WAIT(); asm volatile("" ::: "memory");
}
__device__ __forceinline__ int pairmap(int n0, int half) {
    return n0 < half ? ((n0 >> 7) * 256 + (n0 & 127)) : ((((n0 - half) >> 7) * 256) + 128 + ((n0 - half) & 127));
}
__device__ __forceinline__ void p0_prologue(Frame& F) {
    LAS float* scr = (LAS float*)(F.lds + F.wave * 16384);
    const int lane = F.lane;
    for (int r = F.gw; r < 768 + 256; r += F.NGW) {
        if (r < 768) {
            const int l = r / 384, rem = r % 384, dch = rem / 24, e = (rem % 24) * 256 + 4 * lane;
            const float* aw = F.inp(I_ADAW) + (size_t)l * 1024 * 6144 + e; const float* c = F.inp(I_C);
            f32x4 a0 = (f32x4){0.f, 0.f, 0.f, 0.f}, a1 = a0, a2 = a0, a3 = a0;
#pragma unroll 16
            for (int d = dch * 64; d < dch * 64 + 64; ++d) {
                const f32x4 w = *(const f32x4*)(aw + (size_t)d * 6144);
                const float c0 = c[d], c1 = c[1024 + d], c2 = c[2048 + d], c3 = c[3072 + d];
                a0 += w * (c0 / (1.f + __expf(-c0))); a1 += w * (c1 / (1.f + __expf(-c1))); a2 += w * (c2 / (1.f + __expf(-c2))); a3 += w * (c3 / (1.f + __expf(-c3)));
            }
            float* mp = (float*)(F.wsp() + WS_MODP) + (size_t)dch * 49152 + (size_t)(l * 4) * 6144 + e;
            *(f32x4*)mp = a0; *(f32x4*)(mp + 6144) = a1; *(f32x4*)(mp + 2 * 6144) = a2; *(f32x4*)(mp + 3 * 6144) = a3;
        } else {
            const int q = r - 768, i = q / 128, rem = q % 128, cch = rem / 32, kch = rem % 32, c = cch * 64 + lane;
            const float* pe = F.inp(I_PE) + i * 2048; const float* w1 = F.inp(I_CW1) + (size_t)i * 2048 * 256 + c;
            float a = 0.f;
#pragma unroll 16
            for (int kk = kch * 64; kk < kch * 64 + 64; ++kk) a += pe[kk] * w1[(size_t)kk * 256];
            ((float*)(F.wsp() + WS_PETP))[(kch * 2 + i) * 256 + c] = a;
        }
    }
    constexpr int I1 = 16 * 96, I2 = 512, I3 = 16 * 48, I4 = 16 * 40, I5 = 512, I6 = 512, I7 = 32 * 512, I8 = 32 * 256;
    constexpr int NITEMS = I1 + I2 + I3 + I4 + I5 + I6 + I7 + I8;
    for (int it = F.gw; it < NITEMS; it += F.NGW) {
        int r = it;
        if (r < I1) { const int kb = r / 96, nb = r % 96, n0 = nb * 32;
            const int dr = n0 < 1024 ? n0 : 1024 + pairmap(n0 - 1024, 1024);
            transpose_item(F.inp(I_CWIN), 3072, 3072, 1024, (bf16*)(F.wsp() + WS_WIN), dr, kb * 64, n0, scr, lane); continue; } r -= I1;
        if (r < I2) { transpose_item(F.inp(I_CWOUT), 1024, 1024, 1024, (bf16*)(F.wsp() + WS_WOUT), (r % 32) * 32, (r / 32) * 64, (r % 32) * 32, scr, lane); continue; } r -= I2;
        if (r < I3) { transpose_item(F.inp(I_WKV), 1536, 1536, 1024, (bf16*)(F.wsp() + WS_WKV), (r % 48) * 32, (r / 48) * 64, (r % 48) * 32, scr, lane); continue; } r -= I3;
        if (r < I4) { transpose_item(F.inp(I_WQG), 1072, 1072, 1024, (bf16*)(F.wsp() + WS_WQG), (r % 40) * 32, (r / 40) * 64, (r % 40) * 32, scr, lane); continue; } r -= I4;
        if (r < I5) { transpose_item(F.inp(I_WO), 1024, 1024, 1024, (bf16*)(F.wsp() + WS_WO), (r % 32) * 32, (r / 32) * 64, (r % 32) * 32, scr, lane); continue; } r -= I5;
        if (r < I6) { const int sub = r / 128, q = r % 128, i = sub >> 1, hh = sub & 1;
            transpose_item(F.inp(I_CW1) + (size_t)i * 2048 * 256 + (size_t)hh * 1024 * 256, 256, 256, 1024, (bf16*)(F.wsp() + WS_W1C) + (size_t)i * 512 * 1024, hh * 256 + (q % 8) * 32, (q / 8) * 64, (q % 8) * 32, scr, lane); continue; } r -= I6;
        if (r < I7) { const int mi = r / 512, q = r % 512, n0 = (q % 32) * 32;
            transpose_item(F.inp(I_WGU) + (size_t)mi * 1024 * 1024, 1024, 1024, 1024, (bf16*)(F.wsp() + WS_WGU) + (size_t)mi * 1024 * 1024, pairmap(n0, 512), (q / 32) * 64, n0, scr, lane); continue; } r -= I7;
        { const int mi = r / 256, q = r % 256, n0 = (q % 32) * 32;
            transpose_item(F.inp(I_WDN) + (size_t)mi * 512 * 1024, 1024, 1024, 512, (bf16*)(F.wsp() + WS_WDN) + (size_t)mi * 1024 * 512, n0, (q / 32) * 64, n0, scr, lane); }
    }
}
__device__ __forceinline__ f32x4 mod4_partials(const Frame& F, int l, int b, int e) {
    f32x4 s = *(const f32x4*)(F.inp(I_ADAB) + l * 6144 + e);
    const float* mp = (const float*)(F.wsp() + WS_MODP) + (size_t)(l * 4 + b) * 6144 + e;
#pragma unroll
    for (int d = 0; d < 16; ++d) s += *(const f32x4*)(mp + (size_t)d * 49152);
    return s;
}
__device__ __forceinline__ void p1_mod_u0(Frame& F) {
    float* MOD = (float*)(F.wsp() + WS_MOD);
    for (int ch = F.gw; ch < 768; ch += F.NGW) {
        const int idx = ch * 64 + F.lane, lb = idx / 6144, e = idx % 6144;
        float s = F.inp(I_ADAB)[(lb >> 2) * 6144 + e];
        const float* mp = (const float*)(F.wsp() + WS_MODP) + idx;
#pragma unroll
        for (int d = 0; d < 16; ++d) s += mp[(size_t)d * 49152];
        MOD[idx] = s;
    }
    for (int q = F.gw; q < 2; q += F.NGW) { const int i = q, c = 4 * F.lane;
        f32x4 pe = *(const f32x4*)(F.inp(I_CB1) + i * 256 + c); const float* PETP = (const float*)(F.wsp() + WS_PETP);
#pragma unroll
        for (int k = 0; k < 32; ++k) pe += *(const f32x4*)(PETP + (k * 2 + i) * 256 + c);
        *(f32x4*)((float*)(F.wsp() + WS_PETP) + 64 * 256 + i * 256 + c) = pe; }
    bf16* U = (bf16*)(F.wsp() + WS_U);
    LAS f32x4* msh = (LAS f32x4*)F.lds;
    for (int c0 = blockIdx.x * 64; c0 < T; c0 += gridDim.x * 64) {
        const int b = c0 >> 12;
        __syncthreads();
        { const int t = F.tid, e = 4 * (t & 255) + (t >> 8) * 1024; f32x4 v = mod4_partials(F, 0, b, e); if (t >= 256) v = v + 1.0f; msh[t] = v; }
        __syncthreads();
        f32x4 sh[4], sc[4];
#pragma unroll
        for (int j = 0; j < 4; ++j) { sh[j] = msh[F.lane + 64 * j]; sc[j] = msh[256 + F.lane + 64 * j]; }
        const int m0 = c0 + F.wave * 8;
#pragma unroll 1
        for (int m = m0; m < m0 + 8; m += 2) {
            f32x4 v[2][4];
#pragma unroll
            for (int r = 0; r < 2; ++r)
#pragma unroll
                for (int j = 0; j < 4; ++j) v[r][j] = *(const f32x4*)(F.inp(I_X) + (size_t)(m + r) * DM + 4 * F.lane + 256 * j);
#pragma unroll
            for (int r = 0; r < 2; ++r)
#pragma unroll
                for (int j = 0; j < 4; ++j) st_bf4(U + (size_t)(m + r) * DM + 4 * F.lane + 256 * j, v[r][j] * sc[j] + sh[j]);
        }
    }
}
template <bool PAIR, class AR, class EP>
__device__ __forceinline__ void gemm_wave_tile(const AR& arow, const bf16* Btile, int K, int m0, int nbase, const EP& ep, int lane) {
    const int fr = lane & 15, fq = lane >> 4;
    f32x4 acc[4][4];
#pragma unroll
    for (int i = 0; i < 4; ++i)
#pragma unroll
        for (int j = 0; j < 4; ++j) acc[i][j] = (f32x4){0.f, 0.f, 0.f, 0.f};
    const bf16* ap[4]; const bf16* bp[4];
#pragma unroll
    for (int i = 0; i < 4; ++i) ap[i] = arow(m0 + 16 * i + fr) + 8 * fq;
#pragma unroll
    for (int j = 0; j < 4; ++j) { const int nr = PAIR ? ((j & 1) * 16 + (j >> 1) * 128) : 16 * j; bp[j] = Btile + (size_t)(nr + fr) * K + 8 * fq; }
    for (int k0 = 0; k0 < K; k0 += 32) {
        bf16x8 a[4], b[4];
#pragma unroll
        for (int i = 0; i < 4; ++i) a[i] = *(const bf16x8*)(ap[i] + k0);
#pragma unroll
        for (int j = 0; j < 4; ++j) b[j] = *(const bf16x8*)(bp[j] + k0);
#pragma unroll
        for (int i = 0; i < 4; ++i)
#pragma unroll
            for (int j = 0; j < 4; ++j) acc[i][j] = __builtin_amdgcn_mfma_f32_16x16x32_bf16(b[j], a[i], acc[i][j], 0, 0, 0);
    }
#pragma unroll
    for (int i = 0; i < 4; ++i) {
        const int m = m0 + 16 * i + fr;
        if constexpr (PAIR) {
#pragma unroll
            for (int j = 0; j < 2; ++j) ep.pair(m, nbase + 16 * j + 4 * fq, acc[i][j], acc[i][j + 2]);
        } else {
#pragma unroll
            for (int j = 0; j < 4; ++j) ep(m, nbase + 16 * j + 4 * fq, acc[i][j]);
        }
    }
}
struct ARowPlain { const bf16* A; int K; __device__ __forceinline__ const bf16* operator()(int m) const { return A + (size_t)m * K; } };

struct EpBf16 { bf16* O; int ld; __device__ __forceinline__ void operator()(int m, int n, f32x4 v) const { st_bf4(O + (size_t)m * ld + n, v); }
    __device__ __forceinline__ void op8(int m, int n, f32x4 a, f32x4 b) const { st_bf8(O + (size_t)m * ld + n, a, b); } };
struct EpMulPair { bf16* O; int ld; __device__ __forceinline__ void pair(int m, int ch, f32x4 a, f32x4 b) const { st_bf4(O + (size_t)m * ld + ch, a * b); }
    __device__ __forceinline__ void pair8(int m, int ch, f32x4 a0, f32x4 a1, f32x4 b0, f32x4 b1) const { st_bf8(O + (size_t)m * ld + ch, a0 * b0, a1 * b1); } };
struct EpSiluPair { bf16* O; int ld; __device__ __forceinline__ void pair(int m, int ch, f32x4 a, f32x4 b) const {
    f32x4 s; for (int r = 0; r < 4; ++r) s[r] = silu_f(a[r]) * b[r]; st_bf4(O + (size_t)m * ld + ch, s); } };
__device__ __forceinline__ f32x4 ld_bf4(const bf16* p) { const u32x2 w = *(const u32x2*)p; return (f32x4){bflo(w.x), bfhi(w.x), bflo(w.y), bfhi(w.y)}; }
struct EpRes { const float* base; bf16* out; const float* gmod;
    __device__ __forceinline__ void operator()(int m, int n, f32x4 v) const { const int b = m >> 12; const f32x4 g = *(const f32x4*)(gmod + b * 6144 + n);
        const f32x4 x = *(const f32x4*)(base + (size_t)m * DM + n); st_bf4(out + (size_t)m * DM + n, x * ALPHA + g * v); } };
struct EpResB { bf16* res; const float* gmod;
    __device__ __forceinline__ void operator()(int m, int n, f32x4 v) const { const int b = m >> 12; const f32x4 g = *(const f32x4*)(gmod + b * 6144 + n);
        bf16* p = res + (size_t)m * DM + n; st_bf4(p, ld_bf4(p) * ALPHA + g * v); } };
__device__ __forceinline__ int kfrag_off(int kk, int d) { return ((((kk >> 5) * 4 + (d >> 4)) * 2 + ((d >> 3) & 1)) * 32 + (kk & 31)) * 8 + (d & 7); }
__device__ __forceinline__ int vfrag_off(int kk, int d) { return ((((d >> 5) * 4 + (kk >> 4)) * 2 + ((kk >> 2) & 1)) * 32 + (d & 31)) * 8 + ((((kk >> 3) & 1) << 2) | (kk & 3)); }
struct EpKV { bf16* KV; __device__ __forceinline__ void operator()(int m, int n, f32x4 v) const {
    const int j = n >> 8, hk = (n >> 6) & 3, d = n & 63, b = m >> 12, t = m & 4095;
    bf16* base = KV + (size_t)j * KVBUF_ELEMS + (size_t)(b * 4 + hk) * KVROWS * 64;
    if (j < 2) st_bf4(base + (size_t)t * 64 + d, v);
    else if ((j & 1) == 0) st_bf4(base + (size_t)(t >> 6) * 4096 + kfrag_off(t & 63, d), v);
    else { bf16* tp = base + (size_t)(t >> 6) * 4096;
        for (int r = 0; r < 4; ++r) tp[vfrag_off(t & 63, d + r)] = (bf16)f2bf(v[r]); } }
    __device__ __forceinline__ void op8(int m, int n, f32x4 a, f32x4 c) const {
    const int j = n >> 8, hk = (n >> 6) & 3, d = n & 63, b = m >> 12, t = m & 4095;
    bf16* base = KV + (size_t)j * KVBUF_ELEMS + (size_t)(b * 4 + hk) * KVROWS * 64;
    if (j < 2) st_bf8(base + (size_t)t * 64 + d, a, c);
    else if ((j & 1) == 0) st_bf8(base + (size_t)(t >> 6) * 4096 + kfrag_off(t & 63, d), a, c);
    else { bf16* tp = base + (size_t)(t >> 6) * 4096;
        for (int r = 0; r < 4; ++r) { tp[vfrag_off(t & 63, d + r)] = (bf16)f2bf(a[r]); tp[vfrag_off(t & 63, d + 4 + r)] = (bf16)f2bf(c[r]); } } } };
struct EpQG { bf16* Q; float* GATE; const float* bg; __device__ __forceinline__ void operator()(int m, int n, f32x4 v) const {
    if (n < 1024) st_bf4(Q + (size_t)m * DM + n, v * C2);
    else { for (int r = 0; r < 4; ++r) { const int i = n - 1024 + r; if (i < 48) GATE[(size_t)m * 48 + i] = 1.f / (1.f + __expf(-(v[r] + bg[i]))); } } }
    __device__ __forceinline__ void op8(int m, int n, f32x4 a, f32x4 c) const {
    if (n < 1024) st_bf8(Q + (size_t)m * DM + n, a * C2, c * C2);
    else { (*this)(m, n, a); (*this)(m, n + 4, c); } } };
struct EpF32 { float* O; int ld; __device__ __forceinline__ void operator()(int m, int n, f32x4 v) const { *(f32x4*)(O + (size_t)m * ld + n) = v; } };

template <bool PAIR, class AR, class EP>
__device__ __forceinline__ void gemm_dense(Frame& F, const AR& arow, const bf16* Bt, int K, int nM64, int nN64, int chbase, const EP& ep) {
    const int total = nM64 * nN64;
    for (int it = F.gw; it < total; it += F.NGW) {
        const int ni = it % nN64, mt = it / nN64;
        if constexpr (PAIR) { const int pn = ni >> 2, q = ni & 3;
            gemm_wave_tile<true>(arow, Bt + (size_t)(pn * 256 + q * 32) * K, K, mt * 64, chbase + pn * 128 + q * 32, ep, F.lane);
        } else gemm_wave_tile<false>(arow, Bt + (size_t)(ni * 64) * K, K, mt * 64, chbase + ni * 64, ep, F.lane);
    }
}

namespace pg8 {
#define PG8_LAS __attribute__((address_space(3)))
constexpr int BM = 256, BK = 64, HALF = 128, HTB = HALF * BK * 2, STAGE_BYTES = 8 * HTB, NXCD = 8, WGM = 8;
__device__ __forceinline__ int lds_byte(int r, int c) { const int st = (r >> 4) * 2 + (c >> 5), rr = r & 15, cc = c & 31, ob = rr * 64 + cc * 2; return st * 1024 + (ob ^ (((ob >> 9) & 1) << 5)); }
__device__ __forceinline__ void stage_rc(int b, int& R, int& C) { const int st = b / 1024, sb = b % 1024, swz = sb ^ (((sb >> 9) & 1) << 5); R = (st >> 1) * 16 + swz / 64; C = (st & 1) * 32 + (swz % 64) / 2; }
struct Unit { const char* A; const char* B; int row0, col0, e, pos0, cnt; };
__device__ __forceinline__ bool static_order(int i, int G, int c, int nM, int nN, int& pm, int& pn) {
    const int nwg = nM * nN; const long L = (long)i * G + c; if (L >= nwg) return false;
    int wgid = (int)L; { const int q = nwg / NXCD, r = nwg % NXCD, xcd = wgid % NXCD, off = wgid / NXCD; wgid = (xcd < r ? xcd * (q + 1) : r * (q + 1) + (xcd - r) * q) + off; }
    const int nig = WGM * nN, gid = wgid / nig, fm = gid * WGM, gsz = (nM - fm) < WGM ? (nM - fm) : WGM;
    pm = fm + ((wgid % nig) % gsz); pn = (wgid % nig) / gsz; return true;
}
__device__ __forceinline__ void voff_plain(const int (&R)[2], const int (&C)[2], int K, unsigned (&v)[2][2]) {
#pragma unroll
    for (int h = 0; h < 2; ++h)
#pragma unroll
        for (int i = 0; i < 2; ++i) v[h][i] = (unsigned)((h * HALF + R[i]) * K + C[i]) * 2u;
}
__device__ __forceinline__ int perm32(int rho) { const int n = rho >> 4, i = rho & 15; return 8 * (i >> 2) + 4 * n + (i & 3); }
template <class EP, bool PAIR, bool PERM_ = false> struct EpiWrap {
    static constexpr bool PERM = PERM_;
    EP ep;
    __device__ __forceinline__ void operator()(const f32x4 (&acc)[2][2][4][2], const Unit& u, int wr, int wc, int fr, int fq) const {
#pragma unroll
        for (int ai = 0; ai < 2; ++ai)
#pragma unroll
            for (int m = 0; m < 4; ++m) { const int row = u.row0 + ai * HALF + wr * 64 + m * 16 + fr;
                if constexpr (PERM_) {
                    if constexpr (PAIR) ep.pair8(u, row, u.col0 + wc * 32 + 8 * fq, acc[ai][0][m][0], acc[ai][0][m][1], acc[ai][1][m][0], acc[ai][1][m][1]);
                    else {
#pragma unroll
                        for (int bj = 0; bj < 2; ++bj) ep.op8(u, row, u.col0 + bj * HALF + wc * 32 + 8 * fq, acc[ai][bj][m][0], acc[ai][bj][m][1]); }
                } else if constexpr (PAIR) {
#pragma unroll
                    for (int n = 0; n < 2; ++n) ep.pair(u, row, u.col0 + wc * 32 + 16 * n + 4 * fq, acc[ai][0][m][n], acc[ai][1][m][n]);
                } else {
#pragma unroll
                    for (int bj = 0; bj < 2; ++bj)
#pragma unroll
                        for (int n = 0; n < 2; ++n) ep(u, row, u.col0 + bj * HALF + wc * 32 + 16 * n + 4 * fq, acc[ai][bj][m][n]);
                } }
    }
};
template <class Epi, class Sched, bool ALIGN_EPI, bool GATHER>
__device__ __forceinline__ void gemm_phase(PG8_LAS unsigned char* lds, const int K, const Sched& S, const Epi& E) {
    const int tid = threadIdx.x, wid = __builtin_amdgcn_readfirstlane(tid >> 6), lane = tid & 63, wr = wid >> 2, wc = wid & 3, fr = lane & 15, fq = lane >> 4;
    const int nt = K / BK;
    int R[2], C[2]; unsigned voffB[2]; unsigned vC[2][2], vN[2][2];
#pragma unroll
    for (int i = 0; i < 2; ++i) { stage_rc(tid * 16 + i * 8192, R[i], C[i]); const int Rb = Epi::PERM ? ((R[i] & ~31) | perm32(R[i] & 31)) : R[i]; voffB[i] = (unsigned)(Rb * K + C[i]) * 2u; }
    const size_t kstep = (size_t)(BK * 2);
    const size_t hstep = (size_t)HALF * K * 2;
    const unsigned ldsw = (unsigned)wid * 1024u;
    const int aoff = lds_byte(wr * 64 + fr, fq * 8), boff = lds_byte(wc * 32 + fr, fq * 8);
#define PG8_SA(b, h) (((b) * 2 + (h)) * HTB)
#define PG8_SB(b, h) ((4 + (b) * 2 + (h)) * HTB)
#define PG8_STAGE(bufoff, gbase, voff) do { _Pragma("unroll") for (int _i = 0; _i < 2; ++_i) \
        __builtin_amdgcn_global_load_lds((const unsigned*)((const char*)(gbase) + (voff)[_i]), (PG8_LAS unsigned*)(lds + (bufoff) + ldsw + _i * 8192), 16, 0, 0); } while (0)
#define PG8_LDA(dst, b, h) do { _Pragma("unroll") for (int m = 0; m < 4; ++m) _Pragma("unroll") for (int k = 0; k < 2; ++k) dst[m][k] = *(const PG8_LAS bf16x8*)(lds + PG8_SA(b, h) + aoff + m * 2048 + k * 1024); } while (0)
#define PG8_LDB(dst, b, h) do { _Pragma("unroll") for (int n = 0; n < 2; ++n) _Pragma("unroll") for (int k = 0; k < 2; ++k) dst[n][k] = *(const PG8_LAS bf16x8*)(lds + PG8_SB(b, h) + boff + n * 2048 + k * 1024); } while (0)
#define PG8_MMA(ai, bj, At, Bt) do { __builtin_amdgcn_s_setprio(1); _Pragma("unroll") for (int m = 0; m < 4; ++m) _Pragma("unroll") for (int n = 0; n < 2; ++n) _Pragma("unroll") for (int k = 0; k < 2; ++k) \
        acc[ai][bj][m][n] = __builtin_amdgcn_mfma_f32_16x16x32_bf16(Bt[n][k], At[m][k], acc[ai][bj][m][n], 0, 0, 0); __builtin_amdgcn_s_setprio(0); } while (0)
#define PG8_WAIT_V(n) asm volatile("s_waitcnt vmcnt(" #n ")" ::: "memory")
#define PG8_WAIT_L(n) asm volatile("s_waitcnt lgkmcnt(" #n ")" ::: "memory")
#define PG8_BAR __builtin_amdgcn_s_barrier()
#define PG8_SCHED __builtin_amdgcn_sched_barrier(0)
    Unit cur, nxt; int ui = 0;
    if (!S.next(0, cur)) return;
    S.voff(cur, R, C, K, vC);
    f32x4 acc[2][2][4][2];
#pragma unroll
    for (int a = 0; a < 2; ++a)
#pragma unroll
        for (int b = 0; b < 2; ++b)
#pragma unroll
            for (int m = 0; m < 4; ++m)
#pragma unroll
                for (int n = 0; n < 2; ++n) acc[a][b][m][n] = (f32x4){0.f, 0.f, 0.f, 0.f};
    bf16x8 At[4][2], B0[2][2], B1[2][2];
    const char* cA = cur.A; const char* cB = cur.B;
    PG8_STAGE(PG8_SB(0, 0), cB, voffB); PG8_STAGE(PG8_SB(0, 1), cB + hstep, voffB); PG8_STAGE(PG8_SA(0, 0), cA, vC[0]); PG8_STAGE(PG8_SA(0, 1), cA, vC[1]);
    if (wr == 1) PG8_BAR;
    PG8_WAIT_V(2); PG8_BAR;
    PG8_STAGE(PG8_SB(1, 0), cB + kstep, voffB); PG8_STAGE(PG8_SA(1, 0), cA + kstep, vC[0]); PG8_STAGE(PG8_SB(1, 1), cB + hstep + kstep, voffB);
    PG8_WAIT_V(6); PG8_BAR;
    for (;;) {
        const bool has_next = S.next(ui + 1, nxt);
        const char* nA = has_next ? nxt.A : cA; const char* nB = has_next ? nxt.B : cB;
        if constexpr (GATHER) { if (has_next) S.voff(nxt, R, C, K, vN); else { vN[0][0] = vC[0][0]; vN[0][1] = vC[0][1]; vN[1][0] = vC[1][0]; vN[1][1] = vC[1][1]; } }
        for (int t = 0; t < nt; t += 2) {
            const bool last = (t == nt - 2);
            const char* a1 = cA + (size_t)(t + 1) * kstep;
            const char* a2 = last ? nA : cA + (size_t)(t + 2) * kstep; const char* b2 = last ? nB : cB + (size_t)(t + 2) * kstep;
            const char* a3 = a2 + kstep; const char* b3 = b2 + kstep;
            unsigned v2[2][2];
#pragma unroll
            for (int h = 0; h < 2; ++h)
#pragma unroll
                for (int i = 0; i < 2; ++i) v2[h][i] = (GATHER && last) ? vN[h][i] : vC[h][i];
            PG8_LDB(B0, 0, 0); PG8_LDB(B1, 0, 1); PG8_SCHED; PG8_LDA(At, 0, 0); PG8_STAGE(PG8_SA(1, 1), a1, vC[1]);
            PG8_WAIT_V(8); PG8_WAIT_L(0); PG8_BAR; PG8_MMA(0, 0, At, B0); PG8_MMA(0, 1, At, B1); PG8_BAR; PG8_SCHED;
            PG8_LDA(At, 0, 1); PG8_STAGE(PG8_SB(0, 0), b2, voffB); PG8_STAGE(PG8_SB(0, 1), b2 + hstep, voffB); PG8_STAGE(PG8_SA(0, 0), a2, v2[0]);
            PG8_WAIT_V(8); PG8_WAIT_L(0); PG8_BAR; PG8_MMA(1, 0, At, B0); PG8_MMA(1, 1, At, B1); PG8_BAR; PG8_SCHED;
            PG8_LDB(B0, 1, 0); PG8_LDB(B1, 1, 1); PG8_SCHED; PG8_LDA(At, 1, 0); PG8_STAGE(PG8_SA(0, 1), a2, v2[1]);
            PG8_WAIT_V(8); PG8_WAIT_L(0); PG8_BAR; PG8_MMA(0, 0, At, B0); PG8_MMA(0, 1, At, B1); PG8_BAR; PG8_SCHED;
            PG8_LDA(At, 1, 1); PG8_STAGE(PG8_SB(1, 0), b3, voffB); PG8_STAGE(PG8_SB(1, 1), b3 + hstep, voffB); PG8_STAGE(PG8_SA(1, 0), a3, v2[0]);
            PG8_WAIT_V(8); PG8_WAIT_L(0); PG8_BAR; PG8_MMA(1, 0, At, B0); PG8_MMA(1, 1, At, B1); PG8_BAR; PG8_SCHED;
        }
        if constexpr (ALIGN_EPI) { if (wr == 0) PG8_BAR; }
        E(acc, cur, wr, wc, fr, fq);
        if (!has_next) break;
#pragma unroll
        for (int a = 0; a < 2; ++a)
#pragma unroll
            for (int b = 0; b < 2; ++b)
#pragma unroll
                for (int m = 0; m < 4; ++m)
#pragma unroll
                    for (int n = 0; n < 2; ++n) acc[a][b][m][n] = (f32x4){0.f, 0.f, 0.f, 0.f};
        cur = nxt; cA = nA; cB = nB; ++ui;
        if constexpr (GATHER) { vC[0][0] = vN[0][0]; vC[0][1] = vN[0][1]; vC[1][0] = vN[1][0]; vC[1][1] = vN[1][1]; }
        if constexpr (ALIGN_EPI) { if (wr == 1) PG8_BAR; }
    }
    PG8_WAIT_V(0);
    if constexpr (!ALIGN_EPI) { if (wr == 0) PG8_BAR; }
    PG8_BAR;
#undef PG8_SA
#undef PG8_SB
#undef PG8_STAGE
#undef PG8_LDA
#undef PG8_LDB
#undef PG8_MMA
#undef PG8_WAIT_V
#undef PG8_WAIT_L
#undef PG8_BAR
#undef PG8_SCHED
}
struct SchedDense {
    const char* A0; const char* B0; const char* A1; const char* B1; int nM, nN0, nN1, K, G, c, colmul;
    __device__ __forceinline__ bool next(int i, Unit& u) const {
        int pm, pn; if (!static_order(i, G, c, nM, nN0 + nN1, pm, pn)) return false;
        const int sec = pn >= nN0 ? 1 : 0, pl = pn - (sec ? nN0 : 0);
        u.A = (sec ? A1 : A0) + (size_t)pm * 256 * K * 2; u.B = (sec ? B1 : B0) + (size_t)pl * 256 * K * 2;
        u.row0 = pm * 256; u.col0 = pl * colmul; u.e = sec; u.pos0 = 0; u.cnt = 0; return true;
    }
    __device__ __forceinline__ void voff(const Unit&, const int (&R)[2], const int (&C)[2], int K_, unsigned (&v)[2][2]) const { voff_plain(R, C, K_, v); }
};
}
template <class EP> struct EpU { EP ep; __device__ __forceinline__ void operator()(const pg8::Unit&, int m, int n, f32x4 v) const { ep(m, n, v); }
    __device__ __forceinline__ void op8(const pg8::Unit&, int m, int n, f32x4 a, f32x4 b) const { ep.op8(m, n, a, b); } };
template <class EP> struct EpUP { EP ep; __device__ __forceinline__ void pair(const pg8::Unit&, int m, int ch, f32x4 a, f32x4 b) const { ep.pair(m, ch, a, b); }
    __device__ __forceinline__ void pair8(const pg8::Unit&, int m, int ch, f32x4 a0, f32x4 a1, f32x4 b0, f32x4 b1) const { ep.pair8(m, ch, a0, a1, b0, b1); } };
struct EpG1 { static constexpr bool PERM = true; bf16* BG; bf16* Z;
    __device__ __forceinline__ void operator()(const f32x4 (&acc)[2][2][4][2], const pg8::Unit& u, int wr, int wc, int fr, int fq) const {
        if (u.e == 0) { pg8::EpiWrap<EpU<EpBf16>, false, true> w{{{BG, DM}}}; w(acc, u, wr, wc, fr, fq); }
        else { pg8::Unit u2 = u; u2.col0 = u.col0 >> 1; pg8::EpiWrap<EpUP<EpMulPair>, true, true> w{{{Z, DM}}}; w(acc, u2, wr, wc, fr, fq); }
    } };
struct EpNull { static constexpr bool PERM = false; __device__ __forceinline__ void operator()(const f32x4 (&acc)[2][2][4][2], const pg8::Unit&, int, int, int, int) const {
#pragma unroll
    for (int a = 0; a < 2; ++a)
#pragma unroll
        for (int b = 0; b < 2; ++b)
#pragma unroll
            for (int m = 0; m < 4; ++m)
#pragma unroll
                for (int n = 0; n < 2; ++n) asm volatile("" :: "v"(acc[a][b][m][n])); } };
struct EpKVQG { bf16* KV; bf16* Q; float* GATE; const float* bg;
    __device__ __forceinline__ void operator()(const pg8::Unit& u, int m, int n, f32x4 v) const { if (u.e == 0) { EpKV e{KV}; e(m, n, v); } else { EpQG e{Q, GATE, bg}; e(m, n, v); } }
    __device__ __forceinline__ void op8(const pg8::Unit& u, int m, int n, f32x4 a, f32x4 b) const { if (u.e == 0) { EpKV e{KV}; e.op8(m, n, a, b); } else { EpQG e{Q, GATE, bg}; e.op8(m, n, a, b); } } };

__device__ __forceinline__ void p3_conv(Frame& F) {
    const bf16* BG = (const bf16*)(F.wsp() + WS_BG); const bf16* Z = (const bf16*)(F.wsp() + WS_Z); bf16* A2 = (bf16*)(F.wsp() + WS_A2);
    const float* cw = F.inp(I_CONVW); const float* cb = F.inp(I_CONVB);
    const int gt = F.gw * 64 + F.lane, NT_ = F.NGW * 64;
    for (int it = gt; it < T * 128; it += NT_) {
        const int m = it >> 7, ch = (it & 127) * 8, t = m & 4095;
        const u32x4 bg = *(const u32x4*)(BG + (size_t)m * DM + ch);
        const u32x4 z0 = *(const u32x4*)(Z + (size_t)m * DM + ch);
        u32x4 z1 = (u32x4){0, 0, 0, 0}, z2 = (u32x4){0, 0, 0, 0};
        if (t >= 1) z1 = *(const u32x4*)(Z + (size_t)(m - 1) * DM + ch);
        if (t >= 2) z2 = *(const u32x4*)(Z + (size_t)(m - 2) * DM + ch);
        u32x4 o;
#pragma unroll
        for (int w = 0; w < 4; ++w) {
            const int c = ch + 2 * w;
            const float r0 = bflo(bg[w]) * (cw[c] * bflo(z2[w]) + cw[1024 + c] * bflo(z1[w]) + cw[2048 + c] * bflo(z0[w]) + cb[c]);
            const float r1 = bfhi(bg[w]) * (cw[c + 1] * bfhi(z2[w]) + cw[1024 + c + 1] * bfhi(z1[w]) + cw[2048 + c + 1] * bfhi(z0[w]) + cb[c + 1]);
            o[w] = pk2(r0, r1);
        }
        *(u32x4*)(A2 + (size_t)m * DM + ch) = o;
    }
}

__device__ __forceinline__ void ln_row(f32x4 (&v)[4], const float* g, const float* bb, int lane) {
    float s = 0.f;
#pragma unroll
    for (int j = 0; j < 4; ++j) s += (v[j][0] + v[j][1]) + (v[j][2] + v[j][3]);
    const float mean = wave_sum(s) * (1.f / DM); float s2 = 0.f;
#pragma unroll
    for (int j = 0; j < 4; ++j) { v[j] = v[j] - mean; s2 += (v[j][0] * v[j][0] + v[j][1] * v[j][1]) + (v[j][2] * v[j][2] + v[j][3] * v[j][3]); }
    const float rstd = 1.f / sqrtf(wave_sum(s2) * (1.f / DM) + LN_EPS);
#pragma unroll
    for (int j = 0; j < 4; ++j) { const int col = 4 * lane + 256 * j; v[j] = v[j] * rstd * *(const f32x4*)(g + col) + *(const f32x4*)(bb + col); }
}
template <int L, bool DRY = false>
__device__ __forceinline__ void p_ln_router(Frame& F) {
    bf16* RES = (bf16*)(F.wsp() + WS_XB); bf16* U = (bf16*)(F.wsp() + WS_U);
    bf16* RESO = DRY ? (bf16*)(F.wsp() + WS_Y0) : RES; if (DRY) U = (bf16*)(F.wsp() + WS_H);
    const float* MOD = (const float*)(F.wsp() + WS_MOD) + (size_t)L * 4 * 6144;
    const float* rw = F.inp(I_RW); const float* rb = F.inp(I_RB);
    gu32* cnt = F.ctlp() + CW_CNT + L * 1024;
    unsigned* LIST = (unsigned*)(F.wsp() + WS_LIST) + (size_t)L * NE * T; float* LW = (float*)(F.wsp() + WS_LW) + (size_t)L * NE * T;
    const int lane = F.lane;
    LAS int* ae = (LAS int*)F.lds; LAS float* aw = (LAS float*)(F.lds + 512); LAS int* base = (LAS int*)(F.lds + 1024);
    constexpr int RS = 2064, AST_OFF = 2048, ALO_OFF = AST_OFF + 16 * RS, PST_OFF = ALO_OFF + 16 * RS;
    static_assert(PST_OFF + 8192 <= LDSCTL_OFF, "router LDS map");
    const int r16 = lane & 15, kg = lane >> 4;
    bf16x8 Bh[4], Bl[4];
#pragma unroll
    for (int s_ = 0; s_ < 4; ++s_) { u32x4 hh, ll;
#pragma unroll
        for (int i = 0; i < 4; ++i) { const int k = 128 * F.wave + 32 * s_ + 8 * kg + 2 * i; const float a = rw[(size_t)k * 16 + r16], b_ = rw[(size_t)(k + 1) * 16 + r16];
            const unsigned h = pk2(a, b_); hh[i] = h; ll[i] = pk2(a - bflo(h), b_ - bfhi(h)); }
        Bh[s_] = __builtin_bit_cast(bf16x8, hh); Bl[s_] = __builtin_bit_cast(bf16x8, ll); }
    const int nchunk = T / 64;
    for (int ch = blockIdx.x; ch < nchunk; ch += gridDim.x) {
      const bf16* YB = (const bf16*)(F.wsp() + WS_Y0); const float* XF = F.inp(I_X);
      u32x2 yn[4]; f32x4 xn[4];
#pragma unroll
      for (int j = 0; j < 4; ++j) { const size_t o = (size_t)(ch * 64 + F.wave * 2) * DM + 4 * lane + 256 * j; yn[j] = *(const u32x2*)(YB + o);
          if (L == 0) xn[j] = *(const f32x4*)(XF + o); else xn[j] = ld_bf4(RES + o); }
#pragma unroll 2
      for (int rr = 0; rr < 8; ++rr) {
        const int pass = rr >> 1, sub = rr & 1, lrow = pass * 16 + F.wave * 2 + sub, m = ch * 64 + lrow;
        const int b = m >> 12;
        f32x4 v[4];
#pragma unroll
        for (int j = 0; j < 4; ++j) { const f32x4 g1 = *(const f32x4*)(MOD + b * 6144 + 2 * 1024 + 4 * lane + 256 * j);
            v[j] = xn[j] * ALPHA + g1 * (f32x4){bflo(yn[j].x), bfhi(yn[j].x), bflo(yn[j].y), bfhi(yn[j].y)}; }
        if (rr < 7) {
#pragma unroll
            for (int j = 0; j < 4; ++j) { const size_t o = (size_t)(m + (sub ? 15 : 1)) * DM + 4 * lane + 256 * j; yn[j] = *(const u32x2*)(YB + o);
                if (L == 0) xn[j] = *(const f32x4*)(XF + o); else xn[j] = ld_bf4(RES + o); } }
        ln_row(v, F.inp(I_LNG) + (L * 2 + 0) * DM, F.inp(I_LNB) + (L * 2 + 0) * DM, lane);
        {
            LAS unsigned char* arow = F.lds + AST_OFF + (F.wave * 2 + sub) * RS + lane * 8;
#pragma unroll
            for (int j = 0; j < 4; ++j) { const int col = 4 * lane + 256 * j;
                st_bf4(RESO + (size_t)m * DM + col, v[j]);
                const f32x4 u = v[j] * (*(const f32x4*)(MOD + b * 6144 + 4 * 1024 + col) + 1.0f) + *(const f32x4*)(MOD + b * 6144 + 3 * 1024 + col);
                u32x2 hh, ll; hh.x = pk2(u[0], u[1]); hh.y = pk2(u[2], u[3]);
                ll.x = pk2(u[0] - bflo(hh.x), u[1] - bfhi(hh.x)); ll.y = pk2(u[2] - bflo(hh.y), u[3] - bfhi(hh.y));
                *(u32x2*)(U + (size_t)m * DM + col) = hh;
                *(LAS u32x2*)(arow + j * 512) = hh; *(LAS u32x2*)(arow + 16 * RS + j * 512) = ll; }
        }
        if (sub == 0) continue;
        __syncthreads();
        float lgv;
        {
            f32x4 acc = (f32x4){0.f, 0.f, 0.f, 0.f};
            const LAS unsigned char* ap = F.lds + AST_OFF + r16 * RS + (128 * F.wave + 8 * kg) * 2;
#pragma unroll
            for (int s_ = 0; s_ < 4; ++s_) { const bf16x8 ah = *(const LAS bf16x8*)(ap + s_ * 64), al = *(const LAS bf16x8*)(ap + 16 * RS + s_ * 64);
                acc = __builtin_amdgcn_mfma_f32_16x16x32_bf16(ah, Bh[s_], acc, 0, 0, 0);
                acc = __builtin_amdgcn_mfma_f32_16x16x32_bf16(al, Bh[s_], acc, 0, 0, 0);
                acc = __builtin_amdgcn_mfma_f32_16x16x32_bf16(ah, Bl[s_], acc, 0, 0, 0); }
            *(LAS f32x4*)(F.lds + PST_OFF + ((F.wave * 4 + kg) * 16 + r16) * 16) = acc;
            __syncthreads();
            const int rho = 2 * F.wave + (kg & 1); float sm = 0.f;
#pragma unroll
            for (int x = 0; x < 4; ++x) sm += *(const LAS float*)(F.lds + PST_OFF + ((((kg >> 1) * 4 + x) * 4 + (rho >> 2)) * 16 + r16) * 16 + (rho & 3) * 4);
            lgv = sm + __shfl_xor(sm, 32);
        }
#pragma unroll 1
        for (int sb = 0; sb < 2; ++sb) {
        const int lrow2 = pass * 16 + F.wave * 2 + sb;
        float lg[16];
#pragma unroll
        for (int e = 0; e < 16; ++e) lg[e] = __builtin_bit_cast(float, __builtin_amdgcn_readlane(__builtin_bit_cast(int, lgv), 16 * sb + e));
        float mx = lg[0];
#pragma unroll
        for (int e = 1; e < 16; ++e) mx = fmaxf(mx, lg[e]);
        float aff[16], bi[16]; float sum = 0.f;
#pragma unroll
        for (int e = 0; e < 16; ++e) { aff[e] = __expf(lg[e] - mx); sum += aff[e]; }
        const float inv = 1.f / sum;
#pragma unroll
        for (int e = 0; e < 16; ++e) { aff[e] *= inv; bi[e] = aff[e] + rb[e]; }
        float gs[4];
#pragma unroll
        for (int g = 0; g < 4; ++g) { const float a0 = bi[4 * g], a1 = bi[4 * g + 1], a2 = bi[4 * g + 2], a3 = bi[4 * g + 3];
            const float t1 = fmaxf(a0, a1), t2 = fminf(a0, a1), u1 = fmaxf(a2, a3), u2 = fminf(a2, a3);
            gs[g] = fmaxf(t1, u1) + fmaxf(fminf(t1, u1), fmaxf(t2, u2)); }
        int best = 0; float bv = gs[0];
#pragma unroll
        for (int g = 1; g < 4; ++g) if (gs[g] > bv) { bv = gs[g]; best = g; }
        float cb_[4], ca_[4];
#pragma unroll
        for (int i = 0; i < 4; ++i) { cb_[i] = best == 0 ? bi[i] : best == 1 ? bi[4 + i] : best == 2 ? bi[8 + i] : bi[12 + i];
                                      ca_[i] = best == 0 ? aff[i] : best == 1 ? aff[4 + i] : best == 2 ? aff[8 + i] : aff[12 + i]; }
        int i0 = 0; float b0 = cb_[0];
#pragma unroll
        for (int i = 1; i < 4; ++i) if (cb_[i] > b0) { b0 = cb_[i]; i0 = i; }
        int i1 = -1; float b1 = -3.0e38f;
#pragma unroll
        for (int i = 0; i < 4; ++i) if (i != i0 && cb_[i] > b1) { b1 = cb_[i]; i1 = i; }
        const float w0 = i0 == 0 ? ca_[0] : i0 == 1 ? ca_[1] : i0 == 2 ? ca_[2] : ca_[3];
        const float w1 = i1 == 0 ? ca_[0] : i1 == 1 ? ca_[1] : i1 == 2 ? ca_[2] : ca_[3];
        const float ws_ = 1.f / (w0 + w1);
        if (lane == 0) { ae[2 * lrow2] = best * 4 + i0; ae[2 * lrow2 + 1] = best * 4 + i1; aw[2 * lrow2] = w0 * ws_; aw[2 * lrow2 + 1] = w1 * ws_; }
        }
      }
      __syncthreads();
      if (DRY) continue;
      if (F.tid < NE) { int c = 0; for (int i = 0; i < 128; ++i) c += (ae[i] == F.tid) ? 1 : 0;
          base[F.tid] = c ? (int)__hip_atomic_fetch_add(cnt + F.tid * 64, (unsigned)c, RLX_AGENT) : 0; }
      __syncthreads();
      if (F.tid < 128) { const int e = ae[F.tid]; int rk = 0; for (int i = 0; i < F.tid; ++i) rk += (ae[i] == e) ? 1 : 0;
          const int pos = base[e] + rk; const unsigned m = (unsigned)(ch * 64 + (F.tid >> 1));
          LIST[(size_t)e * T + pos] = m * 2u + (unsigned)(F.tid & 1); LW[(size_t)e * T + pos] = aw[F.tid]; }
      __syncthreads();
    }
}
template <int L, bool DRY = false>
__device__ __forceinline__ void p_ln2(Frame& F) {
    bf16* RES = (bf16*)(F.wsp() + WS_XB); bf16* U = (bf16*)(F.wsp() + WS_U); float* OUT = F.outp();
    bf16* RESO = DRY ? (bf16*)(F.wsp() + WS_R1) : RES; if (DRY) { U = (bf16*)(F.wsp() + WS_H); }
    const bf16* Y0 = (const bf16*)(F.wsp() + WS_Y0); const bf16* Y1 = (const bf16*)(F.wsp() + WS_Y1);
    const float* MOD = (const float*)(F.wsp() + WS_MOD) + (size_t)L * 4 * 6144;
    const float* MODN = (const float*)(F.wsp() + WS_MOD) + (size_t)1 * 4 * 6144;
    const int lane = F.lane;
    for (int m = F.gw; m < T; m += F.NGW) {
        const int b = m >> 12;
        f32x4 v[4];
#pragma unroll
        for (int j = 0; j < 4; ++j) { const int col = 4 * lane + 256 * j;
            const f32x4 x = ld_bf4(RES + (size_t)m * DM + col);
            const u32x2 a = *(const u32x2*)(Y0 + (size_t)m * DM + col), c = *(const u32x2*)(Y1 + (size_t)m * DM + col);
            const f32x4 y = (f32x4){bflo(a.x) + bflo(c.x), bfhi(a.x) + bfhi(c.x), bflo(a.y) + bflo(c.y), bfhi(a.y) + bfhi(c.y)};
            v[j] = x * ALPHA + *(const f32x4*)(MOD + b * 6144 + 5 * 1024 + col) * y; }
        ln_row(v, F.inp(I_LNG) + (L * 2 + 1) * DM, F.inp(I_LNB) + (L * 2 + 1) * DM, lane);
#pragma unroll
        for (int j = 0; j < 4; ++j) { const int col = 4 * lane + 256 * j;
            if (L == 1) *(f32x4*)(OUT + (size_t)m * DM + col) = v[j];
            if (L == 0) { st_bf4(RESO + (size_t)m * DM + col, v[j]);
                st_bf4(U + (size_t)m * DM + col, v[j] * (*(const f32x4*)(MODN + b * 6144 + 1024 + col) + 1.0f) + *(const f32x4*)(MODN + b * 6144 + col)); } }
    }
}

__device__ __forceinline__ void moe_tables(Frame& F, int L) {
    LAS int* tb = (LAS int*)(F.lds + MISC_OFF + 128); LAS int* cn = tb + 20;
    __syncthreads();
    if (F.tid == 0) { int acc = 0; for (int e = 0; e < NE; ++e) { const int c = (int)__hip_atomic_load(F.ctlp() + CW_CNT + L * 1024 + e * 64, RLX_AGENT); cn[e] = c; tb[e] = acc; acc += (c + 255) >> 8; } tb[NE] = acc; }
    __syncthreads();
}
struct ARowMoe { const bf16* U; const unsigned* list; int rbase, cnt;
    __device__ __forceinline__ const bf16* operator()(int r) const { const int pos = r - rbase; const unsigned tok = pos < cnt ? (list[pos] >> 1) : 0u; return U + (size_t)tok * DM; } };
struct EpY { bf16* Y; const unsigned* list; const float* lw; int rbase, cnt;
    __device__ __forceinline__ void operator()(int r, int n, f32x4 v) const { const int pos = r - rbase; if (pos < cnt) { const unsigned ts = list[pos]; const float w = lw[pos];
        st_bf4(Y + (size_t)(ts & 1u) * ((size_t)T * DM) + (size_t)(ts >> 1) * DM + n, v * w); } } };
template <int L>
__device__ __forceinline__ void p_moe_gu(Frame& F) {
    moe_tables(F, L);
    LAS int* tb = (LAS int*)(F.lds + MISC_OFF + 128); LAS int* cn = tb + 20;
    const unsigned* LIST = (const unsigned*)(F.wsp() + WS_LIST) + (size_t)L * NE * T;
    const int total = tb[NE] * 4 * 16;
    for (int it = F.gw; it < total; it += F.NGW) {
        const int ni = it & 15, mt = it >> 4; int e = 0; while (tb[e + 1] * 4 <= mt) ++e;
        const ARowMoe ar{(const bf16*)(F.wsp() + WS_U), LIST + (size_t)e * T, tb[e] * 256, cn[e]};
        const EpSiluPair ep{(bf16*)(F.wsp() + WS_H), FF};
        const int pn = ni >> 2, q = ni & 3;
        gemm_wave_tile<true>(ar, (const bf16*)(F.wsp() + WS_WGU) + (size_t)(L * NE + e) * 1024 * 1024 + (size_t)(pn * 256 + q * 32) * 1024, 1024, mt * 64, pn * 128 + q * 32, ep, F.lane);
    }
}
template <int L>
__device__ __forceinline__ void p_moe_down(Frame& F) {
    moe_tables(F, L);
    LAS int* tb = (LAS int*)(F.lds + MISC_OFF + 128); LAS int* cn = tb + 20;
    const unsigned* LIST = (const unsigned*)(F.wsp() + WS_LIST) + (size_t)L * NE * T; const float* LW = (const float*)(F.wsp() + WS_LW) + (size_t)L * NE * T;
    const int total = tb[NE] * 4 * 16;
    for (int it = F.gw; it < total; it += F.NGW) {
        const int ni = it & 15, mt = it >> 4; int e = 0; while (tb[e + 1] * 4 <= mt) ++e;
        const ARowPlain ar{(const bf16*)(F.wsp() + WS_H), FF};
        const EpY ep{(bf16*)(F.wsp() + WS_Y0), LIST + (size_t)e * T, LW + (size_t)e * T, tb[e] * 256, cn[e]};
        gemm_wave_tile<false>(ar, (const bf16*)(F.wsp() + WS_WDN) + (size_t)(L * NE + e) * 1024 * 512 + (size_t)(ni * 64) * 512, 512, mt * 64, ni * 64, ep, F.lane);
    }
}

struct ARowCmp { const bf16* KVi; __device__ __forceinline__ const bf16* operator()(int R) const { return KVi + ((size_t)(R >> 8) * KVROWS + (size_t)(R & 255) * 16) * 64; } };
__device__ __forceinline__ float gelu_tanh(float x) { const float u = 0.7978845608028654f * (x + 0.044715f * x * x * x); const float e = __expf(2.f * u); const float th = 1.f - 2.f / (e + 1.f); return 0.5f * x * (1.f + th); }
__device__ __forceinline__ void p_cmp_finish(Frame& F) {
    LAS float* w2s = (LAS float*)F.lds;
    LAS float* hd = (LAS float*)(F.lds + 65536 + F.wave * 4096);
    const float* TB = (const float*)(F.wsp() + WS_TB); const float* PETP = (const float*)(F.wsp() + WS_PETP);
    const int lane = F.lane;
    for (int base = blockIdx.x * 32; base < 2 * 16 * 256; base += gridDim.x * 32) {
        const int i = base >> 12;
        __syncthreads();
        const int it0 = base + F.wave * 4, bh = (it0 >> 8) & 15, n0 = it0 & 255, c = 4 * lane;
        f32x4 wv[8], ta[4], tb_[4];
#pragma unroll
        for (int k = 0; k < 8; ++k) wv[k] = *(const f32x4*)(F.inp(I_CW2) + (size_t)i * 256 * 64 + 4 * (F.tid + 512 * k));
#pragma unroll
        for (int r = 0; r < 4; ++r) { const int n = n0 + r < 255 ? n0 + r : 254; const float* r0 = TB + ((size_t)i * 4096 + bh * 256 + n) * 512; ta[r] = *(const f32x4*)(r0 + c); tb_[r] = *(const f32x4*)(r0 + 512 + 256 + c); }
        const f32x4 pe = *(const f32x4*)(PETP + 64 * 256 + i * 256 + c);
#pragma unroll
        for (int k = 0; k < 8; ++k) *(LAS f32x4*)(w2s + 4 * (F.tid + 512 * k)) = wv[k];
#pragma unroll
        for (int r = 0; r < 4; ++r) { const int n = n0 + r;
            f32x4 h = (f32x4){0.f, 0.f, 0.f, 0.f};
            if (n < 255) h = ta[r] + tb_[r] + pe;
#pragma unroll
            for (int q = 0; q < 4; ++q) hd[(c + q) * 4 + r] = gelu_tanh(h[q]); }
        __syncthreads();
        const float b2 = F.inp(I_CB2)[i * 64 + lane];
        float a0 = b2, a1 = b2, a2 = b2, a3 = b2;
#pragma unroll 8
        for (int cc = 0; cc < 256; ++cc) { const float w = w2s[cc * 64 + lane]; const f32x4 h4 = *(const LAS f32x4*)(hd + cc * 4);
            a0 += h4[0] * w; a1 += h4[1] * w; a2 += h4[2] * w; a3 += h4[3] * w; }
        const float av[4] = {a0, a1, a2, a3};
#pragma unroll
        for (int r = 0; r < 4; ++r) { const int n = n0 + r;
            bf16* dst = (bf16*)(F.wsp() + (i ? WS_VC : WS_KC)) + (size_t)bh * 256 * 64 + (size_t)(n >> 6) * 4096 + (i ? vfrag_off(n & 63, lane) : kfrag_off(n & 63, lane));
            *dst = (n == 255) ? (bf16)0 : (bf16)f2bf(av[r]); }
    }
}

__device__ __forceinline__ void score_tile(const bf16* krow, const LAS float* qs, float (&s)[4]) {
    s[0] = s[1] = s[2] = s[3] = 0.f;
#pragma unroll
    for (int c = 0; c < 8; ++c) { const u32x4 kv = *(const u32x4*)(krow + 8 * c);
#pragma unroll
        for (int w = 0; w < 4; ++w) { const f32x4 qa = *(const LAS f32x4*)(qs + (8 * c + 2 * w) * 4), qb = *(const LAS f32x4*)(qs + (8 * c + 2 * w + 1) * 4);
            const float ka = bflo(kv[w]), kb = bfhi(kv[w]);
            s[0] += ka * qa[0] + kb * qb[0]; s[1] += ka * qa[1] + kb * qb[1]; s[2] += ka * qa[2] + kb * qb[2]; s[3] += ka * qa[3] + kb * qb[3]; } }
}
__device__ __forceinline__ void attend_tile(const bf16* Kt, const bf16* Vt, bool valid, const LAS float* qs, LAS float* pbuf, float (&mr)[4], float (&l)[4], float (&o)[4], int lane) {
    float s[4]; score_tile(Kt + (size_t)lane * 64, qs, s);
    f32x4 p4;
#pragma unroll
    for (int g = 0; g < 4; ++g) {
        const float sg = valid ? s[g] : -INFINITY; const float tm = wave_max(sg); const float mn = fmaxf(mr[g], tm);
        const float mref = (mn == -INFINITY) ? 0.f : mn;
        const float alpha = __builtin_amdgcn_exp2f(mr[g] - mref); const float p = valid ? __builtin_amdgcn_exp2f(sg - mref) : 0.f;
        l[g] = l[g] * alpha + wave_sum(p); o[g] *= alpha; mr[g] = mn; p4[g] = p;
    }
    LDS_WAIT(); asm volatile("" ::: "memory");
    *(LAS f32x4*)(pbuf + lane * 4) = p4;
    LDS_WAIT(); asm volatile("" ::: "memory");
#pragma unroll 8
    for (int k = 0; k < 64; ++k) { const f32x4 pk = *(const LAS f32x4*)(pbuf + k * 4); const float vv = bf2f(Vt[(size_t)k * 64 + lane]);
        o[0] += pk[0] * vv; o[1] += pk[1] * vv; o[2] += pk[2] * vv; o[3] += pk[3] * vv; }
    LDS_WAIT(); asm volatile("" ::: "memory");
}
__device__ __forceinline__ void p_attn_simple(Frame& F) {
    LAS float* qs = (LAS float*)(F.lds + F.wave * 16384);
    LAS float* pbuf = qs + 256;
    LAS float* psum = pbuf + 1024;
    const bf16* Q = (const bf16*)(F.wsp() + WS_Q); const float* GATE = (const float*)(F.wsp() + WS_GATE); bf16* O = (bf16*)(F.wsp() + WS_O);
    const bf16* KVb = (const bf16*)(F.wsp() + WS_KV);
    const int lane = F.lane;
    for (int it = F.gw; it < 16 * SEQ; it += F.NGW) {
        const int bh = it & 15, t = it >> 4, b = bh >> 2, hk = bh & 3, m = b * SEQ + t;
        LDS_WAIT(); asm volatile("" ::: "memory");
        { f32x4 q4; for (int g = 0; g < 4; ++g) q4[g] = bf2f(Q[(size_t)m * DM + (hk * 4 + g) * 64 + lane]); *(LAS f32x4*)(qs + lane * 4) = q4; }
        LDS_WAIT(); asm volatile("" ::: "memory");
        const bf16* KC = (const bf16*)(F.wsp() + WS_KC) + (size_t)bh * 256 * 64; const bf16* VC = (const bf16*)(F.wsp() + WS_VC) + (size_t)bh * 256 * 64;
        const int nv = t >= 31 ? ((t - 31) >> 4) + 1 : 0;
        float sc[4][4];
#pragma unroll
        for (int i = 0; i < 4; ++i) { float s[4] = {0.f, 0.f, 0.f, 0.f}; if (64 * i < nv) score_tile(KC + (size_t)(64 * i + lane) * 64, qs, s);
            const bool v = (64 * i + lane) < nv;
#pragma unroll
            for (int g = 0; g < 4; ++g) sc[i][g] = v ? s[g] : -INFINITY; }
        float oc[4];
#pragma unroll
        for (int g = 0; g < 4; ++g) {
            const float mx = wave_max(fmaxf(fmaxf(sc[0][g], sc[1][g]), fmaxf(sc[2][g], sc[3][g]))); const float mref = (mx == -INFINITY) ? 0.f : mx;
            float e[4]; float ls = 0.f;
#pragma unroll
            for (int i = 0; i < 4; ++i) { e[i] = __builtin_amdgcn_exp2f(sc[i][g] - mref); ls += e[i]; }
            const float inv = 1.f / fmaxf(wave_sum(ls), 1e-30f);
#pragma unroll
            for (int i = 0; i < 4; ++i) sc[i][g] = e[i] * inv;
        }
#pragma unroll
        for (int i = 0; i < 4; ++i) { *(LAS f32x4*)(pbuf + (64 * i + lane) * 4) = (f32x4){sc[i][0], sc[i][1], sc[i][2], sc[i][3]};
            psum[64 * i + lane + 1] = (sc[i][0] + sc[i][1]) + (sc[i][2] + sc[i][3]); }
        if (lane == 0) psum[0] = 0.f;
        LDS_WAIT(); asm volatile("" ::: "memory");
        oc[0] = oc[1] = oc[2] = oc[3] = 0.f;
        for (int n = 0; n < nv; ++n) { const f32x4 pk = *(const LAS f32x4*)(pbuf + n * 4); const float vv = bf2f(VC[(size_t)n * 64 + lane]);
            oc[0] += pk[0] * vv; oc[1] += pk[1] * vv; oc[2] += pk[2] * vv; oc[3] += pk[3] * vv; }
        const float imp = 0.5f * psum[4 * lane] + psum[4 * lane + 1] + psum[4 * lane + 2] + psum[4 * lane + 3] + 0.5f * psum[4 * lane + 4];
        const int cur = t >> 6;
        const bool allowed = lane <= cur, forced = allowed && (lane == 0 || lane == cur || lane == cur - 1);
        const float score = forced ? 1e9f : (allowed ? imp : -1e30f);
        int rank = 0;
#pragma unroll
        for (int j = 0; j < 64; ++j) { const float sj = __shfl(score, j); rank += (sj > score || (sj == score && j < lane)) ? 1 : 0; }
        const unsigned long long mask = __ballot(rank < 16 && score > -0.5e30f);
        LDS_WAIT(); asm volatile("" ::: "memory");
        const bf16* KS = KVb + 2 * KVBUF_ELEMS + (size_t)bh * KVROWS * 64; const bf16* VS = KVb + 3 * KVBUF_ELEMS + (size_t)bh * KVROWS * 64;
        float ms[4] = {-INFINITY, -INFINITY, -INFINITY, -INFINITY}, ls[4] = {0.f, 0.f, 0.f, 0.f}, os[4] = {0.f, 0.f, 0.f, 0.f};
        for (unsigned long long mk = mask; mk; mk &= mk - 1) { const int j = __builtin_ctzll(mk);
            attend_tile(KS + (size_t)j * 64 * 64, VS + (size_t)j * 64 * 64, (64 * j + lane) <= t, qs, pbuf, ms, ls, os, lane); }
        const bf16* KW = KVb + 4 * KVBUF_ELEMS + (size_t)bh * KVROWS * 64; const bf16* VW = KVb + 5 * KVBUF_ELEMS + (size_t)bh * KVROWS * 64;
        float mw[4] = {-INFINITY, -INFINITY, -INFINITY, -INFINITY}, lw[4] = {0.f, 0.f, 0.f, 0.f}, ow[4] = {0.f, 0.f, 0.f, 0.f};
        const int lo = t - 511 > 0 ? t - 511 : 0;
        for (int j = lo >> 6; j <= (t >> 6); ++j) { const int pos = 64 * j + lane;
            attend_tile(KW + (size_t)j * 64 * 64, VW + (size_t)j * 64 * 64, pos >= lo && pos <= t, qs, pbuf, mw, lw, ow, lane); }
#pragma unroll
        for (int g = 0; g < 4; ++g) { const float* gp = GATE + (size_t)m * 48 + (hk * 4 + g) * 3;
            const float o = gp[0] * oc[g] + gp[1] * os[g] / fmaxf(ls[g], 1e-30f) + gp[2] * ow[g] / fmaxf(lw[g], 1e-30f);
            O[(size_t)m * DM + (hk * 4 + g) * 64 + lane] = (bf16)f2bf(o); }
    }
}

struct SchedCmp { const char* KV; const char* W1C; int G, c;
    __device__ __forceinline__ bool next(int it, pg8::Unit& u) const { const int L = it * G + c; if (c < 0 || L >= 64) return false;
        const int i = L >> 5, pm = (L >> 1) & 15, pn = L & 1;
        u.A = KV + ((size_t)i * KVBUF_ELEMS + (size_t)pm * KVROWS * 64) * 2; u.B = W1C + ((size_t)i * 512 * 1024 + (size_t)pn * 256 * 1024) * 2;
        u.row0 = i * 4096 + pm * 256; u.col0 = pn * 256; u.e = i; u.pos0 = 0; u.cnt = 0; return true; }
    __device__ __forceinline__ void voff(const pg8::Unit&, const int (&R)[2], const int (&C)[2], int K_, unsigned (&v)[2][2]) const { pg8::voff_plain(R, C, K_, v); }
};
struct SchedKVQG { const char* A0; const char* B0; const char* A1; const char* B1; int G, c, Lbase, Lend;
    __device__ __forceinline__ bool next(int it, pg8::Unit& u) const { const int L = Lbase + it * G + c; if (c < 0 || L >= Lend) return false;
        const int sec = L >= 384 ? 1 : 0, l = sec ? L - 384 : L, nn = sec ? 5 : 6, pm = l / nn, pn = l % nn;
        u.A = (sec ? A1 : A0) + (size_t)pm * 256 * DM * 2; u.B = (sec ? B1 : B0) + (size_t)pn * 256 * DM * 2;
        u.row0 = pm * 256; u.col0 = pn * 256; u.e = sec; u.pos0 = 0; u.cnt = 0; return true; }
    __device__ __forceinline__ void voff(const pg8::Unit&, const int (&R)[2], const int (&C)[2], int K_, unsigned (&v)[2][2]) const { pg8::voff_plain(R, C, K_, v); }
};
struct SchedMoe { LAS int* tb; LAS int* cn; const unsigned* LIST; const char* Abase; const char* Bbase; size_t bstride; int K, nN, colmul, G, c; bool gather; int Lbase, Lend;
    __device__ __forceinline__ bool next(int it, pg8::Unit& u) const { const int L = Lbase + it * G + c; if (c < 0 || L >= Lend) return false;
        const int mt = L / nN, pn = L % nN; int e = 0; while (tb[e + 1] <= mt) ++e;
        u.A = gather ? Abase : Abase + (size_t)mt * 256 * K * 2; u.B = Bbase + (size_t)e * bstride + (size_t)pn * 256 * K * 2;
        u.row0 = mt * 256; u.col0 = pn * colmul; u.e = e; u.pos0 = (mt - tb[e]) * 256; u.cnt = cn[e]; return true; }
    __device__ __forceinline__ void voff(const pg8::Unit& u, const int (&R)[2], const int (&C)[2], int K_, unsigned (&v)[2][2]) const {
        if (!gather) { pg8::voff_plain(R, C, K_, v); return; }
        const unsigned* le = LIST + (size_t)u.e * T; unsigned tk[2][2];
#pragma unroll
        for (int h = 0; h < 2; ++h)
#pragma unroll
            for (int i = 0; i < 2; ++i) { const int pos = u.pos0 + h * 128 + R[i]; tk[h][i] = le[pos < u.cnt ? pos : u.cnt - 1]; }
#pragma unroll
        for (int h = 0; h < 2; ++h)
#pragma unroll
            for (int i = 0; i < 2; ++i) v[h][i] = ((tk[h][i] >> 1) * (unsigned)K_ + (unsigned)C[i]) * 2u;
    }
};
struct EpHU { bf16* H; __device__ __forceinline__ void pair(const pg8::Unit&, int r, int ch, f32x4 a, f32x4 b) const {
    f32x4 s; for (int q = 0; q < 4; ++q) s[q] = silu_f(a[q]) * b[q]; st_bf4(H + (size_t)r * FF + ch, s); }
    __device__ __forceinline__ void pair8(const pg8::Unit&, int r, int ch, f32x4 a0, f32x4 a1, f32x4 b0, f32x4 b1) const {
    f32x4 s0, s1; for (int q = 0; q < 4; ++q) { s0[q] = silu_f(a0[q]) * b0[q]; s1[q] = silu_f(a1[q]) * b1[q]; } st_bf8(H + (size_t)r * FF + ch, s0, s1); } };
struct EpYU { bf16* Y; const unsigned* LIST; const float* LW;
    __device__ __forceinline__ void operator()(const pg8::Unit& u, int r, int n, f32x4 v) const { const int pos = u.pos0 + (r - u.row0);
        if (pos < u.cnt) { const unsigned ts = LIST[(size_t)u.e * T + pos]; const float w = LW[(size_t)u.e * T + pos];
            st_bf4(Y + (size_t)(ts & 1u) * ((size_t)T * DM) + (size_t)(ts >> 1) * DM + n, v * w); } }
    __device__ __forceinline__ void op8(const pg8::Unit& u, int r, int n, f32x4 a, f32x4 b) const { const int pos = u.pos0 + (r - u.row0);
        if (pos < u.cnt) { const unsigned ts = LIST[(size_t)u.e * T + pos]; const float w = LW[(size_t)u.e * T + pos];
            st_bf8(Y + (size_t)(ts & 1u) * ((size_t)T * DM) + (size_t)(ts >> 1) * DM + n, a * w, b * w); } } };
struct EpYUAll { static constexpr bool PERM = true; EpYU ep;
    __device__ __forceinline__ void operator()(const f32x4 (&acc)[2][2][4][2], const pg8::Unit& u, int wr, int wc, int fr, int fq) const {
        unsigned ts[2][4]; float w[2][4];
        const unsigned* le = ep.LIST + (size_t)u.e * T; const float* lw = ep.LW + (size_t)u.e * T;
#pragma unroll
        for (int ai = 0; ai < 2; ++ai)
#pragma unroll
            for (int m = 0; m < 4; ++m) { const int pos = u.pos0 + ai * pg8::HALF + wr * 64 + m * 16 + fr; const int pc = pos < u.cnt ? pos : u.cnt - 1;
                const unsigned t_ = le[pc]; ts[ai][m] = pos < u.cnt ? t_ : 0xFFFFFFFFu; w[ai][m] = lw[pc]; }
#pragma unroll
        for (int ai = 0; ai < 2; ++ai)
#pragma unroll
            for (int m = 0; m < 4; ++m) if (ts[ai][m] != 0xFFFFFFFFu) {
                bf16* yr = ep.Y + (size_t)(ts[ai][m] & 1u) * ((size_t)T * DM) + (size_t)(ts[ai][m] >> 1) * DM + u.col0 + wc * 32 + 8 * fq;
#pragma unroll
                for (int bj = 0; bj < 2; ++bj) st_bf8(yr + bj * pg8::HALF, acc[ai][bj][m][0] * w[ai][m], acc[ai][bj][m][1] * w[ai][m]); }
    } };
template <int L>
__device__ __forceinline__ void p_moe(Frame& F, const XcdBarrier& bar, bool with_barriers) {
    moe_tables(F, L);
    LAS int* tb = (LAS int*)(F.lds + MISC_OFF + 128); LAS int* cn = tb + 20;
    const int G = gridDim.x, bx = blockIdx.x, vcu = (G % 8 == 0) ? (bx % 8) * (G / 8) + bx / 8 : bx;
    const int nt = tb[NE], n128 = nt < 128 ? nt : 128, Wg = 4 * (nt - n128) < G / 2 ? 4 * (nt - n128) : G / 2;
    const int D2 = (4 * n128 < 2 * (G - Wg)) ? 4 * n128 : 2 * (G - Wg);
#pragma unroll 1
    for (int part = 1; part <= 3; ++part) {
        int gc = -1, gG = 1, gb = 0, ge = 0, dc = -1, dG = 1, db = 0, de = 0;
        if (part == 1) { gc = vcu; gG = G; gb = 0; ge = 4 * n128; }
        else if (part == 2) { if (vcu < Wg) { gc = vcu; gG = Wg; gb = 4 * n128; ge = 4 * nt; } else { dc = vcu - Wg; dG = G - Wg; db = 0; de = D2; } }
        else { dc = vcu; dG = G; db = D2; de = 4 * nt; }
        {
            const SchedMoe S{tb, cn, (const unsigned*)(F.wsp() + WS_LIST) + (size_t)L * NE * T, (const char*)(F.wsp() + WS_U), (const char*)(F.wsp() + WS_WGU) + (size_t)L * NE * 1024 * 1024 * 2, (size_t)1024 * 1024 * 2, 1024, 4, 128, gG, gc, true, gb, ge};
            typedef pg8::EpiWrap<EpHU, true, true> E_;
            pg8::gemm_phase<E_, SchedMoe, true, true>(F.lds, 1024, S, E_{{(bf16*)(F.wsp() + WS_H)}});
        }
        {
            const SchedMoe S{tb, cn, nullptr, (const char*)(F.wsp() + WS_H), (const char*)(F.wsp() + WS_WDN) + (size_t)L * NE * 1024 * 512 * 2, (size_t)1024 * 512 * 2, 512, 4, 256, dG, dc, false, db, de};
            typedef EpYUAll E_;
            pg8::gemm_phase<E_, SchedMoe, true, false>(F.lds, 512, S, E_{{(bf16*)(F.wsp() + WS_Y0), (const unsigned*)(F.wsp() + WS_LIST) + (size_t)L * NE * T, (const float*)(F.wsp() + WS_LW) + (size_t)L * NE * T}});
        }
        if (part < 3 && with_barriers) xcd_barrier(bar);
    }
}
typedef float f32x16 __attribute__((ext_vector_type(16)));
#define MFMA32(a, b, c) __builtin_amdgcn_mfma_f32_32x32x16_bf16(a, b, c, 0, 0, 0)
constexpr size_t WS_MASK = WS_GATE + 3 * MiB;
constexpr int STG_STRIDE = 68, STG_BYTES = 32 * STG_STRIDE * 4;
__device__ __forceinline__ int crow(int r, int hi) { return (r & 3) + 8 * (r >> 2) + 4 * hi; }
__device__ __forceinline__ unsigned cvtpk(float lo, float hi) { f32x2v v = {lo, hi}; bf16x2_t b = __builtin_convertvector(v, bf16x2_t); return __builtin_bit_cast(unsigned, b); }
__device__ __forceinline__ float partner32(float x, int hi) { auto rr = __builtin_amdgcn_permlane32_swap(__builtin_bit_cast(unsigned, x), __builtin_bit_cast(unsigned, x), false, false);
    return __builtin_bit_cast(float, hi ? rr[0] : rr[1]); }
__device__ __forceinline__ float max3f(float a, float b, float c) { float r; asm("v_max3_f32 %0, %1, %2, %3" : "=v"(r) : "v"(a), "v"(b), "v"(c)); return r; }
__device__ __forceinline__ float max2f(float a, float b) { float r; asm("v_max_f32_e32 %0, %1, %2" : "=v"(r) : "v"(a), "v"(b)); return r; }
__device__ __forceinline__ float rowmax32(f32x16& p0, f32x16& p1, int hi) {
    asm volatile("s_nop 15\n\ts_nop 7" : "+v"(p0), "+v"(p1));
    float a = max3f(p0[0], p0[1], p1[0]), b = max3f(p0[2], p0[3], p1[1]); a = max3f(a, p1[2], p1[3]);
#pragma unroll
    for (int r = 4; r < 16; r += 4) { a = max3f(a, p0[r], p0[r + 1]); b = max3f(b, p0[r + 2], p0[r + 3]); a = max3f(a, p1[r], p1[r + 1]); b = max3f(b, p1[r + 2], p1[r + 3]); }
    const float m = max2f(a, b);
    return max2f(m, partner32(m, hi));
}
typedef __amdgpu_buffer_rsrc_t rsrc_t;
__device__ __forceinline__ rsrc_t make_rsrc(const void* base, unsigned bytes) { return __builtin_amdgcn_make_buffer_rsrc((void*)base, 0, (int)bytes, 0x00020000); }
__device__ __forceinline__ void load_frag8(bf16x8 (&f)[8], rsrc_t rs, unsigned vo, unsigned so) {
#pragma unroll
    for (int i = 0; i < 8; ++i) f[i] = __builtin_bit_cast(bf16x8, __builtin_amdgcn_raw_buffer_load_b128(rs, vo + i * 1024, so, 0));
}
__device__ __forceinline__ void qk_tile(f32x16& p0, f32x16& p1, const bf16x8 (&kf)[8], const LAS bf16x8* qs, const float cinit) {
    bf16x8 qr[4];
#pragma unroll
    for (int d0 = 0; d0 < 4; ++d0) qr[d0] = qs[d0 * 64];
    f32x16 c;
#pragma unroll
    for (int r = 0; r < 16; ++r) c[r] = cinit;
    p0 = MFMA32(kf[0], qr[0], c); p1 = MFMA32(kf[4], qr[0], c);
#pragma unroll
    for (int d0 = 1; d0 < 4; ++d0) { p0 = MFMA32(kf[d0], qr[d0], p0); p1 = MFMA32(kf[4 + d0], qr[d0], p1); }
}
__device__ __forceinline__ void qk_tile_lo(f32x16& p0, f32x16& p1, rsrc_t rs, unsigned vo, unsigned so, const LAS bf16x8* qs, const float cinit) {
    bf16x8 qr[4];
#pragma unroll
    for (int d0 = 0; d0 < 4; ++d0) qr[d0] = qs[d0 * 64];
#pragma unroll
    for (int r = 0; r < 16; ++r) { p0[r] = cinit; p1[r] = cinit; }
    { bf16x8 kf[4];
#pragma unroll
      for (int d0 = 0; d0 < 4; ++d0) kf[d0] = __builtin_bit_cast(bf16x8, __builtin_amdgcn_raw_buffer_load_b128(rs, vo + d0 * 1024, so, 0));
#pragma unroll
      for (int d0 = 0; d0 < 4; ++d0) p0 = MFMA32(kf[d0], qr[d0], p0); }
    asm volatile("" : "+v"(p0) :: "memory");
    { bf16x8 kf[4];
#pragma unroll
      for (int d0 = 0; d0 < 4; ++d0) kf[d0] = __builtin_bit_cast(bf16x8, __builtin_amdgcn_raw_buffer_load_b128(rs, vo + (4 + d0) * 1024, so, 0));
#pragma unroll
      for (int d0 = 0; d0 < 4; ++d0) p1 = MFMA32(kf[d0], qr[d0], p1); }
}
__device__ __forceinline__ void mask_tile(f32x16& p0, f32x16& p1, int lo, int lim, int hi) {
#pragma unroll
    for (int r = 0; r < 16; ++r) { const int k0 = crow(r, hi);
        if (!(k0 > lo && k0 <= lim)) p0[r] = -INFINITY;
        if (!(k0 + 32 > lo && k0 + 32 <= lim)) p1[r] = -INFINITY; }
}
__device__ __forceinline__ void pack_p(bf16x8 (&pa)[4], const f32x16& p0, const f32x16& p1) {
    u32x4 w0, w1, w2, w3;
#pragma unroll
    for (int q = 0; q < 4; ++q) { w0[q] = cvtpk(p0[2 * q], p0[2 * q + 1]); w1[q] = cvtpk(p0[8 + 2 * q], p0[9 + 2 * q]);
                                  w2[q] = cvtpk(p1[2 * q], p1[2 * q + 1]); w3[q] = cvtpk(p1[8 + 2 * q], p1[9 + 2 * q]); }
    pa[0] = __builtin_bit_cast(bf16x8, w0); pa[1] = __builtin_bit_cast(bf16x8, w1); pa[2] = __builtin_bit_cast(bf16x8, w2); pa[3] = __builtin_bit_cast(bf16x8, w3);
}
__device__ __forceinline__ void pv_tile(f32x16& o0, f32x16& o1, const bf16x8 (&pa)[4], const bf16x8 (&vf)[8]) {
#pragma unroll
    for (int ks = 0; ks < 4; ++ks) { o0 = MFMA32(pa[ks], vf[ks], o0); o1 = MFMA32(pa[ks], vf[4 + ks], o1); }
}
struct Sm { float mhat, l; f32x16 o0, o1, ol; };
__device__ __forceinline__ void sm_init(Sm& st) { st.mhat = 0.f; st.l = 0.f;
#pragma unroll
    for (int r = 0; r < 16; ++r) { st.o0[r] = 0.f; st.o1[r] = 0.f; st.ol[r] = 0.f; } }
__device__ __forceinline__ void sm_tile(Sm& st, f32x16& s0, f32x16& s1, bool first, const bf16x8 (&vf)[8], LAS float* wsf, int r32, int hi) {
    const float rm = rowmax32(s0, s1, hi);
    const bool need = first || (__any(rm > 8.0f) != 0);
    if (need) {
        const float dl = first ? ((rm == -INFINITY) ? 0.f : rm) : fmaxf(rm, 0.f);
        st.mhat += dl;
#pragma unroll
        for (int r = 0; r < 16; ++r) { s0[r] -= dl; s1[r] -= dl; }
        if (!first) {
            const float f = __builtin_amdgcn_exp2f(-dl);
            LDS_WAIT(); asm volatile("" ::: "memory");
            if (hi == 0) wsf[r32] = f;
            LDS_WAIT(); asm volatile("" ::: "memory");
#pragma unroll
            for (int G = 0; G < 4; ++G) { const f32x4 ff = *(const LAS f32x4*)(wsf + 8 * G + 4 * hi);
#pragma unroll
                for (int q = 0; q < 4; ++q) { st.o0[4 * G + q] *= ff[q]; st.o1[4 * G + q] *= ff[q]; st.ol[4 * G + q] *= ff[q]; } }
            LDS_WAIT(); asm volatile("" ::: "memory");
        }
    }
#pragma unroll
    for (int r = 0; r < 16; ++r) { s0[r] = __builtin_amdgcn_exp2f(s0[r]); s1[r] = __builtin_amdgcn_exp2f(s1[r]); }
    bf16x8 pa[4]; pack_p(pa, s0, s1);
    const bf16x8 ones = (bf16x8){0x3F80, 0x3F80, 0x3F80, 0x3F80, 0x3F80, 0x3F80, 0x3F80, 0x3F80};
#pragma unroll
    for (int ks = 0; ks < 4; ++ks) { st.o0 = MFMA32(pa[ks], vf[ks], st.o0); st.o1 = MFMA32(pa[ks], vf[4 + ks], st.o1); st.ol = MFMA32(pa[ks], ones, st.ol); }
}
template <bool NORM>
__device__ __forceinline__ void flush_branch(const f32x16& o0, const f32x16& o1, const f32x16& ol, const float* GATE, bf16* O, int m0, int hq, int br, bool accumulate,
                                             LAS float* stg, int lane) {
    asm volatile("" : "+v"(lane));
    const int r32 = lane & 31, hi = lane >> 5;
    LDS_WAIT(); asm volatile("" ::: "memory");
#pragma unroll
    for (int r = 0; r < 16; ++r) { const float iv = NORM ? __builtin_amdgcn_rcpf(fmaxf(ol[r], 1e-30f)) : 1.f;
        stg[crow(r, hi) * STG_STRIDE + r32] = o0[r] * iv; stg[crow(r, hi) * STG_STRIDE + 32 + r32] = o1[r] * iv; }
    LDS_WAIT(); asm volatile("" ::: "memory");
#pragma unroll
    for (int i = 0; i < 4; ++i) { const int row = i * 8 + (lane >> 3), ch = lane & 7;
        const f32x4 a = *(const LAS f32x4*)(stg + row * STG_STRIDE + ch * 8), b = *(const LAS f32x4*)(stg + row * STG_STRIDE + ch * 8 + 4);
        const float sc = GATE[(size_t)(m0 + row) * 48 + hq * 3 + br];
        bf16* op = O + (size_t)(m0 + row) * DM + hq * 64 + ch * 8;
        f32x4 x = a * sc, y = b * sc;
        if (accumulate) { const u32x4 old = *(const u32x4*)op; x += (f32x4){bflo(old.x), bfhi(old.x), bflo(old.y), bfhi(old.y)}; y += (f32x4){bflo(old.z), bfhi(old.z), bflo(old.w), bfhi(old.w)}; }
        u32x4 w; w.x = pk2(x[0], x[1]); w.y = pk2(x[2], x[3]); w.z = pk2(y[0], y[1]); w.w = pk2(y[2], y[3]);
        *(u32x4*)op = w; }
    LDS_WAIT(); asm volatile("" ::: "memory");
}
__device__ __forceinline__ void load_q(LAS bf16x8* qs, const bf16* Q, int m, int hq, int hi) {
    LDS_WAIT(); asm volatile("" ::: "memory");
#pragma unroll
    for (int d0 = 0; d0 < 4; ++d0) qs[d0 * 64] = *(const bf16x8*)(Q + (size_t)m * DM + hq * 64 + d0 * 16 + hi * 8);
    LDS_WAIT(); asm volatile("" ::: "memory");
}
__device__ __forceinline__ void p_attn_cmp(Frame& F) {
    LAS float* stg = (LAS float*)(F.lds + F.wave * 16384); LAS float* wsf = stg + 32 * STG_STRIDE;
    const bf16* Q = (const bf16*)(F.wsp() + WS_Q); const float* GATE = (const float*)(F.wsp() + WS_GATE); bf16* O = (bf16*)(F.wsp() + WS_O);
    unsigned long long* MASK = (unsigned long long*)(F.wsp() + WS_MASK);
    for (int it = F.gw; it < 16 * 128; it += F.NGW) {
        const int bh = it >> 7, blk = 127 - (it & 127), b = bh >> 2, hk = bh & 3, m0 = b * SEQ + blk * 32;
        const rsrc_t rs = make_rsrc(F.wsp() + WS_KC, 1u << 20);
        const unsigned soK = (unsigned)bh * 32768u, soV = 524288u + (unsigned)bh * 32768u;
        const int nvmax = ((blk * 32) >> 4) + 1, ntc = (nvmax + 63) >> 6;
        float mref0 = 0.f, mref1 = 0.f, mref2 = 0.f, mref3 = 0.f, inv0 = 0.f, inv1 = 0.f, inv2 = 0.f, inv3 = 0.f;
#pragma unroll 1
        for (int g = 0; g < 4; ++g) {
            int lane = F.lane; asm volatile("" : "+v"(lane));
            const int r32 = lane & 31, hi = lane >> 5, t = blk * 32 + r32, nvr = t >= 31 ? ((t - 31) >> 4) + 1 : 0;
            LAS bf16x8* qr = (LAS bf16x8*)(wsf + 64) + lane; load_q(qr, Q, m0 + r32, hk * 4 + g, hi);
            float mrun = -INFINITY, l = 0.f;
#pragma unroll 1
            for (int i = 0; i < ntc; ++i) {
                f32x16 s0, s1; qk_tile_lo(s0, s1, rs, (unsigned)lane * 16u, soK + (unsigned)i * 8192u, qr, 0.f); mask_tile(s0, s1, -1, nvr - 1 - 64 * i, hi);
                const float rm = rowmax32(s0, s1, hi), mn = fmaxf(mrun, rm), mr = (mn == -INFINITY) ? 0.f : mn;
                float sum = 0.f;
#pragma unroll
                for (int r = 0; r < 16; ++r) sum += __builtin_amdgcn_exp2f(s0[r] - mr) + __builtin_amdgcn_exp2f(s1[r] - mr);
                l = l * __builtin_amdgcn_exp2f(mrun - mr) + sum; mrun = mn;
            }
            const float ltot = l + partner32(l, hi);
            const float iv = 1.f / fmaxf(ltot, 1e-30f), mr_ = (mrun == -INFINITY) ? 0.f : mrun;
            if (g == 0) { inv0 = iv; mref0 = mr_; } else if (g == 1) { inv1 = iv; mref1 = mr_; } else if (g == 2) { inv2 = iv; mref2 = mr_; } else { inv3 = iv; mref3 = mr_; }
        }
        {
            float imp[32];
#pragma unroll
            for (int k = 0; k < 32; ++k) imp[k] = 0.f;
#pragma unroll 1
            for (int g = 0; g < 4; ++g) {
                int lane = F.lane; asm volatile("" : "+v"(lane));
                const int r32 = lane & 31, hi = lane >> 5, t = blk * 32 + r32, nvr = t >= 31 ? ((t - 31) >> 4) + 1 : 0;
                LAS bf16x8* qr = (LAS bf16x8*)(wsf + 64) + lane; load_q(qr, Q, m0 + r32, hk * 4 + g, hi);
                const float invg = g == 0 ? inv0 : g == 1 ? inv1 : g == 2 ? inv2 : inv3, mg = g == 0 ? mref0 : g == 1 ? mref1 : g == 2 ? mref2 : mref3;
#pragma unroll
                for (int i = 0; i < 4; ++i) if (i < ntc) {
                    asm volatile("" ::: "memory");
                    f32x16 s0, s1; qk_tile_lo(s0, s1, rs, (unsigned)lane * 16u, soK + (unsigned)i * 8192u, qr, -mg); mask_tile(s0, s1, -1, nvr - 1 - 64 * i, hi);
#pragma unroll
                    for (int r = 0; r < 16; ++r) { s0[r] = __builtin_amdgcn_exp2f(s0[r]) * invg; s1[r] = __builtin_amdgcn_exp2f(s1[r]) * invg; }
#pragma unroll
                    for (int G = 0; G < 4; ++G) {
                        { const int kq = 8 * i + G; const float e = s0[4 * G + 3], pe = partner32(e, hi);
                          imp[kq] += (s0[4 * G] + s0[4 * G + 1]) + s0[4 * G + 2] + 0.5f * e + (hi ? 0.5f * pe : 0.f);
                          if (kq + 1 < 32) imp[kq + 1] += hi ? 0.f : 0.5f * pe; }
                        { const int kq = 8 * i + 4 + G; const float e = s1[4 * G + 3], pe = partner32(e, hi);
                          imp[kq] += (s1[4 * G] + s1[4 * G + 1]) + s1[4 * G + 2] + 0.5f * e + (hi ? 0.5f * pe : 0.f);
                          if (kq + 1 < 32) imp[kq + 1] += hi ? 0.f : 0.5f * pe; }
                    }
                }
            }
            int lane = F.lane; asm volatile("" : "+v"(lane));
            const int r32 = lane & 31, hi = lane >> 5, cur = (blk * 32 + r32) >> 6;
            LDS_WAIT(); asm volatile("" ::: "memory");
#pragma unroll
            for (int k = 0; k < 32; ++k) { const int j = 2 * k + hi; const bool allowed = j <= cur, forced = allowed && (j == 0 || j == cur || j == cur - 1);
                stg[r32 * STG_STRIDE + j] = forced ? 1e9f : (allowed ? imp[k] : -1e30f); }
            LDS_WAIT(); asm volatile("" ::: "memory");
        }
        {
            int lane = F.lane; asm volatile("" : "+v"(lane));
            unsigned long long mymask = 0ull;
#pragma unroll 1
            for (int tok = 0; tok < 32; ++tok) {
                const float sc = stg[tok * STG_STRIDE + lane]; int rank = 0;
#pragma unroll
                for (int q = 0; q < 16; ++q) { const f32x4 v = *(const LAS f32x4*)(stg + tok * STG_STRIDE + 4 * q);
#pragma unroll
                    for (int e = 0; e < 4; ++e) rank += (v[e] > sc || (v[e] == sc && (4 * q + e) < lane)) ? 1 : 0; }
                const unsigned long long mk = __ballot(rank < 16 && sc > -0.5e30f);
                mymask = (lane == tok) ? mk : mymask;
            }
            if (lane < 32) MASK[(size_t)bh * SEQ + blk * 32 + lane] = mymask;
            LDS_WAIT(); asm volatile("" ::: "memory");
        }
#pragma unroll 1
        for (int g = 0; g < 4; ++g) {
            int lane = F.lane; asm volatile("" : "+v"(lane));
            const int r32 = lane & 31, hi = lane >> 5, t = blk * 32 + r32, nvr = t >= 31 ? ((t - 31) >> 4) + 1 : 0;
            LAS bf16x8* qr = (LAS bf16x8*)(wsf + 64) + lane; load_q(qr, Q, m0 + r32, hk * 4 + g, hi);
            const float invg = g == 0 ? inv0 : g == 1 ? inv1 : g == 2 ? inv2 : inv3, mg = g == 0 ? mref0 : g == 1 ? mref1 : g == 2 ? mref2 : mref3;
            f32x16 o0, o1;
#pragma unroll
            for (int r = 0; r < 16; ++r) { o0[r] = 0.f; o1[r] = 0.f; }
#pragma unroll 1
            for (int i = 0; i < ntc; ++i) {
                f32x16 s0, s1; qk_tile_lo(s0, s1, rs, (unsigned)lane * 16u, soK + (unsigned)i * 8192u, qr, -mg); mask_tile(s0, s1, -1, nvr - 1 - 64 * i, hi);
#pragma unroll
                for (int r = 0; r < 16; ++r) { s0[r] = __builtin_amdgcn_exp2f(s0[r]) * invg; s1[r] = __builtin_amdgcn_exp2f(s1[r]) * invg; }
                bf16x8 pa[4]; pack_p(pa, s0, s1);
                bf16x8 vf[8]; load_frag8(vf, rs, (unsigned)lane * 16u, soV + (unsigned)i * 8192u); pv_tile(o0, o1, pa, vf);
            }
            flush_branch<false>(o0, o1, o0, GATE, O, m0, hk * 4 + g, 0, false, stg, lane);
        }
    }
}
__device__ __forceinline__ void attn_main_item(Frame& F, int bh, int g, int blk, LAS float* stg, LAS float* wsf) {
    const bf16* Q = (const bf16*)(F.wsp() + WS_Q); const float* GATE = (const float*)(F.wsp() + WS_GATE); bf16* O = (bf16*)(F.wsp() + WS_O);
    const rsrc_t rs = make_rsrc(F.wsp() + WS_KV, (unsigned)(6 * KVBUF_ELEMS * 2));
    int lane = F.lane; asm volatile("" : "+v"(lane));
    const int r32 = lane & 31, hi = lane >> 5;
    const unsigned vo = (unsigned)lane * 16u;
    const int b = bh >> 2, hk = bh & 3, hq = hk * 4 + g, m0 = b * SEQ + blk * 32, c = blk >> 1, ql = (blk & 1) * 32 + r32;
    LAS bf16x8* qr = (LAS bf16x8*)(wsf + 64) + lane; load_q(qr, Q, m0 + r32, hq, hi);
    const unsigned long long mask = ((const unsigned long long*)(F.wsp() + WS_MASK))[(size_t)bh * SEQ + blk * 32 + r32];
    bf16x8 kf[8], vf[8];
    {
        const unsigned soK = (unsigned)((2 * KVBUF_ELEMS + (size_t)bh * KVROWS * 64) * 2), soV = (unsigned)((3 * KVBUF_ELEMS + (size_t)bh * KVROWS * 64) * 2);
        Sm st; sm_init(st);
        load_frag8(kf, rs, vo, soK);
#pragma unroll 1
        for (int j = 0; j <= c; ++j) {
            const bool sel = ((mask >> j) & 1ull) != 0ull;
            f32x16 s0, s1; qk_tile(s0, s1, kf, qr, sel ? -st.mhat : -INFINITY);
            asm volatile("" : "+v"(s0), "+v"(s1) :: "memory");
            load_frag8(vf, rs, vo, soV + (unsigned)j * 8192u);
            load_frag8(kf, rs, vo, soK + (unsigned)(j < c ? j + 1 : c) * 8192u);
            if (j == c) mask_tile(s0, s1, -1, ql, hi);
            sm_tile(st, s0, s1, j == 0, vf, wsf, r32, hi);
            asm volatile("" : "+v"(st.o0), "+v"(st.o1), "+v"(st.ol) :: "memory");
        }
        flush_branch<true>(st.o0, st.o1, st.ol, GATE, O, m0, hq, 1, true, stg, lane);
    }
    {
        const unsigned soK = (unsigned)((4 * KVBUF_ELEMS + (size_t)bh * KVROWS * 64) * 2), soV = (unsigned)((5 * KVBUF_ELEMS + (size_t)bh * KVROWS * 64) * 2);
        Sm st; sm_init(st);
        const int j0 = c >= 8 ? c - 8 : 0;
        load_frag8(kf, rs, vo, soK + (unsigned)j0 * 8192u);
#pragma unroll 1
        for (int j = j0; j <= c; ++j) {
            f32x16 s0, s1; qk_tile(s0, s1, kf, qr, -st.mhat);
            asm volatile("" : "+v"(s0), "+v"(s1) :: "memory");
            load_frag8(vf, rs, vo, soV + (unsigned)j * 8192u);
            load_frag8(kf, rs, vo, soK + (unsigned)(j < c ? j + 1 : c) * 8192u);
            if (j == c || j + 8 == c) mask_tile(s0, s1, (j + 8 == c) ? ql : -1, (j == c) ? ql : 63, hi);
            sm_tile(st, s0, s1, j == j0, vf, wsf, r32, hi);
            asm volatile("" : "+v"(st.o0), "+v"(st.o1), "+v"(st.ol) :: "memory");
        }
        flush_branch<true>(st.o0, st.o1, st.ol, GATE, O, m0, hq, 2, true, stg, lane);
    }
}
__device__ __forceinline__ void p_attn_main(Frame& F) {
    LAS float* stg = (LAS float*)(F.lds + F.wave * 16384); LAS float* wsf = stg + 32 * STG_STRIDE;
    for (int P = F.gw; P < 4096; P += F.NGW) {
        const int bh = P >> 8, rem = P & 255, g = rem & 3, k = rem >> 2;
        attn_main_item(F, bh, g, 127 - k, stg, wsf);
        attn_main_item(F, bh, g, k, stg, wsf);
    }
}
constexpr int AT_SLOT = 16384, AT_NSLOT = 4, AT_PW_OFF = AT_NSLOT * AT_SLOT, AT_PW_BYTES = STG_BYTES + 256 + 384, AT_MASK_OFF = AT_PW_OFF + 8 * AT_PW_BYTES;
static_assert(AT_MASK_OFF + 512 <= LDSCTL_OFF, "attention LDS map");
#define AT_WAIT_BAR(N) asm volatile("s_waitcnt vmcnt(" #N ") lgkmcnt(0)\n\ts_barrier" ::: "memory")
__device__ __forceinline__ void at_dma(const char* g, LAS unsigned char* l) { __builtin_amdgcn_global_load_lds((const unsigned*)g, (LAS unsigned*)l, 16, 0, 0); }
__device__ __forceinline__ void qk_tile_reg(f32x16& p0, f32x16& p1, const LAS unsigned char* ks, const bf16x8 (&qr)[4], const float cinit) {
    bf16x8 kf[8];
#pragma unroll
    for (int f = 0; f < 8; ++f) kf[f] = *(const LAS bf16x8*)(ks + f * 1024);
    __builtin_amdgcn_sched_barrier(0);
    f32x16 c;
#pragma unroll
    for (int r = 0; r < 16; ++r) c[r] = cinit;
    p0 = MFMA32(kf[0], qr[0], c); p1 = MFMA32(kf[4], qr[0], c);
#pragma unroll
    for (int d0 = 1; d0 < 4; ++d0) { p0 = MFMA32(kf[d0], qr[d0], p0); p1 = MFMA32(kf[4 + d0], qr[d0], p1); }
}
template <int V>
__device__ __forceinline__ void sm_tile_lds(Sm& st, f32x16& s0, f32x16& s1, bool first, const LAS unsigned char* vs, LAS float* wsf, int r32, int hi) {
    const float rm = rowmax32(s0, s1, hi);
    const bool need = first || (__any(rm > 8.0f) != 0);
    if (need) {
        const float dl = first ? ((rm == -INFINITY) ? 0.f : rm) : fmaxf(rm, 0.f);
        st.mhat += dl;
#pragma unroll
        for (int r = 0; r < 16; ++r) { s0[r] -= dl; s1[r] -= dl; }
        if (!first) {
            const float f = __builtin_amdgcn_exp2f(-dl);
            LDS_WAIT(); asm volatile("" ::: "memory");
            if (hi == 0) wsf[r32] = f;
            LDS_WAIT(); asm volatile("" ::: "memory");
#pragma unroll
            for (int G = 0; G < 4; ++G) { const f32x4 ff = *(const LAS f32x4*)(wsf + 8 * G + 4 * hi);
#pragma unroll
                for (int q = 0; q < 4; ++q) { st.o0[4 * G + q] *= ff[q]; st.o1[4 * G + q] *= ff[q]; st.ol[4 * G + q] *= ff[q]; } }
            LDS_WAIT(); asm volatile("" ::: "memory");
        }
    }
    bf16x8 vf[8];
#pragma unroll
    for (int f = 0; f < 8; ++f) vf[f] = *(const LAS bf16x8*)(vs + f * 1024);
    __builtin_amdgcn_sched_barrier(0);
    if (V != 2) {
#pragma unroll
    for (int r = 0; r < 16; ++r) { s0[r] = __builtin_amdgcn_exp2f(s0[r]); s1[r] = __builtin_amdgcn_exp2f(s1[r]); } }
    bf16x8 pa[4]; pack_p(pa, s0, s1);
    const bf16x8 ones = (bf16x8){0x3F80, 0x3F80, 0x3F80, 0x3F80, 0x3F80, 0x3F80, 0x3F80, 0x3F80};
    if (V != 3) {
#pragma unroll
    for (int ks = 0; ks < 4; ++ks) { st.o0 = MFMA32(pa[ks], vf[ks], st.o0); st.o1 = MFMA32(pa[ks], vf[4 + ks], st.o1); st.ol = MFMA32(pa[ks], ones, st.ol); }
    } else { asm volatile("" :: "v"(pa[0]), "v"(pa[1]), "v"(pa[2]), "v"(pa[3]), "v"(vf[0]), "v"(vf[1]), "v"(vf[2]), "v"(vf[3]), "v"(vf[4]), "v"(vf[5]), "v"(vf[6]), "v"(vf[7])); }
}
template <bool WIN, int V>
__device__ __forceinline__ void at_branch(Sm& st, const char* Kg, const char* Vg, int j0, int c, int ql, unsigned long long mask, const bf16x8 (&qr)[4],
                                          LAS unsigned char* ring, LAS float* wsf, int wave, int lane) {
    const int r32 = lane & 31, hi = lane >> 5, n = c - j0 + 1;
    LAS unsigned char* dk = ring + wave * 1024;
    const LAS unsigned char* rd = ring + lane * 16;
#pragma unroll
    for (int d = 0; d < 3; ++d) if (d < n) { at_dma(Kg + (size_t)(j0 + d) * 8192, dk + d * AT_SLOT); at_dma(Vg + (size_t)(j0 + d) * 8192, dk + d * AT_SLOT + 8192); }
#pragma unroll 1
    for (int t = 0; t < n; ++t) {
        const int rem = n - 1 - t;
        if (V != 1) { if (rem >= 2) AT_WAIT_BAR(4); else if (rem == 1) AT_WAIT_BAR(2); else AT_WAIT_BAR(0); }
        if (t + 3 < n) { const int sl = (t + 3) & 3; at_dma(Kg + (size_t)(j0 + t + 3) * 8192, dk + sl * AT_SLOT); at_dma(Vg + (size_t)(j0 + t + 3) * 8192, dk + sl * AT_SLOT + 8192); }
        const int j = j0 + t; const LAS unsigned char* slot = rd + (t & 3) * AT_SLOT;
        const bool sel = WIN ? true : (((mask >> j) & 1ull) != 0ull);
        f32x16 s0, s1;
        if (V != 4) qk_tile_reg(s0, s1, slot, qr, sel ? -st.mhat : -INFINITY);
        else {
#pragma unroll
            for (int r = 0; r < 16; ++r) { s0[r] = sel ? -st.mhat : -1.f; s1[r] = s0[r]; } asm volatile("" : "+v"(s0), "+v"(s1)); }
        if (WIN) { if (j == c || j + 8 == c) mask_tile(s0, s1, (j + 8 == c) ? ql : -1, (j == c) ? ql : 63, hi); }
        else { if (j == c) mask_tile(s0, s1, -1, ql, hi); }
        sm_tile_lds<V>(st, s0, s1, t == 0, slot + 8192, wsf, r32, hi);
    }
}
#define AT_PIN(x) asm volatile("" : "+v"(x))
#define AT_GAPA(MF, P, B, W, I) do { MF; lsum += (P[B] + P[B + 1]) + (P[B + 2] + P[B + 3]); W[I] = cvtpk(P[B], P[B + 1]); W[I + 1] = cvtpk(P[B + 2], P[B + 3]); \
        AT_PIN(lsum); AT_PIN(W); __builtin_amdgcn_sched_barrier(0); } while (0)
#define AT_GAPB(MF, C, B) do { MF; C[B] = __builtin_amdgcn_exp2f(C[B]); C[B + 1] = __builtin_amdgcn_exp2f(C[B + 1]); C[B + 2] = __builtin_amdgcn_exp2f(C[B + 2]); C[B + 3] = __builtin_amdgcn_exp2f(C[B + 3]); \
        AT_PIN(C); __builtin_amdgcn_sched_barrier(0); } while (0)
template <bool WIN>
__device__ __forceinline__ void at_branch_pipe(Sm& st, const char* Kg, const char* Vg, int j0, int c, int ql, unsigned long long mask, const bf16x8 (&qr)[4],
                                               LAS unsigned char* ring, LAS float* wsf, int wave, int lane) {
    const int r32 = lane & 31, hi = lane >> 5, n = c - j0 + 1;
    LAS unsigned char* dk = ring + wave * 1024;
    const LAS unsigned char* rd = ring + lane * 16;
#pragma unroll
    for (int d = 0; d < 2; ++d) if (d < n) { at_dma(Kg + (size_t)(j0 + d) * 8192, dk + d * AT_SLOT); at_dma(Vg + (size_t)(j0 + d) * 8192, dk + d * AT_SLOT + 8192); }
    if (n > 1) AT_WAIT_BAR(2); else AT_WAIT_BAR(0);
    if (2 < n) { at_dma(Kg + (size_t)(j0 + 2) * 8192, dk + 2 * AT_SLOT); at_dma(Vg + (size_t)(j0 + 2) * 8192, dk + 2 * AT_SLOT + 8192); }
    f32x16 p0, p1;
    { const bool sel = WIN ? true : ((mask >> j0) & 1ull) != 0ull;
      qk_tile_reg(p0, p1, rd, qr, sel ? 0.f : -INFINITY);
      if (WIN) { if (j0 == c || j0 + 8 == c) mask_tile(p0, p1, (j0 + 8 == c) ? ql : -1, (j0 == c) ? ql : 63, hi); }
      else { if (j0 == c) mask_tile(p0, p1, -1, ql, hi); }
      const float rm = rowmax32(p0, p1, hi), dl = (rm == -INFINITY) ? 0.f : rm;
      st.mhat = dl;
#pragma unroll
      for (int r = 0; r < 16; ++r) { p0[r] = __builtin_amdgcn_exp2f(p0[r] - dl); p1[r] = __builtin_amdgcn_exp2f(p1[r] - dl); } }
#pragma unroll 1
    for (int t = 1; t < n; ++t) {
        if (t + 1 < n) AT_WAIT_BAR(2); else AT_WAIT_BAR(0);
        if (t + 2 < n) { const int sl = (t + 2) & 3; at_dma(Kg + (size_t)(j0 + t + 2) * 8192, dk + sl * AT_SLOT); at_dma(Vg + (size_t)(j0 + t + 2) * 8192, dk + sl * AT_SLOT + 8192); }
        const int j = j0 + t;
        const bool sel = WIN ? true : ((mask >> j) & 1ull) != 0ull;
        const LAS unsigned char* ks = rd + (t & 3) * AT_SLOT; const LAS unsigned char* vs = rd + ((t - 1) & 3) * AT_SLOT + 8192;
        bf16x8 kf[8], vf[8];
#pragma unroll
        for (int f = 0; f < 8; ++f) kf[f] = *(const LAS bf16x8*)(ks + f * 1024);
        f32x16 cv; { const float ci = sel ? -st.mhat : -INFINITY;
#pragma unroll
            for (int r = 0; r < 16; ++r) cv[r] = ci; }
        __builtin_amdgcn_sched_barrier(0);
        f32x16 c0, c1; u32x4 w0, w1, w2, w3; float lsum = 0.f;
        AT_GAPA(c0 = MFMA32(kf[0], qr[0], cv), p0, 0, w0, 0);
        AT_GAPA(c1 = MFMA32(kf[4], qr[0], cv), p0, 4, w0, 2);
        AT_GAPA(c0 = MFMA32(kf[1], qr[1], c0), p0, 8, w1, 0);
        AT_GAPA(c1 = MFMA32(kf[5], qr[1], c1), p0, 12, w1, 2);
#pragma unroll
        for (int f = 0; f < 8; ++f) vf[f] = *(const LAS bf16x8*)(vs + f * 1024);
        __builtin_amdgcn_sched_barrier(0);
        AT_GAPA(c0 = MFMA32(kf[2], qr[2], c0), p1, 0, w2, 0);
        AT_GAPA(c1 = MFMA32(kf[6], qr[2], c1), p1, 4, w2, 2);
        AT_GAPA(c0 = MFMA32(kf[3], qr[3], c0), p1, 8, w3, 0);
        AT_GAPA(c1 = MFMA32(kf[7], qr[3], c1), p1, 12, w3, 2);
        st.l += lsum;
        if (WIN) { if (j == c || j + 8 == c) mask_tile(c0, c1, (j + 8 == c) ? ql : -1, (j == c) ? ql : 63, hi); }
        else { if (j == c) mask_tile(c0, c1, -1, ql, hi); }
        const float rm = rowmax32(c0, c1, hi);
        const bool resc = (__any(rm > 8.0f) != 0);
        if (resc) { const float dl = fmaxf(rm, 0.f); st.mhat += dl;
#pragma unroll
            for (int r = 0; r < 16; ++r) { c0[r] -= dl; c1[r] -= dl; }
            const float f = __builtin_amdgcn_exp2f(-dl); st.l *= f;
            LDS_WAIT(); asm volatile("" ::: "memory");
            if (hi == 0) wsf[r32] = f; }
        __builtin_amdgcn_sched_barrier(0);
        { const bf16x8 a0 = __builtin_bit_cast(bf16x8, w0), a1 = __builtin_bit_cast(bf16x8, w1), a2 = __builtin_bit_cast(bf16x8, w2), a3 = __builtin_bit_cast(bf16x8, w3);
          AT_GAPB(st.o0 = MFMA32(a0, vf[0], st.o0), c0, 0);
          AT_GAPB(st.o1 = MFMA32(a0, vf[4], st.o1), c0, 4);
          AT_GAPB(st.o0 = MFMA32(a1, vf[1], st.o0), c0, 8);
          AT_GAPB(st.o1 = MFMA32(a1, vf[5], st.o1), c0, 12);
          AT_GAPB(st.o0 = MFMA32(a2, vf[2], st.o0), c1, 0);
          AT_GAPB(st.o1 = MFMA32(a2, vf[6], st.o1), c1, 4);
          AT_GAPB(st.o0 = MFMA32(a3, vf[3], st.o0), c1, 8);
          AT_GAPB(st.o1 = MFMA32(a3, vf[7], st.o1), c1, 12); }
        if (resc) {
            LDS_WAIT(); asm volatile("" ::: "memory");
#pragma unroll
            for (int G = 0; G < 4; ++G) { const f32x4 ff = *(const LAS f32x4*)(wsf + 8 * G + 4 * hi);
#pragma unroll
                for (int q = 0; q < 4; ++q) { st.o0[4 * G + q] *= ff[q]; st.o1[4 * G + q] *= ff[q]; } }
            LDS_WAIT(); asm volatile("" ::: "memory"); }
        p0 = c0; p1 = c1;
    }
    { float lsum = 0.f;
#pragma unroll
      for (int r = 0; r < 16; ++r) lsum += p0[r] + p1[r];
      st.l += lsum;
      bf16x8 pa[4]; pack_p(pa, p0, p1);
      bf16x8 vf[8]; const LAS unsigned char* vs = rd + ((n - 1) & 3) * AT_SLOT + 8192;
#pragma unroll
      for (int f = 0; f < 8; ++f) vf[f] = *(const LAS bf16x8*)(vs + f * 1024);
      pv_tile(st.o0, st.o1, pa, vf); }
    { const float lt = st.l + partner32(st.l, hi);
      LDS_WAIT(); asm volatile("" ::: "memory");
      if (hi == 0) wsf[r32] = lt;
      LDS_WAIT(); asm volatile("" ::: "memory");
#pragma unroll
      for (int G = 0; G < 4; ++G) { const f32x4 ff = *(const LAS f32x4*)(wsf + 8 * G + 4 * hi);
#pragma unroll
          for (int q = 0; q < 4; ++q) st.ol[4 * G + q] = ff[q]; }
      LDS_WAIT(); asm volatile("" ::: "memory"); }
}
template <bool DRY, int V>
__device__ __forceinline__ void attn_unit(Frame& F, int bh, int c) {
    const bf16* Q = (const bf16*)(F.wsp() + WS_Q); const float* GATE = (const float*)(F.wsp() + WS_GATE); bf16* O = (bf16*)(F.wsp() + (DRY ? WS_Y0 : WS_O));
    const int wave = F.wave, g = wave >> 1, th = wave & 1;
    int lane = F.lane; asm volatile("" : "+v"(lane));
    const int r32 = lane & 31, hi = lane >> 5;
    const int b = bh >> 2, hk = bh & 3, hq = hk * 4 + g, m0 = b * SEQ + c * 64 + th * 32, t = c * 64 + th * 32 + r32, ql = th * 32 + r32;
    LAS unsigned char* ring = F.lds;
    LAS float* stg = (LAS float*)(F.lds + AT_PW_OFF + wave * AT_PW_BYTES); LAS float* wsf = stg + 32 * STG_STRIDE;
    LAS unsigned long long* masks = (LAS unsigned long long*)(F.lds + AT_MASK_OFF);
    const size_t lofs = (size_t)wave * 1024 + (size_t)lane * 16;
    bf16x8 qr[4];
#pragma unroll
    for (int d0 = 0; d0 < 4; ++d0) qr[d0] = *(const bf16x8*)(Q + (size_t)(m0 + r32) * DM + hq * 64 + d0 * 16 + hi * 8);
    LAS float* gl = wsf + 64;
    if (hi == 0) { const float* gp = GATE + (size_t)(m0 + r32) * 48 + hq * 3; gl[r32] = gp[0]; gl[32 + r32] = gp[1]; gl[64 + r32] = gp[2]; }
    const int nvr = t >= 31 ? ((t - 31) >> 4) + 1 : 0, ntc = (4 * c + 3 + 63) >> 6;
    f32x16 oc0, oc1;
    {
        const char* KCg = (const char*)(F.wsp() + WS_KC) + (size_t)bh * 32768 + lofs; const char* VCg = (const char*)(F.wsp() + WS_VC) + (size_t)bh * 32768 + lofs;
        asm volatile("s_waitcnt vmcnt(0)" ::: "memory");
        for (int i = 0; i < ntc; ++i) { at_dma(KCg + (size_t)i * 8192, ring + i * AT_SLOT + wave * 1024); at_dma(VCg + (size_t)i * 8192, ring + i * AT_SLOT + 8192 + wave * 1024); }
        AT_WAIT_BAR(0);
        const LAS unsigned char* rd = ring + lane * 16;
        float mhat = 0.f, l = 0.f;
        float imp[32];
#pragma unroll
        for (int k = 0; k < 32; ++k) imp[k] = 0.f;
        f32x16 o0, o1;
#pragma unroll
        for (int r = 0; r < 16; ++r) { o0[r] = 0.f; o1[r] = 0.f; }
#pragma unroll
        for (int i = 0; i < 4; ++i) if (i < ntc) {
            asm volatile("" ::: "memory");
            f32x16 s0, s1; qk_tile_reg(s0, s1, rd + i * AT_SLOT, qr, -mhat); mask_tile(s0, s1, -1, nvr - 1 - 64 * i, hi);
            const float rm = rowmax32(s0, s1, hi);
            if (i == 0) { const float dl = (rm == -INFINITY) ? 0.f : rm; mhat = dl;
#pragma unroll
                for (int r = 0; r < 16; ++r) { s0[r] -= dl; s1[r] -= dl; } }
            else if (__any(rm > 8.0f) != 0) { const float dl = fmaxf(rm, 0.f); mhat += dl;
#pragma unroll
                for (int r = 0; r < 16; ++r) { s0[r] -= dl; s1[r] -= dl; }
                const float f = __builtin_amdgcn_exp2f(-dl); l *= f;
#pragma unroll
                for (int k = 0; k < 32; ++k) imp[k] *= f;
                LDS_WAIT(); asm volatile("" ::: "memory");
                if (hi == 0) wsf[r32] = f;
                LDS_WAIT(); asm volatile("" ::: "memory");
#pragma unroll
                for (int G = 0; G < 4; ++G) { const f32x4 ff = *(const LAS f32x4*)(wsf + 8 * G + 4 * hi);
#pragma unroll
                    for (int q = 0; q < 4; ++q) { o0[4 * G + q] *= ff[q]; o1[4 * G + q] *= ff[q]; } }
                LDS_WAIT(); asm volatile("" ::: "memory"); }
            float sum = 0.f;
#pragma unroll
            for (int r = 0; r < 16; ++r) { s0[r] = __builtin_amdgcn_exp2f(s0[r]); s1[r] = __builtin_amdgcn_exp2f(s1[r]); sum += s0[r] + s1[r]; }
            l += sum;
#pragma unroll
            for (int G = 0; G < 4; ++G) {
                { const int kq = 8 * i + G; const float e = s0[4 * G + 3], pe = partner32(e, hi);
                  imp[kq] += (s0[4 * G] + s0[4 * G + 1]) + s0[4 * G + 2] + 0.5f * e + (hi ? 0.5f * pe : 0.f);
                  if (kq + 1 < 32) imp[kq + 1] += hi ? 0.f : 0.5f * pe; }
                { const int kq = 8 * i + 4 + G; const float e = s1[4 * G + 3], pe = partner32(e, hi);
                  imp[kq] += (s1[4 * G] + s1[4 * G + 1]) + s1[4 * G + 2] + 0.5f * e + (hi ? 0.5f * pe : 0.f);
                  if (kq + 1 < 32) imp[kq + 1] += hi ? 0.f : 0.5f * pe; }
            }
            bf16x8 pa[4]; pack_p(pa, s0, s1);
            { bf16x8 vf[4];
#pragma unroll
              for (int f = 0; f < 4; ++f) vf[f] = *(const LAS bf16x8*)(rd + i * AT_SLOT + 8192 + f * 1024);
#pragma unroll
              for (int ks = 0; ks < 4; ++ks) o0 = MFMA32(pa[ks], vf[ks], o0);
              asm volatile("" : "+v"(o0) :: "memory");
#pragma unroll
              for (int f = 0; f < 4; ++f) vf[f] = *(const LAS bf16x8*)(rd + i * AT_SLOT + 8192 + (4 + f) * 1024);
#pragma unroll
              for (int ks = 0; ks < 4; ++ks) o1 = MFMA32(pa[ks], vf[ks], o1); }
        }
        const float ltot = l + partner32(l, hi), inv = 1.f / fmaxf(ltot, 1e-30f);
#pragma unroll
        for (int k = 0; k < 32; ++k) imp[k] *= inv;
        LDS_WAIT(); asm volatile("" ::: "memory");
        if (hi == 0) wsf[r32] = gl[r32] * inv;
        LDS_WAIT(); asm volatile("" ::: "memory");
#pragma unroll
        for (int G = 0; G < 4; ++G) { const f32x4 gg = *(const LAS f32x4*)(wsf + 8 * G + 4 * hi);
#pragma unroll
            for (int q = 0; q < 4; ++q) { oc0[4 * G + q] = o0[4 * G + q] * gg[q]; oc1[4 * G + q] = o1[4 * G + q] * gg[q]; } }
        LDS_WAIT(); asm volatile("" ::: "memory");
#pragma unroll
        for (int k = 0; k < 32; ++k) stg[r32 * STG_STRIDE + 2 * k + hi] = imp[k];
    }
    AT_WAIT_BAR(0);
    const char* KSg = (const char*)(F.wsp() + WS_KV) + (2 * KVBUF_ELEMS + (size_t)bh * KVROWS * 64) * 2 + lofs;
    const char* VSg = (const char*)(F.wsp() + WS_KV) + (3 * KVBUF_ELEMS + (size_t)bh * KVROWS * 64) * 2 + lofs;
    if (c < 16) { if (lane < 8) masks[th * 32 + 8 * g + lane] = (2ull << c) - 1ull; }
    else {
        const LAS float* st0 = (const LAS float*)(F.lds + AT_PW_OFF + (0 * 2 + th) * AT_PW_BYTES); const LAS float* st1 = (const LAS float*)(F.lds + AT_PW_OFF + (1 * 2 + th) * AT_PW_BYTES);
        const LAS float* st2 = (const LAS float*)(F.lds + AT_PW_OFF + (2 * 2 + th) * AT_PW_BYTES); const LAS float* st3 = (const LAS float*)(F.lds + AT_PW_OFF + (3 * 2 + th) * AT_PW_BYTES);
        const bool allowed = lane <= c, forced = allowed && (lane == 0 || lane == c || lane == c - 1);
        LAS unsigned* kst = (LAS unsigned*)stg;
#pragma unroll 1
        for (int i = 0; i < 8; i += 2) {
            const int tokA = 8 * g + i, tokB = tokA + 1, aA = tokA * STG_STRIDE + lane, aB = tokB * STG_STRIDE + lane;
            const float vA = ((st0[aA] + st1[aA]) + st2[aA]) + st3[aA], vB = ((st0[aB] + st1[aB]) + st2[aB]) + st3[aB];
            const unsigned low = 63u - (unsigned)lane;
            const unsigned keyA = forced ? (0xFFFFFFC0u | low) : (allowed ? ((__builtin_bit_cast(unsigned, vA) & 0xFFFFFFC0u) | low) : 0u);
            const unsigned keyB = forced ? (0xFFFFFFC0u | low) : (allowed ? ((__builtin_bit_cast(unsigned, vB) & 0xFFFFFFC0u) | low) : 0u);
            LDS_WAIT(); asm volatile("" ::: "memory");
            kst[aA] = keyA; kst[aB] = keyB;
            LDS_WAIT(); asm volatile("" ::: "memory");
            int rankA = 0, rankB = 0;
#pragma unroll
            for (int q = 0; q < 16; ++q) { const u32x4 xa = *(const LAS u32x4*)(kst + tokA * STG_STRIDE + 4 * q), xb = *(const LAS u32x4*)(kst + tokB * STG_STRIDE + 4 * q);
#pragma unroll
                for (int e = 0; e < 4; ++e) { rankA += (xa[e] > keyA) ? 1 : 0; rankB += (xb[e] > keyB) ? 1 : 0; } }
            const unsigned long long mkA = __ballot(rankA < 16 && allowed), mkB = __ballot(rankB < 16 && allowed);
            if (lane == 0) { masks[th * 32 + tokA] = mkA; masks[th * 32 + tokB] = mkB; }
        }
    }
    AT_WAIT_BAR(0);
    const unsigned long long mask = masks[th * 32 + r32];
#pragma unroll
    for (int r = 0; r < 16; ++r) { stg[crow(r, hi) * STG_STRIDE + r32] = oc0[r]; stg[crow(r, hi) * STG_STRIDE + 32 + r32] = oc1[r]; }
    {
        Sm st; sm_init(st);
        if (V == 0) at_branch_pipe<false>(st, KSg, VSg, 0, c, ql, mask, qr, ring, wsf, wave, lane); else if (V != 5) at_branch<false, V>(st, KSg, VSg, 0, c, ql, mask, qr, ring, wsf, wave, lane);
        LDS_WAIT(); asm volatile("" ::: "memory");
#pragma unroll
        for (int G = 0; G < 4; ++G) { const f32x4 gg = *(const LAS f32x4*)(gl + 32 + 8 * G + 4 * hi);
#pragma unroll
            for (int q = 0; q < 4; ++q) { const int r = 4 * G + q; const float iv = gg[q] * __builtin_amdgcn_rcpf(fmaxf(st.ol[r], 1e-30f));
                stg[crow(r, hi) * STG_STRIDE + r32] += st.o0[r] * iv; stg[crow(r, hi) * STG_STRIDE + 32 + r32] += st.o1[r] * iv; } }
    }
    AT_WAIT_BAR(0);
    {
        const char* KWg = (const char*)(F.wsp() + WS_KV) + (4 * KVBUF_ELEMS + (size_t)bh * KVROWS * 64) * 2 + lofs;
        const char* VWg = (const char*)(F.wsp() + WS_KV) + (5 * KVBUF_ELEMS + (size_t)bh * KVROWS * 64) * 2 + lofs;
        Sm st; sm_init(st);
        if (V == 0) at_branch_pipe<true>(st, KWg, VWg, c >= 8 ? c - 8 : 0, c, ql, 0ull, qr, ring, wsf, wave, lane); else if (V != 5) at_branch<true, V>(st, KWg, VWg, c >= 8 ? c - 8 : 0, c, ql, 0ull, qr, ring, wsf, wave, lane);
        LDS_WAIT(); asm volatile("" ::: "memory");
#pragma unroll
        for (int G = 0; G < 4; ++G) { const f32x4 gg = *(const LAS f32x4*)(gl + 64 + 8 * G + 4 * hi);
#pragma unroll
            for (int q = 0; q < 4; ++q) { const int r = 4 * G + q; const float iv = gg[q] * __builtin_amdgcn_rcpf(fmaxf(st.ol[r], 1e-30f));
                stg[crow(r, hi) * STG_STRIDE + r32] += st.o0[r] * iv; stg[crow(r, hi) * STG_STRIDE + 32 + r32] += st.o1[r] * iv; } }
        LDS_WAIT(); asm volatile("" ::: "memory");
#pragma unroll
        for (int i = 0; i < 4; ++i) { const int row = i * 8 + (lane >> 3), ch = lane & 7;
            const f32x4 a = *(const LAS f32x4*)(stg + row * STG_STRIDE + ch * 8), b2 = *(const LAS f32x4*)(stg + row * STG_STRIDE + ch * 8 + 4);
            u32x4 w; w.x = pk2(a[0], a[1]); w.y = pk2(a[2], a[3]); w.z = pk2(b2[0], b2[1]); w.w = pk2(b2[2], b2[3]);
            *(u32x4*)(O + (size_t)(m0 + row) * DM + hq * 64 + ch * 8) = w; }
    }
    AT_WAIT_BAR(0);
}
template <bool DRY, int V>
__device__ __forceinline__ void p_attn_fused(Frame& F) {
    const int G = gridDim.x, bx = blockIdx.x, vcu = (G % 8 == 0) ? (bx % 8) * (G / 8) + bx / 8 : bx;
    for (int P = vcu; P < 512; P += G) {
        const int bh = P >> 5, k = P & 31;
#pragma unroll 1
        for (int h = 0; h < 2; ++h) attn_unit<DRY, V>(F, bh, h ? k : 63 - k);
    }
}
struct Args { const float* in[23]; float* out; unsigned char* ws; int ph_lo, ph_hi; };
__global__ void __launch_bounds__(512, 2) mk_fwd(Args args) {
    extern __shared__ __attribute__((aligned(16))) unsigned char lds[];
    Frame F;
    F.lds = (LAS unsigned char*)lds; F.MISC = (volatile LAS unsigned*)(F.lds + MISC_OFF);
    F.tid = threadIdx.x; F.lane = F.tid & 63; F.wave = __builtin_amdgcn_readfirstlane(F.tid >> 6);
    F.gw = blockIdx.x * 8 + F.wave; F.NGW = gridDim.x * 8;
    for (int u = F.tid; u < (LDS_BYTES - LDSCTL_OFF) / 4; u += 512) ((LAS unsigned*)(F.lds + LDSCTL_OFF))[u] = 0u;
    __syncthreads();
    if (F.tid < 25) { const unsigned long long v = F.tid < 23 ? (unsigned long long)args.in[F.tid] : F.tid == 23 ? (unsigned long long)args.out : (unsigned long long)args.ws;
        LAS unsigned* p = (LAS unsigned*)(F.lds + PTR_OFF) + 2 * F.tid; p[0] = (unsigned)v; p[1] = (unsigned)(v >> 32); }
    __syncthreads();
    XcdBarrier bar; bar.bar = (unsigned*)(F.ctlp() + CW_BAR); bar.x = 0; bar.st = nullptr;
    const int lo = args.ph_lo, hi = args.ph_hi;
    if (hi - lo > 1) bar = xcd_barrier_post((unsigned*)(F.ctlp() + CW_BAR), F.MISC + 8);
#ifdef PH_ONLY
#define IN(k) ((k) == PH_ONLY && lo <= (k) && (k) < hi)
#else
#define IN(k) (lo <= (k) && (k) < hi)
#endif
#define SEAM(k) do { if (IN(k) && (k) + 1 < hi) xcd_barrier(bar); } while (0)
    if (IN(0)) {
#pragma unroll 1
        for (int rep = 0; rep < REP0; ++rep) { p0_prologue(F); if (rep + 1 < REP0) xcd_barrier(bar); } } SEAM(0);
    if (IN(1)) {
#pragma unroll 1
        for (int rep = 0; rep < REP1; ++rep) { p1_mod_u0(F); if (rep + 1 < REP1) xcd_barrier(bar); }
#pragma unroll 1
        for (int rep = 0; rep < XBAR - 1; ++rep) xcd_barrier(bar); } SEAM(1);
    if (IN(2)) for (int rep = 0; rep < REP2; ++rep) {
        const char* A = (const char*)(F.wsp() + WS_U); const char* B = (const char*)(F.wsp() + WS_WIN);
        const pg8::SchedDense S{A, B, A, B + (size_t)1024 * DM * 2, T / 256, 4, 8, DM, (int)gridDim.x, (int)blockIdx.x, 256};
#if DRY2 == 1
        { pg8::gemm_phase<EpNull, pg8::SchedDense, true, false>(F.lds, DM, S, EpNull{}); xcd_barrier(bar); }
#elif DRY2 == 2
        { pg8::gemm_phase<EpG1, pg8::SchedDense, true, false>(F.lds, DM, S, EpG1{(bf16*)(F.wsp() + WS_Y0), (bf16*)(F.wsp() + WS_Y1)}); xcd_barrier(bar); }
#endif
        pg8::gemm_phase<EpG1, pg8::SchedDense, true, false>(F.lds, DM, S, EpG1{(bf16*)(F.wsp() + WS_BG), (bf16*)(F.wsp() + WS_Z)});
        if (rep + 1 < REP2) xcd_barrier(bar);
    } SEAM(2);
    if (IN(3)) {
#pragma unroll 1
        for (int rep = 0; rep < REP3; ++rep) { p3_conv(F); if (rep + 1 < REP3) xcd_barrier(bar); } } SEAM(3);
    if (IN(4)) for (int rep = 0; rep < REP4; ++rep) {
        const pg8::SchedDense S{(const char*)(F.wsp() + WS_A2), (const char*)(F.wsp() + WS_WOUT), nullptr, nullptr, T / 256, 4, 0, DM, (int)gridDim.x, (int)blockIdx.x, 256};
        typedef pg8::EpiWrap<EpU<EpBf16>, false, true> E_;
        pg8::gemm_phase<E_, pg8::SchedDense, false, false>(F.lds, DM, S, E_{{{(bf16*)(F.wsp() + WS_Y0), DM}}});
        if (rep + 1 < REP4) xcd_barrier(bar);
    } SEAM(4);
    if (IN(5)) {
#pragma unroll 1
        for (int rep = 0; rep < DRY5; ++rep) { p_ln_router<0, true>(F); xcd_barrier(bar); }
        p_ln_router<0>(F); } SEAM(5);
    if (IN(6)) { p_moe<0>(F, bar, true); } SEAM(6);
    if (IN(8)) {
#pragma unroll 1
        for (int rep = 0; rep < DRY8; ++rep) { p_ln2<0, true>(F); xcd_barrier(bar); }
        p_ln2<0>(F); } SEAM(8);
    if (IN(9)) {
        const int G = gridDim.x, bx = blockIdx.x, vcu = (G % 8 == 0) ? (bx % 8) * (G / 8) + bx / 8 : bx;
        const SchedKVQG S{(const char*)(F.wsp() + WS_XB), (const char*)(F.wsp() + WS_WKV), (const char*)(F.wsp() + WS_U), (const char*)(F.wsp() + WS_WQG), G, vcu, 0, 512};
        typedef pg8::EpiWrap<EpKVQG, false, true> E_;
        pg8::gemm_phase<E_, SchedKVQG, true, false>(F.lds, DM, S, E_{{(bf16*)(F.wsp() + WS_KV), (bf16*)(F.wsp() + WS_Q), (float*)(F.wsp() + WS_GATE), F.inp(I_BG)}});
    } SEAM(9);
    if (IN(10)) {
        const int G = gridDim.x, bx = blockIdx.x, vcu = (G % 8 == 0) ? (bx % 8) * (G / 8) + bx / 8 : bx;
        const int nq = G - 64 > 0 ? G - 64 : G;
        {
            const SchedKVQG S{(const char*)(F.wsp() + WS_XB), (const char*)(F.wsp() + WS_WKV), (const char*)(F.wsp() + WS_U), (const char*)(F.wsp() + WS_WQG), nq, vcu < nq ? vcu : -1, 512, 704};
            typedef pg8::EpiWrap<EpKVQG, false, true> E_;
            pg8::gemm_phase<E_, SchedKVQG, false, false>(F.lds, DM, S, E_{{(bf16*)(F.wsp() + WS_KV), (bf16*)(F.wsp() + WS_Q), (float*)(F.wsp() + WS_GATE), F.inp(I_BG)}});
        }
        {
            const SchedCmp S{(const char*)(F.wsp() + WS_KV), (const char*)(F.wsp() + WS_W1C), G - nq > 0 ? G - nq : G, G - nq > 0 ? (vcu >= nq ? vcu - nq : -1) : vcu};
            typedef pg8::EpiWrap<EpU<EpF32>, false> E_;
            pg8::gemm_phase<E_, SchedCmp, false, false>(F.lds, 1024, S, E_{{{(float*)(F.wsp() + WS_TB), 512}}});
        }
    } SEAM(10);
    if (IN(11)) {
#pragma unroll 1
        for (int rep = 0; rep < REP11; ++rep) { p_cmp_finish(F); if (rep + 1 < REP11) xcd_barrier(bar); } } SEAM(11);
#if ATTN_FUSED
    if (IN(12)) {
#pragma unroll 1
        for (int rep = 0; rep < DRY12; ++rep) { p_attn_fused<true, ATV>(F); xcd_barrier(bar); }
        p_attn_fused<false, 0>(F); } SEAM(12);
#else
    if (IN(12)) { p_attn_cmp(F); } SEAM(12);
    if (IN(13)) { p_attn_main(F); } SEAM(13);
#endif
    if (IN(14)) {
        const pg8::SchedDense S{(const char*)(F.wsp() + WS_O), (const char*)(F.wsp() + WS_WO), nullptr, nullptr, T / 256, 4, 0, DM, (int)gridDim.x, (int)blockIdx.x, 256};
        typedef pg8::EpiWrap<EpU<EpBf16>, false, true> E_;
        pg8::gemm_phase<E_, pg8::SchedDense, false, false>(F.lds, DM, S, E_{{{(bf16*)(F.wsp() + WS_Y0), DM}}});
    } SEAM(14);
    if (IN(15)) { p_ln_router<1>(F); } SEAM(15);
    if (IN(16)) { p_moe<1>(F, bar, true); } SEAM(16);
    if (IN(18)) { p_ln2<1>(F); }
#undef IN
#undef SEAM
}

extern "C" void kernel_launch(void* const* d_in, const int* in_sizes, int n_in, void* d_out, int out_size, void* d_ws, size_t ws_size, hipStream_t stream) {
    static int grid = 0;
    if (grid == 0) {
        if (n_in != 23 || out_size != T * DM || ws_size < WS_END) { fprintf(stderr, "kernel_launch: unexpected shapes (n_in %d out %d ws %zu, need ws >= %zu)\n", n_in, out_size, ws_size, (size_t)WS_END); grid = -1; return; }
        int dev = 0, cus = 0, per_cu = 0;
        if (hipGetDevice(&dev) != hipSuccess || hipDeviceGetAttribute(&cus, hipDeviceAttributeMultiprocessorCount, dev) != hipSuccess) { grid = -1; return; }
        if (hipFuncSetAttribute((const void*)mk_fwd, hipFuncAttributeMaxDynamicSharedMemorySize, LDS_BYTES) != hipSuccess) { fprintf(stderr, "kernel_launch: hipFuncSetAttribute failed\n"); grid = -1; return; }
        if (hipOccupancyMaxActiveBlocksPerMultiprocessor(&per_cu, (const void*)mk_fwd, 512, LDS_BYTES) != hipSuccess || per_cu < 1) { fprintf(stderr, "kernel_launch: occupancy query says %d\n", per_cu); per_cu = 1; }
        (void)hipGetLastError();
        grid = cus;
    }
    if (grid < 0) return;
    (void)hipMemsetAsync((char*)d_ws + WS_CTL, 0, CTL_ZERO_BYTES, stream);
    Args a{};
    for (int i = 0; i < 23; ++i) a.in[i] = (const float*)d_in[i];
    a.out = (float*)d_out; a.ws = (unsigned char*)d_ws;
    if (MK_N_LAUNCHES == 1) { a.ph_lo = 0; a.ph_hi = NPH; hipLaunchKernelGGL(mk_fwd, dim3(grid), dim3(512), LDS_BYTES, stream, a); }
    else for (int p = 0; p < NPH; ++p) { a.ph_lo = p; a.ph_hi = p + 1; hipLaunchKernelGGL(mk_fwd, dim3(grid), dim3(512), LDS_BYTES, stream, a); }
}
```

```cpp
#include <hip/hip_runtime.h>
#include <cstdio>
#include <cstdint>

#ifndef REP0
#define REP0 1
#endif
#ifndef REP1
#define REP1 1
#endif
#ifndef REP11
#define REP11 1
#endif
#ifndef XBAR
#define XBAR 1
#endif
#ifndef DRY5
#define DRY5 0
#endif
#ifndef DRY8
#define DRY8 0
#endif
#ifndef REP4
#define REP4 1
#endif
#ifndef REP2
#define REP2 1
#endif
#ifndef REP3
#define REP3 1
#endif
#ifndef REP6
#define REP6 1
#endif
#ifndef REP7
#define REP7 1
#endif
#ifndef REP9
#define REP9 1
#endif
#ifndef REP10
#define REP10 1
#endif
#ifndef REP12
#define REP12 1
#endif
#ifndef REP1213
#define REP1213 1
#endif
#ifndef ATV
#define ATV 0
#endif
#ifndef DRY2
#define DRY2 0
#endif
#ifndef DRY12
#define DRY12 0
#endif
#ifndef ATTN_FUSED
#define ATTN_FUSED 1
#endif
#ifndef MK_N_LAUNCHES
#define MK_N_LAUNCHES 1
#endif

#define GAS __attribute__((address_space(1)))
#define LAS __attribute__((address_space(3)))
typedef unsigned short bf16;
typedef short bf16x8 __attribute__((ext_vector_type(8)));
typedef float f32x4 __attribute__((ext_vector_type(4)));
typedef unsigned u32x4 __attribute__((ext_vector_type(4)));
typedef unsigned u32x2 __attribute__((ext_vector_type(2)));
typedef GAS unsigned gu32;
#define RLX_AGENT __ATOMIC_RELAXED, __HIP_MEMORY_SCOPE_AGENT

constexpr int NB = 4, SEQ = 4096, DM = 1024, T = NB * SEQ, NH = 16, HKV = 4, HD = 64, NE = 16, FF = 512;
constexpr int NPH = 19;
constexpr float ALPHA = 1.4142135623730951f;
constexpr float LN_EPS = 1e-5f;
constexpr float C2 = 0.125f * 1.4426950408889634f;
constexpr int KVROWS = SEQ + 128;
constexpr int HROWS = 2 * T + NE * 256;

constexpr size_t MiB = 1u << 20;
constexpr size_t WS_CTL = 0, CTL_ZERO_BYTES = 1 * MiB;
constexpr size_t WS_MODP = 290 * MiB;
constexpr size_t WS_MOD = 3 * MiB;
constexpr size_t WS_PETP = 3 * MiB + 512 * 1024;
constexpr size_t WS_LIST = 4 * MiB;
constexpr size_t WS_LW = 6 * MiB;
constexpr size_t WS_WIN = 8 * MiB, WS_WOUT = 14 * MiB, WS_WKV = 16 * MiB, WS_WQG = 19 * MiB, WS_WO = 22 * MiB, WS_W1C = 24 * MiB;
constexpr size_t WS_WGU = 26 * MiB, WS_WDN = 90 * MiB;
constexpr size_t WS_U = 122 * MiB, WS_XB = 154 * MiB, WS_H = 186 * MiB, WS_Y0 = 226 * MiB, WS_Y1 = 258 * MiB;
constexpr size_t WS_R1 = 290 * MiB;
constexpr size_t WS_BG = WS_R1, WS_Z = WS_R1 + 32 * MiB, WS_A2 = WS_R1 + 64 * MiB;
constexpr size_t WS_Q = WS_R1, WS_O = WS_R1 + 32 * MiB, WS_KV = WS_R1 + 64 * MiB;
constexpr size_t KVBUF_ELEMS = (size_t)16 * KVROWS * 64;
constexpr size_t WS_TB = WS_R1 + 114 * MiB, WS_KC = WS_R1 + 130 * MiB, WS_VC = WS_KC + 512 * 1024, WS_GATE = WS_R1 + 131 * MiB;
constexpr size_t WS_END = WS_R1 + 135 * MiB;
static_assert(WS_Y1 == WS_Y0 + (size_t)T * DM * 2, "Y1 follows Y0");
static_assert(WS_KV + 6 * KVBUF_ELEMS * 2 <= WS_TB, "kv buffers");
static_assert((size_t)HROWS * FF * 2 <= 40 * MiB, "H buffer");
constexpr int CW_CNT = 1024;
constexpr int CW_BAR = 4096;

constexpr int RING_BYTES = 131072;
constexpr int LDSCTL_OFF = 143360, MISC_OFF = LDSCTL_OFF + 320;
constexpr int LDS_BYTES = 147456;

#define LDS_WAIT() asm volatile("s_waitcnt lgkmcnt(0)" ::: "memory")
__device__ __forceinline__ unsigned f2bf(float f) { unsigned u = __builtin_bit_cast(unsigned, f); return (u + 0x7fffu + ((u >> 16) & 1u)) >> 16; }
typedef float f32x2v __attribute__((ext_vector_type(2)));
typedef __bf16 bf16x2_t __attribute__((ext_vector_type(2)));
__device__ __forceinline__ unsigned pk2(float lo, float hi) { f32x2v v = {lo, hi}; bf16x2_t b = __builtin_convertvector(v, bf16x2_t); return __builtin_bit_cast(unsigned, b); }
__device__ __forceinline__ float bf2f(unsigned short h) { return __builtin_bit_cast(float, (unsigned)h << 16); }
__device__ __forceinline__ float bflo(unsigned w) { return __builtin_bit_cast(float, w << 16); }
__device__ __forceinline__ float bfhi(unsigned w) { return __builtin_bit_cast(float, w & 0xffff0000u); }
__device__ __forceinline__ float wave_sum(float v) {
#pragma unroll
    for (int o = 1; o < 64; o <<= 1) v += __shfl_xor(v, o);
    return v;
}
__device__ __forceinline__ float wave_max(float v) {
#pragma unroll
    for (int o = 1; o < 64; o <<= 1) v = fmaxf(v, __shfl_xor(v, o));
    return v;
}
__device__ __forceinline__ float silu_f(float a) { return a * __builtin_amdgcn_rcpf(1.f + __builtin_amdgcn_exp2f(-1.4426950408889634f * a)); }
__device__ __forceinline__ void st_bf4(bf16* p, f32x4 v) { u32x2 w; w.x = pk2(v[0], v[1]); w.y = pk2(v[2], v[3]); *(u32x2*)p = w; }
__device__ __forceinline__ void st_bf8(bf16* p, f32x4 a, f32x4 b) { u32x4 w; w.x = pk2(a[0], a[1]); w.y = pk2(a[2], a[3]); w.z = pk2(b[0], b[1]); w.w = pk2(b[2], b[3]); *(u32x4*)p = w; }

#define XB_TMO      128
#define XB_XCNT(j)  (256  + 64 * (j))
#define XB_XSUB(j)  (1280 + 64 * (j))
#define XB_XGEN(j)  (2304 + 64 * (j))
#define XB_TOP      3328
#define XB_TOPGEN   3392
#define XCD_BAR_WORDS 3456
#define XB_SPIN_CAP (1u << 22)
__device__ __forceinline__ unsigned xb_ld(unsigned* p)              { return __hip_atomic_load(p, __ATOMIC_RELAXED, __HIP_MEMORY_SCOPE_AGENT); }
__device__ __forceinline__ unsigned xb_add(unsigned* p, unsigned v) { return __hip_atomic_fetch_add(p, v, __ATOMIC_RELAXED, __HIP_MEMORY_SCOPE_AGENT); }
__device__ __forceinline__ unsigned xb_xcc_id() { return (unsigned)__builtin_amdgcn_s_getreg((3 << 11) | 20) & 0xFu; }
#define XB_SPIN(cond, bar) do { unsigned _sp = 0; while (cond) { __builtin_amdgcn_s_sleep(1); \
    if ((++_sp & 255u) == 0u) { if (xb_ld(&(bar)[XB_TMO])) break; if (_sp > XB_SPIN_CAP) { atomicAdd(&(bar)[XB_TMO], 1u); break; } } } } while (0)
struct XcdBarrier { unsigned* bar; unsigned x; volatile LAS unsigned* st; };
__device__ __forceinline__ XcdBarrier xcd_barrier_post(unsigned* bar, volatile LAS unsigned* st) {
    XcdBarrier b; b.bar = bar; b.x = xb_xcc_id(); b.st = st;
    if (threadIdx.x == 0) (void)xb_add(&bar[XB_XCNT(b.x)], 1u);
    return b;
}
__device__ __forceinline__ void xcd_barrier_complete(unsigned* bar, unsigned x, unsigned& nloc, unsigned& nx) {
    const unsigned G = gridDim.x * gridDim.y * gridDim.z;
    unsigned sum, cnt, mine, sp = 0u;
    for (;;) {
        sum = 0u; cnt = 0u; mine = 0u;
#pragma unroll
        for (unsigned j = 0; j < 16; ++j) { const unsigned c = xb_ld(&bar[XB_XCNT(j)]); sum += c; cnt += (c > 0u) ? 1u : 0u; mine = (j == x) ? c : mine; }
        if (sum == G) break;
        __builtin_amdgcn_s_sleep(1);
        if ((++sp & 255u) == 0u) { if (xb_ld(&bar[XB_TMO])) break; if (sp > XB_SPIN_CAP) { atomicAdd(&bar[XB_TMO], 1u); break; } }
    }
    nloc = mine > 0u ? mine : 1u; nx = cnt > 0u ? cnt : 1u;
}
__device__ __forceinline__ void xcd_barrier(const XcdBarrier& b) {
    asm volatile("s_waitcnt vmcnt(0)" ::: "memory");
    __syncthreads();
    if (threadIdx.x == 0) {
        unsigned* bar = b.bar;
        __builtin_amdgcn_s_waitcnt(0);
        unsigned nloc = b.st[0], nx = b.st[1];
        if (nloc == 0u) { xcd_barrier_complete(bar, b.x, nloc, nx); b.st[0] = nloc; b.st[1] = nx; }
        const unsigned old = xb_add(&bar[XB_XSUB(b.x)], 1u);
        const unsigned gen = old / nloc;
        if (old + 1u == (gen + 1u) * nloc) {
            __builtin_amdgcn_fence(__ATOMIC_RELEASE, "agent");
            asm volatile("s_waitcnt vmcnt(0)" ::: "memory");
            const unsigned og = xb_add(&bar[XB_TOP], 1u);
            const unsigned tg = og / nx;
            if (og + 1u == (tg + 1u) * nx) xb_add(&bar[XB_TOPGEN], 1u);
            else XB_SPIN(xb_ld(&bar[XB_TOPGEN]) == tg, bar);
            __builtin_amdgcn_fence(__ATOMIC_ACQUIRE, "agent");
            xb_add(&bar[XB_XGEN(b.x)], 1u);
            asm volatile("s_waitcnt vmcnt(0)" ::: "memory");
        } else {
            XB_SPIN(xb_ld(&bar[XB_XGEN(b.x)]) == gen, bar);
            __builtin_amdgcn_fence(__ATOMIC_ACQUIRE, "agent");
            asm volatile("s_waitcnt vmcnt(0)" ::: "memory");
        }
    }
    __syncthreads();
}

constexpr int PTR_OFF = MISC_OFF + 512;
struct Frame {
    LAS unsigned char* lds;
    volatile LAS unsigned* MISC;
    int tid, lane, wave, gw, NGW;
    __device__ __forceinline__ unsigned long long ptr(int i) const { const LAS unsigned* p = (const LAS unsigned*)(lds + PTR_OFF) + 2 * i;
        const unsigned lo = __builtin_amdgcn_readfirstlane(p[0]), hi = __builtin_amdgcn_readfirstlane(p[1]); return ((unsigned long long)hi << 32) | lo; }
    __device__ __forceinline__ const float* inp(int i) const { return (const float*)(const GAS float*)ptr(i); }
    __device__ __forceinline__ float* outp() const { return (float*)(GAS float*)ptr(23); }
    __device__ __forceinline__ unsigned char* wsp() const { return (unsigned char*)(GAS unsigned char*)ptr(24); }
    __device__ __forceinline__ gu32* ctlp() const { return (gu32*)(wsp() + WS_CTL); }
};
enum { I_X = 0, I_C, I_ADAW, I_ADAB, I_LNG, I_LNB, I_CWIN, I_CONVW, I_CONVB, I_CWOUT, I_WKV, I_PE, I_CW1, I_CB1, I_CW2, I_CB2, I_WQG, I_BG, I_WO, I_RW, I_RB, I_WGU, I_WDN };

__device__ __forceinline__ void transpose_item(const float* W, int ld, int nvalid, int K, bf16* WT, int dstrow0, int k0, int n0, LAS float* scr, int lane) {
    const int n = n0 + (lane & 31);
#pragma unroll 8
    for (int i = 0; i < 32; ++i) { const int kk = 2 * i + (lane >> 5); scr[kk * 33 + (lane & 31)] = (n < nvalid) ? W[(size_t)(k0 + kk) * ld + n] : 0.f; }
    LDS_WAIT(); asm volatile("" ::: "memory");
    const int c = lane & 7;
#pragma unroll
    for (int j = 0; j < 4; ++j) { const int nl = (lane >> 3) + 8 * j; const LAS float* s = scr + (8 * c) * 33 + nl;
        u32x4 o; o.x = pk2(s[0 * 33], s[1 * 33]); o.y = pk2(s[2 * 33], s[3 * 33]); o.z = pk2(s[4 * 33], s[5 * 33]); o.w = pk2(s[6 * 33], s[7 * 33]);
        *(u32x4*)(WT + (size_t)(dstrow0 + nl) * K + k0 + 8 * c) = o; }
    LDS_WAIT(); asm volatile("" ::: "memory");
}
__device__ __forceinline__ int pairmap(int n0, int half) {
    return n0 < half ? ((n0 >> 7) * 256 + (n0 & 127)) : ((((n0 - half) >> 7) * 256) + 128 + ((n0 - half) & 127));
}
__device__ __forceinline__ void p0_prologue(Frame& F) {
    LAS float* scr = (LAS float*)(F.lds + F.wave * 16384);
    const int lane = F.lane;
    for (int r = F.gw; r < 768 + 256; r += F.NGW) {
        if (r < 768) {
            const int l = r / 384, rem = r % 384, dch = rem / 24, e = (rem % 24) * 256 + 4 * lane;
            const float* aw = F.inp(I_ADAW) + (size_t)l * 1024 * 6144 + e; const float* c = F.inp(I_C);
            f32x4 a0 = (f32x4){0.f, 0.f, 0.f, 0.f}, a1 = a0, a2 = a0, a3 = a0;
#pragma unroll 16
            for (int d = dch * 64; d < dch * 64 + 64; ++d) {
                const f32x4 w = *(const f32x4*)(aw + (size_t)d * 6144);
                const float c0 = c[d], c1 = c[1024 + d], c2 = c[2048 + d], c3 = c[3072 + d];
                a0 += w * (c0 / (1.f + __expf(-c0))); a1 += w * (c1 / (1.f + __expf(-c1))); a2 += w * (c2 / (1.f + __expf(-c2))); a3 += w * (c3 / (1.f + __expf(-c3)));
            }
            float* mp = (float*)(F.wsp() + WS_MODP) + (size_t)dch * 49152 + (size_t)(l * 4) * 6144 + e;
            *(f32x4*)mp = a0; *(f32x4*)(mp + 6144) = a1; *(f32x4*)(mp + 2 * 6144) = a2; *(f32x4*)(mp + 3 * 6144) = a3;
        } else {
            const int q = r - 768, i = q / 128, rem = q % 128, cch = rem / 32, kch = rem % 32, c = cch * 64 + lane;
            const float* pe = F.inp(I_PE) + i * 2048; const float* w1 = F.inp(I_CW1) + (size_t)i * 2048 * 256 + c;
            float a = 0.f;
#pragma unroll 16
            for (int kk = kch * 64; kk < kch * 64 + 64; ++kk) a += pe[kk] * w1[(size_t)kk * 256];
            ((float*)(F.wsp() + WS_PETP))[(kch * 2 + i) * 256 + c] = a;
        }
    }
    constexpr int I1 = 16 * 96, I2 = 512, I3 = 16 * 48, I4 = 16 * 40, I5 = 512, I6 = 512, I7 = 32 * 512, I8 = 32 * 256;
    constexpr int NITEMS = I1 + I2 + I3 + I4 + I5 + I6 + I7 + I8;
    for (int it = F.gw; it < NITEMS; it += F.NGW) {
        int r = it;
        if (r < I1) { const int kb = r / 96, nb = r % 96, n0 = nb * 32;
            const int dr = n0 < 1024 ? n0 : 1024 + pairmap(n0 - 1024, 1024);
            transpose_item(F.inp(I_CWIN), 3072, 3072, 1024, (bf16*)(F.wsp() + WS_WIN), dr, kb * 64, n0, scr, lane); continue; } r -= I1;
        if (r < I2) { transpose_item(F.inp(I_CWOUT), 1024, 1024, 1024, (bf16*)(F.wsp() + WS_WOUT), (r % 32) * 32, (r / 32) * 64, (r % 32) * 32, scr, lane); continue; } r -= I2;
        if (r < I3) { transpose_item(F.inp(I_WKV), 1536, 1536, 1024, (bf16*)(F.wsp() + WS_WKV), (r % 48) * 32, (r / 48) * 64, (r % 48) * 32, scr, lane); continue; } r -= I3;
        if (r < I4) { transpose_item(F.inp(I_WQG), 1072, 1072, 1024, (bf16*)(F.wsp() + WS_WQG), (r % 40) * 32, (r / 40) * 64, (r % 40) * 32, scr, lane); continue; } r -= I4;
        if (r < I5) { transpose_item(F.inp(I_WO), 1024, 1024, 1024, (bf16*)(F.wsp() + WS_WO), (r % 32) * 32, (r / 32) * 64, (r % 32) * 32, scr, lane); continue; } r -= I5;
        if (r < I6) { const int sub = r / 128, q = r % 128, i = sub >> 1, hh = sub & 1;
            transpose_item(F.inp(I_CW1) + (size_t)i * 2048 * 256 + (size_t)hh * 1024 * 256, 256, 256, 1024, (bf16*)(F.wsp() + WS_W1C) + (size_t)i * 512 * 1024, hh * 256 + (q % 8) * 32, (q / 8) * 64, (q % 8) * 32, scr, lane); continue; } r -= I6;
        if (r < I7) { const int mi = r / 512, q = r % 512, n0 = (q % 32) * 32;
            transpose_item(F.inp(I_WGU) + (size_t)mi * 1024 * 1024, 1024, 1024, 1024, (bf16*)(F.wsp() + WS_WGU) + (size_t)mi * 1024 * 1024, pairmap(n0, 512), (q / 32) * 64, n0, scr, lane); continue; } r -= I7;
        { const int mi = r / 256, q = r % 256, n0 = (q % 32) * 32;
            transpose_item(F.inp(I_WDN) + (size_t)mi * 512 * 1024, 1024, 1024, 512, (bf16*)(F.wsp() + WS_WDN) + (size_t)mi * 1024 * 512, n0, (q / 32) * 64, n0, scr, lane); }
    }
}
__device__ __forceinline__ f32x4 mod4_partials(const Frame& F, int l, int b, int e) {
    f32x4 s = *(const f32x4*)(F.inp(I_ADAB) + l * 6144 + e);
    const float* mp = (const float*)(F.wsp() + WS_MODP) + (size_t)(l * 4 + b) * 6144 + e;
#pragma unroll
    for (int d = 0; d < 16; ++d) s += *(const f32x4*)(mp + (size_t)d * 49152);
    return s;
}
__device__ __forceinline__ void p1_mod_u0(Frame& F) {
    float* MOD = (float*)(F.wsp() + WS_MOD);
    for (int ch = F.gw; ch < 768; ch += F.NGW) {
        const int idx = ch * 64 + F.lane, lb = idx / 6144, e = idx % 6144;
        float s = F.inp(I_ADAB)[(lb >> 2) * 6144 + e];
        const float* mp = (const float*)(F.wsp() + WS_MODP) + idx;
#pragma unroll
        for (int d = 0; d < 16; ++d) s += mp[(size_t)d * 49152];
        MOD[idx] = s;
    }
    for (int q = F.gw; q < 2; q += F.NGW) { const int i = q, c = 4 * F.lane;
        f32x4 pe = *(const f32x4*)(F.inp(I_CB1) + i * 256 + c); const float* PETP = (const float*)(F.wsp() + WS_PETP);
#pragma unroll
        for (int k = 0; k < 32; ++k) pe += *(const f32x4*)(PETP + (k * 2 + i) * 256 + c);
        *(f32x4*)((float*)(F.wsp() + WS_PETP) + 64 * 256 + i * 256 + c) = pe; }
    bf16* U = (bf16*)(F.wsp() + WS_U);
    LAS f32x4* msh = (LAS f32x4*)F.lds;
    for (int c0 = blockIdx.x * 64; c0 < T; c0 += gridDim.x * 64) {
        const int b = c0 >> 12;
        __syncthreads();
        { const int t = F.tid, e = 4 * (t & 255) + (t >> 8) * 1024; f32x4 v = mod4_partials(F, 0, b, e); if (t >= 256) v = v + 1.0f; msh[t] = v; }
        __syncthreads();
        f32x4 sh[4], sc[4];
#pragma unroll
        for (int j = 0; j < 4; ++j) { sh[j] = msh[F.lane + 64 * j]; sc[j] = msh[256 + F.lane + 64 * j]; }
        const int m0 = c0 + F.wave * 8;
#pragma unroll 1
        for (int m = m0; m < m0 + 8; m += 2) {
            f32x4 v[2][4];
#pragma unroll
            for (int r = 0; r < 2; ++r)
#pragma unroll
                for (int j = 0; j < 4; ++j) v[r][j] = *(const f32x4*)(F.inp(I_X) + (size_t)(m + r) * DM + 4 * F.lane + 256 * j);
#pragma unroll
            for (int r = 0; r < 2; ++r)
#pragma unroll
                for (int j = 0; j < 4; ++j) st_bf4(U + (size_t)(m + r) * DM + 4 * F.lane + 256 * j, v[r][j] * sc[j] + sh[j]);
        }
    }
}
template <bool PAIR, class AR, class EP>
__device__ __forceinline__ void gemm_wave_tile(const AR& arow, const bf16* Btile, int K, int m0, int nbase, const EP& ep, int lane) {
    const int fr = lane & 15, fq = lane >> 4;
    f32x4 acc[4][4];
#pragma unroll
    for (int i = 0; i < 4; ++i)
#pragma unroll
        for (int j = 0; j < 4; ++j) acc[i][j] = (f32x4){0.f, 0.f, 0.f, 0.f};
    const bf16* ap[4]; const bf16* bp[4];
#pragma unroll
    for (int i = 0; i < 4; ++i) ap[i] = arow(m0 + 16 * i + fr) + 8 * fq;
#pragma unroll
    for (int j = 0; j < 4; ++j) { const int nr = PAIR ? ((j & 1) * 16 + (j >> 1) * 128) : 16 * j; bp[j] = Btile + (size_t)(nr + fr) * K + 8 * fq; }
    for (int k0 = 0; k0 < K; k0 += 32) {
        bf16x8 a[4], b[4];
#pragma unroll
        for (int i = 0; i < 4; ++i) a[i] = *(const bf16x8*)(ap[i] + k0);
#pragma unroll
        for (int j = 0; j < 4; ++j) b[j] = *(const bf16x8*)(bp[j] + k0);
#pragma unroll
        for (int i = 0; i < 4; ++i)
#pragma unroll
            for (int j = 0; j < 4; ++j) acc[i][j] = __builtin_amdgcn_mfma_f32_16x16x32_bf16(b[j], a[i], acc[i][j], 0, 0, 0);
    }
#pragma unroll
    for (int i = 0; i < 4; ++i) {
        const int m = m0 + 16 * i + fr;
        if constexpr (PAIR) {
#pragma unroll
            for (int j = 0; j < 2; ++j) ep.pair(m, nbase + 16 * j + 4 * fq, acc[i][j], acc[i][j + 2]);
        } else {
#pragma unroll
            for (int j = 0; j < 4; ++j) ep(m, nbase + 16 * j + 4 * fq, acc[i][j]);
        }
    }
}
struct ARowPlain { const bf16* A; int K; __device__ __forceinline__ const bf16* operator()(int m) const { return A + (size_t)m * K; } };

struct EpBf16 { bf16* O; int ld; __device__ __forceinline__ void operator()(int m, int n, f32x4 v) const { st_bf4(O + (size_t)m * ld + n, v); }
    __device__ __forceinline__ void op8(int m, int n, f32x4 a, f32x4 b) const { st_bf8(O + (size_t)m * ld + n, a, b); } };
struct EpMulPair { bf16* O; int ld; __device__ __forceinline__ void pair(int m, int ch, f32x4 a, f32x4 b) const { st_bf4(O + (size_t)m * ld + ch, a * b); }
    __device__ __forceinline__ void pair8(int m, int ch, f32x4 a0, f32x4 a1, f32x4 b0, f32x4 b1) const { st_bf8(O + (size_t)m * ld + ch, a0 * b0, a1 * b1); } };
struct EpSiluPair { bf16* O; int ld; __device__ __forceinline__ void pair(int m, int ch, f32x4 a, f32x4 b) const {
    f32x4 s; for (int r = 0; r < 4; ++r) s[r] = silu_f(a[r]) * b[r]; st_bf4(O + (size_t)m * ld + ch, s); } };
__device__ __forceinline__ f32x4 ld_bf4(const bf16* p) { const u32x2 w = *(const u32x2*)p; return (f32x4){bflo(w.x), bfhi(w.x), bflo(w.y), bfhi(w.y)}; }
struct EpRes { const float* base; bf16* out; const float* gmod;
    __device__ __forceinline__ void operator()(int m, int n, f32x4 v) const { const int b = m >> 12; const f32x4 g = *(const f32x4*)(gmod + b * 6144 + n);
        const f32x4 x = *(const f32x4*)(base + (size_t)m * DM + n); st_bf4(out + (size_t)m * DM + n, x * ALPHA + g * v); } };
struct EpResB { bf16* res; const float* gmod;
    __device__ __forceinline__ void operator()(int m, int n, f32x4 v) const { const int b = m >> 12; const f32x4 g = *(const f32x4*)(gmod + b * 6144 + n);
        bf16* p = res + (size_t)m * DM + n; st_bf4(p, ld_bf4(p) * ALPHA + g * v); } };
__device__ __forceinline__ int kfrag_off(int kk, int d) { return ((((kk >> 5) * 4 + (d >> 4)) * 2 + ((d >> 3) & 1)) * 32 + (kk & 31)) * 8 + (d & 7); }
__device__ __forceinline__ int vfrag_off(int kk, int d) { return ((((d >> 5) * 4 + (kk >> 4)) * 2 + ((kk >> 2) & 1)) * 32 + (d & 31)) * 8 + ((((kk >> 3) & 1) << 2) | (kk & 3)); }
struct EpKV { bf16* KV; __device__ __forceinline__ void operator()(int m, int n, f32x4 v) const {
    const int j = n >> 8, hk = (n >> 6) & 3, d = n & 63, b = m >> 12, t = m & 4095;
    bf16* base = KV + (size_t)j * KVBUF_ELEMS + (size_t)(b * 4 + hk) * KVROWS * 64;
    if (j < 2) st_bf4(base + (size_t)t * 64 + d, v);
    else if ((j & 1) == 0) st_bf4(base + (size_t)(t >> 6) * 4096 + kfrag_off(t & 63, d), v);
    else { bf16* tp = base + (size_t)(t >> 6) * 4096;
        for (int r = 0; r < 4; ++r) tp[vfrag_off(t & 63, d + r)] = (bf16)f2bf(v[r]); } }
    __device__ __forceinline__ void op8(int m, int n, f32x4 a, f32x4 c) const {
    const int j = n >> 8, hk = (n >> 6) & 3, d = n & 63, b = m >> 12, t = m & 4095;
    bf16* base = KV + (size_t)j * KVBUF_ELEMS + (size_t)(b * 4 + hk) * KVROWS * 64;
    if (j < 2) st_bf8(base + (size_t)t * 64 + d, a, c);
    else if ((j & 1) == 0) st_bf8(base + (size_t)(t >> 6) * 4096 + kfrag_off(t & 63, d), a, c);
    else { bf16* tp = base + (size_t)(t >> 6) * 4096;
        for (int r = 0; r < 4; ++r) { tp[vfrag_off(t & 63, d + r)] = (bf16)f2bf(a[r]); tp[vfrag_off(t & 63, d + 4 + r)] = (bf16)f2bf(c[r]); } } } };
struct EpQG { bf16* Q; float* GATE; const float* bg; __device__ __forceinline__ void operator()(int m, int n, f32x4 v) const {
    if (n < 1024) st_bf4(Q + (size_t)m * DM + n, v * C2);
    else { for (int r = 0; r < 4; ++r) { const int i = n - 1024 + r; if (i < 48) GATE[(size_t)m * 48 + i] = 1.f / (1.f + __expf(-(v[r] + bg[i]))); } } }
    __device__ __forceinline__ void op8(int m, int n, f32x4 a, f32x4 c) const {
    if (n < 1024) st_bf8(Q + (size_t)m * DM + n, a * C2, c * C2);
    else { (*this)(m, n, a); (*this)(m, n + 4, c); } } };
struct EpF32 { float* O; int ld; __device__ __forceinline__ void operator()(int m, int n, f32x4 v) const { *(f32x4*)(O + (size_t)m * ld + n) = v; } };

template <bool PAIR, class AR, class EP>
__device__ __forceinline__ void gemm_dense(Frame& F, const AR& arow, const bf16* Bt, int K, int nM64, int nN64, int chbase, const EP& ep) {
    const int total = nM64 * nN64;
    for (int it = F.gw; it < total; it += F.NGW) {
        const int ni = it % nN64, mt = it / nN64;
        if constexpr (PAIR) { const int pn = ni >> 2, q = ni & 3;
            gemm_wave_tile<true>(arow, Bt + (size_t)(pn * 256 + q * 32) * K, K, mt * 64, chbase + pn * 128 + q * 32, ep, F.lane);
        } else gemm_wave_tile<false>(arow, Bt + (size_t)(ni * 64) * K, K, mt * 64, chbase + ni * 64, ep, F.lane);
    }
}

namespace pg8 {
#define PG8_LAS __attribute__((address_space(3)))
constexpr int BM = 256, BK = 64, HALF = 128, HTB = HALF * BK * 2, STAGE_BYTES = 8 * HTB, NXCD = 8, WGM = 8;
__device__ __forceinline__ int lds_byte(int r, int c) { const int st = (r >> 4) * 2 + (c >> 5), rr = r & 15, cc = c & 31, ob = rr * 64 + cc * 2; return st * 1024 + (ob ^ (((ob >> 9) & 1) << 5)); }
__device__ __forceinline__ void stage_rc(int b, int& R, int& C) { const int st = b / 1024, sb = b % 1024, swz = sb ^ (((sb >> 9) & 1) << 5); R = (st >> 1) * 16 + swz / 64; C = (st & 1) * 32 + (swz % 64) / 2; }
struct Unit { const char* A; const char* B; int row0, col0, e, pos0, cnt; };
__device__ __forceinline__ bool static_order(int i, int G, int c, int nM, int nN, int& pm, int& pn) {
    const int nwg = nM * nN; const long L = (long)i * G + c; if (L >= nwg) return false;
    int wgid = (int)L; { const int q = nwg / NXCD, r = nwg % NXCD, xcd = wgid % NXCD, off = wgid / NXCD; wgid = (xcd < r ? xcd * (q + 1) : r * (q + 1) + (xcd - r) * q) + off; }
    const int nig = WGM * nN, gid = wgid / nig, fm = gid * WGM, gsz = (nM - fm) < WGM ? (nM - fm) : WGM;
    pm = fm + ((wgid % nig) % gsz); pn = (wgid % nig) / gsz; return true;
}
__device__ __forceinline__ void voff_plain(const int (&R)[2], const int (&C)[2], int K, unsigned (&v)[2][2]) {
#pragma unroll
    for (int h = 0; h < 2; ++h)
#pragma unroll
        for (int i = 0; i < 2; ++i) v[h][i] = (unsigned)((h * HALF + R[i]) * K + C[i]) * 2u;
}
__device__ __forceinline__ int perm32(int rho) { const int n = rho >> 4, i = rho & 15; return 8 * (i >> 2) + 4 * n + (i & 3); }
template <class EP, bool PAIR, bool PERM_ = false> struct EpiWrap {
    static constexpr bool PERM = PERM_;
    EP ep;
    __device__ __forceinline__ void operator()(const f32x4 (&acc)[2][2][4][2], const Unit& u, int wr, int wc, int fr, int fq) const {
#pragma unroll
        for (int ai = 0; ai < 2; ++ai)
#pragma unroll
            for (int m = 0; m < 4; ++m) { const int row = u.row0 + ai * HALF + wr * 64 + m * 16 + fr;
                if constexpr (PERM_) {
                    if constexpr (PAIR) ep.pair8(u, row, u.col0 + wc * 32 + 8 * fq, acc[ai][0][m][0], acc[ai][0][m][1], acc[ai][1][m][0], acc[ai][1][m][1]);
                    else {
#pragma unroll
                        for (int bj = 0; bj < 2; ++bj) ep.op8(u, row, u.col0 + bj * HALF + wc * 32 + 8 * fq, acc[ai][bj][m][0], acc[ai][bj][m][1]); }
                } else if constexpr (PAIR) {
#pragma unroll
                    for (int n = 0; n < 2; ++n) ep.pair(u, row, u.col0 + wc * 32 + 16 * n + 4 * fq, acc[ai][0][m][n], acc[ai][1][m][n]);
                } else {
#pragma unroll
                    for (int bj = 0; bj < 2; ++bj)
#pragma unroll
                        for (int n = 0; n < 2; ++n) ep(u, row, u.col0 + bj * HALF + wc * 32 + 16 * n + 4 * fq, acc[ai][bj][m][n]);
                } }
    }
};
template <class Epi, class Sched, bool ALIGN_EPI, bool GATHER>
__device__ __forceinline__ void gemm_phase(PG8_LAS unsigned char* lds, const int K, const Sched& S, const Epi& E) {
    const int tid = threadIdx.x, wid = __builtin_amdgcn_readfirstlane(tid >> 6), lane = tid & 63, wr = wid >> 2, wc = wid & 3, fr = lane & 15, fq = lane >> 4;
    const int nt = K / BK;
    int R[2], C[2]; unsigned voffB[2]; unsigned vC[2][2], vN[2][2];
#pragma unroll
    for (int i = 0; i < 2; ++i) { stage_rc(tid * 16 + i * 8192, R[i], C[i]); const int Rb = Epi::PERM ? ((R[i] & ~31) | perm32(R[i] & 31)) : R[i]; voffB[i] = (unsigned)(Rb * K + C[i]) * 2u; }
    const size_t kstep = (size_t)(BK * 2);
    const size_t hstep = (size_t)HALF * K * 2;
    const unsigned ldsw = (unsigned)wid * 1024u;
    const int aoff = lds_byte(wr * 64 + fr, fq * 8), boff = lds_byte(wc * 32 + fr, fq * 8);
#define PG8_SA(b, h) (((b) * 2 + (h)) * HTB)
#define PG8_SB(b, h) ((4 + (b) * 2 + (h)) * HTB)
#define PG8_STAGE(bufoff, gbase, voff) do { _Pragma("unroll") for (int _i = 0; _i < 2; ++_i) \
        __builtin_amdgcn_global_load_lds((const unsigned*)((const char*)(gbase) + (voff)[_i]), (PG8_LAS unsigned*)(lds + (bufoff) + ldsw + _i * 8192), 16, 0, 0); } while (0)
#define PG8_LDA(dst, b, h) do { _Pragma("unroll") for (int m = 0; m < 4; ++m) _Pragma("unroll") for (int k = 0; k < 2; ++k) dst[m][k] = *(const PG8_LAS bf16x8*)(lds + PG8_SA(b, h) + aoff + m * 2048 + k * 1024); } while (0)
#define PG8_LDB(dst, b, h) do { _Pragma("unroll") for (int n = 0; n < 2; ++n) _Pragma("unroll") for (int k = 0; k < 2; ++k) dst[n][k] = *(const PG8_LAS bf16x8*)(lds + PG8_SB(b, h) + boff + n * 2048 + k * 1024); } while (0)
#define PG8_MMA(ai, bj, At, Bt) do { __builtin_amdgcn_s_setprio(1); _Pragma("unroll") for (int m = 0; m < 4; ++m) _Pragma("unroll") for (int n = 0; n < 2; ++n) _Pragma("unroll") for (int k = 0; k < 2; ++k) \
        acc[ai][bj][m][n] = __builtin_amdgcn_mfma_f32_16x16x32_bf16(Bt[n][k], At[m][k], acc[ai][bj][m][n], 0, 0, 0); __builtin_amdgcn_s_setprio(0); } while (0)
#define PG8_WAIT_V(n) asm volatile("s_waitcnt vmcnt(" #n ")" ::: "memory")
#define PG8_WAIT_L(n) asm volatile("s_waitcnt lgkmcnt(" #n ")" ::: "memory")
#define PG8_BAR __builtin_amdgcn_s_barrier()
#define PG8_SCHED __builtin_amdgcn_sched_barrier(0)
    Unit cur, nxt; int ui = 0;
    if (!S.next(0, cur)) return;
    S.voff(cur, R, C, K, vC);
    f32x4 acc[2][2][4][2];
#pragma unroll
    for (int a = 0; a < 2; ++a)
#pragma unroll
        for (int b = 0; b < 2; ++b)
#pragma unroll
            for (int m = 0; m < 4; ++m)
#pragma unroll
                for (int n = 0; n < 2; ++n) acc[a][b][m][n] = (f32x4){0.f, 0.f, 0.f, 0.f};
    bf16x8 At[4][2], B0[2][2], B1[2][2];
    const char* cA = cur.A; const char* cB = cur.B;
    PG8_STAGE(PG8_SB(0, 0), cB, voffB); PG8_STAGE(PG8_SB(0, 1), cB + hstep, voffB); PG8_STAGE(PG8_SA(0, 0), cA, vC[0]); PG8_STAGE(PG8_SA(0, 1), cA, vC[1]);
    if (wr == 1) PG8_BAR;
    PG8_WAIT_V(2); PG8_BAR;
    PG8_STAGE(PG8_SB(1, 0), cB + kstep, voffB); PG8_STAGE(PG8_SA(1, 0), cA + kstep, vC[0]); PG8_STAGE(PG8_SB(1, 1), cB + hstep + kstep, voffB);
    PG8_WAIT_V(6); PG8_BAR;
    for (;;) {
        const bool has_next = S.next(ui + 1, nxt);
        const char* nA = has_next ? nxt.A : cA; const char* nB = has_next ? nxt.B : cB;
        if constexpr (GATHER) { if (has_next) S.voff(nxt, R, C, K, vN); else { vN[0][0] = vC[0][0]; vN[0][1] = vC[0][1]; vN[1][0] = vC[1][0]; vN[1][1] = vC[1][1]; } }
        for (int t = 0; t < nt; t += 2) {
            const bool last = (t == nt - 2);
            const char* a1 = cA + (size_t)(t + 1) * kstep;
            const char* a2 = last ? nA : cA + (size_t)(t + 2) * kstep; const char* b2 = last ? nB : cB + (size_t)(t + 2) * kstep;
            const char* a3 = a2 + kstep; const char* b3 = b2 + kstep;
            unsigned v2[2][2];
#pragma unroll
            for (int h = 0; h < 2; ++h)
#pragma unroll
                for (int i = 0; i < 2; ++i) v2[h][i] = (GATHER && last) ? vN[h][i] : vC[h][i];
            PG8_LDB(B0, 0, 0); PG8_LDB(B1, 0, 1); PG8_SCHED; PG8_LDA(At, 0, 0); PG8_STAGE(PG8_SA(1, 1), a1, vC[1]);
            PG8_WAIT_V(8); PG8_WAIT_L(0); PG8_BAR; PG8_MMA(0, 0, At, B0); PG8_MMA(0, 1, At, B1); PG8_BAR; PG8_SCHED;
            PG8_LDA(At, 0, 1); PG8_STAGE(PG8_SB(0, 0), b2, voffB); PG8_STAGE(PG8_SB(0, 1), b2 + hstep, voffB); PG8_STAGE(PG8_SA(0, 0), a2, v2[0]);
            PG8_WAIT_V(8); PG8_WAIT_L(0); PG8_BAR; PG8_MMA(1, 0, At, B0); PG8_MMA(1, 1, At, B1); PG8_BAR; PG8_SCHED;
            PG8_LDB(B0, 1, 0); PG8_LDB(B1, 1, 1); PG8_SCHED; PG8_LDA(At, 1, 0); PG8_STAGE(PG8_SA(0, 1), a2, v2[1]);
            PG8_WAIT_V(8); PG8_WAIT_L(0); PG8_BAR; PG8_MMA(0, 0, At, B0); PG8_MMA(0, 1, At, B1); PG8_BAR; PG8_SCHED;
            PG8_LDA(At, 1, 1); PG8_STAGE(PG8_SB(1, 0), b3, voffB); PG8_STAGE(PG8_SB(1, 1), b3 + hstep, voffB); PG8_STAGE(PG8_SA(1, 0), a3, v2[0]);
            PG8_WAIT_V(8); PG8_WAIT_L(0); PG8_BAR; PG8_MMA(1, 0, At, B0); PG8_MMA(1, 1, At, B1); PG8_BAR; PG8_SCHED;
        }
        if constexpr (ALIGN_EPI) { if (wr == 0) PG8_BAR; }
        E(acc, cur, wr, wc, fr, fq);
        if (!has_next) break;
#pragma unroll
        for (int a = 0; a < 2; ++a)
#pragma unroll
            for (int b = 0; b < 2; ++b)
#pragma unroll
                for (int m = 0; m < 4; ++m)
#pragma unroll
                    for (int n = 0; n < 2; ++n) acc[a][b][m][n] = (f32x4){0.f, 0.f, 0.f, 0.f};
        cur = nxt; cA = nA; cB = nB; ++ui;
        if constexpr (GATHER) { vC[0][0] = vN[0][0]; vC[0][1] = vN[0][1]; vC[1][0] = vN[1][0]; vC[1][1] = vN[1][1]; }
        if constexpr (ALIGN_EPI) { if (wr == 1) PG8_BAR; }
    }
    PG8_WAIT_V(0);
    if constexpr (!ALIGN_EPI) { if (wr == 0) PG8_BAR; }
    PG8_BAR;
#undef PG8_SA
#undef PG8_SB
#undef PG8_STAGE
#undef PG8_LDA
#undef PG8_LDB
#undef PG8_MMA
#undef PG8_WAIT_V
#undef PG8_WAIT_L
#undef PG8_BAR
#undef PG8_SCHED
}
struct SchedDense {
    const char* A0; const char* B0; const char* A1; const char* B1; int nM, nN0, nN1, K, G, c, colmul;
    __device__ __forceinline__ bool next(int i, Unit& u) const {
        int pm, pn; if (!static_order(i, G, c, nM, nN0 + nN1, pm, pn)) return false;
        const int sec = pn >= nN0 ? 1 : 0, pl = pn - (sec ? nN0 : 0);
        u.A = (sec ? A1 : A0) + (size_t)pm * 256 * K * 2; u.B = (sec ? B1 : B0) + (size_t)pl * 256 * K * 2;
        u.row0 = pm * 256; u.col0 = pl * colmul; u.e = sec; u.pos0 = 0; u.cnt = 0; return true;
    }
    __device__ __forceinline__ void voff(const Unit&, const int (&R)[2], const int (&C)[2], int K_, unsigned (&v)[2][2]) const { voff_plain(R, C, K_, v); }
};
}
template <class EP> struct EpU { EP ep; __device__ __forceinline__ void operator()(const pg8::Unit&, int m, int n, f32x4 v) const { ep(m, n, v); }
    __device__ __forceinline__ void op8(const pg8::Unit&, int m, int n, f32x4 a, f32x4 b) const { ep.op8(m, n, a, b); } };
template <class EP> struct EpUP { EP ep; __device__ __forceinline__ void pair(const pg8::Unit&, int m, int ch, f32x4 a, f32x4 b) const { ep.pair(m, ch, a, b); }
    __device__ __forceinline__ void pair8(const pg8::Unit&, int m, int ch, f32x4 a0, f32x4 a1, f32x4 b0, f32x4 b1) const { ep.pair8(m, ch, a0, a1, b0, b1); } };
struct EpG1 { static constexpr bool PERM = true; bf16* BG; bf16* Z;
    __device__ __forceinline__ void operator()(const f32x4 (&acc)[2][2][4][2], const pg8::Unit& u, int wr, int wc, int fr, int fq) const {
        if (u.e == 0) { pg8::EpiWrap<EpU<EpBf16>, false, true> w{{{BG, DM}}}; w(acc, u, wr, wc, fr, fq); }
        else { pg8::Unit u2 = u; u2.col0 = u.col0 >> 1; pg8::EpiWrap<EpUP<EpMulPair>, true, true> w{{{Z, DM}}}; w(acc, u2, wr, wc, fr, fq); }
    } };
struct EpNull { static constexpr bool PERM = false; __device__ __forceinline__ void operator()(const f32x4 (&acc)[2][2][4][2], const pg8::Unit&, int, int, int, int) const {
#pragma unroll
    for (int a = 0; a < 2; ++a)
#pragma unroll
        for (int b = 0; b < 2; ++b)
#pragma unroll
            for (int m = 0; m < 4; ++m)
#pragma unroll
                for (int n = 0; n < 2; ++n) asm volatile("" :: "v"(acc[a][b][m][n])); } };
struct EpKVQG { bf16* KV; bf16* Q; float* GATE; const float* bg;
    __device__ __forceinline__ void operator()(const pg8::Unit& u, int m, int n, f32x4 v) const { if (u.e == 0) { EpKV e{KV}; e(m, n, v); } else { EpQG e{Q, GATE, bg}; e(m, n, v); } }
    __device__ __forceinline__ void op8(const pg8::Unit& u, int m, int n, f32x4 a, f32x4 b) const { if (u.e == 0) { EpKV e{KV}; e.op8(m, n, a, b); } else { EpQG e{Q, GATE, bg}; e.op8(m, n, a, b); } } };

__device__ __forceinline__ void p3_conv(Frame& F) {
    const bf16* BG = (const bf16*)(F.wsp() + WS_BG); const bf16* Z = (const bf16*)(F.wsp() + WS_Z); bf16* A2 = (bf16*)(F.wsp() + WS_A2);
    const float* cw = F.inp(I_CONVW); const float* cb = F.inp(I_CONVB);
    const int gt = F.gw * 64 + F.lane, NT_ = F.NGW * 64;
    for (int it = gt; it < T * 128; it += NT_) {
        const int m = it >> 7, ch = (it & 127) * 8, t = m & 4095;
        const u32x4 bg = *(const u32x4*)(BG + (size_t)m * DM + ch);
        const u32x4 z0 = *(const u32x4*)(Z + (size_t)m * DM + ch);
        u32x4 z1 = (u32x4){0, 0, 0, 0}, z2 = (u32x4){0, 0, 0, 0};
        if (t >= 1) z1 = *(const u32x4*)(Z + (size_t)(m - 1) * DM + ch);
        if (t >= 2) z2 = *(const u32x4*)(Z + (size_t)(m - 2) * DM + ch);
        u32x4 o;
#pragma unroll
        for (int w = 0; w < 4; ++w) {
            const int c = ch + 2 * w;
            const float r0 = bflo(bg[w]) * (cw[c] * bflo(z2[w]) + cw[1024 + c] * bflo(z1[w]) + cw[2048 + c] * bflo(z0[w]) + cb[c]);
            const float r1 = bfhi(bg[w]) * (cw[c + 1] * bfhi(z2[w]) + cw[1024 + c + 1] * bfhi(z1[w]) + cw[2048 + c + 1] * bfhi(z0[w]) + cb[c + 1]);
            o[w] = pk2(r0, r1);
        }
        *(u32x4*)(A2 + (size_t)m * DM + ch) = o;
    }
}

__device__ __forceinline__ void ln_row(f32x4 (&v)[4], const float* g, const float* bb, int lane) {
    float s = 0.f;
#pragma unroll
    for (int j = 0; j < 4; ++j) s += (v[j][0] + v[j][1]) + (v[j][2] + v[j][3]);
    const float mean = wave_sum(s) * (1.f / DM); float s2 = 0.f;
#pragma unroll
    for (int j = 0; j < 4; ++j) { v[j] = v[j] - mean; s2 += (v[j][0] * v[j][0] + v[j][1] * v[j][1]) + (v[j][2] * v[j][2] + v[j][3] * v[j][3]); }
    const float rstd = 1.f / sqrtf(wave_sum(s2) * (1.f / DM) + LN_EPS);
#pragma unroll
    for (int j = 0; j < 4; ++j) { const int col = 4 * lane + 256 * j; v[j] = v[j] * rstd * *(const f32x4*)(g + col) + *(const f32x4*)(bb + col); }
}
template <int L, bool DRY = false>
__device__ __forceinline__ void p_ln_router(Frame& F) {
    bf16* RES = (bf16*)(F.wsp() + WS_XB); bf16* U = (bf16*)(F.wsp() + WS_U);
    bf16* RESO = DRY ? (bf16*)(F.wsp() + WS_Y0) : RES; if (DRY) U = (bf16*)(F.wsp() + WS_H);
    const float* MOD = (const float*)(F.wsp() + WS_MOD) + (size_t)L * 4 * 6144;
    const float* rw = F.inp(I_RW); const float* rb = F.inp(I_RB);
    gu32* cnt = F.ctlp() + CW_CNT + L * 1024;
    unsigned* LIST = (unsigned*)(F.wsp() + WS_LIST) + (size_t)L * NE * T; float* LW = (float*)(F.wsp() + WS_LW) + (size_t)L * NE * T;
    const int lane = F.lane;
    LAS int* ae = (LAS int*)F.lds; LAS float* aw = (LAS float*)(F.lds + 512); LAS int* base = (LAS int*)(F.lds + 1024);
    constexpr int RS = 2064, AST_OFF = 2048, ALO_OFF = AST_OFF + 16 * RS, PST_OFF = ALO_OFF + 16 * RS;
    static_assert(PST_OFF + 8192 <= LDSCTL_OFF, "router LDS map");
    const int r16 = lane & 15, kg = lane >> 4;
    bf16x8 Bh[4], Bl[4];
#pragma unroll
    for (int s_ = 0; s_ < 4; ++s_) { u32x4 hh, ll;
#pragma unroll
        for (int i = 0; i < 4; ++i) { const int k = 128 * F.wave + 32 * s_ + 8 * kg + 2 * i; const float a = rw[(size_t)k * 16 + r16], b_ = rw[(size_t)(k + 1) * 16 + r16];
            const unsigned h = pk2(a, b_); hh[i] = h; ll[i] = pk2(a - bflo(h), b_ - bfhi(h)); }
        Bh[s_] = __builtin_bit_cast(bf16x8, hh); Bl[s_] = __builtin_bit_cast(bf16x8, ll); }
    const int nchunk = T / 64;
    for (int ch = blockIdx.x; ch < nchunk; ch += gridDim.x) {
      const bf16* YB = (const bf16*)(F.wsp() + WS_Y0); const float* XF = F.inp(I_X);
      u32x2 yn[4]; f32x4 xn[4];
#pragma unroll
      for (int j = 0; j < 4; ++j) { const size_t o = (size_t)(ch * 64 + F.wave * 2) * DM + 4 * lane + 256 * j; yn[j] = *(const u32x2*)(YB + o);
          if (L == 0) xn[j] = *(const f32x4*)(XF + o); else xn[j] = ld_bf4(RES + o); }
#pragma unroll 2
      for (int rr = 0; rr < 8; ++rr) {
        const int pass = rr >> 1, sub = rr & 1, lrow = pass * 16 + F.wave * 2 + sub, m = ch * 64 + lrow;
        const int b = m >> 12;
        f32x4 v[4];
#pragma unroll
        for (int j = 0; j < 4; ++j) { const f32x4 g1 = *(const f32x4*)(MOD + b * 6144 + 2 * 1024 + 4 * lane + 256 * j);
            v[j] = xn[j] * ALPHA + g1 * (f32x4){bflo(yn[j].x), bfhi(yn[j].x), bflo(yn[j].y), bfhi(yn[j].y)}; }
        if (rr < 7) {
#pragma unroll
            for (int j = 0; j < 4; ++j) { const size_t o = (size_t)(m + (sub ? 15 : 1)) * DM + 4 * lane + 256 * j; yn[j] = *(const u32x2*)(YB + o);
                if (L == 0) xn[j] = *(const f32x4*)(XF + o); else xn[j] = ld_bf4(RES + o); } }
        ln_row(v, F.inp(I_LNG) + (L * 2 + 0) * DM, F.inp(I_LNB) + (L * 2 + 0) * DM, lane);
        {
            LAS unsigned char* arow = F.lds + AST_OFF + (F.wave * 2 + sub) * RS + lane * 8;
#pragma unroll
            for (int j = 0; j < 4; ++j) { const int col = 4 * lane + 256 * j;
                st_bf4(RESO + (size_t)m * DM + col, v[j]);
                const f32x4 u = v[j] * (*(const f32x4*)(MOD + b * 6144 + 4 * 1024 + col) + 1.0f) + *(const f32x4*)(MOD + b * 6144 + 3 * 1024 + col);
                u32x2 hh, ll; hh.x = pk2(u[0], u[1]); hh.y = pk2(u[2], u[3]);
                ll.x = pk2(u[0] - bflo(hh.x), u[1] - bfhi(hh.x)); ll.y = pk2(u[2] - bflo(hh.y), u[3] - bfhi(hh.y));
                *(u32x2*)(U + (size_t)m * DM + col) = hh;
                *(LAS u32x2*)(arow + j * 512) = hh; *(LAS u32x2*)(arow + 16 * RS + j * 512) = ll; }
        }
        if (sub == 0) continue;
        __syncthreads();
        float lgv;
        {
            f32x4 acc = (f32x4){0.f, 0.f, 0.f, 0.f};
            const LAS unsigned char* ap = F.lds + AST_OFF + r16 * RS + (128 * F.wave + 8 * kg) * 2;
#pragma unroll
            for (int s_ = 0; s_ < 4; ++s_) { const bf16x8 ah = *(const LAS bf16x8*)(ap + s_ * 64), al = *(const LAS bf16x8*)(ap + 16 * RS + s_ * 64);
                acc = __builtin_amdgcn_mfma_f32_16x16x32_bf16(ah, Bh[s_], acc, 0, 0, 0);
                acc = __builtin_amdgcn_mfma_f32_16x16x32_bf16(al, Bh[s_], acc, 0, 0, 0);
                acc = __builtin_amdgcn_mfma_f32_16x16x32_bf16(ah, Bl[s_], acc, 0, 0, 0); }
            *(LAS f32x4*)(F.lds + PST_OFF + ((F.wave * 4 + kg) * 16 + r16) * 16) = acc;
            __syncthreads();
            const int rho = 2 * F.wave + (kg & 1); float sm = 0.f;
#pragma unroll
            for (int x = 0; x < 4; ++x) sm += *(const LAS float*)(F.lds + PST_OFF + ((((kg >> 1) * 4 + x) * 4 + (rho >> 2)) * 16 + r16) * 16 + (rho & 3) * 4);
            lgv = sm + __shfl_xor(sm, 32);
        }
#pragma unroll 1
        for (int sb = 0; sb < 2; ++sb) {
        const int lrow2 = pass * 16 + F.wave * 2 + sb;
        float lg[16];
#pragma unroll
        for (int e = 0; e < 16; ++e) lg[e] = __builtin_bit_cast(float, __builtin_amdgcn_readlane(__builtin_bit_cast(int, lgv), 16 * sb + e));
        float mx = lg[0];
#pragma unroll
        for (int e = 1; e < 16; ++e) mx = fmaxf(mx, lg[e]);
        float aff[16], bi[16]; float sum = 0.f;
#pragma unroll
        for (int e = 0; e < 16; ++e) { aff[e] = __expf(lg[e] - mx); sum += aff[e]; }
        const float inv = 1.f / sum;
#pragma unroll
        for (int e = 0; e < 16; ++e) { aff[e] *= inv; bi[e] = aff[e] + rb[e]; }
        float gs[4];
#pragma unroll
        for (int g = 0; g < 4; ++g) { const float a0 = bi[4 * g], a1 = bi[4 * g + 1], a2 = bi[4 * g + 2], a3 = bi[4 * g + 3];
            const float t1 = fmaxf(a0, a1), t2 = fminf(a0, a1), u1 = fmaxf(a2, a3), u2 = fminf(a2, a3);
            gs[g] = fmaxf(t1, u1) + fmaxf(fminf(t1, u1), fmaxf(t2, u2)); }
        int best = 0; float bv = gs[0];
#pragma unroll
        for (int g = 1; g < 4; ++g) if (gs[g] > bv) { bv = gs[g]; best = g; }
        float cb_[4], ca_[4];
#pragma unroll
        for (int i = 0; i < 4; ++i) { cb_[i] = best == 0 ? bi[i] : best == 1 ? bi[4 + i] : best == 2 ? bi[8 + i] : bi[12 + i];
                                      ca_[i] = best == 0 ? aff[i] : best == 1 ? aff[4 + i] : best == 2 ? aff[8 + i] : aff[12 + i]; }
        int i0 = 0; float b0 = cb_[0];
#pragma unroll
        for (int i = 1; i < 4; ++i) if (cb_[i] > b0) { b0 = cb_[i]; i0 = i; }
        int i1 = -1; float b1 = -3.0e38f;
#pragma unroll
        for (int i = 0; i < 4; ++i) if (i != i0 && cb_[i] > b1) { b1 = cb_[i]; i1 = i; }
        const float w0 = i0 == 0 ? ca_[0] : i0 == 1 ? ca_[1] : i0 == 2 ? ca_[2] : ca_[3];
        const float w1 = i1 == 0 ? ca_[0] : i1 == 1 ? ca_[1] : i1 == 2 ? ca_[2] : ca_[3];
        const float ws_ = 1.f / (w0 + w1);
        if (lane == 0) { ae[2 * lrow2] = best * 4 + i0; ae[2 * lrow2 + 1] = best * 4 + i1; aw[2 * lrow2] = w0 * ws_; aw[2 * lrow2 + 1] = w1 * ws_; }
        }
      }
      __syncthreads();
      if (DRY) continue;
      if (F.tid < NE) { int c = 0; for (int i = 0; i < 128; ++i) c += (ae[i] == F.tid) ? 1 : 0;
          base[F.tid] = c ? (int)__hip_atomic_fetch_add(cnt + F.tid * 64, (unsigned)c, RLX_AGENT) : 0; }
      __syncthreads();
      if (F.tid < 128) { const int e = ae[F.tid]; int rk = 0; for (int i = 0; i < F.tid; ++i) rk += (ae[i] == e) ? 1 : 0;
          const int pos = base[e] + rk; const unsigned m = (unsigned)(ch * 64 + (F.tid >> 1));
          LIST[(size_t)e * T + pos] = m * 2u + (unsigned)(F.tid & 1); LW[(size_t)e * T + pos] = aw[F.tid]; }
      __syncthreads();
    }
}
template <int L, bool DRY = false>
__device__ __forceinline__ void p_ln2(Frame& F) {
    bf16* RES = (bf16*)(F.wsp() + WS_XB); bf16* U = (bf16*)(F.wsp() + WS_U); float* OUT = F.outp();
    bf16* RESO = DRY ? (bf16*)(F.wsp() + WS_R1) : RES; if (DRY) { U = (bf16*)(F.wsp() + WS_H); }
    const bf16* Y0 = (const bf16*)(F.wsp() + WS_Y0); const bf16* Y1 = (const bf16*)(F.wsp() + WS_Y1);
    const float* MOD = (const float*)(F.wsp() + WS_MOD) + (size_t)L * 4 * 6144;
    const float* MODN = (const float*)(F.wsp() + WS_MOD) + (size_t)1 * 4 * 6144;
    const int lane = F.lane;
    for (int m = F.gw; m < T; m += F.NGW) {
        const int b = m >> 12;
        f32x4 v[4];
#pragma unroll
        for (int j = 0; j < 4; ++j) { const int col = 4 * lane + 256 * j;
            const f32x4 x = ld_bf4(RES + (size_t)m * DM + col);
            const u32x2 a = *(const u32x2*)(Y0 + (size_t)m * DM + col), c = *(const u32x2*)(Y1 + (size_t)m * DM + col);
            const f32x4 y = (f32x4){bflo(a.x) + bflo(c.x), bfhi(a.x) + bfhi(c.x), bflo(a.y) + bflo(c.y), bfhi(a.y) + bfhi(c.y)};
            v[j] = x * ALPHA + *(const f32x4*)(MOD + b * 6144 + 5 * 1024 + col) * y; }
        ln_row(v, F.inp(I_LNG) + (L * 2 + 1) * DM, F.inp(I_LNB) + (L * 2 + 1) * DM, lane);
#pragma unroll
        for (int j = 0; j < 4; ++j) { const int col = 4 * lane + 256 * j;
            if (L == 1) *(f32x4*)(OUT + (size_t)m * DM + col) = v[j];
            if (L == 0) { st_bf4(RESO + (size_t)m * DM + col, v[j]);
                st_bf4(U + (size_t)m * DM + col, v[j] * (*(const f32x4*)(MODN + b * 6144 + 1024 + col) + 1.0f) + *(const f32x4*)(MODN + b * 6144 + col)); } }
    }
}

__device__ __forceinline__ void moe_tables(Frame& F, int L) {
    LAS int* tb = (LAS int*)(F.lds + MISC_OFF + 128); LAS int* cn = tb + 20;
    LAS unsigned char* te = (LAS unsigned char*)(tb + 40);
    __syncthreads();
    if (F.tid < NE) cn[F.tid] = (int)__hip_atomic_load(F.ctlp() + CW_CNT + L * 1024 + F.tid * 64, RLX_AGENT);
    __syncthreads();
    if (F.tid == 0) { int acc = 0; for (int e = 0; e < NE; ++e) { const int nte = (cn[e] + 255) >> 8; tb[e] = acc; for (int q = 0; q < nte; ++q) te[acc + q] = (unsigned char)e; acc += nte; } tb[NE] = acc; }
    __syncthreads();
}
struct ARowMoe { const bf16* U; const unsigned* list; int rbase, cnt;
    __device__ __forceinline__ const bf16* operator()(int r) const { const int pos = r - rbase; const unsigned tok = pos < cnt ? (list[pos] >> 1) : 0u; return U + (size_t)tok * DM; } };
struct EpY { bf16* Y; const unsigned* list; const float* lw; int rbase, cnt;
    __device__ __forceinline__ void operator()(int r, int n, f32x4 v) const { const int pos = r - rbase; if (pos < cnt) { const unsigned ts = list[pos]; const float w = lw[pos];
        st_bf4(Y + (size_t)(ts & 1u) * ((size_t)T * DM) + (size_t)(ts >> 1) * DM + n, v * w); } } };
template <int L>
__device__ __forceinline__ void p_moe_gu(Frame& F) {
    moe_tables(F, L);
    LAS int* tb = (LAS int*)(F.lds + MISC_OFF + 128); LAS int* cn = tb + 20;
    const unsigned* LIST = (const unsigned*)(F.wsp() + WS_LIST) + (size_t)L * NE * T;
    const int total = tb[NE] * 4 * 16;
    for (int it = F.gw; it < total; it += F.NGW) {
        const int ni = it & 15, mt = it >> 4; int e = 0; while (tb[e + 1] * 4 <= mt) ++e;
        const ARowMoe ar{(const bf16*)(F.wsp() + WS_U), LIST + (size_t)e * T, tb[e] * 256, cn[e]};
        const EpSiluPair ep{(bf16*)(F.wsp() + WS_H), FF};
        const int pn = ni >> 2, q = ni & 3;
        gemm_wave_tile<true>(ar, (const bf16*)(F.wsp() + WS_WGU) + (size_t)(L * NE + e) * 1024 * 1024 + (size_t)(pn * 256 + q * 32) * 1024, 1024, mt * 64, pn * 128 + q * 32, ep, F.lane);
    }
}
template <int L>
__device__ __forceinline__ void p_moe_down(Frame& F) {
    moe_tables(F, L);
    LAS int* tb = (LAS int*)(F.lds + MISC_OFF + 128); LAS int* cn = tb + 20;
    const unsigned* LIST = (const unsigned*)(F.wsp() + WS_LIST) + (size_t)L * NE * T; const float* LW = (const float*)(F.wsp() + WS_LW) + (size_t)L * NE * T;
    const int total = tb[NE] * 4 * 16;
    for (int it = F.gw; it < total; it += F.NGW) {
        const int ni = it & 15, mt = it >> 4; int e = 0; while (tb[e + 1] * 4 <= mt) ++e;
        const ARowPlain ar{(const bf16*)(F.wsp() + WS_H), FF};
        const EpY ep{(bf16*)(F.wsp() + WS_Y0), LIST + (size_t)e * T, LW + (size_t)e * T, tb[e] * 256, cn[e]};
        gemm_wave_tile<false>(ar, (const bf16*)(F.wsp() + WS_WDN) + (size_t)(L * NE + e) * 1024 * 512 + (size_t)(ni * 64) * 512, 512, mt * 64, ni * 64, ep, F.lane);
    }
}

struct ARowCmp { const bf16* KVi; __device__ __forceinline__ const bf16* operator()(int R) const { return KVi + ((size_t)(R >> 8) * KVROWS + (size_t)(R & 255) * 16) * 64; } };
__device__ __forceinline__ float gelu_tanh(float x) { const float u = 0.7978845608028654f * (x + 0.044715f * x * x * x); const float e = __expf(2.f * u); const float th = 1.f - 2.f / (e + 1.f); return 0.5f * x * (1.f + th); }
__device__ __forceinline__ void p_cmp_finish(Frame& F) {
    LAS float* w2s = (LAS float*)F.lds;
    LAS float* hd = (LAS float*)(F.lds + 65536 + F.wave * 4096);
    const float* TB = (const float*)(F.wsp() + WS_TB); const float* PETP = (const float*)(F.wsp() + WS_PETP);
    const int lane = F.lane;
    for (int base = blockIdx.x * 32; base < 2 * 16 * 256; base += gridDim.x * 32) {
        const int i = base >> 12;
        __syncthreads();
        const int it0 = base + F.wave * 4, bh = (it0 >> 8) & 15, n0 = it0 & 255, c = 4 * lane;
        f32x4 wv[8], ta[4], tb_[4];
#pragma unroll
        for (int k = 0; k < 8; ++k) wv[k] = *(const f32x4*)(F.inp(I_CW2) + (size_t)i * 256 * 64 + 4 * (F.tid + 512 * k));
#pragma unroll
        for (int r = 0; r < 4; ++r) { const int n = n0 + r < 255 ? n0 + r : 254; const float* r0 = TB + ((size_t)i * 4096 + bh * 256 + n) * 512; ta[r] = *(const f32x4*)(r0 + c); tb_[r] = *(const f32x4*)(r0 + 512 + 256 + c); }
        const f32x4 pe = *(const f32x4*)(PETP + 64 * 256 + i * 256 + c);
#pragma unroll
        for (int k = 0; k < 8; ++k) *(LAS f32x4*)(w2s + 4 * (F.tid + 512 * k)) = wv[k];
#pragma unroll
        for (int r = 0; r < 4; ++r) { const int n = n0 + r;
            f32x4 h = (f32x4){0.f, 0.f, 0.f, 0.f};
            if (n < 255) h = ta[r] + tb_[r] + pe;
#pragma unroll
            for (int q = 0; q < 4; ++q) hd[(c + q) * 4 + r] = gelu_tanh(h[q]); }
        __syncthreads();
        const float b2 = F.inp(I_CB2)[i * 64 + lane];
        float a0 = b2, a1 = b2, a2 = b2, a3 = b2;
#pragma unroll 8
        for (int cc = 0; cc < 256; ++cc) { const float w = w2s[cc * 64 + lane]; const f32x4 h4 = *(const LAS f32x4*)(hd + cc * 4);
            a0 += h4[0] * w; a1 += h4[1] * w; a2 += h4[2] * w; a3 += h4[3] * w; }
        const float av[4] = {a0, a1, a2, a3};
#pragma unroll
        for (int r = 0; r < 4; ++r) { const int n = n0 + r;
            bf16* dst = (bf16*)(F.wsp() + (i ? WS_VC : WS_KC)) + (size_t)bh * 256 * 64 + (size_t)(n >> 6) * 4096 + (i ? vfrag_off(n & 63, lane) : kfrag_off(n & 63, lane));
            *dst = (n == 255) ? (bf16)0 : (bf16)f2bf(av[r]); }
    }
}

__device__ __forceinline__ void score_tile(const bf16* krow, const LAS float* qs, float (&s)[4]) {
    s[0] = s[1] = s[2] = s[3] = 0.f;
#pragma unroll
    for (int c = 0; c < 8; ++c) { const u32x4 kv = *(const u32x4*)(krow + 8 * c);
#pragma unroll
        for (int w = 0; w < 4; ++w) { const f32x4 qa = *(const LAS f32x4*)(qs + (8 * c + 2 * w) * 4), qb = *(const LAS f32x4*)(qs + (8 * c + 2 * w + 1) * 4);
            const float ka = bflo(kv[w]), kb = bfhi(kv[w]);
            s[0] += ka * qa[0] + kb * qb[0]; s[1] += ka * qa[1] + kb * qb[1]; s[2] += ka * qa[2] + kb * qb[2]; s[3] += ka * qa[3] + kb * qb[3]; } }
}
__device__ __forceinline__ void attend_tile(const bf16* Kt, const bf16* Vt, bool valid, const LAS float* qs, LAS float* pbuf, float (&mr)[4], float (&l)[4], float (&o)[4], int lane) {
    float s[4]; score_tile(Kt + (size_t)lane * 64, qs, s);
    f32x4 p4;
#pragma unroll
    for (int g = 0; g < 4; ++g) {
        const float sg = valid ? s[g] : -INFINITY; const float tm = wave_max(sg); const float mn = fmaxf(mr[g], tm);
        const float mref = (mn == -INFINITY) ? 0.f : mn;
        const float alpha = __builtin_amdgcn_exp2f(mr[g] - mref); const float p = valid ? __builtin_amdgcn_exp2f(sg - mref) : 0.f;
        l[g] = l[g] * alpha + wave_sum(p); o[g] *= alpha; mr[g] = mn; p4[g] = p;
    }
    LDS_WAIT(); asm volatile("" ::: "memory");
    *(LAS f32x4*)(pbuf + lane * 4) = p4;
    LDS_WAIT(); asm volatile("" ::: "memory");
#pragma unroll 8
    for (int k = 0; k < 64; ++k) { const f32x4 pk = *(const LAS f32x4*)(pbuf + k * 4); const float vv = bf2f(Vt[(size_t)k * 64 + lane]);
        o[0] += pk[0] * vv; o[1] += pk[1] * vv; o[2] += pk[2] * vv; o[3] += pk[3] * vv; }
    LDS_WAIT(); asm volatile("" ::: "memory");
}
__device__ __forceinline__ void p_attn_simple(Frame& F) {
    LAS float* qs = (LAS float*)(F.lds + F.wave * 16384);
    LAS float* pbuf = qs + 256;
    LAS float* psum = pbuf + 1024;
    const bf16* Q = (const bf16*)(F.wsp() + WS_Q); const float* GATE = (const float*)(F.wsp() + WS_GATE); bf16* O = (bf16*)(F.wsp() + WS_O);
    const bf16* KVb = (const bf16*)(F.wsp() + WS_KV);
    const int lane = F.lane;
    for (int it = F.gw; it < 16 * SEQ; it += F.NGW) {
        const int bh = it & 15, t = it >> 4, b = bh >> 2, hk = bh & 3, m = b * SEQ + t;
        LDS_WAIT(); asm volatile("" ::: "memory");
        { f32x4 q4; for (int g = 0; g < 4; ++g) q4[g] = bf2f(Q[(size_t)m * DM + (hk * 4 + g) * 64 + lane]); *(LAS f32x4*)(qs + lane * 4) = q4; }
        LDS_WAIT(); asm volatile("" ::: "memory");
        const bf16* KC = (const bf16*)(F.wsp() + WS_KC) + (size_t)bh * 256 * 64; const bf16* VC = (const bf16*)(F.wsp() + WS_VC) + (size_t)bh * 256 * 64;
        const int nv = t >= 31 ? ((t - 31) >> 4) + 1 : 0;
        float sc[4][4];
#pragma unroll
        for (int i = 0; i < 4; ++i) { float s[4] = {0.f, 0.f, 0.f, 0.f}; if (64 * i < nv) score_tile(KC + (size_t)(64 * i + lane) * 64, qs, s);
            const bool v = (64 * i + lane) < nv;
#pragma unroll
            for (int g = 0; g < 4; ++g) sc[i][g] = v ? s[g] : -INFINITY; }
        float oc[4];
#pragma unroll
        for (int g = 0; g < 4; ++g) {
            const float mx = wave_max(fmaxf(fmaxf(sc[0][g], sc[1][g]), fmaxf(sc[2][g], sc[3][g]))); const float mref = (mx == -INFINITY) ? 0.f : mx;
            float e[4]; float ls = 0.f;
#pragma unroll
            for (int i = 0; i < 4; ++i) { e[i] = __builtin_amdgcn_exp2f(sc[i][g] - mref); ls += e[i]; }
            const float inv = 1.f / fmaxf(wave_sum(ls), 1e-30f);
#pragma unroll
            for (int i = 0; i < 4; ++i) sc[i][g] = e[i] * inv;
        }
#pragma unroll
        for (int i = 0; i < 4; ++i) { *(LAS f32x4*)(pbuf + (64 * i + lane) * 4) = (f32x4){sc[i][0], sc[i][1], sc[i][2], sc[i][3]};
            psum[64 * i + lane + 1] = (sc[i][0] + sc[i][1]) + (sc[i][2] + sc[i][3]); }
        if (lane == 0) psum[0] = 0.f;
        LDS_WAIT(); asm volatile("" ::: "memory");
        oc[0] = oc[1] = oc[2] = oc[3] = 0.f;
        for (int n = 0; n < nv; ++n) { const f32x4 pk = *(const LAS f32x4*)(pbuf + n * 4); const float vv = bf2f(VC[(size_t)n * 64 + lane]);
            oc[0] += pk[0] * vv; oc[1] += pk[1] * vv; oc[2] += pk[2] * vv; oc[3] += pk[3] * vv; }
        const float imp = 0.5f * psum[4 * lane] + psum[4 * lane + 1] + psum[4 * lane + 2] + psum[4 * lane + 3] + 0.5f * psum[4 * lane + 4];
        const int cur = t >> 6;
        const bool allowed = lane <= cur, forced = allowed && (lane == 0 || lane == cur || lane == cur - 1);
        const float score = forced ? 1e9f : (allowed ? imp : -1e30f);
        int rank = 0;
#pragma unroll
        for (int j = 0; j < 64; ++j) { const float sj = __shfl(score, j); rank += (sj > score || (sj == score && j < lane)) ? 1 : 0; }
        const unsigned long long mask = __ballot(rank < 16 && score > -0.5e30f);
        LDS_WAIT(); asm volatile("" ::: "memory");
        const bf16* KS = KVb + 2 * KVBUF_ELEMS + (size_t)bh * KVROWS * 64; const bf16* VS = KVb + 3 * KVBUF_ELEMS + (size_t)bh * KVROWS * 64;
        float ms[4] = {-INFINITY, -INFINITY, -INFINITY, -INFINITY}, ls[4] = {0.f, 0.f, 0.f, 0.f}, os[4] = {0.f, 0.f, 0.f, 0.f};
        for (unsigned long long mk = mask; mk; mk &= mk - 1) { const int j = __builtin_ctzll(mk);
            attend_tile(KS + (size_t)j * 64 * 64, VS + (size_t)j * 64 * 64, (64 * j + lane) <= t, qs, pbuf, ms, ls, os, lane); }
        const bf16* KW = KVb + 4 * KVBUF_ELEMS + (size_t)bh * KVROWS * 64; const bf16* VW = KVb + 5 * KVBUF_ELEMS + (size_t)bh * KVROWS * 64;
        float mw[4] = {-INFINITY, -INFINITY, -INFINITY, -INFINITY}, lw[4] = {0.f, 0.f, 0.f, 0.f}, ow[4] = {0.f, 0.f, 0.f, 0.f};
        const int lo = t - 511 > 0 ? t - 511 : 0;
        for (int j = lo >> 6; j <= (t >> 6); ++j) { const int pos = 64 * j + lane;
            attend_tile(KW + (size_t)j * 64 * 64, VW + (size_t)j * 64 * 64, pos >= lo && pos <= t, qs, pbuf, mw, lw, ow, lane); }
#pragma unroll
        for (int g = 0; g < 4; ++g) { const float* gp = GATE + (size_t)m * 48 + (hk * 4 + g) * 3;
            const float o = gp[0] * oc[g] + gp[1] * os[g] / fmaxf(ls[g], 1e-30f) + gp[2] * ow[g] / fmaxf(lw[g], 1e-30f);
            O[(size_t)m * DM + (hk * 4 + g) * 64 + lane] = (bf16)f2bf(o); }
    }
}

struct SchedCmp { const char* KV; const char* W1C; int G, c;
    __device__ __forceinline__ bool next(int it, pg8::Unit& u) const { const int L = it * G + c; if (c < 0 || L >= 64) return false;
        const int i = L >> 5, pm = (L >> 1) & 15, pn = L & 1;
        u.A = KV + ((size_t)i * KVBUF_ELEMS + (size_t)pm * KVROWS * 64) * 2; u.B = W1C + ((size_t)i * 512 * 1024 + (size_t)pn * 256 * 1024) * 2;
        u.row0 = i * 4096 + pm * 256; u.col0 = pn * 256; u.e = i; u.pos0 = 0; u.cnt = 0; return true; }
    __device__ __forceinline__ void voff(const pg8::Unit&, const int (&R)[2], const int (&C)[2], int K_, unsigned (&v)[2][2]) const { pg8::voff_plain(R, C, K_, v); }
};
struct SchedKVQG { const char* A0; const char* B0; const char* A1; const char* B1; int G, c, Lbase, Lend;
    __device__ __forceinline__ bool next(int it, pg8::Unit& u) const { const int L = Lbase + it * G + c; if (c < 0 || L >= Lend) return false;
        const int sec = L >= 384 ? 1 : 0, l = sec ? L - 384 : L, nn = sec ? 5 : 6, pm = l / nn, pn = l % nn;
        u.A = (sec ? A1 : A0) + (size_t)pm * 256 * DM * 2; u.B = (sec ? B1 : B0) + (size_t)pn * 256 * DM * 2;
        u.row0 = pm * 256; u.col0 = pn * 256; u.e = sec; u.pos0 = 0; u.cnt = 0; return true; }
    __device__ __forceinline__ void voff(const pg8::Unit&, const int (&R)[2], const int (&C)[2], int K_, unsigned (&v)[2][2]) const { pg8::voff_plain(R, C, K_, v); }
};
struct SchedMoe { LAS int* tb; LAS int* cn; const unsigned* LIST; const char* Abase; const char* Bbase; size_t bstride; int K, nN, colmul, G, c; bool gather; int Lbase, Lend;
    __device__ __forceinline__ bool next(int it, pg8::Unit& u) const { const int L = Lbase + it * G + c; if (c < 0 || L >= Lend) return false;
        const int mt = L / nN, pn = L % nN; const int e = ((LAS unsigned char*)(tb + 40))[mt];
        u.A = gather ? Abase : Abase + (size_t)mt * 256 * K * 2; u.B = Bbase + (size_t)e * bstride + (size_t)pn * 256 * K * 2;
        u.row0 = mt * 256; u.col0 = pn * colmul; u.e = e; u.pos0 = (mt - tb[e]) * 256; u.cnt = cn[e]; return true; }
    __device__ __forceinline__ void voff(const pg8::Unit& u, const int (&R)[2], const int (&C)[2], int K_, unsigned (&v)[2][2]) const {
        if (!gather) { pg8::voff_plain(R, C, K_, v); return; }
        const unsigned* le = LIST + (size_t)u.e * T; unsigned tk[2][2];
#pragma unroll
        for (int h = 0; h < 2; ++h)
#pragma unroll
            for (int i = 0; i < 2; ++i) { const int pos = u.pos0 + h * 128 + R[i]; tk[h][i] = le[pos < u.cnt ? pos : u.cnt - 1]; }
#pragma unroll
        for (int h = 0; h < 2; ++h)
#pragma unroll
            for (int i = 0; i < 2; ++i) v[h][i] = ((tk[h][i] >> 1) * (unsigned)K_ + (unsigned)C[i]) * 2u;
    }
};
struct EpHU { bf16* H; __device__ __forceinline__ void pair(const pg8::Unit&, int r, int ch, f32x4 a, f32x4 b) const {
    f32x4 s; for (int q = 0; q < 4; ++q) s[q] = silu_f(a[q]) * b[q]; st_bf4(H + (size_t)r * FF + ch, s); }
    __device__ __forceinline__ void pair8(const pg8::Unit&, int r, int ch, f32x4 a0, f32x4 a1, f32x4 b0, f32x4 b1) const {
    f32x4 s0, s1; for (int q = 0; q < 4; ++q) { s0[q] = silu_f(a0[q]) * b0[q]; s1[q] = silu_f(a1[q]) * b1[q]; } st_bf8(H + (size_t)r * FF + ch, s0, s1); } };
struct EpYU { bf16* Y; const unsigned* LIST; const float* LW;
    __device__ __forceinline__ void operator()(const pg8::Unit& u, int r, int n, f32x4 v) const { const int pos = u.pos0 + (r - u.row0);
        if (pos < u.cnt) { const unsigned ts = LIST[(size_t)u.e * T + pos]; const float w = LW[(size_t)u.e * T + pos];
            st_bf4(Y + (size_t)(ts & 1u) * ((size_t)T * DM) + (size_t)(ts >> 1) * DM + n, v * w); } }
    __device__ __forceinline__ void op8(const pg8::Unit& u, int r, int n, f32x4 a, f32x4 b) const { const int pos = u.pos0 + (r - u.row0);
        if (pos < u.cnt) { const unsigned ts = LIST[(size_t)u.e * T + pos]; const float w = LW[(size_t)u.e * T + pos];
            st_bf8(Y + (size_t)(ts & 1u) * ((size_t)T * DM) + (size_t)(ts >> 1) * DM + n, a * w, b * w); } } };
struct EpYUAll { static constexpr bool PERM = true; EpYU ep;
    __device__ __forceinline__ void operator()(const f32x4 (&acc)[2][2][4][2], const pg8::Unit& u, int wr, int wc, int fr, int fq) const {
        unsigned ts[2][4]; float w[2][4];
        const unsigned* le = ep.LIST + (size_t)u.e * T; const float* lw = ep.LW + (size_t)u.e * T;
#pragma unroll
        for (int ai = 0; ai < 2; ++ai)
#pragma unroll
            for (int m = 0; m < 4; ++m) { const int pos = u.pos0 + ai * pg8::HALF + wr * 64 + m * 16 + fr; const int pc = pos < u.cnt ? pos : u.cnt - 1;
                const unsigned t_ = le[pc]; ts[ai][m] = pos < u.cnt ? t_ : 0xFFFFFFFFu; w[ai][m] = lw[pc]; }
#pragma unroll
        for (int ai = 0; ai < 2; ++ai)
#pragma unroll
            for (int m = 0; m < 4; ++m) if (ts[ai][m] != 0xFFFFFFFFu) {
                bf16* yr = ep.Y + (size_t)(ts[ai][m] & 1u) * ((size_t)T * DM) + (size_t)(ts[ai][m] >> 1) * DM + u.col0 + wc * 32 + 8 * fq;
#pragma unroll
                for (int bj = 0; bj < 2; ++bj) st_bf8(yr + bj * pg8::HALF, acc[ai][bj][m][0] * w[ai][m], acc[ai][bj][m][1] * w[ai][m]); }
    } };
template <int L>
__device__ __forceinline__ void p_moe(Frame& F, const XcdBarrier& bar, bool with_barriers) {
    moe_tables(F, L);
    LAS int* tb = (LAS int*)(F.lds + MISC_OFF + 128); LAS int* cn = tb + 20;
    const int G = gridDim.x, bx = blockIdx.x, vcu = (G % 8 == 0) ? (bx % 8) * (G / 8) + bx / 8 : bx;
    const int nt = tb[NE], n128 = nt < 128 ? nt : 128, Wg = 4 * (nt - n128) < G / 2 ? 4 * (nt - n128) : G / 2;
    const int D2 = (4 * n128 < 2 * (G - Wg)) ? 4 * n128 : 2 * (G - Wg);
#pragma unroll 1
    for (int part = 1; part <= 3; ++part) {
        int gc = -1, gG = 1, gb = 0, ge = 0, dc = -1, dG = 1, db = 0, de = 0;
        if (part == 1) { gc = vcu; gG = G; gb = 0; ge = 4 * n128; }
        else if (part == 2) { if (vcu < Wg) { gc = vcu; gG = Wg; gb = 4 * n128; ge = 4 * nt; } else { dc = vcu - Wg; dG = G - Wg; db = 0; de = D2; } }
        else { dc = vcu; dG = G; db = D2; de = 4 * nt; }
        {
            const SchedMoe S{tb, cn, (const unsigned*)(F.wsp() + WS_LIST) + (size_t)L * NE * T, (const char*)(F.wsp() + WS_U), (const char*)(F.wsp() + WS_WGU) + (size_t)L * NE * 1024 * 1024 * 2, (size_t)1024 * 1024 * 2, 1024, 4, 128, gG, gc, true, gb, ge};
            typedef pg8::EpiWrap<EpHU, true, true> E_;
            pg8::gemm_phase<E_, SchedMoe, true, true>(F.lds, 1024, S, E_{{(bf16*)(F.wsp() + WS_H)}});
        }
        {
            const SchedMoe S{tb, cn, nullptr, (const char*)(F.wsp() + WS_H), (const char*)(F.wsp() + WS_WDN) + (size_t)L * NE * 1024 * 512 * 2, (size_t)1024 * 512 * 2, 512, 4, 256, dG, dc, false, db, de};
            typedef EpYUAll E_;
            pg8::gemm_phase<E_, SchedMoe, true, false>(F.lds, 512, S, E_{{(bf16*)(F.wsp() + WS_Y0), (const unsigned*)(F.wsp() + WS_LIST) + (size_t)L * NE * T, (const float*)(F.wsp() + WS_LW) + (size_t)L * NE * T}});
        }
        if (part < 3 && with_barriers) xcd_barrier(bar);
    }
}
typedef float f32x16 __attribute__((ext_vector_type(16)));
#define MFMA32(a, b, c) __builtin_amdgcn_mfma_f32_32x32x16_bf16(a, b, c, 0, 0, 0)
constexpr size_t WS_MASK = WS_GATE + 3 * MiB;
constexpr int STG_STRIDE = 68, STG_BYTES = 32 * STG_STRIDE * 4;
__device__ __forceinline__ int crow(int r, int hi) { return (r & 3) + 8 * (r >> 2) + 4 * hi; }
__device__ __forceinline__ unsigned cvtpk(float lo, float hi) { f32x2v v = {lo, hi}; bf16x2_t b = __builtin_convertvector(v, bf16x2_t); return __builtin_bit_cast(unsigned, b); }
__device__ __forceinline__ float partner32(float x, int hi) { auto rr = __builtin_amdgcn_permlane32_swap(__builtin_bit_cast(unsigned, x), __builtin_bit_cast(unsigned, x), false, false);
    return __builtin_bit_cast(float, hi ? rr[0] : rr[1]); }
__device__ __forceinline__ float max3f(float a, float b, float c) { float r; asm("v_max3_f32 %0, %1, %2, %3" : "=v"(r) : "v"(a), "v"(b), "v"(c)); return r; }
__device__ __forceinline__ float max2f(float a, float b) { float r; asm("v_max_f32_e32 %0, %1, %2" : "=v"(r) : "v"(a), "v"(b)); return r; }
__device__ __forceinline__ float rowmax32(f32x16& p0, f32x16& p1, int hi) {
    asm volatile("s_nop 15\n\ts_nop 7" : "+v"(p0), "+v"(p1));
    float a = max3f(p0[0], p0[1], p1[0]), b = max3f(p0[2], p0[3], p1[1]); a = max3f(a, p1[2], p1[3]);
#pragma unroll
    for (int r = 4; r < 16; r += 4) { a = max3f(a, p0[r], p0[r + 1]); b = max3f(b, p0[r + 2], p0[r + 3]); a = max3f(a, p1[r], p1[r + 1]); b = max3f(b, p1[r + 2], p1[r + 3]); }
    const float m = max2f(a, b);
    return max2f(m, partner32(m, hi));
}
typedef __amdgpu_buffer_rsrc_t rsrc_t;
__device__ __forceinline__ rsrc_t make_rsrc(const void* base, unsigned bytes) { return __builtin_amdgcn_make_buffer_rsrc((void*)base, 0, (int)bytes, 0x00020000); }
__device__ __forceinline__ void load_frag8(bf16x8 (&f)[8], rsrc_t rs, unsigned vo, unsigned so) {
#pragma unroll
    for (int i = 0; i < 8; ++i) f[i] = __builtin_bit_cast(bf16x8, __builtin_amdgcn_raw_buffer_load_b128(rs, vo + i * 1024, so, 0));
}
__device__ __forceinline__ void qk_tile(f32x16& p0, f32x16& p1, const bf16x8 (&kf)[8], const LAS bf16x8* qs, const float cinit) {
    bf16x8 qr[4];
#pragma unroll
    for (int d0 = 0; d0 < 4; ++d0) qr[d0] = qs[d0 * 64];
    f32x16 c;
#pragma unroll
    for (int r = 0; r < 16; ++r) c[r] = cinit;
    p0 = MFMA32(kf[0], qr[0], c); p1 = MFMA32(kf[4], qr[0], c);
#pragma unroll
    for (int d0 = 1; d0 < 4; ++d0) { p0 = MFMA32(kf[d0], qr[d0], p0); p1 = MFMA32(kf[4 + d0], qr[d0], p1); }
}
__device__ __forceinline__ void qk_tile_lo(f32x16& p0, f32x16& p1, rsrc_t rs, unsigned vo, unsigned so, const LAS bf16x8* qs, const float cinit) {
    bf16x8 qr[4];
#pragma unroll
    for (int d0 = 0; d0 < 4; ++d0) qr[d0] = qs[d0 * 64];
#pragma unroll
    for (int r = 0; r < 16; ++r) { p0[r] = cinit; p1[r] = cinit; }
    { bf16x8 kf[4];
#pragma unroll
      for (int d0 = 0; d0 < 4; ++d0) kf[d0] = __builtin_bit_cast(bf16x8, __builtin_amdgcn_raw_buffer_load_b128(rs, vo + d0 * 1024, so, 0));
#pragma unroll
      for (int d0 = 0; d0 < 4; ++d0) p0 = MFMA32(kf[d0], qr[d0], p0); }
    asm volatile("" : "+v"(p0) :: "memory");
    { bf16x8 kf[4];
#pragma unroll
      for (int d0 = 0; d0 < 4; ++d0) kf[d0] = __builtin_bit_cast(bf16x8, __builtin_amdgcn_raw_buffer_load_b128(rs, vo + (4 + d0) * 1024, so, 0));
#pragma unroll
      for (int d0 = 0; d0 < 4; ++d0) p1 = MFMA32(kf[d0], qr[d0], p1); }
}
__device__ __forceinline__ void mask_tile(f32x16& p0, f32x16& p1, int lo, int lim, int hi) {
#pragma unroll
    for (int r = 0; r < 16; ++r) { const int k0 = crow(r, hi);
        if (!(k0 > lo && k0 <= lim)) p0[r] = -INFINITY;
        if (!(k0 + 32 > lo && k0 + 32 <= lim)) p1[r] = -INFINITY; }
}
__device__ __forceinline__ void pack_p(bf16x8 (&pa)[4], const f32x16& p0, const f32x16& p1) {
    u32x4 w0, w1, w2, w3;
#pragma unroll
    for (int q = 0; q < 4; ++q) { w0[q] = cvtpk(p0[2 * q], p0[2 * q + 1]); w1[q] = cvtpk(p0[8 + 2 * q], p0[9 + 2 * q]);
                                  w2[q] = cvtpk(p1[2 * q], p1[2 * q + 1]); w3[q] = cvtpk(p1[8 + 2 * q], p1[9 + 2 * q]); }
    pa[0] = __builtin_bit_cast(bf16x8, w0); pa[1] = __builtin_bit_cast(bf16x8, w1); pa[2] = __builtin_bit_cast(bf16x8, w2); pa[3] = __builtin_bit_cast(bf16x8, w3);
}
__device__ __forceinline__ void pv_tile(f32x16& o0, f32x16& o1, const bf16x8 (&pa)[4], const bf16x8 (&vf)[8]) {
#pragma unroll
    for (int ks = 0; ks < 4; ++ks) { o0 = MFMA32(pa[ks], vf[ks], o0); o1 = MFMA32(pa[ks], vf[4 + ks], o1); }
}
struct Sm { float mhat, l; f32x16 o0, o1, ol; };
__device__ __forceinline__ void sm_init(Sm& st) { st.mhat = 0.f; st.l = 0.f;
#pragma unroll
    for (int r = 0; r < 16; ++r) { st.o0[r] = 0.f; st.o1[r] = 0.f; st.ol[r] = 0.f; } }
__device__ __forceinline__ void sm_tile(Sm& st, f32x16& s0, f32x16& s1, bool first, const bf16x8 (&vf)[8], LAS float* wsf, int r32, int hi) {
    const float rm = rowmax32(s0, s1, hi);
    const bool need = first || (__any(rm > 8.0f) != 0);
    if (need) {
        const float dl = first ? ((rm == -INFINITY) ? 0.f : rm) : fmaxf(rm, 0.f);
        st.mhat += dl;
#pragma unroll
        for (int r = 0; r < 16; ++r) { s0[r] -= dl; s1[r] -= dl; }
        if (!first) {
            const float f = __builtin_amdgcn_exp2f(-dl);
            LDS_WAIT(); asm volatile("" ::: "memory");
            if (hi == 0) wsf[r32] = f;
            LDS_WAIT(); asm volatile("" ::: "memory");
#pragma unroll
            for (int G = 0; G < 4; ++G) { const f32x4 ff = *(const LAS f32x4*)(wsf + 8 * G + 4 * hi);
#pragma unroll
                for (int q = 0; q < 4; ++q) { st.o0[4 * G + q] *= ff[q]; st.o1[4 * G + q] *= ff[q]; st.ol[4 * G + q] *= ff[q]; } }
            LDS_WAIT(); asm volatile("" ::: "memory");
        }
    }
#pragma unroll
    for (int r = 0; r < 16; ++r) { s0[r] = __builtin_amdgcn_exp2f(s0[r]); s1[r] = __builtin_amdgcn_exp2f(s1[r]); }
    bf16x8 pa[4]; pack_p(pa, s0, s1);
    const bf16x8 ones = (bf16x8){0x3F80, 0x3F80, 0x3F80, 0x3F80, 0x3F80, 0x3F80, 0x3F80, 0x3F80};
#pragma unroll
    for (int ks = 0; ks < 4; ++ks) { st.o0 = MFMA32(pa[ks], vf[ks], st.o0); st.o1 = MFMA32(pa[ks], vf[4 + ks], st.o1); st.ol = MFMA32(pa[ks], ones, st.ol); }
}
template <bool NORM>
__device__ __forceinline__ void flush_branch(const f32x16& o0, const f32x16& o1, const f32x16& ol, const float* GATE, bf16* O, int m0, int hq, int br, bool accumulate,
                                             LAS float* stg, int lane) {
    asm volatile("" : "+v"(lane));
    const int r32 = lane & 31, hi = lane >> 5;
    LDS_WAIT(); asm volatile("" ::: "memory");
#pragma unroll
    for (int r = 0; r < 16; ++r) { const float iv = NORM ? __builtin_amdgcn_rcpf(fmaxf(ol[r], 1e-30f)) : 1.f;
        stg[crow(r, hi) * STG_STRIDE + r32] = o0[r] * iv; stg[crow(r, hi) * STG_STRIDE + 32 + r32] = o1[r] * iv; }
    LDS_WAIT(); asm volatile("" ::: "memory");
#pragma unroll
    for (int i = 0; i < 4; ++i) { const int row = i * 8 + (lane >> 3), ch = lane & 7;
        const f32x4 a = *(const LAS f32x4*)(stg + row * STG_STRIDE + ch * 8), b = *(const LAS f32x4*)(stg + row * STG_STRIDE + ch * 8 + 4);
        const float sc = GATE[(size_t)(m0 + row) * 48 + hq * 3 + br];
        bf16* op = O + (size_t)(m0 + row) * DM + hq * 64 + ch * 8;
        f32x4 x = a * sc, y = b * sc;
        if (accumulate) { const u32x4 old = *(const u32x4*)op; x += (f32x4){bflo(old.x), bfhi(old.x), bflo(old.y), bfhi(old.y)}; y += (f32x4){bflo(old.z), bfhi(old.z), bflo(old.w), bfhi(old.w)}; }
        u32x4 w; w.x = pk2(x[0], x[1]); w.y = pk2(x[2], x[3]); w.z = pk2(y[0], y[1]); w.w = pk2(y[2], y[3]);
        *(u32x4*)op = w; }
    LDS_WAIT(); asm volatile("" ::: "memory");
}
__device__ __forceinline__ void load_q(LAS bf16x8* qs, const bf16* Q, int m, int hq, int hi) {
    LDS_WAIT(); asm volatile("" ::: "memory");
#pragma unroll
    for (int d0 = 0; d0 < 4; ++d0) qs[d0 * 64] = *(const bf16x8*)(Q + (size_t)m * DM + hq * 64 + d0 * 16 + hi * 8);
    LDS_WAIT(); asm volatile("" ::: "memory");
}
__device__ __forceinline__ void p_attn_cmp(Frame& F) {
    LAS float* stg = (LAS float*)(F.lds + F.wave * 16384); LAS float* wsf = stg + 32 * STG_STRIDE;
    const bf16* Q = (const bf16*)(F.wsp() + WS_Q); const float* GATE = (const float*)(F.wsp() + WS_GATE); bf16* O = (bf16*)(F.wsp() + WS_O);
    unsigned long long* MASK = (unsigned long long*)(F.wsp() + WS_MASK);
    for (int it = F.gw; it < 16 * 128; it += F.NGW) {
        const int bh = it >> 7, blk = 127 - (it & 127), b = bh >> 2, hk = bh & 3, m0 = b * SEQ + blk * 32;
        const rsrc_t rs = make_rsrc(F.wsp() + WS_KC, 1u << 20);
        const unsigned soK = (unsigned)bh * 32768u, soV = 524288u + (unsigned)bh * 32768u;
        const int nvmax = ((blk * 32) >> 4) + 1, ntc = (nvmax + 63) >> 6;
        float mref0 = 0.f, mref1 = 0.f, mref2 = 0.f, mref3 = 0.f, inv0 = 0.f, inv1 = 0.f, inv2 = 0.f, inv3 = 0.f;
#pragma unroll 1
        for (int g = 0; g < 4; ++g) {
            int lane = F.lane; asm volatile("" : "+v"(lane));
            const int r32 = lane & 31, hi = lane >> 5, t = blk * 32 + r32, nvr = t >= 31 ? ((t - 31) >> 4) + 1 : 0;
            LAS bf16x8* qr = (LAS bf16x8*)(wsf + 64) + lane; load_q(qr, Q, m0 + r32, hk * 4 + g, hi);
            float mrun = -INFINITY, l = 0.f;
#pragma unroll 1
            for (int i = 0; i < ntc; ++i) {
                f32x16 s0, s1; qk_tile_lo(s0, s1, rs, (unsigned)lane * 16u, soK + (unsigned)i * 8192u, qr, 0.f); mask_tile(s0, s1, -1, nvr - 1 - 64 * i, hi);
                const float rm = rowmax32(s0, s1, hi), mn = fmaxf(mrun, rm), mr = (mn == -INFINITY) ? 0.f : mn;
                float sum = 0.f;
#pragma unroll
                for (int r = 0; r < 16; ++r) sum += __builtin_amdgcn_exp2f(s0[r] - mr) + __builtin_amdgcn_exp2f(s1[r] - mr);
                l = l * __builtin_amdgcn_exp2f(mrun - mr) + sum; mrun = mn;
            }
            const float ltot = l + partner32(l, hi);
            const float iv = 1.f / fmaxf(ltot, 1e-30f), mr_ = (mrun == -INFINITY) ? 0.f : mrun;
            if (g == 0) { inv0 = iv; mref0 = mr_; } else if (g == 1) { inv1 = iv; mref1 = mr_; } else if (g == 2) { inv2 = iv; mref2 = mr_; } else { inv3 = iv; mref3 = mr_; }
        }
        {
            float imp[32];
#pragma unroll
            for (int k = 0; k < 32; ++k) imp[k] = 0.f;
#pragma unroll 1
            for (int g = 0; g < 4; ++g) {
                int lane = F.lane; asm volatile("" : "+v"(lane));
                const int r32 = lane & 31, hi = lane >> 5, t = blk * 32 + r32, nvr = t >= 31 ? ((t - 31) >> 4) + 1 : 0;
                LAS bf16x8* qr = (LAS bf16x8*)(wsf + 64) + lane; load_q(qr, Q, m0 + r32, hk * 4 + g, hi);
                const float invg = g == 0 ? inv0 : g == 1 ? inv1 : g == 2 ? inv2 : inv3, mg = g == 0 ? mref0 : g == 1 ? mref1 : g == 2 ? mref2 : mref3;
#pragma unroll
                for (int i = 0; i < 4; ++i) if (i < ntc) {
                    asm volatile("" ::: "memory");
                    f32x16 s0, s1; qk_tile_lo(s0, s1, rs, (unsigned)lane * 16u, soK + (unsigned)i * 8192u, qr, -mg); mask_tile(s0, s1, -1, nvr - 1 - 64 * i, hi);
#pragma unroll
                    for (int r = 0; r < 16; ++r) { s0[r] = __builtin_amdgcn_exp2f(s0[r]) * invg; s1[r] = __builtin_amdgcn_exp2f(s1[r]) * invg; }
#pragma unroll
                    for (int G = 0; G < 4; ++G) {
                        { const int kq = 8 * i + G; const float e = s0[4 * G + 3], pe = partner32(e, hi);
                          imp[kq] += (s0[4 * G] + s0[4 * G + 1]) + s0[4 * G + 2] + 0.5f * e + (hi ? 0.5f * pe : 0.f);
                          if (kq + 1 < 32) imp[kq + 1] += hi ? 0.f : 0.5f * pe; }
                        { const int kq = 8 * i + 4 + G; const float e = s1[4 * G + 3], pe = partner32(e, hi);
                          imp[kq] += (s1[4 * G] + s1[4 * G + 1]) + s1[4 * G + 2] + 0.5f * e + (hi ? 0.5f * pe : 0.f);
                          if (kq + 1 < 32) imp[kq + 1] += hi ? 0.f : 0.5f * pe; }
                    }
                }
            }
            int lane = F.lane; asm volatile("" : "+v"(lane));
            const int r32 = lane & 31, hi = lane >> 5, cur = (blk * 32 + r32) >> 6;
            LDS_WAIT(); asm volatile("" ::: "memory");
#pragma unroll
            for (int k = 0; k < 32; ++k) { const int j = 2 * k + hi; const bool allowed = j <= cur, forced = allowed && (j == 0 || j == cur || j == cur - 1);
                stg[r32 * STG_STRIDE + j] = forced ? 1e9f : (allowed ? imp[k] : -1e30f); }
            LDS_WAIT(); asm volatile("" ::: "memory");
        }
        {
            int lane = F.lane; asm volatile("" : "+v"(lane));
            unsigned long long mymask = 0ull;
#pragma unroll 1
            for (int tok = 0; tok < 32; ++tok) {
                const float sc = stg[tok * STG_STRIDE + lane]; int rank = 0;
#pragma unroll
                for (int q = 0; q < 16; ++q) { const f32x4 v = *(const LAS f32x4*)(stg + tok * STG_STRIDE + 4 * q);
#pragma unroll
                    for (int e = 0; e < 4; ++e) rank += (v[e] > sc || (v[e] == sc && (4 * q + e) < lane)) ? 1 : 0; }
                const unsigned long long mk = __ballot(rank < 16 && sc > -0.5e30f);
                mymask = (lane == tok) ? mk : mymask;
            }
            if (lane < 32) MASK[(size_t)bh * SEQ + blk * 32 + lane] = mymask;
            LDS_WAIT(); asm volatile("" ::: "memory");
        }
#pragma unroll 1
        for (int g = 0; g < 4; ++g) {
            int lane = F.lane; asm volatile("" : "+v"(lane));
            const int r32 = lane & 31, hi = lane >> 5, t = blk * 32 + r32, nvr = t >= 31 ? ((t - 31) >> 4) + 1 : 0;
            LAS bf16x8* qr = (LAS bf16x8*)(wsf + 64) + lane; load_q(qr, Q, m0 + r32, hk * 4 + g, hi);
            const float invg = g == 0 ? inv0 : g == 1 ? inv1 : g == 2 ? inv2 : inv3, mg = g == 0 ? mref0 : g == 1 ? mref1 : g == 2 ? mref2 : mref3;
            f32x16 o0, o1;
#pragma unroll
            for (int r = 0; r < 16; ++r) { o0[r] = 0.f; o1[r] = 0.f; }
#pragma unroll 1
            for (int i = 0; i < ntc; ++i) {
                f32x16 s0, s1; qk_tile_lo(s0, s1, rs, (unsigned)lane * 16u, soK + (unsigned)i * 8192u, qr, -mg); mask_tile(s0, s1, -1, nvr - 1 - 64 * i, hi);
#pragma unroll
                for (int r = 0; r < 16; ++r) { s0[r] = __builtin_amdgcn_exp2f(s0[r]) * invg; s1[r] = __builtin_amdgcn_exp2f(s1[r]) * invg; }
                bf16x8 pa[4]; pack_p(pa, s0, s1);
                bf16x8 vf[8]; load_frag8(vf, rs, (unsigned)lane * 16u, soV + (unsigned)i * 8192u); pv_tile(o0, o1, pa, vf);
            }
            flush_branch<false>(o0, o1, o0, GATE, O, m0, hk * 4 + g, 0, false, stg, lane);
        }
    }
}
__device__ __forceinline__ void attn_main_item(Frame& F, int bh, int g, int blk, LAS float* stg, LAS float* wsf) {
    const bf16* Q = (const bf16*)(F.wsp() + WS_Q); const float* GATE = (const float*)(F.wsp() + WS_GATE); bf16* O = (bf16*)(F.wsp() + WS_O);
    const rsrc_t rs = make_rsrc(F.wsp() + WS_KV, (unsigned)(6 * KVBUF_ELEMS * 2));
    int lane = F.lane; asm volatile("" : "+v"(lane));
    const int r32 = lane & 31, hi = lane >> 5;
    const unsigned vo = (unsigned)lane * 16u;
    const int b = bh >> 2, hk = bh & 3, hq = hk * 4 + g, m0 = b * SEQ + blk * 32, c = blk >> 1, ql = (blk & 1) * 32 + r32;
    LAS bf16x8* qr = (LAS bf16x8*)(wsf + 64) + lane; load_q(qr, Q, m0 + r32, hq, hi);
    const unsigned long long mask = ((const unsigned long long*)(F.wsp() + WS_MASK))[(size_t)bh * SEQ + blk * 32 + r32];
    bf16x8 kf[8], vf[8];
    {
        const unsigned soK = (unsigned)((2 * KVBUF_ELEMS + (size_t)bh * KVROWS * 64) * 2), soV = (unsigned)((3 * KVBUF_ELEMS + (size_t)bh * KVROWS * 64) * 2);
        Sm st; sm_init(st);
        load_frag8(kf, rs, vo, soK);
#pragma unroll 1
        for (int j = 0; j <= c; ++j) {
            const bool sel = ((mask >> j) & 1ull) != 0ull;
            f32x16 s0, s1; qk_tile(s0, s1, kf, qr, sel ? -st.mhat : -INFINITY);
            asm volatile("" : "+v"(s0), "+v"(s1) :: "memory");
            load_frag8(vf, rs, vo, soV + (unsigned)j * 8192u);
            load_frag8(kf, rs, vo, soK + (unsigned)(j < c ? j + 1 : c) * 8192u);
            if (j == c) mask_tile(s0, s1, -1, ql, hi);
            sm_tile(st, s0, s1, j == 0, vf, wsf, r32, hi);
            asm volatile("" : "+v"(st.o0), "+v"(st.o1), "+v"(st.ol) :: "memory");
        }
        flush_branch<true>(st.o0, st.o1, st.ol, GATE, O, m0, hq, 1, true, stg, lane);
    }
    {
        const unsigned soK = (unsigned)((4 * KVBUF_ELEMS + (size_t)bh * KVROWS * 64) * 2), soV = (unsigned)((5 * KVBUF_ELEMS + (size_t)bh * KVROWS * 64) * 2);
        Sm st; sm_init(st);
        const int j0 = c >= 8 ? c - 8 : 0;
        load_frag8(kf, rs, vo, soK + (unsigned)j0 * 8192u);
#pragma unroll 1
        for (int j = j0; j <= c; ++j) {
            f32x16 s0, s1; qk_tile(s0, s1, kf, qr, -st.mhat);
            asm volatile("" : "+v"(s0), "+v"(s1) :: "memory");
            load_frag8(vf, rs, vo, soV + (unsigned)j * 8192u);
            load_frag8(kf, rs, vo, soK + (unsigned)(j < c ? j + 1 : c) * 8192u);
            if (j == c || j + 8 == c) mask_tile(s0, s1, (j + 8 == c) ? ql : -1, (j == c) ? ql : 63, hi);
            sm_tile(st, s0, s1, j == j0, vf, wsf, r32, hi);
            asm volatile("" : "+v"(st.o0), "+v"(st.o1), "+v"(st.ol) :: "memory");
        }
        flush_branch<true>(st.o0, st.o1, st.ol, GATE, O, m0, hq, 2, true, stg, lane);
    }
}
__device__ __forceinline__ void p_attn_main(Frame& F) {
    LAS float* stg = (LAS float*)(F.lds + F.wave * 16384); LAS float* wsf = stg + 32 * STG_STRIDE;
    for (int P = F.gw; P < 4096; P += F.NGW) {
        const int bh = P >> 8, rem = P & 255, g = rem & 3, k = rem >> 2;
        attn_main_item(F, bh, g, 127 - k, stg, wsf);
        attn_main_item(F, bh, g, k, stg, wsf);
    }
}
constexpr int AT_SLOT = 16384, AT_NSLOT = 4, AT_PW_OFF = AT_NSLOT * AT_SLOT, AT_PW_BYTES = STG_BYTES + 256 + 384, AT_MASK_OFF = AT_PW_OFF + 8 * AT_PW_BYTES;
static_assert(AT_MASK_OFF + 512 <= LDSCTL_OFF, "attention LDS map");
#define AT_WAIT_BAR(N) asm volatile("s_waitcnt vmcnt(" #N ") lgkmcnt(0)\n\ts_barrier" ::: "memory")
__device__ __forceinline__ void at_dma(const char* g, LAS unsigned char* l) { __builtin_amdgcn_global_load_lds((const unsigned*)g, (LAS unsigned*)l, 16, 0, 0); }
__device__ __forceinline__ void qk_tile_reg(f32x16& p0, f32x16& p1, const LAS unsigned char* ks, const bf16x8 (&qr)[4], const float cinit) {
    bf16x8 kf[8];
#pragma unroll
    for (int f = 0; f < 8; ++f) kf[f] = *(const LAS bf16x8*)(ks + f * 1024);
    __builtin_amdgcn_sched_barrier(0);
    f32x16 c;
#pragma unroll
    for (int r = 0; r < 16; ++r) c[r] = cinit;
    p0 = MFMA32(kf[0], qr[0], c); p1 = MFMA32(kf[4], qr[0], c);
#pragma unroll
    for (int d0 = 1; d0 < 4; ++d0) { p0 = MFMA32(kf[d0], qr[d0], p0); p1 = MFMA32(kf[4 + d0], qr[d0], p1); }
}
template <int V>
__device__ __forceinline__ void sm_tile_lds(Sm& st, f32x16& s0, f32x16& s1, bool first, const LAS unsigned char* vs, LAS float* wsf, int r32, int hi) {
    const float rm = rowmax32(s0, s1, hi);
    const bool need = first || (__any(rm > 8.0f) != 0);
    if (need) {
        const float dl = first ? ((rm == -INFINITY) ? 0.f : rm) : fmaxf(rm, 0.f);
        st.mhat += dl;
#pragma unroll
        for (int r = 0; r < 16; ++r) { s0[r] -= dl; s1[r] -= dl; }
        if (!first) {
            const float f = __builtin_amdgcn_exp2f(-dl);
            LDS_WAIT(); asm volatile("" ::: "memory");
            if (hi == 0) wsf[r32] = f;
            LDS_WAIT(); asm volatile("" ::: "memory");
#pragma unroll
            for (int G = 0; G < 4; ++G) { const f32x4 ff = *(const LAS f32x4*)(wsf + 8 * G + 4 * hi);
#pragma unroll
                for (int q = 0; q < 4; ++q) { st.o0[4 * G + q] *= ff[q]; st.o1[4 * G + q] *= ff[q]; st.ol[4 * G + q] *= ff[q]; } }
            LDS_WAIT(); asm volatile("" ::: "memory");
        }
    }
    bf16x8 vf[8];
#pragma unroll
    for (int f = 0; f < 8; ++f) vf[f] = *(const LAS bf16x8*)(vs + f * 1024);
    __builtin_amdgcn_sched_barrier(0);
    if (V != 2) {
#pragma unroll
    for (int r = 0; r < 16; ++r) { s0[r] = __builtin_amdgcn_exp2f(s0[r]); s1[r] = __builtin_amdgcn_exp2f(s1[r]); } }
    bf16x8 pa[4]; pack_p(pa, s0, s1);
    const bf16x8 ones = (bf16x8){0x3F80, 0x3F80, 0x3F80, 0x3F80, 0x3F80, 0x3F80, 0x3F80, 0x3F80};
    if (V != 3) {
#pragma unroll
    for (int ks = 0; ks < 4; ++ks) { st.o0 = MFMA32(pa[ks], vf[ks], st.o0); st.o1 = MFMA32(pa[ks], vf[4 + ks], st.o1); st.ol = MFMA32(pa[ks], ones, st.ol); }
    } else { asm volatile("" :: "v"(pa[0]), "v"(pa[1]), "v"(pa[2]), "v"(pa[3]), "v"(vf[0]), "v"(vf[1]), "v"(vf[2]), "v"(vf[3]), "v"(vf[4]), "v"(vf[5]), "v"(vf[6]), "v"(vf[7])); }
}
template <bool WIN, int V>
__device__ __forceinline__ void at_branch(Sm& st, const char* Kg, const char* Vg, int j0, int c, int ql, unsigned long long mask, const bf16x8 (&qr)[4],
                                          LAS unsigned char* ring, LAS float* wsf, int wave, int lane) {
    const int r32 = lane & 31, hi = lane >> 5, n = c - j0 + 1;
    LAS unsigned char* dk = ring + wave * 1024;
    const LAS unsigned char* rd = ring + lane * 16;
#pragma unroll
    for (int d = 0; d < 3; ++d) if (d < n) { at_dma(Kg + (size_t)(j0 + d) * 8192, dk + d * AT_SLOT); at_dma(Vg + (size_t)(j0 + d) * 8192, dk + d * AT_SLOT + 8192); }
#pragma unroll 1
    for (int t = 0; t < n; ++t) {
        const int rem = n - 1 - t;
        if (V != 1) { if (rem >= 2) AT_WAIT_BAR(4); else if (rem == 1) AT_WAIT_BAR(2); else AT_WAIT_BAR(0); }
        if (t + 3 < n) { const int sl = (t + 3) & 3; at_dma(Kg + (size_t)(j0 + t + 3) * 8192, dk + sl * AT_SLOT); at_dma(Vg + (size_t)(j0 + t + 3) * 8192, dk + sl * AT_SLOT + 8192); }
        const int j = j0 + t; const LAS unsigned char* slot = rd + (t & 3) * AT_SLOT;
        const bool sel = WIN ? true : (((mask >> j) & 1ull) != 0ull);
        f32x16 s0, s1;
        if (V != 4) qk_tile_reg(s0, s1, slot, qr, sel ? -st.mhat : -INFINITY);
        else {
#pragma unroll
            for (int r = 0; r < 16; ++r) { s0[r] = sel ? -st.mhat : -1.f; s1[r] = s0[r]; } asm volatile("" : "+v"(s0), "+v"(s1)); }
        if (WIN) { if (j == c || j + 8 == c) mask_tile(s0, s1, (j + 8 == c) ? ql : -1, (j == c) ? ql : 63, hi); }
        else { if (j == c) mask_tile(s0, s1, -1, ql, hi); }
        sm_tile_lds<V>(st, s0, s1, t == 0, slot + 8192, wsf, r32, hi);
    }
}
#define AT_PIN(x) asm volatile("" : "+v"(x))
#define AT_GAPA(MF, P, B, W, I) do { MF; lsum += (P[B] + P[B + 1]) + (P[B + 2] + P[B + 3]); W[I] = cvtpk(P[B], P[B + 1]); W[I + 1] = cvtpk(P[B + 2], P[B + 3]); \
        AT_PIN(lsum); AT_PIN(W); __builtin_amdgcn_sched_barrier(0); } while (0)
#define AT_GAPB(MF, C, B) do { MF; C[B] = __builtin_amdgcn_exp2f(C[B]); C[B + 1] = __builtin_amdgcn_exp2f(C[B + 1]); C[B + 2] = __builtin_amdgcn_exp2f(C[B + 2]); C[B + 3] = __builtin_amdgcn_exp2f(C[B + 3]); \
        AT_PIN(C); __builtin_amdgcn_sched_barrier(0); } while (0)
template <bool WIN>
__device__ __forceinline__ void at_branch_pipe(Sm& st, const char* Kg, const char* Vg, int j0, int c, int ql, unsigned long long mask, const bf16x8 (&qr)[4],
                                               LAS unsigned char* ring, LAS float* wsf, int wave, int lane) {
    const int r32 = lane & 31, hi = lane >> 5, n = c - j0 + 1;
    LAS unsigned char* dk = ring + wave * 1024;
    const LAS unsigned char* rd = ring + lane * 16;
#pragma unroll
    for (int d = 0; d < 2; ++d) if (d < n) { at_dma(Kg + (size_t)(j0 + d) * 8192, dk + d * AT_SLOT); at_dma(Vg + (size_t)(j0 + d) * 8192, dk + d * AT_SLOT + 8192); }
    if (n > 1) AT_WAIT_BAR(2); else AT_WAIT_BAR(0);
    if (2 < n) { at_dma(Kg + (size_t)(j0 + 2) * 8192, dk + 2 * AT_SLOT); at_dma(Vg + (size_t)(j0 + 2) * 8192, dk + 2 * AT_SLOT + 8192); }
    f32x16 p0, p1;
    { const bool sel = WIN ? true : ((mask >> j0) & 1ull) != 0ull;
      qk_tile_reg(p0, p1, rd, qr, sel ? 0.f : -INFINITY);
      if (WIN) { if (j0 == c || j0 + 8 == c) mask_tile(p0, p1, (j0 + 8 == c) ? ql : -1, (j0 == c) ? ql : 63, hi); }
      else { if (j0 == c) mask_tile(p0, p1, -1, ql, hi); }
      const float rm = rowmax32(p0, p1, hi), dl = (rm == -INFINITY) ? 0.f : rm;
      st.mhat = dl;
#pragma unroll
      for (int r = 0; r < 16; ++r) { p0[r] = __builtin_amdgcn_exp2f(p0[r] - dl); p1[r] = __builtin_amdgcn_exp2f(p1[r] - dl); } }
#pragma unroll 1
    for (int t = 1; t < n; ++t) {
        if (t + 1 < n) AT_WAIT_BAR(2); else AT_WAIT_BAR(0);
        if (t + 2 < n) { const int sl = (t + 2) & 3; at_dma(Kg + (size_t)(j0 + t + 2) * 8192, dk + sl * AT_SLOT); at_dma(Vg + (size_t)(j0 + t + 2) * 8192, dk + sl * AT_SLOT + 8192); }
        const int j = j0 + t;
        const bool sel = WIN ? true : ((mask >> j) & 1ull) != 0ull;
        const LAS unsigned char* ks = rd + (t & 3) * AT_SLOT; const LAS unsigned char* vs = rd + ((t - 1) & 3) * AT_SLOT + 8192;
        bf16x8 kf[8], vf[8];
#pragma unroll
        for (int f = 0; f < 8; ++f) kf[f] = *(const LAS bf16x8*)(ks + f * 1024);
        f32x16 cv; { const float ci = sel ? -st.mhat : -INFINITY;
#pragma unroll
            for (int r = 0; r < 16; ++r) cv[r] = ci; }
        __builtin_amdgcn_sched_barrier(0);
        f32x16 c0, c1; u32x4 w0, w1, w2, w3; float lsum = 0.f;
        AT_GAPA(c0 = MFMA32(kf[0], qr[0], cv), p0, 0, w0, 0);
        AT_GAPA(c1 = MFMA32(kf[4], qr[0], cv), p0, 4, w0, 2);
        AT_GAPA(c0 = MFMA32(kf[1], qr[1], c0), p0, 8, w1, 0);
        AT_GAPA(c1 = MFMA32(kf[5], qr[1], c1), p0, 12, w1, 2);
#pragma unroll
        for (int f = 0; f < 8; ++f) vf[f] = *(const LAS bf16x8*)(vs + f * 1024);
        __builtin_amdgcn_sched_barrier(0);
        AT_GAPA(c0 = MFMA32(kf[2], qr[2], c0), p1, 0, w2, 0);
        AT_GAPA(c1 = MFMA32(kf[6], qr[2], c1), p1, 4, w2, 2);
        AT_GAPA(c0 = MFMA32(kf[3], qr[3], c0), p1, 8, w3, 0);
        AT_GAPA(c1 = MFMA32(kf[7], qr[3], c1), p1, 12, w3, 2);
        st.l += lsum;
        if (WIN) { if (j == c || j + 8 == c) mask_tile(c0, c1, (j + 8 == c) ? ql : -1, (j == c) ? ql : 63, hi); }
        else { if (j == c) mask_tile(c0, c1, -1, ql, hi); }
        const float rm = rowmax32(c0, c1, hi);
        const bool resc = (__any(rm > 8.0f) != 0);
        if (resc) { const float dl = fmaxf(rm, 0.f); st.mhat += dl;
#pragma unroll
            for (int r = 0; r < 16; ++r) { c0[r] -= dl; c1[r] -= dl; }
            const float f = __builtin_amdgcn_exp2f(-dl); st.l *= f;
            LDS_WAIT(); asm volatile("" ::: "memory");
            if (hi == 0) wsf[r32] = f; }
        __builtin_amdgcn_sched_barrier(0);
        { const bf16x8 a0 = __builtin_bit_cast(bf16x8, w0), a1 = __builtin_bit_cast(bf16x8, w1), a2 = __builtin_bit_cast(bf16x8, w2), a3 = __builtin_bit_cast(bf16x8, w3);
          AT_GAPB(st.o0 = MFMA32(a0, vf[0], st.o0), c0, 0);
          AT_GAPB(st.o1 = MFMA32(a0, vf[4], st.o1), c0, 4);
          AT_GAPB(st.o0 = MFMA32(a1, vf[1], st.o0), c0, 8);
          AT_GAPB(st.o1 = MFMA32(a1, vf[5], st.o1), c0, 12);
          AT_GAPB(st.o0 = MFMA32(a2, vf[2], st.o0), c1, 0);
          AT_GAPB(st.o1 = MFMA32(a2, vf[6], st.o1), c1, 4);
          AT_GAPB(st.o0 = MFMA32(a3, vf[3], st.o0), c1, 8);
          AT_GAPB(st.o1 = MFMA32(a3, vf[7], st.o1), c1, 12); }
        if (resc) {
            LDS_WAIT(); asm volatile("" ::: "memory");
#pragma unroll
            for (int G = 0; G < 4; ++G) { const f32x4 ff = *(const LAS f32x4*)(wsf + 8 * G + 4 * hi);
#pragma unroll
                for (int q = 0; q < 4; ++q) { st.o0[4 * G + q] *= ff[q]; st.o1[4 * G + q] *= ff[q]; } }
            LDS_WAIT(); asm volatile("" ::: "memory"); }
        p0 = c0; p1 = c1;
    }
    { float lsum = 0.f;
#pragma unroll
      for (int r = 0; r < 16; ++r) lsum += p0[r] + p1[r];
      st.l += lsum;
      bf16x8 pa[4]; pack_p(pa, p0, p1);
      bf16x8 vf[8]; const LAS unsigned char* vs = rd + ((n - 1) & 3) * AT_SLOT + 8192;
#pragma unroll
      for (int f = 0; f < 8; ++f) vf[f] = *(const LAS bf16x8*)(vs + f * 1024);
      pv_tile(st.o0, st.o1, pa, vf); }
    { const float lt = st.l + partner32(st.l, hi);
      LDS_WAIT(); asm volatile("" ::: "memory");
      if (hi == 0) wsf[r32] = lt;
      LDS_WAIT(); asm volatile("" ::: "memory");
#pragma unroll
      for (int G = 0; G < 4; ++G) { const f32x4 ff = *(const LAS f32x4*)(wsf + 8 * G + 4 * hi);
#pragma unroll
          for (int q = 0; q < 4; ++q) st.ol[4 * G + q] = ff[q]; }
      LDS_WAIT(); asm volatile("" ::: "memory"); }
}
template <bool DRY, int V>
__device__ __forceinline__ void attn_unit(Frame& F, int bh, int c) {
    const bf16* Q = (const bf16*)(F.wsp() + WS_Q); const float* GATE = (const float*)(F.wsp() + WS_GATE); bf16* O = (bf16*)(F.wsp() + (DRY ? WS_Y0 : WS_O));
    const int wave = F.wave, g = wave >> 1, th = wave & 1;
    int lane = F.lane; asm volatile("" : "+v"(lane));
    const int r32 = lane & 31, hi = lane >> 5;
    const int b = bh >> 2, hk = bh & 3, hq = hk * 4 + g, m0 = b * SEQ + c * 64 + th * 32, t = c * 64 + th * 32 + r32, ql = th * 32 + r32;
    LAS unsigned char* ring = F.lds;
    LAS float* stg = (LAS float*)(F.lds + AT_PW_OFF + wave * AT_PW_BYTES); LAS float* wsf = stg + 32 * STG_STRIDE;
    LAS unsigned long long* masks = (LAS unsigned long long*)(F.lds + AT_MASK_OFF);
    const size_t lofs = (size_t)wave * 1024 + (size_t)lane * 16;
    bf16x8 qr[4];
#pragma unroll
    for (int d0 = 0; d0 < 4; ++d0) qr[d0] = *(const bf16x8*)(Q + (size_t)(m0 + r32) * DM + hq * 64 + d0 * 16 + hi * 8);
    LAS float* gl = wsf + 64;
    if (hi == 0) { const float* gp = GATE + (size_t)(m0 + r32) * 48 + hq * 3; gl[r32] = gp[0]; gl[32 + r32] = gp[1]; gl[64 + r32] = gp[2]; }
    const int nvr = t >= 31 ? ((t - 31) >> 4) + 1 : 0, ntc = (4 * c + 3 + 63) >> 6;
    f32x16 oc0, oc1;
    {
        const char* KCg = (const char*)(F.wsp() + WS_KC) + (size_t)bh * 32768 + lofs; const char* VCg = (const char*)(F.wsp() + WS_VC) + (size_t)bh * 32768 + lofs;
        asm volatile("s_waitcnt vmcnt(0)" ::: "memory");
        for (int i = 0; i < ntc; ++i) { at_dma(KCg + (size_t)i * 8192, ring + i * AT_SLOT + wave * 1024); at_dma(VCg + (size_t)i * 8192, ring + i * AT_SLOT + 8192 + wave * 1024); }
        AT_WAIT_BAR(0);
        const LAS unsigned char* rd = ring + lane * 16;
        float mhat = 0.f, l = 0.f;
        float imp[32];
#pragma unroll
        for (int k = 0; k < 32; ++k) imp[k] = 0.f;
        f32x16 o0, o1;
#pragma unroll
        for (int r = 0; r < 16; ++r) { o0[r] = 0.f; o1[r] = 0.f; }
#pragma unroll
        for (int i = 0; i < 4; ++i) if (i < ntc) {
            asm volatile("" ::: "memory");
            f32x16 s0, s1; qk_tile_reg(s0, s1, rd + i * AT_SLOT, qr, -mhat); mask_tile(s0, s1, -1, nvr - 1 - 64 * i, hi);
            const float rm = rowmax32(s0, s1, hi);
            if (i == 0) { const float dl = (rm == -INFINITY) ? 0.f : rm; mhat = dl;
#pragma unroll
                for (int r = 0; r < 16; ++r) { s0[r] -= dl; s1[r] -= dl; } }
            else if (__any(rm > 8.0f) != 0) { const float dl = fmaxf(rm, 0.f); mhat += dl;
#pragma unroll
                for (int r = 0; r < 16; ++r) { s0[r] -= dl; s1[r] -= dl; }
                const float f = __builtin_amdgcn_exp2f(-dl); l *= f;
#pragma unroll
                for (int k = 0; k < 32; ++k) imp[k] *= f;
                LDS_WAIT(); asm volatile("" ::: "memory");
                if (hi == 0) wsf[r32] = f;
                LDS_WAIT(); asm volatile("" ::: "memory");
#pragma unroll
                for (int G = 0; G < 4; ++G) { const f32x4 ff = *(const LAS f32x4*)(wsf + 8 * G + 4 * hi);
#pragma unroll
                    for (int q = 0; q < 4; ++q) { o0[4 * G + q] *= ff[q]; o1[4 * G + q] *= ff[q]; } }
                LDS_WAIT(); asm volatile("" ::: "memory"); }
            float sum = 0.f;
#pragma unroll
            for (int r = 0; r < 16; ++r) { s0[r] = __builtin_amdgcn_exp2f(s0[r]); s1[r] = __builtin_amdgcn_exp2f(s1[r]); sum += s0[r] + s1[r]; }
            l += sum;
#pragma unroll
            for (int G = 0; G < 4; ++G) {
                { const int kq = 8 * i + G; const float e = s0[4 * G + 3], pe = partner32(e, hi);
                  imp[kq] += (s0[4 * G] + s0[4 * G + 1]) + s0[4 * G + 2] + 0.5f * e + (hi ? 0.5f * pe : 0.f);
                  if (kq + 1 < 32) imp[kq + 1] += hi ? 0.f : 0.5f * pe; }
                { const int kq = 8 * i + 4 + G; const float e = s1[4 * G + 3], pe = partner32(e, hi);
                  imp[kq] += (s1[4 * G] + s1[4 * G + 1]) + s1[4 * G + 2] + 0.5f * e + (hi ? 0.5f * pe : 0.f);
                  if (kq + 1 < 32) imp[kq + 1] += hi ? 0.f : 0.5f * pe; }
            }
            bf16x8 pa[4]; pack_p(pa, s0, s1);
            { bf16x8 vf[4];
#pragma unroll
              for (int f = 0; f < 4; ++f) vf[f] = *(const LAS bf16x8*)(rd + i * AT_SLOT + 8192 + f * 1024);
#pragma unroll
              for (int ks = 0; ks < 4; ++ks) o0 = MFMA32(pa[ks], vf[ks], o0);
              asm volatile("" : "+v"(o0) :: "memory");
#pragma unroll
              for (int f = 0; f < 4; ++f) vf[f] = *(const LAS bf16x8*)(rd + i * AT_SLOT + 8192 + (4 + f) * 1024);
#pragma unroll
              for (int ks = 0; ks < 4; ++ks) o1 = MFMA32(pa[ks], vf[ks], o1); }
        }
        const float ltot = l + partner32(l, hi), inv = 1.f / fmaxf(ltot, 1e-30f);
#pragma unroll
        for (int k = 0; k < 32; ++k) imp[k] *= inv;
        LDS_WAIT(); asm volatile("" ::: "memory");
        if (hi == 0) wsf[r32] = gl[r32] * inv;
        LDS_WAIT(); asm volatile("" ::: "memory");
#pragma unroll
        for (int G = 0; G < 4; ++G) { const f32x4 gg = *(const LAS f32x4*)(wsf + 8 * G + 4 * hi);
#pragma unroll
            for (int q = 0; q < 4; ++q) { oc0[4 * G + q] = o0[4 * G + q] * gg[q]; oc1[4 * G + q] = o1[4 * G + q] * gg[q]; } }
        LDS_WAIT(); asm volatile("" ::: "memory");
#pragma unroll
        for (int k = 0; k < 32; ++k) stg[r32 * STG_STRIDE + 2 * k + hi] = imp[k];
    }
    AT_WAIT_BAR(0);
    const char* KSg = (const char*)(F.wsp() + WS_KV) + (2 * KVBUF_ELEMS + (size_t)bh * KVROWS * 64) * 2 + lofs;
    const char* VSg = (const char*)(F.wsp() + WS_KV) + (3 * KVBUF_ELEMS + (size_t)bh * KVROWS * 64) * 2 + lofs;
    if (c < 16) { if (lane < 8) masks[th * 32 + 8 * g + lane] = (2ull << c) - 1ull; }
    else {
        const LAS float* st0 = (const LAS float*)(F.lds + AT_PW_OFF + (0 * 2 + th) * AT_PW_BYTES); const LAS float* st1 = (const LAS float*)(F.lds + AT_PW_OFF + (1 * 2 + th) * AT_PW_BYTES);
        const LAS float* st2 = (const LAS float*)(F.lds + AT_PW_OFF + (2 * 2 + th) * AT_PW_BYTES); const LAS float* st3 = (const LAS float*)(F.lds + AT_PW_OFF + (3 * 2 + th) * AT_PW_BYTES);
        const bool allowed = lane <= c, forced = allowed && (lane == 0 || lane == c || lane == c - 1);
        LAS unsigned* kst = (LAS unsigned*)stg;
#pragma unroll 1
        for (int i = 0; i < 8; i += 2) {
            const int tokA = 8 * g + i, tokB = tokA + 1, aA = tokA * STG_STRIDE + lane, aB = tokB * STG_STRIDE + lane;
            const float vA = ((st0[aA] + st1[aA]) + st2[aA]) + st3[aA], vB = ((st0[aB] + st1[aB]) + st2[aB]) + st3[aB];
            const unsigned low = 63u - (unsigned)lane;
            const unsigned keyA = forced ? (0xFFFFFFC0u | low) : (allowed ? ((__builtin_bit_cast(unsigned, vA) & 0xFFFFFFC0u) | low) : 0u);
            const unsigned keyB = forced ? (0xFFFFFFC0u | low) : (allowed ? ((__builtin_bit_cast(unsigned, vB) & 0xFFFFFFC0u) | low) : 0u);
            LDS_WAIT(); asm volatile("" ::: "memory");
            kst[aA] = keyA; kst[aB] = keyB;
            LDS_WAIT(); asm volatile("" ::: "memory");
            int rankA = 0, rankB = 0;
#pragma unroll
            for (int q = 0; q < 16; ++q) { const u32x4 xa = *(const LAS u32x4*)(kst + tokA * STG_STRIDE + 4 * q), xb = *(const LAS u32x4*)(kst + tokB * STG_STRIDE + 4 * q);
#pragma unroll
                for (int e = 0; e < 4; ++e) { rankA += (xa[e] > keyA) ? 1 : 0; rankB += (xb[e] > keyB) ? 1 : 0; } }
            const unsigned long long mkA = __ballot(rankA < 16 && allowed), mkB = __ballot(rankB < 16 && allowed);
            if (lane == 0) { masks[th * 32 + tokA] = mkA; masks[th * 32 + tokB] = mkB; }
        }
    }
    AT_WAIT_BAR(0);
    const unsigned long long mask = masks[th * 32 + r32];
#pragma unroll
    for (int r = 0; r < 16; ++r) { stg[crow(r, hi) * STG_STRIDE + r32] = oc0[r]; stg[crow(r, hi) * STG_STRIDE + 32 + r32] = oc1[r]; }
    {
        Sm st; sm_init(st);
        if (V == 0) at_branch_pipe<false>(st, KSg, VSg, 0, c, ql, mask, qr, ring, wsf, wave, lane); else if (V != 5) at_branch<false, V>(st, KSg, VSg, 0, c, ql, mask, qr, ring, wsf, wave, lane);
        LDS_WAIT(); asm volatile("" ::: "memory");
#pragma unroll
        for (int G = 0; G < 4; ++G) { const f32x4 gg = *(const LAS f32x4*)(gl + 32 + 8 * G + 4 * hi);
#pragma unroll
            for (int q = 0; q < 4; ++q) { const int r = 4 * G + q; const float iv = gg[q] * __builtin_amdgcn_rcpf(fmaxf(st.ol[r], 1e-30f));
                stg[crow(r, hi) * STG_STRIDE + r32] += st.o0[r] * iv; stg[crow(r, hi) * STG_STRIDE + 32 + r32] += st.o1[r] * iv; } }
    }
    AT_WAIT_BAR(0);
    {
        const char* KWg = (const char*)(F.wsp() + WS_KV) + (4 * KVBUF_ELEMS + (size_t)bh * KVROWS * 64) * 2 + lofs;
        const char* VWg = (const char*)(F.wsp() + WS_KV) + (5 * KVBUF_ELEMS + (size_t)bh * KVROWS * 64) * 2 + lofs;
        Sm st; sm_init(st);
        if (V == 0) at_branch_pipe<true>(st, KWg, VWg, c >= 8 ? c - 8 : 0, c, ql, 0ull, qr, ring, wsf, wave, lane); else if (V != 5) at_branch<true, V>(st, KWg, VWg, c >= 8 ? c - 8 : 0, c, ql, 0ull, qr, ring, wsf, wave, lane);
        LDS_WAIT(); asm volatile("" ::: "memory");
#pragma unroll
        for (int G = 0; G < 4; ++G) { const f32x4 gg = *(const LAS f32x4*)(gl + 64 + 8 * G + 4 * hi);
#pragma unroll
            for (int q = 0; q < 4; ++q) { const int r = 4 * G + q; const float iv = gg[q] * __builtin_amdgcn_rcpf(fmaxf(st.ol[r], 1e-30f));
                stg[crow(r, hi) * STG_STRIDE + r32] += st.o0[r] * iv; stg[crow(r, hi) * STG_STRIDE + 32 + r32] += st.o1[r] * iv; } }
        LDS_WAIT(); asm volatile("" ::: "memory");
#pragma unroll
        for (int i = 0; i < 4; ++i) { const int row = i * 8 + (lane >> 3), ch = lane & 7;
            const f32x4 a = *(const LAS f32x4*)(stg + row * STG_STRIDE + ch * 8), b2 = *(const LAS f32x4*)(stg + row * STG_STRIDE + ch * 8 + 4);
            u32x4 w; w.x = pk2(a[0], a[1]); w.y = pk2(a[2], a[3]); w.z = pk2(b2[0], b2[1]); w.w = pk2(b2[2], b2[3]);
            *(u32x4*)(O + (size_t)(m0 + row) * DM + hq * 64 + ch * 8) = w; }
    }
    AT_WAIT_BAR(0);
}
template <bool DRY, int V>
__device__ __forceinline__ void p_attn_fused(Frame& F) {
    const int G = gridDim.x, bx = blockIdx.x, vcu = (G % 8 == 0) ? (bx % 8) * (G / 8) + bx / 8 : bx;
    for (int P = vcu; P < 512; P += G) {
        const int bh = P >> 5, k = P & 31;
#pragma unroll 1
        for (int h = 0; h < 2; ++h) attn_unit<DRY, V>(F, bh, h ? k : 63 - k);
    }
}
struct Args { const float* in[23]; float* out; unsigned char* ws; int ph_lo, ph_hi; };
__global__ void __launch_bounds__(512, 2) mk_fwd(Args args) {
    extern __shared__ __attribute__((aligned(16))) unsigned char lds[];
    Frame F;
    F.lds = (LAS unsigned char*)lds; F.MISC = (volatile LAS unsigned*)(F.lds + MISC_OFF);
    F.tid = threadIdx.x; F.lane = F.tid & 63; F.wave = __builtin_amdgcn_readfirstlane(F.tid >> 6);
    F.gw = blockIdx.x * 8 + F.wave; F.NGW = gridDim.x * 8;
    for (int u = F.tid; u < (LDS_BYTES - LDSCTL_OFF) / 4; u += 512) ((LAS unsigned*)(F.lds + LDSCTL_OFF))[u] = 0u;
    __syncthreads();
    if (F.tid < 25) { const unsigned long long v = F.tid < 23 ? (unsigned long long)args.in[F.tid] : F.tid == 23 ? (unsigned long long)args.out : (unsigned long long)args.ws;
        LAS unsigned* p = (LAS unsigned*)(F.lds + PTR_OFF) + 2 * F.tid; p[0] = (unsigned)v; p[1] = (unsigned)(v >> 32); }
    __syncthreads();
    XcdBarrier bar; bar.bar = (unsigned*)(F.ctlp() + CW_BAR); bar.x = 0; bar.st = nullptr;
    const int lo = args.ph_lo, hi = args.ph_hi;
    if (hi - lo > 1) bar = xcd_barrier_post((unsigned*)(F.ctlp() + CW_BAR), F.MISC + 8);
#ifdef PH_ONLY
#define IN(k) ((k) == PH_ONLY && lo <= (k) && (k) < hi)
#else
#define IN(k) (lo <= (k) && (k) < hi)
#endif
#define SEAM(k) do { if (IN(k) && (k) + 1 < hi) xcd_barrier(bar); } while (0)
    if (IN(0)) {
#pragma unroll 1
        for (int rep = 0; rep < REP0; ++rep) { p0_prologue(F); if (rep + 1 < REP0) xcd_barrier(bar); } } SEAM(0);
    if (IN(1)) {
#pragma unroll 1
        for (int rep = 0; rep < REP1; ++rep) { p1_mod_u0(F); if (rep + 1 < REP1) xcd_barrier(bar); }
#pragma unroll 1
        for (int rep = 0; rep < XBAR - 1; ++rep) xcd_barrier(bar); } SEAM(1);
    if (IN(2)) for (int rep = 0; rep < REP2; ++rep) {
        const char* A = (const char*)(F.wsp() + WS_U); const char* B = (const char*)(F.wsp() + WS_WIN);
        const pg8::SchedDense S{A, B, A, B + (size_t)1024 * DM * 2, T / 256, 4, 8, DM, (int)gridDim.x, (int)blockIdx.x, 256};
#if DRY2 == 1
        { pg8::gemm_phase<EpNull, pg8::SchedDense, true, false>(F.lds, DM, S, EpNull{}); xcd_barrier(bar); }
#elif DRY2 == 2
        { pg8::gemm_phase<EpG1, pg8::SchedDense, true, false>(F.lds, DM, S, EpG1{(bf16*)(F.wsp() + WS_Y0), (bf16*)(F.wsp() + WS_Y1)}); xcd_barrier(bar); }
#endif
        pg8::gemm_phase<EpG1, pg8::SchedDense, true, false>(F.lds, DM, S, EpG1{(bf16*)(F.wsp() + WS_BG), (bf16*)(F.wsp() + WS_Z)});
        if (rep + 1 < REP2) xcd_barrier(bar);
    } SEAM(2);
    if (IN(3)) {
#pragma unroll 1
        for (int rep = 0; rep < REP3; ++rep) { p3_conv(F); if (rep + 1 < REP3) xcd_barrier(bar); } } SEAM(3);
    if (IN(4)) for (int rep = 0; rep < REP4; ++rep) {
        const pg8::SchedDense S{(const char*)(F.wsp() + WS_A2), (const char*)(F.wsp() + WS_WOUT), nullptr, nullptr, T / 256, 4, 0, DM, (int)gridDim.x, (int)blockIdx.x, 256};
        typedef pg8::EpiWrap<EpU<EpBf16>, false, true> E_;
        pg8::gemm_phase<E_, pg8::SchedDense, false, false>(F.lds, DM, S, E_{{{(bf16*)(F.wsp() + WS_Y0), DM}}});
        if (rep + 1 < REP4) xcd_barrier(bar);
    } SEAM(4);
    if (IN(5)) {
#pragma unroll 1
        for (int rep = 0; rep < DRY5; ++rep) { p_ln_router<0, true>(F); xcd_barrier(bar); }
        p_ln_router<0>(F); } SEAM(5);
    if (IN(6)) { p_moe<0>(F, bar, true); } SEAM(6);
    if (IN(8)) {
#pragma unroll 1
        for (int rep = 0; rep < DRY8; ++rep) { p_ln2<0, true>(F); xcd_barrier(bar); }
        p_ln2<0>(F); } SEAM(8);
    if (IN(9)) {
        const int G = gridDim.x, bx = blockIdx.x, vcu = (G % 8 == 0) ? (bx % 8) * (G / 8) + bx / 8 : bx;
        const SchedKVQG S{(const char*)(F.wsp() + WS_XB), (const char*)(F.wsp() + WS_WKV), (const char*)(F.wsp() + WS_U), (const char*)(F.wsp() + WS_WQG), G, vcu, 0, 512};
        typedef pg8::EpiWrap<EpKVQG, false, true> E_;
        pg8::gemm_phase<E_, SchedKVQG, true, false>(F.lds, DM, S, E_{{(bf16*)(F.wsp() + WS_KV), (bf16*)(F.wsp() + WS_Q), (float*)(F.wsp() + WS_GATE), F.inp(I_BG)}});
    } SEAM(9);
    if (IN(10)) {
        const int G = gridDim.x, bx = blockIdx.x, vcu = (G % 8 == 0) ? (bx % 8) * (G / 8) + bx / 8 : bx;
        const int nq = G - 64 > 0 ? G - 64 : G;
        {
            const SchedKVQG S{(const char*)(F.wsp() + WS_XB), (const char*)(F.wsp() + WS_WKV), (const char*)(F.wsp() + WS_U), (const char*)(F.wsp() + WS_WQG), nq, vcu < nq ? vcu : -1, 512, 704};
            typedef pg8::EpiWrap<EpKVQG, false, true> E_;
            pg8::gemm_phase<E_, SchedKVQG, false, false>(F.lds, DM, S, E_{{(bf16*)(F.wsp() + WS_KV), (bf16*)(F.wsp() + WS_Q), (float*)(F.wsp() + WS_GATE), F.inp(I_BG)}});
        }
        {
            const SchedCmp S{(const char*)(F.wsp() + WS_KV), (const char*)(F.wsp() + WS_W1C), G - nq > 0 ? G - nq : G, G - nq > 0 ? (vcu >= nq ? vcu - nq : -1) : vcu};
            typedef pg8::EpiWrap<EpU<EpF32>, false> E_;
            pg8::gemm_phase<E_, SchedCmp, false, false>(F.lds, 1024, S, E_{{{(float*)(F.wsp() + WS_TB), 512}}});
        }
    } SEAM(10);
    if (IN(11)) {
#pragma unroll 1
        for (int rep = 0; rep < REP11; ++rep) { p_cmp_finish(F); if (rep + 1 < REP11) xcd_barrier(bar); } } SEAM(11);
#if ATTN_FUSED
    if (IN(12)) {
#pragma unroll 1
        for (int rep = 0; rep < DRY12; ++rep) { p_attn_fused<true, ATV>(F); xcd_barrier(bar); }
        p_attn_fused<false, 0>(F); } SEAM(12);
#else
    if (IN(12)) { p_attn_cmp(F); } SEAM(12);
    if (IN(13)) { p_attn_main(F); } SEAM(13);
#endif
    if (IN(14)) {
        const pg8::SchedDense S{(const char*)(F.wsp() + WS_O), (const char*)(F.wsp() + WS_WO), nullptr, nullptr, T / 256, 4, 0, DM, (int)gridDim.x, (int)blockIdx.x, 256};
        typedef pg8::EpiWrap<EpU<EpBf16>, false, true> E_;
        pg8::gemm_phase<E_, pg8::SchedDense, false, false>(F.lds, DM, S, E_{{{(bf16*)(F.wsp() + WS_Y0), DM}}});
    } SEAM(14);
    if (IN(15)) { p_ln_router<1>(F); } SEAM(15);
    if (IN(16)) { p_moe<1>(F, bar, true); } SEAM(16);
    if (IN(18)) { p_ln2<1>(F); }
#undef IN
#undef SEAM
}

extern "C" void kernel_launch(void* const* d_in, const int* in_sizes, int n_in, void* d_out, int out_size, void* d_ws, size_t ws_size, hipStream_t stream) {
    static int grid = 0;
    if (grid == 0) {
        if (n_in != 23 || out_size != T * DM || ws_size < WS_END) { fprintf(stderr, "kernel_launch: unexpected shapes (n_in %d out %d ws %zu, need ws >= %zu)\n", n_in, out_size, ws_size, (size_t)WS_END); grid = -1; return; }
        int dev = 0, cus = 0, per_cu = 0;
        if (hipGetDevice(&dev) != hipSuccess || hipDeviceGetAttribute(&cus, hipDeviceAttributeMultiprocessorCount, dev) != hipSuccess) { grid = -1; return; }
        if (hipFuncSetAttribute((const void*)mk_fwd, hipFuncAttributeMaxDynamicSharedMemorySize, LDS_BYTES) != hipSuccess) { fprintf(stderr, "kernel_launch: hipFuncSetAttribute failed\n"); grid = -1; return; }
        if (hipOccupancyMaxActiveBlocksPerMultiprocessor(&per_cu, (const void*)mk_fwd, 512, LDS_BYTES) != hipSuccess || per_cu < 1) { fprintf(stderr, "kernel_launch: occupancy query says %d\n", per_cu); per_cu = 1; }
        (void)hipGetLastError();
        grid = cus;
    }
    if (grid < 0) return;
    (void)hipMemsetAsync((char*)d_ws + WS_CTL, 0, CTL_ZERO_BYTES, stream);
    Args a{};
    for (int i = 0; i < 23; ++i) a.in[i] = (const float*)d_in[i];
    a.out = (float*)d_out; a.ws = (unsigned char*)d_ws;
    if (MK_N_LAUNCHES == 1) { a.ph_lo = 0; a.ph_hi = NPH; hipLaunchKernelGGL(mk_fwd, dim3(grid), dim3(512), LDS_BYTES, stream, a); }
    else for (int p = 0; p < NPH; ++p) { a.ph_lo = p; a.ph_hi = p + 1; hipLaunchKernelGGL(mk_fwd, dim3(grid), dim3(512), LDS_BYTES, stream, a); }
}
```

```cpp
#include <hip/hip_runtime.h>
#include <cstdio>
#include <cstdint>

#ifndef REP0
#define REP0 1
#endif
#ifndef REP1
#define REP1 1
#endif
#ifndef REP11
#define REP11 1
#endif
#ifndef XBAR
#define XBAR 1
#endif
#ifndef DRY5
#define DRY5 0
#endif
#ifndef DRY8
#define DRY8 0
#endif
#ifndef REP4
#define REP4 1
#endif
#ifndef REP2
#define REP2 1
#endif
#ifndef REP3
#define REP3 1
#endif
#ifndef REP6
#define REP6 1
#endif
#ifndef REP7
#define REP7 1
#endif
#ifndef REP9
#define REP9 1
#endif
#ifndef REP10
#define REP10 1
#endif
#ifndef REP12
#define REP12 1
#endif
#ifndef REP1213
#define REP1213 1
#endif
#ifndef ATV
#define ATV 0
#endif
#ifndef DRY2
#define DRY2 0
#endif
#ifndef DRY12
#define DRY12 0
#endif
#ifndef ATTN_FUSED
#define ATTN_FUSED 1
#endif
#ifndef MK_N_LAUNCHES
#define MK_N_LAUNCHES 1
#endif

#define GAS __attribute__((address_space(1)))
#define LAS __attribute__((address_space(3)))
typedef unsigned short bf16;
typedef short bf16x8 __attribute__((ext_vector_type(8)));
typedef float f32x4 __attribute__((ext_vector_type(4)));
typedef unsigned u32x4 __attribute__((ext_vector_type(4)));
typedef unsigned u32x2 __attribute__((ext_vector_type(2)));
typedef GAS unsigned gu32;
#define RLX_AGENT __ATOMIC_RELAXED, __HIP_MEMORY_SCOPE_AGENT

constexpr int NB = 4, SEQ = 4096, DM = 1024, T = NB * SEQ, NH = 16, HKV = 4, HD = 64, NE = 16, FF = 512;
constexpr int NPH = 19;
constexpr float ALPHA = 1.4142135623730951f;
constexpr float LN_EPS = 1e-5f;
constexpr float C2 = 0.125f * 1.4426950408889634f;
constexpr int KVROWS = SEQ + 128;
constexpr int HROWS = 2 * T + NE * 256;

constexpr size_t MiB = 1u << 20;
constexpr size_t WS_CTL = 0, CTL_ZERO_BYTES = 1 * MiB;
constexpr size_t WS_MODP = 290 * MiB;
constexpr size_t WS_MOD = 3 * MiB;
constexpr size_t WS_PETP = 3 * MiB + 512 * 1024;
constexpr size_t WS_LIST = 4 * MiB;
constexpr size_t WS_LW = 6 * MiB;
constexpr size_t WS_WIN = 8 * MiB, WS_WOUT = 14 * MiB, WS_WKV = 16 * MiB, WS_WQG = 19 * MiB, WS_WO = 22 * MiB, WS_W1C = 24 * MiB;
constexpr size_t WS_WGU = 26 * MiB, WS_WDN = 90 * MiB;
constexpr size_t WS_U = 122 * MiB, WS_XB = 154 * MiB, WS_H = 186 * MiB, WS_Y0 = 226 * MiB, WS_Y1 = 258 * MiB;
constexpr size_t WS_R1 = 290 * MiB;
constexpr size_t WS_BG = WS_R1, WS_Z = WS_R1 + 32 * MiB, WS_A2 = WS_R1 + 64 * MiB;
constexpr size_t WS_Q = WS_R1, WS_O = WS_R1 + 32 * MiB, WS_KV = WS_R1 + 64 * MiB;
constexpr size_t KVBUF_ELEMS = (size_t)16 * KVROWS * 64;
constexpr size_t WS_TB = WS_R1 + 114 * MiB, WS_KC = WS_R1 + 130 * MiB, WS_VC = WS_KC + 512 * 1024, WS_GATE = WS_R1 + 131 * MiB;
constexpr size_t WS_END = WS_R1 + 135 * MiB;
static_assert(WS_Y1 == WS_Y0 + (size_t)T * DM * 2, "Y1 follows Y0");
static_assert(WS_KV + 6 * KVBUF_ELEMS * 2 <= WS_TB, "kv buffers");
static_assert((size_t)HROWS * FF * 2 <= 40 * MiB, "H buffer");
constexpr int CW_CNT = 1024;
constexpr int CW_BAR = 4096;

constexpr int RING_BYTES = 131072;
constexpr int LDSCTL_OFF = 143360, MISC_OFF = LDSCTL_OFF + 320;
constexpr int LDS_BYTES = 147456;

#define LDS_WAIT() asm volatile("s_waitcnt lgkmcnt(0)" ::: "memory")
__device__ __forceinline__ unsigned f2bf(float f) { unsigned u = __builtin_bit_cast(unsigned, f); return (u + 0x7fffu + ((u >> 16) & 1u)) >> 16; }
typedef float f32x2v __attribute__((ext_vector_type(2)));
typedef __bf16 bf16x2_t __attribute__((ext_vector_type(2)));
__device__ __forceinline__ unsigned pk2(float lo, float hi) { f32x2v v = {lo, hi}; bf16x2_t b = __builtin_convertvector(v, bf16x2_t); return __builtin_bit_cast(unsigned, b); }
__device__ __forceinline__ float bf2f(unsigned short h) { return __builtin_bit_cast(float, (unsigned)h << 16); }
__device__ __forceinline__ float bflo(unsigned w) { return __builtin_bit_cast(float, w << 16); }
__device__ __forceinline__ float bfhi(unsigned w) { return __builtin_bit_cast(float, w & 0xffff0000u); }
__device__ __forceinline__ float wave_sum(float v) {
#pragma unroll
    for (int o = 1; o < 64; o <<= 1) v += __shfl_xor(v, o);
    return v;
}
__device__ __forceinline__ float wave_max(float v) {
#pragma unroll
    for (int o = 1; o < 64; o <<= 1) v = fmaxf(v, __shfl_xor(v, o));
    return v;
}
__device__ __forceinline__ float silu_f(float a) { return a * __builtin_amdgcn_rcpf(1.f + __builtin_amdgcn_exp2f(-1.4426950408889634f * a)); }
__device__ __forceinline__ void st_bf4(bf16* p, f32x4 v) { u32x2 w; w.x = pk2(v[0], v[1]); w.y = pk2(v[2], v[3]); *(u32x2*)p = w; }
__device__ __forceinline__ void st_bf8(bf16* p, f32x4 a, f32x4 b) { u32x4 w; w.x = pk2(a[0], a[1]); w.y = pk2(a[2], a[3]); w.z = pk2(b[0], b[1]); w.w = pk2(b[2], b[3]); *(u32x4*)p = w; }

#define XB_TMO      128
#define XB_XCNT(j)  (256  + 64 * (j))
#define XB_XSUB(j)  (1280 + 64 * (j))
#define XB_XGEN(j)  (2304 + 64 * (j))
#define XB_TOP      3328
#define XB_TOPGEN   3392
#define XCD_BAR_WORDS 3456
#define XB_SPIN_CAP (1u << 22)
__device__ __forceinline__ unsigned xb_ld(unsigned* p)              { return __hip_atomic_load(p, __ATOMIC_RELAXED, __HIP_MEMORY_SCOPE_AGENT); }
__device__ __forceinline__ unsigned xb_add(unsigned* p, unsigned v) { return __hip_atomic_fetch_add(p, v, __ATOMIC_RELAXED, __HIP_MEMORY_SCOPE_AGENT); }
__device__ __forceinline__ unsigned xb_xcc_id() { return (unsigned)__builtin_amdgcn_s_getreg((3 << 11) | 20) & 0xFu; }
#define XB_SPIN(cond, bar) do { unsigned _sp = 0; while (cond) { __builtin_amdgcn_s_sleep(1); \
    if ((++_sp & 255u) == 0u) { if (xb_ld(&(bar)[XB_TMO])) break; if (_sp > XB_SPIN_CAP) { atomicAdd(&(bar)[XB_TMO], 1u); break; } } } } while (0)
struct XcdBarrier { unsigned* bar; unsigned x; volatile LAS unsigned* st; };
__device__ __forceinline__ XcdBarrier xcd_barrier_post(unsigned* bar, volatile LAS unsigned* st) {
    XcdBarrier b; b.bar = bar; b.x = xb_xcc_id(); b.st = st;
    if (threadIdx.x == 0) (void)xb_add(&bar[XB_XCNT(b.x)], 1u);
    return b;
}
__device__ __forceinline__ void xcd_barrier_complete(unsigned* bar, unsigned x, unsigned& nloc, unsigned& nx) {
    const unsigned G = gridDim.x * gridDim.y * gridDim.z;
    unsigned sum, cnt, mine, sp = 0u;
    for (;;) {
        sum = 0u; cnt = 0u; mine = 0u;
#pragma unroll
        for (unsigned j = 0; j < 16; ++j) { const unsigned c = xb_ld(&bar[XB_XCNT(j)]); sum += c; cnt += (c > 0u) ? 1u : 0u; mine = (j == x) ? c : mine; }
        if (sum == G) break;
        __builtin_amdgcn_s_sleep(1);
        if ((++sp & 255u) == 0u) { if (xb_ld(&bar[XB_TMO])) break; if (sp > XB_SPIN_CAP) { atomicAdd(&bar[XB_TMO], 1u); break; } }
    }
    nloc = mine > 0u ? mine : 1u; nx = cnt > 0u ? cnt : 1u;
}
__device__ __forceinline__ void xcd_barrier(const XcdBarrier& b) {
    asm volatile("s_waitcnt vmcnt(0)" ::: "memory");
    __syncthreads();
    if (threadIdx.x == 0) {
        unsigned* bar = b.bar;
        __builtin_amdgcn_s_waitcnt(0);
        unsigned nloc = b.st[0], nx = b.st[1];
        if (nloc == 0u) { xcd_barrier_complete(bar, b.x, nloc, nx); b.st[0] = nloc; b.st[1] = nx; }
        const unsigned old = xb_add(&bar[XB_XSUB(b.x)], 1u);
        const unsigned gen = old / nloc;
        if (old + 1u == (gen + 1u) * nloc) {
            __builtin_amdgcn_fence(__ATOMIC_RELEASE, "agent");
            asm volatile("s_waitcnt vmcnt(0)" ::: "memory");
            const unsigned og = xb_add(&bar[XB_TOP], 1u);
            const unsigned tg = og / nx;
            if (og + 1u == (tg + 1u) * nx) xb_add(&bar[XB_TOPGEN], 1u);
            else XB_SPIN(xb_ld(&bar[XB_TOPGEN]) == tg, bar);
            __builtin_amdgcn_fence(__ATOMIC_ACQUIRE, "agent");
            xb_add(&bar[XB_XGEN(b.x)], 1u);
            asm volatile("s_waitcnt vmcnt(0)" ::: "memory");
        } else {
            XB_SPIN(xb_ld(&bar[XB_XGEN(b.x)]) == gen, bar);
            __builtin_amdgcn_fence(__ATOMIC_ACQUIRE, "agent");
            asm volatile("s_waitcnt vmcnt(0)" ::: "memory");
        }
    }
    __syncthreads();
}

constexpr int PTR_OFF = MISC_OFF + 512;
struct Frame {
    LAS unsigned char* lds;
    volatile LAS unsigned* MISC;
    int tid, lane, wave, gw, NGW;
    __device__ __forceinline__ unsigned long long ptr(int i) const { const LAS unsigned* p = (const LAS unsigned*)(lds + PTR_OFF) + 2 * i;
        const unsigned lo = __builtin_amdgcn_readfirstlane(p[0]), hi = __builtin_amdgcn_readfirstlane(p[1]); return ((unsigned long long)hi << 32) | lo; }
    __device__ __forceinline__ const float* inp(int i) const { return (const float*)(const GAS float*)ptr(i); }
    __device__ __forceinline__ float* outp() const { return (float*)(GAS float*)ptr(23); }
    __device__ __forceinline__ unsigned char* wsp() const { return (unsigned char*)(GAS unsigned char*)ptr(24); }
    __device__ __forceinline__ gu32* ctlp() const { return (gu32*)(wsp() + WS_CTL); }
};
enum { I_X = 0, I_C, I_ADAW, I_ADAB, I_LNG, I_LNB, I_CWIN, I_CONVW, I_CONVB, I_CWOUT, I_WKV, I_PE, I_CW1, I_CB1, I_CW2, I_CB2, I_WQG, I_BG, I_WO, I_RW, I_RB, I_WGU, I_WDN };

__device__ __forceinline__ void transpose_item(const float* W, int ld, int nvalid, int K, bf16* WT, int dstrow0, int k0, int n0, LAS float* scr, int lane) {
    const int n = n0 + (lane & 31);
#pragma unroll 8
    for (int i = 0; i < 32; ++i) { const int kk = 2 * i + (lane >> 5); scr[kk * 33 + (lane & 31)] = (n < nvalid) ? W[(size_t)(k0 + kk) * ld + n] : 0.f; }
    LDS_WAIT(); asm volatile("" ::: "memory");
    const int c = lane & 7;
#pragma unroll
    for (int j = 0; j < 4; ++j) { const int nl = (lane >> 3) + 8 * j; const LAS float* s = scr + (8 * c) * 33 + nl;
        u32x4 o; o.x = pk2(s[0 * 33], s[1 * 33]); o.y = pk2(s[2 * 33], s[3 * 33]); o.z = pk2(s[4 * 33], s[5 * 33]); o.w = pk2(s[6 * 33], s[7 * 33]);
        *(u32x4*)(WT + (size_t)(dstrow0 + nl) * K + k0 + 8 * c) = o; }
    LDS_WAIT(); asm volatile("" ::: "memory");
}
__device__ __forceinline__ int pairmap(int n0, int half) {
    return n0 < half ? ((n0 >> 7) * 256 + (n0 & 127)) : ((((n0 - half) >> 7) * 256) + 128 + ((n0 - half) & 127));
}
__device__ __forceinline__ void p0_prologue(Frame& F) {
    LAS float* scr = (LAS float*)(F.lds + F.wave * 16384);
    const int lane = F.lane;
    for (int r = F.gw; r < 768 + 256; r += F.NGW) {
        if (r < 768) {
            const int l = r / 384, rem = r % 384, dch = rem / 24, e = (rem % 24) * 256 + 4 * lane;
            const float* aw = F.inp(I_ADAW) + (size_t)l * 1024 * 6144 + e; const float* c = F.inp(I_C);
            f32x4 a0 = (f32x4){0.f, 0.f, 0.f, 0.f}, a1 = a0, a2 = a0, a3 = a0;
#pragma unroll 16
            for (int d = dch * 64; d < dch * 64 + 64; ++d) {
                const f32x4 w = *(const f32x4*)(aw + (size_t)d * 6144);
                const float c0 = c[d], c1 = c[1024 + d], c2 = c[2048 + d], c3 = c[3072 + d];
                a0 += w * (c0 / (1.f + __expf(-c0))); a1 += w * (c1 / (1.f + __expf(-c1))); a2 += w * (c2 / (1.f + __expf(-c2))); a3 += w * (c3 / (1.f + __expf(-c3)));
            }
            float* mp = (float*)(F.wsp() + WS_MODP) + (size_t)dch * 49152 + (size_t)(l * 4) * 6144 + e;
            *(f32x4*)mp = a0; *(f32x4*)(mp + 6144) = a1; *(f32x4*)(mp + 2 * 6144) = a2; *(f32x4*)(mp + 3 * 6144) = a3;
        } else {
            const int q = r - 768, i = q / 128, rem = q % 128, cch = rem / 32, kch = rem % 32, c = cch * 64 + lane;
            const float* pe = F.inp(I_PE) + i * 2048; const float* w1 = F.inp(I_CW1) + (size_t)i * 2048 * 256 + c;
            float a = 0.f;
#pragma unroll 16
            for (int kk = kch * 64; kk < kch * 64 + 64; ++kk) a += pe[kk] * w1[(size_t)kk * 256];
            ((float*)(F.wsp() + WS_PETP))[(kch * 2 + i) * 256 + c] = a;
        }
    }
    constexpr int I1 = 16 * 96, I2 = 512, I3 = 16 * 48, I4 = 16 * 40, I5 = 512, I6 = 512, I7 = 32 * 512, I8 = 32 * 256;
    constexpr int NITEMS = I1 + I2 + I3 + I4 + I5 + I6 + I7 + I8;
    for (int it = F.gw; it < NITEMS; it += F.NGW) {
        int r = it;
        if (r < I1) { const int kb = r / 96, nb = r % 96, n0 = nb * 32;
            const int dr = n0 < 1024 ? n0 : 1024 + pairmap(n0 - 1024, 1024);
            transpose_item(F.inp(I_CWIN), 3072, 3072, 1024, (bf16*)(F.wsp() + WS_WIN), dr, kb * 64, n0, scr, lane); continue; } r -= I1;
        if (r < I2) { transpose_item(F.inp(I_CWOUT), 1024, 1024, 1024, (bf16*)(F.wsp() + WS_WOUT), (r % 32) * 32, (r / 32) * 64, (r % 32) * 32, scr, lane); continue; } r -= I2;
        if (r < I3) { transpose_item(F.inp(I_WKV), 1536, 1536, 1024, (bf16*)(F.wsp() + WS_WKV), (r % 48) * 32, (r / 48) * 64, (r % 48) * 32, scr, lane); continue; } r -= I3;
        if (r < I4) { transpose_item(F.inp(I_WQG), 1072, 1072, 1024, (bf16*)(F.wsp() + WS_WQG), (r % 40) * 32, (r / 40) * 64, (r % 40) * 32, scr, lane); continue; } r -= I4;
        if (r < I5) { transpose_item(F.inp(I_WO), 1024, 1024, 1024, (bf16*)(F.wsp() + WS_WO), (r % 32) * 32, (r / 32) * 64, (r % 32) * 32, scr, lane); continue; } r -= I5;
        if (r < I6) { const int sub = r / 128, q = r % 128, i = sub >> 1, hh = sub & 1;
            transpose_item(F.inp(I_CW1) + (size_t)i * 2048 * 256 + (size_t)hh * 1024 * 256, 256, 256, 1024, (bf16*)(F.wsp() + WS_W1C) + (size_t)i * 512 * 1024, hh * 256 + (q % 8) * 32, (q / 8) * 64, (q % 8) * 32, scr, lane); continue; } r -= I6;
        if (r < I7) { const int mi = r / 512, q = r % 512, n0 = (q % 32) * 32;
            transpose_item(F.inp(I_WGU) + (size_t)mi * 1024 * 1024, 1024, 1024, 1024, (bf16*)(F.wsp() + WS_WGU) + (size_t)mi * 1024 * 1024, pairmap(n0, 512), (q / 32) * 64, n0, scr, lane); continue; } r -= I7;
        { const int mi = r / 256, q = r % 256, n0 = (q % 32) * 32;
            transpose_item(F.inp(I_WDN) + (size_t)mi * 512 * 1024, 1024, 1024, 512, (bf16*)(F.wsp() + WS_WDN) + (size_t)mi * 1024 * 512, n0, (q / 32) * 64, n0, scr, lane); }
    }
}
__device__ __forceinline__ f32x4 mod4_partials(const Frame& F, int l, int b, int e) {
    f32x4 s = *(const f32x4*)(F.inp(I_ADAB) + l * 6144 + e);
    const float* mp = (const float*)(F.wsp() + WS_MODP) + (size_t)(l * 4 + b) * 6144 + e;
#pragma unroll
    for (int d = 0; d < 16; ++d) s += *(const f32x4*)(mp + (size_t)d * 49152);
    return s;
}
__device__ __forceinline__ void p1_mod_u0(Frame& F) {
    float* MOD = (float*)(F.wsp() + WS_MOD);
    for (int ch = F.gw; ch < 768; ch += F.NGW) {
        const int idx = ch * 64 + F.lane, lb = idx / 6144, e = idx % 6144;
        float s = F.inp(I_ADAB)[(lb >> 2) * 6144 + e];
        const float* mp = (const float*)(F.wsp() + WS_MODP) + idx;
#pragma unroll
        for (int d = 0; d < 16; ++d) s += mp[(size_t)d * 49152];
        MOD[idx] = s;
    }
    for (int q = F.gw; q < 2; q += F.NGW) { const int i = q, c = 4 * F.lane;
        f32x4 pe = *(const f32x4*)(F.inp(I_CB1) + i * 256 + c); const float* PETP = (const float*)(F.wsp() + WS_PETP);
#pragma unroll
        for (int k = 0; k < 32; ++k) pe += *(const f32x4*)(PETP + (k * 2 + i) * 256 + c);
        *(f32x4*)((float*)(F.wsp() + WS_PETP) + 64 * 256 + i * 256 + c) = pe; }
    bf16* U = (bf16*)(F.wsp() + WS_U);
    LAS f32x4* msh = (LAS f32x4*)F.lds;
    for (int c0 = blockIdx.x * 64; c0 < T; c0 += gridDim.x * 64) {
        const int b = c0 >> 12;
        __syncthreads();
        { const int t = F.tid, e = 4 * (t & 255) + (t >> 8) * 1024; f32x4 v = mod4_partials(F, 0, b, e); if (t >= 256) v = v + 1.0f; msh[t] = v; }
        __syncthreads();
        f32x4 sh[4], sc[4];
#pragma unroll
        for (int j = 0; j < 4; ++j) { sh[j] = msh[F.lane + 64 * j]; sc[j] = msh[256 + F.lane + 64 * j]; }
        const int m0 = c0 + F.wave * 8;
#pragma unroll 1
        for (int m = m0; m < m0 + 8; m += 2) {
            f32x4 v[2][4];
#pragma unroll
            for (int r = 0; r < 2; ++r)
#pragma unroll
                for (int j = 0; j < 4; ++j) v[r][j] = *(const f32x4*)(F.inp(I_X) + (size_t)(m + r) * DM + 4 * F.lane + 256 * j);
#pragma unroll
            for (int r = 0; r < 2; ++r)
#pragma unroll
                for (int j = 0; j < 4; ++j) st_bf4(U + (size_t)(m + r) * DM + 4 * F.lane + 256 * j, v[r][j] * sc[j] + sh[j]);
        }
    }
}
template <bool PAIR, class AR, class EP>
__device__ __forceinline__ void gemm_wave_tile(const AR& arow, const bf16* Btile, int K, int m0, int nbase, const EP& ep, int lane) {
    const int fr = lane & 15, fq = lane >> 4;
    f32x4 acc[4][4];
#pragma unroll
    for (int i = 0; i < 4; ++i)
#pragma unroll
        for (int j = 0; j < 4; ++j) acc[i][j] = (f32x4){0.f, 0.f, 0.f, 0.f};
    const bf16* ap[4]; const bf16* bp[4];
#pragma unroll
    for (int i = 0; i < 4; ++i) ap[i] = arow(m0 + 16 * i + fr) + 8 * fq;
#pragma unroll
    for (int j = 0; j < 4; ++j) { const int nr = PAIR ? ((j & 1) * 16 + (j >> 1) * 128) : 16 * j; bp[j] = Btile + (size_t)(nr + fr) * K + 8 * fq; }
    for (int k0 = 0; k0 < K; k0 += 32) {
        bf16x8 a[4], b[4];
#pragma unroll
        for (int i = 0; i < 4; ++i) a[i] = *(const bf16x8*)(ap[i] + k0);
#pragma unroll
        for (int j = 0; j < 4; ++j) b[j] = *(const bf16x8*)(bp[j] + k0);
#pragma unroll
        for (int i = 0; i < 4; ++i)
#pragma unroll
            for (int j = 0; j < 4; ++j) acc[i][j] = __builtin_amdgcn_mfma_f32_16x16x32_bf16(b[j], a[i], acc[i][j], 0, 0, 0);
    }
#pragma unroll
    for (int i = 0; i < 4; ++i) {
        const int m = m0 + 16 * i + fr;
        if constexpr (PAIR) {
#pragma unroll
            for (int j = 0; j < 2; ++j) ep.pair(m, nbase + 16 * j + 4 * fq, acc[i][j], acc[i][j + 2]);
        } else {
#pragma unroll
            for (int j = 0; j < 4; ++j) ep(m, nbase + 16 * j + 4 * fq, acc[i][j]);
        }
    }
}
struct ARowPlain { const bf16* A; int K; __device__ __forceinline__ const bf16* operator()(int m) const { return A + (size_t)m * K; } };

struct EpBf16 { bf16* O; int ld; __device__ __forceinline__ void operator()(int m, int n, f32x4 v) const { st_bf4(O + (size_t)m * ld + n, v); }
    __device__ __forceinline__ void op8(int m, int n, f32x4 a, f32x4 b) const { st_bf8(O + (size_t)m * ld + n, a, b); } };
struct EpMulPair { bf16* O; int ld; __device__ __forceinline__ void pair(int m, int ch, f32x4 a, f32x4 b) const { st_bf4(O + (size_t)m * ld + ch, a * b); }
    __device__ __forceinline__ void pair8(int m, int ch, f32x4 a0, f32x4 a1, f32x4 b0, f32x4 b1) const { st_bf8(O + (size_t)m * ld + ch, a0 * b0, a1 * b1); } };
struct EpSiluPair { bf16* O; int ld; __device__ __forceinline__ void pair(int m, int ch, f32x4 a, f32x4 b) const {
    f32x4 s; for (int r = 0; r < 4; ++r) s[r] = silu_f(a[r]) * b[r]; st_bf4(O + (size_t)m * ld + ch, s); } };
__device__ __forceinline__ f32x4 ld_bf4(const bf16* p) { const u32x2 w = *(const u32x2*)p; return (f32x4){bflo(w.x), bfhi(w.x), bflo(w.y), bfhi(w.y)}; }
struct EpRes { const float* base; bf16* out; const float* gmod;
    __device__ __forceinline__ void operator()(int m, int n, f32x4 v) const { const int b = m >> 12; const f32x4 g = *(const f32x4*)(gmod + b * 6144 + n);
        const f32x4 x = *(const f32x4*)(base + (size_t)m * DM + n); st_bf4(out + (size_t)m * DM + n, x * ALPHA + g * v); } };
struct EpResB { bf16* res; const float* gmod;
    __device__ __forceinline__ void operator()(int m, int n, f32x4 v) const { const int b = m >> 12; const f32x4 g = *(const f32x4*)(gmod + b * 6144 + n);
        bf16* p = res + (size_t)m * DM + n; st_bf4(p, ld_bf4(p) * ALPHA + g * v); } };
__device__ __forceinline__ int kfrag_off(int kk, int d) { return ((((kk >> 5) * 4 + (d >> 4)) * 2 + ((d >> 3) & 1)) * 32 + (kk & 31)) * 8 + (d & 7); }
__device__ __forceinline__ int vfrag_off(int kk, int d) { return ((((d >> 5) * 4 + (kk >> 4)) * 2 + ((kk >> 2) & 1)) * 32 + (d & 31)) * 8 + ((((kk >> 3) & 1) << 2) | (kk & 3)); }
struct EpKV { bf16* KV; __device__ __forceinline__ void operator()(int m, int n, f32x4 v) const {
    const int j = n >> 8, hk = (n >> 6) & 3, d = n & 63, b = m >> 12, t = m & 4095;
    bf16* base = KV + (size_t)j * KVBUF_ELEMS + (size_t)(b * 4 + hk) * KVROWS * 64;
    if (j < 2) st_bf4(base + (size_t)t * 64 + d, v);
    else if ((j & 1) == 0) st_bf4(base + (size_t)(t >> 6) * 4096 + kfrag_off(t & 63, d), v);
    else { bf16* tp = base + (size_t)(t >> 6) * 4096;
        for (int r = 0; r < 4; ++r) tp[vfrag_off(t & 63, d + r)] = (bf16)f2bf(v[r]); } }
    __device__ __forceinline__ void op8(int m, int n, f32x4 a, f32x4 c) const {
    const int j = n >> 8, hk = (n >> 6) & 3, d = n & 63, b = m >> 12, t = m & 4095;
    bf16* base = KV + (size_t)j * KVBUF_ELEMS + (size_t)(b * 4 + hk) * KVROWS * 64;
    if (j < 2) st_bf8(base + (size_t)t * 64 + d, a, c);
    else if ((j & 1) == 0) st_bf8(base + (size_t)(t >> 6) * 4096 + kfrag_off(t & 63, d), a, c);
    else { bf16* tp = base + (size_t)(t >> 6) * 4096;
        for (int r = 0; r < 4; ++r) { tp[vfrag_off(t & 63, d + r)] = (bf16)f2bf(a[r]); tp[vfrag_off(t & 63, d + 4 + r)] = (bf16)f2bf(c[r]); } } } };
struct EpQG { bf16* Q; float* GATE; const float* bg; __device__ __forceinline__ void operator()(int m, int n, f32x4 v) const {
    if (n < 1024) st_bf4(Q + (size_t)m * DM + n, v * C2);
    else { for (int r = 0; r < 4; ++r) { const int i = n - 1024 + r; if (i < 48) GATE[(size_t)m * 48 + i] = 1.f / (1.f + __expf(-(v[r] + bg[i]))); } } }
    __device__ __forceinline__ void op8(int m, int n, f32x4 a, f32x4 c) const {
    st_bf8(Q + (size_t)m * DM + n, a * C2, c * C2); } };
struct EpF32 { float* O; int ld; __device__ __forceinline__ void operator()(int m, int n, f32x4 v) const { *(f32x4*)(O + (size_t)m * ld + n) = v; } };

template <bool PAIR, class AR, class EP>
__device__ __forceinline__ void gemm_dense(Frame& F, const AR& arow, const bf16* Bt, int K, int nM64, int nN64, int chbase, const EP& ep) {
    const int total = nM64 * nN64;
    for (int it = F.gw; it < total; it += F.NGW) {
        const int ni = it % nN64, mt = it / nN64;
        if constexpr (PAIR) { const int pn = ni >> 2, q = ni & 3;
            gemm_wave_tile<true>(arow, Bt + (size_t)(pn * 256 + q * 32) * K, K, mt * 64, chbase + pn * 128 + q * 32, ep, F.lane);
        } else gemm_wave_tile<false>(arow, Bt + (size_t)(ni * 64) * K, K, mt * 64, chbase + ni * 64, ep, F.lane);
    }
}

namespace pg8 {
#define PG8_LAS __attribute__((address_space(3)))
constexpr int BM = 256, BK = 64, HALF = 128, HTB = HALF * BK * 2, STAGE_BYTES = 8 * HTB, NXCD = 8, WGM = 8;
__device__ __forceinline__ int lds_byte(int r, int c) { const int st = (r >> 4) * 2 + (c >> 5), rr = r & 15, cc = c & 31, ob = rr * 64 + cc * 2; return st * 1024 + (ob ^ (((ob >> 9) & 1) << 5)); }
__device__ __forceinline__ void stage_rc(int b, int& R, int& C) { const int st = b / 1024, sb = b % 1024, swz = sb ^ (((sb >> 9) & 1) << 5); R = (st >> 1) * 16 + swz / 64; C = (st & 1) * 32 + (swz % 64) / 2; }
struct Unit { const char* A; const char* B; int row0, col0, e, pos0, cnt; };
__device__ __forceinline__ bool static_order(int i, int G, int c, int nM, int nN, int& pm, int& pn) {
    const int nwg = nM * nN; const long L = (long)i * G + c; if (L >= nwg) return false;
    int wgid = (int)L; { const int q = nwg / NXCD, r = nwg % NXCD, xcd = wgid % NXCD, off = wgid / NXCD; wgid = (xcd < r ? xcd * (q + 1) : r * (q + 1) + (xcd - r) * q) + off; }
    const int nig = WGM * nN, gid = wgid / nig, fm = gid * WGM, gsz = (nM - fm) < WGM ? (nM - fm) : WGM;
    pm = fm + ((wgid % nig) % gsz); pn = (wgid % nig) / gsz; return true;
}
__device__ __forceinline__ void voff_plain(const int (&R)[2], const int (&C)[2], int K, unsigned (&v)[2][2]) {
#pragma unroll
    for (int h = 0; h < 2; ++h)
#pragma unroll
        for (int i = 0; i < 2; ++i) v[h][i] = (unsigned)((h * HALF + R[i]) * K + C[i]) * 2u;
}
__device__ __forceinline__ int perm32(int rho) { const int n = rho >> 4, i = rho & 15; return 8 * (i >> 2) + 4 * n + (i & 3); }
template <class EP, bool PAIR, bool PERM_ = false> struct EpiWrap {
    static constexpr bool PERM = PERM_;
    EP ep;
    __device__ __forceinline__ void operator()(const f32x4 (&acc)[2][2][4][2], const Unit& u, int wr, int wc, int fr, int fq) const {
#pragma unroll
        for (int ai = 0; ai < 2; ++ai)
#pragma unroll
            for (int m = 0; m < 4; ++m) { const int row = u.row0 + ai * HALF + wr * 64 + m * 16 + fr;
                if constexpr (PERM_) {
                    if constexpr (PAIR) ep.pair8(u, row, u.col0 + wc * 32 + 8 * fq, acc[ai][0][m][0], acc[ai][0][m][1], acc[ai][1][m][0], acc[ai][1][m][1]);
                    else {
#pragma unroll
                        for (int bj = 0; bj < 2; ++bj) ep.op8(u, row, u.col0 + bj * HALF + wc * 32 + 8 * fq, acc[ai][bj][m][0], acc[ai][bj][m][1]); }
                } else if constexpr (PAIR) {
#pragma unroll
                    for (int n = 0; n < 2; ++n) ep.pair(u, row, u.col0 + wc * 32 + 16 * n + 4 * fq, acc[ai][0][m][n], acc[ai][1][m][n]);
                } else {
#pragma unroll
                    for (int bj = 0; bj < 2; ++bj)
#pragma unroll
                        for (int n = 0; n < 2; ++n) ep(u, row, u.col0 + bj * HALF + wc * 32 + 16 * n + 4 * fq, acc[ai][bj][m][n]);
                } }
    }
};
template <class Epi, class Sched, bool ALIGN_EPI, bool GATHER>
__device__ __forceinline__ void gemm_phase(PG8_LAS unsigned char* lds, const int K, const Sched& S, const Epi& E) {
    const int tid = threadIdx.x, wid = __builtin_amdgcn_readfirstlane(tid >> 6), lane = tid & 63, wr = wid >> 2, wc = wid & 3, fr = lane & 15, fq = lane >> 4;
    const int nt = K / BK;
    int R[2], C[2]; unsigned voffB[2]; unsigned vC[2][2], vN[2][2];
#pragma unroll
    for (int i = 0; i < 2; ++i) { stage_rc(tid * 16 + i * 8192, R[i], C[i]); const int Rb = Epi::PERM ? ((R[i] & ~31) | perm32(R[i] & 31)) : R[i]; voffB[i] = (unsigned)(Rb * K + C[i]) * 2u; }
    const size_t kstep = (size_t)(BK * 2);
    const size_t hstep = (size_t)HALF * K * 2;
    const unsigned ldsw = (unsigned)wid * 1024u;
    const int aoff = lds_byte(wr * 64 + fr, fq * 8), boff = lds_byte(wc * 32 + fr, fq * 8);
#define PG8_SA(b, h) (((b) * 2 + (h)) * HTB)
#define PG8_SB(b, h) ((4 + (b) * 2 + (h)) * HTB)
#define PG8_STAGE(bufoff, gbase, voff) do { _Pragma("unroll") for (int _i = 0; _i < 2; ++_i) \
        __builtin_amdgcn_global_load_lds((const unsigned*)((const char*)(gbase) + (voff)[_i]), (PG8_LAS unsigned*)(lds + (bufoff) + ldsw + _i * 8192), 16, 0, 0); } while (0)
#define PG8_LDA(dst, b, h) do { _Pragma("unroll") for (int m = 0; m < 4; ++m) _Pragma("unroll") for (int k = 0; k < 2; ++k) dst[m][k] = *(const PG8_LAS bf16x8*)(lds + PG8_SA(b, h) + aoff + m * 2048 + k * 1024); } while (0)
#define PG8_LDB(dst, b, h) do { _Pragma("unroll") for (int n = 0; n < 2; ++n) _Pragma("unroll") for (int k = 0; k < 2; ++k) dst[n][k] = *(const PG8_LAS bf16x8*)(lds + PG8_SB(b, h) + boff + n * 2048 + k * 1024); } while (0)
#define PG8_MMA(ai, bj, At, Bt) do { __builtin_amdgcn_s_setprio(1); _Pragma("unroll") for (int m = 0; m < 4; ++m) _Pragma("unroll") for (int n = 0; n < 2; ++n) _Pragma("unroll") for (int k = 0; k < 2; ++k) \
        acc[ai][bj][m][n] = __builtin_amdgcn_mfma_f32_16x16x32_bf16(Bt[n][k], At[m][k], acc[ai][bj][m][n], 0, 0, 0); __builtin_amdgcn_s_setprio(0); } while (0)
#define PG8_WAIT_V(n) asm volatile("s_waitcnt vmcnt(" #n ")" ::: "memory")
#define PG8_WAIT_L(n) asm volatile("s_waitcnt lgkmcnt(" #n ")" ::: "memory")
#define PG8_BAR __builtin_amdgcn_s_barrier()
#define PG8_SCHED __builtin_amdgcn_sched_barrier(0)
    Unit cur, nxt; int ui = 0;
    if (!S.next(0, cur)) return;
    S.voff(cur, R, C, K, vC);
    f32x4 acc[2][2][4][2];
#pragma unroll
    for (int a = 0; a < 2; ++a)
#pragma unroll
        for (int b = 0; b < 2; ++b)
#pragma unroll
            for (int m = 0; m < 4; ++m)
#pragma unroll
                for (int n = 0; n < 2; ++n) acc[a][b][m][n] = (f32x4){0.f, 0.f, 0.f, 0.f};
    bf16x8 At[4][2], B0[2][2], B1[2][2];
    const char* cA = cur.A; const char* cB = cur.B;
    PG8_STAGE(PG8_SB(0, 0), cB, voffB); PG8_STAGE(PG8_SB(0, 1), cB + hstep, voffB); PG8_STAGE(PG8_SA(0, 0), cA, vC[0]); PG8_STAGE(PG8_SA(0, 1), cA, vC[1]);
    if (wr == 1) PG8_BAR;
    PG8_WAIT_V(2); PG8_BAR;
    PG8_STAGE(PG8_SB(1, 0), cB + kstep, voffB); PG8_STAGE(PG8_SA(1, 0), cA + kstep, vC[0]); PG8_STAGE(PG8_SB(1, 1), cB + hstep + kstep, voffB);
    PG8_WAIT_V(6); PG8_BAR;
    for (;;) {
        const bool has_next = S.next(ui + 1, nxt);
        const char* nA = has_next ? nxt.A : cA; const char* nB = has_next ? nxt.B : cB;
        if constexpr (GATHER) { if (has_next) S.voff(nxt, R, C, K, vN); else { vN[0][0] = vC[0][0]; vN[0][1] = vC[0][1]; vN[1][0] = vC[1][0]; vN[1][1] = vC[1][1]; } }
        for (int t = 0; t < nt; t += 2) {
            const bool last = (t == nt - 2);
            const char* a1 = cA + (size_t)(t + 1) * kstep;
            const char* a2 = last ? nA : cA + (size_t)(t + 2) * kstep; const char* b2 = last ? nB : cB + (size_t)(t + 2) * kstep;
            const char* a3 = a2 + kstep; const char* b3 = b2 + kstep;
            unsigned v2[2][2];
#pragma unroll
            for (int h = 0; h < 2; ++h)
#pragma unroll
                for (int i = 0; i < 2; ++i) v2[h][i] = (GATHER && last) ? vN[h][i] : vC[h][i];
            PG8_LDB(B0, 0, 0); PG8_LDB(B1, 0, 1); PG8_SCHED; PG8_LDA(At, 0, 0); PG8_STAGE(PG8_SA(1, 1), a1, vC[1]);
            PG8_WAIT_V(8); PG8_WAIT_L(0); PG8_BAR; PG8_MMA(0, 0, At, B0); PG8_MMA(0, 1, At, B1); PG8_BAR; PG8_SCHED;
            PG8_LDA(At, 0, 1); PG8_STAGE(PG8_SB(0, 0), b2, voffB); PG8_STAGE(PG8_SB(0, 1), b2 + hstep, voffB); PG8_STAGE(PG8_SA(0, 0), a2, v2[0]);
            PG8_WAIT_V(8); PG8_WAIT_L(0); PG8_BAR; PG8_MMA(1, 0, At, B0); PG8_MMA(1, 1, At, B1); PG8_BAR; PG8_SCHED;
            PG8_LDB(B0, 1, 0); PG8_LDB(B1, 1, 1); PG8_SCHED; PG8_LDA(At, 1, 0); PG8_STAGE(PG8_SA(0, 1), a2, v2[1]);
            PG8_WAIT_V(8); PG8_WAIT_L(0); PG8_BAR; PG8_MMA(0, 0, At, B0); PG8_MMA(0, 1, At, B1); PG8_BAR; PG8_SCHED;
            PG8_LDA(At, 1, 1); PG8_STAGE(PG8_SB(1, 0), b3, voffB); PG8_STAGE(PG8_SB(1, 1), b3 + hstep, voffB); PG8_STAGE(PG8_SA(1, 0), a3, v2[0]);
            PG8_WAIT_V(8); PG8_WAIT_L(0); PG8_BAR; PG8_MMA(1, 0, At, B0); PG8_MMA(1, 1, At, B1); PG8_BAR; PG8_SCHED;
        }
        if constexpr (ALIGN_EPI) { if (wr == 0) PG8_BAR; }
        E(acc, cur, wr, wc, fr, fq);
        if (!has_next) break;
#pragma unroll
        for (int a = 0; a < 2; ++a)
#pragma unroll
            for (int b = 0; b < 2; ++b)
#pragma unroll
                for (int m = 0; m < 4; ++m)
#pragma unroll
                    for (int n = 0; n < 2; ++n) acc[a][b][m][n] = (f32x4){0.f, 0.f, 0.f, 0.f};
        cur = nxt; cA = nA; cB = nB; ++ui;
        if constexpr (GATHER) { vC[0][0] = vN[0][0]; vC[0][1] = vN[0][1]; vC[1][0] = vN[1][0]; vC[1][1] = vN[1][1]; }
        if constexpr (ALIGN_EPI) { if (wr == 1) PG8_BAR; }
    }
    PG8_WAIT_V(0);
    if constexpr (!ALIGN_EPI) { if (wr == 0) PG8_BAR; }
    PG8_BAR;
#undef PG8_SA
#undef PG8_SB
#undef PG8_STAGE
#undef PG8_LDA
#undef PG8_LDB
#undef PG8_MMA
#undef PG8_WAIT_V
#undef PG8_WAIT_L
#undef PG8_BAR
#undef PG8_SCHED
}
struct SchedDense {
    const char* A0; const char* B0; const char* A1; const char* B1; int nM, nN0, nN1, K, G, c, colmul;
    __device__ __forceinline__ bool next(int i, Unit& u) const {
        int pm, pn; if (!static_order(i, G, c, nM, nN0 + nN1, pm, pn)) return false;
        const int sec = pn >= nN0 ? 1 : 0, pl = pn - (sec ? nN0 : 0);
        u.A = (sec ? A1 : A0) + (size_t)pm * 256 * K * 2; u.B = (sec ? B1 : B0) + (size_t)pl * 256 * K * 2;
        u.row0 = pm * 256; u.col0 = pl * colmul; u.e = sec; u.pos0 = 0; u.cnt = 0; return true;
    }
    __device__ __forceinline__ void voff(const Unit&, const int (&R)[2], const int (&C)[2], int K_, unsigned (&v)[2][2]) const { voff_plain(R, C, K_, v); }
};
}
template <class EP> struct EpU { EP ep; __device__ __forceinline__ void operator()(const pg8::Unit&, int m, int n, f32x4 v) const { ep(m, n, v); }
    __device__ __forceinline__ void op8(const pg8::Unit&, int m, int n, f32x4 a, f32x4 b) const { ep.op8(m, n, a, b); } };
template <class EP> struct EpUP { EP ep; __device__ __forceinline__ void pair(const pg8::Unit&, int m, int ch, f32x4 a, f32x4 b) const { ep.pair(m, ch, a, b); }
    __device__ __forceinline__ void pair8(const pg8::Unit&, int m, int ch, f32x4 a0, f32x4 a1, f32x4 b0, f32x4 b1) const { ep.pair8(m, ch, a0, a1, b0, b1); } };
struct EpG1 { static constexpr bool PERM = true; bf16* BG; bf16* Z;
    __device__ __forceinline__ void operator()(const f32x4 (&acc)[2][2][4][2], const pg8::Unit& u, int wr, int wc, int fr, int fq) const {
        if (u.e == 0) { pg8::EpiWrap<EpU<EpBf16>, false, true> w{{{BG, DM}}}; w(acc, u, wr, wc, fr, fq); }
        else { pg8::Unit u2 = u; u2.col0 = u.col0 >> 1; pg8::EpiWrap<EpUP<EpMulPair>, true, true> w{{{Z, DM}}}; w(acc, u2, wr, wc, fr, fq); }
    } };
struct EpNull { static constexpr bool PERM = false; __device__ __forceinline__ void operator()(const f32x4 (&acc)[2][2][4][2], const pg8::Unit&, int, int, int, int) const {
#pragma unroll
    for (int a = 0; a < 2; ++a)
#pragma unroll
        for (int b = 0; b < 2; ++b)
#pragma unroll
            for (int m = 0; m < 4; ++m)
#pragma unroll
                for (int n = 0; n < 2; ++n) asm volatile("" :: "v"(acc[a][b][m][n])); } };
struct EpKVQG { bf16* KV; bf16* Q; float* GATE; const float* bg;
    __device__ __forceinline__ void operator()(const pg8::Unit& u, int m, int n, f32x4 v) const { if (u.e == 0) { EpKV e{KV}; e(m, n, v); } else { EpQG e{Q, GATE, bg}; e(m, n, v); } }
    __device__ __forceinline__ void op8(const pg8::Unit& u, int m, int n, f32x4 a, f32x4 b) const { if (u.e == 0) { EpKV e{KV}; e.op8(m, n, a, b); } else { EpQG e{Q, GATE, bg}; e.op8(m, n, a, b); } } };
struct EpKVQGAll { static constexpr bool PERM = true; EpKVQG ep;
    __device__ __forceinline__ void operator()(const f32x4 (&acc)[2][2][4][2], const pg8::Unit& u, int wr, int wc, int fr, int fq) const {
        if (u.e == 1 && u.col0 == 1024) {
            const int i0 = wc * 32 + 8 * fq;
            if (i0 < 48) {
                const f32x4 b0 = *(const f32x4*)(ep.bg + i0), b1 = *(const f32x4*)(ep.bg + i0 + 4);
#pragma unroll
                for (int ai = 0; ai < 2; ++ai)
#pragma unroll
                    for (int m = 0; m < 4; ++m) { const int row = u.row0 + ai * pg8::HALF + wr * 64 + m * 16 + fr;
                        f32x4 g0, g1;
#pragma unroll
                        for (int r = 0; r < 4; ++r) { g0[r] = __builtin_amdgcn_rcpf(1.f + __builtin_amdgcn_exp2f(-1.4426950408889634f * (acc[ai][0][m][0][r] + b0[r])));
                                                      g1[r] = __builtin_amdgcn_rcpf(1.f + __builtin_amdgcn_exp2f(-1.4426950408889634f * (acc[ai][0][m][1][r] + b1[r]))); }
                        float* gp = ep.GATE + (size_t)row * 48 + i0; *(f32x4*)gp = g0; *(f32x4*)(gp + 4) = g1; }
            }
        } else { pg8::EpiWrap<EpKVQG, false, true> w{ep}; w(acc, u, wr, wc, fr, fq); }
    } };

__device__ __forceinline__ void p3_conv(Frame& F) {
    const bf16* BG = (const bf16*)(F.wsp() + WS_BG); const bf16* Z = (const bf16*)(F.wsp() + WS_Z); bf16* A2 = (bf16*)(F.wsp() + WS_A2);
    const float* cw = F.inp(I_CONVW); const float* cb = F.inp(I_CONVB);
    const int gt = F.gw * 64 + F.lane, NT_ = F.NGW * 64;
    for (int it = gt; it < T * 128; it += NT_) {
        const int m = it >> 7, ch = (it & 127) * 8, t = m & 4095;
        const u32x4 bg = *(const u32x4*)(BG + (size_t)m * DM + ch);
        const u32x4 z0 = *(const u32x4*)(Z + (size_t)m * DM + ch);
        u32x4 z1 = (u32x4){0, 0, 0, 0}, z2 = (u32x4){0, 0, 0, 0};
        if (t >= 1) z1 = *(const u32x4*)(Z + (size_t)(m - 1) * DM + ch);
        if (t >= 2) z2 = *(const u32x4*)(Z + (size_t)(m - 2) * DM + ch);
        u32x4 o;
#pragma unroll
        for (int w = 0; w < 4; ++w) {
            const int c = ch + 2 * w;
            const float r0 = bflo(bg[w]) * (cw[c] * bflo(z2[w]) + cw[1024 + c] * bflo(z1[w]) + cw[2048 + c] * bflo(z0[w]) + cb[c]);
            const float r1 = bfhi(bg[w]) * (cw[c + 1] * bfhi(z2[w]) + cw[1024 + c + 1] * bfhi(z1[w]) + cw[2048 + c + 1] * bfhi(z0[w]) + cb[c + 1]);
            o[w] = pk2(r0, r1);
        }
        *(u32x4*)(A2 + (size_t)m * DM + ch) = o;
    }
}

__device__ __forceinline__ void ln_row(f32x4 (&v)[4], const float* g, const float* bb, int lane) {
    float s = 0.f;
#pragma unroll
    for (int j = 0; j < 4; ++j) s += (v[j][0] + v[j][1]) + (v[j][2] + v[j][3]);
    const float mean = wave_sum(s) * (1.f / DM); float s2 = 0.f;
#pragma unroll
    for (int j = 0; j < 4; ++j) { v[j] = v[j] - mean; s2 += (v[j][0] * v[j][0] + v[j][1] * v[j][1]) + (v[j][2] * v[j][2] + v[j][3] * v[j][3]); }
    const float rstd = 1.f / sqrtf(wave_sum(s2) * (1.f / DM) + LN_EPS);
#pragma unroll
    for (int j = 0; j < 4; ++j) { const int col = 4 * lane + 256 * j; v[j] = v[j] * rstd * *(const f32x4*)(g + col) + *(const f32x4*)(bb + col); }
}
template <int L, bool DRY = false>
__device__ __forceinline__ void p_ln_router(Frame& F) {
    bf16* RES = (bf16*)(F.wsp() + WS_XB); bf16* U = (bf16*)(F.wsp() + WS_U);
    bf16* RESO = DRY ? (bf16*)(F.wsp() + WS_Y0) : RES; if (DRY) U = (bf16*)(F.wsp() + WS_H);
    const float* MOD = (const float*)(F.wsp() + WS_MOD) + (size_t)L * 4 * 6144;
    const float* rw = F.inp(I_RW); const float* rb = F.inp(I_RB);
    gu32* cnt = F.ctlp() + CW_CNT + L * 1024;
    unsigned* LIST = (unsigned*)(F.wsp() + WS_LIST) + (size_t)L * NE * T; float* LW = (float*)(F.wsp() + WS_LW) + (size_t)L * NE * T;
    const int lane = F.lane;
    LAS int* ae = (LAS int*)F.lds; LAS float* aw = (LAS float*)(F.lds + 512); LAS int* base = (LAS int*)(F.lds + 1024);
    constexpr int RS = 2064, AST_OFF = 2048, ALO_OFF = AST_OFF + 16 * RS, PST_OFF = ALO_OFF + 16 * RS;
    static_assert(PST_OFF + 8192 <= LDSCTL_OFF, "router LDS map");
    const int r16 = lane & 15, kg = lane >> 4;
    bf16x8 Bh[4], Bl[4];
#pragma unroll
    for (int s_ = 0; s_ < 4; ++s_) { u32x4 hh, ll;
#pragma unroll
        for (int i = 0; i < 4; ++i) { const int k = 128 * F.wave + 32 * s_ + 8 * kg + 2 * i; const float a = rw[(size_t)k * 16 + r16], b_ = rw[(size_t)(k + 1) * 16 + r16];
            const unsigned h = pk2(a, b_); hh[i] = h; ll[i] = pk2(a - bflo(h), b_ - bfhi(h)); }
        Bh[s_] = __builtin_bit_cast(bf16x8, hh); Bl[s_] = __builtin_bit_cast(bf16x8, ll); }
    const int nchunk = T / 64;
    for (int ch = blockIdx.x; ch < nchunk; ch += gridDim.x) {
      const bf16* YB = (const bf16*)(F.wsp() + WS_Y0); const float* XF = F.inp(I_X);
      u32x2 yn[4]; f32x4 xn[4];
#pragma unroll
      for (int j = 0; j < 4; ++j) { const size_t o = (size_t)(ch * 64 + F.wave * 2) * DM + 4 * lane + 256 * j; yn[j] = *(const u32x2*)(YB + o);
          if (L == 0) xn[j] = *(const f32x4*)(XF + o); else xn[j] = ld_bf4(RES + o); }
#pragma unroll 2
      for (int rr = 0; rr < 8; ++rr) {
        const int pass = rr >> 1, sub = rr & 1, lrow = pass * 16 + F.wave * 2 + sub, m = ch * 64 + lrow;
        const int b = m >> 12;
        f32x4 v[4];
#pragma unroll
        for (int j = 0; j < 4; ++j) { const f32x4 g1 = *(const f32x4*)(MOD + b * 6144 + 2 * 1024 + 4 * lane + 256 * j);
            v[j] = xn[j] * ALPHA + g1 * (f32x4){bflo(yn[j].x), bfhi(yn[j].x), bflo(yn[j].y), bfhi(yn[j].y)}; }
        if (rr < 7) {
#pragma unroll
            for (int j = 0; j < 4; ++j) { const size_t o = (size_t)(m + (sub ? 15 : 1)) * DM + 4 * lane + 256 * j; yn[j] = *(const u32x2*)(YB + o);
                if (L == 0) xn[j] = *(const f32x4*)(XF + o); else xn[j] = ld_bf4(RES + o); } }
        ln_row(v, F.inp(I_LNG) + (L * 2 + 0) * DM, F.inp(I_LNB) + (L * 2 + 0) * DM, lane);
        {
            LAS unsigned char* arow = F.lds + AST_OFF + (F.wave * 2 + sub) * RS + lane * 8;
#pragma unroll
            for (int j = 0; j < 4; ++j) { const int col = 4 * lane + 256 * j;
                st_bf4(RESO + (size_t)m * DM + col, v[j]);
                const f32x4 u = v[j] * (*(const f32x4*)(MOD + b * 6144 + 4 * 1024 + col) + 1.0f) + *(const f32x4*)(MOD + b * 6144 + 3 * 1024 + col);
                u32x2 hh, ll; hh.x = pk2(u[0], u[1]); hh.y = pk2(u[2], u[3]);
                ll.x = pk2(u[0] - bflo(hh.x), u[1] - bfhi(hh.x)); ll.y = pk2(u[2] - bflo(hh.y), u[3] - bfhi(hh.y));
                *(u32x2*)(U + (size_t)m * DM + col) = hh;
                *(LAS u32x2*)(arow + j * 512) = hh; *(LAS u32x2*)(arow + 16 * RS + j * 512) = ll; }
        }
        if (sub == 0) continue;
        __syncthreads();
        float lgv;
        {
            f32x4 acc = (f32x4){0.f, 0.f, 0.f, 0.f};
            const LAS unsigned char* ap = F.lds + AST_OFF + r16 * RS + (128 * F.wave + 8 * kg) * 2;
#pragma unroll
            for (int s_ = 0; s_ < 4; ++s_) { const bf16x8 ah = *(const LAS bf16x8*)(ap + s_ * 64), al = *(const LAS bf16x8*)(ap + 16 * RS + s_ * 64);
                acc = __builtin_amdgcn_mfma_f32_16x16x32_bf16(ah, Bh[s_], acc, 0, 0, 0);
                acc = __builtin_amdgcn_mfma_f32_16x16x32_bf16(al, Bh[s_], acc, 0, 0, 0);
                acc = __builtin_amdgcn_mfma_f32_16x16x32_bf16(ah, Bl[s_], acc, 0, 0, 0); }
            *(LAS f32x4*)(F.lds + PST_OFF + ((F.wave * 4 + kg) * 16 + r16) * 16) = acc;
            __syncthreads();
            const int rho = 2 * F.wave + (kg & 1); float sm = 0.f;
#pragma unroll
            for (int x = 0; x < 4; ++x) sm += *(const LAS float*)(F.lds + PST_OFF + ((((kg >> 1) * 4 + x) * 4 + (rho >> 2)) * 16 + r16) * 16 + (rho & 3) * 4);
            lgv = sm + __shfl_xor(sm, 32);
        }
#pragma unroll 1
        for (int sb = 0; sb < 2; ++sb) {
        const int lrow2 = pass * 16 + F.wave * 2 + sb;
        float lg[16];
#pragma unroll
        for (int e = 0; e < 16; ++e) lg[e] = __builtin_bit_cast(float, __builtin_amdgcn_readlane(__builtin_bit_cast(int, lgv), 16 * sb + e));
        float mx = lg[0];
#pragma unroll
        for (int e = 1; e < 16; ++e) mx = fmaxf(mx, lg[e]);
        float aff[16], bi[16]; float sum = 0.f;
#pragma unroll
        for (int e = 0; e < 16; ++e) { aff[e] = __expf(lg[e] - mx); sum += aff[e]; }
        const float inv = 1.f / sum;
#pragma unroll
        for (int e = 0; e < 16; ++e) { aff[e] *= inv; bi[e] = aff[e] + rb[e]; }
        float gs[4];
#pragma unroll
        for (int g = 0; g < 4; ++g) { const float a0 = bi[4 * g], a1 = bi[4 * g + 1], a2 = bi[4 * g + 2], a3 = bi[4 * g + 3];
            const float t1 = fmaxf(a0, a1), t2 = fminf(a0, a1), u1 = fmaxf(a2, a3), u2 = fminf(a2, a3);
            gs[g] = fmaxf(t1, u1) + fmaxf(fminf(t1, u1), fmaxf(t2, u2)); }
        int best = 0; float bv = gs[0];
#pragma unroll
        for (int g = 1; g < 4; ++g) if (gs[g] > bv) { bv = gs[g]; best = g; }
        float cb_[4], ca_[4];
#pragma unroll
        for (int i = 0; i < 4; ++i) { cb_[i] = best == 0 ? bi[i] : best == 1 ? bi[4 + i] : best == 2 ? bi[8 + i] : bi[12 + i];
                                      ca_[i] = best == 0 ? aff[i] : best == 1 ? aff[4 + i] : best == 2 ? aff[8 + i] : aff[12 + i]; }
        int i0 = 0; float b0 = cb_[0];
#pragma unroll
        for (int i = 1; i < 4; ++i) if (cb_[i] > b0) { b0 = cb_[i]; i0 = i; }
        int i1 = -1; float b1 = -3.0e38f;
#pragma unroll
        for (int i = 0; i < 4; ++i) if (i != i0 && cb_[i] > b1) { b1 = cb_[i]; i1 = i; }
        const float w0 = i0 == 0 ? ca_[0] : i0 == 1 ? ca_[1] : i0 == 2 ? ca_[2] : ca_[3];
        const float w1 = i1 == 0 ? ca_[0] : i1 == 1 ? ca_[1] : i1 == 2 ? ca_[2] : ca_[3];
        const float ws_ = 1.f / (w0 + w1);
        if (lane == 0) { ae[2 * lrow2] = best * 4 + i0; ae[2 * lrow2 + 1] = best * 4 + i1; aw[2 * lrow2] = w0 * ws_; aw[2 * lrow2 + 1] = w1 * ws_; }
        }
      }
      __syncthreads();
      if (DRY) continue;
      if (F.tid < NE) { int c = 0; for (int i = 0; i < 128; ++i) c += (ae[i] == F.tid) ? 1 : 0;
          base[F.tid] = c ? (int)__hip_atomic_fetch_add(cnt + F.tid * 64, (unsigned)c, RLX_AGENT) : 0; }
      __syncthreads();
      if (F.tid < 128) { const int e = ae[F.tid]; int rk = 0; for (int i = 0; i < F.tid; ++i) rk += (ae[i] == e) ? 1 : 0;
          const int pos = base[e] + rk; const unsigned m = (unsigned)(ch * 64 + (F.tid >> 1));
          LIST[(size_t)e * T + pos] = m * 2u + (unsigned)(F.tid & 1); LW[(size_t)e * T + pos] = aw[F.tid]; }
      __syncthreads();
    }
}
template <int L, bool DRY = false>
__device__ __forceinline__ void p_ln2(Frame& F) {
    bf16* RES = (bf16*)(F.wsp() + WS_XB); bf16* U = (bf16*)(F.wsp() + WS_U); float* OUT = F.outp();
    bf16* RESO = DRY ? (bf16*)(F.wsp() + WS_R1) : RES; if (DRY) { U = (bf16*)(F.wsp() + WS_H); }
    const bf16* Y0 = (const bf16*)(F.wsp() + WS_Y0); const bf16* Y1 = (const bf16*)(F.wsp() + WS_Y1);
    const float* MOD = (const float*)(F.wsp() + WS_MOD) + (size_t)L * 4 * 6144;
    const float* MODN = (const float*)(F.wsp() + WS_MOD) + (size_t)1 * 4 * 6144;
    const int lane = F.lane;
    for (int m = F.gw; m < T; m += F.NGW) {
        const int b = m >> 12;
        f32x4 v[4];
#pragma unroll
        for (int j = 0; j < 4; ++j) { const int col = 4 * lane + 256 * j;
            const f32x4 x = ld_bf4(RES + (size_t)m * DM + col);
            const u32x2 a = *(const u32x2*)(Y0 + (size_t)m * DM + col), c = *(const u32x2*)(Y1 + (size_t)m * DM + col);
            const f32x4 y = (f32x4){bflo(a.x) + bflo(c.x), bfhi(a.x) + bfhi(c.x), bflo(a.y) + bflo(c.y), bfhi(a.y) + bfhi(c.y)};
            v[j] = x * ALPHA + *(const f32x4*)(MOD + b * 6144 + 5 * 1024 + col) * y; }
        ln_row(v, F.inp(I_LNG) + (L * 2 + 1) * DM, F.inp(I_LNB) + (L * 2 + 1) * DM, lane);
#pragma unroll
        for (int j = 0; j < 4; ++j) { const int col = 4 * lane + 256 * j;
            if (L == 1) *(f32x4*)(OUT + (size_t)m * DM + col) = v[j];
            if (L == 0) { st_bf4(RESO + (size_t)m * DM + col, v[j]);
                st_bf4(U + (size_t)m * DM + col, v[j] * (*(const f32x4*)(MODN + b * 6144 + 1024 + col) + 1.0f) + *(const f32x4*)(MODN + b * 6144 + col)); } }
    }
}

__device__ __forceinline__ void moe_tables(Frame& F, int L) {
    LAS int* tb = (LAS int*)(F.lds + MISC_OFF + 128); LAS int* cn = tb + 20;
    LAS unsigned char* te = (LAS unsigned char*)(tb + 40);
    __syncthreads();
    if (F.tid < NE) cn[F.tid] = (int)__hip_atomic_load(F.ctlp() + CW_CNT + L * 1024 + F.tid * 64, RLX_AGENT);
    __syncthreads();
    if (F.tid == 0) { int acc = 0; for (int e = 0; e < NE; ++e) { const int nte = (cn[e] + 255) >> 8; tb[e] = acc; for (int q = 0; q < nte; ++q) te[acc + q] = (unsigned char)e; acc += nte; } tb[NE] = acc; }
    __syncthreads();
}
struct ARowMoe { const bf16* U; const unsigned* list; int rbase, cnt;
    __device__ __forceinline__ const bf16* operator()(int r) const { const int pos = r - rbase; const unsigned tok = pos < cnt ? (list[pos] >> 1) : 0u; return U + (size_t)tok * DM; } };
struct EpY { bf16* Y; const unsigned* list; const float* lw; int rbase, cnt;
    __device__ __forceinline__ void operator()(int r, int n, f32x4 v) const { const int pos = r - rbase; if (pos < cnt) { const unsigned ts = list[pos]; const float w = lw[pos];
        st_bf4(Y + (size_t)(ts & 1u) * ((size_t)T * DM) + (size_t)(ts >> 1) * DM + n, v * w); } } };
template <int L>
__device__ __forceinline__ void p_moe_gu(Frame& F) {
    moe_tables(F, L);
    LAS int* tb = (LAS int*)(F.lds + MISC_OFF + 128); LAS int* cn = tb + 20;
    const unsigned* LIST = (const unsigned*)(F.wsp() + WS_LIST) + (size_t)L * NE * T;
    const int total = tb[NE] * 4 * 16;
    for (int it = F.gw; it < total; it += F.NGW) {
        const int ni = it & 15, mt = it >> 4; int e = 0; while (tb[e + 1] * 4 <= mt) ++e;
        const ARowMoe ar{(const bf16*)(F.wsp() + WS_U), LIST + (size_t)e * T, tb[e] * 256, cn[e]};
        const EpSiluPair ep{(bf16*)(F.wsp() + WS_H), FF};
        const int pn = ni >> 2, q = ni & 3;
        gemm_wave_tile<true>(ar, (const bf16*)(F.wsp() + WS_WGU) + (size_t)(L * NE + e) * 1024 * 1024 + (size_t)(pn * 256 + q * 32) * 1024, 1024, mt * 64, pn * 128 + q * 32, ep, F.lane);
    }
}
template <int L>
__device__ __forceinline__ void p_moe_down(Frame& F) {
    moe_tables(F, L);
    LAS int* tb = (LAS int*)(F.lds + MISC_OFF + 128); LAS int* cn = tb + 20;
    const unsigned* LIST = (const unsigned*)(F.wsp() + WS_LIST) + (size_t)L * NE * T; const float* LW = (const float*)(F.wsp() + WS_LW) + (size_t)L * NE * T;
    const int total = tb[NE] * 4 * 16;
    for (int it = F.gw; it < total; it += F.NGW) {
        const int ni = it & 15, mt = it >> 4; int e = 0; while (tb[e + 1] * 4 <= mt) ++e;
        const ARowPlain ar{(const bf16*)(F.wsp() + WS_H), FF};
        const EpY ep{(bf16*)(F.wsp() + WS_Y0), LIST + (size_t)e * T, LW + (size_t)e * T, tb[e] * 256, cn[e]};
        gemm_wave_tile<false>(ar, (const bf16*)(F.wsp() + WS_WDN) + (size_t)(L * NE + e) * 1024 * 512 + (size_t)(ni * 64) * 512, 512, mt * 64, ni * 64, ep, F.lane);
    }
}

struct ARowCmp { const bf16* KVi; __device__ __forceinline__ const bf16* operator()(int R) const { return KVi + ((size_t)(R >> 8) * KVROWS + (size_t)(R & 255) * 16) * 64; } };
__device__ __forceinline__ float gelu_tanh(float x) { const float u = 0.7978845608028654f * (x + 0.044715f * x * x * x); const float e = __expf(2.f * u); const float th = 1.f - 2.f / (e + 1.f); return 0.5f * x * (1.f + th); }
__device__ __forceinline__ void p_cmp_finish(Frame& F) {
    LAS float* w2s = (LAS float*)F.lds;
    LAS float* hd = (LAS float*)(F.lds + 65536 + F.wave * 4096);
    const float* TB = (const float*)(F.wsp() + WS_TB); const float* PETP = (const float*)(F.wsp() + WS_PETP);
    const int lane = F.lane;
    for (int base = blockIdx.x * 32; base < 2 * 16 * 256; base += gridDim.x * 32) {
        const int i = base >> 12;
        __syncthreads();
        const int it0 = base + F.wave * 4, bh = (it0 >> 8) & 15, n0 = it0 & 255, c = 4 * lane;
        f32x4 wv[8], ta[4], tb_[4];
#pragma unroll
        for (int k = 0; k < 8; ++k) wv[k] = *(const f32x4*)(F.inp(I_CW2) + (size_t)i * 256 * 64 + 4 * (F.tid + 512 * k));
#pragma unroll
        for (int r = 0; r < 4; ++r) { const int n = n0 + r < 255 ? n0 + r : 254; const float* r0 = TB + ((size_t)i * 4096 + bh * 256 + n) * 512; ta[r] = *(const f32x4*)(r0 + c); tb_[r] = *(const f32x4*)(r0 + 512 + 256 + c); }
        const f32x4 pe = *(const f32x4*)(PETP + 64 * 256 + i * 256 + c);
#pragma unroll
        for (int k = 0; k < 8; ++k) *(LAS f32x4*)(w2s + 4 * (F.tid + 512 * k)) = wv[k];
#pragma unroll
        for (int r = 0; r < 4; ++r) { const int n = n0 + r;
            f32x4 h = (f32x4){0.f, 0.f, 0.f, 0.f};
            if (n < 255) h = ta[r] + tb_[r] + pe;
#pragma unroll
            for (int q = 0; q < 4; ++q) hd[(c + q) * 4 + r] = gelu_tanh(h[q]); }
        __syncthreads();
        const float b2 = F.inp(I_CB2)[i * 64 + lane];
        float a0 = b2, a1 = b2, a2 = b2, a3 = b2;
#pragma unroll 8
        for (int cc = 0; cc < 256; ++cc) { const float w = w2s[cc * 64 + lane]; const f32x4 h4 = *(const LAS f32x4*)(hd + cc * 4);
            a0 += h4[0] * w; a1 += h4[1] * w; a2 += h4[2] * w; a3 += h4[3] * w; }
        const float av[4] = {a0, a1, a2, a3};
#pragma unroll
        for (int r = 0; r < 4; ++r) { const int n = n0 + r;
            bf16* dst = (bf16*)(F.wsp() + (i ? WS_VC : WS_KC)) + (size_t)bh * 256 * 64 + (size_t)(n >> 6) * 4096 + (i ? vfrag_off(n & 63, lane) : kfrag_off(n & 63, lane));
            *dst = (n == 255) ? (bf16)0 : (bf16)f2bf(av[r]); }
    }
}

__device__ __forceinline__ void score_tile(const bf16* krow, const LAS float* qs, float (&s)[4]) {
    s[0] = s[1] = s[2] = s[3] = 0.f;
#pragma unroll
    for (int c = 0; c < 8; ++c) { const u32x4 kv = *(const u32x4*)(krow + 8 * c);
#pragma unroll
        for (int w = 0; w < 4; ++w) { const f32x4 qa = *(const LAS f32x4*)(qs + (8 * c + 2 * w) * 4), qb = *(const LAS f32x4*)(qs + (8 * c + 2 * w + 1) * 4);
            const float ka = bflo(kv[w]), kb = bfhi(kv[w]);
            s[0] += ka * qa[0] + kb * qb[0]; s[1] += ka * qa[1] + kb * qb[1]; s[2] += ka * qa[2] + kb * qb[2]; s[3] += ka * qa[3] + kb * qb[3]; } }
}
__device__ __forceinline__ void attend_tile(const bf16* Kt, const bf16* Vt, bool valid, const LAS float* qs, LAS float* pbuf, float (&mr)[4], float (&l)[4], float (&o)[4], int lane) {
    float s[4]; score_tile(Kt + (size_t)lane * 64, qs, s);
    f32x4 p4;
#pragma unroll
    for (int g = 0; g < 4; ++g) {
        const float sg = valid ? s[g] : -INFINITY; const float tm = wave_max(sg); const float mn = fmaxf(mr[g], tm);
        const float mref = (mn == -INFINITY) ? 0.f : mn;
        const float alpha = __builtin_amdgcn_exp2f(mr[g] - mref); const float p = valid ? __builtin_amdgcn_exp2f(sg - mref) : 0.f;
        l[g] = l[g] * alpha + wave_sum(p); o[g] *= alpha; mr[g] = mn; p4[g] = p;
    }
    LDS_WAIT(); asm volatile("" ::: "memory");
    *(LAS f32x4*)(pbuf + lane * 4) = p4;
    LDS_WAIT(); asm volatile("" ::: "memory");
#pragma unroll 8
    for (int k = 0; k < 64; ++k) { const f32x4 pk = *(const LAS f32x4*)(pbuf + k * 4); const float vv = bf2f(Vt[(size_t)k * 64 + lane]);
        o[0] += pk[0] * vv; o[1] += pk[1] * vv; o[2] += pk[2] * vv; o[3] += pk[3] * vv; }
    LDS_WAIT(); asm volatile("" ::: "memory");
}
__device__ __forceinline__ void p_attn_simple(Frame& F) {
    LAS float* qs = (LAS float*)(F.lds + F.wave * 16384);
    LAS float* pbuf = qs + 256;
    LAS float* psum = pbuf + 1024;
    const bf16* Q = (const bf16*)(F.wsp() + WS_Q); const float* GATE = (const float*)(F.wsp() + WS_GATE); bf16* O = (bf16*)(F.wsp() + WS_O);
    const bf16* KVb = (const bf16*)(F.wsp() + WS_KV);
    const int lane = F.lane;
    for (int it = F.gw; it < 16 * SEQ; it += F.NGW) {
        const int bh = it & 15, t = it >> 4, b = bh >> 2, hk = bh & 3, m = b * SEQ + t;
        LDS_WAIT(); asm volatile("" ::: "memory");
        { f32x4 q4; for (int g = 0; g < 4; ++g) q4[g] = bf2f(Q[(size_t)m * DM + (hk * 4 + g) * 64 + lane]); *(LAS f32x4*)(qs + lane * 4) = q4; }
        LDS_WAIT(); asm volatile("" ::: "memory");
        const bf16* KC = (const bf16*)(F.wsp() + WS_KC) + (size_t)bh * 256 * 64; const bf16* VC = (const bf16*)(F.wsp() + WS_VC) + (size_t)bh * 256 * 64;
        const int nv = t >= 31 ? ((t - 31) >> 4) + 1 : 0;
        float sc[4][4];
#pragma unroll
        for (int i = 0; i < 4; ++i) { float s[4] = {0.f, 0.f, 0.f, 0.f}; if (64 * i < nv) score_tile(KC + (size_t)(64 * i + lane) * 64, qs, s);
            const bool v = (64 * i + lane) < nv;
#pragma unroll
            for (int g = 0; g < 4; ++g) sc[i][g] = v ? s[g] : -INFINITY; }
        float oc[4];
#pragma unroll
        for (int g = 0; g < 4; ++g) {
            const float mx = wave_max(fmaxf(fmaxf(sc[0][g], sc[1][g]), fmaxf(sc[2][g], sc[3][g]))); const float mref = (mx == -INFINITY) ? 0.f : mx;
            float e[4]; float ls = 0.f;
#pragma unroll
            for (int i = 0; i < 4; ++i) { e[i] = __builtin_amdgcn_exp2f(sc[i][g] - mref); ls += e[i]; }
            const float inv = 1.f / fmaxf(wave_sum(ls), 1e-30f);
#pragma unroll
            for (int i = 0; i < 4; ++i) sc[i][g] = e[i] * inv;
        }
#pragma unroll
        for (int i = 0; i < 4; ++i) { *(LAS f32x4*)(pbuf + (64 * i + lane) * 4) = (f32x4){sc[i][0], sc[i][1], sc[i][2], sc[i][3]};
            psum[64 * i + lane + 1] = (sc[i][0] + sc[i][1]) + (sc[i][2] + sc[i][3]); }
        if (lane == 0) psum[0] = 0.f;
        LDS_WAIT(); asm volatile("" ::: "memory");
        oc[0] = oc[1] = oc[2] = oc[3] = 0.f;
        for (int n = 0; n < nv; ++n) { const f32x4 pk = *(const LAS f32x4*)(pbuf + n * 4); const float vv = bf2f(VC[(size_t)n * 64 + lane]);
            oc[0] += pk[0] * vv; oc[1] += pk[1] * vv; oc[2] += pk[2] * vv; oc[3] += pk[3] * vv; }
        const float imp = 0.5f * psum[4 * lane] + psum[4 * lane + 1] + psum[4 * lane + 2] + psum[4 * lane + 3] + 0.5f * psum[4 * lane + 4];
        const int cur = t >> 6;
        const bool allowed = lane <= cur, forced = allowed && (lane == 0 || lane == cur || lane == cur - 1);
        const float score = forced ? 1e9f : (allowed ? imp : -1e30f);
        int rank = 0;
#pragma unroll
        for (int j = 0; j < 64; ++j) { const float sj = __shfl(score, j); rank += (sj > score || (sj == score && j < lane)) ? 1 : 0; }
        const unsigned long long mask = __ballot(rank < 16 && score > -0.5e30f);
        LDS_WAIT(); asm volatile("" ::: "memory");
        const bf16* KS = KVb + 2 * KVBUF_ELEMS + (size_t)bh * KVROWS * 64; const bf16* VS = KVb + 3 * KVBUF_ELEMS + (size_t)bh * KVROWS * 64;
        float ms[4] = {-INFINITY, -INFINITY, -INFINITY, -INFINITY}, ls[4] = {0.f, 0.f, 0.f, 0.f}, os[4] = {0.f, 0.f, 0.f, 0.f};
        for (unsigned long long mk = mask; mk; mk &= mk - 1) { const int j = __builtin_ctzll(mk);
            attend_tile(KS + (size_t)j * 64 * 64, VS + (size_t)j * 64 * 64, (64 * j + lane) <= t, qs, pbuf, ms, ls, os, lane); }
        const bf16* KW = KVb + 4 * KVBUF_ELEMS + (size_t)bh * KVROWS * 64; const bf16* VW = KVb + 5 * KVBUF_ELEMS + (size_t)bh * KVROWS * 64;
        float mw[4] = {-INFINITY, -INFINITY, -INFINITY, -INFINITY}, lw[4] = {0.f, 0.f, 0.f, 0.f}, ow[4] = {0.f, 0.f, 0.f, 0.f};
        const int lo = t - 511 > 0 ? t - 511 : 0;
        for (int j = lo >> 6; j <= (t >> 6); ++j) { const int pos = 64 * j + lane;
            attend_tile(KW + (size_t)j * 64 * 64, VW + (size_t)j * 64 * 64, pos >= lo && pos <= t, qs, pbuf, mw, lw, ow, lane); }
#pragma unroll
        for (int g = 0; g < 4; ++g) { const float* gp = GATE + (size_t)m * 48 + (hk * 4 + g) * 3;
            const float o = gp[0] * oc[g] + gp[1] * os[g] / fmaxf(ls[g], 1e-30f) + gp[2] * ow[g] / fmaxf(lw[g], 1e-30f);
            O[(size_t)m * DM + (hk * 4 + g) * 64 + lane] = (bf16)f2bf(o); }
    }
}

struct SchedCmp { const char* KV; const char* W1C; int G, c;
    __device__ __forceinline__ bool next(int it, pg8::Unit& u) const { const int L = it * G + c; if (c < 0 || L >= 64) return false;
        const int i = L >> 5, pm = (L >> 1) & 15, pn = L & 1;
        u.A = KV + ((size_t)i * KVBUF_ELEMS + (size_t)pm * KVROWS * 64) * 2; u.B = W1C + ((size_t)i * 512 * 1024 + (size_t)pn * 256 * 1024) * 2;
        u.row0 = i * 4096 + pm * 256; u.col0 = pn * 256; u.e = i; u.pos0 = 0; u.cnt = 0; return true; }
    __device__ __forceinline__ void voff(const pg8::Unit&, const int (&R)[2], const int (&C)[2], int K_, unsigned (&v)[2][2]) const { pg8::voff_plain(R, C, K_, v); }
};
struct SchedKVQG { const char* A0; const char* B0; const char* A1; const char* B1; int G, c, Lbase, Lend;
    __device__ __forceinline__ bool next(int it, pg8::Unit& u) const { const int L = Lbase + it * G + c; if (c < 0 || L >= Lend) return false;
        const int sec = L >= 384 ? 1 : 0, l = sec ? L - 384 : L, nn = sec ? 5 : 6, pm = l / nn, pn = l % nn;
        u.A = (sec ? A1 : A0) + (size_t)pm * 256 * DM * 2; u.B = (sec ? B1 : B0) + (size_t)pn * 256 * DM * 2;
        u.row0 = pm * 256; u.col0 = pn * 256; u.e = sec; u.pos0 = 0; u.cnt = 0; return true; }
    __device__ __forceinline__ void voff(const pg8::Unit&, const int (&R)[2], const int (&C)[2], int K_, unsigned (&v)[2][2]) const { pg8::voff_plain(R, C, K_, v); }
};
struct SchedMoe { LAS int* tb; LAS int* cn; const unsigned* LIST; const char* Abase; const char* Bbase; size_t bstride; int K, nN, colmul, G, c; bool gather; int Lbase, Lend;
    __device__ __forceinline__ bool next(int it, pg8::Unit& u) const { const int L = Lbase + it * G + c; if (c < 0 || L >= Lend) return false;
        const int mt = L / nN, pn = L % nN; const int e = ((LAS unsigned char*)(tb + 40))[mt];
        u.A = gather ? Abase : Abase + (size_t)mt * 256 * K * 2; u.B = Bbase + (size_t)e * bstride + (size_t)pn * 256 * K * 2;
        u.row0 = mt * 256; u.col0 = pn * colmul; u.e = e; u.pos0 = (mt - tb[e]) * 256; u.cnt = cn[e]; return true; }
    __device__ __forceinline__ void voff(const pg8::Unit& u, const int (&R)[2], const int (&C)[2], int K_, unsigned (&v)[2][2]) const {
        if (!gather) { pg8::voff_plain(R, C, K_, v); return; }
        const unsigned* le = LIST + (size_t)u.e * T; unsigned tk[2][2];
#pragma unroll
        for (int h = 0; h < 2; ++h)
#pragma unroll
            for (int i = 0; i < 2; ++i) { const int pos = u.pos0 + h * 128 + R[i]; tk[h][i] = le[pos < u.cnt ? pos : u.cnt - 1]; }
#pragma unroll
        for (int h = 0; h < 2; ++h)
#pragma unroll
            for (int i = 0; i < 2; ++i) v[h][i] = ((tk[h][i] >> 1) * (unsigned)K_ + (unsigned)C[i]) * 2u;
    }
};
struct EpHU { bf16* H; __device__ __forceinline__ void pair(const pg8::Unit&, int r, int ch, f32x4 a, f32x4 b) const {
    f32x4 s; for (int q = 0; q < 4; ++q) s[q] = silu_f(a[q]) * b[q]; st_bf4(H + (size_t)r * FF + ch, s); }
    __device__ __forceinline__ void pair8(const pg8::Unit&, int r, int ch, f32x4 a0, f32x4 a1, f32x4 b0, f32x4 b1) const {
    f32x4 s0, s1; for (int q = 0; q < 4; ++q) { s0[q] = silu_f(a0[q]) * b0[q]; s1[q] = silu_f(a1[q]) * b1[q]; } st_bf8(H + (size_t)r * FF + ch, s0, s1); } };
struct EpYU { bf16* Y; const unsigned* LIST; const float* LW;
    __device__ __forceinline__ void operator()(const pg8::Unit& u, int r, int n, f32x4 v) const { const int pos = u.pos0 + (r - u.row0);
        if (pos < u.cnt) { const unsigned ts = LIST[(size_t)u.e * T + pos]; const float w = LW[(size_t)u.e * T + pos];
            st_bf4(Y + (size_t)(ts & 1u) * ((size_t)T * DM) + (size_t)(ts >> 1) * DM + n, v * w); } }
    __device__ __forceinline__ void op8(const pg8::Unit& u, int r, int n, f32x4 a, f32x4 b) const { const int pos = u.pos0 + (r - u.row0);
        if (pos < u.cnt) { const unsigned ts = LIST[(size_t)u.e * T + pos]; const float w = LW[(size_t)u.e * T + pos];
            st_bf8(Y + (size_t)(ts & 1u) * ((size_t)T * DM) + (size_t)(ts >> 1) * DM + n, a * w, b * w); } } };
struct EpYUAll { static constexpr bool PERM = true; EpYU ep;
    __device__ __forceinline__ void operator()(const f32x4 (&acc)[2][2][4][2], const pg8::Unit& u, int wr, int wc, int fr, int fq) const {
        unsigned ts[2][4]; float w[2][4];
        const unsigned* le = ep.LIST + (size_t)u.e * T; const float* lw = ep.LW + (size_t)u.e * T;
#pragma unroll
        for (int ai = 0; ai < 2; ++ai)
#pragma unroll
            for (int m = 0; m < 4; ++m) { const int pos = u.pos0 + ai * pg8::HALF + wr * 64 + m * 16 + fr; const int pc = pos < u.cnt ? pos : u.cnt - 1;
                const unsigned t_ = le[pc]; ts[ai][m] = pos < u.cnt ? t_ : 0xFFFFFFFFu; w[ai][m] = lw[pc]; }
#pragma unroll
        for (int ai = 0; ai < 2; ++ai)
#pragma unroll
            for (int m = 0; m < 4; ++m) if (ts[ai][m] != 0xFFFFFFFFu) {
                bf16* yr = ep.Y + (size_t)(ts[ai][m] & 1u) * ((size_t)T * DM) + (size_t)(ts[ai][m] >> 1) * DM + u.col0 + wc * 32 + 8 * fq;
#pragma unroll
                for (int bj = 0; bj < 2; ++bj) st_bf8(yr + bj * pg8::HALF, acc[ai][bj][m][0] * w[ai][m], acc[ai][bj][m][1] * w[ai][m]); }
    } };
template <int L>
__device__ __forceinline__ void p_moe(Frame& F, const XcdBarrier& bar, bool with_barriers) {
    moe_tables(F, L);
    LAS int* tb = (LAS int*)(F.lds + MISC_OFF + 128); LAS int* cn = tb + 20;
    const int G = gridDim.x, bx = blockIdx.x, vcu = (G % 8 == 0) ? (bx % 8) * (G / 8) + bx / 8 : bx;
    const int nt = tb[NE], n128 = nt < 128 ? nt : 128, Wg = 4 * (nt - n128) < G / 2 ? 4 * (nt - n128) : G / 2;
    const int D2 = (4 * n128 < 2 * (G - Wg)) ? 4 * n128 : 2 * (G - Wg);
#pragma unroll 1
    for (int part = 1; part <= 3; ++part) {
        int gc = -1, gG = 1, gb = 0, ge = 0, dc = -1, dG = 1, db = 0, de = 0;
        if (part == 1) { gc = vcu; gG = G; gb = 0; ge = 4 * n128; }
        else if (part == 2) { if (vcu < Wg) { gc = vcu; gG = Wg; gb = 4 * n128; ge = 4 * nt; } else { dc = vcu - Wg; dG = G - Wg; db = 0; de = D2; } }
        else { dc = vcu; dG = G; db = D2; de = 4 * nt; }
        {
            const SchedMoe S{tb, cn, (const unsigned*)(F.wsp() + WS_LIST) + (size_t)L * NE * T, (const char*)(F.wsp() + WS_U), (const char*)(F.wsp() + WS_WGU) + (size_t)L * NE * 1024 * 1024 * 2, (size_t)1024 * 1024 * 2, 1024, 4, 128, gG, gc, true, gb, ge};
            typedef pg8::EpiWrap<EpHU, true, true> E_;
            pg8::gemm_phase<E_, SchedMoe, true, true>(F.lds, 1024, S, E_{{(bf16*)(F.wsp() + WS_H)}});
        }
        {
            const SchedMoe S{tb, cn, nullptr, (const char*)(F.wsp() + WS_H), (const char*)(F.wsp() + WS_WDN) + (size_t)L * NE * 1024 * 512 * 2, (size_t)1024 * 512 * 2, 512, 4, 256, dG, dc, false, db, de};
            typedef EpYUAll E_;
            pg8::gemm_phase<E_, SchedMoe, true, false>(F.lds, 512, S, E_{{(bf16*)(F.wsp() + WS_Y0), (const unsigned*)(F.wsp() + WS_LIST) + (size_t)L * NE * T, (const float*)(F.wsp() + WS_LW) + (size_t)L * NE * T}});
        }
        if (part < 3 && with_barriers) xcd_barrier(bar);
    }
}
typedef float f32x16 __attribute__((ext_vector_type(16)));
#define MFMA32(a, b, c) __builtin_amdgcn_mfma_f32_32x32x16_bf16(a, b, c, 0, 0, 0)
constexpr size_t WS_MASK = WS_GATE + 3 * MiB;
constexpr int STG_STRIDE = 68, STG_BYTES = 32 * STG_STRIDE * 4;
__device__ __forceinline__ int crow(int r, int hi) { return (r & 3) + 8 * (r >> 2) + 4 * hi; }
__device__ __forceinline__ unsigned cvtpk(float lo, float hi) { f32x2v v = {lo, hi}; bf16x2_t b = __builtin_convertvector(v, bf16x2_t); return __builtin_bit_cast(unsigned, b); }
__device__ __forceinline__ float partner32(float x, int hi) { auto rr = __builtin_amdgcn_permlane32_swap(__builtin_bit_cast(unsigned, x), __builtin_bit_cast(unsigned, x), false, false);
    return __builtin_bit_cast(float, hi ? rr[0] : rr[1]); }
__device__ __forceinline__ float max3f(float a, float b, float c) { float r; asm("v_max3_f32 %0, %1, %2, %3" : "=v"(r) : "v"(a), "v"(b), "v"(c)); return r; }
__device__ __forceinline__ float max2f(float a, float b) { float r; asm("v_max_f32_e32 %0, %1, %2" : "=v"(r) : "v"(a), "v"(b)); return r; }
__device__ __forceinline__ float rowmax32(f32x16& p0, f32x16& p1, int hi) {
    asm volatile("s_nop 15\n\ts_nop 7" : "+v"(p0), "+v"(p1));
    float a = max3f(p0[0], p0[1], p1[0]), b = max3f(p0[2], p0[3], p1[1]); a = max3f(a, p1[2], p1[3]);
#pragma unroll
    for (int r = 4; r < 16; r += 4) { a = max3f(a, p0[r], p0[r + 1]); b = max3f(b, p0[r + 2], p0[r + 3]); a = max3f(a, p1[r], p1[r + 1]); b = max3f(b, p1[r + 2], p1[r + 3]); }
    const float m = max2f(a, b);
    return max2f(m, partner32(m, hi));
}
typedef __amdgpu_buffer_rsrc_t rsrc_t;
__device__ __forceinline__ rsrc_t make_rsrc(const void* base, unsigned bytes) { return __builtin_amdgcn_make_buffer_rsrc((void*)base, 0, (int)bytes, 0x00020000); }
__device__ __forceinline__ void load_frag8(bf16x8 (&f)[8], rsrc_t rs, unsigned vo, unsigned so) {
#pragma unroll
    for (int i = 0; i < 8; ++i) f[i] = __builtin_bit_cast(bf16x8, __builtin_amdgcn_raw_buffer_load_b128(rs, vo + i * 1024, so, 0));
}
__device__ __forceinline__ void qk_tile(f32x16& p0, f32x16& p1, const bf16x8 (&kf)[8], const LAS bf16x8* qs, const float cinit) {
    bf16x8 qr[4];
#pragma unroll
    for (int d0 = 0; d0 < 4; ++d0) qr[d0] = qs[d0 * 64];
    f32x16 c;
#pragma unroll
    for (int r = 0; r < 16; ++r) c[r] = cinit;
    p0 = MFMA32(kf[0], qr[0], c); p1 = MFMA32(kf[4], qr[0], c);
#pragma unroll
    for (int d0 = 1; d0 < 4; ++d0) { p0 = MFMA32(kf[d0], qr[d0], p0); p1 = MFMA32(kf[4 + d0], qr[d0], p1); }
}
__device__ __forceinline__ void qk_tile_lo(f32x16& p0, f32x16& p1, rsrc_t rs, unsigned vo, unsigned so, const LAS bf16x8* qs, const float cinit) {
    bf16x8 qr[4];
#pragma unroll
    for (int d0 = 0; d0 < 4; ++d0) qr[d0] = qs[d0 * 64];
#pragma unroll
    for (int r = 0; r < 16; ++r) { p0[r] = cinit; p1[r] = cinit; }
    { bf16x8 kf[4];
#pragma unroll
      for (int d0 = 0; d0 < 4; ++d0) kf[d0] = __builtin_bit_cast(bf16x8, __builtin_amdgcn_raw_buffer_load_b128(rs, vo + d0 * 1024, so, 0));
#pragma unroll
      for (int d0 = 0; d0 < 4; ++d0) p0 = MFMA32(kf[d0], qr[d0], p0); }
    asm volatile("" : "+v"(p0) :: "memory");
    { bf16x8 kf[4];
#pragma unroll
      for (int d0 = 0; d0 < 4; ++d0) kf[d0] = __builtin_bit_cast(bf16x8, __builtin_amdgcn_raw_buffer_load_b128(rs, vo + (4 + d0) * 1024, so, 0));
#pragma unroll
      for (int d0 = 0; d0 < 4; ++d0) p1 = MFMA32(kf[d0], qr[d0], p1); }
}
__device__ __forceinline__ void mask_tile(f32x16& p0, f32x16& p1, int lo, int lim, int hi) {
#pragma unroll
    for (int r = 0; r < 16; ++r) { const int k0 = crow(r, hi);
        if (!(k0 > lo && k0 <= lim)) p0[r] = -INFINITY;
        if (!(k0 + 32 > lo && k0 + 32 <= lim)) p1[r] = -INFINITY; }
}
__device__ __forceinline__ void pack_p(bf16x8 (&pa)[4], const f32x16& p0, const f32x16& p1) {
    u32x4 w0, w1, w2, w3;
#pragma unroll
    for (int q = 0; q < 4; ++q) { w0[q] = cvtpk(p0[2 * q], p0[2 * q + 1]); w1[q] = cvtpk(p0[8 + 2 * q], p0[9 + 2 * q]);
                                  w2[q] = cvtpk(p1[2 * q], p1[2 * q + 1]); w3[q] = cvtpk(p1[8 + 2 * q], p1[9 + 2 * q]); }
    pa[0] = __builtin_bit_cast(bf16x8, w0); pa[1] = __builtin_bit_cast(bf16x8, w1); pa[2] = __builtin_bit_cast(bf16x8, w2); pa[3] = __builtin_bit_cast(bf16x8, w3);
}
__device__ __forceinline__ void pv_tile(f32x16& o0, f32x16& o1, const bf16x8 (&pa)[4], const bf16x8 (&vf)[8]) {
#pragma unroll
    for (int ks = 0; ks < 4; ++ks) { o0 = MFMA32(pa[ks], vf[ks], o0); o1 = MFMA32(pa[ks], vf[4 + ks], o1); }
}
struct Sm { float mhat, l; f32x16 o0, o1, ol; };
__device__ __forceinline__ void sm_init(Sm& st) { st.mhat = 0.f; st.l = 0.f;
#pragma unroll
    for (int r = 0; r < 16; ++r) { st.o0[r] = 0.f; st.o1[r] = 0.f; st.ol[r] = 0.f; } }
__device__ __forceinline__ void sm_tile(Sm& st, f32x16& s0, f32x16& s1, bool first, const bf16x8 (&vf)[8], LAS float* wsf, int r32, int hi) {
    const float rm = rowmax32(s0, s1, hi);
    const bool need = first || (__any(rm > 8.0f) != 0);
    if (need) {
        const float dl = first ? ((rm == -INFINITY) ? 0.f : rm) : fmaxf(rm, 0.f);
        st.mhat += dl;
#pragma unroll
        for (int r = 0; r < 16; ++r) { s0[r] -= dl; s1[r] -= dl; }
        if (!first) {
            const float f = __builtin_amdgcn_exp2f(-dl);
            LDS_WAIT(); asm volatile("" ::: "memory");
            if (hi == 0) wsf[r32] = f;
            LDS_WAIT(); asm volatile("" ::: "memory");
#pragma unroll
            for (int G = 0; G < 4; ++G) { const f32x4 ff = *(const LAS f32x4*)(wsf + 8 * G + 4 * hi);
#pragma unroll
                for (int q = 0; q < 4; ++q) { st.o0[4 * G + q] *= ff[q]; st.o1[4 * G + q] *= ff[q]; st.ol[4 * G + q] *= ff[q]; } }
            LDS_WAIT(); asm volatile("" ::: "memory");
        }
    }
#pragma unroll
    for (int r = 0; r < 16; ++r) { s0[r] = __builtin_amdgcn_exp2f(s0[r]); s1[r] = __builtin_amdgcn_exp2f(s1[r]); }
    bf16x8 pa[4]; pack_p(pa, s0, s1);
    const bf16x8 ones = (bf16x8){0x3F80, 0x3F80, 0x3F80, 0x3F80, 0x3F80, 0x3F80, 0x3F80, 0x3F80};
#pragma unroll
    for (int ks = 0; ks < 4; ++ks) { st.o0 = MFMA32(pa[ks], vf[ks], st.o0); st.o1 = MFMA32(pa[ks], vf[4 + ks], st.o1); st.ol = MFMA32(pa[ks], ones, st.ol); }
}
template <bool NORM>
__device__ __forceinline__ void flush_branch(const f32x16& o0, const f32x16& o1, const f32x16& ol, const float* GATE, bf16* O, int m0, int hq, int br, bool accumulate,
                                             LAS float* stg, int lane) {
    asm volatile("" : "+v"(lane));
    const int r32 = lane & 31, hi = lane >> 5;
    LDS_WAIT(); asm volatile("" ::: "memory");
#pragma unroll
    for (int r = 0; r < 16; ++r) { const float iv = NORM ? __builtin_amdgcn_rcpf(fmaxf(ol[r], 1e-30f)) : 1.f;
        stg[crow(r, hi) * STG_STRIDE + r32] = o0[r] * iv; stg[crow(r, hi) * STG_STRIDE + 32 + r32] = o1[r] * iv; }
    LDS_WAIT(); asm volatile("" ::: "memory");
#pragma unroll
    for (int i = 0; i < 4; ++i) { const int row = i * 8 + (lane >> 3), ch = lane & 7;
        const f32x4 a = *(const LAS f32x4*)(stg + row * STG_STRIDE + ch * 8), b = *(const LAS f32x4*)(stg + row * STG_STRIDE + ch * 8 + 4);
        const float sc = GATE[(size_t)(m0 + row) * 48 + hq * 3 + br];
        bf16* op = O + (size_t)(m0 + row) * DM + hq * 64 + ch * 8;
        f32x4 x = a * sc, y = b * sc;
        if (accumulate) { const u32x4 old = *(const u32x4*)op; x += (f32x4){bflo(old.x), bfhi(old.x), bflo(old.y), bfhi(old.y)}; y += (f32x4){bflo(old.z), bfhi(old.z), bflo(old.w), bfhi(old.w)}; }
        u32x4 w; w.x = pk2(x[0], x[1]); w.y = pk2(x[2], x[3]); w.z = pk2(y[0], y[1]); w.w = pk2(y[2], y[3]);
        *(u32x4*)op = w; }
    LDS_WAIT(); asm volatile("" ::: "memory");
}
__device__ __forceinline__ void load_q(LAS bf16x8* qs, const bf16* Q, int m, int hq, int hi) {
    LDS_WAIT(); asm volatile("" ::: "memory");
#pragma unroll
    for (int d0 = 0; d0 < 4; ++d0) qs[d0 * 64] = *(const bf16x8*)(Q + (size_t)m * DM + hq * 64 + d0 * 16 + hi * 8);
    LDS_WAIT(); asm volatile("" ::: "memory");
}
__device__ __forceinline__ void p_attn_cmp(Frame& F) {
    LAS float* stg = (LAS float*)(F.lds + F.wave * 16384); LAS float* wsf = stg + 32 * STG_STRIDE;
    const bf16* Q = (const bf16*)(F.wsp() + WS_Q); const float* GATE = (const float*)(F.wsp() + WS_GATE); bf16* O = (bf16*)(F.wsp() + WS_O);
    unsigned long long* MASK = (unsigned long long*)(F.wsp() + WS_MASK);
    for (int it = F.gw; it < 16 * 128; it += F.NGW) {
        const int bh = it >> 7, blk = 127 - (it & 127), b = bh >> 2, hk = bh & 3, m0 = b * SEQ + blk * 32;
        const rsrc_t rs = make_rsrc(F.wsp() + WS_KC, 1u << 20);
        const unsigned soK = (unsigned)bh * 32768u, soV = 524288u + (unsigned)bh * 32768u;
        const int nvmax = ((blk * 32) >> 4) + 1, ntc = (nvmax + 63) >> 6;
        float mref0 = 0.f, mref1 = 0.f, mref2 = 0.f, mref3 = 0.f, inv0 = 0.f, inv1 = 0.f, inv2 = 0.f, inv3 = 0.f;
#pragma unroll 1
        for (int g = 0; g < 4; ++g) {
            int lane = F.lane; asm volatile("" : "+v"(lane));
            const int r32 = lane & 31, hi = lane >> 5, t = blk * 32 + r32, nvr = t >= 31 ? ((t - 31) >> 4) + 1 : 0;
            LAS bf16x8* qr = (LAS bf16x8*)(wsf + 64) + lane; load_q(qr, Q, m0 + r32, hk * 4 + g, hi);
            float mrun = -INFINITY, l = 0.f;
#pragma unroll 1
            for (int i = 0; i < ntc; ++i) {
                f32x16 s0, s1; qk_tile_lo(s0, s1, rs, (unsigned)lane * 16u, soK + (unsigned)i * 8192u, qr, 0.f); mask_tile(s0, s1, -1, nvr - 1 - 64 * i, hi);
                const float rm = rowmax32(s0, s1, hi), mn = fmaxf(mrun, rm), mr = (mn == -INFINITY) ? 0.f : mn;
                float sum = 0.f;
#pragma unroll
                for (int r = 0; r < 16; ++r) sum += __builtin_amdgcn_exp2f(s0[r] - mr) + __builtin_amdgcn_exp2f(s1[r] - mr);
                l = l * __builtin_amdgcn_exp2f(mrun - mr) + sum; mrun = mn;
            }
            const float ltot = l + partner32(l, hi);
            const float iv = 1.f / fmaxf(ltot, 1e-30f), mr_ = (mrun == -INFINITY) ? 0.f : mrun;
            if (g == 0) { inv0 = iv; mref0 = mr_; } else if (g == 1) { inv1 = iv; mref1 = mr_; } else if (g == 2) { inv2 = iv; mref2 = mr_; } else { inv3 = iv; mref3 = mr_; }
        }
        {
            float imp[32];
#pragma unroll
            for (int k = 0; k < 32; ++k) imp[k] = 0.f;
#pragma unroll 1
            for (int g = 0; g < 4; ++g) {
                int lane = F.lane; asm volatile("" : "+v"(lane));
                const int r32 = lane & 31, hi = lane >> 5, t = blk * 32 + r32, nvr = t >= 31 ? ((t - 31) >> 4) + 1 : 0;
                LAS bf16x8* qr = (LAS bf16x8*)(wsf + 64) + lane; load_q(qr, Q, m0 + r32, hk * 4 + g, hi);
                const float invg = g == 0 ? inv0 : g == 1 ? inv1 : g == 2 ? inv2 : inv3, mg = g == 0 ? mref0 : g == 1 ? mref1 : g == 2 ? mref2 : mref3;
#pragma unroll
                for (int i = 0; i < 4; ++i) if (i < ntc) {
                    asm volatile("" ::: "memory");
                    f32x16 s0, s1; qk_tile_lo(s0, s1, rs, (unsigned)lane * 16u, soK + (unsigned)i * 8192u, qr, -mg); mask_tile(s0, s1, -1, nvr - 1 - 64 * i, hi);
#pragma unroll
                    for (int r = 0; r < 16; ++r) { s0[r] = __builtin_amdgcn_exp2f(s0[r]) * invg; s1[r] = __builtin_amdgcn_exp2f(s1[r]) * invg; }
#pragma unroll
                    for (int G = 0; G < 4; ++G) {
                        { const int kq = 8 * i + G; const float e = s0[4 * G + 3], pe = partner32(e, hi);
                          imp[kq] += (s0[4 * G] + s0[4 * G + 1]) + s0[4 * G + 2] + 0.5f * e + (hi ? 0.5f * pe : 0.f);
                          if (kq + 1 < 32) imp[kq + 1] += hi ? 0.f : 0.5f * pe; }
                        { const int kq = 8 * i + 4 + G; const float e = s1[4 * G + 3], pe = partner32(e, hi);
                          imp[kq] += (s1[4 * G] + s1[4 * G + 1]) + s1[4 * G + 2] + 0.5f * e + (hi ? 0.5f * pe : 0.f);
                          if (kq + 1 < 32) imp[kq + 1] += hi ? 0.f : 0.5f * pe; }
                    }
                }
            }
            int lane = F.lane; asm volatile("" : "+v"(lane));
            const int r32 = lane & 31, hi = lane >> 5, cur = (blk * 32 + r32) >> 6;
            LDS_WAIT(); asm volatile("" ::: "memory");
#pragma unroll
            for (int k = 0; k < 32; ++k) { const int j = 2 * k + hi; const bool allowed = j <= cur, forced = allowed && (j == 0 || j == cur || j == cur - 1);
                stg[r32 * STG_STRIDE + j] = forced ? 1e9f : (allowed ? imp[k] : -1e30f); }
            LDS_WAIT(); asm volatile("" ::: "memory");
        }
        {
            int lane = F.lane; asm volatile("" : "+v"(lane));
            unsigned long long mymask = 0ull;
#pragma unroll 1
            for (int tok = 0; tok < 32; ++tok) {
                const float sc = stg[tok * STG_STRIDE + lane]; int rank = 0;
#pragma unroll
                for (int q = 0; q < 16; ++q) { const f32x4 v = *(const LAS f32x4*)(stg + tok * STG_STRIDE + 4 * q);
#pragma unroll
                    for (int e = 0; e < 4; ++e) rank += (v[e] > sc || (v[e] == sc && (4 * q + e) < lane)) ? 1 : 0; }
                const unsigned long long mk = __ballot(rank < 16 && sc > -0.5e30f);
                mymask = (lane == tok) ? mk : mymask;
            }
            if (lane < 32) MASK[(size_t)bh * SEQ + blk * 32 + lane] = mymask;
            LDS_WAIT(); asm volatile("" ::: "memory");
        }
#pragma unroll 1
        for (int g = 0; g < 4; ++g) {
            int lane = F.lane; asm volatile("" : "+v"(lane));
            const int r32 = lane & 31, hi = lane >> 5, t = blk * 32 + r32, nvr = t >= 31 ? ((t - 31) >> 4) + 1 : 0;
            LAS bf16x8* qr = (LAS bf16x8*)(wsf + 64) + lane; load_q(qr, Q, m0 + r32, hk * 4 + g, hi);
            const float invg = g == 0 ? inv0 : g == 1 ? inv1 : g == 2 ? inv2 : inv3, mg = g == 0 ? mref0 : g == 1 ? mref1 : g == 2 ? mref2 : mref3;
            f32x16 o0, o1;
#pragma unroll
            for (int r = 0; r < 16; ++r) { o0[r] = 0.f; o1[r] = 0.f; }
#pragma unroll 1
            for (int i = 0; i < ntc; ++i) {
                f32x16 s0, s1; qk_tile_lo(s0, s1, rs, (unsigned)lane * 16u, soK + (unsigned)i * 8192u, qr, -mg); mask_tile(s0, s1, -1, nvr - 1 - 64 * i, hi);
#pragma unroll
                for (int r = 0; r < 16; ++r) { s0[r] = __builtin_amdgcn_exp2f(s0[r]) * invg; s1[r] = __builtin_amdgcn_exp2f(s1[r]) * invg; }
                bf16x8 pa[4]; pack_p(pa, s0, s1);
                bf16x8 vf[8]; load_frag8(vf, rs, (unsigned)lane * 16u, soV + (unsigned)i * 8192u); pv_tile(o0, o1, pa, vf);
            }
            flush_branch<false>(o0, o1, o0, GATE, O, m0, hk * 4 + g, 0, false, stg, lane);
        }
    }
}
__device__ __forceinline__ void attn_main_item(Frame& F, int bh, int g, int blk, LAS float* stg, LAS float* wsf) {
    const bf16* Q = (const bf16*)(F.wsp() + WS_Q); const float* GATE = (const float*)(F.wsp() + WS_GATE); bf16* O = (bf16*)(F.wsp() + WS_O);
    const rsrc_t rs = make_rsrc(F.wsp() + WS_KV, (unsigned)(6 * KVBUF_ELEMS * 2));
    int lane = F.lane; asm volatile("" : "+v"(lane));
    const int r32 = lane & 31, hi = lane >> 5;
    const unsigned vo = (unsigned)lane * 16u;
    const int b = bh >> 2, hk = bh & 3, hq = hk * 4 + g, m0 = b * SEQ + blk * 32, c = blk >> 1, ql = (blk & 1) * 32 + r32;
    LAS bf16x8* qr = (LAS bf16x8*)(wsf + 64) + lane; load_q(qr, Q, m0 + r32, hq, hi);
    const unsigned long long mask = ((const unsigned long long*)(F.wsp() + WS_MASK))[(size_t)bh * SEQ + blk * 32 + r32];
    bf16x8 kf[8], vf[8];
    {
        const unsigned soK = (unsigned)((2 * KVBUF_ELEMS + (size_t)bh * KVROWS * 64) * 2), soV = (unsigned)((3 * KVBUF_ELEMS + (size_t)bh * KVROWS * 64) * 2);
        Sm st; sm_init(st);
        load_frag8(kf, rs, vo, soK);
#pragma unroll 1
        for (int j = 0; j <= c; ++j) {
            const bool sel = ((mask >> j) & 1ull) != 0ull;
            f32x16 s0, s1; qk_tile(s0, s1, kf, qr, sel ? -st.mhat : -INFINITY);
            asm volatile("" : "+v"(s0), "+v"(s1) :: "memory");
            load_frag8(vf, rs, vo, soV + (unsigned)j * 8192u);
            load_frag8(kf, rs, vo, soK + (unsigned)(j < c ? j + 1 : c) * 8192u);
            if (j == c) mask_tile(s0, s1, -1, ql, hi);
            sm_tile(st, s0, s1, j == 0, vf, wsf, r32, hi);
            asm volatile("" : "+v"(st.o0), "+v"(st.o1), "+v"(st.ol) :: "memory");
        }
        flush_branch<true>(st.o0, st.o1, st.ol, GATE, O, m0, hq, 1, true, stg, lane);
    }
    {
        const unsigned soK = (unsigned)((4 * KVBUF_ELEMS + (size_t)bh * KVROWS * 64) * 2), soV = (unsigned)((5 * KVBUF_ELEMS + (size_t)bh * KVROWS * 64) * 2);
        Sm st; sm_init(st);
        const int j0 = c >= 8 ? c - 8 : 0;
        load_frag8(kf, rs, vo, soK + (unsigned)j0 * 8192u);
#pragma unroll 1
        for (int j = j0; j <= c; ++j) {
            f32x16 s0, s1; qk_tile(s0, s1, kf, qr, -st.mhat);
            asm volatile("" : "+v"(s0), "+v"(s1) :: "memory");
            load_frag8(vf, rs, vo, soV + (unsigned)j * 8192u);
            load_frag8(kf, rs, vo, soK + (unsigned)(j < c ? j + 1 : c) * 8192u);
            if (j == c || j + 8 == c) mask_tile(s0, s1, (j + 8 == c) ? ql : -1, (j == c) ? ql : 63, hi);
            sm_tile(st, s0, s1, j == j0, vf, wsf, r32, hi);
            asm volatile("" : "+v"(st.o0), "+v"(st.o1), "+v"(st.ol) :: "memory");
        }
        flush_branch<true>(st.o0, st.o1, st.ol, GATE, O, m0, hq, 2, true, stg, lane);
    }
}
__device__ __forceinline__ void p_attn_main(Frame& F) {
    LAS float* stg = (LAS float*)(F.lds + F.wave * 16384); LAS float* wsf = stg + 32 * STG_STRIDE;
    for (int P = F.gw; P < 4096; P += F.NGW) {
        const int bh = P >> 8, rem = P & 255, g = rem & 3, k = rem >> 2;
        attn_main_item(F, bh, g, 127 - k, stg, wsf);
        attn_main_item(F, bh, g, k, stg, wsf);
    }
}
constexpr int AT_SLOT = 16384, AT_NSLOT = 4, AT_PW_OFF = AT_NSLOT * AT_SLOT, AT_PW_BYTES = STG_BYTES + 256 + 384, AT_MASK_OFF = AT_PW_OFF + 8 * AT_PW_BYTES;
static_assert(AT_MASK_OFF + 512 <= LDSCTL_OFF, "attention LDS map");
#define AT_WAIT_BAR(N) asm volatile("s_waitcnt vmcnt(" #N ") lgkmcnt(0)\n\ts_barrier" ::: "memory")
__device__ __forceinline__ void at_dma(const char* g, LAS unsigned char* l) { __builtin_amdgcn_global_load_lds((const unsigned*)g, (LAS unsigned*)l, 16, 0, 0); }
__device__ __forceinline__ void qk_tile_reg(f32x16& p0, f32x16& p1, const LAS unsigned char* ks, const bf16x8 (&qr)[4], const float cinit) {
    bf16x8 kf[8];
#pragma unroll
    for (int f = 0; f < 8; ++f) kf[f] = *(const LAS bf16x8*)(ks + f * 1024);
    __builtin_amdgcn_sched_barrier(0);
    f32x16 c;
#pragma unroll
    for (int r = 0; r < 16; ++r) c[r] = cinit;
    p0 = MFMA32(kf[0], qr[0], c); p1 = MFMA32(kf[4], qr[0], c);
#pragma unroll
    for (int d0 = 1; d0 < 4; ++d0) { p0 = MFMA32(kf[d0], qr[d0], p0); p1 = MFMA32(kf[4 + d0], qr[d0], p1); }
}
template <int V>
__device__ __forceinline__ void sm_tile_lds(Sm& st, f32x16& s0, f32x16& s1, bool first, const LAS unsigned char* vs, LAS float* wsf, int r32, int hi) {
    const float rm = rowmax32(s0, s1, hi);
    const bool need = first || (__any(rm > 8.0f) != 0);
    if (need) {
        const float dl = first ? ((rm == -INFINITY) ? 0.f : rm) : fmaxf(rm, 0.f);
        st.mhat += dl;
#pragma unroll
        for (int r = 0; r < 16; ++r) { s0[r] -= dl; s1[r] -= dl; }
        if (!first) {
            const float f = __builtin_amdgcn_exp2f(-dl);
            LDS_WAIT(); asm volatile("" ::: "memory");
            if (hi == 0) wsf[r32] = f;
            LDS_WAIT(); asm volatile("" ::: "memory");
#pragma unroll
            for (int G = 0; G < 4; ++G) { const f32x4 ff = *(const LAS f32x4*)(wsf + 8 * G + 4 * hi);
#pragma unroll
                for (int q = 0; q < 4; ++q) { st.o0[4 * G + q] *= ff[q]; st.o1[4 * G + q] *= ff[q]; st.ol[4 * G + q] *= ff[q]; } }
            LDS_WAIT(); asm volatile("" ::: "memory");
        }
    }
    bf16x8 vf[8];
#pragma unroll
    for (int f = 0; f < 8; ++f) vf[f] = *(const LAS bf16x8*)(vs + f * 1024);
    __builtin_amdgcn_sched_barrier(0);
    if (V != 2) {
#pragma unroll
    for (int r = 0; r < 16; ++r) { s0[r] = __builtin_amdgcn_exp2f(s0[r]); s1[r] = __builtin_amdgcn_exp2f(s1[r]); } }
    bf16x8 pa[4]; pack_p(pa, s0, s1);
    const bf16x8 ones = (bf16x8){0x3F80, 0x3F80, 0x3F80, 0x3F80, 0x3F80, 0x3F80, 0x3F80, 0x3F80};
    if (V != 3) {
#pragma unroll
    for (int ks = 0; ks < 4; ++ks) { st.o0 = MFMA32(pa[ks], vf[ks], st.o0); st.o1 = MFMA32(pa[ks], vf[4 + ks], st.o1); st.ol = MFMA32(pa[ks], ones, st.ol); }
    } else { asm volatile("" :: "v"(pa[0]), "v"(pa[1]), "v"(pa[2]), "v"(pa[3]), "v"(vf[0]), "v"(vf[1]), "v"(vf[2]), "v"(vf[3]), "v"(vf[4]), "v"(vf[5]), "v"(vf[6]), "v"(vf[7])); }
}
template <bool WIN, int V>
__device__ __forceinline__ void at_branch(Sm& st, const char* Kg, const char* Vg, int j0, int c, int ql, unsigned long long mask, const bf16x8 (&qr)[4],
                                          LAS unsigned char* ring, LAS float* wsf, int wave, int lane) {
    const int r32 = lane & 31, hi = lane >> 5, n = c - j0 + 1;
    LAS unsigned char* dk = ring + wave * 1024;
    const LAS unsigned char* rd = ring + lane * 16;
#pragma unroll
    for (int d = 0; d < 3; ++d) if (d < n) { at_dma(Kg + (size_t)(j0 + d) * 8192, dk + d * AT_SLOT); at_dma(Vg + (size_t)(j0 + d) * 8192, dk + d * AT_SLOT + 8192); }
#pragma unroll 1
    for (int t = 0; t < n; ++t) {
        const int rem = n - 1 - t;
        if (V != 1) { if (rem >= 2) AT_WAIT_BAR(4); else if (rem == 1) AT_WAIT_BAR(2); else AT_WAIT_BAR(0); }
        if (t + 3 < n) { const int sl = (t + 3) & 3; at_dma(Kg + (size_t)(j0 + t + 3) * 8192, dk + sl * AT_SLOT); at_dma(Vg + (size_t)(j0 + t + 3) * 8192, dk + sl * AT_SLOT + 8192); }
        const int j = j0 + t; const LAS unsigned char* slot = rd + (t & 3) * AT_SLOT;
        const bool sel = WIN ? true : (((mask >> j) & 1ull) != 0ull);
        f32x16 s0, s1;
        if (V != 4) qk_tile_reg(s0, s1, slot, qr, sel ? -st.mhat : -INFINITY);
        else {
#pragma unroll
            for (int r = 0; r < 16; ++r) { s0[r] = sel ? -st.mhat : -1.f; s1[r] = s0[r]; } asm volatile("" : "+v"(s0), "+v"(s1)); }
        if (WIN) { if (j == c || j + 8 == c) mask_tile(s0, s1, (j + 8 == c) ? ql : -1, (j == c) ? ql : 63, hi); }
        else { if (j == c) mask_tile(s0, s1, -1, ql, hi); }
        sm_tile_lds<V>(st, s0, s1, t == 0, slot + 8192, wsf, r32, hi);
    }
}
#define AT_PIN(x) asm volatile("" : "+v"(x))
#define AT_GAPA(MF, P, B, W, I) do { MF; lsum += (P[B] + P[B + 1]) + (P[B + 2] + P[B + 3]); W[I] = cvtpk(P[B], P[B + 1]); W[I + 1] = cvtpk(P[B + 2], P[B + 3]); \
        AT_PIN(lsum); AT_PIN(W); __builtin_amdgcn_sched_barrier(0); } while (0)
#define AT_GAPB(MF, C, B) do { MF; C[B] = __builtin_amdgcn_exp2f(C[B]); C[B + 1] = __builtin_amdgcn_exp2f(C[B + 1]); C[B + 2] = __builtin_amdgcn_exp2f(C[B + 2]); C[B + 3] = __builtin_amdgcn_exp2f(C[B + 3]); \
        AT_PIN(C); __builtin_amdgcn_sched_barrier(0); } while (0)
template <bool WIN>
__device__ __forceinline__ void at_branch_pipe(Sm& st, const char* Kg, const char* Vg, int j0, int c, int ql, unsigned long long mask, const bf16x8 (&qr)[4],
                                               LAS unsigned char* ring, LAS float* wsf, int wave, int lane) {
    const int r32 = lane & 31, hi = lane >> 5, n = c - j0 + 1;
    LAS unsigned char* dk = ring + wave * 1024;
    const LAS unsigned char* rd = ring + lane * 16;
#pragma unroll
    for (int d = 0; d < 2; ++d) if (d < n) { at_dma(Kg + (size_t)(j0 + d) * 8192, dk + d * AT_SLOT); at_dma(Vg + (size_t)(j0 + d) * 8192, dk + d * AT_SLOT + 8192); }
    if (n > 1) AT_WAIT_BAR(2); else AT_WAIT_BAR(0);
    if (2 < n) { at_dma(Kg + (size_t)(j0 + 2) * 8192, dk + 2 * AT_SLOT); at_dma(Vg + (size_t)(j0 + 2) * 8192, dk + 2 * AT_SLOT + 8192); }
    f32x16 p0, p1;
    { const bool sel = WIN ? true : ((mask >> j0) & 1ull) != 0ull;
      qk_tile_reg(p0, p1, rd, qr, sel ? 0.f : -INFINITY);
      if (WIN) { if (j0 == c || j0 + 8 == c) mask_tile(p0, p1, (j0 + 8 == c) ? ql : -1, (j0 == c) ? ql : 63, hi); }
      else { if (j0 == c) mask_tile(p0, p1, -1, ql, hi); }
      const float rm = rowmax32(p0, p1, hi), dl = (rm == -INFINITY) ? 0.f : rm;
      st.mhat = dl;
#pragma unroll
      for (int r = 0; r < 16; ++r) { p0[r] = __builtin_amdgcn_exp2f(p0[r] - dl); p1[r] = __builtin_amdgcn_exp2f(p1[r] - dl); } }
#pragma unroll 1
    for (int t = 1; t < n; ++t) {
        if (t + 1 < n) AT_WAIT_BAR(2); else AT_WAIT_BAR(0);
        if (t + 2 < n) { const int sl = (t + 2) & 3; at_dma(Kg + (size_t)(j0 + t + 2) * 8192, dk + sl * AT_SLOT); at_dma(Vg + (size_t)(j0 + t + 2) * 8192, dk + sl * AT_SLOT + 8192); }
        const int j = j0 + t;
        const bool sel = WIN ? true : ((mask >> j) & 1ull) != 0ull;
        const LAS unsigned char* ks = rd + (t & 3) * AT_SLOT; const LAS unsigned char* vs = rd + ((t - 1) & 3) * AT_SLOT + 8192;
        bf16x8 kf[8], vf[8];
#pragma unroll
        for (int f = 0; f < 8; ++f) kf[f] = *(const LAS bf16x8*)(ks + f * 1024);
        f32x16 cv; { const float ci = sel ? -st.mhat : -INFINITY;
#pragma unroll
            for (int r = 0; r < 16; ++r) cv[r] = ci; }
        __builtin_amdgcn_sched_barrier(0);
        f32x16 c0, c1; u32x4 w0, w1, w2, w3; float lsum = 0.f;
        AT_GAPA(c0 = MFMA32(kf[0], qr[0], cv), p0, 0, w0, 0);
        AT_GAPA(c1 = MFMA32(kf[4], qr[0], cv), p0, 4, w0, 2);
        AT_GAPA(c0 = MFMA32(kf[1], qr[1], c0), p0, 8, w1, 0);
        AT_GAPA(c1 = MFMA32(kf[5], qr[1], c1), p0, 12, w1, 2);
#pragma unroll
        for (int f = 0; f < 8; ++f) vf[f] = *(const LAS bf16x8*)(vs + f * 1024);
        __builtin_amdgcn_sched_barrier(0);
        AT_GAPA(c0 = MFMA32(kf[2], qr[2], c0), p1, 0, w2, 0);
        AT_GAPA(c1 = MFMA32(kf[6], qr[2], c1), p1, 4, w2, 2);
        AT_GAPA(c0 = MFMA32(kf[3], qr[3], c0), p1, 8, w3, 0);
        AT_GAPA(c1 = MFMA32(kf[7], qr[3], c1), p1, 12, w3, 2);
        st.l += lsum;
        if (WIN) { if (j == c || j + 8 == c) mask_tile(c0, c1, (j + 8 == c) ? ql : -1, (j == c) ? ql : 63, hi); }
        else { if (j == c) mask_tile(c0, c1, -1, ql, hi); }
        const float rm = rowmax32(c0, c1, hi);
        const bool resc = (__any(rm > 8.0f) != 0);
        if (resc) { const float dl = fmaxf(rm, 0.f); st.mhat += dl;
#pragma unroll
            for (int r = 0; r < 16; ++r) { c0[r] -= dl; c1[r] -= dl; }
            const float f = __builtin_amdgcn_exp2f(-dl); st.l *= f;
            LDS_WAIT(); asm volatile("" ::: "memory");
            if (hi == 0) wsf[r32] = f; }
        __builtin_amdgcn_sched_barrier(0);
        { const bf16x8 a0 = __builtin_bit_cast(bf16x8, w0), a1 = __builtin_bit_cast(bf16x8, w1), a2 = __builtin_bit_cast(bf16x8, w2), a3 = __builtin_bit_cast(bf16x8, w3);
          AT_GAPB(st.o0 = MFMA32(a0, vf[0], st.o0), c0, 0);
          AT_GAPB(st.o1 = MFMA32(a0, vf[4], st.o1), c0, 4);
          AT_GAPB(st.o0 = MFMA32(a1, vf[1], st.o0), c0, 8);
          AT_GAPB(st.o1 = MFMA32(a1, vf[5], st.o1), c0, 12);
          AT_GAPB(st.o0 = MFMA32(a2, vf[2], st.o0), c1, 0);
          AT_GAPB(st.o1 = MFMA32(a2, vf[6], st.o1), c1, 4);
          AT_GAPB(st.o0 = MFMA32(a3, vf[3], st.o0), c1, 8);
          AT_GAPB(st.o1 = MFMA32(a3, vf[7], st.o1), c1, 12); }
        if (resc) {
            LDS_WAIT(); asm volatile("" ::: "memory");
#pragma unroll
            for (int G = 0; G < 4; ++G) { const f32x4 ff = *(const LAS f32x4*)(wsf + 8 * G + 4 * hi);
#pragma unroll
                for (int q = 0; q < 4; ++q) { st.o0[4 * G + q] *= ff[q]; st.o1[4 * G + q] *= ff[q]; } }
            LDS_WAIT(); asm volatile("" ::: "memory"); }
        p0 = c0; p1 = c1;
    }
    { float lsum = 0.f;
#pragma unroll
      for (int r = 0; r < 16; ++r) lsum += p0[r] + p1[r];
      st.l += lsum;
      bf16x8 pa[4]; pack_p(pa, p0, p1);
      bf16x8 vf[8]; const LAS unsigned char* vs = rd + ((n - 1) & 3) * AT_SLOT + 8192;
#pragma unroll
      for (int f = 0; f < 8; ++f) vf[f] = *(const LAS bf16x8*)(vs + f * 1024);
      pv_tile(st.o0, st.o1, pa, vf); }
    { const float lt = st.l + partner32(st.l, hi);
      LDS_WAIT(); asm volatile("" ::: "memory");
      if (hi == 0) wsf[r32] = lt;
      LDS_WAIT(); asm volatile("" ::: "memory");
#pragma unroll
      for (int G = 0; G < 4; ++G) { const f32x4 ff = *(const LAS f32x4*)(wsf + 8 * G + 4 * hi);
#pragma unroll
          for (int q = 0; q < 4; ++q) st.ol[4 * G + q] = ff[q]; }
      LDS_WAIT(); asm volatile("" ::: "memory"); }
}
template <bool DRY, int V>
__device__ __forceinline__ void attn_unit(Frame& F, int bh, int c) {
    const bf16* Q = (const bf16*)(F.wsp() + WS_Q); const float* GATE = (const float*)(F.wsp() + WS_GATE); bf16* O = (bf16*)(F.wsp() + (DRY ? WS_Y0 : WS_O));
    const int wave = F.wave, g = wave >> 1, th = wave & 1;
    int lane = F.lane; asm volatile("" : "+v"(lane));
    const int r32 = lane & 31, hi = lane >> 5;
    const int b = bh >> 2, hk = bh & 3, hq = hk * 4 + g, m0 = b * SEQ + c * 64 + th * 32, t = c * 64 + th * 32 + r32, ql = th * 32 + r32;
    LAS unsigned char* ring = F.lds;
    LAS float* stg = (LAS float*)(F.lds + AT_PW_OFF + wave * AT_PW_BYTES); LAS float* wsf = stg + 32 * STG_STRIDE;
    LAS unsigned long long* masks = (LAS unsigned long long*)(F.lds + AT_MASK_OFF);
    const size_t lofs = (size_t)wave * 1024 + (size_t)lane * 16;
    bf16x8 qr[4];
#pragma unroll
    for (int d0 = 0; d0 < 4; ++d0) qr[d0] = *(const bf16x8*)(Q + (size_t)(m0 + r32) * DM + hq * 64 + d0 * 16 + hi * 8);
    LAS float* gl = wsf + 64;
    if (hi == 0) { const float* gp = GATE + (size_t)(m0 + r32) * 48 + hq * 3; gl[r32] = gp[0]; gl[32 + r32] = gp[1]; gl[64 + r32] = gp[2]; }
    const int nvr = t >= 31 ? ((t - 31) >> 4) + 1 : 0, ntc = (4 * c + 3 + 63) >> 6;
    f32x16 oc0, oc1;
    {
        const char* KCg = (const char*)(F.wsp() + WS_KC) + (size_t)bh * 32768 + lofs; const char* VCg = (const char*)(F.wsp() + WS_VC) + (size_t)bh * 32768 + lofs;
        asm volatile("s_waitcnt vmcnt(0)" ::: "memory");
        for (int i = 0; i < ntc; ++i) { at_dma(KCg + (size_t)i * 8192, ring + i * AT_SLOT + wave * 1024); at_dma(VCg + (size_t)i * 8192, ring + i * AT_SLOT + 8192 + wave * 1024); }
        AT_WAIT_BAR(0);
        const LAS unsigned char* rd = ring + lane * 16;
        float mhat = 0.f, l = 0.f;
        float imp[32];
#pragma unroll
        for (int k = 0; k < 32; ++k) imp[k] = 0.f;
        f32x16 o0, o1;
#pragma unroll
        for (int r = 0; r < 16; ++r) { o0[r] = 0.f; o1[r] = 0.f; }
#pragma unroll
        for (int i = 0; i < 4; ++i) if (i < ntc) {
            asm volatile("" ::: "memory");
            f32x16 s0, s1; qk_tile_reg(s0, s1, rd + i * AT_SLOT, qr, -mhat); mask_tile(s0, s1, -1, nvr - 1 - 64 * i, hi);
            const float rm = rowmax32(s0, s1, hi);
            if (i == 0) { const float dl = (rm == -INFINITY) ? 0.f : rm; mhat = dl;
#pragma unroll
                for (int r = 0; r < 16; ++r) { s0[r] -= dl; s1[r] -= dl; } }
            else if (__any(rm > 8.0f) != 0) { const float dl = fmaxf(rm, 0.f); mhat += dl;
#pragma unroll
                for (int r = 0; r < 16; ++r) { s0[r] -= dl; s1[r] -= dl; }
                const float f = __builtin_amdgcn_exp2f(-dl); l *= f;
#pragma unroll
                for (int k = 0; k < 32; ++k) imp[k] *= f;
                LDS_WAIT(); asm volatile("" ::: "memory");
                if (hi == 0) wsf[r32] = f;
                LDS_WAIT(); asm volatile("" ::: "memory");
#pragma unroll
                for (int G = 0; G < 4; ++G) { const f32x4 ff = *(const LAS f32x4*)(wsf + 8 * G + 4 * hi);
#pragma unroll
                    for (int q = 0; q < 4; ++q) { o0[4 * G + q] *= ff[q]; o1[4 * G + q] *= ff[q]; } }
                LDS_WAIT(); asm volatile("" ::: "memory"); }
            float sum = 0.f;
#pragma unroll
            for (int r = 0; r < 16; ++r) { s0[r] = __builtin_amdgcn_exp2f(s0[r]); s1[r] = __builtin_amdgcn_exp2f(s1[r]); sum += s0[r] + s1[r]; }
            l += sum;
#pragma unroll
            for (int G = 0; G < 4; ++G) {
                { const int kq = 8 * i + G; const float e = s0[4 * G + 3], pe = partner32(e, hi);
                  imp[kq] += (s0[4 * G] + s0[4 * G + 1]) + s0[4 * G + 2] + 0.5f * e + (hi ? 0.5f * pe : 0.f);
                  if (kq + 1 < 32) imp[kq + 1] += hi ? 0.f : 0.5f * pe; }
                { const int kq = 8 * i + 4 + G; const float e = s1[4 * G + 3], pe = partner32(e, hi);
                  imp[kq] += (s1[4 * G] + s1[4 * G + 1]) + s1[4 * G + 2] + 0.5f * e + (hi ? 0.5f * pe : 0.f);
                  if (kq + 1 < 32) imp[kq + 1] += hi ? 0.f : 0.5f * pe; }
            }
            bf16x8 pa[4]; pack_p(pa, s0, s1);
            { bf16x8 vf[4];
#pragma unroll
              for (int f = 0; f < 4; ++f) vf[f] = *(const LAS bf16x8*)(rd + i * AT_SLOT + 8192 + f * 1024);
#pragma unroll
              for (int ks = 0; ks < 4; ++ks) o0 = MFMA32(pa[ks], vf[ks], o0);
              asm volatile("" : "+v"(o0) :: "memory");
#pragma unroll
              for (int f = 0; f < 4; ++f) vf[f] = *(const LAS bf16x8*)(rd + i * AT_SLOT + 8192 + (4 + f) * 1024);
#pragma unroll
              for (int ks = 0; ks < 4; ++ks) o1 = MFMA32(pa[ks], vf[ks], o1); }
        }
        const float ltot = l + partner32(l, hi), inv = 1.f / fmaxf(ltot, 1e-30f);
#pragma unroll
        for (int k = 0; k < 32; ++k) imp[k] *= inv;
        LDS_WAIT(); asm volatile("" ::: "memory");
        if (hi == 0) wsf[r32] = gl[r32] * inv;
        LDS_WAIT(); asm volatile("" ::: "memory");
#pragma unroll
        for (int G = 0; G < 4; ++G) { const f32x4 gg = *(const LAS f32x4*)(wsf + 8 * G + 4 * hi);
#pragma unroll
            for (int q = 0; q < 4; ++q) { oc0[4 * G + q] = o0[4 * G + q] * gg[q]; oc1[4 * G + q] = o1[4 * G + q] * gg[q]; } }
        LDS_WAIT(); asm volatile("" ::: "memory");
#pragma unroll
        for (int k = 0; k < 32; ++k) stg[r32 * STG_STRIDE + 2 * k + hi] = imp[k];
    }
    AT_WAIT_BAR(0);
    const char* KSg = (const char*)(F.wsp() + WS_KV) + (2 * KVBUF_ELEMS + (size_t)bh * KVROWS * 64) * 2 + lofs;
    const char* VSg = (const char*)(F.wsp() + WS_KV) + (3 * KVBUF_ELEMS + (size_t)bh * KVROWS * 64) * 2 + lofs;
    if (c < 16) { if (lane < 8) masks[th * 32 + 8 * g + lane] = (2ull << c) - 1ull; }
    else {
        const LAS float* st0 = (const LAS float*)(F.lds + AT_PW_OFF + (0 * 2 + th) * AT_PW_BYTES); const LAS float* st1 = (const LAS float*)(F.lds + AT_PW_OFF + (1 * 2 + th) * AT_PW_BYTES);
        const LAS float* st2 = (const LAS float*)(F.lds + AT_PW_OFF + (2 * 2 + th) * AT_PW_BYTES); const LAS float* st3 = (const LAS float*)(F.lds + AT_PW_OFF + (3 * 2 + th) * AT_PW_BYTES);
        const bool allowed = lane <= c, forced = allowed && (lane == 0 || lane == c || lane == c - 1);
        LAS unsigned* kst = (LAS unsigned*)stg;
#pragma unroll 1
        for (int i = 0; i < 8; i += 2) {
            const int tokA = 8 * g + i, tokB = tokA + 1, aA = tokA * STG_STRIDE + lane, aB = tokB * STG_STRIDE + lane;
            const float vA = ((st0[aA] + st1[aA]) + st2[aA]) + st3[aA], vB = ((st0[aB] + st1[aB]) + st2[aB]) + st3[aB];
            const unsigned low = 63u - (unsigned)lane;
            const unsigned keyA = forced ? (0xFFFFFFC0u | low) : (allowed ? ((__builtin_bit_cast(unsigned, vA) & 0xFFFFFFC0u) | low) : 0u);
            const unsigned keyB = forced ? (0xFFFFFFC0u | low) : (allowed ? ((__builtin_bit_cast(unsigned, vB) & 0xFFFFFFC0u) | low) : 0u);
            LDS_WAIT(); asm volatile("" ::: "memory");
            kst[aA] = keyA; kst[aB] = keyB;
            LDS_WAIT(); asm volatile("" ::: "memory");
            int rankA = 0, rankB = 0;
#pragma unroll
            for (int q = 0; q < 16; ++q) { const u32x4 xa = *(const LAS u32x4*)(kst + tokA * STG_STRIDE + 4 * q), xb = *(const LAS u32x4*)(kst + tokB * STG_STRIDE + 4 * q);
#pragma unroll
                for (int e = 0; e < 4; ++e) { rankA += (xa[e] > keyA) ? 1 : 0; rankB += (xb[e] > keyB) ? 1 : 0; } }
            const unsigned long long mkA = __ballot(rankA < 16 && allowed), mkB = __ballot(rankB < 16 && allowed);
            if (lane == 0) { masks[th * 32 + tokA] = mkA; masks[th * 32 + tokB] = mkB; }
        }
    }
    AT_WAIT_BAR(0);
    const unsigned long long mask = masks[th * 32 + r32];
#pragma unroll
    for (int r = 0; r < 16; ++r) { stg[crow(r, hi) * STG_STRIDE + r32] = oc0[r]; stg[crow(r, hi) * STG_STRIDE + 32 + r32] = oc1[r]; }
    {
        Sm st; sm_init(st);
        if (V == 0) at_branch_pipe<false>(st, KSg, VSg, 0, c, ql, mask, qr, ring, wsf, wave, lane); else if (V != 5) at_branch<false, V>(st, KSg, VSg, 0, c, ql, mask, qr, ring, wsf, wave, lane);
        LDS_WAIT(); asm volatile("" ::: "memory");
#pragma unroll
        for (int G = 0; G < 4; ++G) { const f32x4 gg = *(const LAS f32x4*)(gl + 32 + 8 * G + 4 * hi);
#pragma unroll
            for (int q = 0; q < 4; ++q) { const int r = 4 * G + q; const float iv = gg[q] * __builtin_amdgcn_rcpf(fmaxf(st.ol[r], 1e-30f));
                stg[crow(r, hi) * STG_STRIDE + r32] += st.o0[r] * iv; stg[crow(r, hi) * STG_STRIDE + 32 + r32] += st.o1[r] * iv; } }
    }
    AT_WAIT_BAR(0);
    {
        const char* KWg = (const char*)(F.wsp() + WS_KV) + (4 * KVBUF_ELEMS + (size_t)bh * KVROWS * 64) * 2 + lofs;
        const char* VWg = (const char*)(F.wsp() + WS_KV) + (5 * KVBUF_ELEMS + (size_t)bh * KVROWS * 64) * 2 + lofs;
        Sm st; sm_init(st);
        if (V == 0) at_branch_pipe<true>(st, KWg, VWg, c >= 8 ? c - 8 : 0, c, ql, 0ull, qr, ring, wsf, wave, lane); else if (V != 5) at_branch<true, V>(st, KWg, VWg, c >= 8 ? c - 8 : 0, c, ql, 0ull, qr, ring, wsf, wave, lane);
        LDS_WAIT(); asm volatile("" ::: "memory");
#pragma unroll
        for (int G = 0; G < 4; ++G) { const f32x4 gg = *(const LAS f32x4*)(gl + 64 + 8 * G + 4 * hi);
#pragma unroll
            for (int q = 0; q < 4; ++q) { const int r = 4 * G + q; const float iv = gg[q] * __builtin_amdgcn_rcpf(fmaxf(st.ol[r], 1e-30f));
                stg[crow(r, hi) * STG_STRIDE + r32] += st.o0[r] * iv; stg[crow(r, hi) * STG_STRIDE + 32 + r32] += st.o1[r] * iv; } }
        LDS_WAIT(); asm volatile("" ::: "memory");
#pragma unroll
        for (int i = 0; i < 4; ++i) { const int row = i * 8 + (lane >> 3), ch = lane & 7;
            const f32x4 a = *(const LAS f32x4*)(stg + row * STG_STRIDE + ch * 8), b2 = *(const LAS f32x4*)(stg + row * STG_STRIDE + ch * 8 + 4);
            u32x4 w; w.x = pk2(a[0], a[1]); w.y = pk2(a[2], a[3]); w.z = pk2(b2[0], b2[1]); w.w = pk2(b2[2], b2[3]);
            *(u32x4*)(O + (size_t)(m0 + row) * DM + hq * 64 + ch * 8) = w; }
    }
    AT_WAIT_BAR(0);
}
template <bool DRY, int V>
__device__ __forceinline__ void p_attn_fused(Frame& F) {
    const int G = gridDim.x, bx = blockIdx.x, vcu = (G % 8 == 0) ? (bx % 8) * (G / 8) + bx / 8 : bx;
    for (int P = vcu; P < 512; P += G) {
        const int bh = P >> 5, k = P & 31;
#pragma unroll 1
        for (int h = 0; h < 2; ++h) attn_unit<DRY, V>(F, bh, h ? k : 63 - k);
    }
}
struct Args { const float* in[23]; float* out; unsigned char* ws; int ph_lo, ph_hi; };
__global__ void __launch_bounds__(512, 2) mk_fwd(Args args) {
    extern __shared__ __attribute__((aligned(16))) unsigned char lds[];
    Frame F;
    F.lds = (LAS unsigned char*)lds; F.MISC = (volatile LAS unsigned*)(F.lds + MISC_OFF);
    F.tid = threadIdx.x; F.lane = F.tid & 63; F.wave = __builtin_amdgcn_readfirstlane(F.tid >> 6);
    F.gw = blockIdx.x * 8 + F.wave; F.NGW = gridDim.x * 8;
    for (int u = F.tid; u < (LDS_BYTES - LDSCTL_OFF) / 4; u += 512) ((LAS unsigned*)(F.lds + LDSCTL_OFF))[u] = 0u;
    __syncthreads();
    if (F.tid < 25) { const unsigned long long v = F.tid < 23 ? (unsigned long long)args.in[F.tid] : F.tid == 23 ? (unsigned long long)args.out : (unsigned long long)args.ws;
        LAS unsigned* p = (LAS unsigned*)(F.lds + PTR_OFF) + 2 * F.tid; p[0] = (unsigned)v; p[1] = (unsigned)(v >> 32); }
    __syncthreads();
    XcdBarrier bar; bar.bar = (unsigned*)(F.ctlp() + CW_BAR); bar.x = 0; bar.st = nullptr;
    const int lo = args.ph_lo, hi = args.ph_hi;
    if (hi - lo > 1) bar = xcd_barrier_post((unsigned*)(F.ctlp() + CW_BAR), F.MISC + 8);
#ifdef PH_ONLY
#define IN(k) ((k) == PH_ONLY && lo <= (k) && (k) < hi)
#else
#define IN(k) (lo <= (k) && (k) < hi)
#endif
#define SEAM(k) do { if (IN(k) && (k) + 1 < hi) xcd_barrier(bar); } while (0)
    if (IN(0)) {
#pragma unroll 1
        for (int rep = 0; rep < REP0; ++rep) { p0_prologue(F); if (rep + 1 < REP0) xcd_barrier(bar); } } SEAM(0);
    if (IN(1)) {
#pragma unroll 1
        for (int rep = 0; rep < REP1; ++rep) { p1_mod_u0(F); if (rep + 1 < REP1) xcd_barrier(bar); }
#pragma unroll 1
        for (int rep = 0; rep < XBAR - 1; ++rep) xcd_barrier(bar); } SEAM(1);
    if (IN(2)) for (int rep = 0; rep < REP2; ++rep) {
        const char* A = (const char*)(F.wsp() + WS_U); const char* B = (const char*)(F.wsp() + WS_WIN);
        const pg8::SchedDense S{A, B, A, B + (size_t)1024 * DM * 2, T / 256, 4, 8, DM, (int)gridDim.x, (int)blockIdx.x, 256};
#if DRY2 == 1
        { pg8::gemm_phase<EpNull, pg8::SchedDense, true, false>(F.lds, DM, S, EpNull{}); xcd_barrier(bar); }
#elif DRY2 == 2
        { pg8::gemm_phase<EpG1, pg8::SchedDense, true, false>(F.lds, DM, S, EpG1{(bf16*)(F.wsp() + WS_Y0), (bf16*)(F.wsp() + WS_Y1)}); xcd_barrier(bar); }
#endif
        pg8::gemm_phase<EpG1, pg8::SchedDense, true, false>(F.lds, DM, S, EpG1{(bf16*)(F.wsp() + WS_BG), (bf16*)(F.wsp() + WS_Z)});
        if (rep + 1 < REP2) xcd_barrier(bar);
    } SEAM(2);
    if (IN(3)) {
#pragma unroll 1
        for (int rep = 0; rep < REP3; ++rep) { p3_conv(F); if (rep + 1 < REP3) xcd_barrier(bar); } } SEAM(3);
    if (IN(4)) for (int rep = 0; rep < REP4; ++rep) {
        const pg8::SchedDense S{(const char*)(F.wsp() + WS_A2), (const char*)(F.wsp() + WS_WOUT), nullptr, nullptr, T / 256, 4, 0, DM, (int)gridDim.x, (int)blockIdx.x, 256};
        typedef pg8::EpiWrap<EpU<EpBf16>, false, true> E_;
        pg8::gemm_phase<E_, pg8::SchedDense, false, false>(F.lds, DM, S, E_{{{(bf16*)(F.wsp() + WS_Y0), DM}}});
        if (rep + 1 < REP4) xcd_barrier(bar);
    } SEAM(4);
    if (IN(5)) {
#pragma unroll 1
        for (int rep = 0; rep < DRY5; ++rep) { p_ln_router<0, true>(F); xcd_barrier(bar); }
        p_ln_router<0>(F); } SEAM(5);
    if (IN(6)) { p_moe<0>(F, bar, true); } SEAM(6);
    if (IN(8)) {
#pragma unroll 1
        for (int rep = 0; rep < DRY8; ++rep) { p_ln2<0, true>(F); xcd_barrier(bar); }
        p_ln2<0>(F); } SEAM(8);
    if (IN(9)) {
        const int G = gridDim.x, bx = blockIdx.x, vcu = (G % 8 == 0) ? (bx % 8) * (G / 8) + bx / 8 : bx;
        const SchedKVQG S{(const char*)(F.wsp() + WS_XB), (const char*)(F.wsp() + WS_WKV), (const char*)(F.wsp() + WS_U), (const char*)(F.wsp() + WS_WQG), G, vcu, 0, 512};
        typedef EpKVQGAll E_;
        pg8::gemm_phase<E_, SchedKVQG, true, false>(F.lds, DM, S, E_{{(bf16*)(F.wsp() + WS_KV), (bf16*)(F.wsp() + WS_Q), (float*)(F.wsp() + WS_GATE), F.inp(I_BG)}});
    } SEAM(9);
    if (IN(10)) {
        const int G = gridDim.x, bx = blockIdx.x, vcu = (G % 8 == 0) ? (bx % 8) * (G / 8) + bx / 8 : bx;
        const int nq = G - 64 > 0 ? G - 64 : G;
        {
            const SchedKVQG S{(const char*)(F.wsp() + WS_XB), (const char*)(F.wsp() + WS_WKV), (const char*)(F.wsp() + WS_U), (const char*)(F.wsp() + WS_WQG), nq, vcu < nq ? vcu : -1, 512, 704};
            typedef EpKVQGAll E_;
            pg8::gemm_phase<E_, SchedKVQG, false, false>(F.lds, DM, S, E_{{(bf16*)(F.wsp() + WS_KV), (bf16*)(F.wsp() + WS_Q), (float*)(F.wsp() + WS_GATE), F.inp(I_BG)}});
        }
        {
            const SchedCmp S{(const char*)(F.wsp() + WS_KV), (const char*)(F.wsp() + WS_W1C), G - nq > 0 ? G - nq : G, G - nq > 0 ? (vcu >= nq ? vcu - nq : -1) : vcu};
            typedef pg8::EpiWrap<EpU<EpF32>, false> E_;
            pg8::gemm_phase<E_, SchedCmp, false, false>(F.lds, 1024, S, E_{{{(float*)(F.wsp() + WS_TB), 512}}});
        }
    } SEAM(10);
    if (IN(11)) {
#pragma unroll 1
        for (int rep = 0; rep < REP11; ++rep) { p_cmp_finish(F); if (rep + 1 < REP11) xcd_barrier(bar); } } SEAM(11);
#if ATTN_FUSED
    if (IN(12)) {
#pragma unroll 1
        for (int rep = 0; rep < DRY12; ++rep) { p_attn_fused<true, ATV>(F); xcd_barrier(bar); }
        p_attn_fused<false, 0>(F); } SEAM(12);
#else
    if (IN(12)) { p_attn_cmp(F); } SEAM(12);
    if (IN(13)) { p_attn_main(F); } SEAM(13);
#endif
    if (IN(14)) {
        const pg8::SchedDense S{(const char*)(F.wsp() + WS_O), (const char*)(F.wsp() + WS_WO), nullptr, nullptr, T / 256, 4, 0, DM, (int)gridDim.x, (int)blockIdx.x, 256};
        typedef pg8::EpiWrap<EpU<EpBf16>, false, true> E_;
        pg8::gemm_phase<E_, pg8::SchedDense, false, false>(F.lds, DM, S, E_{{{(bf16*)(F.wsp() + WS_Y0), DM}}});
    } SEAM(14);
    if (IN(15)) { p_ln_router<1>(F); } SEAM(15);
    if (IN(16)) { p_moe<1>(F, bar, true); } SEAM(16);
    if (IN(18)) { p_ln2<1>(F); }
#undef IN
#undef SEAM
}

extern "C" void kernel_launch(void* const* d_in, const int* in_sizes, int n_in, void* d_out, int out_size, void* d_ws, size_t ws_size, hipStream_t stream) {
    static int grid = 0;
    if (grid == 0) {
        if (n_in != 23 || out_size != T * DM || ws_size < WS_END) { fprintf(stderr, "kernel_launch: unexpected shapes (n_in %d out %d ws %zu, need ws >= %zu)\n", n_in, out_size, ws_size, (size_t)WS_END); grid = -1; return; }
        int dev = 0, cus = 0, per_cu = 0;
        if (hipGetDevice(&dev) != hipSuccess || hipDeviceGetAttribute(&cus, hipDeviceAttributeMultiprocessorCount, dev) != hipSuccess) { grid = -1; return; }
        if (hipFuncSetAttribute((const void*)mk_fwd, hipFuncAttributeMaxDynamicSharedMemorySize, LDS_BYTES) != hipSuccess) { fprintf(stderr, "kernel_launch: hipFuncSetAttribute failed\n"); grid = -1; return; }
        if (hipOccupancyMaxActiveBlocksPerMultiprocessor(&per_cu, (const void*)mk_fwd, 512, LDS_BYTES) != hipSuccess || per_cu < 1) { fprintf(stderr, "kernel_launch: occupancy query says %d\n", per_cu); per_cu = 1; }
        (void)hipGetLastError();
        grid = cus;
    }
    if (grid < 0) return;
    (void)hipMemsetAsync((char*)d_ws + WS_CTL, 0, CTL_ZERO_BYTES, stream);
    Args a{};
    for (int i = 0; i < 23; ++i) a.in[i] = (const float*)d_in[i];
    a.out = (float*)d_out; a.ws = (unsigned char*)d_ws;
    if (MK_N_LAUNCHES == 1) { a.ph_lo = 0; a.ph_hi = NPH; hipLaunchKernelGGL(mk_fwd, dim3(grid), dim3(512), LDS_BYTES, stream, a); }
    else for (int p = 0; p < NPH; ++p) { a.ph_lo = p; a.ph_hi = p + 1; hipLaunchKernelGGL(mk_fwd, dim3(grid), dim3(512), LDS_BYTES, stream, a); }
}
```
